# Optimizing an MI355X kernel written in HIP

```python
import math
import jax, jax.numpy as jnp
from jax import lax
import numpy as np

D_MODEL = 1024
BATCH = 4
SEQ = 4096
DEPTH = 4

DA_HEADS = 4
DA_QK_DIM = 64
DA_V_DIM = 2 * DA_QK_DIM
DA_QK_WIDTH = DA_HEADS * 2 * DA_QK_DIM
DA_WIDTH = DA_HEADS * DA_V_DIM
ROPE_THETA = 500000.0
ROT_DIM = DA_QK_DIM // 4
Q_BLOCK = 128
HG_HEADS = 4
HG_K_DIM = 128
HG_V_DIM = 128
HG_K_WIDTH = HG_HEADS * HG_K_DIM
HG_V_WIDTH = HG_HEADS * HG_V_DIM
HG_CHUNK = 64
FFN_HIDDEN = -(-8 * D_MODEL // (3 * 256)) * 256
NORM_EPS = 1e-6
IN_SIZES = (DA_QK_WIDTH, DA_QK_WIDTH, DA_WIDTH,
            HG_K_WIDTH, HG_K_WIDTH, HG_K_WIDTH, HG_V_WIDTH, HG_V_WIDTH,
            D_MODEL, D_MODEL)
IN_WIDTH = sum(IN_SIZES)

kernel_name = "hybrid_diffattn_hgrn2_gated_encoder"


def rmsnorm(x, gain):
    xf = x.astype(jnp.float32)
    y = xf * lax.rsqrt(jnp.mean(xf * xf, axis=-1, keepdims=True) + NORM_EPS)
    return (y * gain.astype(jnp.float32)).astype(x.dtype)


def split_columns(p):
    outs, start = [], 0
    for size in IN_SIZES:
        outs.append(p[..., start:start + size])
        start += size
    return outs


def rope_tables(positions):
    inv_freq = ROPE_THETA ** (-(jnp.arange(0, ROT_DIM, 2, dtype=jnp.float32) / ROT_DIM))
    ang = positions.astype(jnp.float32)[..., None] * inv_freq
    return jnp.cos(ang), jnp.sin(ang)


def apply_partial_rope(t, cos, sin):
    c = cos[:, :, None, None, :].astype(t.dtype)
    s = sin[:, :, None, None, :].astype(t.dtype)
    half = ROT_DIM // 2
    t1 = t[..., :half]
    t2 = t[..., half:ROT_DIM]
    rot = jnp.concatenate([t1 * c - t2 * s, t2 * c + t1 * s], axis=-1)
    return jnp.concatenate([rot, t[..., ROT_DIM:]], axis=-1)


def diff_attention(h_q, h_k, h_v, cos, sin, lam, norm_gain, layer):
    B, S, _ = h_q.shape
    q = h_q.reshape(B, S, DA_HEADS, 2, DA_QK_DIM)
    k = h_k.reshape(B, S, DA_HEADS, 2, DA_QK_DIM)
    v = h_v.reshape(B, S, DA_HEADS, DA_V_DIM)
    q = apply_partial_rope(q, cos, sin) * (DA_QK_DIM ** -0.5)
    k = apply_partial_rope(k, cos, sin)
    lam_init = 0.8 - 0.6 * math.exp(-0.3 * layer)
    l32 = lam.astype(jnp.float32)
    lam_full = (jnp.exp(jnp.sum(l32[0] * l32[1])) - jnp.exp(jnp.sum(l32[2] * l32[3]))
                + lam_init)
    nq = S // Q_BLOCK
    qb = q.reshape(B, nq, Q_BLOCK, DA_HEADS, 2, DA_QK_DIM).transpose(1, 0, 2, 3, 4, 5)

    def block(qi):
        s = jnp.einsum('bqhcd,bkhcd->bhcqk', qi, k).astype(jnp.float32)
        p = jax.nn.softmax(s, axis=-1)
        w = p[:, :, 0] - lam_full * p[:, :, 1]
        return jnp.einsum('bhqk,bkhv->bqhv', w.astype(v.dtype), v)

    o = lax.map(block, qb)
    o = o.transpose(1, 0, 2, 3, 4).reshape(B, S, DA_HEADS, DA_V_DIM)
    o = rmsnorm(o, norm_gain.reshape(DA_HEADS, DA_V_DIM)) * (1.0 - lam_init)
    return o.reshape(B, S, DA_WIDTH)


def hgrn_lower_bounds(lb_logits):
    p = jax.nn.softmax(lb_logits.astype(jnp.float32), axis=1)
    c = jnp.cumsum(p, axis=1)
    return c - c[:, :1]


def log_forget(z, lb):
    return jnp.logaddexp(jnp.log(lb), jnp.log1p(-lb) + jax.nn.log_sigmoid(z))


def chunk_scan(q, k, g, v):
    B, S, H, dk = q.shape
    dv = v.shape[-1]
    n = S // HG_CHUNK

    def to_chunks(t):
        return t.reshape(B, n, HG_CHUNK, H, t.shape[-1]).transpose(1, 0, 3, 2, 4)

    tril = jnp.tril(jnp.ones((HG_CHUNK, HG_CHUNK), dtype=bool))

    def step(state, inp):
        qc, kc, gc, vc = inp
        b = jnp.cumsum(gc, axis=2)
        inter = jnp.einsum('bhck,bhkv->bhcv', qc * jnp.exp(b), state)
        diff = b[:, :, :, None, :] - b[:, :, None, :, :]
        decay = jnp.exp(jnp.where(tril[:, :, None], diff, -jnp.inf))
        scores = jnp.einsum('bhtk,bhsk,bhtsk->bhts', qc, kc, decay)
        intra = jnp.einsum('bhts,bhsv->bhtv', scores, vc)
        b_last = b[:, :, -1, :]
        state = (jnp.exp(b_last)[..., None] * state
                 + jnp.einsum('bhck,bhcv->bhkv', kc * jnp.exp(b_last[:, :, None, :] - b), vc))
        return state, inter + intra

    s0 = jnp.zeros((B, H, dk, dv), jnp.float32)
    _, out = lax.scan(step, s0, (to_chunks(q), to_chunks(k), to_chunks(g), to_chunks(v)))
    return out.transpose(1, 0, 3, 2, 4).reshape(B, S, H, dv)


def hgrn2_bidirectional(h_q, h_ff, h_fb, h_i, h_g, lb_f, lb_b, norm_gain):
    B, S, _ = h_q.shape
    f32 = jnp.float32
    q = h_q.astype(f32).reshape(B, S, HG_HEADS, HG_K_DIM)
    v = h_i.astype(f32).reshape(B, S, HG_HEADS, HG_V_DIM)
    g_f = log_forget(h_ff.astype(f32).reshape(B, S, HG_HEADS, HG_K_DIM),
                     lb_f.reshape(HG_HEADS, HG_K_DIM))
    g_b = log_forget(h_fb.astype(f32).reshape(B, S, HG_HEADS, HG_K_DIM),
                     lb_b.reshape(HG_HEADS, HG_K_DIM))
    k_f = -jnp.expm1(g_f)
    k_b = -jnp.expm1(g_b)
    out_f = chunk_scan(q, k_f, g_f, v)
    out_b = chunk_scan(q[:, ::-1], k_b[:, ::-1], g_b[:, ::-1], v[:, ::-1])[:, ::-1]
    o = rmsnorm(out_f + out_b, norm_gain.reshape(HG_HEADS, HG_V_DIM))
    o = o * jax.nn.sigmoid(h_g.astype(f32).reshape(B, S, HG_HEADS, HG_V_DIM))
    return o.reshape(B, S, HG_V_WIDTH).astype(h_q.dtype)


def setup_inputs(seed: int = 0) -> dict:
    key = jax.random.key(seed)
    ks = jax.random.split(key, 18)
    nrm = jax.random.normal
    f32 = jnp.float32
    x = nrm(ks[0], (BATCH, SEQ, D_MODEL), f32)
    offset = jax.random.randint(ks[1], (BATCH, 1), 0, 1024, dtype=jnp.int32)
    positions = offset + jnp.arange(SEQ, dtype=jnp.int32)[None, :]
    w_in = nrm(ks[2], (DEPTH, D_MODEL, IN_WIDTH), f32) * D_MODEL ** -0.5
    da_lambda = nrm(ks[3], (DEPTH, 4, DA_QK_DIM), f32) * 0.1
    da_norm = 1.0 + 0.02 * nrm(ks[4], (DEPTH, DA_WIDTH), f32)
    hg_lb_logits = 0.5 * nrm(ks[5], (2, DEPTH, HG_K_WIDTH), f32)
    hg_norm = 1.0 + 0.02 * nrm(ks[6], (DEPTH, HG_V_WIDTH), f32)
    w_a = nrm(ks[7], (DEPTH, DA_WIDTH, D_MODEL), f32) * DA_WIDTH ** -0.5
    w_b = nrm(ks[8], (DEPTH, HG_V_WIDTH, D_MODEL), f32) * HG_V_WIDTH ** -0.5
    w_o = nrm(ks[9], (DEPTH, D_MODEL, D_MODEL), f32) * D_MODEL ** -0.5
    attn_norm = 1.0 + 0.02 * nrm(ks[10], (DEPTH, D_MODEL), f32)
    ffn_norm = 1.0 + 0.02 * nrm(ks[11], (DEPTH, D_MODEL), f32)
    w_gate = nrm(ks[12], (DEPTH, D_MODEL, FFN_HIDDEN), f32) * D_MODEL ** -0.5
    w_up = nrm(ks[13], (DEPTH, D_MODEL, FFN_HIDDEN), f32) * D_MODEL ** -0.5
    w_down = nrm(ks[14], (DEPTH, FFN_HIDDEN, D_MODEL), f32) * FFN_HIDDEN ** -0.5
    final_norm = 1.0 + 0.02 * nrm(ks[15], (D_MODEL,), f32)
    return {"x": x, "positions": positions, "w_in": w_in, "da_lambda": da_lambda,
            "da_norm": da_norm, "hg_lb_logits": hg_lb_logits, "hg_norm": hg_norm,
            "w_a": w_a, "w_b": w_b, "w_o": w_o, "attn_norm": attn_norm,
            "ffn_norm": ffn_norm, "w_gate": w_gate, "w_up": w_up, "w_down": w_down,
            "final_norm": final_norm}


def reference(x, positions, w_in, da_lambda, da_norm, hg_lb_logits, hg_norm, w_a, w_b,
              w_o, attn_norm, ffn_norm, w_gate, w_up, w_down, final_norm):
    cos, sin = rope_tables(positions)
    lbs = hgrn_lower_bounds(hg_lb_logits)
    for layer in range(DEPTH):
        h = rmsnorm(x, attn_norm[layer])
        proj = h @ w_in[layer]
        (a_q, a_k, a_v, b_q, b_ff, b_fb, b_i, b_g, gate_a, gate_b) = split_columns(proj)
        y_a = diff_attention(a_q, a_k, a_v, cos, sin, da_lambda[layer], da_norm[layer],
                             layer) @ w_a[layer]
        y_b = hgrn2_bidirectional(b_q, b_ff, b_fb, b_i, b_g,
                                  lbs[0, layer].astype(x.dtype).astype(jnp.float32),
                                  lbs[1, layer].astype(x.dtype).astype(jnp.float32),
                                  hg_norm[layer]) @ w_b[layer]
        merged = jax.nn.sigmoid(gate_a) * y_a + jax.nn.sigmoid(gate_b) * y_b
        x = x + merged @ w_o[layer]
        h = rmsnorm(x, ffn_norm[layer])
        x = x + (jax.nn.silu(h @ w_gate[layer]) * (h @ w_up[layer])) @ w_down[layer]
    return rmsnorm(x, final_norm)
```

```cpp
#include <hip/hip_runtime.h>
#include <hip/hip_cooperative_groups.h>
#include <cstdio>
#include <cstdint>
namespace cg = cooperative_groups;

#define LAS __attribute__((address_space(3)))
typedef unsigned short bf16_t;
typedef short bf16x8 __attribute__((ext_vector_type(8)));
typedef short s16x4 __attribute__((ext_vector_type(4)));
typedef float f32x4 __attribute__((ext_vector_type(4)));
typedef float f32x16 __attribute__((ext_vector_type(16)));
typedef unsigned u32x4 __attribute__((ext_vector_type(4)));
typedef unsigned u32x2 __attribute__((ext_vector_type(2)));

constexpr int Dm = 1024, NB = 4, SEQ = 4096, M = NB * SEQ, DEPTH = 4, FF = 2816, INW = 6144;
constexpr float EPS = 1e-6f;
constexpr float LOG2E = 1.4426950408889634f;

constexpr size_t W_IN = 0, W_AB = 12582912, W_O2 = 14680064, W_GU = 18874368, W_D = 30408704, WSZ = 36175872;
constexpr size_t MiB = 1048576;
constexpr size_t OFF_XB = 2 * WSZ;
constexpr size_t OFF_RSA = OFF_XB + 32 * MiB;
constexpr size_t OFF_RSB = OFF_RSA + MiB;
constexpr size_t OFF_CS = OFF_RSB + MiB;
constexpr size_t OFF_LB = OFF_CS + MiB;
constexpr size_t OFF_LAM = OFF_LB + 16384;
constexpr size_t OFF_DG = OFF_LAM + 256;
constexpr size_t OFF_EG = OFF_DG + MiB;
constexpr size_t OFF_B = OFF_EG + MiB;
constexpr size_t OFF_GATE = OFF_B;
constexpr size_t OFF_Q = OFF_B, OFF_K = OFF_B + 16 * MiB, OFF_V = OFF_B + 32 * MiB;
constexpr size_t OFF_HQ = OFF_B + 64 * MiB;
constexpr size_t OFF_HV = OFF_HQ + 16 * MiB;
constexpr size_t OFF_GF = OFF_HV + 16 * MiB;
constexpr size_t OFF_GB = OFF_GF + 32 * MiB;
constexpr size_t OFF_Y = OFF_GF;
constexpr size_t OFF_BG = OFF_GB + 32 * MiB;
constexpr size_t OFF_AO = OFF_BG + 16 * MiB;
constexpr size_t OFF_UT = OFF_AO + 32 * MiB;
constexpr size_t OFF_H = OFF_B;
constexpr size_t WS_END = OFF_UT + 64 * MiB;

constexpr int LDS_BYTES = 131072 + 2048;

__device__ __forceinline__ unsigned f2bf(float f) { unsigned u = __builtin_bit_cast(unsigned, f); return (u + 0x7fffu + ((u >> 16) & 1u)) >> 16; }
__device__ __forceinline__ unsigned pk2(float lo, float hi) { return f2bf(lo) | (f2bf(hi) << 16); }
__device__ __forceinline__ float bf2f(unsigned short b) { return __builtin_bit_cast(float, (unsigned)b << 16); }
__device__ __forceinline__ float bflo(unsigned u) { return __builtin_bit_cast(float, u << 16); }
__device__ __forceinline__ float bfhi(unsigned u) { return __builtin_bit_cast(float, u & 0xffff0000u); }
__device__ __forceinline__ float sigmoidf_(float x) { return 1.0f / (1.0f + __expf(-x)); }

namespace pg8 {
constexpr int BM = 256, BK = 64, HALF = 128, HTB = HALF * BK * 2, STAGE_BYTES = 8 * HTB, NXCD = 8, WGM = 8;
__host__ __device__ __forceinline__ int lds_byte(int r, int c) { const int st = (r >> 4) * 2 + (c >> 5), rr = r & 15, cc = c & 31, ob = rr * 64 + cc * 2; return st * 1024 + (ob ^ (((ob >> 9) & 1) << 5)); }
__host__ __device__ __forceinline__ void stage_rc(int b, int& R, int& C) { const int st = b / 1024, sb = b % 1024, swz = sb ^ (((sb >> 9) & 1) << 5); R = (st >> 1) * 16 + swz / 64; C = (st & 1) * 32 + (swz % 64) / 2; }
__host__ __device__ __forceinline__ int perm32(int rho) { const int n = rho >> 4, i = rho & 15; return 8 * (i >> 2) + 4 * n + (i & 3); }

struct Unit { int pm, pn; };
struct Gemm { const bf16_t* A; const bf16_t* Bt; int lda, ldb, K; int split_pn; int split_aoff; };

struct StaticOrder {
    int nM, nN, nwg, G, c;
    __device__ __forceinline__ void init(int M_, int N_, int G_, int c_) { nM = M_ / BM; nN = N_ / BM; nwg = nM * nN; G = G_; c = c_; }
    __device__ bool next(int i, Unit& u) const {
        const long L = (long)i * G + c; if (L >= nwg) return false;
        int wgid = (int)L; { const int q = nwg / NXCD, r = nwg % NXCD, xcd = wgid % NXCD, off = wgid / NXCD; wgid = (xcd < r ? xcd * (q + 1) : r * (q + 1) + (xcd - r) * q) + off; }
        const int nig = WGM * nN, gid = wgid / nig, fm = gid * WGM, gsz = (nM - fm) < WGM ? (nM - fm) : WGM;
        u.pm = fm + ((wgid % nig) % gsz); u.pn = (wgid % nig) / gsz; return true;
    }
};

template <class Epi>
__device__ __forceinline__ void gemm_phase(LAS unsigned char* lds, const Gemm g, const StaticOrder& S, const Epi& E) {
    int tid_ = threadIdx.x; asm volatile("" : "+v"(tid_));
    const int tid = tid_, wid = __builtin_amdgcn_readfirstlane(tid >> 6), lane = tid & 63, wr = wid >> 2, wc = wid & 3, fr = lane & 15, fq = lane >> 4;
    const int K = g.K, nt = K / BK;
    unsigned voffA[2], voffB[2];
#pragma unroll
    for (int i = 0; i < 2; ++i) { int R, C; stage_rc(tid * 16 + i * 8192, R, C); const int Rb = (R & ~31) + perm32(R & 31);
        voffA[i] = (unsigned)(R * g.lda + C) * 2u; voffB[i] = (unsigned)(Rb * g.ldb + C) * 2u; }
    const size_t kstep = (size_t)(BK * 2);
    const size_t hstepA = (size_t)HALF * g.lda * 2, hstepB = (size_t)HALF * g.ldb * 2;
    const size_t tstepA = 2 * hstepA, tstepB = 2 * hstepB;
    const unsigned ldsw = (unsigned)wid * 1024u;
    const int aoff = lds_byte(wr * 64 + fr, fq * 8), boff = lds_byte(wc * 32 + fr, fq * 8);
#define PG8_SA(b, h) (((b) * 2 + (h)) * HTB)
#define PG8_SB(b, h) ((4 + (b) * 2 + (h)) * HTB)
#define PG8_STAGE(bufoff, gbase, voff) do { _Pragma("unroll") for (int _i = 0; _i < 2; ++_i) \
        __builtin_amdgcn_global_load_lds((const unsigned*)((const char*)(gbase) + (voff)[_i]), (LAS unsigned*)(lds + (bufoff) + ldsw + _i * 8192), 16, 0, 0); } while (0)
#define PG8_LDA(dst, b, h) do { _Pragma("unroll") for (int m = 0; m < 4; ++m) _Pragma("unroll") for (int k = 0; k < 2; ++k) dst[m][k] = *(const LAS bf16x8*)(lds + PG8_SA(b, h) + aoff + m * 2048 + k * 1024); } while (0)
#define PG8_LDB(dst, b, h) do { _Pragma("unroll") for (int n = 0; n < 2; ++n) _Pragma("unroll") for (int k = 0; k < 2; ++k) dst[n][k] = *(const LAS bf16x8*)(lds + PG8_SB(b, h) + boff + n * 2048 + k * 1024); } while (0)
#define PG8_MMA(ai, bj, At, Bt) do { __builtin_amdgcn_s_setprio(1); _Pragma("unroll") for (int m = 0; m < 4; ++m) _Pragma("unroll") for (int n = 0; n < 2; ++n) _Pragma("unroll") for (int k = 0; k < 2; ++k) \
        acc[ai][bj][m][n] = __builtin_amdgcn_mfma_f32_16x16x32_bf16(Bt[n][k], At[m][k], acc[ai][bj][m][n], 0, 0, 0); __builtin_amdgcn_s_setprio(0); } while (0)
#define PG8_WAIT_V(n) asm volatile("s_waitcnt vmcnt(" #n ")" ::: "memory")
#define PG8_WAIT_L(n) asm volatile("s_waitcnt lgkmcnt(" #n ")" ::: "memory")
#define PG8_BAR __builtin_amdgcn_s_barrier()
#define PG8_SCHED __builtin_amdgcn_sched_barrier(0)
#define PG8_UA(u) ((const char*)g.A + (size_t)(u).pm * tstepA + (((u).pn >= g.split_pn) ? (size_t)g.split_aoff * 2 : (size_t)0))
    Unit cur, nxt; int ui = 0;
    if (!S.next(0, cur)) return;
    f32x4 acc[2][2][4][2];
#pragma unroll
    for (int a = 0; a < 2; ++a)
#pragma unroll
        for (int b = 0; b < 2; ++b)
#pragma unroll
            for (int m = 0; m < 4; ++m)
#pragma unroll
                for (int n = 0; n < 2; ++n) acc[a][b][m][n] = (f32x4){0.f, 0.f, 0.f, 0.f};
    bf16x8 At[4][2], B0[2][2], B1[2][2];
    const char* cA = PG8_UA(cur); const char* cB = (const char*)g.Bt + (size_t)cur.pn * tstepB;
    PG8_STAGE(PG8_SB(0, 0), cB, voffB); PG8_STAGE(PG8_SB(0, 1), cB + hstepB, voffB); PG8_STAGE(PG8_SA(0, 0), cA, voffA); PG8_STAGE(PG8_SA(0, 1), cA + hstepA, voffA);
    if (wr == 1) PG8_BAR;
    PG8_WAIT_V(2); PG8_BAR;
    PG8_STAGE(PG8_SB(1, 0), cB + kstep, voffB); PG8_STAGE(PG8_SA(1, 0), cA + kstep, voffA); PG8_STAGE(PG8_SB(1, 1), cB + hstepB + kstep, voffB);
    PG8_WAIT_V(6); PG8_BAR;
    for (;;) {
        const bool has_next = S.next(ui + 1, nxt);
        const char* nA = has_next ? PG8_UA(nxt) : cA; const char* nB = has_next ? (const char*)g.Bt + (size_t)nxt.pn * tstepB : cB;
        for (int t = 0; t < nt; t += 2) {
            const bool last = (t == nt - 2);
            const char* a1 = cA + (size_t)(t + 1) * kstep;
            const char* a2 = last ? nA : cA + (size_t)(t + 2) * kstep; const char* b2 = last ? nB : cB + (size_t)(t + 2) * kstep;
            const char* a3 = a2 + kstep; const char* b3 = b2 + kstep;
            PG8_LDB(B0, 0, 0); PG8_LDB(B1, 0, 1); PG8_SCHED; PG8_LDA(At, 0, 0); PG8_STAGE(PG8_SA(1, 1), a1 + hstepA, voffA);
            PG8_WAIT_V(8); PG8_WAIT_L(0); PG8_BAR; PG8_MMA(0, 0, At, B0); PG8_MMA(0, 1, At, B1); PG8_BAR; PG8_SCHED;
            PG8_LDA(At, 0, 1); PG8_STAGE(PG8_SB(0, 0), b2, voffB); PG8_STAGE(PG8_SB(0, 1), b2 + hstepB, voffB); PG8_STAGE(PG8_SA(0, 0), a2, voffA);
            PG8_WAIT_V(8); PG8_WAIT_L(0); PG8_BAR; PG8_MMA(1, 0, At, B0); PG8_MMA(1, 1, At, B1); PG8_BAR; PG8_SCHED;
            PG8_LDB(B0, 1, 0); PG8_LDB(B1, 1, 1); PG8_SCHED; PG8_LDA(At, 1, 0); PG8_STAGE(PG8_SA(0, 1), a2 + hstepA, voffA);
            PG8_WAIT_V(8); PG8_WAIT_L(0); PG8_BAR; PG8_MMA(0, 0, At, B0); PG8_MMA(0, 1, At, B1); PG8_BAR; PG8_SCHED;
            PG8_LDA(At, 1, 1); PG8_STAGE(PG8_SB(1, 0), b3, voffB); PG8_STAGE(PG8_SB(1, 1), b3 + hstepB, voffB); PG8_STAGE(PG8_SA(1, 0), a3, voffA);
            PG8_WAIT_V(8); PG8_WAIT_L(0); PG8_BAR; PG8_MMA(1, 0, At, B0); PG8_MMA(1, 1, At, B1); PG8_BAR; PG8_SCHED;
        }
        if (wr == 0) PG8_BAR;
        E(acc, cur, wr, wc, fr, fq);
        if (!has_next) break;
#pragma unroll
        for (int a = 0; a < 2; ++a)
#pragma unroll
            for (int b = 0; b < 2; ++b)
#pragma unroll
                for (int m = 0; m < 4; ++m)
#pragma unroll
                    for (int n = 0; n < 2; ++n) acc[a][b][m][n] = (f32x4){0.f, 0.f, 0.f, 0.f};
        cur = nxt; cA = nA; cB = nB; ++ui;
        if (wr == 1) PG8_BAR;
    }
    PG8_WAIT_V(0);
    PG8_BAR;
#undef PG8_SA
#undef PG8_SB
#undef PG8_STAGE
#undef PG8_LDA
#undef PG8_LDB
#undef PG8_MMA
#undef PG8_UA
}
}

__device__ __forceinline__ float row_rs(const float* rsp, int row) {
    const f32x4* p = (const f32x4*)(rsp + (size_t)row * 16);
    f32x4 a = p[0], b = p[1], c = p[2], d = p[3];
    float s = ((a.x + a.y) + (a.z + a.w)) + ((b.x + b.y) + (b.z + b.w)) + ((c.x + c.y) + (c.z + c.w)) + ((d.x + d.y) + (d.z + d.w));
    return rsqrtf(s * (1.0f / Dm) + EPS);
}
__device__ __forceinline__ u32x4 pack8(const float* v) { u32x4 w; w.x = pk2(v[0], v[1]); w.y = pk2(v[2], v[3]); w.z = pk2(v[4], v[5]); w.w = pk2(v[6], v[7]); return w; }

struct EpiMix {
    const float* rsp; const float* cs; const float* lbF; const float* lbB;
    bf16_t *Q, *Kk, *V, *HQ, *HV, *BG; float *GF, *GB;
    __device__ __forceinline__ void operator()(const f32x4 (&acc)[2][2][4][2], const pg8::Unit& u, int wr, int wc, int fr, int fq) const {
        const int grp = u.pn >> 1;
#pragma unroll
        for (int ai = 0; ai < 2; ++ai)
#pragma unroll
            for (int m = 0; m < 4; ++m) {
                const int row = u.pm * 256 + ai * 128 + wr * 64 + m * 16 + fr;
                const float rs = row_rs(rsp, row);
                const int b = row >> 12, s = row & 4095;
#pragma unroll
                for (int bj = 0; bj < 2; ++bj) {
                    const int col = u.pn * 256 + bj * 128 + wc * 32 + fq * 8;
                    const int jj = col & 511;
                    float v[8];
#pragma unroll
                    for (int e = 0; e < 4; ++e) { v[e] = acc[ai][bj][m][0][e] * rs; v[4 + e] = acc[ai][bj][m][1][e] * rs; }
                    if (grp <= 1) {
                        const int d0 = jj & 63;
                        if (d0 < 16) {
                            const int gsel = d0 >> 3;
                            const f32x4 c4 = *(const f32x4*)(cs + (size_t)row * 16 + gsel * 4), s4 = *(const f32x4*)(cs + (size_t)row * 16 + 8 + gsel * 4);
#pragma unroll
                            for (int e = 0; e < 4; ++e) { const float t1 = v[e], t2 = v[4 + e]; v[e] = t1 * c4[e] - t2 * s4[e]; v[4 + e] = t2 * c4[e] + t1 * s4[e]; }
                        }
                        if (grp == 0) {
#pragma unroll
                            for (int e = 0; e < 8; ++e) v[e] *= 0.125f * LOG2E;
                        }
                        const int h = jj >> 7, c = (jj >> 6) & 1;
                        bf16_t* dst = (grp == 0 ? Q : Kk) + ((size_t)(((b * 4 + h) * 2 + c) * SEQ + s)) * 64 + d0;
                        *(u32x4*)dst = pack8(v);
                    } else if (grp == 2) {
                        const int h = jj >> 7, d0 = jj & 127;
                        *(u32x4*)(V + ((size_t)((b * 4 + h) * SEQ + s)) * 128 + d0) = pack8(v);
                    } else if (grp == 3) {
                        *(u32x4*)(HQ + (size_t)row * 512 + jj) = pack8(v);
                    } else if (grp == 4 || grp == 5) {
                        const float* lbp = (grp == 4 ? lbF : lbB) + jj;
                        const f32x4 l0 = *(const f32x4*)lbp, l1 = *(const f32x4*)(lbp + 4);
                        float gl[8];
#pragma unroll
                        for (int e = 0; e < 8; ++e) { const float lb = e < 4 ? l0[e] : l1[e - 4]; const float f = lb + (1.0f - lb) * sigmoidf_(v[e]); gl[e] = __logf(fmaxf(f, 1e-37f)); }
                        float* dst = (grp == 4 ? GF : GB) + (size_t)row * 512 + jj;
                        *(f32x4*)dst = (f32x4){gl[0], gl[1], gl[2], gl[3]}; *(f32x4*)(dst + 4) = (f32x4){gl[4], gl[5], gl[6], gl[7]};
                    } else if (grp == 6) {
                        *(u32x4*)(HV + (size_t)row * 512 + jj) = pack8(v);
                    } else {
#pragma unroll
                        for (int e = 0; e < 8; ++e) v[e] = sigmoidf_(v[e]);
                        *(u32x4*)(BG + (size_t)row * 512 + jj) = pack8(v);
                    }
                }
            }
    }
};

struct EpiGate {
    const float* rsp; bf16_t* G;
    __device__ __forceinline__ void operator()(const f32x4 (&acc)[2][2][4][2], const pg8::Unit& u, int wr, int wc, int fr, int fq) const {
#pragma unroll
        for (int ai = 0; ai < 2; ++ai)
#pragma unroll
            for (int m = 0; m < 4; ++m) {
                const int row = u.pm * 256 + ai * 128 + wr * 64 + m * 16 + fr;
                const float rs = row_rs(rsp, row);
#pragma unroll
                for (int bj = 0; bj < 2; ++bj) {
                    const int col = u.pn * 256 + bj * 128 + wc * 32 + fq * 8;
                    float v[8];
#pragma unroll
                    for (int e = 0; e < 4; ++e) { v[e] = sigmoidf_(acc[ai][bj][m][0][e] * rs); v[4 + e] = sigmoidf_(acc[ai][bj][m][1][e] * rs); }
                    *(u32x4*)(G + (size_t)row * 2048 + col) = pack8(v);
                }
            }
    }
};

struct EpiY {
    const bf16_t* G; bf16_t* Y;
    __device__ __forceinline__ void operator()(const f32x4 (&acc)[2][2][4][2], const pg8::Unit& u, int wr, int wc, int fr, int fq) const {
#pragma unroll
        for (int ai = 0; ai < 2; ++ai)
#pragma unroll
            for (int m = 0; m < 4; ++m) {
                const int row = u.pm * 256 + ai * 128 + wr * 64 + m * 16 + fr;
#pragma unroll
                for (int bj = 0; bj < 2; ++bj) {
                    const int col = u.pn * 256 + bj * 128 + wc * 32 + fq * 8;
                    const u32x4 gq = *(const u32x4*)(G + (size_t)row * 2048 + col);
                    float v[8];
                    v[0] = acc[ai][bj][m][0][0] * bflo(gq.x); v[1] = acc[ai][bj][m][0][1] * bfhi(gq.x);
                    v[2] = acc[ai][bj][m][0][2] * bflo(gq.y); v[3] = acc[ai][bj][m][0][3] * bfhi(gq.y);
                    v[4] = acc[ai][bj][m][1][0] * bflo(gq.z); v[5] = acc[ai][bj][m][1][1] * bfhi(gq.z);
                    v[6] = acc[ai][bj][m][1][2] * bflo(gq.w); v[7] = acc[ai][bj][m][1][3] * bfhi(gq.w);
                    *(u32x4*)(Y + (size_t)row * 2048 + col) = pack8(v);
                }
            }
    }
};

struct EpiRes {
    const float* xres; float* xout; bf16_t* XB; float* rsp;
    __device__ __forceinline__ void operator()(const f32x4 (&acc)[2][2][4][2], const pg8::Unit& u, int wr, int wc, int fr, int fq) const {
#pragma unroll
        for (int ai = 0; ai < 2; ++ai)
#pragma unroll
            for (int m = 0; m < 4; ++m) {
                const int row = u.pm * 256 + ai * 128 + wr * 64 + m * 16 + fr;
                float ss = 0.f;
#pragma unroll
                for (int bj = 0; bj < 2; ++bj) {
                    const int col = u.pn * 256 + bj * 128 + wc * 32 + fq * 8;
                    const float* xr = xres + (size_t)row * Dm + col;
                    const f32x4 x0 = *(const f32x4*)xr, x1 = *(const f32x4*)(xr + 4);
                    float v[8];
#pragma unroll
                    for (int e = 0; e < 4; ++e) { v[e] = x0[e] + acc[ai][bj][m][0][e]; v[4 + e] = x1[e] + acc[ai][bj][m][1][e]; }
#pragma unroll
                    for (int e = 0; e < 8; ++e) ss += v[e] * v[e];
                    float* xo = xout + (size_t)row * Dm + col;
                    *(f32x4*)xo = (f32x4){v[0], v[1], v[2], v[3]}; *(f32x4*)(xo + 4) = (f32x4){v[4], v[5], v[6], v[7]};
                    *(u32x4*)(XB + (size_t)row * Dm + col) = pack8(v);
                }
                ss += __shfl_xor(ss, 16); ss += __shfl_xor(ss, 32);
                if (fq == 0) rsp[(size_t)row * 16 + u.pn * 4 + wc] = ss;
            }
    }
};

struct EpiGU {
    const float* rsp; bf16_t* H;
    __device__ __forceinline__ void operator()(const f32x4 (&acc)[2][2][4][2], const pg8::Unit& u, int wr, int wc, int fr, int fq) const {
#pragma unroll
        for (int ai = 0; ai < 2; ++ai)
#pragma unroll
            for (int m = 0; m < 4; ++m) {
                const int row = u.pm * 256 + ai * 128 + wr * 64 + m * 16 + fr;
                const float rs = row_rs(rsp, row);
                const int col = u.pn * 128 + wc * 32 + fq * 8;
                float v[8];
#pragma unroll
                for (int n = 0; n < 2; ++n)
#pragma unroll
                    for (int e = 0; e < 4; ++e) { const float gg = acc[ai][0][m][n][e] * rs, uu = acc[ai][1][m][n][e] * rs; v[n * 4 + e] = gg * sigmoidf_(gg) * uu; }
                *(u32x4*)(H + (size_t)row * FF + col) = pack8(v);
            }
    }
};

__device__ __forceinline__ int rope_perm(int n) {
    const int d = n & 63; if (d >= 16) return n;
    const int g = d >> 3, e = d & 7; return (n & ~63) + ((e < 4) ? 4 * g + e : 8 + 4 * g + (e - 4));
}
__device__ __forceinline__ void conv_item(const float* src, int ld_src, int ks0, int c0  , int mode  ,
                                          const float* gain, bf16_t* dst, int ld_dst, int n0, int kd0, LAS float* scr, int lane) {
    const int nl = lane & 31;
    const int sc = mode ? rope_perm(c0 + nl) : c0 + nl;
#pragma unroll 8
    for (int i = 0; i < 32; ++i) { const int kk = 2 * i + (lane >> 5); float w = src[(size_t)(ks0 + kk) * ld_src + sc]; if (gain) w *= gain[ks0 + kk]; scr[kk * 33 + nl] = w; }
    asm volatile("s_waitcnt lgkmcnt(0)" ::: "memory");
    const int c = lane & 7;
#pragma unroll
    for (int j = 0; j < 4; ++j) { const int n = (lane >> 3) + 8 * j; const LAS float* s = scr + (8 * c) * 33 + n;
        u32x4 o; o.x = pk2(s[0 * 33], s[1 * 33]); o.y = pk2(s[2 * 33], s[3 * 33]); o.z = pk2(s[4 * 33], s[5 * 33]); o.w = pk2(s[6 * 33], s[7 * 33]);
        *(u32x4*)(dst + (size_t)(n0 + n) * ld_dst + kd0 + 8 * c) = o; }
    asm volatile("s_waitcnt lgkmcnt(0)" ::: "memory");
}

struct Ptrs {
    const float *x; const int* pos; const float *w_in, *da_lambda, *da_norm, *hg_lb, *hg_norm, *w_a, *w_b, *w_o, *attn_norm, *ffn_norm, *w_gate, *w_up, *w_down, *final_norm;
    float* out; unsigned char* ws; int ph_lo, ph_hi;
};

__device__ __forceinline__ void convert_layer(const Ptrs& P, int layer, unsigned char* wbuf, LAS unsigned char* lds, int gw, int ngw, int wave, int lane) {
    LAS float* scr = (LAS float*)(lds + wave * 8704);
    constexpr int I_IN = 16 * 192, I_A = 8 * 32, I_B = 8 * 32, I_O = 32 * 32, I_GU = 16 * 176, I_D = 44 * 32;
    constexpr int NIT = I_IN + I_A + I_B + I_O + I_GU + I_D;
    for (int it = gw; it < NIT; it += ngw) {
        int r = it;
        if (r < I_IN) { const int kb = r / 192, nb = r % 192, n0 = nb * 32;
            conv_item(P.w_in + (size_t)layer * Dm * INW, INW, kb * 64, n0, n0 < 1024 ? 1 : 0, P.attn_norm + layer * Dm, (bf16_t*)(wbuf + W_IN), Dm, n0, kb * 64, scr, lane); continue; }
        r -= I_IN;
        if (r < I_A) { const int kb = r / 32, nb = r % 32;
            conv_item(P.w_a + (size_t)layer * 512 * Dm, Dm, kb * 64, nb * 32, 0, nullptr, (bf16_t*)(wbuf + W_AB), 512, nb * 32, kb * 64, scr, lane); continue; }
        r -= I_A;
        if (r < I_B) { const int kb = r / 32, nb = r % 32;
            conv_item(P.w_b + (size_t)layer * 512 * Dm, Dm, kb * 64, nb * 32, 0, nullptr, (bf16_t*)(wbuf + W_AB), 512, 1024 + nb * 32, kb * 64, scr, lane); continue; }
        r -= I_B;
        if (r < I_O) { const int kb = r / 32, nb = r % 32;
            conv_item(P.w_o + (size_t)layer * Dm * Dm, Dm, (kb * 64) & 1023, nb * 32, 0, nullptr, (bf16_t*)(wbuf + W_O2), 2048, nb * 32, kb * 64, scr, lane); continue; }
        r -= I_O;
        if (r < I_GU) { const int kb = r / 176, nb = r % 176, n0 = nb * 32, tile = n0 >> 8, rr = n0 & 255;
            const float* srcm = (rr < 128 ? P.w_gate : P.w_up) + (size_t)layer * Dm * FF;
            conv_item(srcm, FF, kb * 64, tile * 128 + (rr & 127), 0, P.ffn_norm + layer * Dm, (bf16_t*)(wbuf + W_GU), Dm, n0, kb * 64, scr, lane); continue; }
        r -= I_GU;
        { const int kb = r / 32, nb = r % 32;
            conv_item(P.w_down + (size_t)layer * FF * Dm, Dm, kb * 64, nb * 32, 0, nullptr, (bf16_t*)(wbuf + W_D), FF, nb * 32, kb * 64, scr, lane); }
    }
}

__device__ __forceinline__ float wave_sum(float v) {
#pragma unroll
    for (int o = 1; o < 64; o <<= 1) v += __shfl_xor(v, o);
    return v;
}
__device__ __forceinline__ void prologue(const Ptrs& P, LAS unsigned char* lds, int gw, int ngw, int wave, int lane) {
    unsigned char* ws = P.ws;
    bf16_t* XB = (bf16_t*)(ws + OFF_XB); float* rsb = (float*)(ws + OFF_RSB);
    for (int r = gw; r < M; r += ngw) {
        const f32x4* xr = (const f32x4*)(P.x + (size_t)r * Dm) + lane;
        float ss = 0.f;
#pragma unroll
        for (int j = 0; j < 4; ++j) { const f32x4 v = xr[64 * j]; ss += (v.x * v.x + v.y * v.y) + (v.z * v.z + v.w * v.w);
            u32x2 o; o.x = pk2(v.x, v.y); o.y = pk2(v.z, v.w); *((u32x2*)(XB + (size_t)r * Dm) + lane + 64 * j) = o; }
        ss = wave_sum(ss);
        if (lane < 16) rsb[(size_t)r * 16 + lane] = (lane == 0) ? ss : 0.f;
    }
    const int gt = gw * 64 + lane, ngt = ngw * 64;
    float* cs = (float*)(ws + OFF_CS);
    for (int i = gt; i < M * 8; i += ngt) {
        const int tok = i >> 3, f = i & 7;
        const double invf[8] = {1.0, 0.19392274474868576, 0.03760603093086393, 0.007292664737217109, 0.001414213562373095, 0.0002742481756762073, 5.318295896944988e-05, 1.031338537721246e-05};
        double fr;
        switch (f) { case 0: fr = invf[0]; break; case 1: fr = invf[1]; break; case 2: fr = invf[2]; break; case 3: fr = invf[3]; break; case 4: fr = invf[4]; break; case 5: fr = invf[5]; break; case 6: fr = invf[6]; break; default: fr = invf[7]; }
        const float ang32 = (float)P.pos[tok] * (float)fr;
        const double ang = (double)ang32;
        const double rev = ang * 0.15915494309189535;
        const double fracrev = rev - __builtin_floor(rev + 0.5);
        const float a = (float)(fracrev * 6.283185307179586);
        cs[(size_t)tok * 16 + f] = __cosf(a); cs[(size_t)tok * 16 + 8 + f] = __sinf(a);
    }
    float* LB = (float*)(ws + OFF_LB);
    for (int i = gt; i < 2 * 512; i += ngt) {
        const int d = i >> 9, k = i & 511;
        float l[4], mx = -1e30f;
#pragma unroll
        for (int j = 0; j < 4; ++j) { l[j] = P.hg_lb[(size_t)(d * 4 + j) * 512 + k]; mx = fmaxf(mx, l[j]); }
        float e[4], sum = 0.f;
#pragma unroll
        for (int j = 0; j < 4; ++j) { e[j] = __expf(l[j] - mx); sum += e[j]; }
        float cum = 0.f;
#pragma unroll
        for (int j = 0; j < 4; ++j) { if (j > 0) cum += e[j] / sum; LB[(size_t)(d * 4 + j) * 512 + k] = cum; }
    }
    if (gw == 0) {
        float* LAM = (float*)(ws + OFF_LAM);
        for (int l = 0; l < 4; ++l) {
            const float* p = P.da_lambda + l * 256;
            float a = wave_sum(p[lane] * p[64 + lane]), b = wave_sum(p[128 + lane] * p[192 + lane]);
            const float lam_init = 0.8f - 0.6f * __expf(-0.3f * (float)l);
            if (lane == 0) LAM[l] = __expf(a) - __expf(b) + lam_init;
        }
    }
}

constexpr int AT_KROW = 144, AT_VROW = 320, AT_K1 = 64 * AT_KROW, AT_V = 2 * AT_K1, AT_STG = AT_V + 64 * AT_VROW;
constexpr int AT_IMG_ROW = 132;
__device__ __forceinline__ s16x4 tr_read(const LAS unsigned char* p) { return __builtin_bit_cast(s16x4, __builtin_amdgcn_ds_read_tr16_b64_v4i16((LAS s16x4*)p)); }

__device__ __forceinline__ void attn_unit(int b, int h, int qb, const bf16_t* Q, const bf16_t* Kk, const bf16_t* V, bf16_t* AO, const float* gainA  , float one_minus_lam_init, float lam, LAS unsigned char* lds) {
    int tid_ = threadIdx.x; asm volatile("" : "+v"(tid_));
    const int tid = tid_, wave = __builtin_amdgcn_readfirstlane(tid >> 6), lane = tid & 63, c = wave >> 2, wq = wave & 3, r32 = lane & 31, hh = lane >> 5;
    const int q0 = qb * 128 + wq * 32;
    bf16x8 qf[4];
    { const bf16_t* Qp = Q + ((size_t)(((b * 4 + h) * 2 + c) * SEQ + q0 + r32)) * 64 + 8 * hh;
#pragma unroll
      for (int s = 0; s < 4; ++s) qf[s] = *(const bf16x8*)(Qp + 16 * s); }
    f32x16 o[4];
#pragma unroll
    for (int i = 0; i < 4; ++i)
#pragma unroll
        for (int e = 0; e < 16; ++e) o[i][e] = 0.f;
    float mrow = -1e30f, lrow = 0.f;
    const unsigned char* Kg0 = (const unsigned char*)(Kk + ((size_t)((b * 4 + h) * 2 + 0) * SEQ) * 64);
    const unsigned char* Kg1 = (const unsigned char*)(Kk + ((size_t)((b * 4 + h) * 2 + 1) * SEQ) * 64);
    const unsigned char* Vg = (const unsigned char*)(V + ((size_t)(b * 4 + h) * SEQ) * 128);
    const int lk = (tid >> 3) * AT_KROW + (tid & 7) * 16;
    const int lv0 = AT_V + (tid >> 4) * AT_VROW + (tid & 15) * 16, lv1 = lv0 + 32 * AT_VROW;
    u32x4 r0, r1, r2, r3;
    r0 = *(const u32x4*)(Kg0 + tid * 16); r1 = *(const u32x4*)(Kg1 + tid * 16); r2 = *(const u32x4*)(Vg + tid * 16); r3 = *(const u32x4*)(Vg + 8192 + tid * 16);
    *(LAS u32x4*)(lds + lk) = r0; *(LAS u32x4*)(lds + AT_K1 + lk) = r1; *(LAS u32x4*)(lds + lv0) = r2; *(LAS u32x4*)(lds + lv1) = r3;
    __syncthreads();
    const int ka = c * AT_K1 + r32 * AT_KROW + hh * 16;
    const int va = AT_V + (4 * hh + ((lane & 15) >> 2)) * AT_VROW + ((lane >> 4) & 1) * 32 + (lane & 3) * 8;
    for (int j = 0; j < 64; ++j) {
        const int st = (j & 1) * AT_STG;
        if (j + 1 < 64) {
            const size_t go = (size_t)(j + 1) * 8192;
            r0 = *(const u32x4*)(Kg0 + go + tid * 16); r1 = *(const u32x4*)(Kg1 + go + tid * 16);
            r2 = *(const u32x4*)(Vg + 2 * go + tid * 16); r3 = *(const u32x4*)(Vg + 2 * go + 8192 + tid * 16);
        }
        f32x16 s0, s1;
#pragma unroll
        for (int e = 0; e < 16; ++e) { s0[e] = 0.f; s1[e] = 0.f; }
#pragma unroll
        for (int ks = 0; ks < 4; ++ks) {
            const bf16x8 a0 = *(const LAS bf16x8*)(lds + st + ka + ks * 32), a1 = *(const LAS bf16x8*)(lds + st + ka + 32 * AT_KROW + ks * 32);
            s0 = __builtin_amdgcn_mfma_f32_32x32x16_bf16(a0, qf[ks], s0, 0, 0, 0);
            s1 = __builtin_amdgcn_mfma_f32_32x32x16_bf16(a1, qf[ks], s1, 0, 0, 0);
        }
        float mx = s0[0];
#pragma unroll
        for (int e = 1; e < 16; ++e) mx = fmaxf(mx, s0[e]);
#pragma unroll
        for (int e = 0; e < 16; ++e) mx = fmaxf(mx, s1[e]);
        mx = fmaxf(mx, __shfl_xor(mx, 32));
        const float mnew = fmaxf(mrow, mx), alpha = exp2f(mrow - mnew);
        mrow = mnew;
        float ls = 0.f;
#pragma unroll
        for (int e = 0; e < 16; ++e) { s0[e] = exp2f(s0[e] - mnew); s1[e] = exp2f(s1[e] - mnew); ls += s0[e] + s1[e]; }
        lrow = lrow * alpha + ls;
#pragma unroll
        for (int i = 0; i < 4; ++i)
#pragma unroll
            for (int e = 0; e < 16; ++e) o[i][e] *= alpha;
        bf16x8 pf[2][2];
#pragma unroll
        for (int s = 0; s < 2; ++s) {
            u32x4 w0, w1;
            w0.x = pk2(s0[8 * s + 0], s0[8 * s + 1]); w0.y = pk2(s0[8 * s + 2], s0[8 * s + 3]); w0.z = pk2(s0[8 * s + 4], s0[8 * s + 5]); w0.w = pk2(s0[8 * s + 6], s0[8 * s + 7]);
            w1.x = pk2(s1[8 * s + 0], s1[8 * s + 1]); w1.y = pk2(s1[8 * s + 2], s1[8 * s + 3]); w1.z = pk2(s1[8 * s + 4], s1[8 * s + 5]); w1.w = pk2(s1[8 * s + 6], s1[8 * s + 7]);
            pf[0][s] = __builtin_bit_cast(bf16x8, w0); pf[1][s] = __builtin_bit_cast(bf16x8, w1);
        }
#pragma unroll
        for (int kb = 0; kb < 2; ++kb)
#pragma unroll
            for (int s = 0; s < 2; ++s) {
                const LAS unsigned char* vb = lds + st + va + (32 * kb + 16 * s) * AT_VROW;
#pragma unroll
                for (int vt = 0; vt < 4; ++vt) {
                    const s16x4 t0 = tr_read(vb + vt * 64), t1 = tr_read(vb + vt * 64 + 8 * AT_VROW);
                    const bf16x8 av = {t0[0], t0[1], t0[2], t0[3], t1[0], t1[1], t1[2], t1[3]};
                    o[vt] = __builtin_amdgcn_mfma_f32_32x32x16_bf16(av, pf[kb][s], o[vt], 0, 0, 0);
                }
            }
        if (j + 1 < 64) {
            const int sn = ((j + 1) & 1) * AT_STG;
            *(LAS u32x4*)(lds + sn + lk) = r0; *(LAS u32x4*)(lds + sn + AT_K1 + lk) = r1; *(LAS u32x4*)(lds + sn + lv0) = r2; *(LAS u32x4*)(lds + sn + lv1) = r3;
        }
        __syncthreads();
    }
    const float inv = 1.0f / (lrow + __shfl_xor(lrow, 32));
    LAS float* img = (LAS float*)lds;
    const int qrow = wq * 32 + r32;
    if (c == 1) {
        const float sc = -lam * inv;
#pragma unroll
        for (int vt = 0; vt < 4; ++vt)
#pragma unroll
            for (int g = 0; g < 4; ++g)
                *(LAS f32x4*)(img + qrow * AT_IMG_ROW + 32 * vt + 8 * g + 4 * hh) = (f32x4){o[vt][4 * g] * sc, o[vt][4 * g + 1] * sc, o[vt][4 * g + 2] * sc, o[vt][4 * g + 3] * sc};
    }
    __syncthreads();
    if (c == 0) {
#pragma unroll
        for (int vt = 0; vt < 4; ++vt)
#pragma unroll
            for (int g = 0; g < 4; ++g) {
                LAS f32x4* p = (LAS f32x4*)(img + qrow * AT_IMG_ROW + 32 * vt + 8 * g + 4 * hh);
                f32x4 t = *p;
                t.x += o[vt][4 * g] * inv; t.y += o[vt][4 * g + 1] * inv; t.z += o[vt][4 * g + 2] * inv; t.w += o[vt][4 * g + 3] * inv;
                *p = t;
            }
    }
    __syncthreads();
    {
        const int q = tid >> 2, part = tid & 3;
        float v[32]; float ss = 0.f;
#pragma unroll
        for (int i = 0; i < 8; ++i) { const f32x4 t = *(const LAS f32x4*)(img + q * AT_IMG_ROW + 32 * part + 4 * i); v[4 * i] = t.x; v[4 * i + 1] = t.y; v[4 * i + 2] = t.z; v[4 * i + 3] = t.w;
            ss += (t.x * t.x + t.y * t.y) + (t.z * t.z + t.w * t.w); }
        ss += __shfl_xor(ss, 1); ss += __shfl_xor(ss, 2);
        const float rs = rsqrtf(ss * (1.0f / 128.0f) + EPS) * one_minus_lam_init;
        const float* gp = gainA + h * 128 + 32 * part;
        bf16_t* dst = AO + ((size_t)(b * SEQ + qb * 128 + q)) * 1024 + h * 128 + 32 * part;
#pragma unroll
        for (int i = 0; i < 4; ++i) {
            const f32x4 g0 = *(const f32x4*)(gp + 8 * i), g1 = *(const f32x4*)(gp + 8 * i + 4);
            u32x4 w; w.x = pk2(v[8 * i] * rs * g0.x, v[8 * i + 1] * rs * g0.y); w.y = pk2(v[8 * i + 2] * rs * g0.z, v[8 * i + 3] * rs * g0.w);
            w.z = pk2(v[8 * i + 4] * rs * g1.x, v[8 * i + 5] * rs * g1.y); w.w = pk2(v[8 * i + 6] * rs * g1.z, v[8 * i + 7] * rs * g1.w);
            *(u32x4*)(dst + 8 * i) = w;
        }
    }
    __syncthreads();
}

constexpr int HG_SEG = 0;
constexpr int HG_F = 2048;
constexpr int HG_PART = 2560;
constexpr int HG_V = 4096;
constexpr int HG_VROW = 288;
constexpr int HG_A = HG_V + 64 * HG_VROW;
constexpr int HG_KTROW = 144, HG_QKROW = 272;
constexpr int HG_Bq = HG_A + 128 * HG_KTROW;

__device__ __forceinline__ void hg_cumsum(const float* G, int tok0, int h, int dir, int k, int j, LAS unsigned char* lds, float (&gv)[16], float (&d)[16], float& m_out, float& tot_out) {
    const float* gp = G + (size_t)(tok0 + 16 * j) * 512 + h * 128 + k;
#pragma unroll
    for (int i = 0; i < 16; ++i) gv[i] = gp[(size_t)i * 512];
    float run = 0.f;
    if (dir == 0) {
#pragma unroll
        for (int i = 0; i < 16; ++i) { run += gv[i]; d[i] = run; }
    } else {
#pragma unroll
        for (int i = 15; i >= 0; --i) { run += gv[i]; d[i] = run; }
    }
    LAS float* seg = (LAS float*)(lds + HG_SEG);
    seg[j * 128 + k] = run;
    __syncthreads();
    const float s0 = seg[k], s1 = seg[128 + k], s2 = seg[256 + k], s3 = seg[384 + k];
    float off, m;
    if (dir == 0) { off = (j > 0 ? s0 : 0.f) + (j > 1 ? s1 : 0.f) + (j > 2 ? s2 : 0.f); m = s0 + s1; }
    else { off = (j < 3 ? s3 : 0.f) + (j < 2 ? s2 : 0.f) + (j < 1 ? s1 : 0.f); m = s2 + s3; }
#pragma unroll
    for (int i = 0; i < 16; ++i) d[i] = d[i] + off - m;
    m_out = m; tot_out = (s0 + s1) + (s2 + s3);
}

__device__ __forceinline__ void hg_load_v(const bf16_t* HV, int tok0, int h, LAS unsigned char* lds, int tid) {
#pragma unroll
    for (int i = 0; i < 2; ++i) { const int ch = tid + 512 * i, p = ch >> 4, part = ch & 15;
        *(LAS u32x4*)(lds + HG_V + p * HG_VROW + part * 16) = *(const u32x4*)(HV + (size_t)(tok0 + p) * 512 + h * 128 + part * 8); }
}

__device__ __forceinline__ void hg1_unit(int u, const float* GF, const float* GB, const bf16_t* HV, bf16_t* UT, float* Dg, float* Eg, LAS unsigned char* lds) {
    int tid_ = threadIdx.x; asm volatile("" : "+v"(tid_));
    const int tid = tid_, wave = __builtin_amdgcn_readfirstlane(tid >> 6), lane = tid & 63;
    const int dir = u & 1, cch = (u >> 1) & 63, bh = u >> 7, b = bh >> 2, h = bh & 3;
    const int tok0 = b * SEQ + cch * 64, k = tid & 127, j = tid >> 7;
    float gv[16], d[16], m, tot;
    hg_cumsum(dir ? GB : GF, tok0, h, dir, k, j, lds, gv, d, m, tot);
    hg_load_v(HV, tok0, h, lds, tid);
    float kt[16];
#pragma unroll
    for (int i = 0; i < 16; ++i) kt[i] = (1.0f - __expf(gv[i])) * __expf(fminf(-d[i], 40.f));
    { u32x4 w0, w1;
      w0.x = pk2(kt[0], kt[1]); w0.y = pk2(kt[2], kt[3]); w0.z = pk2(kt[4], kt[5]); w0.w = pk2(kt[6], kt[7]);
      w1.x = pk2(kt[8], kt[9]); w1.y = pk2(kt[10], kt[11]); w1.z = pk2(kt[12], kt[13]); w1.w = pk2(kt[14], kt[15]);
      *(LAS u32x4*)(lds + HG_A + k * HG_KTROW + j * 32) = w0; *(LAS u32x4*)(lds + HG_A + k * HG_KTROW + j * 32 + 16) = w1; }
    if (j == 0) { ((LAS float*)(lds + HG_F))[k] = __expf(tot - m); Dg[(size_t)u * 128 + k] = __expf(tot); Eg[(size_t)u * 128 + k] = __expf(m); }
    __syncthreads();
    const int i16 = lane & 15, g4 = lane >> 4;
    bf16x8 af[2];
#pragma unroll
    for (int s = 0; s < 2; ++s) {
        const LAS unsigned char* ap = lds + HG_A + (16 * wave + i16) * HG_KTROW + (32 * s + 4 * g4) * 2;
        const u32x2 lo = *(const LAS u32x2*)ap, hi = *(const LAS u32x2*)(ap + 32);
        af[s] = __builtin_bit_cast(bf16x8, (u32x4){lo.x, lo.y, hi.x, hi.y});
    }
    const f32x4 fsc = *(const LAS f32x4*)(lds + HG_F + (16 * wave + 4 * g4) * 4);
    const LAS unsigned char* vbase = lds + HG_V + (4 * g4 + (i16 >> 2)) * HG_VROW + (i16 & 3) * 8;
#pragma unroll
    for (int vt = 0; vt < 8; ++vt) {
        f32x4 acc = {0.f, 0.f, 0.f, 0.f};
#pragma unroll
        for (int s = 0; s < 2; ++s) {
            const s16x4 t0 = tr_read(vbase + (32 * s) * HG_VROW + vt * 32), t1 = tr_read(vbase + (32 * s + 16) * HG_VROW + vt * 32);
            const bf16x8 bv = {t0[0], t0[1], t0[2], t0[3], t1[0], t1[1], t1[2], t1[3]};
            acc = __builtin_amdgcn_mfma_f32_16x16x32_bf16(af[s], bv, acc, 0, 0, 0);
        }
        u32x2 w; w.x = pk2(acc[0] * fsc[0], acc[1] * fsc[1]); w.y = pk2(acc[2] * fsc[2], acc[3] * fsc[3]);
        *(u32x2*)(UT + ((size_t)u * 128 + 16 * vt + i16) * 128 + 16 * wave + 4 * g4) = w;
    }
    __syncthreads();
}

__device__ __forceinline__ void hg2_scan(bf16_t* UT, const float* Dg, const float* Eg, int gthread, int nthreads) {
    for (int idx = gthread; idx < 32 * 4096; idx += nthreads) {
        const int chain = idx >> 12, e4 = idx & 4095, v = e4 >> 5, k0 = (e4 & 31) * 4;
        const int dir = chain & 1, bh = chain >> 1;
        float S0 = 0.f, S1 = 0.f, S2 = 0.f, S3 = 0.f;
        int u = (bh * 64 + (dir ? 63 : 0)) * 2 + dir;
        const int ustep = dir ? -2 : 2;
        u32x2 uu = *(const u32x2*)(UT + ((size_t)u * 128 + v) * 128 + k0);
        f32x4 dd = *(const f32x4*)(Dg + (size_t)u * 128 + k0), ee = *(const f32x4*)(Eg + (size_t)u * 128 + k0);
        for (int cc = 0; cc < 64; ++cc) {
            u32x2 un = uu; f32x4 dn = dd, en = ee;
            const int u2 = u + ustep;
            if (cc + 1 < 64) { un = *(const u32x2*)(UT + ((size_t)u2 * 128 + v) * 128 + k0); dn = *(const f32x4*)(Dg + (size_t)u2 * 128 + k0); en = *(const f32x4*)(Eg + (size_t)u2 * 128 + k0); }
            u32x2 w; w.x = pk2(ee.x * S0, ee.y * S1); w.y = pk2(ee.z * S2, ee.w * S3);
            *(u32x2*)(UT + ((size_t)u * 128 + v) * 128 + k0) = w;
            S0 = dd.x * S0 + bflo(uu.x); S1 = dd.y * S1 + bfhi(uu.x); S2 = dd.z * S2 + bflo(uu.y); S3 = dd.w * S3 + bfhi(uu.y);
            uu = un; dd = dn; ee = en; u = u2;
        }
    }
}

__device__ __forceinline__ void hg3_unit(int u3, const float* GF, const float* GB, const bf16_t* HQ, const bf16_t* HV, const bf16_t* ST, const bf16_t* BG, const float* gainH, bf16_t* AO, LAS unsigned char* lds) {
    int tid_ = threadIdx.x; asm volatile("" : "+v"(tid_));
    const int tid = tid_, wave = __builtin_amdgcn_readfirstlane(tid >> 6), lane = tid & 63;
    const int cch = u3 & 63, bh = u3 >> 6, b = bh >> 2, h = bh & 3;
    const int tok0 = b * SEQ + cch * 64, k = tid & 127, j = tid >> 7;
    const int tb = wave & 3, vh = wave >> 2, i16 = lane & 15, g4 = lane >> 4;
    f32x4 oacc[4];
#pragma unroll
    for (int i = 0; i < 4; ++i) oacc[i] = (f32x4){0.f, 0.f, 0.f, 0.f};
    hg_load_v(HV, tok0, h, lds, tid);
    for (int dir = 0; dir < 2; ++dir) {
        float gv[16], d[16], m, tot;
        hg_cumsum(dir ? GB : GF, tok0, h, dir, k, j, lds, gv, d, m, tot);
        const bf16_t* qp = HQ + (size_t)(tok0 + 16 * j) * 512 + h * 128 + k;
#pragma unroll
        for (int i = 0; i < 16; ++i) {
            const float kt = (1.0f - __expf(gv[i])) * __expf(fminf(-d[i], 40.f));
            const float qt = bf2f(qp[(size_t)i * 512]) * __expf(fminf(d[i], 40.f));
            *(LAS unsigned short*)(lds + HG_A + (16 * j + i) * HG_QKROW + k * 2) = (unsigned short)f2bf(kt);
            *(LAS unsigned short*)(lds + HG_Bq + (16 * j + i) * HG_QKROW + k * 2) = (unsigned short)f2bf(qt);
        }
        __syncthreads();
        f32x4 pt[4];
#pragma unroll
        for (int sg = 0; sg < 4; ++sg) pt[sg] = (f32x4){0.f, 0.f, 0.f, 0.f};
        bf16x8 qa[4];
#pragma unroll
        for (int ks = 0; ks < 4; ++ks) qa[ks] = *(const LAS bf16x8*)(lds + HG_Bq + (16 * tb + i16) * HG_QKROW + (32 * ks + 8 * g4) * 2);
#pragma unroll
        for (int sg = 0; sg < 4; ++sg)
#pragma unroll
            for (int ks = 0; ks < 4; ++ks) {
                const bf16x8 ka = *(const LAS bf16x8*)(lds + HG_A + (16 * sg + i16) * HG_QKROW + (32 * ks + 8 * g4) * 2);
                pt[sg] = __builtin_amdgcn_mfma_f32_16x16x32_bf16(ka, qa[ks], pt[sg], 0, 0, 0);
            }
        const int tcol = 16 * tb + i16;
#pragma unroll
        for (int sg = 0; sg < 4; ++sg)
#pragma unroll
            for (int e = 0; e < 4; ++e) { const int srow = 16 * sg + 4 * g4 + e; const bool keep = dir ? (srow >= tcol) : (srow <= tcol); pt[sg][e] = keep ? pt[sg][e] : 0.f; }
        bf16x8 pa[2];
#pragma unroll
        for (int s2 = 0; s2 < 2; ++s2) {
            u32x4 w; w.x = pk2(pt[2 * s2][0], pt[2 * s2][1]); w.y = pk2(pt[2 * s2][2], pt[2 * s2][3]); w.z = pk2(pt[2 * s2 + 1][0], pt[2 * s2 + 1][1]); w.w = pk2(pt[2 * s2 + 1][2], pt[2 * s2 + 1][3]);
            pa[s2] = __builtin_bit_cast(bf16x8, w);
        }
        const LAS unsigned char* vbase = lds + HG_V + (4 * g4 + (i16 >> 2)) * HG_VROW + (i16 & 3) * 8;
        const bf16_t* stp = ST + ((size_t)((bh * 64 + cch) * 2 + dir) * 128) * 128;
#pragma unroll
        for (int vv = 0; vv < 4; ++vv) {
            const int vt = 4 * vh + vv;
#pragma unroll
            for (int s2 = 0; s2 < 2; ++s2) {
                const s16x4 t0 = tr_read(vbase + (32 * s2) * HG_VROW + vt * 32), t1 = tr_read(vbase + (32 * s2 + 16) * HG_VROW + vt * 32);
                const bf16x8 bv = {t0[0], t0[1], t0[2], t0[3], t1[0], t1[1], t1[2], t1[3]};
                oacc[vv] = __builtin_amdgcn_mfma_f32_16x16x32_bf16(pa[s2], bv, oacc[vv], 0, 0, 0);
            }
#pragma unroll
            for (int ks = 0; ks < 4; ++ks) {
                const bf16x8 sb = *(const bf16x8*)(stp + (size_t)(16 * vt + i16) * 128 + 32 * ks + 8 * g4);
                oacc[vv] = __builtin_amdgcn_mfma_f32_16x16x32_bf16(qa[ks], sb, oacc[vv], 0, 0, 0);
            }
        }
        __syncthreads();
    }
    float ssq[4];
#pragma unroll
    for (int e = 0; e < 4; ++e) { float s = 0.f;
#pragma unroll
        for (int vv = 0; vv < 4; ++vv) s += oacc[vv][e] * oacc[vv][e];
        s += __shfl_xor(s, 1); s += __shfl_xor(s, 2); s += __shfl_xor(s, 4); s += __shfl_xor(s, 8); ssq[e] = s; }
    LAS float* part = (LAS float*)(lds + HG_PART);
    if (i16 == 0) {
#pragma unroll
        for (int e = 0; e < 4; ++e) part[vh * 64 + 16 * tb + 4 * g4 + e] = ssq[e];
    }
    __syncthreads();
#pragma unroll
    for (int e = 0; e < 4; ++e) {
        const int t = 16 * tb + 4 * g4 + e;
        const float rs = rsqrtf((part[t] + part[64 + t]) * (1.0f / 128.0f) + EPS);
#pragma unroll
        for (int vv = 0; vv < 4; ++vv) {
            const int v = 16 * (4 * vh + vv) + i16;
            const float gate = bf2f(BG[(size_t)(tok0 + t) * 512 + h * 128 + v]);
            AO[(size_t)(tok0 + t) * 1024 + 512 + h * 128 + v] = (bf16_t)f2bf(oacc[vv][e] * rs * gainH[h * 128 + v] * gate);
        }
    }
    __syncthreads();
}

__global__ void __launch_bounds__(512, 2) fwd_kernel(Ptrs P) {
    extern __shared__ __attribute__((aligned(16))) unsigned char lds_raw[];
    LAS unsigned char* lds = (LAS unsigned char*)lds_raw;
    cg::grid_group grid = cg::this_grid();
    const int G = gridDim.x, bx = blockIdx.x;
    const int lo = P.ph_lo, hi = P.ph_hi;
    int ph = 0;
#ifndef PH_MASK
#define PH_MASK 0xFFFFFFFFu
#endif
#define ON(id) constexpr (((PH_MASK) >> (id)) & 1u)
#define PHASE_BEGIN if (ph >= lo && ph < hi) { unsigned char* ws = P.ws; asm volatile("" : "+s"(ws)); int tid = threadIdx.x; asm volatile("" : "+v"(tid)); \
    const int lane = tid & 63, wave = __builtin_amdgcn_readfirstlane(tid >> 6), gw = bx * 8 + wave, ngw = G * 8; (void)lane; (void)gw; (void)ngw;
#define XB ((bf16_t*)(ws + OFF_XB))
#define RSA ((float*)(ws + OFF_RSA))
#define RSB ((float*)(ws + OFF_RSB))
#define CS ((const float*)(ws + OFF_CS))
#define LB ((const float*)(ws + OFF_LB))
#define LAM ((const float*)(ws + OFF_LAM))
#define Dg ((float*)(ws + OFF_DG))
#define Eg ((float*)(ws + OFF_EG))
#define GATE ((bf16_t*)(ws + OFF_GATE))
#define Qb ((bf16_t*)(ws + OFF_Q))
#define Kb ((bf16_t*)(ws + OFF_K))
#define Vb ((bf16_t*)(ws + OFF_V))
#define HQ ((bf16_t*)(ws + OFF_HQ))
#define HV ((bf16_t*)(ws + OFF_HV))
#define GF ((float*)(ws + OFF_GF))
#define GB ((float*)(ws + OFF_GB))
#define Yb ((bf16_t*)(ws + OFF_Y))
#define BG ((bf16_t*)(ws + OFF_BG))
#define AO ((bf16_t*)(ws + OFF_AO))
#define UT ((bf16_t*)(ws + OFF_UT))
#define Hb ((bf16_t*)(ws + OFF_H))
#define PHASE_END   if (ph + 1 < hi) grid.sync(); } ++ph;

    PHASE_BEGIN
        if ON(0) prologue(P, lds, gw, ngw, wave, lane);
        if ON(6) convert_layer(P, 0, ws, lds, gw, ngw, wave, lane);
    PHASE_END

    for (int layer = 0; layer < DEPTH; ++layer) {
        PHASE_BEGIN
            pg8::Gemm g{XB, (const bf16_t*)(ws + (size_t)(layer & 1) * WSZ + W_IN), Dm, Dm, Dm, 1 << 30, 0};
            pg8::StaticOrder S; S.init(M, 4096, G, bx);
            EpiMix E{RSB, CS, LB + (0 * 4 + layer) * 512, LB + (1 * 4 + layer) * 512, Qb, Kb, Vb, HQ, HV, BG, GF, GB};
            if ON(1) pg8::gemm_phase(lds, g, S, E);
        PHASE_END
        PHASE_BEGIN
            const float lam_init = 0.8f - 0.6f * __expf(-0.3f * (float)layer);
            const float lam = LAM[layer];
            if ON(2) for (int i = 0; i * G + bx < 512; ++i) {
                const int uid = i * G + bx; const int round = uid >> 8, r = uid & 255;
                const int bhh = round * 8 + (r & 7), qb = r >> 3;
                attn_unit(bhh >> 2, bhh & 3, qb, Qb, Kb, Vb, AO, P.da_norm + layer * 512, 1.0f - lam_init, lam, lds);
            }
            if ON(3) for (int u = bx; u < 2048; u += G) hg1_unit(u, GF, GB, HV, UT, Dg, Eg, lds);
        PHASE_END
        PHASE_BEGIN
            {
                pg8::Gemm g{XB, (const bf16_t*)(ws + (size_t)(layer & 1) * WSZ + W_IN) + (size_t)4096 * Dm, Dm, Dm, Dm, 1 << 30, 0};
                pg8::StaticOrder S; S.init(M, 2048, G, bx);
                EpiGate E{RSB, GATE};
                if ON(4) pg8::gemm_phase(lds, g, S, E);
            }
            if ON(5) hg2_scan(UT, Dg, Eg, bx * 512 + tid, G * 512);
            if ON(6) if (layer + 1 < DEPTH) convert_layer(P, layer + 1, ws + (size_t)((layer + 1) & 1) * WSZ, lds, gw, ngw, wave, lane);
        PHASE_END
        PHASE_BEGIN
            if ON(7) for (int u = bx; u < 1024; u += G) hg3_unit(u, GF, GB, HQ, HV, UT, BG, P.hg_norm + layer * 512, AO, lds);
        PHASE_END
        PHASE_BEGIN
            pg8::Gemm g{AO, (const bf16_t*)(ws + (size_t)(layer & 1) * WSZ + W_AB), 1024, 512, 512, 4, 512};
            pg8::StaticOrder S; S.init(M, 2048, G, bx);
            EpiY E{GATE, Yb};
            if ON(8) pg8::gemm_phase(lds, g, S, E);
        PHASE_END
        PHASE_BEGIN
            pg8::Gemm g{Yb, (const bf16_t*)(ws + (size_t)(layer & 1) * WSZ + W_O2), 2048, 2048, 2048, 1 << 30, 0};
            pg8::StaticOrder S; S.init(M, Dm, G, bx);
            EpiRes E{layer == 0 ? P.x : P.out, P.out, XB, RSA};
            if ON(9) pg8::gemm_phase(lds, g, S, E);
        PHASE_END
        PHASE_BEGIN
            pg8::Gemm g{XB, (const bf16_t*)(ws + (size_t)(layer & 1) * WSZ + W_GU), Dm, Dm, Dm, 1 << 30, 0};
            pg8::StaticOrder S; S.init(M, 2 * FF, G, bx);
            EpiGU E{RSA, Hb};
            if ON(10) pg8::gemm_phase(lds, g, S, E);
        PHASE_END
        PHASE_BEGIN
            pg8::Gemm g{Hb, (const bf16_t*)(ws + (size_t)(layer & 1) * WSZ + W_D), FF, FF, FF, 1 << 30, 0};
            pg8::StaticOrder S; S.init(M, Dm, G, bx);
            EpiRes E{P.out, P.out, XB, RSB};
            if ON(11) pg8::gemm_phase(lds, g, S, E);
        PHASE_END
    }
    PHASE_BEGIN
        if ON(12) for (int r = gw; r < M; r += ngw) {
            f32x4* xr = (f32x4*)(P.out + (size_t)r * Dm) + lane;
            f32x4 v[4]; float ss = 0.f;
#pragma unroll
            for (int j = 0; j < 4; ++j) { v[j] = xr[64 * j]; ss += (v[j].x * v[j].x + v[j].y * v[j].y) + (v[j].z * v[j].z + v[j].w * v[j].w); }
            const float rs = rsqrtf(wave_sum(ss) * (1.0f / Dm) + EPS);
#pragma unroll
            for (int j = 0; j < 4; ++j) { const f32x4 gn = *((const f32x4*)P.final_norm + lane + 64 * j); xr[64 * j] = (f32x4){v[j].x * rs * gn.x, v[j].y * rs * gn.y, v[j].z * rs * gn.z, v[j].w * rs * gn.w}; }
        }
    PHASE_END
}
constexpr int NPHASES = 2 + 8 * DEPTH;

#ifndef MK_PER_PHASE
#define MK_PER_PHASE 0
#endif

extern "C" void kernel_launch(void* const* d_in, const int* in_sizes, int n_in, void* d_out, int out_size, void* d_ws, size_t ws_size, hipStream_t stream) {
    static int grid = 0;
    if (grid == 0) {
        if (n_in != 16 || out_size != M * Dm || ws_size < WS_END) { fprintf(stderr, "kernel_launch: unexpected sizes (n_in %d, out %d, ws %zu, need %zu)\n", n_in, out_size, ws_size, (size_t)WS_END); grid = -1; return; }
        int dev = 0, cus = 0, per_cu = 0;
        (void)hipGetDevice(&dev);
        (void)hipDeviceGetAttribute(&cus, hipDeviceAttributeMultiprocessorCount, dev);
        if (hipFuncSetAttribute((const void*)fwd_kernel, hipFuncAttributeMaxDynamicSharedMemorySize, LDS_BYTES) != hipSuccess) { fprintf(stderr, "kernel_launch: hipFuncSetAttribute failed\n"); grid = -1; return; }
        (void)hipOccupancyMaxActiveBlocksPerMultiprocessor(&per_cu, (const void*)fwd_kernel, 512, LDS_BYTES);
        (void)hipGetLastError();
        if (per_cu < 1) per_cu = 1;
        grid = cus * 1;
        fprintf(stderr, "kernel_launch: grid %d (per_cu %d), ws %zu need %zu\n", grid, per_cu, ws_size, (size_t)WS_END);
    }
    if (grid < 0) return;
    Ptrs p{};
    p.x = (const float*)d_in[0]; p.pos = (const int*)d_in[1]; p.w_in = (const float*)d_in[2]; p.da_lambda = (const float*)d_in[3]; p.da_norm = (const float*)d_in[4];
    p.hg_lb = (const float*)d_in[5]; p.hg_norm = (const float*)d_in[6]; p.w_a = (const float*)d_in[7]; p.w_b = (const float*)d_in[8]; p.w_o = (const float*)d_in[9];
    p.attn_norm = (const float*)d_in[10]; p.ffn_norm = (const float*)d_in[11]; p.w_gate = (const float*)d_in[12]; p.w_up = (const float*)d_in[13]; p.w_down = (const float*)d_in[14];
    p.final_norm = (const float*)d_in[15];
    p.out = (float*)d_out; p.ws = (unsigned char*)d_ws;
#if MK_PER_PHASE
    for (int ph = 0; ph < NPHASES; ++ph) {
        p.ph_lo = ph; p.ph_hi = ph + 1;
        hipLaunchKernelGGL(fwd_kernel, dim3(grid), dim3(512), LDS_BYTES, stream, p);
    }
#else
    p.ph_lo = 0; p.ph_hi = NPHASES;
    void* args[] = {&p};
    hipError_t e = hipLaunchCooperativeKernel((const void*)fwd_kernel, dim3(grid), dim3(512), args, LDS_BYTES, stream);
    if (e != hipSuccess) fprintf(stderr, "cooperative launch failed: %s (grid %d)\n", hipGetErrorString(e), grid);
#endif
}
```

```cpp
#include <hip/hip_runtime.h>
#include <hip/hip_cooperative_groups.h>
#include <cstdio>
#include <cstdint>
namespace cg = cooperative_groups;

#define LAS __attribute__((address_space(3)))
typedef unsigned short bf16_t;
typedef short bf16x8 __attribute__((ext_vector_type(8)));
typedef short s16x4 __attribute__((ext_vector_type(4)));
typedef float f32x4 __attribute__((ext_vector_type(4)));
typedef float f32x16 __attribute__((ext_vector_type(16)));
typedef unsigned u32x4 __attribute__((ext_vector_type(4)));
typedef unsigned u32x2 __attribute__((ext_vector_type(2)));

constexpr int Dm = 1024, NB = 4, SEQ = 4096, M = NB * SEQ, DEPTH = 4, FF = 2816, INW = 6144;
constexpr float EPS = 1e-6f;
constexpr float LOG2E = 1.4426950408889634f;

constexpr size_t W_IN = 0, W_AB = 12582912, W_O2 = 14680064, W_GU = 18874368, W_D = 30408704, WSZ = 36175872;
constexpr size_t MiB = 1048576;
constexpr size_t OFF_XB = 2 * WSZ;
constexpr size_t OFF_RSA = OFF_XB + 32 * MiB;
constexpr size_t OFF_RSB = OFF_RSA + MiB;
constexpr size_t OFF_CS = OFF_RSB + MiB;
constexpr size_t OFF_LB = OFF_CS + MiB;
constexpr size_t OFF_LAM = OFF_LB + 16384;
constexpr size_t OFF_DG = OFF_LAM + 256;
constexpr size_t OFF_EG = OFF_DG + MiB;
constexpr size_t OFF_B = OFF_EG + MiB;
constexpr size_t OFF_GATE = OFF_B;
constexpr size_t OFF_Q = OFF_B, OFF_K = OFF_B + 16 * MiB, OFF_V = OFF_B + 32 * MiB;
constexpr size_t OFF_HQ = OFF_B + 64 * MiB;
constexpr size_t OFF_HV = OFF_HQ + 16 * MiB;
constexpr size_t OFF_GF = OFF_HV + 16 * MiB;
constexpr size_t OFF_GB = OFF_GF + 32 * MiB;
constexpr size_t OFF_Y = OFF_GF;
constexpr size_t OFF_BG = OFF_GB + 32 * MiB;
constexpr size_t OFF_AO = OFF_BG + 16 * MiB;
constexpr size_t OFF_UT = OFF_AO + 32 * MiB;
constexpr size_t OFF_H = OFF_B;
constexpr size_t OFF_BAR = OFF_UT + 64 * MiB;
constexpr size_t BAR_BYTES = 16384;
constexpr size_t WS_END = OFF_BAR + BAR_BYTES;

constexpr int LDS_BYTES = 131072 + 2048;

__device__ __forceinline__ unsigned f2bf(float f) { unsigned u = __builtin_bit_cast(unsigned, f); return (u + 0x7fffu + ((u >> 16) & 1u)) >> 16; }
__device__ __forceinline__ unsigned pk2(float lo, float hi) { return f2bf(lo) | (f2bf(hi) << 16); }
__device__ __forceinline__ float bf2f(unsigned short b) { return __builtin_bit_cast(float, (unsigned)b << 16); }
__device__ __forceinline__ float bflo(unsigned u) { return __builtin_bit_cast(float, u << 16); }
__device__ __forceinline__ float bfhi(unsigned u) { return __builtin_bit_cast(float, u & 0xffff0000u); }
__device__ __forceinline__ float sigmoidf_(float x) { return 1.0f / (1.0f + __expf(-x)); }

namespace pg8 {
constexpr int BM = 256, BK = 64, HALF = 128, HTB = HALF * BK * 2, STAGE_BYTES = 8 * HTB, NXCD = 8, WGM = 8;
__host__ __device__ __forceinline__ int lds_byte(int r, int c) { const int st = (r >> 4) * 2 + (c >> 5), rr = r & 15, cc = c & 31, ob = rr * 64 + cc * 2; return st * 1024 + (ob ^ (((ob >> 9) & 1) << 5)); }
__host__ __device__ __forceinline__ void stage_rc(int b, int& R, int& C) { const int st = b / 1024, sb = b % 1024, swz = sb ^ (((sb >> 9) & 1) << 5); R = (st >> 1) * 16 + swz / 64; C = (st & 1) * 32 + (swz % 64) / 2; }
__host__ __device__ __forceinline__ int perm32(int rho) { const int n = rho >> 4, i = rho & 15; return 8 * (i >> 2) + 4 * n + (i & 3); }

struct Unit { int pm, pn; };
struct Gemm { const bf16_t* A; const bf16_t* Bt; int lda, ldb, K; int split_pn; int split_aoff; };

struct StaticOrder {
    int nM, nN, nwg, G, c;
    __device__ __forceinline__ void init(int M_, int N_, int G_, int c_) { nM = M_ / BM; nN = N_ / BM; nwg = nM * nN; G = G_; c = c_; }
    __device__ bool next(int i, Unit& u) const {
        const long L = (long)i * G + c; if (L >= nwg) return false;
        int wgid = (int)L; { const int q = nwg / NXCD, r = nwg % NXCD, xcd = wgid % NXCD, off = wgid / NXCD; wgid = (xcd < r ? xcd * (q + 1) : r * (q + 1) + (xcd - r) * q) + off; }
        const int nig = WGM * nN, gid = wgid / nig, fm = gid * WGM, gsz = (nM - fm) < WGM ? (nM - fm) : WGM;
        u.pm = fm + ((wgid % nig) % gsz); u.pn = (wgid % nig) / gsz; return true;
    }
};

template <class Epi>
__device__ __forceinline__ void gemm_phase(LAS unsigned char* lds, const Gemm g, const StaticOrder& S, const Epi& E) {
    int tid_ = threadIdx.x; asm volatile("" : "+v"(tid_));
    const int tid = tid_, wid = __builtin_amdgcn_readfirstlane(tid >> 6), lane = tid & 63, wr = wid >> 2, wc = wid & 3, fr = lane & 15, fq = lane >> 4;
    const int K = g.K, nt = K / BK;
    unsigned voffA[2], voffB[2];
#pragma unroll
    for (int i = 0; i < 2; ++i) { int R, C; stage_rc(tid * 16 + i * 8192, R, C); const int Rb = (R & ~31) + perm32(R & 31);
        voffA[i] = (unsigned)(R * g.lda + C) * 2u; voffB[i] = (unsigned)(Rb * g.ldb + C) * 2u; }
    const size_t kstep = (size_t)(BK * 2);
    const size_t hstepA = (size_t)HALF * g.lda * 2, hstepB = (size_t)HALF * g.ldb * 2;
    const size_t tstepA = 2 * hstepA, tstepB = 2 * hstepB;
    const unsigned ldsw = (unsigned)wid * 1024u;
    const int aoff = lds_byte(wr * 64 + fr, fq * 8), boff = lds_byte(wc * 32 + fr, fq * 8);
#define PG8_SA(b, h) (((b) * 2 + (h)) * HTB)
#define PG8_SB(b, h) ((4 + (b) * 2 + (h)) * HTB)
#define PG8_STAGE(bufoff, gbase, voff) do { _Pragma("unroll") for (int _i = 0; _i < 2; ++_i) \
        __builtin_amdgcn_global_load_lds((const unsigned*)((const char*)(gbase) + (voff)[_i]), (LAS unsigned*)(lds + (bufoff) + ldsw + _i * 8192), 16, 0, 0); } while (0)
#define PG8_LDA(dst, b, h) do { _Pragma("unroll") for (int m = 0; m < 4; ++m) _Pragma("unroll") for (int k = 0; k < 2; ++k) dst[m][k] = *(const LAS bf16x8*)(lds + PG8_SA(b, h) + aoff + m * 2048 + k * 1024); } while (0)
#define PG8_LDB(dst, b, h) do { _Pragma("unroll") for (int n = 0; n < 2; ++n) _Pragma("unroll") for (int k = 0; k < 2; ++k) dst[n][k] = *(const LAS bf16x8*)(lds + PG8_SB(b, h) + boff + n * 2048 + k * 1024); } while (0)
#define PG8_MMA(ai, bj, At, Bt) do { __builtin_amdgcn_s_setprio(1); _Pragma("unroll") for (int m = 0; m < 4; ++m) _Pragma("unroll") for (int n = 0; n < 2; ++n) _Pragma("unroll") for (int k = 0; k < 2; ++k) \
        acc[ai][bj][m][n] = __builtin_amdgcn_mfma_f32_16x16x32_bf16(Bt[n][k], At[m][k], acc[ai][bj][m][n], 0, 0, 0); __builtin_amdgcn_s_setprio(0); } while (0)
#define PG8_WAIT_V(n) asm volatile("s_waitcnt vmcnt(" #n ")" ::: "memory")
#define PG8_WAIT_L(n) asm volatile("s_waitcnt lgkmcnt(" #n ")" ::: "memory")
#define PG8_BAR __builtin_amdgcn_s_barrier()
#define PG8_SCHED __builtin_amdgcn_sched_barrier(0)
#define PG8_UA(u) ((const char*)g.A + (size_t)(u).pm * tstepA + (((u).pn >= g.split_pn) ? (size_t)g.split_aoff * 2 : (size_t)0))
    Unit cur, nxt; int ui = 0;
    if (!S.next(0, cur)) return;
    f32x4 acc[2][2][4][2];
#pragma unroll
    for (int a = 0; a < 2; ++a)
#pragma unroll
        for (int b = 0; b < 2; ++b)
#pragma unroll
            for (int m = 0; m < 4; ++m)
#pragma unroll
                for (int n = 0; n < 2; ++n) acc[a][b][m][n] = (f32x4){0.f, 0.f, 0.f, 0.f};
    bf16x8 At[4][2], B0[2][2], B1[2][2];
    const char* cA = PG8_UA(cur); const char* cB = (const char*)g.Bt + (size_t)cur.pn * tstepB;
    PG8_STAGE(PG8_SB(0, 0), cB, voffB); PG8_STAGE(PG8_SB(0, 1), cB + hstepB, voffB); PG8_STAGE(PG8_SA(0, 0), cA, voffA); PG8_STAGE(PG8_SA(0, 1), cA + hstepA, voffA);
    if (wr == 1) PG8_BAR;
    PG8_WAIT_V(2); PG8_BAR;
    PG8_STAGE(PG8_SB(1, 0), cB + kstep, voffB); PG8_STAGE(PG8_SA(1, 0), cA + kstep, voffA); PG8_STAGE(PG8_SB(1, 1), cB + hstepB + kstep, voffB);
    PG8_WAIT_V(6); PG8_BAR;
    for (;;) {
        const bool has_next = S.next(ui + 1, nxt);
        const char* nA = has_next ? PG8_UA(nxt) : cA; const char* nB = has_next ? (const char*)g.Bt + (size_t)nxt.pn * tstepB : cB;
        for (int t = 0; t < nt; t += 2) {
            const bool last = (t == nt - 2);
            const char* a1 = cA + (size_t)(t + 1) * kstep;
            const char* a2 = last ? nA : cA + (size_t)(t + 2) * kstep; const char* b2 = last ? nB : cB + (size_t)(t + 2) * kstep;
            const char* a3 = a2 + kstep; const char* b3 = b2 + kstep;
            PG8_LDB(B0, 0, 0); PG8_LDB(B1, 0, 1); PG8_SCHED; PG8_LDA(At, 0, 0); PG8_STAGE(PG8_SA(1, 1), a1 + hstepA, voffA);
            PG8_WAIT_V(8); PG8_WAIT_L(0); PG8_BAR; PG8_MMA(0, 0, At, B0); PG8_MMA(0, 1, At, B1); PG8_BAR; PG8_SCHED;
            PG8_LDA(At, 0, 1); PG8_STAGE(PG8_SB(0, 0), b2, voffB); PG8_STAGE(PG8_SB(0, 1), b2 + hstepB, voffB); PG8_STAGE(PG8_SA(0, 0), a2, voffA);
            PG8_WAIT_V(8); PG8_WAIT_L(0); PG8_BAR; PG8_MMA(1, 0, At, B0); PG8_MMA(1, 1, At, B1); PG8_BAR; PG8_SCHED;
            PG8_LDB(B0, 1, 0); PG8_LDB(B1, 1, 1); PG8_SCHED; PG8_LDA(At, 1, 0); PG8_STAGE(PG8_SA(0, 1), a2 + hstepA, voffA);
            PG8_WAIT_V(8); PG8_WAIT_L(0); PG8_BAR; PG8_MMA(0, 0, At, B0); PG8_MMA(0, 1, At, B1); PG8_BAR; PG8_SCHED;
            PG8_LDA(At, 1, 1); PG8_STAGE(PG8_SB(1, 0), b3, voffB); PG8_STAGE(PG8_SB(1, 1), b3 + hstepB, voffB); PG8_STAGE(PG8_SA(1, 0), a3, voffA);
            PG8_WAIT_V(8); PG8_WAIT_L(0); PG8_BAR; PG8_MMA(1, 0, At, B0); PG8_MMA(1, 1, At, B1); PG8_BAR; PG8_SCHED;
        }
        if (wr == 0) PG8_BAR;
        E(acc, cur, wr, wc, fr, fq);
        if (!has_next) break;
#pragma unroll
        for (int a = 0; a < 2; ++a)
#pragma unroll
            for (int b = 0; b < 2; ++b)
#pragma unroll
                for (int m = 0; m < 4; ++m)
#pragma unroll
                    for (int n = 0; n < 2; ++n) acc[a][b][m][n] = (f32x4){0.f, 0.f, 0.f, 0.f};
        cur = nxt; cA = nA; cB = nB; ++ui;
        if (wr == 1) PG8_BAR;
    }
    PG8_WAIT_V(0);
    PG8_BAR;
#undef PG8_SA
#undef PG8_SB
#undef PG8_STAGE
#undef PG8_LDA
#undef PG8_LDB
#undef PG8_MMA
#undef PG8_UA
}
}

__device__ __forceinline__ float row_rs(const float* rsp, int row) {
    const f32x4* p = (const f32x4*)(rsp + (size_t)row * 16);
    f32x4 a = p[0], b = p[1], c = p[2], d = p[3];
    float s = ((a.x + a.y) + (a.z + a.w)) + ((b.x + b.y) + (b.z + b.w)) + ((c.x + c.y) + (c.z + c.w)) + ((d.x + d.y) + (d.z + d.w));
    return rsqrtf(s * (1.0f / Dm) + EPS);
}
__device__ __forceinline__ u32x4 pack8(const float* v) { u32x4 w; w.x = pk2(v[0], v[1]); w.y = pk2(v[2], v[3]); w.z = pk2(v[4], v[5]); w.w = pk2(v[6], v[7]); return w; }

struct EpiMix {
    const float* rsp; const float* cs; const float* lbF; const float* lbB;
    bf16_t *Q, *Kk, *V, *HQ, *HV, *BG; float *GF, *GB;
    __device__ __forceinline__ void operator()(const f32x4 (&acc)[2][2][4][2], const pg8::Unit& u, int wr, int wc, int fr, int fq) const {
        const int grp = u.pn >> 1;
#pragma unroll
        for (int ai = 0; ai < 2; ++ai)
#pragma unroll
            for (int m = 0; m < 4; ++m) {
                const int row = u.pm * 256 + ai * 128 + wr * 64 + m * 16 + fr;
                const float rs = row_rs(rsp, row);
                const int b = row >> 12, s = row & 4095;
#pragma unroll
                for (int bj = 0; bj < 2; ++bj) {
                    const int col = u.pn * 256 + bj * 128 + wc * 32 + fq * 8;
                    const int jj = col & 511;
                    float v[8];
#pragma unroll
                    for (int e = 0; e < 4; ++e) { v[e] = acc[ai][bj][m][0][e] * rs; v[4 + e] = acc[ai][bj][m][1][e] * rs; }
                    if (grp <= 1) {
                        const int d0 = jj & 63;
                        if (d0 < 16) {
                            const int gsel = d0 >> 3;
                            const f32x4 c4 = *(const f32x4*)(cs + (size_t)row * 16 + gsel * 4), s4 = *(const f32x4*)(cs + (size_t)row * 16 + 8 + gsel * 4);
#pragma unroll
                            for (int e = 0; e < 4; ++e) { const float t1 = v[e], t2 = v[4 + e]; v[e] = t1 * c4[e] - t2 * s4[e]; v[4 + e] = t2 * c4[e] + t1 * s4[e]; }
                        }
                        if (grp == 0) {
#pragma unroll
                            for (int e = 0; e < 8; ++e) v[e] *= 0.125f * LOG2E;
                        }
                        const int h = jj >> 7, c = (jj >> 6) & 1;
                        bf16_t* dst = (grp == 0 ? Q : Kk) + ((size_t)(((b * 4 + h) * 2 + c) * SEQ + s)) * 64 + d0;
                        *(u32x4*)dst = pack8(v);
                    } else if (grp == 2) {
                        const int h = jj >> 7, d0 = jj & 127;
                        *(u32x4*)(V + ((size_t)((b * 4 + h) * SEQ + s)) * 128 + d0) = pack8(v);
                    } else if (grp == 3) {
                        *(u32x4*)(HQ + (size_t)row * 512 + jj) = pack8(v);
                    } else if (grp == 4 || grp == 5) {
                        const float* lbp = (grp == 4 ? lbF : lbB) + jj;
                        const f32x4 l0 = *(const f32x4*)lbp, l1 = *(const f32x4*)(lbp + 4);
                        float gl[8];
#pragma unroll
                        for (int e = 0; e < 8; ++e) { const float lb = e < 4 ? l0[e] : l1[e - 4]; const float f = lb + (1.0f - lb) * sigmoidf_(v[e]); gl[e] = __logf(fmaxf(f, 1e-37f)); }
                        float* dst = (grp == 4 ? GF : GB) + (size_t)row * 512 + jj;
                        *(f32x4*)dst = (f32x4){gl[0], gl[1], gl[2], gl[3]}; *(f32x4*)(dst + 4) = (f32x4){gl[4], gl[5], gl[6], gl[7]};
                    } else if (grp == 6) {
                        *(u32x4*)(HV + (size_t)row * 512 + jj) = pack8(v);
                    } else {
#pragma unroll
                        for (int e = 0; e < 8; ++e) v[e] = sigmoidf_(v[e]);
                        *(u32x4*)(BG + (size_t)row * 512 + jj) = pack8(v);
                    }
                }
            }
    }
};

struct EpiGate {
    const float* rsp; bf16_t* G;
    __device__ __forceinline__ void operator()(const f32x4 (&acc)[2][2][4][2], const pg8::Unit& u, int wr, int wc, int fr, int fq) const {
#pragma unroll
        for (int ai = 0; ai < 2; ++ai)
#pragma unroll
            for (int m = 0; m < 4; ++m) {
                const int row = u.pm * 256 + ai * 128 + wr * 64 + m * 16 + fr;
                const float rs = row_rs(rsp, row);
#pragma unroll
                for (int bj = 0; bj < 2; ++bj) {
                    const int col = u.pn * 256 + bj * 128 + wc * 32 + fq * 8;
                    float v[8];
#pragma unroll
                    for (int e = 0; e < 4; ++e) { v[e] = sigmoidf_(acc[ai][bj][m][0][e] * rs); v[4 + e] = sigmoidf_(acc[ai][bj][m][1][e] * rs); }
                    *(u32x4*)(G + (size_t)row * 2048 + col) = pack8(v);
                }
            }
    }
};

struct EpiY {
    const bf16_t* G; bf16_t* Y;
    __device__ __forceinline__ void operator()(const f32x4 (&acc)[2][2][4][2], const pg8::Unit& u, int wr, int wc, int fr, int fq) const {
#pragma unroll
        for (int ai = 0; ai < 2; ++ai)
#pragma unroll
            for (int m = 0; m < 4; ++m) {
                const int row = u.pm * 256 + ai * 128 + wr * 64 + m * 16 + fr;
#pragma unroll
                for (int bj = 0; bj < 2; ++bj) {
                    const int col = u.pn * 256 + bj * 128 + wc * 32 + fq * 8;
                    const u32x4 gq = *(const u32x4*)(G + (size_t)row * 2048 + col);
                    float v[8];
                    v[0] = acc[ai][bj][m][0][0] * bflo(gq.x); v[1] = acc[ai][bj][m][0][1] * bfhi(gq.x);
                    v[2] = acc[ai][bj][m][0][2] * bflo(gq.y); v[3] = acc[ai][bj][m][0][3] * bfhi(gq.y);
                    v[4] = acc[ai][bj][m][1][0] * bflo(gq.z); v[5] = acc[ai][bj][m][1][1] * bfhi(gq.z);
                    v[6] = acc[ai][bj][m][1][2] * bflo(gq.w); v[7] = acc[ai][bj][m][1][3] * bfhi(gq.w);
                    *(u32x4*)(Y + (size_t)row * 2048 + col) = pack8(v);
                }
            }
    }
};

struct EpiRes {
    const float* xres; float* xout; bf16_t* XB; float* rsp;
    __device__ __forceinline__ void operator()(const f32x4 (&acc)[2][2][4][2], const pg8::Unit& u, int wr, int wc, int fr, int fq) const {
#pragma unroll
        for (int ai = 0; ai < 2; ++ai)
#pragma unroll
            for (int m = 0; m < 4; ++m) {
                const int row = u.pm * 256 + ai * 128 + wr * 64 + m * 16 + fr;
                float ss = 0.f;
#pragma unroll
                for (int bj = 0; bj < 2; ++bj) {
                    const int col = u.pn * 256 + bj * 128 + wc * 32 + fq * 8;
                    const float* xr = xres + (size_t)row * Dm + col;
                    const f32x4 x0 = *(const f32x4*)xr, x1 = *(const f32x4*)(xr + 4);
                    float v[8];
#pragma unroll
                    for (int e = 0; e < 4; ++e) { v[e] = x0[e] + acc[ai][bj][m][0][e]; v[4 + e] = x1[e] + acc[ai][bj][m][1][e]; }
#pragma unroll
                    for (int e = 0; e < 8; ++e) ss += v[e] * v[e];
                    float* xo = xout + (size_t)row * Dm + col;
                    *(f32x4*)xo = (f32x4){v[0], v[1], v[2], v[3]}; *(f32x4*)(xo + 4) = (f32x4){v[4], v[5], v[6], v[7]};
                    *(u32x4*)(XB + (size_t)row * Dm + col) = pack8(v);
                }
                ss += __shfl_xor(ss, 16); ss += __shfl_xor(ss, 32);
                if (fq == 0) rsp[(size_t)row * 16 + u.pn * 4 + wc] = ss;
            }
    }
};

struct EpiGU {
    const float* rsp; bf16_t* H;
    __device__ __forceinline__ void operator()(const f32x4 (&acc)[2][2][4][2], const pg8::Unit& u, int wr, int wc, int fr, int fq) const {
#pragma unroll
        for (int ai = 0; ai < 2; ++ai)
#pragma unroll
            for (int m = 0; m < 4; ++m) {
                const int row = u.pm * 256 + ai * 128 + wr * 64 + m * 16 + fr;
                const float rs = row_rs(rsp, row);
                const int col = u.pn * 128 + wc * 32 + fq * 8;
                float v[8];
#pragma unroll
                for (int n = 0; n < 2; ++n)
#pragma unroll
                    for (int e = 0; e < 4; ++e) { const float gg = acc[ai][0][m][n][e] * rs, uu = acc[ai][1][m][n][e] * rs; v[n * 4 + e] = gg * sigmoidf_(gg) * uu; }
                *(u32x4*)(H + (size_t)row * FF + col) = pack8(v);
            }
    }
};

__device__ __forceinline__ int rope_perm(int n) {
    const int d = n & 63; if (d >= 16) return n;
    const int g = d >> 3, e = d & 7; return (n & ~63) + ((e < 4) ? 4 * g + e : 8 + 4 * g + (e - 4));
}
__device__ __forceinline__ void conv_item(const float* src, int ld_src, int ks0, int c0  , int mode  ,
                                          const float* gain, bf16_t* dst, int ld_dst, int n0, int kd0, LAS float* scr, int lane) {
    const int n4 = lane & 7, kr = lane >> 3;
    int sc = c0 + 4 * n4;
    if (mode) { const int q = (sc & 63) >> 2; if (q == 1) sc += 4; else if (q == 2) sc -= 4; }
#pragma unroll
    for (int i = 0; i < 8; ++i) { const int kk = kr + 8 * i; f32x4 w = *(const f32x4*)(src + (size_t)(ks0 + kk) * ld_src + sc);
        if (gain) { const float gg = gain[ks0 + kk]; w.x *= gg; w.y *= gg; w.z *= gg; w.w *= gg; }
        LAS float* d = scr + kk * 33 + 4 * n4; d[0] = w.x; d[1] = w.y; d[2] = w.z; d[3] = w.w; }
    asm volatile("s_waitcnt lgkmcnt(0)" ::: "memory");
    const int c = lane & 7;
#pragma unroll
    for (int j = 0; j < 4; ++j) { const int n = (lane >> 3) + 8 * j; const LAS float* s = scr + (8 * c) * 33 + n;
        u32x4 o; o.x = pk2(s[0 * 33], s[1 * 33]); o.y = pk2(s[2 * 33], s[3 * 33]); o.z = pk2(s[4 * 33], s[5 * 33]); o.w = pk2(s[6 * 33], s[7 * 33]);
        *(u32x4*)(dst + (size_t)(n0 + n) * ld_dst + kd0 + 8 * c) = o; }
    asm volatile("s_waitcnt lgkmcnt(0)" ::: "memory");
}

struct Ptrs {
    const float *x; const int* pos; const float *w_in, *da_lambda, *da_norm, *hg_lb, *hg_norm, *w_a, *w_b, *w_o, *attn_norm, *ffn_norm, *w_gate, *w_up, *w_down, *final_norm;
    float* out; unsigned char* ws; int ph_lo, ph_hi;
};

__device__ __forceinline__ void convert_layer(const Ptrs& P, int layer, unsigned char* wbuf, LAS unsigned char* lds, int gw, int ngw, int wave, int lane) {
    LAS float* scr = (LAS float*)(lds + wave * 8704);
    constexpr int I_IN = 16 * 192, I_A = 8 * 32, I_B = 8 * 32, I_O = 32 * 32, I_GU = 16 * 176, I_D = 44 * 32;
    constexpr int NIT = I_IN + I_A + I_B + I_O + I_GU + I_D;
    for (int it = gw; it < NIT; it += ngw) {
        int r = it;
        if (r < I_IN) { const int kb = r / 192, nb = r % 192, n0 = nb * 32;
            conv_item(P.w_in + (size_t)layer * Dm * INW, INW, kb * 64, n0, n0 < 1024 ? 1 : 0, P.attn_norm + layer * Dm, (bf16_t*)(wbuf + W_IN), Dm, n0, kb * 64, scr, lane); continue; }
        r -= I_IN;
        if (r < I_A) { const int kb = r / 32, nb = r % 32;
            conv_item(P.w_a + (size_t)layer * 512 * Dm, Dm, kb * 64, nb * 32, 0, nullptr, (bf16_t*)(wbuf + W_AB), 512, nb * 32, kb * 64, scr, lane); continue; }
        r -= I_A;
        if (r < I_B) { const int kb = r / 32, nb = r % 32;
            conv_item(P.w_b + (size_t)layer * 512 * Dm, Dm, kb * 64, nb * 32, 0, nullptr, (bf16_t*)(wbuf + W_AB), 512, 1024 + nb * 32, kb * 64, scr, lane); continue; }
        r -= I_B;
        if (r < I_O) { const int kb = r / 32, nb = r % 32;
            conv_item(P.w_o + (size_t)layer * Dm * Dm, Dm, (kb * 64) & 1023, nb * 32, 0, nullptr, (bf16_t*)(wbuf + W_O2), 2048, nb * 32, kb * 64, scr, lane); continue; }
        r -= I_O;
        if (r < I_GU) { const int kb = r / 176, nb = r % 176, n0 = nb * 32, tile = n0 >> 8, rr = n0 & 255;
            const float* srcm = (rr < 128 ? P.w_gate : P.w_up) + (size_t)layer * Dm * FF;
            conv_item(srcm, FF, kb * 64, tile * 128 + (rr & 127), 0, P.ffn_norm + layer * Dm, (bf16_t*)(wbuf + W_GU), Dm, n0, kb * 64, scr, lane); continue; }
        r -= I_GU;
        { const int kb = r / 32, nb = r % 32;
            conv_item(P.w_down + (size_t)layer * FF * Dm, Dm, kb * 64, nb * 32, 0, nullptr, (bf16_t*)(wbuf + W_D), FF, nb * 32, kb * 64, scr, lane); }
    }
}

__device__ __forceinline__ float wave_sum(float v) {
#pragma unroll
    for (int o = 1; o < 64; o <<= 1) v += __shfl_xor(v, o);
    return v;
}
__device__ __forceinline__ void prologue(const Ptrs& P, LAS unsigned char* lds, int gw, int ngw, int wave, int lane) {
    unsigned char* ws = P.ws;
    bf16_t* XB = (bf16_t*)(ws + OFF_XB); float* rsb = (float*)(ws + OFF_RSB);
    for (int r = gw; r < M; r += ngw) {
        const f32x4* xr = (const f32x4*)(P.x + (size_t)r * Dm) + lane;
        float ss = 0.f;
#pragma unroll
        for (int j = 0; j < 4; ++j) { const f32x4 v = xr[64 * j]; ss += (v.x * v.x + v.y * v.y) + (v.z * v.z + v.w * v.w);
            u32x2 o; o.x = pk2(v.x, v.y); o.y = pk2(v.z, v.w); *((u32x2*)(XB + (size_t)r * Dm) + lane + 64 * j) = o; }
        ss = wave_sum(ss);
        if (lane < 16) rsb[(size_t)r * 16 + lane] = (lane == 0) ? ss : 0.f;
    }
    const int gt = gw * 64 + lane, ngt = ngw * 64;
    float* cs = (float*)(ws + OFF_CS);
    for (int i = gt; i < M * 8; i += ngt) {
        const int tok = i >> 3, f = i & 7;
        const double invf[8] = {1.0, 0.19392274474868576, 0.03760603093086393, 0.007292664737217109, 0.001414213562373095, 0.0002742481756762073, 5.318295896944988e-05, 1.031338537721246e-05};
        double fr;
        switch (f) { case 0: fr = invf[0]; break; case 1: fr = invf[1]; break; case 2: fr = invf[2]; break; case 3: fr = invf[3]; break; case 4: fr = invf[4]; break; case 5: fr = invf[5]; break; case 6: fr = invf[6]; break; default: fr = invf[7]; }
        const float ang32 = (float)P.pos[tok] * (float)fr;
        const double ang = (double)ang32;
        const double rev = ang * 0.15915494309189535;
        const double fracrev = rev - __builtin_floor(rev + 0.5);
        const float a = (float)(fracrev * 6.283185307179586);
        cs[(size_t)tok * 16 + f] = __cosf(a); cs[(size_t)tok * 16 + 8 + f] = __sinf(a);
    }
    float* LB = (float*)(ws + OFF_LB);
    for (int i = gt; i < 2 * 512; i += ngt) {
        const int d = i >> 9, k = i & 511;
        float l[4], mx = -1e30f;
#pragma unroll
        for (int j = 0; j < 4; ++j) { l[j] = P.hg_lb[(size_t)(d * 4 + j) * 512 + k]; mx = fmaxf(mx, l[j]); }
        float e[4], sum = 0.f;
#pragma unroll
        for (int j = 0; j < 4; ++j) { e[j] = __expf(l[j] - mx); sum += e[j]; }
        float cum = 0.f;
#pragma unroll
        for (int j = 0; j < 4; ++j) { if (j > 0) cum += e[j] / sum; LB[(size_t)(d * 4 + j) * 512 + k] = cum; }
    }
    if (gw == 0) {
        float* LAM = (float*)(ws + OFF_LAM);
        for (int l = 0; l < 4; ++l) {
            const float* p = P.da_lambda + l * 256;
            float a = wave_sum(p[lane] * p[64 + lane]), b = wave_sum(p[128 + lane] * p[192 + lane]);
            const float lam_init = 0.8f - 0.6f * __expf(-0.3f * (float)l);
            if (lane == 0) LAM[l] = __expf(a) - __expf(b) + lam_init;
        }
    }
}

constexpr int AT_KROW = 144, AT_VROW = 320, AT_K1 = 64 * AT_KROW, AT_V = 2 * AT_K1, AT_STG = AT_V + 64 * AT_VROW;
constexpr int AT_IMG_ROW = 132;
__device__ __forceinline__ s16x4 tr_read(const LAS unsigned char* p) { return __builtin_bit_cast(s16x4, __builtin_amdgcn_ds_read_tr16_b64_v4i16((LAS s16x4*)p)); }

__device__ __forceinline__ void attn_unit(int b, int h, int qb, const bf16_t* Q, const bf16_t* Kk, const bf16_t* V, bf16_t* AO, const float* gainA  , float one_minus_lam_init, float lam, LAS unsigned char* lds) {
    int tid_ = threadIdx.x; asm volatile("" : "+v"(tid_));
    const int tid = tid_, wave = __builtin_amdgcn_readfirstlane(tid >> 6), lane = tid & 63, c = wave >> 2, wq = wave & 3, r32 = lane & 31, hh = lane >> 5;
    const int q0 = qb * 128 + wq * 32;
    bf16x8 qf[4];
    { const bf16_t* Qp = Q + ((size_t)(((b * 4 + h) * 2 + c) * SEQ + q0 + r32)) * 64 + 8 * hh;
#pragma unroll
      for (int s = 0; s < 4; ++s) qf[s] = *(const bf16x8*)(Qp + 16 * s); }
    f32x16 o[4];
#pragma unroll
    for (int i = 0; i < 4; ++i)
#pragma unroll
        for (int e = 0; e < 16; ++e) o[i][e] = 0.f;
    float mrow = -1e30f, lrow = 0.f;
    const unsigned char* Kg0 = (const unsigned char*)(Kk + ((size_t)((b * 4 + h) * 2 + 0) * SEQ) * 64);
    const unsigned char* Kg1 = (const unsigned char*)(Kk + ((size_t)((b * 4 + h) * 2 + 1) * SEQ) * 64);
    const unsigned char* Vg = (const unsigned char*)(V + ((size_t)(b * 4 + h) * SEQ) * 128);
    const int lk = (tid >> 3) * AT_KROW + (tid & 7) * 16;
    const int lv0 = AT_V + (tid >> 4) * AT_VROW + (tid & 15) * 16, lv1 = lv0 + 32 * AT_VROW;
    u32x4 r0, r1, r2, r3;
    r0 = *(const u32x4*)(Kg0 + tid * 16); r1 = *(const u32x4*)(Kg1 + tid * 16); r2 = *(const u32x4*)(Vg + tid * 16); r3 = *(const u32x4*)(Vg + 8192 + tid * 16);
    *(LAS u32x4*)(lds + lk) = r0; *(LAS u32x4*)(lds + AT_K1 + lk) = r1; *(LAS u32x4*)(lds + lv0) = r2; *(LAS u32x4*)(lds + lv1) = r3;
    __syncthreads();
    const int ka = c * AT_K1 + r32 * AT_KROW + hh * 16;
    const int va = AT_V + (4 * hh + ((lane & 15) >> 2)) * AT_VROW + ((lane >> 4) & 1) * 32 + (lane & 3) * 8;
    for (int j = 0; j < 64; ++j) {
        const int st = (j & 1) * AT_STG;
        if (j + 1 < 64) {
            const size_t go = (size_t)(j + 1) * 8192;
            r0 = *(const u32x4*)(Kg0 + go + tid * 16); r1 = *(const u32x4*)(Kg1 + go + tid * 16);
            r2 = *(const u32x4*)(Vg + 2 * go + tid * 16); r3 = *(const u32x4*)(Vg + 2 * go + 8192 + tid * 16);
        }
        f32x16 s0, s1;
#pragma unroll
        for (int e = 0; e < 16; ++e) { s0[e] = 0.f; s1[e] = 0.f; }
#pragma unroll
        for (int ks = 0; ks < 4; ++ks) {
            const bf16x8 a0 = *(const LAS bf16x8*)(lds + st + ka + ks * 32), a1 = *(const LAS bf16x8*)(lds + st + ka + 32 * AT_KROW + ks * 32);
            s0 = __builtin_amdgcn_mfma_f32_32x32x16_bf16(a0, qf[ks], s0, 0, 0, 0);
            s1 = __builtin_amdgcn_mfma_f32_32x32x16_bf16(a1, qf[ks], s1, 0, 0, 0);
        }
        float mx = s0[0];
#pragma unroll
        for (int e = 1; e < 16; ++e) mx = fmaxf(mx, s0[e]);
#pragma unroll
        for (int e = 0; e < 16; ++e) mx = fmaxf(mx, s1[e]);
        mx = fmaxf(mx, __shfl_xor(mx, 32));
        const float mnew = fmaxf(mrow, mx), alpha = exp2f(mrow - mnew);
        mrow = mnew;
        float ls = 0.f;
#pragma unroll
        for (int e = 0; e < 16; ++e) { s0[e] = exp2f(s0[e] - mnew); s1[e] = exp2f(s1[e] - mnew); ls += s0[e] + s1[e]; }
        lrow = lrow * alpha + ls;
#pragma unroll
        for (int i = 0; i < 4; ++i)
#pragma unroll
            for (int e = 0; e < 16; ++e) o[i][e] *= alpha;
        bf16x8 pf[2][2];
#pragma unroll
        for (int s = 0; s < 2; ++s) {
            u32x4 w0, w1;
            w0.x = pk2(s0[8 * s + 0], s0[8 * s + 1]); w0.y = pk2(s0[8 * s + 2], s0[8 * s + 3]); w0.z = pk2(s0[8 * s + 4], s0[8 * s + 5]); w0.w = pk2(s0[8 * s + 6], s0[8 * s + 7]);
            w1.x = pk2(s1[8 * s + 0], s1[8 * s + 1]); w1.y = pk2(s1[8 * s + 2], s1[8 * s + 3]); w1.z = pk2(s1[8 * s + 4], s1[8 * s + 5]); w1.w = pk2(s1[8 * s + 6], s1[8 * s + 7]);
            pf[0][s] = __builtin_bit_cast(bf16x8, w0); pf[1][s] = __builtin_bit_cast(bf16x8, w1);
        }
#pragma unroll
        for (int kb = 0; kb < 2; ++kb)
#pragma unroll
            for (int s = 0; s < 2; ++s) {
                const LAS unsigned char* vb = lds + st + va + (32 * kb + 16 * s) * AT_VROW;
#pragma unroll
                for (int vt = 0; vt < 4; ++vt) {
                    const s16x4 t0 = tr_read(vb + vt * 64), t1 = tr_read(vb + vt * 64 + 8 * AT_VROW);
                    const bf16x8 av = {t0[0], t0[1], t0[2], t0[3], t1[0], t1[1], t1[2], t1[3]};
                    o[vt] = __builtin_amdgcn_mfma_f32_32x32x16_bf16(av, pf[kb][s], o[vt], 0, 0, 0);
                }
            }
        if (j + 1 < 64) {
            const int sn = ((j + 1) & 1) * AT_STG;
            *(LAS u32x4*)(lds + sn + lk) = r0; *(LAS u32x4*)(lds + sn + AT_K1 + lk) = r1; *(LAS u32x4*)(lds + sn + lv0) = r2; *(LAS u32x4*)(lds + sn + lv1) = r3;
        }
        __syncthreads();
    }
    const float inv = 1.0f / (lrow + __shfl_xor(lrow, 32));
    LAS float* img = (LAS float*)lds;
    const int qrow = wq * 32 + r32;
    if (c == 1) {
        const float sc = -lam * inv;
#pragma unroll
        for (int vt = 0; vt < 4; ++vt)
#pragma unroll
            for (int g = 0; g < 4; ++g)
                *(LAS f32x4*)(img + qrow * AT_IMG_ROW + 32 * vt + 8 * g + 4 * hh) = (f32x4){o[vt][4 * g] * sc, o[vt][4 * g + 1] * sc, o[vt][4 * g + 2] * sc, o[vt][4 * g + 3] * sc};
    }
    __syncthreads();
    if (c == 0) {
#pragma unroll
        for (int vt = 0; vt < 4; ++vt)
#pragma unroll
            for (int g = 0; g < 4; ++g) {
                LAS f32x4* p = (LAS f32x4*)(img + qrow * AT_IMG_ROW + 32 * vt + 8 * g + 4 * hh);
                f32x4 t = *p;
                t.x += o[vt][4 * g] * inv; t.y += o[vt][4 * g + 1] * inv; t.z += o[vt][4 * g + 2] * inv; t.w += o[vt][4 * g + 3] * inv;
                *p = t;
            }
    }
    __syncthreads();
    {
        const int q = tid >> 2, part = tid & 3;
        float v[32]; float ss = 0.f;
#pragma unroll
        for (int i = 0; i < 8; ++i) { const f32x4 t = *(const LAS f32x4*)(img + q * AT_IMG_ROW + 32 * part + 4 * i); v[4 * i] = t.x; v[4 * i + 1] = t.y; v[4 * i + 2] = t.z; v[4 * i + 3] = t.w;
            ss += (t.x * t.x + t.y * t.y) + (t.z * t.z + t.w * t.w); }
        ss += __shfl_xor(ss, 1); ss += __shfl_xor(ss, 2);
        const float rs = rsqrtf(ss * (1.0f / 128.0f) + EPS) * one_minus_lam_init;
        const float* gp = gainA + h * 128 + 32 * part;
        bf16_t* dst = AO + ((size_t)(b * SEQ + qb * 128 + q)) * 1024 + h * 128 + 32 * part;
#pragma unroll
        for (int i = 0; i < 4; ++i) {
            const f32x4 g0 = *(const f32x4*)(gp + 8 * i), g1 = *(const f32x4*)(gp + 8 * i + 4);
            u32x4 w; w.x = pk2(v[8 * i] * rs * g0.x, v[8 * i + 1] * rs * g0.y); w.y = pk2(v[8 * i + 2] * rs * g0.z, v[8 * i + 3] * rs * g0.w);
            w.z = pk2(v[8 * i + 4] * rs * g1.x, v[8 * i + 5] * rs * g1.y); w.w = pk2(v[8 * i + 6] * rs * g1.z, v[8 * i + 7] * rs * g1.w);
            *(u32x4*)(dst + 8 * i) = w;
        }
    }
    __syncthreads();
}

constexpr int HG_SEG = 0;
constexpr int HG_F = 2048;
constexpr int HG_PART = 2560;
constexpr int HG_V = 4096;
constexpr int HG_VROW = 288;
constexpr int HG_A = HG_V + 64 * HG_VROW;
constexpr int HG_KTROW = 144, HG_QKROW = 272;
constexpr int HG_Bq = HG_A + 128 * HG_KTROW;

__device__ __forceinline__ void hg_cumsum(const float* G, int tok0, int h, int dir, int k, int j, LAS unsigned char* lds, float (&gv)[16], float (&d)[16], float& m_out, float& tot_out) {
    const float* gp = G + (size_t)(tok0 + 16 * j) * 512 + h * 128 + k;
#pragma unroll
    for (int i = 0; i < 16; ++i) gv[i] = gp[(size_t)i * 512];
    float run = 0.f;
    if (dir == 0) {
#pragma unroll
        for (int i = 0; i < 16; ++i) { run += gv[i]; d[i] = run; }
    } else {
#pragma unroll
        for (int i = 15; i >= 0; --i) { run += gv[i]; d[i] = run; }
    }
    LAS float* seg = (LAS float*)(lds + HG_SEG);
    seg[j * 128 + k] = run;
    __syncthreads();
    const float s0 = seg[k], s1 = seg[128 + k], s2 = seg[256 + k], s3 = seg[384 + k];
    float off, m;
    if (dir == 0) { off = (j > 0 ? s0 : 0.f) + (j > 1 ? s1 : 0.f) + (j > 2 ? s2 : 0.f); m = s0 + s1; }
    else { off = (j < 3 ? s3 : 0.f) + (j < 2 ? s2 : 0.f) + (j < 1 ? s1 : 0.f); m = s2 + s3; }
#pragma unroll
    for (int i = 0; i < 16; ++i) d[i] = d[i] + off - m;
    m_out = m; tot_out = (s0 + s1) + (s2 + s3);
}

__device__ __forceinline__ void hg_load_v(const bf16_t* HV, int tok0, int h, LAS unsigned char* lds, int tid) {
#pragma unroll
    for (int i = 0; i < 2; ++i) { const int ch = tid + 512 * i, p = ch >> 4, part = ch & 15;
        *(LAS u32x4*)(lds + HG_V + p * HG_VROW + part * 16) = *(const u32x4*)(HV + (size_t)(tok0 + p) * 512 + h * 128 + part * 8); }
}

__device__ __forceinline__ void hg1_unit(int u, const float* GF, const float* GB, const bf16_t* HV, bf16_t* UT, float* Dg, float* Eg, LAS unsigned char* lds) {
    int tid_ = threadIdx.x; asm volatile("" : "+v"(tid_));
    const int tid = tid_, wave = __builtin_amdgcn_readfirstlane(tid >> 6), lane = tid & 63;
    const int dir = u & 1, cch = (u >> 1) & 63, bh = u >> 7, b = bh >> 2, h = bh & 3;
    const int tok0 = b * SEQ + cch * 64, k = tid & 127, j = tid >> 7;
    float gv[16], d[16], m, tot;
    hg_cumsum(dir ? GB : GF, tok0, h, dir, k, j, lds, gv, d, m, tot);
    hg_load_v(HV, tok0, h, lds, tid);
    float kt[16];
#pragma unroll
    for (int i = 0; i < 16; ++i) kt[i] = (1.0f - __expf(gv[i])) * __expf(fminf(-d[i], 40.f));
    { u32x4 w0, w1;
      w0.x = pk2(kt[0], kt[1]); w0.y = pk2(kt[2], kt[3]); w0.z = pk2(kt[4], kt[5]); w0.w = pk2(kt[6], kt[7]);
      w1.x = pk2(kt[8], kt[9]); w1.y = pk2(kt[10], kt[11]); w1.z = pk2(kt[12], kt[13]); w1.w = pk2(kt[14], kt[15]);
      *(LAS u32x4*)(lds + HG_A + k * HG_KTROW + j * 32) = w0; *(LAS u32x4*)(lds + HG_A + k * HG_KTROW + j * 32 + 16) = w1; }
    if (j == 0) { ((LAS float*)(lds + HG_F))[k] = __expf(tot - m); Dg[(size_t)u * 128 + k] = __expf(tot); Eg[(size_t)u * 128 + k] = __expf(m); }
    __syncthreads();
    const int i16 = lane & 15, g4 = lane >> 4;
    bf16x8 af[2];
#pragma unroll
    for (int s = 0; s < 2; ++s) {
        const LAS unsigned char* ap = lds + HG_A + (16 * wave + i16) * HG_KTROW + (32 * s + 4 * g4) * 2;
        const u32x2 lo = *(const LAS u32x2*)ap, hi = *(const LAS u32x2*)(ap + 32);
        af[s] = __builtin_bit_cast(bf16x8, (u32x4){lo.x, lo.y, hi.x, hi.y});
    }
    const f32x4 fsc = *(const LAS f32x4*)(lds + HG_F + (16 * wave + 4 * g4) * 4);
    const LAS unsigned char* vbase = lds + HG_V + (4 * g4 + (i16 >> 2)) * HG_VROW + (i16 & 3) * 8;
#pragma unroll
    for (int vt = 0; vt < 8; ++vt) {
        f32x4 acc = {0.f, 0.f, 0.f, 0.f};
#pragma unroll
        for (int s = 0; s < 2; ++s) {
            const s16x4 t0 = tr_read(vbase + (32 * s) * HG_VROW + vt * 32), t1 = tr_read(vbase + (32 * s + 16) * HG_VROW + vt * 32);
            const bf16x8 bv = {t0[0], t0[1], t0[2], t0[3], t1[0], t1[1], t1[2], t1[3]};
            acc = __builtin_amdgcn_mfma_f32_16x16x32_bf16(af[s], bv, acc, 0, 0, 0);
        }
        u32x2 w; w.x = pk2(acc[0] * fsc[0], acc[1] * fsc[1]); w.y = pk2(acc[2] * fsc[2], acc[3] * fsc[3]);
        *(u32x2*)(UT + ((size_t)u * 128 + 16 * vt + i16) * 128 + 16 * wave + 4 * g4) = w;
    }
    __syncthreads();
}

__device__ __forceinline__ void hg2_scan(bf16_t* UT, const float* Dg, const float* Eg, int gthread, int nthreads) {
    for (int idx = gthread; idx < 32 * 4096; idx += nthreads) {
        const int chain = idx >> 12, e4 = idx & 4095, v = e4 >> 5, k0 = (e4 & 31) * 4;
        const int dir = chain & 1, bh = chain >> 1;
        float S0 = 0.f, S1 = 0.f, S2 = 0.f, S3 = 0.f;
        int u = (bh * 64 + (dir ? 63 : 0)) * 2 + dir;
        const int ustep = dir ? -2 : 2;
        u32x2 uu[4]; f32x4 dd[4], ee[4];
#pragma unroll
        for (int r = 0; r < 4; ++r) { const int ur = u + r * ustep; uu[r] = *(const u32x2*)(UT + ((size_t)ur * 128 + v) * 128 + k0); dd[r] = *(const f32x4*)(Dg + (size_t)ur * 128 + k0); ee[r] = *(const f32x4*)(Eg + (size_t)ur * 128 + k0); }
        for (int cc = 0; cc < 64; cc += 4) {
#pragma unroll
            for (int r = 0; r < 4; ++r) {
                const u32x2 uc = uu[r]; const f32x4 dc = dd[r], ec = ee[r];
                if (cc + 4 < 64) { const int un = u + 4 * ustep; uu[r] = *(const u32x2*)(UT + ((size_t)un * 128 + v) * 128 + k0); dd[r] = *(const f32x4*)(Dg + (size_t)un * 128 + k0); ee[r] = *(const f32x4*)(Eg + (size_t)un * 128 + k0); }
                u32x2 w; w.x = pk2(ec.x * S0, ec.y * S1); w.y = pk2(ec.z * S2, ec.w * S3);
                *(u32x2*)(UT + ((size_t)u * 128 + v) * 128 + k0) = w;
                S0 = dc.x * S0 + bflo(uc.x); S1 = dc.y * S1 + bfhi(uc.x); S2 = dc.z * S2 + bflo(uc.y); S3 = dc.w * S3 + bfhi(uc.y);
                u += ustep;
            }
        }
    }
}

__device__ __forceinline__ void hg3_unit(int u3, const float* GF, const float* GB, const bf16_t* HQ, const bf16_t* HV, const bf16_t* ST, const bf16_t* BG, const float* gainH, bf16_t* AO, LAS unsigned char* lds) {
    int tid_ = threadIdx.x; asm volatile("" : "+v"(tid_));
    const int tid = tid_, wave = __builtin_amdgcn_readfirstlane(tid >> 6), lane = tid & 63;
    const int cch = u3 & 63, bh = u3 >> 6, b = bh >> 2, h = bh & 3;
    const int tok0 = b * SEQ + cch * 64, k = tid & 127, j = tid >> 7;
    const int tb = wave & 3, vh = wave >> 2, i16 = lane & 15, g4 = lane >> 4;
    f32x4 oacc[4];
#pragma unroll
    for (int i = 0; i < 4; ++i) oacc[i] = (f32x4){0.f, 0.f, 0.f, 0.f};
    hg_load_v(HV, tok0, h, lds, tid);
    for (int dir = 0; dir < 2; ++dir) {
        float gv[16], d[16], m, tot;
        hg_cumsum(dir ? GB : GF, tok0, h, dir, k, j, lds, gv, d, m, tot);
        const bf16_t* qp = HQ + (size_t)(tok0 + 16 * j) * 512 + h * 128 + k;
#pragma unroll
        for (int i = 0; i < 16; ++i) {
            const float kt = (1.0f - __expf(gv[i])) * __expf(fminf(-d[i], 40.f));
            const float qt = bf2f(qp[(size_t)i * 512]) * __expf(fminf(d[i], 40.f));
            *(LAS unsigned short*)(lds + HG_A + (16 * j + i) * HG_QKROW + k * 2) = (unsigned short)f2bf(kt);
            *(LAS unsigned short*)(lds + HG_Bq + (16 * j + i) * HG_QKROW + k * 2) = (unsigned short)f2bf(qt);
        }
        __syncthreads();
        f32x4 pt[4];
#pragma unroll
        for (int sg = 0; sg < 4; ++sg) pt[sg] = (f32x4){0.f, 0.f, 0.f, 0.f};
        bf16x8 qa[4];
#pragma unroll
        for (int ks = 0; ks < 4; ++ks) qa[ks] = *(const LAS bf16x8*)(lds + HG_Bq + (16 * tb + i16) * HG_QKROW + (32 * ks + 8 * g4) * 2);
#pragma unroll
        for (int sg = 0; sg < 4; ++sg)
#pragma unroll
            for (int ks = 0; ks < 4; ++ks) {
                const bf16x8 ka = *(const LAS bf16x8*)(lds + HG_A + (16 * sg + i16) * HG_QKROW + (32 * ks + 8 * g4) * 2);
                pt[sg] = __builtin_amdgcn_mfma_f32_16x16x32_bf16(ka, qa[ks], pt[sg], 0, 0, 0);
            }
        const int tcol = 16 * tb + i16;
#pragma unroll
        for (int sg = 0; sg < 4; ++sg)
#pragma unroll
            for (int e = 0; e < 4; ++e) { const int srow = 16 * sg + 4 * g4 + e; const bool keep = dir ? (srow >= tcol) : (srow <= tcol); pt[sg][e] = keep ? pt[sg][e] : 0.f; }
        bf16x8 pa[2];
#pragma unroll
        for (int s2 = 0; s2 < 2; ++s2) {
            u32x4 w; w.x = pk2(pt[2 * s2][0], pt[2 * s2][1]); w.y = pk2(pt[2 * s2][2], pt[2 * s2][3]); w.z = pk2(pt[2 * s2 + 1][0], pt[2 * s2 + 1][1]); w.w = pk2(pt[2 * s2 + 1][2], pt[2 * s2 + 1][3]);
            pa[s2] = __builtin_bit_cast(bf16x8, w);
        }
        const LAS unsigned char* vbase = lds + HG_V + (4 * g4 + (i16 >> 2)) * HG_VROW + (i16 & 3) * 8;
        const bf16_t* stp = ST + ((size_t)((bh * 64 + cch) * 2 + dir) * 128) * 128;
#pragma unroll
        for (int vv = 0; vv < 4; ++vv) {
            const int vt = 4 * vh + vv;
#pragma unroll
            for (int s2 = 0; s2 < 2; ++s2) {
                const s16x4 t0 = tr_read(vbase + (32 * s2) * HG_VROW + vt * 32), t1 = tr_read(vbase + (32 * s2 + 16) * HG_VROW + vt * 32);
                const bf16x8 bv = {t0[0], t0[1], t0[2], t0[3], t1[0], t1[1], t1[2], t1[3]};
                oacc[vv] = __builtin_amdgcn_mfma_f32_16x16x32_bf16(pa[s2], bv, oacc[vv], 0, 0, 0);
            }
#pragma unroll
            for (int ks = 0; ks < 4; ++ks) {
                const bf16x8 sb = *(const bf16x8*)(stp + (size_t)(16 * vt + i16) * 128 + 32 * ks + 8 * g4);
                oacc[vv] = __builtin_amdgcn_mfma_f32_16x16x32_bf16(qa[ks], sb, oacc[vv], 0, 0, 0);
            }
        }
        __syncthreads();
    }
    float ssq[4];
#pragma unroll
    for (int e = 0; e < 4; ++e) { float s = 0.f;
#pragma unroll
        for (int vv = 0; vv < 4; ++vv) s += oacc[vv][e] * oacc[vv][e];
        s += __shfl_xor(s, 1); s += __shfl_xor(s, 2); s += __shfl_xor(s, 4); s += __shfl_xor(s, 8); ssq[e] = s; }
    LAS float* part = (LAS float*)(lds + HG_PART);
    if (i16 == 0) {
#pragma unroll
        for (int e = 0; e < 4; ++e) part[vh * 64 + 16 * tb + 4 * g4 + e] = ssq[e];
    }
    __syncthreads();
#pragma unroll
    for (int e = 0; e < 4; ++e) {
        const int t = 16 * tb + 4 * g4 + e;
        const float rs = rsqrtf((part[t] + part[64 + t]) * (1.0f / 128.0f) + EPS);
#pragma unroll
        for (int vv = 0; vv < 4; ++vv) {
            const int v = 16 * (4 * vh + vv) + i16;
            const float gate = bf2f(BG[(size_t)(tok0 + t) * 512 + h * 128 + v]);
            AO[(size_t)(tok0 + t) * 1024 + 512 + h * 128 + v] = (bf16_t)f2bf(oacc[vv][e] * rs * gainH[h * 128 + v] * gate);
        }
    }
    __syncthreads();
}

#define XB_TMO      128
#define XB_XCNT(j)  (256  + 64 * (j))
#define XB_XSUB(j)  (1280 + 64 * (j))
#define XB_XGEN(j)  (2304 + 64 * (j))
#define XB_TOP      3328
#define XB_TOPGEN   3392
#define XCD_BAR_WORDS 3456
#define XB_SPIN_CAP (1u << 18)

__device__ __forceinline__ unsigned xb_ld(unsigned* p)              { return __hip_atomic_load(p, __ATOMIC_RELAXED, __HIP_MEMORY_SCOPE_AGENT); }
__device__ __forceinline__ unsigned xb_add(unsigned* p, unsigned v) { return __hip_atomic_fetch_add(p, v, __ATOMIC_RELAXED, __HIP_MEMORY_SCOPE_AGENT); }
__device__ __forceinline__ unsigned xb_xcc_id() { return (unsigned)__builtin_amdgcn_s_getreg((3 << 11) | 20) & 0xFu; }
#define XB_SPIN(cond, bar) do { unsigned _sp = 0; while (cond) { __builtin_amdgcn_s_sleep(1); \
    if ((++_sp & 255u) == 0u) { if (xb_ld(&(bar)[XB_TMO])) break; if (_sp > XB_SPIN_CAP) { atomicAdd(&(bar)[XB_TMO], 1u); break; } } } } while (0)

struct XcdBarrier {
    unsigned* bar; unsigned x;
    volatile LAS unsigned* st;
};

__device__ __forceinline__ XcdBarrier xcd_barrier_post(unsigned* bar, volatile LAS unsigned* st) {
    XcdBarrier b; b.bar = bar; b.x = xb_xcc_id(); b.st = st;
    if (threadIdx.x == 0) (void)xb_add(&bar[XB_XCNT(b.x)], 1u);
    return b;
}
__device__ __forceinline__ void xcd_barrier_complete(unsigned* bar, unsigned x, unsigned& nloc, unsigned& nx) {
    const unsigned G = gridDim.x * gridDim.y * gridDim.z;
    unsigned sum, cnt, mine, sp = 0u;
    for (;;) {
        sum = 0u; cnt = 0u; mine = 0u;
#pragma unroll
        for (unsigned j = 0; j < 16; ++j) { const unsigned c = xb_ld(&bar[XB_XCNT(j)]); sum += c; cnt += (c > 0u) ? 1u : 0u; mine = (j == x) ? c : mine; }
        if (sum == G) break;
        __builtin_amdgcn_s_sleep(1);
        if ((++sp & 255u) == 0u) { if (xb_ld(&bar[XB_TMO])) break; if (sp > XB_SPIN_CAP) { atomicAdd(&bar[XB_TMO], 1u); break; } }
    }
    nloc = mine > 0u ? mine : 1u; nx = cnt > 0u ? cnt : 1u;
}

__device__ __forceinline__ void xcd_barrier(const XcdBarrier& b) {
    asm volatile("s_waitcnt vmcnt(0)" ::: "memory");
    __syncthreads();
    if (threadIdx.x == 0) {
        unsigned* bar = b.bar;
        __builtin_amdgcn_s_waitcnt(0);
        unsigned nloc = b.st[0], nx = b.st[1];
        if (nloc == 0u) { xcd_barrier_complete(bar, b.x, nloc, nx); b.st[0] = nloc; b.st[1] = nx; }
        const unsigned old = xb_add(&bar[XB_XSUB(b.x)], 1u);
        const unsigned gen = old / nloc;
        if (old + 1u == (gen + 1u) * nloc) {
            __builtin_amdgcn_fence(__ATOMIC_RELEASE, "agent");
            asm volatile("s_waitcnt vmcnt(0)" ::: "memory");
            const unsigned og = xb_add(&bar[XB_TOP], 1u);
            const unsigned tg = og / nx;
            if (og + 1u == (tg + 1u) * nx) xb_add(&bar[XB_TOPGEN], 1u);
            else XB_SPIN(xb_ld(&bar[XB_TOPGEN]) == tg, bar);
            __builtin_amdgcn_fence(__ATOMIC_ACQUIRE, "agent");
            xb_add(&bar[XB_XGEN(b.x)], 1u);
            asm volatile("s_waitcnt vmcnt(0)" ::: "memory");
        } else {
            XB_SPIN(xb_ld(&bar[XB_XGEN(b.x)]) == gen, bar);
            __builtin_amdgcn_fence(__ATOMIC_ACQUIRE, "agent");
            asm volatile("s_waitcnt vmcnt(0)" ::: "memory");
        }
    }
    __syncthreads();
}

__global__ void __launch_bounds__(512, 2) fwd_kernel(Ptrs P) {
    extern __shared__ __attribute__((aligned(16))) unsigned char lds_raw[];
    LAS unsigned char* lds = (LAS unsigned char*)lds_raw;
    cg::grid_group grid = cg::this_grid();
    const int G = gridDim.x, bx = blockIdx.x;
    const int lo = P.ph_lo, hi = P.ph_hi;
    int ph = 0;
    if (threadIdx.x < 4) ((LAS unsigned*)(lds + 131072 + 1024))[threadIdx.x] = 0u;
    __syncthreads();
    XcdBarrier xbar = xcd_barrier_post((unsigned*)(P.ws + OFF_BAR), (volatile LAS unsigned*)(lds + 131072 + 1024));
#ifdef TS_A
    if (threadIdx.x == 0) { LAS unsigned long long* TS_ = (LAS unsigned long long*)(lds + 131072); for (int i = 0; i < 15; ++i) TS_[i] = 0ull; TS_[15] = __builtin_amdgcn_s_memrealtime(); }
#endif
#ifndef PH_MASK
#define PH_MASK 0xFFFFFFFFu
#endif
#define ON(id) constexpr (((PH_MASK) >> (id)) & 1u)
#define PHASE_BEGIN if (ph >= lo && ph < hi) { unsigned char* ws = P.ws; asm volatile("" : "+s"(ws)); int tid = threadIdx.x; asm volatile("" : "+v"(tid)); \
    const int lane = tid & 63, wave = __builtin_amdgcn_readfirstlane(tid >> 6), gw = bx * 8 + wave, ngw = G * 8; (void)lane; (void)gw; (void)ngw;
#define XB ((bf16_t*)(ws + OFF_XB))
#define RSA ((float*)(ws + OFF_RSA))
#define RSB ((float*)(ws + OFF_RSB))
#define CS ((const float*)(ws + OFF_CS))
#define LB ((const float*)(ws + OFF_LB))
#define LAM ((const float*)(ws + OFF_LAM))
#define Dg ((float*)(ws + OFF_DG))
#define Eg ((float*)(ws + OFF_EG))
#define GATE ((bf16_t*)(ws + OFF_GATE))
#define Qb ((bf16_t*)(ws + OFF_Q))
#define Kb ((bf16_t*)(ws + OFF_K))
#define Vb ((bf16_t*)(ws + OFF_V))
#define HQ ((bf16_t*)(ws + OFF_HQ))
#define HV ((bf16_t*)(ws + OFF_HV))
#define GF ((float*)(ws + OFF_GF))
#define GB ((float*)(ws + OFF_GB))
#define Yb ((bf16_t*)(ws + OFF_Y))
#define BG ((bf16_t*)(ws + OFF_BG))
#define AO ((bf16_t*)(ws + OFF_AO))
#define UT ((bf16_t*)(ws + OFF_UT))
#define Hb ((bf16_t*)(ws + OFF_H))
#ifdef TS_A
#define TICK(cat) do { if (bx == 0 && threadIdx.x == 0) { LAS unsigned long long* TS_ = (LAS unsigned long long*)(lds + 131072); const unsigned long long t_ = __builtin_amdgcn_s_memrealtime(); TS_[cat] += t_ - TS_[15]; TS_[15] = t_; } } while (0)
#else
#define TICK(cat) do { } while (0)
#endif
#define PHASE_END(cat)   TICK(cat); if (ph + 1 < hi) { if (ph == 0) grid.sync(); else xcd_barrier(xbar); TICK(13); } } ++ph;

    PHASE_BEGIN
        if ON(0) prologue(P, lds, gw, ngw, wave, lane);
        if ON(6) convert_layer(P, 0, ws, lds, gw, ngw, wave, lane);
    PHASE_END(0)

    for (int layer = 0; layer < DEPTH; ++layer) {
        PHASE_BEGIN
            pg8::Gemm g{XB, (const bf16_t*)(ws + (size_t)(layer & 1) * WSZ + W_IN), Dm, Dm, Dm, 1 << 30, 0};
            pg8::StaticOrder S; S.init(M, 4096, G, bx);
            EpiMix E{RSB, CS, LB + (0 * 4 + layer) * 512, LB + (1 * 4 + layer) * 512, Qb, Kb, Vb, HQ, HV, BG, GF, GB};
            if ON(1) pg8::gemm_phase(lds, g, S, E);
        PHASE_END(1)
        PHASE_BEGIN
            const float lam_init = 0.8f - 0.6f * __expf(-0.3f * (float)layer);
            const float lam = LAM[layer];
            if ON(2) for (int i = 0; i * G + bx < 512; ++i) {
                const int uid = i * G + bx; const int round = uid >> 8, r = uid & 255;
                const int bhh = round * 8 + (r & 7), qb = r >> 3;
                attn_unit(bhh >> 2, bhh & 3, qb, Qb, Kb, Vb, AO, P.da_norm + layer * 512, 1.0f - lam_init, lam, lds);
            }
            TICK(2);
            if ON(3) for (int u = bx; u < 2048; u += G) hg1_unit(u, GF, GB, HV, UT, Dg, Eg, lds);
        PHASE_END(3)
        PHASE_BEGIN
            {
                pg8::Gemm g{XB, (const bf16_t*)(ws + (size_t)(layer & 1) * WSZ + W_IN) + (size_t)4096 * Dm, Dm, Dm, Dm, 1 << 30, 0};
                pg8::StaticOrder S; S.init(M, 2048, G, bx);
                EpiGate E{RSB, GATE};
                if ON(4) pg8::gemm_phase(lds, g, S, E);
            }
            TICK(4);
            if ON(5) hg2_scan(UT, Dg, Eg, bx * 512 + tid, G * 512);
            TICK(5);
            if ON(6) if (layer + 1 < DEPTH) convert_layer(P, layer + 1, ws + (size_t)((layer + 1) & 1) * WSZ, lds, gw, ngw, wave, lane);
        PHASE_END(6)
        PHASE_BEGIN
            if ON(7) for (int u = bx; u < 1024; u += G) hg3_unit(u, GF, GB, HQ, HV, UT, BG, P.hg_norm + layer * 512, AO, lds);
        PHASE_END(7)
        PHASE_BEGIN
            pg8::Gemm g{AO, (const bf16_t*)(ws + (size_t)(layer & 1) * WSZ + W_AB), 1024, 512, 512, 4, 512};
            pg8::StaticOrder S; S.init(M, 2048, G, bx);
            EpiY E{GATE, Yb};
            if ON(8) pg8::gemm_phase(lds, g, S, E);
        PHASE_END(8)
        PHASE_BEGIN
            pg8::Gemm g{Yb, (const bf16_t*)(ws + (size_t)(layer & 1) * WSZ + W_O2), 2048, 2048, 2048, 1 << 30, 0};
            pg8::StaticOrder S; S.init(M, Dm, G, bx);
            EpiRes E{layer == 0 ? P.x : P.out, P.out, XB, RSA};
            if ON(9) pg8::gemm_phase(lds, g, S, E);
        PHASE_END(9)
        PHASE_BEGIN
            pg8::Gemm g{XB, (const bf16_t*)(ws + (size_t)(layer & 1) * WSZ + W_GU), Dm, Dm, Dm, 1 << 30, 0};
            pg8::StaticOrder S; S.init(M, 2 * FF, G, bx);
            EpiGU E{RSA, Hb};
            if ON(10) pg8::gemm_phase(lds, g, S, E);
        PHASE_END(10)
        PHASE_BEGIN
            pg8::Gemm g{Hb, (const bf16_t*)(ws + (size_t)(layer & 1) * WSZ + W_D), FF, FF, FF, 1 << 30, 0};
            pg8::StaticOrder S; S.init(M, Dm, G, bx);
            EpiRes E{P.out, P.out, XB, RSB};
            if ON(11) pg8::gemm_phase(lds, g, S, E);
        PHASE_END(11)
    }
    PHASE_BEGIN
        if ON(12) for (int r = gw; r < M; r += ngw) {
            f32x4* xr = (f32x4*)(P.out + (size_t)r * Dm) + lane;
            f32x4 v[4]; float ss = 0.f;
#pragma unroll
            for (int j = 0; j < 4; ++j) { v[j] = xr[64 * j]; ss += (v[j].x * v[j].x + v[j].y * v[j].y) + (v[j].z * v[j].z + v[j].w * v[j].w); }
            const float rs = rsqrtf(wave_sum(ss) * (1.0f / Dm) + EPS);
#pragma unroll
            for (int j = 0; j < 4; ++j) { const f32x4 gn = *((const f32x4*)P.final_norm + lane + 64 * j); xr[64 * j] = (f32x4){v[j].x * rs * gn.x, v[j].y * rs * gn.y, v[j].z * rs * gn.z, v[j].w * rs * gn.w}; }
        }
    PHASE_END(12)
#ifdef TS_A
    if (bx == 0 && threadIdx.x == 0) {
        LAS unsigned long long* TS_ = (LAS unsigned long long*)(lds + 131072);
        unsigned long long a = 0;
        for (int i = 0; i < 15; ++i) { if ((TS_A >> i) & 1) a += TS_[i]; }
        const unsigned long long t_end = __builtin_amdgcn_s_memrealtime() + a;
        while (__builtin_amdgcn_s_memrealtime() < t_end) __builtin_amdgcn_s_sleep(20);
    }
#endif
}
constexpr int NPHASES = 2 + 8 * DEPTH;

#ifndef MK_PER_PHASE
#define MK_PER_PHASE 0
#endif

extern "C" void kernel_launch(void* const* d_in, const int* in_sizes, int n_in, void* d_out, int out_size, void* d_ws, size_t ws_size, hipStream_t stream) {
    static int grid = 0;
    if (grid == 0) {
        if (n_in != 16 || out_size != M * Dm || ws_size < WS_END) { fprintf(stderr, "kernel_launch: unexpected sizes (n_in %d, out %d, ws %zu, need %zu)\n", n_in, out_size, ws_size, (size_t)WS_END); grid = -1; return; }
        int dev = 0, cus = 0, per_cu = 0;
        (void)hipGetDevice(&dev);
        (void)hipDeviceGetAttribute(&cus, hipDeviceAttributeMultiprocessorCount, dev);
        if (hipFuncSetAttribute((const void*)fwd_kernel, hipFuncAttributeMaxDynamicSharedMemorySize, LDS_BYTES) != hipSuccess) { fprintf(stderr, "kernel_launch: hipFuncSetAttribute failed\n"); grid = -1; return; }
        (void)hipOccupancyMaxActiveBlocksPerMultiprocessor(&per_cu, (const void*)fwd_kernel, 512, LDS_BYTES);
        (void)hipGetLastError();
        if (per_cu < 1) per_cu = 1;
        grid = cus * 1;
        fprintf(stderr, "kernel_launch: grid %d (per_cu %d), ws %zu need %zu\n", grid, per_cu, ws_size, (size_t)WS_END);
    }
    if (grid < 0) return;
    Ptrs p{};
    p.x = (const float*)d_in[0]; p.pos = (const int*)d_in[1]; p.w_in = (const float*)d_in[2]; p.da_lambda = (const float*)d_in[3]; p.da_norm = (const float*)d_in[4];
    p.hg_lb = (const float*)d_in[5]; p.hg_norm = (const float*)d_in[6]; p.w_a = (const float*)d_in[7]; p.w_b = (const float*)d_in[8]; p.w_o = (const float*)d_in[9];
    p.attn_norm = (const float*)d_in[10]; p.ffn_norm = (const float*)d_in[11]; p.w_gate = (const float*)d_in[12]; p.w_up = (const float*)d_in[13]; p.w_down = (const float*)d_in[14];
    p.final_norm = (const float*)d_in[15];
    p.out = (float*)d_out; p.ws = (unsigned char*)d_ws;
    (void)hipMemsetAsync((char*)d_ws + OFF_BAR, 0, BAR_BYTES, stream);
#if MK_PER_PHASE
    for (int ph = 0; ph < NPHASES; ++ph) {
        p.ph_lo = ph; p.ph_hi = ph + 1;
        hipLaunchKernelGGL(fwd_kernel, dim3(grid), dim3(512), LDS_BYTES, stream, p);
    }
#else
    p.ph_lo = 0; p.ph_hi = NPHASES;
    void* args[] = {&p};
    hipError_t e = hipLaunchCooperativeKernel((const void*)fwd_kernel, dim3(grid), dim3(512), args, LDS_BYTES, stream);
    if (e != hipSuccess) fprintf(stderr, "cooperative launch failed: %s (grid %d)\n", hipGetErrorString(e), grid);
#endif
}
```

```cpp
#include <hip/hip_runtime.h>
#include <hip/hip_cooperative_groups.h>
#include <cstdio>
#include <cstdint>
namespace cg = cooperative_groups;

#define LAS __attribute__((address_space(3)))
typedef unsigned short bf16_t;
typedef short bf16x8 __attribute__((ext_vector_type(8)));
typedef short s16x4 __attribute__((ext_vector_type(4)));
typedef float f32x4 __attribute__((ext_vector_type(4)));
typedef float f32x16 __attribute__((ext_vector_type(16)));
typedef unsigned u32x4 __attribute__((ext_vector_type(4)));
typedef unsigned u32x2 __attribute__((ext_vector_type(2)));

constexpr int Dm = 1024, NB = 4, SEQ = 4096, M = NB * SEQ, DEPTH = 4, FF = 2816, INW = 6144;
constexpr float EPS = 1e-6f;
constexpr float LOG2E = 1.4426950408889634f;

constexpr size_t W_IN = 0, W_AB = 12582912, W_O2 = 14680064, W_GU = 18874368, W_D = 30408704, WSZ = 36175872;
constexpr size_t MiB = 1048576;
constexpr size_t OFF_XB = 2 * WSZ;
constexpr size_t OFF_RSA = OFF_XB + 32 * MiB;
constexpr size_t OFF_RSB = OFF_RSA + MiB;
constexpr size_t OFF_CS = OFF_RSB + MiB;
constexpr size_t OFF_LB = OFF_CS + MiB;
constexpr size_t OFF_LAM = OFF_LB + 16384;
constexpr size_t OFF_DG = OFF_LAM + 256;
constexpr size_t OFF_EG = OFF_DG + MiB;
constexpr size_t OFF_B = OFF_EG + MiB;
constexpr size_t OFF_GATE = OFF_B;
constexpr size_t OFF_Q = OFF_B, OFF_K = OFF_B + 16 * MiB, OFF_V = OFF_B + 32 * MiB;
constexpr size_t OFF_HQ = OFF_B + 64 * MiB;
constexpr size_t OFF_HV = OFF_HQ + 16 * MiB;
constexpr size_t OFF_GF = OFF_HV + 16 * MiB;
constexpr size_t OFF_GB = OFF_GF + 32 * MiB;
constexpr size_t OFF_Y = OFF_GF;
constexpr size_t OFF_BG = OFF_GB + 32 * MiB;
constexpr size_t OFF_AO = OFF_BG + 16 * MiB;
constexpr size_t OFF_UT = OFF_AO + 32 * MiB;
constexpr size_t OFF_H = OFF_B;
constexpr size_t OFF_BAR = OFF_UT + 64 * MiB;
constexpr size_t BAR_BYTES = 16384;
constexpr size_t WS_END = OFF_BAR + BAR_BYTES;

constexpr int LDS_BYTES = 131072 + 2048;

__device__ __forceinline__ unsigned f2bf(float f) { unsigned u = __builtin_bit_cast(unsigned, f); return (u + 0x7fffu + ((u >> 16) & 1u)) >> 16; }
typedef float f32x2_t __attribute__((ext_vector_type(2)));
typedef __bf16 bf16x2_t __attribute__((ext_vector_type(2)));
__device__ __forceinline__ unsigned pk2(float lo, float hi) { f32x2_t v = {lo, hi}; bf16x2_t b = __builtin_convertvector(v, bf16x2_t); return __builtin_bit_cast(unsigned, b); }
__device__ __forceinline__ float bf2f(unsigned short b) { return __builtin_bit_cast(float, (unsigned)b << 16); }
__device__ __forceinline__ float bflo(unsigned u) { return __builtin_bit_cast(float, u << 16); }
__device__ __forceinline__ float bfhi(unsigned u) { return __builtin_bit_cast(float, u & 0xffff0000u); }
__device__ __forceinline__ float sigmoidf_(float x) { return 1.0f / (1.0f + __expf(-x)); }

namespace pg8 {
constexpr int BM = 256, BK = 64, HALF = 128, HTB = HALF * BK * 2, STAGE_BYTES = 8 * HTB, NXCD = 8, WGM = 8;
__host__ __device__ __forceinline__ int lds_byte(int r, int c) { const int st = (r >> 4) * 2 + (c >> 5), rr = r & 15, cc = c & 31, ob = rr * 64 + cc * 2; return st * 1024 + (ob ^ (((ob >> 9) & 1) << 5)); }
__host__ __device__ __forceinline__ void stage_rc(int b, int& R, int& C) { const int st = b / 1024, sb = b % 1024, swz = sb ^ (((sb >> 9) & 1) << 5); R = (st >> 1) * 16 + swz / 64; C = (st & 1) * 32 + (swz % 64) / 2; }
__host__ __device__ __forceinline__ int perm32(int rho) { const int n = rho >> 4, i = rho & 15; return 8 * (i >> 2) + 4 * n + (i & 3); }

struct Unit { int pm, pn; };
struct Gemm { const bf16_t* A; const bf16_t* Bt; int lda, ldb, K; int split_pn; int split_aoff; };

struct StaticOrder {
    int nM, nN, nwg, G, c;
    __device__ __forceinline__ void init(int M_, int N_, int G_, int c_) { nM = M_ / BM; nN = N_ / BM; nwg = nM * nN; G = G_; c = c_; }
    __device__ bool next(int i, Unit& u) const {
        const long L = (long)i * G + c; if (L >= nwg) return false;
        int wgid = (int)L; { const int q = nwg / NXCD, r = nwg % NXCD, xcd = wgid % NXCD, off = wgid / NXCD; wgid = (xcd < r ? xcd * (q + 1) : r * (q + 1) + (xcd - r) * q) + off; }
        const int nig = WGM * nN, gid = wgid / nig, fm = gid * WGM, gsz = (nM - fm) < WGM ? (nM - fm) : WGM;
        u.pm = fm + ((wgid % nig) % gsz); u.pn = (wgid % nig) / gsz; return true;
    }
};

template <class Epi>
__device__ __forceinline__ void gemm_phase(LAS unsigned char* lds, const Gemm g, const StaticOrder& S, const Epi& E) {
    int tid_ = threadIdx.x; asm volatile("" : "+v"(tid_));
    const int tid = tid_, wid = __builtin_amdgcn_readfirstlane(tid >> 6), lane = tid & 63, wr = wid >> 2, wc = wid & 3, fr = lane & 15, fq = lane >> 4;
    const int K = g.K, nt = K / BK;
    unsigned voffA[2], voffB[2];
#pragma unroll
    for (int i = 0; i < 2; ++i) { int R, C; stage_rc(tid * 16 + i * 8192, R, C); const int Rb = (R & ~31) + perm32(R & 31);
        voffA[i] = (unsigned)(R * g.lda + C) * 2u; voffB[i] = (unsigned)(Rb * g.ldb + C) * 2u; }
    const size_t kstep = (size_t)(BK * 2);
    const size_t hstepA = (size_t)HALF * g.lda * 2, hstepB = (size_t)HALF * g.ldb * 2;
    const size_t tstepA = 2 * hstepA, tstepB = 2 * hstepB;
    const unsigned ldsw = (unsigned)wid * 1024u;
    const int aoff = lds_byte(wr * 64 + fr, fq * 8), boff = lds_byte(wc * 32 + fr, fq * 8);
#define PG8_SA(b, h) (((b) * 2 + (h)) * HTB)
#define PG8_SB(b, h) ((4 + (b) * 2 + (h)) * HTB)
#define PG8_STAGE(bufoff, gbase, voff) do { _Pragma("unroll") for (int _i = 0; _i < 2; ++_i) \
        __builtin_amdgcn_global_load_lds((const unsigned*)((const char*)(gbase) + (voff)[_i]), (LAS unsigned*)(lds + (bufoff) + ldsw + _i * 8192), 16, 0, 0); } while (0)
#define PG8_LDA(dst, b, h) do { _Pragma("unroll") for (int m = 0; m < 4; ++m) _Pragma("unroll") for (int k = 0; k < 2; ++k) dst[m][k] = *(const LAS bf16x8*)(lds + PG8_SA(b, h) + aoff + m * 2048 + k * 1024); } while (0)
#define PG8_LDB(dst, b, h) do { _Pragma("unroll") for (int n = 0; n < 2; ++n) _Pragma("unroll") for (int k = 0; k < 2; ++k) dst[n][k] = *(const LAS bf16x8*)(lds + PG8_SB(b, h) + boff + n * 2048 + k * 1024); } while (0)
#define PG8_MMA(ai, bj, At, Bt) do { __builtin_amdgcn_s_setprio(1); _Pragma("unroll") for (int m = 0; m < 4; ++m) _Pragma("unroll") for (int n = 0; n < 2; ++n) _Pragma("unroll") for (int k = 0; k < 2; ++k) \
        acc[ai][bj][m][n] = __builtin_amdgcn_mfma_f32_16x16x32_bf16(Bt[n][k], At[m][k], acc[ai][bj][m][n], 0, 0, 0); __builtin_amdgcn_s_setprio(0); } while (0)
#define PG8_WAIT_V(n) asm volatile("s_waitcnt vmcnt(" #n ")" ::: "memory")
#define PG8_WAIT_L(n) asm volatile("s_waitcnt lgkmcnt(" #n ")" ::: "memory")
#define PG8_BAR __builtin_amdgcn_s_barrier()
#define PG8_SCHED __builtin_amdgcn_sched_barrier(0)
#define PG8_UA(u) ((const char*)g.A + (size_t)(u).pm * tstepA + (((u).pn >= g.split_pn) ? (size_t)g.split_aoff * 2 : (size_t)0))
    Unit cur, nxt; int ui = 0;
    if (!S.next(0, cur)) return;
    f32x4 acc[2][2][4][2];
#pragma unroll
    for (int a = 0; a < 2; ++a)
#pragma unroll
        for (int b = 0; b < 2; ++b)
#pragma unroll
            for (int m = 0; m < 4; ++m)
#pragma unroll
                for (int n = 0; n < 2; ++n) acc[a][b][m][n] = (f32x4){0.f, 0.f, 0.f, 0.f};
    bf16x8 At[4][2], B0[2][2], B1[2][2];
    const char* cA = PG8_UA(cur); const char* cB = (const char*)g.Bt + (size_t)cur.pn * tstepB;
    PG8_STAGE(PG8_SB(0, 0), cB, voffB); PG8_STAGE(PG8_SB(0, 1), cB + hstepB, voffB); PG8_STAGE(PG8_SA(0, 0), cA, voffA); PG8_STAGE(PG8_SA(0, 1), cA + hstepA, voffA);
    if (wr == 1) PG8_BAR;
    PG8_WAIT_V(2); PG8_BAR;
    PG8_STAGE(PG8_SB(1, 0), cB + kstep, voffB); PG8_STAGE(PG8_SA(1, 0), cA + kstep, voffA); PG8_STAGE(PG8_SB(1, 1), cB + hstepB + kstep, voffB);
    PG8_WAIT_V(6); PG8_BAR;
    for (;;) {
        const bool has_next = S.next(ui + 1, nxt);
        const char* nA = has_next ? PG8_UA(nxt) : cA; const char* nB = has_next ? (const char*)g.Bt + (size_t)nxt.pn * tstepB : cB;
        for (int t = 0; t < nt; t += 2) {
            const bool last = (t == nt - 2);
            const char* a1 = cA + (size_t)(t + 1) * kstep;
            const char* a2 = last ? nA : cA + (size_t)(t + 2) * kstep; const char* b2 = last ? nB : cB + (size_t)(t + 2) * kstep;
            const char* a3 = a2 + kstep; const char* b3 = b2 + kstep;
            PG8_LDB(B0, 0, 0); PG8_LDB(B1, 0, 1); PG8_SCHED; PG8_LDA(At, 0, 0); PG8_STAGE(PG8_SA(1, 1), a1 + hstepA, voffA);
            PG8_WAIT_V(8); PG8_WAIT_L(0); PG8_BAR; PG8_MMA(0, 0, At, B0); PG8_MMA(0, 1, At, B1); PG8_BAR; PG8_SCHED;
            PG8_LDA(At, 0, 1); PG8_STAGE(PG8_SB(0, 0), b2, voffB); PG8_STAGE(PG8_SB(0, 1), b2 + hstepB, voffB); PG8_STAGE(PG8_SA(0, 0), a2, voffA);
            PG8_WAIT_V(8); PG8_WAIT_L(0); PG8_BAR; PG8_MMA(1, 0, At, B0); PG8_MMA(1, 1, At, B1); PG8_BAR; PG8_SCHED;
            PG8_LDB(B0, 1, 0); PG8_LDB(B1, 1, 1); PG8_SCHED; PG8_LDA(At, 1, 0); PG8_STAGE(PG8_SA(0, 1), a2 + hstepA, voffA);
            PG8_WAIT_V(8); PG8_WAIT_L(0); PG8_BAR; PG8_MMA(0, 0, At, B0); PG8_MMA(0, 1, At, B1); PG8_BAR; PG8_SCHED;
            PG8_LDA(At, 1, 1); PG8_STAGE(PG8_SB(1, 0), b3, voffB); PG8_STAGE(PG8_SB(1, 1), b3 + hstepB, voffB); PG8_STAGE(PG8_SA(1, 0), a3, voffA);
            PG8_WAIT_V(8); PG8_WAIT_L(0); PG8_BAR; PG8_MMA(1, 0, At, B0); PG8_MMA(1, 1, At, B1); PG8_BAR; PG8_SCHED;
        }
        if (wr == 0) PG8_BAR;
        E(acc, cur, wr, wc, fr, fq);
        if (!has_next) break;
#pragma unroll
        for (int a = 0; a < 2; ++a)
#pragma unroll
            for (int b = 0; b < 2; ++b)
#pragma unroll
                for (int m = 0; m < 4; ++m)
#pragma unroll
                    for (int n = 0; n < 2; ++n) acc[a][b][m][n] = (f32x4){0.f, 0.f, 0.f, 0.f};
        cur = nxt; cA = nA; cB = nB; ++ui;
        if (wr == 1) PG8_BAR;
    }
    PG8_WAIT_V(0);
    PG8_BAR;
#undef PG8_SA
#undef PG8_SB
#undef PG8_STAGE
#undef PG8_LDA
#undef PG8_LDB
#undef PG8_MMA
#undef PG8_UA
}
}

__device__ __forceinline__ float row_rs(const float* rsp, int row) {
    const f32x4* p = (const f32x4*)(rsp + (size_t)row * 16);
    f32x4 a = p[0], b = p[1], c = p[2], d = p[3];
    float s = ((a.x + a.y) + (a.z + a.w)) + ((b.x + b.y) + (b.z + b.w)) + ((c.x + c.y) + (c.z + c.w)) + ((d.x + d.y) + (d.z + d.w));
    return rsqrtf(s * (1.0f / Dm) + EPS);
}
__device__ __forceinline__ u32x4 pack8(const float* v) { u32x4 w; w.x = pk2(v[0], v[1]); w.y = pk2(v[2], v[3]); w.z = pk2(v[4], v[5]); w.w = pk2(v[6], v[7]); return w; }

struct EpiMix {
    const float* rsp; const float* cs; const float* lbF; const float* lbB;
    bf16_t *Q, *Kk, *V, *HQ, *HV, *BG; float *GF, *GB;
    __device__ __forceinline__ void operator()(const f32x4 (&acc)[2][2][4][2], const pg8::Unit& u, int wr, int wc, int fr, int fq) const {
        const int grp = u.pn >> 1;
#pragma unroll
        for (int ai = 0; ai < 2; ++ai)
#pragma unroll
            for (int m = 0; m < 4; ++m) {
                const int row = u.pm * 256 + ai * 128 + wr * 64 + m * 16 + fr;
                const float rs = row_rs(rsp, row);
                const int b = row >> 12, s = row & 4095;
#pragma unroll
                for (int bj = 0; bj < 2; ++bj) {
                    const int col = u.pn * 256 + bj * 128 + wc * 32 + fq * 8;
                    const int jj = col & 511;
                    float v[8];
#pragma unroll
                    for (int e = 0; e < 4; ++e) { v[e] = acc[ai][bj][m][0][e] * rs; v[4 + e] = acc[ai][bj][m][1][e] * rs; }
                    if (grp <= 1) {
                        const int d0 = jj & 63;
                        if (d0 < 16) {
                            const int gsel = d0 >> 3;
                            const f32x4 c4 = *(const f32x4*)(cs + (size_t)row * 16 + gsel * 4), s4 = *(const f32x4*)(cs + (size_t)row * 16 + 8 + gsel * 4);
#pragma unroll
                            for (int e = 0; e < 4; ++e) { const float t1 = v[e], t2 = v[4 + e]; v[e] = t1 * c4[e] - t2 * s4[e]; v[4 + e] = t2 * c4[e] + t1 * s4[e]; }
                        }
                        if (grp == 0) {
#pragma unroll
                            for (int e = 0; e < 8; ++e) v[e] *= 0.125f * LOG2E;
                        }
                        const int h = jj >> 7, c = (jj >> 6) & 1;
                        bf16_t* dst = (grp == 0 ? Q : Kk) + ((size_t)(((b * 4 + h) * 2 + c) * SEQ + s)) * 64 + d0;
                        *(u32x4*)dst = pack8(v);
                    } else if (grp == 2) {
                        const int h = jj >> 7, d0 = jj & 127;
                        *(u32x4*)(V + ((size_t)((b * 4 + h) * SEQ + s)) * 128 + d0) = pack8(v);
                    } else if (grp == 3) {
                        *(u32x4*)(HQ + (size_t)row * 512 + jj) = pack8(v);
                    } else if (grp == 4 || grp == 5) {
                        const float* lbp = (grp == 4 ? lbF : lbB) + jj;
                        const f32x4 l0 = *(const f32x4*)lbp, l1 = *(const f32x4*)(lbp + 4);
                        float gl[8];
#pragma unroll
                        for (int e = 0; e < 8; ++e) { const float lb = e < 4 ? l0[e] : l1[e - 4]; const float f = lb + (1.0f - lb) * sigmoidf_(v[e]); gl[e] = __logf(fmaxf(f, 1e-37f)); }
                        float* dst = (grp == 4 ? GF : GB) + (size_t)row * 512 + jj;
                        *(f32x4*)dst = (f32x4){gl[0], gl[1], gl[2], gl[3]}; *(f32x4*)(dst + 4) = (f32x4){gl[4], gl[5], gl[6], gl[7]};
                    } else if (grp == 6) {
                        *(u32x4*)(HV + (size_t)row * 512 + jj) = pack8(v);
                    } else {
#pragma unroll
                        for (int e = 0; e < 8; ++e) v[e] = sigmoidf_(v[e]);
                        *(u32x4*)(BG + (size_t)row * 512 + jj) = pack8(v);
                    }
                }
            }
    }
};

struct EpiGate {
    const float* rsp; bf16_t* G;
    __device__ __forceinline__ void operator()(const f32x4 (&acc)[2][2][4][2], const pg8::Unit& u, int wr, int wc, int fr, int fq) const {
#pragma unroll
        for (int ai = 0; ai < 2; ++ai)
#pragma unroll
            for (int m = 0; m < 4; ++m) {
                const int row = u.pm * 256 + ai * 128 + wr * 64 + m * 16 + fr;
                const float rs = row_rs(rsp, row);
#pragma unroll
                for (int bj = 0; bj < 2; ++bj) {
                    const int col = u.pn * 256 + bj * 128 + wc * 32 + fq * 8;
                    float v[8];
#pragma unroll
                    for (int e = 0; e < 4; ++e) { v[e] = sigmoidf_(acc[ai][bj][m][0][e] * rs); v[4 + e] = sigmoidf_(acc[ai][bj][m][1][e] * rs); }
                    *(u32x4*)(G + (size_t)row * 2048 + col) = pack8(v);
                }
            }
    }
};

struct EpiY {
    const bf16_t* G; bf16_t* Y;
    __device__ __forceinline__ void operator()(const f32x4 (&acc)[2][2][4][2], const pg8::Unit& u, int wr, int wc, int fr, int fq) const {
#pragma unroll
        for (int ai = 0; ai < 2; ++ai)
#pragma unroll
            for (int m = 0; m < 4; ++m) {
                const int row = u.pm * 256 + ai * 128 + wr * 64 + m * 16 + fr;
#pragma unroll
                for (int bj = 0; bj < 2; ++bj) {
                    const int col = u.pn * 256 + bj * 128 + wc * 32 + fq * 8;
                    const u32x4 gq = *(const u32x4*)(G + (size_t)row * 2048 + col);
                    float v[8];
                    v[0] = acc[ai][bj][m][0][0] * bflo(gq.x); v[1] = acc[ai][bj][m][0][1] * bfhi(gq.x);
                    v[2] = acc[ai][bj][m][0][2] * bflo(gq.y); v[3] = acc[ai][bj][m][0][3] * bfhi(gq.y);
                    v[4] = acc[ai][bj][m][1][0] * bflo(gq.z); v[5] = acc[ai][bj][m][1][1] * bfhi(gq.z);
                    v[6] = acc[ai][bj][m][1][2] * bflo(gq.w); v[7] = acc[ai][bj][m][1][3] * bfhi(gq.w);
                    *(u32x4*)(Y + (size_t)row * 2048 + col) = pack8(v);
                }
            }
    }
};

struct EpiRes {
    const float* xres; float* xout; bf16_t* XB; float* rsp;
    __device__ __forceinline__ void operator()(const f32x4 (&acc)[2][2][4][2], const pg8::Unit& u, int wr, int wc, int fr, int fq) const {
#pragma unroll
        for (int ai = 0; ai < 2; ++ai)
#pragma unroll
            for (int m = 0; m < 4; ++m) {
                const int row = u.pm * 256 + ai * 128 + wr * 64 + m * 16 + fr;
                float ss = 0.f;
#pragma unroll
                for (int bj = 0; bj < 2; ++bj) {
                    const int col = u.pn * 256 + bj * 128 + wc * 32 + fq * 8;
                    const float* xr = xres + (size_t)row * Dm + col;
                    const f32x4 x0 = *(const f32x4*)xr, x1 = *(const f32x4*)(xr + 4);
                    float v[8];
#pragma unroll
                    for (int e = 0; e < 4; ++e) { v[e] = x0[e] + acc[ai][bj][m][0][e]; v[4 + e] = x1[e] + acc[ai][bj][m][1][e]; }
#pragma unroll
                    for (int e = 0; e < 8; ++e) ss += v[e] * v[e];
                    float* xo = xout + (size_t)row * Dm + col;
                    *(f32x4*)xo = (f32x4){v[0], v[1], v[2], v[3]}; *(f32x4*)(xo + 4) = (f32x4){v[4], v[5], v[6], v[7]};
                    *(u32x4*)(XB + (size_t)row * Dm + col) = pack8(v);
                }
                ss += __shfl_xor(ss, 16); ss += __shfl_xor(ss, 32);
                if (fq == 0) rsp[(size_t)row * 16 + u.pn * 4 + wc] = ss;
            }
    }
};

struct EpiGU {
    const float* rsp; bf16_t* H;
    __device__ __forceinline__ void operator()(const f32x4 (&acc)[2][2][4][2], const pg8::Unit& u, int wr, int wc, int fr, int fq) const {
#pragma unroll
        for (int ai = 0; ai < 2; ++ai)
#pragma unroll
            for (int m = 0; m < 4; ++m) {
                const int row = u.pm * 256 + ai * 128 + wr * 64 + m * 16 + fr;
                const float rs = row_rs(rsp, row);
                const int col = u.pn * 128 + wc * 32 + fq * 8;
                float v[8];
#pragma unroll
                for (int n = 0; n < 2; ++n)
#pragma unroll
                    for (int e = 0; e < 4; ++e) { const float gg = acc[ai][0][m][n][e] * rs, uu = acc[ai][1][m][n][e] * rs; v[n * 4 + e] = gg * sigmoidf_(gg) * uu; }
                *(u32x4*)(H + (size_t)row * FF + col) = pack8(v);
            }
    }
};

__device__ __forceinline__ int rope_perm(int n) {
    const int d = n & 63; if (d >= 16) return n;
    const int g = d >> 3, e = d & 7; return (n & ~63) + ((e < 4) ? 4 * g + e : 8 + 4 * g + (e - 4));
}
__device__ __forceinline__ void conv_item(const float* src, int ld_src, int ks0, int c0  , int mode  ,
                                          const float* gain, bf16_t* dst, int ld_dst, int n0, int kd0, LAS float* scr, int lane) {
    const int n4 = lane & 7, kr = lane >> 3;
    int sc = c0 + 4 * n4;
    if (mode) { const int q = (sc & 63) >> 2; if (q == 1) sc += 4; else if (q == 2) sc -= 4; }
#pragma unroll
    for (int i = 0; i < 8; ++i) { const int kk = kr + 8 * i; f32x4 w = *(const f32x4*)(src + (size_t)(ks0 + kk) * ld_src + sc);
        if (gain) { const float gg = gain[ks0 + kk]; w.x *= gg; w.y *= gg; w.z *= gg; w.w *= gg; }
        LAS float* d = scr + kk * 33 + 4 * n4; d[0] = w.x; d[1] = w.y; d[2] = w.z; d[3] = w.w; }
    asm volatile("s_waitcnt lgkmcnt(0)" ::: "memory");
    const int c = lane & 7;
#pragma unroll
    for (int j = 0; j < 4; ++j) { const int n = (lane >> 3) + 8 * j; const LAS float* s = scr + (8 * c) * 33 + n;
        u32x4 o; o.x = pk2(s[0 * 33], s[1 * 33]); o.y = pk2(s[2 * 33], s[3 * 33]); o.z = pk2(s[4 * 33], s[5 * 33]); o.w = pk2(s[6 * 33], s[7 * 33]);
        *(u32x4*)(dst + (size_t)(n0 + n) * ld_dst + kd0 + 8 * c) = o; }
    asm volatile("s_waitcnt lgkmcnt(0)" ::: "memory");
}

struct Ptrs {
    const float *x; const int* pos; const float *w_in, *da_lambda, *da_norm, *hg_lb, *hg_norm, *w_a, *w_b, *w_o, *attn_norm, *ffn_norm, *w_gate, *w_up, *w_down, *final_norm;
    float* out; unsigned char* ws; int ph_lo, ph_hi;
};

__device__ __forceinline__ void convert_layer(const Ptrs& P, int layer, unsigned char* wbuf, LAS unsigned char* lds, int gw, int ngw, int wave, int lane) {
    LAS float* scr = (LAS float*)(lds + wave * 8704);
    constexpr int I_IN = 16 * 192, I_A = 8 * 32, I_B = 8 * 32, I_O = 32 * 32, I_GU = 16 * 176, I_D = 44 * 32;
    constexpr int NIT = I_IN + I_A + I_B + I_O + I_GU + I_D;
    for (int it = gw; it < NIT; it += ngw) {
        int r = it;
        if (r < I_IN) { const int kb = r / 192, nb = r % 192, n0 = nb * 32;
            conv_item(P.w_in + (size_t)layer * Dm * INW, INW, kb * 64, n0, n0 < 1024 ? 1 : 0, P.attn_norm + layer * Dm, (bf16_t*)(wbuf + W_IN), Dm, n0, kb * 64, scr, lane); continue; }
        r -= I_IN;
        if (r < I_A) { const int kb = r / 32, nb = r % 32;
            conv_item(P.w_a + (size_t)layer * 512 * Dm, Dm, kb * 64, nb * 32, 0, nullptr, (bf16_t*)(wbuf + W_AB), 512, nb * 32, kb * 64, scr, lane); continue; }
        r -= I_A;
        if (r < I_B) { const int kb = r / 32, nb = r % 32;
            conv_item(P.w_b + (size_t)layer * 512 * Dm, Dm, kb * 64, nb * 32, 0, nullptr, (bf16_t*)(wbuf + W_AB), 512, 1024 + nb * 32, kb * 64, scr, lane); continue; }
        r -= I_B;
        if (r < I_O) { const int kb = r / 32, nb = r % 32;
            conv_item(P.w_o + (size_t)layer * Dm * Dm, Dm, (kb * 64) & 1023, nb * 32, 0, nullptr, (bf16_t*)(wbuf + W_O2), 2048, nb * 32, kb * 64, scr, lane); continue; }
        r -= I_O;
        if (r < I_GU) { const int kb = r / 176, nb = r % 176, n0 = nb * 32, tile = n0 >> 8, rr = n0 & 255;
            const float* srcm = (rr < 128 ? P.w_gate : P.w_up) + (size_t)layer * Dm * FF;
            conv_item(srcm, FF, kb * 64, tile * 128 + (rr & 127), 0, P.ffn_norm + layer * Dm, (bf16_t*)(wbuf + W_GU), Dm, n0, kb * 64, scr, lane); continue; }
        r -= I_GU;
        { const int kb = r / 32, nb = r % 32;
            conv_item(P.w_down + (size_t)layer * FF * Dm, Dm, kb * 64, nb * 32, 0, nullptr, (bf16_t*)(wbuf + W_D), FF, nb * 32, kb * 64, scr, lane); }
    }
}

__device__ __forceinline__ float wave_sum(float v) {
#pragma unroll
    for (int o = 1; o < 64; o <<= 1) v += __shfl_xor(v, o);
    return v;
}
__device__ __forceinline__ void prologue(const Ptrs& P, LAS unsigned char* lds, int gw, int ngw, int wave, int lane) {
    unsigned char* ws = P.ws;
    bf16_t* XB = (bf16_t*)(ws + OFF_XB); float* rsb = (float*)(ws + OFF_RSB);
    for (int r = gw; r < M; r += ngw) {
        const f32x4* xr = (const f32x4*)(P.x + (size_t)r * Dm) + lane;
        float ss = 0.f;
#pragma unroll
        for (int j = 0; j < 4; ++j) { const f32x4 v = xr[64 * j]; ss += (v.x * v.x + v.y * v.y) + (v.z * v.z + v.w * v.w);
            u32x2 o; o.x = pk2(v.x, v.y); o.y = pk2(v.z, v.w); *((u32x2*)(XB + (size_t)r * Dm) + lane + 64 * j) = o; }
        ss = wave_sum(ss);
        if (lane < 16) rsb[(size_t)r * 16 + lane] = (lane == 0) ? ss : 0.f;
    }
    const int gt = gw * 64 + lane, ngt = ngw * 64;
    float* cs = (float*)(ws + OFF_CS);
    for (int i = gt; i < M * 8; i += ngt) {
        const int tok = i >> 3, f = i & 7;
        const double invf[8] = {1.0, 0.19392274474868576, 0.03760603093086393, 0.007292664737217109, 0.001414213562373095, 0.0002742481756762073, 5.318295896944988e-05, 1.031338537721246e-05};
        double fr;
        switch (f) { case 0: fr = invf[0]; break; case 1: fr = invf[1]; break; case 2: fr = invf[2]; break; case 3: fr = invf[3]; break; case 4: fr = invf[4]; break; case 5: fr = invf[5]; break; case 6: fr = invf[6]; break; default: fr = invf[7]; }
        const float ang32 = (float)P.pos[tok] * (float)fr;
        const double ang = (double)ang32;
        const double rev = ang * 0.15915494309189535;
        const double fracrev = rev - __builtin_floor(rev + 0.5);
        const float a = (float)(fracrev * 6.283185307179586);
        cs[(size_t)tok * 16 + f] = __cosf(a); cs[(size_t)tok * 16 + 8 + f] = __sinf(a);
    }
    float* LB = (float*)(ws + OFF_LB);
    for (int i = gt; i < 2 * 512; i += ngt) {
        const int d = i >> 9, k = i & 511;
        float l[4], mx = -1e30f;
#pragma unroll
        for (int j = 0; j < 4; ++j) { l[j] = P.hg_lb[(size_t)(d * 4 + j) * 512 + k]; mx = fmaxf(mx, l[j]); }
        float e[4], sum = 0.f;
#pragma unroll
        for (int j = 0; j < 4; ++j) { e[j] = __expf(l[j] - mx); sum += e[j]; }
        float cum = 0.f;
#pragma unroll
        for (int j = 0; j < 4; ++j) { if (j > 0) cum += e[j] / sum; LB[(size_t)(d * 4 + j) * 512 + k] = cum; }
    }
    if (gw == 0) {
        float* LAM = (float*)(ws + OFF_LAM);
        for (int l = 0; l < 4; ++l) {
            const float* p = P.da_lambda + l * 256;
            float a = wave_sum(p[lane] * p[64 + lane]), b = wave_sum(p[128 + lane] * p[192 + lane]);
            const float lam_init = 0.8f - 0.6f * __expf(-0.3f * (float)l);
            if (lane == 0) LAM[l] = __expf(a) - __expf(b) + lam_init;
        }
    }
}

constexpr int AT_KROW = 144, AT_VROW = 320, AT_K1 = 64 * AT_KROW, AT_V = 2 * AT_K1, AT_STG = AT_V + 64 * AT_VROW;
constexpr int AT_IMG_ROW = 132;
__device__ __forceinline__ s16x4 tr_read(const LAS unsigned char* p) { return __builtin_bit_cast(s16x4, __builtin_amdgcn_ds_read_tr16_b64_v4i16((LAS s16x4*)p)); }

__device__ __forceinline__ void attn_unit(int b, int h, int qb, const bf16_t* Q, const bf16_t* Kk, const bf16_t* V, bf16_t* AO, const float* gainA  , float one_minus_lam_init, float lam, LAS unsigned char* lds) {
    int tid_ = threadIdx.x; asm volatile("" : "+v"(tid_));
    const int tid = tid_, wave = __builtin_amdgcn_readfirstlane(tid >> 6), lane = tid & 63, c = wave >> 2, wq = wave & 3, r32 = lane & 31, hh = lane >> 5;
    const int q0 = qb * 128 + wq * 32;
    bf16x8 qf[4];
    { const bf16_t* Qp = Q + ((size_t)(((b * 4 + h) * 2 + c) * SEQ + q0 + r32)) * 64 + 8 * hh;
#pragma unroll
      for (int s = 0; s < 4; ++s) qf[s] = *(const bf16x8*)(Qp + 16 * s); }
    f32x16 o[4];
#pragma unroll
    for (int i = 0; i < 4; ++i)
#pragma unroll
        for (int e = 0; e < 16; ++e) o[i][e] = 0.f;
    float mrow = -1e30f, lrow = 0.f;
    const unsigned char* Kg0 = (const unsigned char*)(Kk + ((size_t)((b * 4 + h) * 2 + 0) * SEQ) * 64);
    const unsigned char* Kg1 = (const unsigned char*)(Kk + ((size_t)((b * 4 + h) * 2 + 1) * SEQ) * 64);
    const unsigned char* Vg = (const unsigned char*)(V + ((size_t)(b * 4 + h) * SEQ) * 128);
    const int lk = (tid >> 3) * AT_KROW + (tid & 7) * 16;
    const int lv0 = AT_V + (tid >> 4) * AT_VROW + (tid & 15) * 16, lv1 = lv0 + 32 * AT_VROW;
    u32x4 r0, r1, r2, r3;
    r0 = *(const u32x4*)(Kg0 + tid * 16); r1 = *(const u32x4*)(Kg1 + tid * 16); r2 = *(const u32x4*)(Vg + tid * 16); r3 = *(const u32x4*)(Vg + 8192 + tid * 16);
    *(LAS u32x4*)(lds + lk) = r0; *(LAS u32x4*)(lds + AT_K1 + lk) = r1; *(LAS u32x4*)(lds + lv0) = r2; *(LAS u32x4*)(lds + lv1) = r3;
    r0 = *(const u32x4*)(Kg0 + 8192 + tid * 16); r1 = *(const u32x4*)(Kg1 + 8192 + tid * 16);
    *(LAS u32x4*)(lds + AT_STG + lk) = r0; *(LAS u32x4*)(lds + AT_STG + AT_K1 + lk) = r1;
    __syncthreads();
    const int ka = c * AT_K1 + r32 * AT_KROW + hh * 16;
    const int va = AT_V + (4 * hh + ((lane & 15) >> 2)) * AT_VROW + ((lane >> 4) & 1) * 32 + (lane & 3) * 8;

#define AT_QK(sv, st) do { f32x16 t0_, t1_; _Pragma("unroll") for (int e = 0; e < 16; ++e) { t0_[e] = 0.f; t1_[e] = 0.f; } \
        _Pragma("unroll") for (int ks = 0; ks < 4; ++ks) { \
            const bf16x8 a0 = *(const LAS bf16x8*)(lds + (st) + ka + ks * 32), a1 = *(const LAS bf16x8*)(lds + (st) + ka + 32 * AT_KROW + ks * 32); \
            t0_ = __builtin_amdgcn_mfma_f32_32x32x16_bf16(a0, qf[ks], t0_, 0, 0, 0); t1_ = __builtin_amdgcn_mfma_f32_32x32x16_bf16(a1, qf[ks], t1_, 0, 0, 0); } \
        sv##0 = t0_; sv##1 = t1_; } while (0)
    f32x16 sA0, sA1, sB0, sB1;
    AT_QK(sA, 0);
#define AT_TILE(j, s0, s1, sn, STC  , STN  ) do { \
        if ((j) + 2 < 64) { const size_t go = (size_t)((j) + 2) * 8192; r0 = *(const u32x4*)(Kg0 + go + tid * 16); r1 = *(const u32x4*)(Kg1 + go + tid * 16); } \
        if ((j) + 1 < 64) { const size_t go = (size_t)((j) + 1) * 16384; r2 = *(const u32x4*)(Vg + go + tid * 16); r3 = *(const u32x4*)(Vg + go + 8192 + tid * 16); } \
        if ((j) + 1 < 64) AT_QK(sn, STN); \
        float mx = fmaxf(s0[0], s1[0]); \
        _Pragma("unroll") for (int e = 1; e < 16; ++e) mx = fmaxf(mx, fmaxf(s0[e], s1[e])); \
        mx = fmaxf(mx, __shfl_xor(mx, 32)); \
        if (__builtin_amdgcn_ballot_w64(mx > mrow + 8.0f) != 0ull) { \
            const float mnew = fmaxf(mrow, mx), alpha = __builtin_amdgcn_exp2f(mrow - mnew); mrow = mnew; lrow *= alpha; \
            _Pragma("unroll") for (int i = 0; i < 4; ++i) _Pragma("unroll") for (int e = 0; e < 16; ++e) o[i][e] *= alpha; } \
        float ls = 0.f; \
        _Pragma("unroll") for (int e = 0; e < 16; ++e) { s0[e] = __builtin_amdgcn_exp2f(s0[e] - mrow); s1[e] = __builtin_amdgcn_exp2f(s1[e] - mrow); ls += s0[e] + s1[e]; } \
        lrow += ls; \
        bf16x8 pf[2][2]; \
        _Pragma("unroll") for (int s = 0; s < 2; ++s) { u32x4 w0, w1; \
            w0.x = pk2(s0[8 * s + 0], s0[8 * s + 1]); w0.y = pk2(s0[8 * s + 2], s0[8 * s + 3]); w0.z = pk2(s0[8 * s + 4], s0[8 * s + 5]); w0.w = pk2(s0[8 * s + 6], s0[8 * s + 7]); \
            w1.x = pk2(s1[8 * s + 0], s1[8 * s + 1]); w1.y = pk2(s1[8 * s + 2], s1[8 * s + 3]); w1.z = pk2(s1[8 * s + 4], s1[8 * s + 5]); w1.w = pk2(s1[8 * s + 6], s1[8 * s + 7]); \
            pf[0][s] = __builtin_bit_cast(bf16x8, w0); pf[1][s] = __builtin_bit_cast(bf16x8, w1); } \
        _Pragma("unroll") for (int kb = 0; kb < 2; ++kb) _Pragma("unroll") for (int s = 0; s < 2; ++s) { \
            const LAS unsigned char* vb = lds + (STC) + va + (32 * kb + 16 * s) * AT_VROW; \
            _Pragma("unroll") for (int vt = 0; vt < 4; ++vt) { \
                const s16x4 t0 = tr_read(vb + vt * 64), t1 = tr_read(vb + vt * 64 + 8 * AT_VROW); \
                const bf16x8 av = {t0[0], t0[1], t0[2], t0[3], t1[0], t1[1], t1[2], t1[3]}; \
                o[vt] = __builtin_amdgcn_mfma_f32_32x32x16_bf16(av, pf[kb][s], o[vt], 0, 0, 0); } } \
        if ((j) + 2 < 64) { *(LAS u32x4*)(lds + (STC) + lk) = r0; *(LAS u32x4*)(lds + (STC) + AT_K1 + lk) = r1; } \
        if ((j) + 1 < 64) { *(LAS u32x4*)(lds + (STN) + lv0) = r2; *(LAS u32x4*)(lds + (STN) + lv1) = r3; } \
        __syncthreads(); } while (0)
    for (int j = 0; j < 64; j += 2) {
        AT_TILE(j, sA0, sA1, sB, 0, AT_STG);
        AT_TILE(j + 1, sB0, sB1, sA, AT_STG, 0);
    }
#undef AT_TILE
#undef AT_QK
    const float inv = 1.0f / (lrow + __shfl_xor(lrow, 32));
    LAS float* img = (LAS float*)lds;
    const int qrow = wq * 32 + r32;
    if (c == 1) {
        const float sc = -lam * inv;
#pragma unroll
        for (int vt = 0; vt < 4; ++vt)
#pragma unroll
            for (int g = 0; g < 4; ++g)
                *(LAS f32x4*)(img + qrow * AT_IMG_ROW + 32 * vt + 8 * g + 4 * hh) = (f32x4){o[vt][4 * g] * sc, o[vt][4 * g + 1] * sc, o[vt][4 * g + 2] * sc, o[vt][4 * g + 3] * sc};
    }
    __syncthreads();
    if (c == 0) {
#pragma unroll
        for (int vt = 0; vt < 4; ++vt)
#pragma unroll
            for (int g = 0; g < 4; ++g) {
                LAS f32x4* p = (LAS f32x4*)(img + qrow * AT_IMG_ROW + 32 * vt + 8 * g + 4 * hh);
                f32x4 t = *p;
                t.x += o[vt][4 * g] * inv; t.y += o[vt][4 * g + 1] * inv; t.z += o[vt][4 * g + 2] * inv; t.w += o[vt][4 * g + 3] * inv;
                *p = t;
            }
    }
    __syncthreads();
    {
        const int q = tid >> 2, part = tid & 3;
        float v[32]; float ss = 0.f;
#pragma unroll
        for (int i = 0; i < 8; ++i) { const f32x4 t = *(const LAS f32x4*)(img + q * AT_IMG_ROW + 32 * part + 4 * i); v[4 * i] = t.x; v[4 * i + 1] = t.y; v[4 * i + 2] = t.z; v[4 * i + 3] = t.w;
            ss += (t.x * t.x + t.y * t.y) + (t.z * t.z + t.w * t.w); }
        ss += __shfl_xor(ss, 1); ss += __shfl_xor(ss, 2);
        const float rs = rsqrtf(ss * (1.0f / 128.0f) + EPS) * one_minus_lam_init;
        const float* gp = gainA + h * 128 + 32 * part;
        bf16_t* dst = AO + ((size_t)(b * SEQ + qb * 128 + q)) * 1024 + h * 128 + 32 * part;
#pragma unroll
        for (int i = 0; i < 4; ++i) {
            const f32x4 g0 = *(const f32x4*)(gp + 8 * i), g1 = *(const f32x4*)(gp + 8 * i + 4);
            u32x4 w; w.x = pk2(v[8 * i] * rs * g0.x, v[8 * i + 1] * rs * g0.y); w.y = pk2(v[8 * i + 2] * rs * g0.z, v[8 * i + 3] * rs * g0.w);
            w.z = pk2(v[8 * i + 4] * rs * g1.x, v[8 * i + 5] * rs * g1.y); w.w = pk2(v[8 * i + 6] * rs * g1.z, v[8 * i + 7] * rs * g1.w);
            *(u32x4*)(dst + 8 * i) = w;
        }
    }
    __syncthreads();
}

constexpr int HG_SEG = 0;
constexpr int HG_F = 2048;
constexpr int HG_PART = 2560;
constexpr int HG_V = 4096;
constexpr int HG_VROW = 288;
constexpr int HG_A = HG_V + 64 * HG_VROW;
constexpr int HG_KTROW = 144, HG_QKROW = 272;
constexpr int HG_Bq = HG_A + 128 * HG_KTROW;

__device__ __forceinline__ void hg_cumsum(const float* G, int tok0, int h, int dir, int k, int j, LAS unsigned char* lds, float (&gv)[16], float (&d)[16], float& m_out, float& tot_out) {
    const float* gp = G + (size_t)(tok0 + 16 * j) * 512 + h * 128 + k;
#pragma unroll
    for (int i = 0; i < 16; ++i) gv[i] = gp[(size_t)i * 512];
    float run = 0.f;
    if (dir == 0) {
#pragma unroll
        for (int i = 0; i < 16; ++i) { run += gv[i]; d[i] = run; }
    } else {
#pragma unroll
        for (int i = 15; i >= 0; --i) { run += gv[i]; d[i] = run; }
    }
    LAS float* seg = (LAS float*)(lds + HG_SEG);
    seg[j * 128 + k] = run;
    __syncthreads();
    const float s0 = seg[k], s1 = seg[128 + k], s2 = seg[256 + k], s3 = seg[384 + k];
    float off, m;
    if (dir == 0) { off = (j > 0 ? s0 : 0.f) + (j > 1 ? s1 : 0.f) + (j > 2 ? s2 : 0.f); m = s0 + s1; }
    else { off = (j < 3 ? s3 : 0.f) + (j < 2 ? s2 : 0.f) + (j < 1 ? s1 : 0.f); m = s2 + s3; }
#pragma unroll
    for (int i = 0; i < 16; ++i) d[i] = d[i] + off - m;
    m_out = m; tot_out = (s0 + s1) + (s2 + s3);
}

__device__ __forceinline__ void hg_load_v(const bf16_t* HV, int tok0, int h, LAS unsigned char* lds, int tid) {
#pragma unroll
    for (int i = 0; i < 2; ++i) { const int ch = tid + 512 * i, p = ch >> 4, part = ch & 15;
        *(LAS u32x4*)(lds + HG_V + p * HG_VROW + part * 16) = *(const u32x4*)(HV + (size_t)(tok0 + p) * 512 + h * 128 + part * 8); }
}

__device__ __forceinline__ void hg1_unit(int u, const float* GF, const float* GB, const bf16_t* HV, bf16_t* UT, float* Dg, float* Eg, LAS unsigned char* lds) {
    int tid_ = threadIdx.x; asm volatile("" : "+v"(tid_));
    const int tid = tid_, wave = __builtin_amdgcn_readfirstlane(tid >> 6), lane = tid & 63;
    const int dir = u & 1, cch = (u >> 1) & 63, bh = u >> 7, b = bh >> 2, h = bh & 3;
    const int tok0 = b * SEQ + cch * 64, k = tid & 127, j = tid >> 7;
    float gv[16], d[16], m, tot;
    hg_cumsum(dir ? GB : GF, tok0, h, dir, k, j, lds, gv, d, m, tot);
    hg_load_v(HV, tok0, h, lds, tid);
    float kt[16];
#pragma unroll
    for (int i = 0; i < 16; ++i) kt[i] = (1.0f - __expf(gv[i])) * __expf(fminf(-d[i], 40.f));
    { u32x4 w0, w1;
      w0.x = pk2(kt[0], kt[1]); w0.y = pk2(kt[2], kt[3]); w0.z = pk2(kt[4], kt[5]); w0.w = pk2(kt[6], kt[7]);
      w1.x = pk2(kt[8], kt[9]); w1.y = pk2(kt[10], kt[11]); w1.z = pk2(kt[12], kt[13]); w1.w = pk2(kt[14], kt[15]);
      *(LAS u32x4*)(lds + HG_A + k * HG_KTROW + j * 32) = w0; *(LAS u32x4*)(lds + HG_A + k * HG_KTROW + j * 32 + 16) = w1; }
    if (j == 0) { ((LAS float*)(lds + HG_F))[k] = __expf(tot - m); Dg[(size_t)u * 128 + k] = __expf(tot); Eg[(size_t)u * 128 + k] = __expf(m); }
    __syncthreads();
    const int i16 = lane & 15, g4 = lane >> 4;
    bf16x8 af[2];
#pragma unroll
    for (int s = 0; s < 2; ++s) {
        const LAS unsigned char* ap = lds + HG_A + (16 * wave + i16) * HG_KTROW + (32 * s + 4 * g4) * 2;
        const u32x2 lo = *(const LAS u32x2*)ap, hi = *(const LAS u32x2*)(ap + 32);
        af[s] = __builtin_bit_cast(bf16x8, (u32x4){lo.x, lo.y, hi.x, hi.y});
    }
    const f32x4 fsc = *(const LAS f32x4*)(lds + HG_F + (16 * wave + 4 * g4) * 4);
    const LAS unsigned char* vbase = lds + HG_V + (4 * g4 + (i16 >> 2)) * HG_VROW + (i16 & 3) * 8;
#pragma unroll
    for (int vt = 0; vt < 8; ++vt) {
        f32x4 acc = {0.f, 0.f, 0.f, 0.f};
#pragma unroll
        for (int s = 0; s < 2; ++s) {
            const s16x4 t0 = tr_read(vbase + (32 * s) * HG_VROW + vt * 32), t1 = tr_read(vbase + (32 * s + 16) * HG_VROW + vt * 32);
            const bf16x8 bv = {t0[0], t0[1], t0[2], t0[3], t1[0], t1[1], t1[2], t1[3]};
            acc = __builtin_amdgcn_mfma_f32_16x16x32_bf16(af[s], bv, acc, 0, 0, 0);
        }
        u32x2 w; w.x = pk2(acc[0] * fsc[0], acc[1] * fsc[1]); w.y = pk2(acc[2] * fsc[2], acc[3] * fsc[3]);
        *(u32x2*)(UT + ((size_t)u * 128 + 16 * vt + i16) * 128 + 16 * wave + 4 * g4) = w;
    }
    __syncthreads();
}

__device__ __forceinline__ void hg2_scan(bf16_t* UT, const float* Dg, const float* Eg, int gthread, int nthreads) {
    for (int idx = gthread; idx < 32 * 4096; idx += nthreads) {
        const int chain = idx >> 12, e4 = idx & 4095, v = e4 >> 5, k0 = (e4 & 31) * 4;
        const int dir = chain & 1, bh = chain >> 1;
        float S0 = 0.f, S1 = 0.f, S2 = 0.f, S3 = 0.f;
        int u = (bh * 64 + (dir ? 63 : 0)) * 2 + dir;
        const int ustep = dir ? -2 : 2;
        u32x2 uu[4]; f32x4 dd[4], ee[4];
#pragma unroll
        for (int r = 0; r < 4; ++r) { const int ur = u + r * ustep; uu[r] = *(const u32x2*)(UT + ((size_t)ur * 128 + v) * 128 + k0); dd[r] = *(const f32x4*)(Dg + (size_t)ur * 128 + k0); ee[r] = *(const f32x4*)(Eg + (size_t)ur * 128 + k0); }
        for (int cc = 0; cc < 64; cc += 4) {
#pragma unroll
            for (int r = 0; r < 4; ++r) {
                const u32x2 uc = uu[r]; const f32x4 dc = dd[r], ec = ee[r];
                if (cc + 4 < 64) { const int un = u + 4 * ustep; uu[r] = *(const u32x2*)(UT + ((size_t)un * 128 + v) * 128 + k0); dd[r] = *(const f32x4*)(Dg + (size_t)un * 128 + k0); ee[r] = *(const f32x4*)(Eg + (size_t)un * 128 + k0); }
                u32x2 w; w.x = pk2(ec.x * S0, ec.y * S1); w.y = pk2(ec.z * S2, ec.w * S3);
                *(u32x2*)(UT + ((size_t)u * 128 + v) * 128 + k0) = w;
                S0 = dc.x * S0 + bflo(uc.x); S1 = dc.y * S1 + bfhi(uc.x); S2 = dc.z * S2 + bflo(uc.y); S3 = dc.w * S3 + bfhi(uc.y);
                u += ustep;
            }
        }
    }
}

__device__ __forceinline__ void hg3_unit(int u3, const float* GF, const float* GB, const bf16_t* HQ, const bf16_t* HV, const bf16_t* ST, const bf16_t* BG, const float* gainH, bf16_t* AO, LAS unsigned char* lds) {
    int tid_ = threadIdx.x; asm volatile("" : "+v"(tid_));
    const int tid = tid_, wave = __builtin_amdgcn_readfirstlane(tid >> 6), lane = tid & 63;
    const int cch = u3 & 63, bh = u3 >> 6, b = bh >> 2, h = bh & 3;
    const int tok0 = b * SEQ + cch * 64, k = tid & 127, j = tid >> 7;
    const int tb = wave & 3, vh = wave >> 2, i16 = lane & 15, g4 = lane >> 4;
    f32x4 oacc[4];
#pragma unroll
    for (int i = 0; i < 4; ++i) oacc[i] = (f32x4){0.f, 0.f, 0.f, 0.f};
    hg_load_v(HV, tok0, h, lds, tid);
    for (int dir = 0; dir < 2; ++dir) {
        float gv[16], d[16], m, tot;
        hg_cumsum(dir ? GB : GF, tok0, h, dir, k, j, lds, gv, d, m, tot);
        const bf16_t* qp = HQ + (size_t)(tok0 + 16 * j) * 512 + h * 128 + k;
#pragma unroll
        for (int i = 0; i < 16; ++i) {
            const float kt = (1.0f - __expf(gv[i])) * __expf(fminf(-d[i], 40.f));
            const float qt = bf2f(qp[(size_t)i * 512]) * __expf(fminf(d[i], 40.f));
            *(LAS unsigned short*)(lds + HG_A + (16 * j + i) * HG_QKROW + k * 2) = (unsigned short)f2bf(kt);
            *(LAS unsigned short*)(lds + HG_Bq + (16 * j + i) * HG_QKROW + k * 2) = (unsigned short)f2bf(qt);
        }
        __syncthreads();
        f32x4 pt[4];
#pragma unroll
        for (int sg = 0; sg < 4; ++sg) pt[sg] = (f32x4){0.f, 0.f, 0.f, 0.f};
        bf16x8 qa[4];
#pragma unroll
        for (int ks = 0; ks < 4; ++ks) qa[ks] = *(const LAS bf16x8*)(lds + HG_Bq + (16 * tb + i16) * HG_QKROW + (32 * ks + 8 * g4) * 2);
#pragma unroll
        for (int sg = 0; sg < 4; ++sg)
#pragma unroll
            for (int ks = 0; ks < 4; ++ks) {
                const bf16x8 ka = *(const LAS bf16x8*)(lds + HG_A + (16 * sg + i16) * HG_QKROW + (32 * ks + 8 * g4) * 2);
                pt[sg] = __builtin_amdgcn_mfma_f32_16x16x32_bf16(ka, qa[ks], pt[sg], 0, 0, 0);
            }
        const int tcol = 16 * tb + i16;
#pragma unroll
        for (int sg = 0; sg < 4; ++sg)
#pragma unroll
            for (int e = 0; e < 4; ++e) { const int srow = 16 * sg + 4 * g4 + e; const bool keep = dir ? (srow >= tcol) : (srow <= tcol); pt[sg][e] = keep ? pt[sg][e] : 0.f; }
        bf16x8 pa[2];
#pragma unroll
        for (int s2 = 0; s2 < 2; ++s2) {
            u32x4 w; w.x = pk2(pt[2 * s2][0], pt[2 * s2][1]); w.y = pk2(pt[2 * s2][2], pt[2 * s2][3]); w.z = pk2(pt[2 * s2 + 1][0], pt[2 * s2 + 1][1]); w.w = pk2(pt[2 * s2 + 1][2], pt[2 * s2 + 1][3]);
            pa[s2] = __builtin_bit_cast(bf16x8, w);
        }
        const LAS unsigned char* vbase = lds + HG_V + (4 * g4 + (i16 >> 2)) * HG_VROW + (i16 & 3) * 8;
        const bf16_t* stp = ST + ((size_t)((bh * 64 + cch) * 2 + dir) * 128) * 128;
#pragma unroll
        for (int vv = 0; vv < 4; ++vv) {
            const int vt = 4 * vh + vv;
#pragma unroll
            for (int s2 = 0; s2 < 2; ++s2) {
                const s16x4 t0 = tr_read(vbase + (32 * s2) * HG_VROW + vt * 32), t1 = tr_read(vbase + (32 * s2 + 16) * HG_VROW + vt * 32);
                const bf16x8 bv = {t0[0], t0[1], t0[2], t0[3], t1[0], t1[1], t1[2], t1[3]};
                oacc[vv] = __builtin_amdgcn_mfma_f32_16x16x32_bf16(pa[s2], bv, oacc[vv], 0, 0, 0);
            }
#pragma unroll
            for (int ks = 0; ks < 4; ++ks) {
                const bf16x8 sb = *(const bf16x8*)(stp + (size_t)(16 * vt + i16) * 128 + 32 * ks + 8 * g4);
                oacc[vv] = __builtin_amdgcn_mfma_f32_16x16x32_bf16(qa[ks], sb, oacc[vv], 0, 0, 0);
            }
        }
        __syncthreads();
    }
    float ssq[4];
#pragma unroll
    for (int e = 0; e < 4; ++e) { float s = 0.f;
#pragma unroll
        for (int vv = 0; vv < 4; ++vv) s += oacc[vv][e] * oacc[vv][e];
        s += __shfl_xor(s, 1); s += __shfl_xor(s, 2); s += __shfl_xor(s, 4); s += __shfl_xor(s, 8); ssq[e] = s; }
    LAS float* part = (LAS float*)(lds + HG_PART);
    if (i16 == 0) {
#pragma unroll
        for (int e = 0; e < 4; ++e) part[vh * 64 + 16 * tb + 4 * g4 + e] = ssq[e];
    }
    __syncthreads();
#pragma unroll
    for (int e = 0; e < 4; ++e) {
        const int t = 16 * tb + 4 * g4 + e;
        const float rs = rsqrtf((part[t] + part[64 + t]) * (1.0f / 128.0f) + EPS);
#pragma unroll
        for (int vv = 0; vv < 4; ++vv) {
            const int v = 16 * (4 * vh + vv) + i16;
            const float gate = bf2f(BG[(size_t)(tok0 + t) * 512 + h * 128 + v]);
            AO[(size_t)(tok0 + t) * 1024 + 512 + h * 128 + v] = (bf16_t)f2bf(oacc[vv][e] * rs * gainH[h * 128 + v] * gate);
        }
    }
    __syncthreads();
}

#define XB_TMO      128
#define XB_XCNT(j)  (256  + 64 * (j))
#define XB_XSUB(j)  (1280 + 64 * (j))
#define XB_XGEN(j)  (2304 + 64 * (j))
#define XB_TOP      3328
#define XB_TOPGEN   3392
#define XCD_BAR_WORDS 3456
#define XB_SPIN_CAP (1u << 18)

__device__ __forceinline__ unsigned xb_ld(unsigned* p)              { return __hip_atomic_load(p, __ATOMIC_RELAXED, __HIP_MEMORY_SCOPE_AGENT); }
__device__ __forceinline__ unsigned xb_add(unsigned* p, unsigned v) { return __hip_atomic_fetch_add(p, v, __ATOMIC_RELAXED, __HIP_MEMORY_SCOPE_AGENT); }
__device__ __forceinline__ unsigned xb_xcc_id() { return (unsigned)__builtin_amdgcn_s_getreg((3 << 11) | 20) & 0xFu; }
#define XB_SPIN(cond, bar) do { unsigned _sp = 0; while (cond) { __builtin_amdgcn_s_sleep(1); \
    if ((++_sp & 255u) == 0u) { if (xb_ld(&(bar)[XB_TMO])) break; if (_sp > XB_SPIN_CAP) { atomicAdd(&(bar)[XB_TMO], 1u); break; } } } } while (0)

struct XcdBarrier {
    unsigned* bar; unsigned x;
    volatile LAS unsigned* st;
};

__device__ __forceinline__ XcdBarrier xcd_barrier_post(unsigned* bar, volatile LAS unsigned* st) {
    XcdBarrier b; b.bar = bar; b.x = xb_xcc_id(); b.st = st;
    if (threadIdx.x == 0) (void)xb_add(&bar[XB_XCNT(b.x)], 1u);
    return b;
}
__device__ __forceinline__ void xcd_barrier_complete(unsigned* bar, unsigned x, unsigned& nloc, unsigned& nx) {
    const unsigned G = gridDim.x * gridDim.y * gridDim.z;
    unsigned sum, cnt, mine, sp = 0u;
    for (;;) {
        sum = 0u; cnt = 0u; mine = 0u;
#pragma unroll
        for (unsigned j = 0; j < 16; ++j) { const unsigned c = xb_ld(&bar[XB_XCNT(j)]); sum += c; cnt += (c > 0u) ? 1u : 0u; mine = (j == x) ? c : mine; }
        if (sum == G) break;
        __builtin_amdgcn_s_sleep(1);
        if ((++sp & 255u) == 0u) { if (xb_ld(&bar[XB_TMO])) break; if (sp > XB_SPIN_CAP) { atomicAdd(&bar[XB_TMO], 1u); break; } }
    }
    nloc = mine > 0u ? mine : 1u; nx = cnt > 0u ? cnt : 1u;
}

__device__ __forceinline__ void xcd_barrier(const XcdBarrier& b) {
    asm volatile("s_waitcnt vmcnt(0)" ::: "memory");
    __syncthreads();
    if (threadIdx.x == 0) {
        unsigned* bar = b.bar;
        __builtin_amdgcn_s_waitcnt(0);
        unsigned nloc = b.st[0], nx = b.st[1];
        if (nloc == 0u) { xcd_barrier_complete(bar, b.x, nloc, nx); b.st[0] = nloc; b.st[1] = nx; }
        const unsigned old = xb_add(&bar[XB_XSUB(b.x)], 1u);
        const unsigned gen = old / nloc;
        if (old + 1u == (gen + 1u) * nloc) {
            __builtin_amdgcn_fence(__ATOMIC_RELEASE, "agent");
            asm volatile("s_waitcnt vmcnt(0)" ::: "memory");
            const unsigned og = xb_add(&bar[XB_TOP], 1u);
            const unsigned tg = og / nx;
            if (og + 1u == (tg + 1u) * nx) xb_add(&bar[XB_TOPGEN], 1u);
            else XB_SPIN(xb_ld(&bar[XB_TOPGEN]) == tg, bar);
            __builtin_amdgcn_fence(__ATOMIC_ACQUIRE, "agent");
            xb_add(&bar[XB_XGEN(b.x)], 1u);
            asm volatile("s_waitcnt vmcnt(0)" ::: "memory");
        } else {
            XB_SPIN(xb_ld(&bar[XB_XGEN(b.x)]) == gen, bar);
            __builtin_amdgcn_fence(__ATOMIC_ACQUIRE, "agent");
            asm volatile("s_waitcnt vmcnt(0)" ::: "memory");
        }
    }
    __syncthreads();
}

__global__ void __launch_bounds__(512, 2) fwd_kernel(Ptrs P) {
    extern __shared__ __attribute__((aligned(16))) unsigned char lds_raw[];
    LAS unsigned char* lds = (LAS unsigned char*)lds_raw;
    cg::grid_group grid = cg::this_grid();
    const int G = gridDim.x, bx = blockIdx.x;
    const int lo = P.ph_lo, hi = P.ph_hi;
    int ph = 0;
    if (threadIdx.x < 4) ((LAS unsigned*)(lds + 131072 + 1024))[threadIdx.x] = 0u;
    __syncthreads();
    XcdBarrier xbar = xcd_barrier_post((unsigned*)(P.ws + OFF_BAR), (volatile LAS unsigned*)(lds + 131072 + 1024));
#ifdef TS_A
    if (threadIdx.x == 0) { LAS unsigned long long* TS_ = (LAS unsigned long long*)(lds + 131072); for (int i = 0; i < 15; ++i) TS_[i] = 0ull; TS_[15] = __builtin_amdgcn_s_memrealtime(); }
#endif
#ifndef PH_MASK
#define PH_MASK 0xFFFFFFFFu
#endif
#define ON(id) constexpr (((PH_MASK) >> (id)) & 1u)
#define PHASE_BEGIN if (ph >= lo && ph < hi) { unsigned char* ws = P.ws; asm volatile("" : "+s"(ws)); int tid = threadIdx.x; asm volatile("" : "+v"(tid)); \
    const int lane = tid & 63, wave = __builtin_amdgcn_readfirstlane(tid >> 6), gw = bx * 8 + wave, ngw = G * 8; (void)lane; (void)gw; (void)ngw;
#define XB ((bf16_t*)(ws + OFF_XB))
#define RSA ((float*)(ws + OFF_RSA))
#define RSB ((float*)(ws + OFF_RSB))
#define CS ((const float*)(ws + OFF_CS))
#define LB ((const float*)(ws + OFF_LB))
#define LAM ((const float*)(ws + OFF_LAM))
#define Dg ((float*)(ws + OFF_DG))
#define Eg ((float*)(ws + OFF_EG))
#define GATE ((bf16_t*)(ws + OFF_GATE))
#define Qb ((bf16_t*)(ws + OFF_Q))
#define Kb ((bf16_t*)(ws + OFF_K))
#define Vb ((bf16_t*)(ws + OFF_V))
#define HQ ((bf16_t*)(ws + OFF_HQ))
#define HV ((bf16_t*)(ws + OFF_HV))
#define GF ((float*)(ws + OFF_GF))
#define GB ((float*)(ws + OFF_GB))
#define Yb ((bf16_t*)(ws + OFF_Y))
#define BG ((bf16_t*)(ws + OFF_BG))
#define AO ((bf16_t*)(ws + OFF_AO))
#define UT ((bf16_t*)(ws + OFF_UT))
#define Hb ((bf16_t*)(ws + OFF_H))
#ifdef TS_A
#define TICK(cat) do { if (bx == 0 && threadIdx.x == 0) { LAS unsigned long long* TS_ = (LAS unsigned long long*)(lds + 131072); const unsigned long long t_ = __builtin_amdgcn_s_memrealtime(); TS_[cat] += t_ - TS_[15]; TS_[15] = t_; } } while (0)
#else
#define TICK(cat) do { } while (0)
#endif
#define PHASE_END(cat)   TICK(cat); if (ph + 1 < hi) { if (ph == 0) grid.sync(); else xcd_barrier(xbar); TICK(13); } } ++ph;

    PHASE_BEGIN
        if ON(0) prologue(P, lds, gw, ngw, wave, lane);
        if ON(6) convert_layer(P, 0, ws, lds, gw, ngw, wave, lane);
    PHASE_END(0)

    for (int layer = 0; layer < DEPTH; ++layer) {
        PHASE_BEGIN
            pg8::Gemm g{XB, (const bf16_t*)(ws + (size_t)(layer & 1) * WSZ + W_IN), Dm, Dm, Dm, 1 << 30, 0};
            pg8::StaticOrder S; S.init(M, 4096, G, bx);
            EpiMix E{RSB, CS, LB + (0 * 4 + layer) * 512, LB + (1 * 4 + layer) * 512, Qb, Kb, Vb, HQ, HV, BG, GF, GB};
            if ON(1) pg8::gemm_phase(lds, g, S, E);
        PHASE_END(1)
        PHASE_BEGIN
            const float lam_init = 0.8f - 0.6f * __expf(-0.3f * (float)layer);
            const float lam = LAM[layer];
            if ON(2) for (int i = 0; i * G + bx < 512; ++i) {
                const int uid = i * G + bx; const int round = uid >> 8, r = uid & 255;
                const int bhh = round * 8 + (r & 7), qb = r >> 3;
                attn_unit(bhh >> 2, bhh & 3, qb, Qb, Kb, Vb, AO, P.da_norm + layer * 512, 1.0f - lam_init, lam, lds);
            }
            TICK(2);
            if ON(3) for (int u = bx; u < 2048; u += G) hg1_unit(u, GF, GB, HV, UT, Dg, Eg, lds);
        PHASE_END(3)
        PHASE_BEGIN
            {
                pg8::Gemm g{XB, (const bf16_t*)(ws + (size_t)(layer & 1) * WSZ + W_IN) + (size_t)4096 * Dm, Dm, Dm, Dm, 1 << 30, 0};
                pg8::StaticOrder S; S.init(M, 2048, G, bx);
                EpiGate E{RSB, GATE};
                if ON(4) pg8::gemm_phase(lds, g, S, E);
            }
            TICK(4);
            if ON(5) hg2_scan(UT, Dg, Eg, bx * 512 + tid, G * 512);
            TICK(5);
            if ON(6) if (layer + 1 < DEPTH) convert_layer(P, layer + 1, ws + (size_t)((layer + 1) & 1) * WSZ, lds, gw, ngw, wave, lane);
        PHASE_END(6)
        PHASE_BEGIN
            if ON(7) for (int u = bx; u < 1024; u += G) hg3_unit(u, GF, GB, HQ, HV, UT, BG, P.hg_norm + layer * 512, AO, lds);
        PHASE_END(7)
        PHASE_BEGIN
            pg8::Gemm g{AO, (const bf16_t*)(ws + (size_t)(layer & 1) * WSZ + W_AB), 1024, 512, 512, 4, 512};
            pg8::StaticOrder S; S.init(M, 2048, G, bx);
            EpiY E{GATE, Yb};
            if ON(8) pg8::gemm_phase(lds, g, S, E);
        PHASE_END(8)
        PHASE_BEGIN
            pg8::Gemm g{Yb, (const bf16_t*)(ws + (size_t)(layer & 1) * WSZ + W_O2), 2048, 2048, 2048, 1 << 30, 0};
            pg8::StaticOrder S; S.init(M, Dm, G, bx);
            EpiRes E{layer == 0 ? P.x : P.out, P.out, XB, RSA};
            if ON(9) pg8::gemm_phase(lds, g, S, E);
        PHASE_END(9)
        PHASE_BEGIN
            pg8::Gemm g{XB, (const bf16_t*)(ws + (size_t)(layer & 1) * WSZ + W_GU), Dm, Dm, Dm, 1 << 30, 0};
            pg8::StaticOrder S; S.init(M, 2 * FF, G, bx);
            EpiGU E{RSA, Hb};
            if ON(10) pg8::gemm_phase(lds, g, S, E);
        PHASE_END(10)
        PHASE_BEGIN
            pg8::Gemm g{Hb, (const bf16_t*)(ws + (size_t)(layer & 1) * WSZ + W_D), FF, FF, FF, 1 << 30, 0};
            pg8::StaticOrder S; S.init(M, Dm, G, bx);
            EpiRes E{P.out, P.out, XB, RSB};
            if ON(11) pg8::gemm_phase(lds, g, S, E);
        PHASE_END(11)
    }
    PHASE_BEGIN
        if ON(12) for (int r = gw; r < M; r += ngw) {
            f32x4* xr = (f32x4*)(P.out + (size_t)r * Dm) + lane;
            f32x4 v[4]; float ss = 0.f;
#pragma unroll
            for (int j = 0; j < 4; ++j) { v[j] = xr[64 * j]; ss += (v[j].x * v[j].x + v[j].y * v[j].y) + (v[j].z * v[j].z + v[j].w * v[j].w); }
            const float rs = rsqrtf(wave_sum(ss) * (1.0f / Dm) + EPS);
#pragma unroll
            for (int j = 0; j < 4; ++j) { const f32x4 gn = *((const f32x4*)P.final_norm + lane + 64 * j); xr[64 * j] = (f32x4){v[j].x * rs * gn.x, v[j].y * rs * gn.y, v[j].z * rs * gn.z, v[j].w * rs * gn.w}; }
        }
    PHASE_END(12)
#ifdef TS_A
    if (bx == 0 && threadIdx.x == 0) {
        LAS unsigned long long* TS_ = (LAS unsigned long long*)(lds + 131072);
        unsigned long long a = 0;
        for (int i = 0; i < 15; ++i) { if ((TS_A >> i) & 1) a += TS_[i]; }
        const unsigned long long t_end = __builtin_amdgcn_s_memrealtime() + a;
        while (__builtin_amdgcn_s_memrealtime() < t_end) __builtin_amdgcn_s_sleep(20);
    }
#endif
}
constexpr int NPHASES = 2 + 8 * DEPTH;

#ifndef MK_PER_PHASE
#define MK_PER_PHASE 0
#endif

extern "C" void kernel_launch(void* const* d_in, const int* in_sizes, int n_in, void* d_out, int out_size, void* d_ws, size_t ws_size, hipStream_t stream) {
    static int grid = 0;
    if (grid == 0) {
        if (n_in != 16 || out_size != M * Dm || ws_size < WS_END) { fprintf(stderr, "kernel_launch: unexpected sizes (n_in %d, out %d, ws %zu, need %zu)\n", n_in, out_size, ws_size, (size_t)WS_END); grid = -1; return; }
        int dev = 0, cus = 0, per_cu = 0;
        (void)hipGetDevice(&dev);
        (void)hipDeviceGetAttribute(&cus, hipDeviceAttributeMultiprocessorCount, dev);
        if (hipFuncSetAttribute((const void*)fwd_kernel, hipFuncAttributeMaxDynamicSharedMemorySize, LDS_BYTES) != hipSuccess) { fprintf(stderr, "kernel_launch: hipFuncSetAttribute failed\n"); grid = -1; return; }
        (void)hipOccupancyMaxActiveBlocksPerMultiprocessor(&per_cu, (const void*)fwd_kernel, 512, LDS_BYTES);
        (void)hipGetLastError();
        if (per_cu < 1) per_cu = 1;
        grid = cus * 1;
        fprintf(stderr, "kernel_launch: grid %d (per_cu %d), ws %zu need %zu\n", grid, per_cu, ws_size, (size_t)WS_END);
    }
    if (grid < 0) return;
    Ptrs p{};
    p.x = (const float*)d_in[0]; p.pos = (const int*)d_in[1]; p.w_in = (const float*)d_in[2]; p.da_lambda = (const float*)d_in[3]; p.da_norm = (const float*)d_in[4];
    p.hg_lb = (const float*)d_in[5]; p.hg_norm = (const float*)d_in[6]; p.w_a = (const float*)d_in[7]; p.w_b = (const float*)d_in[8]; p.w_o = (const float*)d_in[9];
    p.attn_norm = (const float*)d_in[10]; p.ffn_norm = (const float*)d_in[11]; p.w_gate = (const float*)d_in[12]; p.w_up = (const float*)d_in[13]; p.w_down = (const float*)d_in[14];
    p.final_norm = (const float*)d_in[15];
    p.out = (float*)d_out; p.ws = (unsigned char*)d_ws;
    (void)hipMemsetAsync((char*)d_ws + OFF_BAR, 0, BAR_BYTES, stream);
#if MK_PER_PHASE
    for (int ph = 0; ph < NPHASES; ++ph) {
        p.ph_lo = ph; p.ph_hi = ph + 1;
        hipLaunchKernelGGL(fwd_kernel, dim3(grid), dim3(512), LDS_BYTES, stream, p);
    }
#else
    p.ph_lo = 0; p.ph_hi = NPHASES;
    void* args[] = {&p};
    hipError_t e = hipLaunchCooperativeKernel((const void*)fwd_kernel, dim3(grid), dim3(512), args, LDS_BYTES, stream);
    if (e != hipSuccess) fprintf(stderr, "cooperative launch failed: %s (grid %d)\n", hipGetErrorString(e), grid);
#endif
}
```

```cpp
#include <hip/hip_runtime.h>
#include <hip/hip_cooperative_groups.h>
#include <cstdio>
#include <cstdint>
namespace cg = cooperative_groups;

#define LAS __attribute__((address_space(3)))
typedef unsigned short bf16_t;
typedef short bf16x8 __attribute__((ext_vector_type(8)));
typedef short s16x4 __attribute__((ext_vector_type(4)));
typedef float f32x4 __attribute__((ext_vector_type(4)));
typedef float f32x16 __attribute__((ext_vector_type(16)));
typedef unsigned u32x4 __attribute__((ext_vector_type(4)));
typedef unsigned u32x2 __attribute__((ext_vector_type(2)));

constexpr int Dm = 1024, NB = 4, SEQ = 4096, M = NB * SEQ, DEPTH = 4, FF = 2816, INW = 6144;
constexpr float EPS = 1e-6f;
constexpr float LOG2E = 1.4426950408889634f;

constexpr size_t W_IN = 0, W_AB = 12582912, W_O2 = 14680064, W_GU = 18874368, W_D = 30408704, WSZ = 36175872;
constexpr size_t MiB = 1048576;
constexpr size_t OFF_XB = 2 * WSZ;
constexpr size_t OFF_RSA = OFF_XB + 32 * MiB;
constexpr size_t OFF_RSB = OFF_RSA + MiB;
constexpr size_t OFF_CS = OFF_RSB + MiB;
constexpr size_t OFF_LB = OFF_CS + MiB;
constexpr size_t OFF_LAM = OFF_LB + 16384;
constexpr size_t OFF_DG = OFF_LAM + 256;
constexpr size_t OFF_EG = OFF_DG + MiB;
constexpr size_t OFF_B = OFF_EG + MiB;
constexpr size_t OFF_GATE = OFF_B;
constexpr size_t OFF_Q = OFF_B, OFF_K = OFF_B + 16 * MiB, OFF_V = OFF_B + 32 * MiB;
constexpr size_t OFF_HQ = OFF_B + 64 * MiB;
constexpr size_t OFF_HV = OFF_HQ + 16 * MiB;
constexpr size_t OFF_GF = OFF_HV + 16 * MiB;
constexpr size_t OFF_GB = OFF_GF + 32 * MiB;
constexpr size_t OFF_Y = OFF_GF;
constexpr size_t OFF_BG = OFF_GB + 32 * MiB;
constexpr size_t OFF_AO = OFF_BG + 16 * MiB;
constexpr size_t OFF_UT = OFF_AO + 32 * MiB;
constexpr size_t OFF_H = OFF_B;
constexpr size_t OFF_BAR = OFF_UT + 64 * MiB;
constexpr size_t BAR_BYTES = 16384;
constexpr size_t WS_END = OFF_BAR + BAR_BYTES;

constexpr int LDS_BYTES = 131072 + 2048;

__device__ __forceinline__ unsigned f2bf(float f) { unsigned u = __builtin_bit_cast(unsigned, f); return (u + 0x7fffu + ((u >> 16) & 1u)) >> 16; }
typedef float f32x2_t __attribute__((ext_vector_type(2)));
typedef __bf16 bf16x2_t __attribute__((ext_vector_type(2)));
__device__ __forceinline__ unsigned pk2(float lo, float hi) { f32x2_t v = {lo, hi}; bf16x2_t b = __builtin_convertvector(v, bf16x2_t); return __builtin_bit_cast(unsigned, b); }
__device__ __forceinline__ float bf2f(unsigned short b) { return __builtin_bit_cast(float, (unsigned)b << 16); }
__device__ __forceinline__ float bflo(unsigned u) { return __builtin_bit_cast(float, u << 16); }
__device__ __forceinline__ float bfhi(unsigned u) { return __builtin_bit_cast(float, u & 0xffff0000u); }
__device__ __forceinline__ float sigmoidf_(float x) { return 1.0f / (1.0f + __expf(-x)); }

namespace pg8 {
constexpr int BM = 256, BK = 64, HALF = 128, HTB = HALF * BK * 2, STAGE_BYTES = 8 * HTB, NXCD = 8, WGM = 8;
__host__ __device__ __forceinline__ int lds_byte(int r, int c) { const int st = (r >> 4) * 2 + (c >> 5), rr = r & 15, cc = c & 31, ob = rr * 64 + cc * 2; return st * 1024 + (ob ^ (((ob >> 9) & 1) << 5)); }
__host__ __device__ __forceinline__ void stage_rc(int b, int& R, int& C) { const int st = b / 1024, sb = b % 1024, swz = sb ^ (((sb >> 9) & 1) << 5); R = (st >> 1) * 16 + swz / 64; C = (st & 1) * 32 + (swz % 64) / 2; }
__host__ __device__ __forceinline__ int perm32(int rho) { const int n = rho >> 4, i = rho & 15; return 8 * (i >> 2) + 4 * n + (i & 3); }

struct Unit { int pm, pn; };
struct Gemm { const bf16_t* A; const bf16_t* Bt; int lda, ldb, K; int split_pn; int split_aoff; };

struct StaticOrder {
    int nM, nN, nwg, G, c;
    __device__ __forceinline__ void init(int M_, int N_, int G_, int c_) { nM = M_ / BM; nN = N_ / BM; nwg = nM * nN; G = G_; c = c_; }
    __device__ bool next(int i, Unit& u) const {
        const long L = (long)i * G + c; if (L >= nwg) return false;
        int wgid = (int)L; { const int q = nwg / NXCD, r = nwg % NXCD, xcd = wgid % NXCD, off = wgid / NXCD; wgid = (xcd < r ? xcd * (q + 1) : r * (q + 1) + (xcd - r) * q) + off; }
        const int nig = WGM * nN, gid = wgid / nig, fm = gid * WGM, gsz = (nM - fm) < WGM ? (nM - fm) : WGM;
        u.pm = fm + ((wgid % nig) % gsz); u.pn = (wgid % nig) / gsz; return true;
    }
};

template <class Epi>
__device__ __forceinline__ void gemm_phase(LAS unsigned char* lds, const Gemm g, const StaticOrder& S, const Epi& E) {
    int tid_ = threadIdx.x; asm volatile("" : "+v"(tid_));
    const int tid = tid_, wid = __builtin_amdgcn_readfirstlane(tid >> 6), lane = tid & 63, wr = wid >> 2, wc = wid & 3, fr = lane & 15, fq = lane >> 4;
    const int K = g.K, nt = K / BK;
    unsigned voffA[2], voffB[2];
#pragma unroll
    for (int i = 0; i < 2; ++i) { int R, C; stage_rc(tid * 16 + i * 8192, R, C); const int Rb = (R & ~31) + perm32(R & 31);
        voffA[i] = (unsigned)(R * g.lda + C) * 2u; voffB[i] = (unsigned)(Rb * g.ldb + C) * 2u; }
    const size_t kstep = (size_t)(BK * 2);
    const size_t hstepA = (size_t)HALF * g.lda * 2, hstepB = (size_t)HALF * g.ldb * 2;
    const size_t tstepA = 2 * hstepA, tstepB = 2 * hstepB;
    const unsigned ldsw = (unsigned)wid * 1024u;
    const int aoff = lds_byte(wr * 64 + fr, fq * 8), boff = lds_byte(wc * 32 + fr, fq * 8);
#define PG8_SA(b, h) (((b) * 2 + (h)) * HTB)
#define PG8_SB(b, h) ((4 + (b) * 2 + (h)) * HTB)
#define PG8_STAGE(bufoff, gbase, voff) do { _Pragma("unroll") for (int _i = 0; _i < 2; ++_i) \
        __builtin_amdgcn_global_load_lds((const unsigned*)((const char*)(gbase) + (voff)[_i]), (LAS unsigned*)(lds + (bufoff) + ldsw + _i * 8192), 16, 0, 0); } while (0)
#define PG8_LDA(dst, b, h) do { _Pragma("unroll") for (int m = 0; m < 4; ++m) _Pragma("unroll") for (int k = 0; k < 2; ++k) dst[m][k] = *(const LAS bf16x8*)(lds + PG8_SA(b, h) + aoff + m * 2048 + k * 1024); } while (0)
#define PG8_LDB(dst, b, h) do { _Pragma("unroll") for (int n = 0; n < 2; ++n) _Pragma("unroll") for (int k = 0; k < 2; ++k) dst[n][k] = *(const LAS bf16x8*)(lds + PG8_SB(b, h) + boff + n * 2048 + k * 1024); } while (0)
#define PG8_MMA(ai, bj, At, Bt) do { __builtin_amdgcn_s_setprio(1); _Pragma("unroll") for (int m = 0; m < 4; ++m) _Pragma("unroll") for (int n = 0; n < 2; ++n) _Pragma("unroll") for (int k = 0; k < 2; ++k) \
        acc[ai][bj][m][n] = __builtin_amdgcn_mfma_f32_16x16x32_bf16(Bt[n][k], At[m][k], acc[ai][bj][m][n], 0, 0, 0); __builtin_amdgcn_s_setprio(0); } while (0)
#define PG8_WAIT_V(n) asm volatile("s_waitcnt vmcnt(" #n ")" ::: "memory")
#define PG8_WAIT_L(n) asm volatile("s_waitcnt lgkmcnt(" #n ")" ::: "memory")
#define PG8_BAR __builtin_amdgcn_s_barrier()
#define PG8_SCHED __builtin_amdgcn_sched_barrier(0)
#define PG8_UA(u) ((const char*)g.A + (size_t)(u).pm * tstepA + (((u).pn >= g.split_pn) ? (size_t)g.split_aoff * 2 : (size_t)0))
    Unit cur, nxt; int ui = 0;
    if (!S.next(0, cur)) return;
    f32x4 acc[2][2][4][2];
#pragma unroll
    for (int a = 0; a < 2; ++a)
#pragma unroll
        for (int b = 0; b < 2; ++b)
#pragma unroll
            for (int m = 0; m < 4; ++m)
#pragma unroll
                for (int n = 0; n < 2; ++n) acc[a][b][m][n] = (f32x4){0.f, 0.f, 0.f, 0.f};
    bf16x8 At[4][2], B0[2][2], B1[2][2];
    const char* cA = PG8_UA(cur); const char* cB = (const char*)g.Bt + (size_t)cur.pn * tstepB;
    PG8_STAGE(PG8_SB(0, 0), cB, voffB); PG8_STAGE(PG8_SB(0, 1), cB + hstepB, voffB); PG8_STAGE(PG8_SA(0, 0), cA, voffA); PG8_STAGE(PG8_SA(0, 1), cA + hstepA, voffA);
    if (wr == 1) PG8_BAR;
    PG8_WAIT_V(2); PG8_BAR;
    PG8_STAGE(PG8_SB(1, 0), cB + kstep, voffB); PG8_STAGE(PG8_SA(1, 0), cA + kstep, voffA); PG8_STAGE(PG8_SB(1, 1), cB + hstepB + kstep, voffB);
    PG8_WAIT_V(6); PG8_BAR;
    for (;;) {
        const bool has_next = S.next(ui + 1, nxt);
        const char* nA = has_next ? PG8_UA(nxt) : cA; const char* nB = has_next ? (const char*)g.Bt + (size_t)nxt.pn * tstepB : cB;
        for (int t = 0; t < nt; t += 2) {
            const bool last = (t == nt - 2);
            const char* a1 = cA + (size_t)(t + 1) * kstep;
            const char* a2 = last ? nA : cA + (size_t)(t + 2) * kstep; const char* b2 = last ? nB : cB + (size_t)(t + 2) * kstep;
            const char* a3 = a2 + kstep; const char* b3 = b2 + kstep;
            PG8_LDB(B0, 0, 0); PG8_LDB(B1, 0, 1); PG8_SCHED; PG8_LDA(At, 0, 0); PG8_STAGE(PG8_SA(1, 1), a1 + hstepA, voffA);
            PG8_WAIT_V(8); PG8_WAIT_L(0); PG8_BAR; PG8_MMA(0, 0, At, B0); PG8_MMA(0, 1, At, B1); PG8_BAR; PG8_SCHED;
            PG8_LDA(At, 0, 1); PG8_STAGE(PG8_SB(0, 0), b2, voffB); PG8_STAGE(PG8_SB(0, 1), b2 + hstepB, voffB); PG8_STAGE(PG8_SA(0, 0), a2, voffA);
            PG8_WAIT_V(8); PG8_WAIT_L(0); PG8_BAR; PG8_MMA(1, 0, At, B0); PG8_MMA(1, 1, At, B1); PG8_BAR; PG8_SCHED;
            PG8_LDB(B0, 1, 0); PG8_LDB(B1, 1, 1); PG8_SCHED; PG8_LDA(At, 1, 0); PG8_STAGE(PG8_SA(0, 1), a2 + hstepA, voffA);
            PG8_WAIT_V(8); PG8_WAIT_L(0); PG8_BAR; PG8_MMA(0, 0, At, B0); PG8_MMA(0, 1, At, B1); PG8_BAR; PG8_SCHED;
            PG8_LDA(At, 1, 1); PG8_STAGE(PG8_SB(1, 0), b3, voffB); PG8_STAGE(PG8_SB(1, 1), b3 + hstepB, voffB); PG8_STAGE(PG8_SA(1, 0), a3, voffA);
            PG8_WAIT_V(8); PG8_WAIT_L(0); PG8_BAR; PG8_MMA(1, 0, At, B0); PG8_MMA(1, 1, At, B1); PG8_BAR; PG8_SCHED;
        }
        if (wr == 0) PG8_BAR;
        E(acc, cur, wr, wc, fr, fq);
        if (!has_next) break;
#pragma unroll
        for (int a = 0; a < 2; ++a)
#pragma unroll
            for (int b = 0; b < 2; ++b)
#pragma unroll
                for (int m = 0; m < 4; ++m)
#pragma unroll
                    for (int n = 0; n < 2; ++n) acc[a][b][m][n] = (f32x4){0.f, 0.f, 0.f, 0.f};
        cur = nxt; cA = nA; cB = nB; ++ui;
        if (wr == 1) PG8_BAR;
    }
    PG8_WAIT_V(0);
    PG8_BAR;
#undef PG8_SA
#undef PG8_SB
#undef PG8_STAGE
#undef PG8_LDA
#undef PG8_LDB
#undef PG8_MMA
#undef PG8_UA
}
}

__device__ __forceinline__ float row_rs(const float* rsp, int row) {
    const f32x4* p = (const f32x4*)(rsp + (size_t)row * 16);
    f32x4 a = p[0], b = p[1], c = p[2], d = p[3];
    float s = ((a.x + a.y) + (a.z + a.w)) + ((b.x + b.y) + (b.z + b.w)) + ((c.x + c.y) + (c.z + c.w)) + ((d.x + d.y) + (d.z + d.w));
    return rsqrtf(s * (1.0f / Dm) + EPS);
}
__device__ __forceinline__ u32x4 pack8(const float* v) { u32x4 w; w.x = pk2(v[0], v[1]); w.y = pk2(v[2], v[3]); w.z = pk2(v[4], v[5]); w.w = pk2(v[6], v[7]); return w; }

struct EpiMix {
    const float* rsp; const float* cs; const float* lbF; const float* lbB;
    bf16_t *Q, *Kk, *V, *HQ, *HV, *BG; float *GF, *GB;
    __device__ __forceinline__ void operator()(const f32x4 (&acc)[2][2][4][2], const pg8::Unit& u, int wr, int wc, int fr, int fq) const {
        const int grp = u.pn >> 1;
#pragma unroll
        for (int ai = 0; ai < 2; ++ai)
#pragma unroll
            for (int m = 0; m < 4; ++m) {
                const int row = u.pm * 256 + ai * 128 + wr * 64 + m * 16 + fr;
                const float rs = row_rs(rsp, row);
                const int b = row >> 12, s = row & 4095;
#pragma unroll
                for (int bj = 0; bj < 2; ++bj) {
                    const int col = u.pn * 256 + bj * 128 + wc * 32 + fq * 8;
                    const int jj = col & 511;
                    float v[8];
#pragma unroll
                    for (int e = 0; e < 4; ++e) { v[e] = acc[ai][bj][m][0][e] * rs; v[4 + e] = acc[ai][bj][m][1][e] * rs; }
                    if (grp <= 1) {
                        const int d0 = jj & 63;
                        if (d0 < 16) {
                            const int gsel = d0 >> 3;
                            const f32x4 c4 = *(const f32x4*)(cs + (size_t)row * 16 + gsel * 4), s4 = *(const f32x4*)(cs + (size_t)row * 16 + 8 + gsel * 4);
#pragma unroll
                            for (int e = 0; e < 4; ++e) { const float t1 = v[e], t2 = v[4 + e]; v[e] = t1 * c4[e] - t2 * s4[e]; v[4 + e] = t2 * c4[e] + t1 * s4[e]; }
                        }
                        if (grp == 0) {
#pragma unroll
                            for (int e = 0; e < 8; ++e) v[e] *= 0.125f * LOG2E;
                        }
                        const int h = jj >> 7, c = (jj >> 6) & 1;
                        bf16_t* dst = (grp == 0 ? Q : Kk) + ((size_t)(((b * 4 + h) * 2 + c) * SEQ + s)) * 64 + d0;
                        *(u32x4*)dst = pack8(v);
                    } else if (grp == 2) {
                        const int h = jj >> 7, d0 = jj & 127;
                        *(u32x4*)(V + ((size_t)((b * 4 + h) * SEQ + s)) * 128 + d0) = pack8(v);
                    } else if (grp == 3) {
                        *(u32x4*)(HQ + (size_t)row * 512 + jj) = pack8(v);
                    } else if (grp == 4 || grp == 5) {
                        const float* lbp = (grp == 4 ? lbF : lbB) + jj;
                        const f32x4 l0 = *(const f32x4*)lbp, l1 = *(const f32x4*)(lbp + 4);
                        float gl[8];
#pragma unroll
                        for (int e = 0; e < 8; ++e) { const float lb = e < 4 ? l0[e] : l1[e - 4]; const float f = lb + (1.0f - lb) * sigmoidf_(v[e]); gl[e] = __logf(fmaxf(f, 1e-37f)); }
                        float* dst = (grp == 4 ? GF : GB) + (size_t)row * 512 + jj;
                        *(f32x4*)dst = (f32x4){gl[0], gl[1], gl[2], gl[3]}; *(f32x4*)(dst + 4) = (f32x4){gl[4], gl[5], gl[6], gl[7]};
                    } else if (grp == 6) {
                        *(u32x4*)(HV + (size_t)row * 512 + jj) = pack8(v);
                    } else {
#pragma unroll
                        for (int e = 0; e < 8; ++e) v[e] = sigmoidf_(v[e]);
                        *(u32x4*)(BG + (size_t)row * 512 + jj) = pack8(v);
                    }
                }
            }
    }
};

struct EpiGate {
    const float* rsp; bf16_t* G;
    __device__ __forceinline__ void operator()(const f32x4 (&acc)[2][2][4][2], const pg8::Unit& u, int wr, int wc, int fr, int fq) const {
#pragma unroll
        for (int ai = 0; ai < 2; ++ai)
#pragma unroll
            for (int m = 0; m < 4; ++m) {
                const int row = u.pm * 256 + ai * 128 + wr * 64 + m * 16 + fr;
                const float rs = row_rs(rsp, row);
#pragma unroll
                for (int bj = 0; bj < 2; ++bj) {
                    const int col = u.pn * 256 + bj * 128 + wc * 32 + fq * 8;
                    float v[8];
#pragma unroll
                    for (int e = 0; e < 4; ++e) { v[e] = sigmoidf_(acc[ai][bj][m][0][e] * rs); v[4 + e] = sigmoidf_(acc[ai][bj][m][1][e] * rs); }
                    *(u32x4*)(G + (size_t)row * 2048 + col) = pack8(v);
                }
            }
    }
};

struct EpiY {
    const bf16_t* G; bf16_t* Y;
    __device__ __forceinline__ void operator()(const f32x4 (&acc)[2][2][4][2], const pg8::Unit& u, int wr, int wc, int fr, int fq) const {
#pragma unroll
        for (int ai = 0; ai < 2; ++ai)
#pragma unroll
            for (int m = 0; m < 4; ++m) {
                const int row = u.pm * 256 + ai * 128 + wr * 64 + m * 16 + fr;
#pragma unroll
                for (int bj = 0; bj < 2; ++bj) {
                    const int col = u.pn * 256 + bj * 128 + wc * 32 + fq * 8;
                    const u32x4 gq = *(const u32x4*)(G + (size_t)row * 2048 + col);
                    float v[8];
                    v[0] = acc[ai][bj][m][0][0] * bflo(gq.x); v[1] = acc[ai][bj][m][0][1] * bfhi(gq.x);
                    v[2] = acc[ai][bj][m][0][2] * bflo(gq.y); v[3] = acc[ai][bj][m][0][3] * bfhi(gq.y);
                    v[4] = acc[ai][bj][m][1][0] * bflo(gq.z); v[5] = acc[ai][bj][m][1][1] * bfhi(gq.z);
                    v[6] = acc[ai][bj][m][1][2] * bflo(gq.w); v[7] = acc[ai][bj][m][1][3] * bfhi(gq.w);
                    *(u32x4*)(Y + (size_t)row * 2048 + col) = pack8(v);
                }
            }
    }
};

struct EpiRes {
    const float* xres; float* xout; bf16_t* XB; float* rsp;
    __device__ __forceinline__ void operator()(const f32x4 (&acc)[2][2][4][2], const pg8::Unit& u, int wr, int wc, int fr, int fq) const {
#pragma unroll
        for (int ai = 0; ai < 2; ++ai)
#pragma unroll
            for (int m = 0; m < 4; ++m) {
                const int row = u.pm * 256 + ai * 128 + wr * 64 + m * 16 + fr;
                float ss = 0.f;
#pragma unroll
                for (int bj = 0; bj < 2; ++bj) {
                    const int col = u.pn * 256 + bj * 128 + wc * 32 + fq * 8;
                    const float* xr = xres + (size_t)row * Dm + col;
                    const f32x4 x0 = *(const f32x4*)xr, x1 = *(const f32x4*)(xr + 4);
                    float v[8];
#pragma unroll
                    for (int e = 0; e < 4; ++e) { v[e] = x0[e] + acc[ai][bj][m][0][e]; v[4 + e] = x1[e] + acc[ai][bj][m][1][e]; }
#pragma unroll
                    for (int e = 0; e < 8; ++e) ss += v[e] * v[e];
                    float* xo = xout + (size_t)row * Dm + col;
                    *(f32x4*)xo = (f32x4){v[0], v[1], v[2], v[3]}; *(f32x4*)(xo + 4) = (f32x4){v[4], v[5], v[6], v[7]};
                    *(u32x4*)(XB + (size_t)row * Dm + col) = pack8(v);
                }
                ss += __shfl_xor(ss, 16); ss += __shfl_xor(ss, 32);
                if (fq == 0) rsp[(size_t)row * 16 + u.pn * 4 + wc] = ss;
            }
    }
};

struct EpiGU {
    const float* rsp; bf16_t* H;
    __device__ __forceinline__ void operator()(const f32x4 (&acc)[2][2][4][2], const pg8::Unit& u, int wr, int wc, int fr, int fq) const {
#pragma unroll
        for (int ai = 0; ai < 2; ++ai)
#pragma unroll
            for (int m = 0; m < 4; ++m) {
                const int row = u.pm * 256 + ai * 128 + wr * 64 + m * 16 + fr;
                const float rs = row_rs(rsp, row);
                const int col = u.pn * 128 + wc * 32 + fq * 8;
                float v[8];
#pragma unroll
                for (int n = 0; n < 2; ++n)
#pragma unroll
                    for (int e = 0; e < 4; ++e) { const float gg = acc[ai][0][m][n][e] * rs, uu = acc[ai][1][m][n][e] * rs; v[n * 4 + e] = gg * sigmoidf_(gg) * uu; }
                *(u32x4*)(H + (size_t)row * FF + col) = pack8(v);
            }
    }
};

__device__ __forceinline__ int rope_perm(int n) {
    const int d = n & 63; if (d >= 16) return n;
    const int g = d >> 3, e = d & 7; return (n & ~63) + ((e < 4) ? 4 * g + e : 8 + 4 * g + (e - 4));
}
__device__ __forceinline__ void conv_item(const float* src, int ld_src, int ks0, int c0  , int mode  ,
                                          const float* gain, bf16_t* dst, int ld_dst, int n0, int kd0, LAS float* scr, int lane) {
    const int n4 = lane & 7, kr = lane >> 3;
    int sc = c0 + 4 * n4;
    if (mode) { const int q = (sc & 63) >> 2; if (q == 1) sc += 4; else if (q == 2) sc -= 4; }
#pragma unroll
    for (int i = 0; i < 8; ++i) { const int kk = kr + 8 * i; f32x4 w = *(const f32x4*)(src + (size_t)(ks0 + kk) * ld_src + sc);
        if (gain) { const float gg = gain[ks0 + kk]; w.x *= gg; w.y *= gg; w.z *= gg; w.w *= gg; }
        LAS float* d = scr + kk * 33 + 4 * n4; d[0] = w.x; d[1] = w.y; d[2] = w.z; d[3] = w.w; }
    asm volatile("s_waitcnt lgkmcnt(0)" ::: "memory");
    const int c = lane & 7;
#pragma unroll
    for (int j = 0; j < 4; ++j) { const int n = (lane >> 3) + 8 * j; const LAS float* s = scr + (8 * c) * 33 + n;
        u32x4 o; o.x = pk2(s[0 * 33], s[1 * 33]); o.y = pk2(s[2 * 33], s[3 * 33]); o.z = pk2(s[4 * 33], s[5 * 33]); o.w = pk2(s[6 * 33], s[7 * 33]);
        *(u32x4*)(dst + (size_t)(n0 + n) * ld_dst + kd0 + 8 * c) = o; }
    asm volatile("s_waitcnt lgkmcnt(0)" ::: "memory");
}

struct Ptrs {
    const float *x; const int* pos; const float *w_in, *da_lambda, *da_norm, *hg_lb, *hg_norm, *w_a, *w_b, *w_o, *attn_norm, *ffn_norm, *w_gate, *w_up, *w_down, *final_norm;
    float* out; unsigned char* ws; int ph_lo, ph_hi;
};

__device__ __forceinline__ void convert_layer(const Ptrs& P, int layer, unsigned char* wbuf, LAS unsigned char* lds, int gw, int ngw, int wave, int lane) {
    LAS float* scr = (LAS float*)(lds + wave * 8704);
    constexpr int I_IN = 16 * 192, I_A = 8 * 32, I_B = 8 * 32, I_O = 32 * 32, I_GU = 16 * 176, I_D = 44 * 32;
    constexpr int NIT = I_IN + I_A + I_B + I_O + I_GU + I_D;
    for (int it = gw; it < NIT; it += ngw) {
        int r = it;
        if (r < I_IN) { const int kb = r / 192, nb = r % 192, n0 = nb * 32;
            conv_item(P.w_in + (size_t)layer * Dm * INW, INW, kb * 64, n0, n0 < 1024 ? 1 : 0, P.attn_norm + layer * Dm, (bf16_t*)(wbuf + W_IN), Dm, n0, kb * 64, scr, lane); continue; }
        r -= I_IN;
        if (r < I_A) { const int kb = r / 32, nb = r % 32;
            conv_item(P.w_a + (size_t)layer * 512 * Dm, Dm, kb * 64, nb * 32, 0, nullptr, (bf16_t*)(wbuf + W_AB), 512, nb * 32, kb * 64, scr, lane); continue; }
        r -= I_A;
        if (r < I_B) { const int kb = r / 32, nb = r % 32;
            conv_item(P.w_b + (size_t)layer * 512 * Dm, Dm, kb * 64, nb * 32, 0, nullptr, (bf16_t*)(wbuf + W_AB), 512, 1024 + nb * 32, kb * 64, scr, lane); continue; }
        r -= I_B;
        if (r < I_O) { const int kb = r / 32, nb = r % 32;
            conv_item(P.w_o + (size_t)layer * Dm * Dm, Dm, (kb * 64) & 1023, nb * 32, 0, nullptr, (bf16_t*)(wbuf + W_O2), 2048, nb * 32, kb * 64, scr, lane); continue; }
        r -= I_O;
        if (r < I_GU) { const int kb = r / 176, nb = r % 176, n0 = nb * 32, tile = n0 >> 8, rr = n0 & 255;
            const float* srcm = (rr < 128 ? P.w_gate : P.w_up) + (size_t)layer * Dm * FF;
            conv_item(srcm, FF, kb * 64, tile * 128 + (rr & 127), 0, P.ffn_norm + layer * Dm, (bf16_t*)(wbuf + W_GU), Dm, n0, kb * 64, scr, lane); continue; }
        r -= I_GU;
        { const int kb = r / 32, nb = r % 32;
            conv_item(P.w_down + (size_t)layer * FF * Dm, Dm, kb * 64, nb * 32, 0, nullptr, (bf16_t*)(wbuf + W_D), FF, nb * 32, kb * 64, scr, lane); }
    }
}

__device__ __forceinline__ float wave_sum(float v) {
#pragma unroll
    for (int o = 1; o < 64; o <<= 1) v += __shfl_xor(v, o);
    return v;
}
__device__ __forceinline__ void prologue(const Ptrs& P, LAS unsigned char* lds, int gw, int ngw, int wave, int lane) {
    unsigned char* ws = P.ws;
    bf16_t* XB = (bf16_t*)(ws + OFF_XB); float* rsb = (float*)(ws + OFF_RSB);
    for (int r = gw; r < M; r += ngw) {
        const f32x4* xr = (const f32x4*)(P.x + (size_t)r * Dm) + lane;
        float ss = 0.f;
#pragma unroll
        for (int j = 0; j < 4; ++j) { const f32x4 v = xr[64 * j]; ss += (v.x * v.x + v.y * v.y) + (v.z * v.z + v.w * v.w);
            u32x2 o; o.x = pk2(v.x, v.y); o.y = pk2(v.z, v.w); *((u32x2*)(XB + (size_t)r * Dm) + lane + 64 * j) = o; }
        ss = wave_sum(ss);
        if (lane < 16) rsb[(size_t)r * 16 + lane] = (lane == 0) ? ss : 0.f;
    }
    const int gt = gw * 64 + lane, ngt = ngw * 64;
    float* cs = (float*)(ws + OFF_CS);
    for (int i = gt; i < M * 8; i += ngt) {
        const int tok = i >> 3, f = i & 7;
        const double invf[8] = {1.0, 0.19392274474868576, 0.03760603093086393, 0.007292664737217109, 0.001414213562373095, 0.0002742481756762073, 5.318295896944988e-05, 1.031338537721246e-05};
        double fr;
        switch (f) { case 0: fr = invf[0]; break; case 1: fr = invf[1]; break; case 2: fr = invf[2]; break; case 3: fr = invf[3]; break; case 4: fr = invf[4]; break; case 5: fr = invf[5]; break; case 6: fr = invf[6]; break; default: fr = invf[7]; }
        const float ang32 = (float)P.pos[tok] * (float)fr;
        const double ang = (double)ang32;
        const double rev = ang * 0.15915494309189535;
        const double fracrev = rev - __builtin_floor(rev + 0.5);
        const float a = (float)(fracrev * 6.283185307179586);
        cs[(size_t)tok * 16 + f] = __cosf(a); cs[(size_t)tok * 16 + 8 + f] = __sinf(a);
    }
    float* LB = (float*)(ws + OFF_LB);
    for (int i = gt; i < 2 * 512; i += ngt) {
        const int d = i >> 9, k = i & 511;
        float l[4], mx = -1e30f;
#pragma unroll
        for (int j = 0; j < 4; ++j) { l[j] = P.hg_lb[(size_t)(d * 4 + j) * 512 + k]; mx = fmaxf(mx, l[j]); }
        float e[4], sum = 0.f;
#pragma unroll
        for (int j = 0; j < 4; ++j) { e[j] = __expf(l[j] - mx); sum += e[j]; }
        float cum = 0.f;
#pragma unroll
        for (int j = 0; j < 4; ++j) { if (j > 0) cum += e[j] / sum; LB[(size_t)(d * 4 + j) * 512 + k] = cum; }
    }
    if (gw == 0) {
        float* LAM = (float*)(ws + OFF_LAM);
        for (int l = 0; l < 4; ++l) {
            const float* p = P.da_lambda + l * 256;
            float a = wave_sum(p[lane] * p[64 + lane]), b = wave_sum(p[128 + lane] * p[192 + lane]);
            const float lam_init = 0.8f - 0.6f * __expf(-0.3f * (float)l);
            if (lane == 0) LAM[l] = __expf(a) - __expf(b) + lam_init;
        }
    }
}

constexpr int AT_KROW = 144, AT_VROW = 320, AT_K1 = 64 * AT_KROW, AT_V = 2 * AT_K1, AT_STG = AT_V + 64 * AT_VROW;
constexpr int AT_IMG_ROW = 132;
__device__ __forceinline__ s16x4 tr_read(const LAS unsigned char* p) { return __builtin_bit_cast(s16x4, __builtin_amdgcn_ds_read_tr16_b64_v4i16((LAS s16x4*)p)); }

__device__ __forceinline__ void attn_unit(int b, int h, int qb, const bf16_t* Q, const bf16_t* Kk, const bf16_t* V, bf16_t* AO, const float* gainA  , float one_minus_lam_init, float lam, LAS unsigned char* lds) {
    int tid_ = threadIdx.x; asm volatile("" : "+v"(tid_));
    const int tid = tid_, wave = __builtin_amdgcn_readfirstlane(tid >> 6), lane = tid & 63, c = wave >> 2, wq = wave & 3, r32 = lane & 31, hh = lane >> 5;
    const int q0 = qb * 128 + wq * 32;
    bf16x8 qf[4];
    { const bf16_t* Qp = Q + ((size_t)(((b * 4 + h) * 2 + c) * SEQ + q0 + r32)) * 64 + 8 * hh;
#pragma unroll
      for (int s = 0; s < 4; ++s) qf[s] = *(const bf16x8*)(Qp + 16 * s); }
    f32x16 o[4];
#pragma unroll
    for (int i = 0; i < 4; ++i)
#pragma unroll
        for (int e = 0; e < 16; ++e) o[i][e] = 0.f;
    float mrow = -1e30f, lrow = 0.f;
    const unsigned char* Kg0 = (const unsigned char*)(Kk + ((size_t)((b * 4 + h) * 2 + 0) * SEQ) * 64);
    const unsigned char* Kg1 = (const unsigned char*)(Kk + ((size_t)((b * 4 + h) * 2 + 1) * SEQ) * 64);
    const unsigned char* Vg = (const unsigned char*)(V + ((size_t)(b * 4 + h) * SEQ) * 128);
    const int lk = (tid >> 3) * AT_KROW + (tid & 7) * 16;
    const int lv0 = AT_V + (tid >> 4) * AT_VROW + (tid & 15) * 16, lv1 = lv0 + 32 * AT_VROW;
    u32x4 r0, r1, r2, r3;
    r0 = *(const u32x4*)(Kg0 + tid * 16); r1 = *(const u32x4*)(Kg1 + tid * 16); r2 = *(const u32x4*)(Vg + tid * 16); r3 = *(const u32x4*)(Vg + 8192 + tid * 16);
    *(LAS u32x4*)(lds + lk) = r0; *(LAS u32x4*)(lds + AT_K1 + lk) = r1; *(LAS u32x4*)(lds + lv0) = r2; *(LAS u32x4*)(lds + lv1) = r3;
    r0 = *(const u32x4*)(Kg0 + 8192 + tid * 16); r1 = *(const u32x4*)(Kg1 + 8192 + tid * 16);
    *(LAS u32x4*)(lds + AT_STG + lk) = r0; *(LAS u32x4*)(lds + AT_STG + AT_K1 + lk) = r1;
    __syncthreads();
    const int ka = c * AT_K1 + r32 * AT_KROW + hh * 16;
    const int va = AT_V + (4 * hh + ((lane & 15) >> 2)) * AT_VROW + ((lane >> 4) & 1) * 32 + (lane & 3) * 8;

#define AT_QK(sv, st) do { f32x16 t0_, t1_; _Pragma("unroll") for (int e = 0; e < 16; ++e) { t0_[e] = 0.f; t1_[e] = 0.f; } \
        _Pragma("unroll") for (int ks = 0; ks < 4; ++ks) { \
            const bf16x8 a0 = *(const LAS bf16x8*)(lds + (st) + ka + ks * 32), a1 = *(const LAS bf16x8*)(lds + (st) + ka + 32 * AT_KROW + ks * 32); \
            t0_ = __builtin_amdgcn_mfma_f32_32x32x16_bf16(a0, qf[ks], t0_, 0, 0, 0); t1_ = __builtin_amdgcn_mfma_f32_32x32x16_bf16(a1, qf[ks], t1_, 0, 0, 0); } \
        sv##0 = t0_; sv##1 = t1_; } while (0)
    f32x16 sA0, sA1, sB0, sB1;
    AT_QK(sA, 0);
#define AT_TILE(j, s0, s1, sn, STC  , STN  ) do { \
        if ((j) + 2 < 64) { const size_t go = (size_t)((j) + 2) * 8192; r0 = *(const u32x4*)(Kg0 + go + tid * 16); r1 = *(const u32x4*)(Kg1 + go + tid * 16); } \
        if ((j) + 1 < 64) { const size_t go = (size_t)((j) + 1) * 16384; r2 = *(const u32x4*)(Vg + go + tid * 16); r3 = *(const u32x4*)(Vg + go + 8192 + tid * 16); } \
        if ((j) + 1 < 64) AT_QK(sn, STN); \
        float mx = fmaxf(s0[0], s1[0]); \
        _Pragma("unroll") for (int e = 1; e < 16; ++e) mx = fmaxf(mx, fmaxf(s0[e], s1[e])); \
        mx = fmaxf(mx, __shfl_xor(mx, 32)); \
        if (__builtin_amdgcn_ballot_w64(mx > mrow + 8.0f) != 0ull) { \
            const float mnew = fmaxf(mrow, mx), alpha = __builtin_amdgcn_exp2f(mrow - mnew); mrow = mnew; lrow *= alpha; \
            _Pragma("unroll") for (int i = 0; i < 4; ++i) _Pragma("unroll") for (int e = 0; e < 16; ++e) o[i][e] *= alpha; } \
        float ls = 0.f; \
        _Pragma("unroll") for (int e = 0; e < 16; ++e) { s0[e] = __builtin_amdgcn_exp2f(s0[e] - mrow); s1[e] = __builtin_amdgcn_exp2f(s1[e] - mrow); ls += s0[e] + s1[e]; } \
        lrow += ls; \
        bf16x8 pf[2][2]; \
        _Pragma("unroll") for (int s = 0; s < 2; ++s) { u32x4 w0, w1; \
            w0.x = pk2(s0[8 * s + 0], s0[8 * s + 1]); w0.y = pk2(s0[8 * s + 2], s0[8 * s + 3]); w0.z = pk2(s0[8 * s + 4], s0[8 * s + 5]); w0.w = pk2(s0[8 * s + 6], s0[8 * s + 7]); \
            w1.x = pk2(s1[8 * s + 0], s1[8 * s + 1]); w1.y = pk2(s1[8 * s + 2], s1[8 * s + 3]); w1.z = pk2(s1[8 * s + 4], s1[8 * s + 5]); w1.w = pk2(s1[8 * s + 6], s1[8 * s + 7]); \
            pf[0][s] = __builtin_bit_cast(bf16x8, w0); pf[1][s] = __builtin_bit_cast(bf16x8, w1); } \
        _Pragma("unroll") for (int kb = 0; kb < 2; ++kb) _Pragma("unroll") for (int s = 0; s < 2; ++s) { \
            const LAS unsigned char* vb = lds + (STC) + va + (32 * kb + 16 * s) * AT_VROW; \
            _Pragma("unroll") for (int vt = 0; vt < 4; ++vt) { \
                const s16x4 t0 = tr_read(vb + vt * 64), t1 = tr_read(vb + vt * 64 + 8 * AT_VROW); \
                const bf16x8 av = {t0[0], t0[1], t0[2], t0[3], t1[0], t1[1], t1[2], t1[3]}; \
                o[vt] = __builtin_amdgcn_mfma_f32_32x32x16_bf16(av, pf[kb][s], o[vt], 0, 0, 0); } } \
        if ((j) + 2 < 64) { *(LAS u32x4*)(lds + (STC) + lk) = r0; *(LAS u32x4*)(lds + (STC) + AT_K1 + lk) = r1; } \
        if ((j) + 1 < 64) { *(LAS u32x4*)(lds + (STN) + lv0) = r2; *(LAS u32x4*)(lds + (STN) + lv1) = r3; } \
        __syncthreads(); } while (0)
    for (int j = 0; j < 64; j += 2) {
        AT_TILE(j, sA0, sA1, sB, 0, AT_STG);
        AT_TILE(j + 1, sB0, sB1, sA, AT_STG, 0);
    }
#undef AT_TILE
#undef AT_QK
    const float inv = 1.0f / (lrow + __shfl_xor(lrow, 32));
    LAS float* img = (LAS float*)lds;
    const int qrow = wq * 32 + r32;
    if (c == 1) {
        const float sc = -lam * inv;
#pragma unroll
        for (int vt = 0; vt < 4; ++vt)
#pragma unroll
            for (int g = 0; g < 4; ++g)
                *(LAS f32x4*)(img + qrow * AT_IMG_ROW + 32 * vt + 8 * g + 4 * hh) = (f32x4){o[vt][4 * g] * sc, o[vt][4 * g + 1] * sc, o[vt][4 * g + 2] * sc, o[vt][4 * g + 3] * sc};
    }
    __syncthreads();
    if (c == 0) {
#pragma unroll
        for (int vt = 0; vt < 4; ++vt)
#pragma unroll
            for (int g = 0; g < 4; ++g) {
                LAS f32x4* p = (LAS f32x4*)(img + qrow * AT_IMG_ROW + 32 * vt + 8 * g + 4 * hh);
                f32x4 t = *p;
                t.x += o[vt][4 * g] * inv; t.y += o[vt][4 * g + 1] * inv; t.z += o[vt][4 * g + 2] * inv; t.w += o[vt][4 * g + 3] * inv;
                *p = t;
            }
    }
    __syncthreads();
    {
        const int q = tid >> 2, part = tid & 3;
        float v[32]; float ss = 0.f;
#pragma unroll
        for (int i = 0; i < 8; ++i) { const f32x4 t = *(const LAS f32x4*)(img + q * AT_IMG_ROW + 32 * part + 4 * i); v[4 * i] = t.x; v[4 * i + 1] = t.y; v[4 * i + 2] = t.z; v[4 * i + 3] = t.w;
            ss += (t.x * t.x + t.y * t.y) + (t.z * t.z + t.w * t.w); }
        ss += __shfl_xor(ss, 1); ss += __shfl_xor(ss, 2);
        const float rs = rsqrtf(ss * (1.0f / 128.0f) + EPS) * one_minus_lam_init;
        const float* gp = gainA + h * 128 + 32 * part;
        bf16_t* dst = AO + ((size_t)(b * SEQ + qb * 128 + q)) * 1024 + h * 128 + 32 * part;
#pragma unroll
        for (int i = 0; i < 4; ++i) {
            const f32x4 g0 = *(const f32x4*)(gp + 8 * i), g1 = *(const f32x4*)(gp + 8 * i + 4);
            u32x4 w; w.x = pk2(v[8 * i] * rs * g0.x, v[8 * i + 1] * rs * g0.y); w.y = pk2(v[8 * i + 2] * rs * g0.z, v[8 * i + 3] * rs * g0.w);
            w.z = pk2(v[8 * i + 4] * rs * g1.x, v[8 * i + 5] * rs * g1.y); w.w = pk2(v[8 * i + 6] * rs * g1.z, v[8 * i + 7] * rs * g1.w);
            *(u32x4*)(dst + 8 * i) = w;
        }
    }
    __syncthreads();
}

constexpr int HG_SEG = 0;
constexpr int HG_F = 2048;
constexpr int HG_PART = 2560;
constexpr int HG_V = 4096;
constexpr int HG_VROW = 288;
constexpr int HG_A = HG_V + 64 * HG_VROW;
constexpr int HG_KTROW = 144, HG_QKROW = 272;
constexpr int HG_Bq = HG_A + 128 * HG_KTROW;

__device__ __forceinline__ void hg_cumsum(const float (&gv)[16], int dir, int k, int j, LAS unsigned char* lds, float (&d)[16], float& m_out, float& tot_out) {
    float run = 0.f;
    if (dir == 0) {
#pragma unroll
        for (int i = 0; i < 16; ++i) { run += gv[i]; d[i] = run; }
    } else {
#pragma unroll
        for (int i = 15; i >= 0; --i) { run += gv[i]; d[i] = run; }
    }
    LAS float* seg = (LAS float*)(lds + HG_SEG);
    seg[j * 128 + k] = run;
    __syncthreads();
    const float s0 = seg[k], s1 = seg[128 + k], s2 = seg[256 + k], s3 = seg[384 + k];
    float off, m;
    if (dir == 0) { off = (j > 0 ? s0 : 0.f) + (j > 1 ? s1 : 0.f) + (j > 2 ? s2 : 0.f); m = s0 + s1; }
    else { off = (j < 3 ? s3 : 0.f) + (j < 2 ? s2 : 0.f) + (j < 1 ? s1 : 0.f); m = s2 + s3; }
#pragma unroll
    for (int i = 0; i < 16; ++i) d[i] = d[i] + off - m;
    m_out = m; tot_out = (s0 + s1) + (s2 + s3);
}
__device__ __forceinline__ void hg_load_v(const bf16_t* HV, int tok0, int h, LAS unsigned char* lds, int tid) {
#pragma unroll
    for (int i = 0; i < 2; ++i) { const int ch = tid + 512 * i, p = ch >> 4, part = ch & 15;
        *(LAS u32x4*)(lds + HG_V + p * HG_VROW + part * 16) = *(const u32x4*)(HV + (size_t)(tok0 + p) * 512 + h * 128 + part * 8); }
}
__device__ __forceinline__ void hg_load_g(const float* G, int tok0, int h, int k, int j, float (&gv)[16]) {
    const float* gp = G + (size_t)(tok0 + 16 * j) * 512 + h * 128 + k;
#pragma unroll
    for (int i = 0; i < 16; ++i) gv[i] = gp[(size_t)i * 512];
}

__device__ __forceinline__ void hg1_phase(int bx, int G, const float* GF, const float* GB, const bf16_t* HV, bf16_t* UT, float* Dg, float* Eg, LAS unsigned char* lds) {
    int tid_ = threadIdx.x; asm volatile("" : "+v"(tid_));
    const int tid = tid_, wave = __builtin_amdgcn_readfirstlane(tid >> 6), lane = tid & 63;
    const int k = tid & 127, j = tid >> 7, i16 = lane & 15, g4 = lane >> 4;
    float gn[16];
    if (bx < 2048) { const int u = bx, dir = u & 1, cch = (u >> 1) & 63, bh = u >> 7; hg_load_g(dir ? GB : GF, (bh >> 2) * SEQ + cch * 64, bh & 3, k, j, gn); }
    for (int u = bx; u < 2048; u += G) {
        const int dir = u & 1, cch = (u >> 1) & 63, bh = u >> 7, b = bh >> 2, h = bh & 3;
        const int tok0 = b * SEQ + cch * 64;
        float gv[16], d[16], m, tot;
#pragma unroll
        for (int i = 0; i < 16; ++i) gv[i] = gn[i];
        u32x4 vr[2];
#pragma unroll
        for (int i = 0; i < 2; ++i) { const int ch = tid + 512 * i; vr[i] = *(const u32x4*)(HV + (size_t)(tok0 + (ch >> 4)) * 512 + h * 128 + (ch & 15) * 8); }
        hg_cumsum(gv, dir, k, j, lds, d, m, tot);
        float kt[16];
#pragma unroll
        for (int i = 0; i < 16; ++i) kt[i] = (1.0f - __expf(gv[i])) * __expf(fminf(-d[i], 40.f));
        { u32x4 w0, w1;
          w0.x = pk2(kt[0], kt[1]); w0.y = pk2(kt[2], kt[3]); w0.z = pk2(kt[4], kt[5]); w0.w = pk2(kt[6], kt[7]);
          w1.x = pk2(kt[8], kt[9]); w1.y = pk2(kt[10], kt[11]); w1.z = pk2(kt[12], kt[13]); w1.w = pk2(kt[14], kt[15]);
          *(LAS u32x4*)(lds + HG_A + k * HG_KTROW + j * 32) = w0; *(LAS u32x4*)(lds + HG_A + k * HG_KTROW + j * 32 + 16) = w1; }
#pragma unroll
        for (int i = 0; i < 2; ++i) { const int ch = tid + 512 * i; *(LAS u32x4*)(lds + HG_V + (ch >> 4) * HG_VROW + (ch & 15) * 16) = vr[i]; }
        if (j == 0) { ((LAS float*)(lds + HG_F))[k] = __expf(tot - m); Dg[(size_t)u * 128 + k] = __expf(tot); Eg[(size_t)u * 128 + k] = __expf(m); }
        __syncthreads();
        if (u + G < 2048) { const int u2 = u + G, dir2 = u2 & 1, cch2 = (u2 >> 1) & 63, bh2 = u2 >> 7; hg_load_g(dir2 ? GB : GF, (bh2 >> 2) * SEQ + cch2 * 64, bh2 & 3, k, j, gn); }
        bf16x8 af[2];
#pragma unroll
        for (int s = 0; s < 2; ++s) {
            const LAS unsigned char* ap = lds + HG_A + (16 * wave + i16) * HG_KTROW + (32 * s + 4 * g4) * 2;
            const u32x2 lo = *(const LAS u32x2*)ap, hi = *(const LAS u32x2*)(ap + 32);
            af[s] = __builtin_bit_cast(bf16x8, (u32x4){lo.x, lo.y, hi.x, hi.y});
        }
        const f32x4 fsc = *(const LAS f32x4*)(lds + HG_F + (16 * wave + 4 * g4) * 4);
        const LAS unsigned char* vbase = lds + HG_V + (4 * g4 + (i16 >> 2)) * HG_VROW + (i16 & 3) * 8;
#pragma unroll
        for (int vt = 0; vt < 8; ++vt) {
            f32x4 acc = {0.f, 0.f, 0.f, 0.f};
#pragma unroll
            for (int s = 0; s < 2; ++s) {
                const s16x4 t0 = tr_read(vbase + (32 * s) * HG_VROW + vt * 32), t1 = tr_read(vbase + (32 * s + 16) * HG_VROW + vt * 32);
                const bf16x8 bv = {t0[0], t0[1], t0[2], t0[3], t1[0], t1[1], t1[2], t1[3]};
                acc = __builtin_amdgcn_mfma_f32_16x16x32_bf16(af[s], bv, acc, 0, 0, 0);
            }
            u32x2 w; w.x = pk2(acc[0] * fsc[0], acc[1] * fsc[1]); w.y = pk2(acc[2] * fsc[2], acc[3] * fsc[3]);
            *(u32x2*)(UT + ((size_t)u * 128 + 16 * vt + i16) * 128 + 16 * wave + 4 * g4) = w;
        }
        __syncthreads();
    }
}

__device__ __forceinline__ void hg2_scan(bf16_t* UT, const float* Dg, const float* Eg, int gthread, int nthreads) {
    for (int idx = gthread; idx < 32 * 4096; idx += nthreads) {
        const int chain = idx >> 12, e4 = idx & 4095, v = e4 >> 5, k0 = (e4 & 31) * 4;
        const int dir = chain & 1, bh = chain >> 1;
        float S0 = 0.f, S1 = 0.f, S2 = 0.f, S3 = 0.f;
        int u = (bh * 64 + (dir ? 63 : 0)) * 2 + dir;
        const int ustep = dir ? -2 : 2;
        u32x2 uu[4]; f32x4 dd[4], ee[4];
#pragma unroll
        for (int r = 0; r < 4; ++r) { const int ur = u + r * ustep; uu[r] = *(const u32x2*)(UT + ((size_t)ur * 128 + v) * 128 + k0); dd[r] = *(const f32x4*)(Dg + (size_t)ur * 128 + k0); ee[r] = *(const f32x4*)(Eg + (size_t)ur * 128 + k0); }
        for (int cc = 0; cc < 64; cc += 4) {
#pragma unroll
            for (int r = 0; r < 4; ++r) {
                const u32x2 uc = uu[r]; const f32x4 dc = dd[r], ec = ee[r];
                if (cc + 4 < 64) { const int un = u + 4 * ustep; uu[r] = *(const u32x2*)(UT + ((size_t)un * 128 + v) * 128 + k0); dd[r] = *(const f32x4*)(Dg + (size_t)un * 128 + k0); ee[r] = *(const f32x4*)(Eg + (size_t)un * 128 + k0); }
                u32x2 w; w.x = pk2(ec.x * S0, ec.y * S1); w.y = pk2(ec.z * S2, ec.w * S3);
                *(u32x2*)(UT + ((size_t)u * 128 + v) * 128 + k0) = w;
                S0 = dc.x * S0 + bflo(uc.x); S1 = dc.y * S1 + bfhi(uc.x); S2 = dc.z * S2 + bflo(uc.y); S3 = dc.w * S3 + bfhi(uc.y);
                u += ustep;
            }
        }
    }
}

constexpr int HG_OUT = HG_Bq + 64 * HG_QKROW;
__device__ __forceinline__ void hg3_unit(int u3, const float* GF, const float* GB, const bf16_t* HQ, const bf16_t* HV, const bf16_t* ST, const bf16_t* BG, const float* gainH, bf16_t* AO, LAS unsigned char* lds) {
    int tid_ = threadIdx.x; asm volatile("" : "+v"(tid_));
    const int tid = tid_, wave = __builtin_amdgcn_readfirstlane(tid >> 6), lane = tid & 63;
    const int cch = u3 & 63, bh = u3 >> 6, b = bh >> 2, h = bh & 3;
    const int tok0 = b * SEQ + cch * 64, k = tid & 127, j = tid >> 7;
    const int tb = wave & 3, vh = wave >> 2, i16 = lane & 15, g4 = lane >> 4;
    float gf[16], gb[16]; unsigned short qr[16];
    hg_load_g(GF, tok0, h, k, j, gf); hg_load_g(GB, tok0, h, k, j, gb);
    { const bf16_t* qp = HQ + (size_t)(tok0 + 16 * j) * 512 + h * 128 + k;
#pragma unroll
      for (int i = 0; i < 16; ++i) qr[i] = qp[(size_t)i * 512]; }
    hg_load_v(HV, tok0, h, lds, tid);
    bf16x8 sb[16];
    { const bf16_t* stp = ST + ((size_t)((bh * 64 + cch) * 2 + 0) * 128) * 128;
#pragma unroll
      for (int vv = 0; vv < 4; ++vv)
#pragma unroll
        for (int ks = 0; ks < 4; ++ks) sb[vv * 4 + ks] = *(const bf16x8*)(stp + (size_t)(16 * (4 * vh + vv) + i16) * 128 + 32 * ks + 8 * g4); }
    f32x4 oacc[4];
#pragma unroll
    for (int i = 0; i < 4; ++i) oacc[i] = (f32x4){0.f, 0.f, 0.f, 0.f};
#pragma unroll
    for (int dir = 0; dir < 2; ++dir) {
        float d[16], m, tot;
        hg_cumsum(dir ? gb : gf, dir, k, j, lds, d, m, tot);
#pragma unroll
        for (int i = 0; i < 16; ++i) {
            const float gvi = dir ? gb[i] : gf[i];
            const float kt = (1.0f - __expf(gvi)) * __expf(fminf(-d[i], 40.f));
            const float qt = bf2f(qr[i]) * __expf(fminf(d[i], 40.f));
            *(LAS unsigned short*)(lds + HG_A + (16 * j + i) * HG_QKROW + k * 2) = (unsigned short)f2bf(kt);
            *(LAS unsigned short*)(lds + HG_Bq + (16 * j + i) * HG_QKROW + k * 2) = (unsigned short)f2bf(qt);
        }
        __syncthreads();
        f32x4 pt[4];
#pragma unroll
        for (int sg = 0; sg < 4; ++sg) pt[sg] = (f32x4){0.f, 0.f, 0.f, 0.f};
        bf16x8 qa[4];
#pragma unroll
        for (int ks = 0; ks < 4; ++ks) qa[ks] = *(const LAS bf16x8*)(lds + HG_Bq + (16 * tb + i16) * HG_QKROW + (32 * ks + 8 * g4) * 2);
#pragma unroll
        for (int sg = 0; sg < 4; ++sg)
#pragma unroll
            for (int ks = 0; ks < 4; ++ks) {
                const bf16x8 ka = *(const LAS bf16x8*)(lds + HG_A + (16 * sg + i16) * HG_QKROW + (32 * ks + 8 * g4) * 2);
                pt[sg] = __builtin_amdgcn_mfma_f32_16x16x32_bf16(ka, qa[ks], pt[sg], 0, 0, 0);
            }
        const int tcol = 16 * tb + i16;
#pragma unroll
        for (int sg = 0; sg < 4; ++sg)
#pragma unroll
            for (int e = 0; e < 4; ++e) { const int srow = 16 * sg + 4 * g4 + e; const bool keep = dir ? (srow >= tcol) : (srow <= tcol); pt[sg][e] = keep ? pt[sg][e] : 0.f; }
        bf16x8 pa[2];
#pragma unroll
        for (int s2 = 0; s2 < 2; ++s2) {
            u32x4 w; w.x = pk2(pt[2 * s2][0], pt[2 * s2][1]); w.y = pk2(pt[2 * s2][2], pt[2 * s2][3]); w.z = pk2(pt[2 * s2 + 1][0], pt[2 * s2 + 1][1]); w.w = pk2(pt[2 * s2 + 1][2], pt[2 * s2 + 1][3]);
            pa[s2] = __builtin_bit_cast(bf16x8, w);
        }
        const LAS unsigned char* vbase = lds + HG_V + (4 * g4 + (i16 >> 2)) * HG_VROW + (i16 & 3) * 8;
#pragma unroll
        for (int vv = 0; vv < 4; ++vv) {
            const int vt = 4 * vh + vv;
#pragma unroll
            for (int s2 = 0; s2 < 2; ++s2) {
                const s16x4 t0 = tr_read(vbase + (32 * s2) * HG_VROW + vt * 32), t1 = tr_read(vbase + (32 * s2 + 16) * HG_VROW + vt * 32);
                const bf16x8 bv = {t0[0], t0[1], t0[2], t0[3], t1[0], t1[1], t1[2], t1[3]};
                oacc[vv] = __builtin_amdgcn_mfma_f32_16x16x32_bf16(pa[s2], bv, oacc[vv], 0, 0, 0);
            }
#pragma unroll
            for (int ks = 0; ks < 4; ++ks) oacc[vv] = __builtin_amdgcn_mfma_f32_16x16x32_bf16(qa[ks], sb[vv * 4 + ks], oacc[vv], 0, 0, 0);
        }
        if (dir == 0) {
            const bf16_t* stp = ST + ((size_t)((bh * 64 + cch) * 2 + 1) * 128) * 128;
#pragma unroll
            for (int vv = 0; vv < 4; ++vv)
#pragma unroll
                for (int ks = 0; ks < 4; ++ks) sb[vv * 4 + ks] = *(const bf16x8*)(stp + (size_t)(16 * (4 * vh + vv) + i16) * 128 + 32 * ks + 8 * g4);
        }
        __syncthreads();
    }
    LAS float* ot = (LAS float*)(lds + HG_OUT);
#pragma unroll
    for (int vv = 0; vv < 4; ++vv)
#pragma unroll
        for (int e = 0; e < 4; ++e) ot[(16 * tb + 4 * g4 + e) * 132 + 16 * (4 * vh + vv) + i16] = oacc[vv][e];
    __syncthreads();
    {
        const int t = tid >> 3, part = tid & 7;
        float v[16]; float ss = 0.f;
#pragma unroll
        for (int i = 0; i < 4; ++i) { const f32x4 x = *(const LAS f32x4*)(ot + t * 132 + 16 * part + 4 * i); v[4 * i] = x.x; v[4 * i + 1] = x.y; v[4 * i + 2] = x.z; v[4 * i + 3] = x.w; ss += (x.x * x.x + x.y * x.y) + (x.z * x.z + x.w * x.w); }
        ss += __shfl_xor(ss, 1); ss += __shfl_xor(ss, 2); ss += __shfl_xor(ss, 4);
        const float rs = rsqrtf(ss * (1.0f / 128.0f) + EPS);
        const float* gp = gainH + h * 128 + 16 * part;
        const bf16_t* bgp = BG + (size_t)(tok0 + t) * 512 + h * 128 + 16 * part;
        bf16_t* dst = AO + (size_t)(tok0 + t) * 1024 + 512 + h * 128 + 16 * part;
#pragma unroll
        for (int i = 0; i < 2; ++i) {
            const u32x4 gq = *(const u32x4*)(bgp + 8 * i);
            const f32x4 g0 = *(const f32x4*)(gp + 8 * i), g1 = *(const f32x4*)(gp + 8 * i + 4);
            u32x4 w;
            w.x = pk2(v[8 * i] * rs * g0.x * bflo(gq.x), v[8 * i + 1] * rs * g0.y * bfhi(gq.x)); w.y = pk2(v[8 * i + 2] * rs * g0.z * bflo(gq.y), v[8 * i + 3] * rs * g0.w * bfhi(gq.y));
            w.z = pk2(v[8 * i + 4] * rs * g1.x * bflo(gq.z), v[8 * i + 5] * rs * g1.y * bfhi(gq.z)); w.w = pk2(v[8 * i + 6] * rs * g1.z * bflo(gq.w), v[8 * i + 7] * rs * g1.w * bfhi(gq.w));
            *(u32x4*)(dst + 8 * i) = w;
        }
    }
    __syncthreads();
}

#define XB_TMO      128
#define XB_XCNT(j)  (256  + 64 * (j))
#define XB_XSUB(j)  (1280 + 64 * (j))
#define XB_XGEN(j)  (2304 + 64 * (j))
#define XB_TOP      3328
#define XB_TOPGEN   3392
#define XCD_BAR_WORDS 3456
#define XB_SPIN_CAP (1u << 18)

__device__ __forceinline__ unsigned xb_ld(unsigned* p)              { return __hip_atomic_load(p, __ATOMIC_RELAXED, __HIP_MEMORY_SCOPE_AGENT); }
__device__ __forceinline__ unsigned xb_add(unsigned* p, unsigned v) { return __hip_atomic_fetch_add(p, v, __ATOMIC_RELAXED, __HIP_MEMORY_SCOPE_AGENT); }
__device__ __forceinline__ unsigned xb_xcc_id() { return (unsigned)__builtin_amdgcn_s_getreg((3 << 11) | 20) & 0xFu; }
#define XB_SPIN(cond, bar) do { unsigned _sp = 0; while (cond) { __builtin_amdgcn_s_sleep(1); \
    if ((++_sp & 255u) == 0u) { if (xb_ld(&(bar)[XB_TMO])) break; if (_sp > XB_SPIN_CAP) { atomicAdd(&(bar)[XB_TMO], 1u); break; } } } } while (0)

struct XcdBarrier {
    unsigned* bar; unsigned x;
    volatile LAS unsigned* st;
};

__device__ __forceinline__ XcdBarrier xcd_barrier_post(unsigned* bar, volatile LAS unsigned* st) {
    XcdBarrier b; b.bar = bar; b.x = xb_xcc_id(); b.st = st;
    if (threadIdx.x == 0) (void)xb_add(&bar[XB_XCNT(b.x)], 1u);
    return b;
}
__device__ __forceinline__ void xcd_barrier_complete(unsigned* bar, unsigned x, unsigned& nloc, unsigned& nx) {
    const unsigned G = gridDim.x * gridDim.y * gridDim.z;
    unsigned sum, cnt, mine, sp = 0u;
    for (;;) {
        sum = 0u; cnt = 0u; mine = 0u;
#pragma unroll
        for (unsigned j = 0; j < 16; ++j) { const unsigned c = xb_ld(&bar[XB_XCNT(j)]); sum += c; cnt += (c > 0u) ? 1u : 0u; mine = (j == x) ? c : mine; }
        if (sum == G) break;
        __builtin_amdgcn_s_sleep(1);
        if ((++sp & 255u) == 0u) { if (xb_ld(&bar[XB_TMO])) break; if (sp > XB_SPIN_CAP) { atomicAdd(&bar[XB_TMO], 1u); break; } }
    }
    nloc = mine > 0u ? mine : 1u; nx = cnt > 0u ? cnt : 1u;
}

__device__ __forceinline__ void xcd_barrier(const XcdBarrier& b) {
    asm volatile("s_waitcnt vmcnt(0)" ::: "memory");
    __syncthreads();
    if (threadIdx.x == 0) {
        unsigned* bar = b.bar;
        __builtin_amdgcn_s_waitcnt(0);
        unsigned nloc = b.st[0], nx = b.st[1];
        if (nloc == 0u) { xcd_barrier_complete(bar, b.x, nloc, nx); b.st[0] = nloc; b.st[1] = nx; }
        const unsigned old = xb_add(&bar[XB_XSUB(b.x)], 1u);
        const unsigned gen = old / nloc;
        if (old + 1u == (gen + 1u) * nloc) {
            __builtin_amdgcn_fence(__ATOMIC_RELEASE, "agent");
            asm volatile("s_waitcnt vmcnt(0)" ::: "memory");
            const unsigned og = xb_add(&bar[XB_TOP], 1u);
            const unsigned tg = og / nx;
            if (og + 1u == (tg + 1u) * nx) xb_add(&bar[XB_TOPGEN], 1u);
            else XB_SPIN(xb_ld(&bar[XB_TOPGEN]) == tg, bar);
            __builtin_amdgcn_fence(__ATOMIC_ACQUIRE, "agent");
            xb_add(&bar[XB_XGEN(b.x)], 1u);
            asm volatile("s_waitcnt vmcnt(0)" ::: "memory");
        } else {
            XB_SPIN(xb_ld(&bar[XB_XGEN(b.x)]) == gen, bar);
            __builtin_amdgcn_fence(__ATOMIC_ACQUIRE, "agent");
            asm volatile("s_waitcnt vmcnt(0)" ::: "memory");
        }
    }
    __syncthreads();
}

__global__ void __launch_bounds__(512, 2) fwd_kernel(Ptrs P) {
    extern __shared__ __attribute__((aligned(16))) unsigned char lds_raw[];
    LAS unsigned char* lds = (LAS unsigned char*)lds_raw;
    cg::grid_group grid = cg::this_grid();
    const int G = gridDim.x, bx = blockIdx.x;
    const int lo = P.ph_lo, hi = P.ph_hi;
    int ph = 0;
    if (threadIdx.x < 4) ((LAS unsigned*)(lds + 131072 + 1024))[threadIdx.x] = 0u;
    __syncthreads();
    XcdBarrier xbar = xcd_barrier_post((unsigned*)(P.ws + OFF_BAR), (volatile LAS unsigned*)(lds + 131072 + 1024));
#ifdef TS_A
    if (threadIdx.x == 0) { LAS unsigned long long* TS_ = (LAS unsigned long long*)(lds + 131072); for (int i = 0; i < 15; ++i) TS_[i] = 0ull; TS_[15] = __builtin_amdgcn_s_memrealtime(); }
#endif
#ifndef PH_MASK
#define PH_MASK 0xFFFFFFFFu
#endif
#define ON(id) constexpr (((PH_MASK) >> (id)) & 1u)
#define PHASE_BEGIN if (ph >= lo && ph < hi) { unsigned char* ws = P.ws; asm volatile("" : "+s"(ws)); int tid = threadIdx.x; asm volatile("" : "+v"(tid)); \
    const int lane = tid & 63, wave = __builtin_amdgcn_readfirstlane(tid >> 6), gw = bx * 8 + wave, ngw = G * 8; (void)lane; (void)gw; (void)ngw;
#define XB ((bf16_t*)(ws + OFF_XB))
#define RSA ((float*)(ws + OFF_RSA))
#define RSB ((float*)(ws + OFF_RSB))
#define CS ((const float*)(ws + OFF_CS))
#define LB ((const float*)(ws + OFF_LB))
#define LAM ((const float*)(ws + OFF_LAM))
#define Dg ((float*)(ws + OFF_DG))
#define Eg ((float*)(ws + OFF_EG))
#define GATE ((bf16_t*)(ws + OFF_GATE))
#define Qb ((bf16_t*)(ws + OFF_Q))
#define Kb ((bf16_t*)(ws + OFF_K))
#define Vb ((bf16_t*)(ws + OFF_V))
#define HQ ((bf16_t*)(ws + OFF_HQ))
#define HV ((bf16_t*)(ws + OFF_HV))
#define GF ((float*)(ws + OFF_GF))
#define GB ((float*)(ws + OFF_GB))
#define Yb ((bf16_t*)(ws + OFF_Y))
#define BG ((bf16_t*)(ws + OFF_BG))
#define AO ((bf16_t*)(ws + OFF_AO))
#define UT ((bf16_t*)(ws + OFF_UT))
#define Hb ((bf16_t*)(ws + OFF_H))
#ifdef TS_A
#define TICK(cat) do { if (bx == 0 && threadIdx.x == 0) { LAS unsigned long long* TS_ = (LAS unsigned long long*)(lds + 131072); const unsigned long long t_ = __builtin_amdgcn_s_memrealtime(); TS_[cat] += t_ - TS_[15]; TS_[15] = t_; } } while (0)
#else
#define TICK(cat) do { } while (0)
#endif
#define PHASE_END(cat)   TICK(cat); if (ph + 1 < hi) { if (ph == 0) grid.sync(); else xcd_barrier(xbar); TICK(13); } } ++ph;

    PHASE_BEGIN
        if ON(0) prologue(P, lds, gw, ngw, wave, lane);
        if ON(6) convert_layer(P, 0, ws, lds, gw, ngw, wave, lane);
    PHASE_END(0)

    for (int layer = 0; layer < DEPTH; ++layer) {
        PHASE_BEGIN
            pg8::Gemm g{XB, (const bf16_t*)(ws + (size_t)(layer & 1) * WSZ + W_IN), Dm, Dm, Dm, 1 << 30, 0};
            pg8::StaticOrder S; S.init(M, 4096, G, bx);
            EpiMix E{RSB, CS, LB + (0 * 4 + layer) * 512, LB + (1 * 4 + layer) * 512, Qb, Kb, Vb, HQ, HV, BG, GF, GB};
            if ON(1) pg8::gemm_phase(lds, g, S, E);
        PHASE_END(1)
        PHASE_BEGIN
            const float lam_init = 0.8f - 0.6f * __expf(-0.3f * (float)layer);
            const float lam = LAM[layer];
            if ON(2) for (int i = 0; i * G + bx < 512; ++i) {
                const int uid = i * G + bx; const int round = uid >> 8, r = uid & 255;
                const int bhh = round * 8 + (r & 7), qb = r >> 3;
                attn_unit(bhh >> 2, bhh & 3, qb, Qb, Kb, Vb, AO, P.da_norm + layer * 512, 1.0f - lam_init, lam, lds);
            }
            TICK(2);
            if ON(3) hg1_phase(bx, G, GF, GB, HV, UT, Dg, Eg, lds);
        PHASE_END(3)
        PHASE_BEGIN
            {
                pg8::Gemm g{XB, (const bf16_t*)(ws + (size_t)(layer & 1) * WSZ + W_IN) + (size_t)4096 * Dm, Dm, Dm, Dm, 1 << 30, 0};
                pg8::StaticOrder S; S.init(M, 2048, G, bx);
                EpiGate E{RSB, GATE};
                if ON(4) pg8::gemm_phase(lds, g, S, E);
            }
            TICK(4);
            if ON(5) hg2_scan(UT, Dg, Eg, bx * 512 + tid, G * 512);
            TICK(5);
            if ON(6) if (layer + 1 < DEPTH) convert_layer(P, layer + 1, ws + (size_t)((layer + 1) & 1) * WSZ, lds, gw, ngw, wave, lane);
        PHASE_END(6)
        PHASE_BEGIN
            if ON(7) for (int u = bx; u < 1024; u += G) hg3_unit(u, GF, GB, HQ, HV, UT, BG, P.hg_norm + layer * 512, AO, lds);
        PHASE_END(7)
        PHASE_BEGIN
            pg8::Gemm g{AO, (const bf16_t*)(ws + (size_t)(layer & 1) * WSZ + W_AB), 1024, 512, 512, 4, 512};
            pg8::StaticOrder S; S.init(M, 2048, G, bx);
            EpiY E{GATE, Yb};
            if ON(8) pg8::gemm_phase(lds, g, S, E);
        PHASE_END(8)
        PHASE_BEGIN
            pg8::Gemm g{Yb, (const bf16_t*)(ws + (size_t)(layer & 1) * WSZ + W_O2), 2048, 2048, 2048, 1 << 30, 0};
            pg8::StaticOrder S; S.init(M, Dm, G, bx);
            EpiRes E{layer == 0 ? P.x : P.out, P.out, XB, RSA};
            if ON(9) pg8::gemm_phase(lds, g, S, E);
        PHASE_END(9)
        PHASE_BEGIN
            pg8::Gemm g{XB, (const bf16_t*)(ws + (size_t)(layer & 1) * WSZ + W_GU), Dm, Dm, Dm, 1 << 30, 0};
            pg8::StaticOrder S; S.init(M, 2 * FF, G, bx);
            EpiGU E{RSA, Hb};
            if ON(10) pg8::gemm_phase(lds, g, S, E);
        PHASE_END(10)
        PHASE_BEGIN
            pg8::Gemm g{Hb, (const bf16_t*)(ws + (size_t)(layer & 1) * WSZ + W_D), FF, FF, FF, 1 << 30, 0};
            pg8::StaticOrder S; S.init(M, Dm, G, bx);
            EpiRes E{P.out, P.out, XB, RSB};
            if ON(11) pg8::gemm_phase(lds, g, S, E);
        PHASE_END(11)
    }
    PHASE_BEGIN
        if ON(12) for (int r = gw; r < M; r += ngw) {
            f32x4* xr = (f32x4*)(P.out + (size_t)r * Dm) + lane;
            f32x4 v[4]; float ss = 0.f;
#pragma unroll
            for (int j = 0; j < 4; ++j) { v[j] = xr[64 * j]; ss += (v[j].x * v[j].x + v[j].y * v[j].y) + (v[j].z * v[j].z + v[j].w * v[j].w); }
            const float rs = rsqrtf(wave_sum(ss) * (1.0f / Dm) + EPS);
#pragma unroll
            for (int j = 0; j < 4; ++j) { const f32x4 gn = *((const f32x4*)P.final_norm + lane + 64 * j); xr[64 * j] = (f32x4){v[j].x * rs * gn.x, v[j].y * rs * gn.y, v[j].z * rs * gn.z, v[j].w * rs * gn.w}; }
        }
    PHASE_END(12)
#ifdef TS_A
    if (bx == 0 && threadIdx.x == 0) {
        LAS unsigned long long* TS_ = (LAS unsigned long long*)(lds + 131072);
        unsigned long long a = 0;
        for (int i = 0; i < 15; ++i) { if ((TS_A >> i) & 1) a += TS_[i]; }
        const unsigned long long t_end = __builtin_amdgcn_s_memrealtime() + a;
        while (__builtin_amdgcn_s_memrealtime() < t_end) __builtin_amdgcn_s_sleep(20);
    }
#endif
}
constexpr int NPHASES = 2 + 8 * DEPTH;

#ifndef MK_PER_PHASE
#define MK_PER_PHASE 0
#endif

extern "C" void kernel_launch(void* const* d_in, const int* in_sizes, int n_in, void* d_out, int out_size, void* d_ws, size_t ws_size, hipStream_t stream) {
    static int grid = 0;
    if (grid == 0) {
        if (n_in != 16 || out_size != M * Dm || ws_size < WS_END) { fprintf(stderr, "kernel_launch: unexpected sizes (n_in %d, out %d, ws %zu, need %zu)\n", n_in, out_size, ws_size, (size_t)WS_END); grid = -1; return; }
        int dev = 0, cus = 0, per_cu = 0;
        (void)hipGetDevice(&dev);
        (void)hipDeviceGetAttribute(&cus, hipDeviceAttributeMultiprocessorCount, dev);
        if (hipFuncSetAttribute((const void*)fwd_kernel, hipFuncAttributeMaxDynamicSharedMemorySize, LDS_BYTES) != hipSuccess) { fprintf(stderr, "kernel_launch: hipFuncSetAttribute failed\n"); grid = -1; return; }
        (void)hipOccupancyMaxActiveBlocksPerMultiprocessor(&per_cu, (const void*)fwd_kernel, 512, LDS_BYTES);
        (void)hipGetLastError();
        if (per_cu < 1) per_cu = 1;
        grid = cus * 1;
        fprintf(stderr, "kernel_launch: grid %d (per_cu %d), ws %zu need %zu\n", grid, per_cu, ws_size, (size_t)WS_END);
    }
    if (grid < 0) return;
    Ptrs p{};
    p.x = (const float*)d_in[0]; p.pos = (const int*)d_in[1]; p.w_in = (const float*)d_in[2]; p.da_lambda = (const float*)d_in[3]; p.da_norm = (const float*)d_in[4];
    p.hg_lb = (const float*)d_in[5]; p.hg_norm = (const float*)d_in[6]; p.w_a = (const float*)d_in[7]; p.w_b = (const float*)d_in[8]; p.w_o = (const float*)d_in[9];
    p.attn_norm = (const float*)d_in[10]; p.ffn_norm = (const float*)d_in[11]; p.w_gate = (const float*)d_in[12]; p.w_up = (const float*)d_in[13]; p.w_down = (const float*)d_in[14];
    p.final_norm = (const float*)d_in[15];
    p.out = (float*)d_out; p.ws = (unsigned char*)d_ws;
    (void)hipMemsetAsync((char*)d_ws + OFF_BAR, 0, BAR_BYTES, stream);
#if MK_PER_PHASE
    for (int ph = 0; ph < NPHASES; ++ph) {
        p.ph_lo = ph; p.ph_hi = ph + 1;
        hipLaunchKernelGGL(fwd_kernel, dim3(grid), dim3(512), LDS_BYTES, stream, p);
    }
#else
    p.ph_lo = 0; p.ph_hi = NPHASES;
    void* args[] = {&p};
    hipError_t e = hipLaunchCooperativeKernel((const void*)fwd_kernel, dim3(grid), dim3(512), args, LDS_BYTES, stream);
    if (e != hipSuccess) fprintf(stderr, "cooperative launch failed: %s (grid %d)\n", hipGetErrorString(e), grid);
#endif
}
```

```cpp
#include <hip/hip_runtime.h>
#include <hip/hip_cooperative_groups.h>
#include <cstdio>
#include <cstdint>
namespace cg = cooperative_groups;

#define LAS __attribute__((address_space(3)))
typedef unsigned short bf16_t;
typedef short bf16x8 __attribute__((ext_vector_type(8)));
typedef short s16x4 __attribute__((ext_vector_type(4)));
typedef float f32x4 __attribute__((ext_vector_type(4)));
typedef float f32x16 __attribute__((ext_vector_type(16)));
typedef unsigned u32x4 __attribute__((ext_vector_type(4)));
typedef unsigned u32x2 __attribute__((ext_vector_type(2)));

constexpr int Dm = 1024, NB = 4, SEQ = 4096, M = NB * SEQ, DEPTH = 4, FF = 2816, INW = 6144;
constexpr float EPS = 1e-6f;
constexpr float LOG2E = 1.4426950408889634f;

constexpr size_t W_IN = 0, W_AB = 12582912, W_O2 = 14680064, W_GU = 18874368, W_D = 30408704, WSZ = 36175872;
constexpr size_t MiB = 1048576;
constexpr size_t OFF_XB = 2 * WSZ;
constexpr size_t OFF_RSA = OFF_XB + 32 * MiB;
constexpr size_t OFF_RSB = OFF_RSA + MiB;
constexpr size_t OFF_CS = OFF_RSB + MiB;
constexpr size_t OFF_LB = OFF_CS + MiB;
constexpr size_t OFF_LAM = OFF_LB + 16384;
constexpr size_t OFF_DG = OFF_LAM + 256;
constexpr size_t OFF_EG = OFF_DG + MiB;
constexpr size_t OFF_B = OFF_EG + MiB;
constexpr size_t OFF_GATE = OFF_B;
constexpr size_t OFF_Q = OFF_B, OFF_K = OFF_B + 16 * MiB, OFF_V = OFF_B + 32 * MiB;
constexpr size_t OFF_HQ = OFF_B + 64 * MiB;
constexpr size_t OFF_HV = OFF_HQ + 16 * MiB;
constexpr size_t OFF_GF = OFF_HV + 16 * MiB;
constexpr size_t OFF_GB = OFF_GF + 32 * MiB;
constexpr size_t OFF_Y = OFF_GF;
constexpr size_t OFF_BG = OFF_GB + 32 * MiB;
constexpr size_t OFF_AO = OFF_BG + 16 * MiB;
constexpr size_t OFF_UT = OFF_AO + 32 * MiB;
constexpr size_t OFF_H = OFF_B;
constexpr size_t OFF_BAR = OFF_UT + 64 * MiB;
constexpr size_t BAR_BYTES = 16384;
constexpr size_t WS_END = OFF_BAR + BAR_BYTES;

constexpr int LDS_BYTES = 131072 + 2048;

__device__ __forceinline__ unsigned f2bf(float f) { unsigned u = __builtin_bit_cast(unsigned, f); return (u + 0x7fffu + ((u >> 16) & 1u)) >> 16; }
typedef float f32x2_t __attribute__((ext_vector_type(2)));
typedef __bf16 bf16x2_t __attribute__((ext_vector_type(2)));
__device__ __forceinline__ unsigned pk2(float lo, float hi) { f32x2_t v = {lo, hi}; bf16x2_t b = __builtin_convertvector(v, bf16x2_t); return __builtin_bit_cast(unsigned, b); }
__device__ __forceinline__ float bf2f(unsigned short b) { return __builtin_bit_cast(float, (unsigned)b << 16); }
__device__ __forceinline__ float bflo(unsigned u) { return __builtin_bit_cast(float, u << 16); }
__device__ __forceinline__ float bfhi(unsigned u) { return __builtin_bit_cast(float, u & 0xffff0000u); }
__device__ __forceinline__ float sigmoidf_(float x) { return 1.0f / (1.0f + __expf(-x)); }

namespace pg8 {
constexpr int BM = 256, BK = 64, HALF = 128, HTB = HALF * BK * 2, STAGE_BYTES = 8 * HTB, NXCD = 8, WGM = 8;
__host__ __device__ __forceinline__ int lds_byte(int r, int c) { const int st = (r >> 4) * 2 + (c >> 5), rr = r & 15, cc = c & 31, ob = rr * 64 + cc * 2; return st * 1024 + (ob ^ (((ob >> 9) & 1) << 5)); }
__host__ __device__ __forceinline__ void stage_rc(int b, int& R, int& C) { const int st = b / 1024, sb = b % 1024, swz = sb ^ (((sb >> 9) & 1) << 5); R = (st >> 1) * 16 + swz / 64; C = (st & 1) * 32 + (swz % 64) / 2; }
__host__ __device__ __forceinline__ int perm32(int rho) { const int n = rho >> 4, i = rho & 15; return 8 * (i >> 2) + 4 * n + (i & 3); }

struct Unit { int pm, pn; };
struct Gemm { const bf16_t* A; const bf16_t* Bt; int lda, ldb, K; int split_pn; int split_aoff; int mid_t; };

struct StaticOrder {
    int nM, nN, nwg, G, c;
    __device__ __forceinline__ void init(int M_, int N_, int G_, int c_) { nM = M_ / BM; nN = N_ / BM; nwg = nM * nN; G = G_; c = c_; }
    __device__ bool next(int i, Unit& u) const {
        const long L = (long)i * G + c; if (L >= nwg) return false;
        int wgid = (int)L; { const int q = nwg / NXCD, r = nwg % NXCD, xcd = wgid % NXCD, off = wgid / NXCD; wgid = (xcd < r ? xcd * (q + 1) : r * (q + 1) + (xcd - r) * q) + off; }
        const int nig = WGM * nN, gid = wgid / nig, fm = gid * WGM, gsz = (nM - fm) < WGM ? (nM - fm) : WGM;
        u.pm = fm + ((wgid % nig) % gsz); u.pn = (wgid % nig) / gsz; return true;
    }
};

template <class Epi>
__device__ __forceinline__ void gemm_phase(LAS unsigned char* lds, const Gemm g, const StaticOrder& S, const Epi& E) {
    int tid_ = threadIdx.x; asm volatile("" : "+v"(tid_));
    const int tid = tid_, wid = __builtin_amdgcn_readfirstlane(tid >> 6), lane = tid & 63, wr = wid >> 2, wc = wid & 3, fr = lane & 15, fq = lane >> 4;
    const int K = g.K, nt = K / BK;
    unsigned voffA[2], voffB[2];
#pragma unroll
    for (int i = 0; i < 2; ++i) { int R, C; stage_rc(tid * 16 + i * 8192, R, C); const int Rb = (R & ~31) + perm32(R & 31);
        voffA[i] = (unsigned)(R * g.lda + C) * 2u; voffB[i] = (unsigned)(Rb * g.ldb + C) * 2u; }
    const size_t kstep = (size_t)(BK * 2);
    const size_t hstepA = (size_t)HALF * g.lda * 2, hstepB = (size_t)HALF * g.ldb * 2;
    const size_t tstepA = 2 * hstepA, tstepB = 2 * hstepB;
    const unsigned ldsw = (unsigned)wid * 1024u;
    const int aoff = lds_byte(wr * 64 + fr, fq * 8), boff = lds_byte(wc * 32 + fr, fq * 8);
#define PG8_SA(b, h) (((b) * 2 + (h)) * HTB)
#define PG8_SB(b, h) ((4 + (b) * 2 + (h)) * HTB)
#define PG8_STAGE(bufoff, gbase, voff) do { _Pragma("unroll") for (int _i = 0; _i < 2; ++_i) \
        __builtin_amdgcn_global_load_lds((const unsigned*)((const char*)(gbase) + (voff)[_i]), (LAS unsigned*)(lds + (bufoff) + ldsw + _i * 8192), 16, 0, 0); } while (0)
#define PG8_LDA(dst, b, h) do { _Pragma("unroll") for (int m = 0; m < 4; ++m) _Pragma("unroll") for (int k = 0; k < 2; ++k) dst[m][k] = *(const LAS bf16x8*)(lds + PG8_SA(b, h) + aoff + m * 2048 + k * 1024); } while (0)
#define PG8_LDB(dst, b, h) do { _Pragma("unroll") for (int n = 0; n < 2; ++n) _Pragma("unroll") for (int k = 0; k < 2; ++k) dst[n][k] = *(const LAS bf16x8*)(lds + PG8_SB(b, h) + boff + n * 2048 + k * 1024); } while (0)
#define PG8_MMA(ai, bj, At, Bt) do { __builtin_amdgcn_s_setprio(1); _Pragma("unroll") for (int m = 0; m < 4; ++m) _Pragma("unroll") for (int n = 0; n < 2; ++n) _Pragma("unroll") for (int k = 0; k < 2; ++k) \
        acc[ai][bj][m][n] = __builtin_amdgcn_mfma_f32_16x16x32_bf16(Bt[n][k], At[m][k], acc[ai][bj][m][n], 0, 0, 0); __builtin_amdgcn_s_setprio(0); } while (0)
#define PG8_WAIT_V(n) asm volatile("s_waitcnt vmcnt(" #n ")" ::: "memory")
#define PG8_WAIT_L(n) asm volatile("s_waitcnt lgkmcnt(" #n ")" ::: "memory")
#define PG8_BAR __builtin_amdgcn_s_barrier()
#define PG8_SCHED __builtin_amdgcn_sched_barrier(0)
#define PG8_UA(u) ((const char*)g.A + (size_t)(u).pm * tstepA + (((u).pn >= g.split_pn) ? (size_t)g.split_aoff * 2 : (size_t)0))
    Unit cur, nxt; int ui = 0;
    if (!S.next(0, cur)) return;
    f32x4 acc[2][2][4][2];
#pragma unroll
    for (int a = 0; a < 2; ++a)
#pragma unroll
        for (int b = 0; b < 2; ++b)
#pragma unroll
            for (int m = 0; m < 4; ++m)
#pragma unroll
                for (int n = 0; n < 2; ++n) acc[a][b][m][n] = (f32x4){0.f, 0.f, 0.f, 0.f};
    bf16x8 At[4][2], B0[2][2], B1[2][2];
    const char* cA = PG8_UA(cur); const char* cB = (const char*)g.Bt + (size_t)cur.pn * tstepB;
    PG8_STAGE(PG8_SB(0, 0), cB, voffB); PG8_STAGE(PG8_SB(0, 1), cB + hstepB, voffB); PG8_STAGE(PG8_SA(0, 0), cA, voffA); PG8_STAGE(PG8_SA(0, 1), cA + hstepA, voffA);
    if (wr == 1) PG8_BAR;
    PG8_WAIT_V(2); PG8_BAR;
    PG8_STAGE(PG8_SB(1, 0), cB + kstep, voffB); PG8_STAGE(PG8_SA(1, 0), cA + kstep, voffA); PG8_STAGE(PG8_SB(1, 1), cB + hstepB + kstep, voffB);
    PG8_WAIT_V(6); PG8_BAR;
    for (;;) {
        const bool has_next = S.next(ui + 1, nxt);
        const char* nA = has_next ? PG8_UA(nxt) : cA; const char* nB = has_next ? (const char*)g.Bt + (size_t)nxt.pn * tstepB : cB;
        for (int t = 0; t < nt; t += 2) {
            if constexpr (Epi::HAS_MID) { if (t == g.mid_t) E.mid(acc, cur, wr, wc, fr, fq); }
            const bool last = (t == nt - 2);
            const char* a1 = cA + (size_t)(t + 1) * kstep;
            const char* a2 = last ? nA : cA + (size_t)(t + 2) * kstep; const char* b2 = last ? nB : cB + (size_t)(t + 2) * kstep;
            const char* a3 = a2 + kstep; const char* b3 = b2 + kstep;
            PG8_LDB(B0, 0, 0); PG8_LDB(B1, 0, 1); PG8_SCHED; PG8_LDA(At, 0, 0); PG8_STAGE(PG8_SA(1, 1), a1 + hstepA, voffA);
            PG8_WAIT_V(8); PG8_WAIT_L(0); PG8_BAR; PG8_MMA(0, 0, At, B0); PG8_MMA(0, 1, At, B1); PG8_BAR; PG8_SCHED;
            PG8_LDA(At, 0, 1); PG8_STAGE(PG8_SB(0, 0), b2, voffB); PG8_STAGE(PG8_SB(0, 1), b2 + hstepB, voffB); PG8_STAGE(PG8_SA(0, 0), a2, voffA);
            PG8_WAIT_V(8); PG8_WAIT_L(0); PG8_BAR; PG8_MMA(1, 0, At, B0); PG8_MMA(1, 1, At, B1); PG8_BAR; PG8_SCHED;
            PG8_LDB(B0, 1, 0); PG8_LDB(B1, 1, 1); PG8_SCHED; PG8_LDA(At, 1, 0); PG8_STAGE(PG8_SA(0, 1), a2 + hstepA, voffA);
            PG8_WAIT_V(8); PG8_WAIT_L(0); PG8_BAR; PG8_MMA(0, 0, At, B0); PG8_MMA(0, 1, At, B1); PG8_BAR; PG8_SCHED;
            PG8_LDA(At, 1, 1); PG8_STAGE(PG8_SB(1, 0), b3, voffB); PG8_STAGE(PG8_SB(1, 1), b3 + hstepB, voffB); PG8_STAGE(PG8_SA(1, 0), a3, voffA);
            PG8_WAIT_V(8); PG8_WAIT_L(0); PG8_BAR; PG8_MMA(1, 0, At, B0); PG8_MMA(1, 1, At, B1); PG8_BAR; PG8_SCHED;
        }
        if (wr == 0) PG8_BAR;
        E(acc, cur, wr, wc, fr, fq);
        if (!has_next) break;
#pragma unroll
        for (int a = 0; a < 2; ++a)
#pragma unroll
            for (int b = 0; b < 2; ++b)
#pragma unroll
                for (int m = 0; m < 4; ++m)
#pragma unroll
                    for (int n = 0; n < 2; ++n) acc[a][b][m][n] = (f32x4){0.f, 0.f, 0.f, 0.f};
        cur = nxt; cA = nA; cB = nB; ++ui;
        if (wr == 1) PG8_BAR;
    }
    PG8_WAIT_V(0);
    PG8_BAR;
#undef PG8_SA
#undef PG8_SB
#undef PG8_STAGE
#undef PG8_LDA
#undef PG8_LDB
#undef PG8_MMA
#undef PG8_UA
}
}

__device__ __forceinline__ float row_rs(const float* rsp, int row) {
    const f32x4* p = (const f32x4*)(rsp + (size_t)row * 16);
    f32x4 a = p[0], b = p[1], c = p[2], d = p[3];
    float s = ((a.x + a.y) + (a.z + a.w)) + ((b.x + b.y) + (b.z + b.w)) + ((c.x + c.y) + (c.z + c.w)) + ((d.x + d.y) + (d.z + d.w));
    return rsqrtf(s * (1.0f / Dm) + EPS);
}
__device__ __forceinline__ u32x4 pack8(const float* v) { u32x4 w; w.x = pk2(v[0], v[1]); w.y = pk2(v[2], v[3]); w.z = pk2(v[4], v[5]); w.w = pk2(v[6], v[7]); return w; }

struct EpiMix {
    static constexpr bool HAS_MID = false;
    const float* rsp; const float* cs; const float* lbF; const float* lbB;
    bf16_t *Q, *Kk, *V, *HQ, *HV, *BG; float *GF, *GB;
    __device__ __forceinline__ void operator()(const f32x4 (&acc)[2][2][4][2], const pg8::Unit& u, int wr, int wc, int fr, int fq) const {
        const int grp = u.pn >> 1;
#pragma unroll
        for (int ai = 0; ai < 2; ++ai)
#pragma unroll
            for (int m = 0; m < 4; ++m) {
                const int row = u.pm * 256 + ai * 128 + wr * 64 + m * 16 + fr;
                const float rs = row_rs(rsp, row);
                const int b = row >> 12, s = row & 4095;
#pragma unroll
                for (int bj = 0; bj < 2; ++bj) {
                    const int col = u.pn * 256 + bj * 128 + wc * 32 + fq * 8;
                    const int jj = col & 511;
                    float v[8];
#pragma unroll
                    for (int e = 0; e < 4; ++e) { v[e] = acc[ai][bj][m][0][e] * rs; v[4 + e] = acc[ai][bj][m][1][e] * rs; }
                    if (grp <= 1) {
                        const int d0 = jj & 63;
                        if (d0 < 16) {
                            const int gsel = d0 >> 3;
                            const f32x4 c4 = *(const f32x4*)(cs + (size_t)row * 16 + gsel * 4), s4 = *(const f32x4*)(cs + (size_t)row * 16 + 8 + gsel * 4);
#pragma unroll
                            for (int e = 0; e < 4; ++e) { const float t1 = v[e], t2 = v[4 + e]; v[e] = t1 * c4[e] - t2 * s4[e]; v[4 + e] = t2 * c4[e] + t1 * s4[e]; }
                        }
                        if (grp == 0) {
#pragma unroll
                            for (int e = 0; e < 8; ++e) v[e] *= 0.125f * LOG2E;
                        }
                        const int h = jj >> 7, c = (jj >> 6) & 1;
                        bf16_t* dst = (grp == 0 ? Q : Kk) + ((size_t)(((b * 4 + h) * 2 + c) * SEQ + s)) * 64 + d0;
                        *(u32x4*)dst = pack8(v);
                    } else if (grp == 2) {
                        const int h = jj >> 7, d0 = jj & 127;
                        *(u32x4*)(V + ((size_t)((b * 4 + h) * SEQ + s)) * 128 + d0) = pack8(v);
                    } else if (grp == 3) {
                        *(u32x4*)(HQ + (size_t)row * 512 + jj) = pack8(v);
                    } else if (grp == 4 || grp == 5) {
                        const float* lbp = (grp == 4 ? lbF : lbB) + jj;
                        const f32x4 l0 = *(const f32x4*)lbp, l1 = *(const f32x4*)(lbp + 4);
                        float gl[8];
#pragma unroll
                        for (int e = 0; e < 8; ++e) { const float lb = e < 4 ? l0[e] : l1[e - 4]; const float f = lb + (1.0f - lb) * sigmoidf_(v[e]); gl[e] = __logf(fmaxf(f, 1e-37f)); }
                        float* dst = (grp == 4 ? GF : GB) + (size_t)row * 512 + jj;
                        *(f32x4*)dst = (f32x4){gl[0], gl[1], gl[2], gl[3]}; *(f32x4*)(dst + 4) = (f32x4){gl[4], gl[5], gl[6], gl[7]};
                    } else if (grp == 6) {
                        *(u32x4*)(HV + (size_t)row * 512 + jj) = pack8(v);
                    } else {
#pragma unroll
                        for (int e = 0; e < 8; ++e) v[e] = sigmoidf_(v[e]);
                        *(u32x4*)(BG + (size_t)row * 512 + jj) = pack8(v);
                    }
                }
            }
    }
};

struct EpiGate {
    static constexpr bool HAS_MID = false;
    const float* rsp; bf16_t* G;
    __device__ __forceinline__ void operator()(const f32x4 (&acc)[2][2][4][2], const pg8::Unit& u, int wr, int wc, int fr, int fq) const {
#pragma unroll
        for (int ai = 0; ai < 2; ++ai)
#pragma unroll
            for (int m = 0; m < 4; ++m) {
                const int row = u.pm * 256 + ai * 128 + wr * 64 + m * 16 + fr;
                const float rs = row_rs(rsp, row);
                const int col = u.pn * 128 + wc * 32 + fq * 8;
                float r[8], sb[8];
#pragma unroll
                for (int n = 0; n < 2; ++n)
#pragma unroll
                    for (int e = 0; e < 4; ++e) {
                        const float ea = __expf(fminf(-acc[ai][0][m][n][e] * rs, 60.f)), eb = __expf(fminf(-acc[ai][1][m][n][e] * rs, 60.f));
                        sb[n * 4 + e] = 1.0f / (1.0f + eb); r[n * 4 + e] = (1.0f + eb) / (1.0f + ea);
                    }
                *(u32x4*)(G + (size_t)row * 2048 + col) = pack8(r);
                *(u32x4*)(G + (size_t)row * 2048 + 1024 + col) = pack8(sb);
            }
    }
};

struct EpiY {
    static constexpr bool HAS_MID = true;
    const bf16_t* G; bf16_t* Y;
    __device__ __forceinline__ void mid(f32x4 (&acc)[2][2][4][2], const pg8::Unit& u, int wr, int wc, int fr, int fq) const {
        int fr_ = fr; asm volatile("" : "+v"(fr_));
#pragma unroll
        for (int ai = 0; ai < 2; ++ai) {
            __builtin_amdgcn_sched_barrier(0);
#pragma unroll
            for (int m = 0; m < 4; ++m) {
                const int row = u.pm * 256 + ai * 128 + wr * 64 + m * 16 + fr_;
#pragma unroll
                for (int bj = 0; bj < 2; ++bj) {
                    const int col = u.pn * 256 + bj * 128 + wc * 32 + fq * 8;
                    const u32x4 gq = *(const u32x4*)(G + (size_t)row * 2048 + col);
                    acc[ai][bj][m][0][0] *= bflo(gq.x); acc[ai][bj][m][0][1] *= bfhi(gq.x); acc[ai][bj][m][0][2] *= bflo(gq.y); acc[ai][bj][m][0][3] *= bfhi(gq.y);
                    acc[ai][bj][m][1][0] *= bflo(gq.z); acc[ai][bj][m][1][1] *= bfhi(gq.z); acc[ai][bj][m][1][2] *= bflo(gq.w); acc[ai][bj][m][1][3] *= bfhi(gq.w);
                }
            }
        }
        __builtin_amdgcn_sched_barrier(0);
    }
    __device__ __forceinline__ void operator()(const f32x4 (&acc)[2][2][4][2], const pg8::Unit& u, int wr, int wc, int fr, int fq) const {
#pragma unroll
        for (int ai = 0; ai < 2; ++ai)
#pragma unroll
            for (int m = 0; m < 4; ++m) {
                const int row = u.pm * 256 + ai * 128 + wr * 64 + m * 16 + fr;
#pragma unroll
                for (int bj = 0; bj < 2; ++bj) {
                    const int col = u.pn * 256 + bj * 128 + wc * 32 + fq * 8;
                    const u32x4 gq = *(const u32x4*)(G + (size_t)row * 2048 + 1024 + col);
                    float v[8];
                    v[0] = acc[ai][bj][m][0][0] * bflo(gq.x); v[1] = acc[ai][bj][m][0][1] * bfhi(gq.x);
                    v[2] = acc[ai][bj][m][0][2] * bflo(gq.y); v[3] = acc[ai][bj][m][0][3] * bfhi(gq.y);
                    v[4] = acc[ai][bj][m][1][0] * bflo(gq.z); v[5] = acc[ai][bj][m][1][1] * bfhi(gq.z);
                    v[6] = acc[ai][bj][m][1][2] * bflo(gq.w); v[7] = acc[ai][bj][m][1][3] * bfhi(gq.w);
                    *(u32x4*)(Y + (size_t)row * 1024 + col) = pack8(v);
                }
            }
    }
};

struct EpiRes {
    static constexpr bool HAS_MID = false;
    const float* xres; float* xout; bf16_t* XB; float* rsp;
    __device__ __forceinline__ void operator()(const f32x4 (&acc)[2][2][4][2], const pg8::Unit& u, int wr, int wc, int fr, int fq) const {
#pragma unroll
        for (int ai = 0; ai < 2; ++ai)
#pragma unroll
            for (int m = 0; m < 4; ++m) {
                const int row = u.pm * 256 + ai * 128 + wr * 64 + m * 16 + fr;
                float ss = 0.f;
#pragma unroll
                for (int bj = 0; bj < 2; ++bj) {
                    const int col = u.pn * 256 + bj * 128 + wc * 32 + fq * 8;
                    const float* xr = xres + (size_t)row * Dm + col;
                    const f32x4 x0 = *(const f32x4*)xr, x1 = *(const f32x4*)(xr + 4);
                    float v[8];
#pragma unroll
                    for (int e = 0; e < 4; ++e) { v[e] = x0[e] + acc[ai][bj][m][0][e]; v[4 + e] = x1[e] + acc[ai][bj][m][1][e]; }
#pragma unroll
                    for (int e = 0; e < 8; ++e) ss += v[e] * v[e];
                    float* xo = xout + (size_t)row * Dm + col;
                    *(f32x4*)xo = (f32x4){v[0], v[1], v[2], v[3]}; *(f32x4*)(xo + 4) = (f32x4){v[4], v[5], v[6], v[7]};
                    *(u32x4*)(XB + (size_t)row * Dm + col) = pack8(v);
                }
                ss += __shfl_xor(ss, 16); ss += __shfl_xor(ss, 32);
                if (fq == 0) rsp[(size_t)row * 16 + u.pn * 4 + wc] = ss;
            }
    }
};

struct EpiGU {
    static constexpr bool HAS_MID = false;
    const float* rsp; bf16_t* H;
    __device__ __forceinline__ void operator()(const f32x4 (&acc)[2][2][4][2], const pg8::Unit& u, int wr, int wc, int fr, int fq) const {
#pragma unroll
        for (int ai = 0; ai < 2; ++ai)
#pragma unroll
            for (int m = 0; m < 4; ++m) {
                const int row = u.pm * 256 + ai * 128 + wr * 64 + m * 16 + fr;
                const float rs = row_rs(rsp, row);
                const int col = u.pn * 128 + wc * 32 + fq * 8;
                float v[8];
#pragma unroll
                for (int n = 0; n < 2; ++n)
#pragma unroll
                    for (int e = 0; e < 4; ++e) { const float gg = acc[ai][0][m][n][e] * rs, uu = acc[ai][1][m][n][e] * rs; v[n * 4 + e] = gg * sigmoidf_(gg) * uu; }
                *(u32x4*)(H + (size_t)row * FF + col) = pack8(v);
            }
    }
};

__device__ __forceinline__ int rope_perm(int n) {
    const int d = n & 63; if (d >= 16) return n;
    const int g = d >> 3, e = d & 7; return (n & ~63) + ((e < 4) ? 4 * g + e : 8 + 4 * g + (e - 4));
}
__device__ __forceinline__ void conv_item(const float* src, int ld_src, int ks0, int c0  , int mode  ,
                                          const float* gain, bf16_t* dst, int ld_dst, int n0, int kd0, LAS float* scr, int lane) {
    const int n4 = lane & 7, kr = lane >> 3;
    int sc = c0 + 4 * n4;
    if (mode) { const int q = (sc & 63) >> 2; if (q == 1) sc += 4; else if (q == 2) sc -= 4; }
#pragma unroll
    for (int i = 0; i < 8; ++i) { const int kk = kr + 8 * i; f32x4 w = *(const f32x4*)(src + (size_t)(ks0 + kk) * ld_src + sc);
        if (gain) { const float gg = gain[ks0 + kk]; w.x *= gg; w.y *= gg; w.z *= gg; w.w *= gg; }
        LAS float* d = scr + kk * 33 + 4 * n4; d[0] = w.x; d[1] = w.y; d[2] = w.z; d[3] = w.w; }
    asm volatile("s_waitcnt lgkmcnt(0)" ::: "memory");
    const int c = lane & 7;
#pragma unroll
    for (int j = 0; j < 4; ++j) { const int n = (lane >> 3) + 8 * j; const LAS float* s = scr + (8 * c) * 33 + n;
        u32x4 o; o.x = pk2(s[0 * 33], s[1 * 33]); o.y = pk2(s[2 * 33], s[3 * 33]); o.z = pk2(s[4 * 33], s[5 * 33]); o.w = pk2(s[6 * 33], s[7 * 33]);
        *(u32x4*)(dst + (size_t)(n0 + n) * ld_dst + kd0 + 8 * c) = o; }
    asm volatile("s_waitcnt lgkmcnt(0)" ::: "memory");
}

struct Ptrs {
    const float *x; const int* pos; const float *w_in, *da_lambda, *da_norm, *hg_lb, *hg_norm, *w_a, *w_b, *w_o, *attn_norm, *ffn_norm, *w_gate, *w_up, *w_down, *final_norm;
    float* out; unsigned char* ws; int ph_lo, ph_hi;
};

__device__ __forceinline__ void convert_layer(const Ptrs& P, int layer, unsigned char* wbuf, LAS unsigned char* lds, int gw, int ngw, int wave, int lane) {
    LAS float* scr = (LAS float*)(lds + wave * 8704);
    constexpr int I_IN = 16 * 192, I_A = 8 * 32, I_B = 8 * 32, I_O = 16 * 32, I_GU = 16 * 176, I_D = 44 * 32;
    constexpr int NIT = I_IN + I_A + I_B + I_O + I_GU + I_D;
    for (int it = gw; it < NIT; it += ngw) {
        int r = it;
        if (r < I_IN) { const int kb = r / 192, nb = r % 192, n0 = nb * 32;
            int c0 = n0; if (n0 >= 4096) { const int q = n0 - 4096, tile = q >> 8, rr = q & 255; c0 = (rr < 128 ? 4096 : 5120) + tile * 128 + (rr & 127); }
            conv_item(P.w_in + (size_t)layer * Dm * INW, INW, kb * 64, c0, n0 < 1024 ? 1 : 0, P.attn_norm + layer * Dm, (bf16_t*)(wbuf + W_IN), Dm, n0, kb * 64, scr, lane); continue; }
        r -= I_IN;
        if (r < I_A) { const int kb = r / 32, nb = r % 32;
            conv_item(P.w_a + (size_t)layer * 512 * Dm, Dm, kb * 64, nb * 32, 0, nullptr, (bf16_t*)(wbuf + W_AB), 1024, nb * 32, kb * 64, scr, lane); continue; }
        r -= I_A;
        if (r < I_B) { const int kb = r / 32, nb = r % 32;
            conv_item(P.w_b + (size_t)layer * 512 * Dm, Dm, kb * 64, nb * 32, 0, nullptr, (bf16_t*)(wbuf + W_AB), 1024, nb * 32, 512 + kb * 64, scr, lane); continue; }
        r -= I_B;
        if (r < I_O) { const int kb = r / 32, nb = r % 32;
            conv_item(P.w_o + (size_t)layer * Dm * Dm, Dm, kb * 64, nb * 32, 0, nullptr, (bf16_t*)(wbuf + W_O2), Dm, nb * 32, kb * 64, scr, lane); continue; }
        r -= I_O;
        if (r < I_GU) { const int kb = r / 176, nb = r % 176, n0 = nb * 32, tile = n0 >> 8, rr = n0 & 255;
            const float* srcm = (rr < 128 ? P.w_gate : P.w_up) + (size_t)layer * Dm * FF;
            conv_item(srcm, FF, kb * 64, tile * 128 + (rr & 127), 0, P.ffn_norm + layer * Dm, (bf16_t*)(wbuf + W_GU), Dm, n0, kb * 64, scr, lane); continue; }
        r -= I_GU;
        { const int kb = r / 32, nb = r % 32;
            conv_item(P.w_down + (size_t)layer * FF * Dm, Dm, kb * 64, nb * 32, 0, nullptr, (bf16_t*)(wbuf + W_D), FF, nb * 32, kb * 64, scr, lane); }
    }
}

__device__ __forceinline__ float wave_sum(float v) {
#pragma unroll
    for (int o = 1; o < 64; o <<= 1) v += __shfl_xor(v, o);
    return v;
}
__device__ __forceinline__ void prologue(const Ptrs& P, LAS unsigned char* lds, int gw, int ngw, int wave, int lane) {
    unsigned char* ws = P.ws;
    bf16_t* XB = (bf16_t*)(ws + OFF_XB); float* rsb = (float*)(ws + OFF_RSB);
    for (int r = gw; r < M; r += ngw) {
        const f32x4* xr = (const f32x4*)(P.x + (size_t)r * Dm) + lane;
        float ss = 0.f;
#pragma unroll
        for (int j = 0; j < 4; ++j) { const f32x4 v = xr[64 * j]; ss += (v.x * v.x + v.y * v.y) + (v.z * v.z + v.w * v.w);
            u32x2 o; o.x = pk2(v.x, v.y); o.y = pk2(v.z, v.w); *((u32x2*)(XB + (size_t)r * Dm) + lane + 64 * j) = o; }
        ss = wave_sum(ss);
        if (lane < 16) rsb[(size_t)r * 16 + lane] = (lane == 0) ? ss : 0.f;
    }
    const int gt = gw * 64 + lane, ngt = ngw * 64;
    float* cs = (float*)(ws + OFF_CS);
    for (int i = gt; i < M * 8; i += ngt) {
        const int tok = i >> 3, f = i & 7;
        const double invf[8] = {1.0, 0.19392274474868576, 0.03760603093086393, 0.007292664737217109, 0.001414213562373095, 0.0002742481756762073, 5.318295896944988e-05, 1.031338537721246e-05};
        double fr;
        switch (f) { case 0: fr = invf[0]; break; case 1: fr = invf[1]; break; case 2: fr = invf[2]; break; case 3: fr = invf[3]; break; case 4: fr = invf[4]; break; case 5: fr = invf[5]; break; case 6: fr = invf[6]; break; default: fr = invf[7]; }
        const float ang32 = (float)P.pos[tok] * (float)fr;
        const double ang = (double)ang32;
        const double rev = ang * 0.15915494309189535;
        const double fracrev = rev - __builtin_floor(rev + 0.5);
        const float a = (float)(fracrev * 6.283185307179586);
        cs[(size_t)tok * 16 + f] = __cosf(a); cs[(size_t)tok * 16 + 8 + f] = __sinf(a);
    }
    float* LB = (float*)(ws + OFF_LB);
    for (int i = gt; i < 2 * 512; i += ngt) {
        const int d = i >> 9, k = i & 511;
        float l[4], mx = -1e30f;
#pragma unroll
        for (int j = 0; j < 4; ++j) { l[j] = P.hg_lb[(size_t)(d * 4 + j) * 512 + k]; mx = fmaxf(mx, l[j]); }
        float e[4], sum = 0.f;
#pragma unroll
        for (int j = 0; j < 4; ++j) { e[j] = __expf(l[j] - mx); sum += e[j]; }
        float cum = 0.f;
#pragma unroll
        for (int j = 0; j < 4; ++j) { if (j > 0) cum += e[j] / sum; LB[(size_t)(d * 4 + j) * 512 + k] = cum; }
    }
    if (gw == 0) {
        float* LAM = (float*)(ws + OFF_LAM);
        for (int l = 0; l < 4; ++l) {
            const float* p = P.da_lambda + l * 256;
            float a = wave_sum(p[lane] * p[64 + lane]), b = wave_sum(p[128 + lane] * p[192 + lane]);
            const float lam_init = 0.8f - 0.6f * __expf(-0.3f * (float)l);
            if (lane == 0) LAM[l] = __expf(a) - __expf(b) + lam_init;
        }
    }
}

constexpr int AT_KROW = 144, AT_VROW = 320, AT_K1 = 64 * AT_KROW, AT_V = 2 * AT_K1, AT_STG = AT_V + 64 * AT_VROW;
constexpr int AT_IMG_ROW = 132;
__device__ __forceinline__ s16x4 tr_read(const LAS unsigned char* p) { return __builtin_bit_cast(s16x4, __builtin_amdgcn_ds_read_tr16_b64_v4i16((LAS s16x4*)p)); }

__device__ __forceinline__ void attn_unit(int b, int h, int qb, const bf16_t* Q, const bf16_t* Kk, const bf16_t* V, bf16_t* AO, const float* gainA  , float one_minus_lam_init, float lam, LAS unsigned char* lds) {
    int tid_ = threadIdx.x; asm volatile("" : "+v"(tid_));
    const int tid = tid_, wave = __builtin_amdgcn_readfirstlane(tid >> 6), lane = tid & 63, c = wave >> 2, wq = wave & 3, r32 = lane & 31, hh = lane >> 5;
    const int q0 = qb * 128 + wq * 32;
    bf16x8 qf[4];
    { const bf16_t* Qp = Q + ((size_t)(((b * 4 + h) * 2 + c) * SEQ + q0 + r32)) * 64 + 8 * hh;
#pragma unroll
      for (int s = 0; s < 4; ++s) qf[s] = *(const bf16x8*)(Qp + 16 * s); }
    f32x16 o[4];
#pragma unroll
    for (int i = 0; i < 4; ++i)
#pragma unroll
        for (int e = 0; e < 16; ++e) o[i][e] = 0.f;
    float mrow = -1e30f, lrow = 0.f;
    const unsigned char* Kg0 = (const unsigned char*)(Kk + ((size_t)((b * 4 + h) * 2 + 0) * SEQ) * 64);
    const unsigned char* Kg1 = (const unsigned char*)(Kk + ((size_t)((b * 4 + h) * 2 + 1) * SEQ) * 64);
    const unsigned char* Vg = (const unsigned char*)(V + ((size_t)(b * 4 + h) * SEQ) * 128);
    const int lk = (tid >> 3) * AT_KROW + (tid & 7) * 16;
    const int lv0 = AT_V + (tid >> 4) * AT_VROW + (tid & 15) * 16, lv1 = lv0 + 32 * AT_VROW;
    u32x4 r0, r1, r2, r3;
    r0 = *(const u32x4*)(Kg0 + tid * 16); r1 = *(const u32x4*)(Kg1 + tid * 16); r2 = *(const u32x4*)(Vg + tid * 16); r3 = *(const u32x4*)(Vg + 8192 + tid * 16);
    *(LAS u32x4*)(lds + lk) = r0; *(LAS u32x4*)(lds + AT_K1 + lk) = r1; *(LAS u32x4*)(lds + lv0) = r2; *(LAS u32x4*)(lds + lv1) = r3;
    r0 = *(const u32x4*)(Kg0 + 8192 + tid * 16); r1 = *(const u32x4*)(Kg1 + 8192 + tid * 16);
    *(LAS u32x4*)(lds + AT_STG + lk) = r0; *(LAS u32x4*)(lds + AT_STG + AT_K1 + lk) = r1;
    __syncthreads();
    const int ka = c * AT_K1 + r32 * AT_KROW + hh * 16;
    const int va = AT_V + (4 * hh + ((lane & 15) >> 2)) * AT_VROW + ((lane >> 4) & 1) * 32 + (lane & 3) * 8;

#define AT_QK(sv, st) do { f32x16 t0_, t1_; _Pragma("unroll") for (int e = 0; e < 16; ++e) { t0_[e] = 0.f; t1_[e] = 0.f; } \
        _Pragma("unroll") for (int ks = 0; ks < 4; ++ks) { \
            const bf16x8 a0 = *(const LAS bf16x8*)(lds + (st) + ka + ks * 32), a1 = *(const LAS bf16x8*)(lds + (st) + ka + 32 * AT_KROW + ks * 32); \
            t0_ = __builtin_amdgcn_mfma_f32_32x32x16_bf16(a0, qf[ks], t0_, 0, 0, 0); t1_ = __builtin_amdgcn_mfma_f32_32x32x16_bf16(a1, qf[ks], t1_, 0, 0, 0); } \
        sv##0 = t0_; sv##1 = t1_; } while (0)
    f32x16 sA0, sA1, sB0, sB1;
    AT_QK(sA, 0);
#define AT_VFRAG(dst, STC, g) do { const LAS unsigned char* vb_ = lds + (STC) + va + (16 * (g)) * AT_VROW; \
        _Pragma("unroll") for (int vt = 0; vt < 4; ++vt) { const s16x4 t0 = tr_read(vb_ + vt * 64), t1 = tr_read(vb_ + vt * 64 + 8 * AT_VROW); \
            dst[vt] = (bf16x8){t0[0], t0[1], t0[2], t0[3], t1[0], t1[1], t1[2], t1[3]}; } } while (0)
#define AT_PV(vf, p) do { __builtin_amdgcn_s_setprio(1); _Pragma("unroll") for (int vt = 0; vt < 4; ++vt) o[vt] = __builtin_amdgcn_mfma_f32_32x32x16_bf16(vf[vt], p, o[vt], 0, 0, 0); __builtin_amdgcn_s_setprio(0); } while (0)
#define AT_SB __builtin_amdgcn_sched_barrier(0)
#define AT_TILE(j, s0, s1, sn, STC  , STN  ) do { \
        if ((j) + 2 < 64) { const size_t go = (size_t)((j) + 2) * 8192; r0 = *(const u32x4*)(Kg0 + go + tid * 16); r1 = *(const u32x4*)(Kg1 + go + tid * 16); } \
        if ((j) + 1 < 64) { const size_t go = (size_t)((j) + 1) * 16384; r2 = *(const u32x4*)(Vg + go + tid * 16); r3 = *(const u32x4*)(Vg + go + 8192 + tid * 16); } \
        bf16x8 kf[4], kg[4], vA[4]; \
        if ((j) + 1 < 64) { _Pragma("unroll") for (int ks = 0; ks < 2; ++ks) { kf[2 * ks] = *(const LAS bf16x8*)(lds + (STN) + ka + ks * 32); kf[2 * ks + 1] = *(const LAS bf16x8*)(lds + (STN) + ka + 32 * AT_KROW + ks * 32); } } \
        AT_SB; \
        float mx = fmaxf(s0[0], s1[0]); \
        _Pragma("unroll") for (int e = 1; e < 16; ++e) mx = fmaxf(mx, fmaxf(s0[e], s1[e])); \
        mx = fmaxf(mx, __shfl_xor(mx, 32)); \
        if (__builtin_amdgcn_ballot_w64(mx > mrow + 8.0f) != 0ull) { \
            const float mnew = fmaxf(mrow, mx), alpha = __builtin_amdgcn_exp2f(mrow - mnew); mrow = mnew; lrow *= alpha; \
            _Pragma("unroll") for (int i = 0; i < 4; ++i) _Pragma("unroll") for (int e = 0; e < 16; ++e) o[i][e] *= alpha; } \
        AT_SB; \
        if ((j) + 1 < 64) { f32x16 t0_, t1_; _Pragma("unroll") for (int e = 0; e < 16; ++e) { t0_[e] = 0.f; t1_[e] = 0.f; } \
            __builtin_amdgcn_s_setprio(1); \
            _Pragma("unroll") for (int ks = 0; ks < 2; ++ks) { t0_ = __builtin_amdgcn_mfma_f32_32x32x16_bf16(kf[2 * ks], qf[ks], t0_, 0, 0, 0); t1_ = __builtin_amdgcn_mfma_f32_32x32x16_bf16(kf[2 * ks + 1], qf[ks], t1_, 0, 0, 0); } \
            AT_SB; \
            _Pragma("unroll") for (int ks = 0; ks < 2; ++ks) { kg[2 * ks] = *(const LAS bf16x8*)(lds + (STN) + ka + (ks + 2) * 32); kg[2 * ks + 1] = *(const LAS bf16x8*)(lds + (STN) + ka + 32 * AT_KROW + (ks + 2) * 32); } \
            AT_SB; \
            _Pragma("unroll") for (int ks = 0; ks < 2; ++ks) { t0_ = __builtin_amdgcn_mfma_f32_32x32x16_bf16(kg[2 * ks], qf[ks + 2], t0_, 0, 0, 0); t1_ = __builtin_amdgcn_mfma_f32_32x32x16_bf16(kg[2 * ks + 1], qf[ks + 2], t1_, 0, 0, 0); } \
            __builtin_amdgcn_s_setprio(0); sn##0 = t0_; sn##1 = t1_; } \
        AT_VFRAG(vA, STC, 0); \
        AT_SB; \
        float ls = 0.f; \
        _Pragma("unroll") for (int e = 0; e < 16; ++e) { s0[e] = __builtin_amdgcn_exp2f(s0[e] - mrow); s1[e] = __builtin_amdgcn_exp2f(s1[e] - mrow); ls += s0[e] + s1[e]; } \
        lrow += ls; \
        bf16x8 pf[2][2]; \
        _Pragma("unroll") for (int s = 0; s < 2; ++s) { u32x4 w0, w1; \
            w0.x = pk2(s0[8 * s + 0], s0[8 * s + 1]); w0.y = pk2(s0[8 * s + 2], s0[8 * s + 3]); w0.z = pk2(s0[8 * s + 4], s0[8 * s + 5]); w0.w = pk2(s0[8 * s + 6], s0[8 * s + 7]); \
            w1.x = pk2(s1[8 * s + 0], s1[8 * s + 1]); w1.y = pk2(s1[8 * s + 2], s1[8 * s + 3]); w1.z = pk2(s1[8 * s + 4], s1[8 * s + 5]); w1.w = pk2(s1[8 * s + 6], s1[8 * s + 7]); \
            pf[0][s] = __builtin_bit_cast(bf16x8, w0); pf[1][s] = __builtin_bit_cast(bf16x8, w1); } \
        AT_SB; \
        AT_PV(vA, pf[0][0]); \
        AT_SB; \
        AT_VFRAG(vA, STC, 1); \
        AT_SB; \
        AT_PV(vA, pf[0][1]); \
        AT_SB; \
        AT_VFRAG(vA, STC, 2); \
        AT_SB; \
        AT_PV(vA, pf[1][0]); \
        AT_SB; \
        AT_VFRAG(vA, STC, 3); \
        AT_SB; \
        AT_PV(vA, pf[1][1]); \
        if ((j) + 2 < 64) { *(LAS u32x4*)(lds + (STC) + lk) = r0; *(LAS u32x4*)(lds + (STC) + AT_K1 + lk) = r1; } \
        if ((j) + 1 < 64) { *(LAS u32x4*)(lds + (STN) + lv0) = r2; *(LAS u32x4*)(lds + (STN) + lv1) = r3; } \
        __syncthreads(); } while (0)
    for (int j = 0; j < 64; j += 2) {
        AT_TILE(j, sA0, sA1, sB, 0, AT_STG);
        AT_TILE(j + 1, sB0, sB1, sA, AT_STG, 0);
    }
#undef AT_TILE
#undef AT_QK
#undef AT_VFRAG
#undef AT_PV
#undef AT_SB
    const float inv = 1.0f / (lrow + __shfl_xor(lrow, 32));
    LAS float* img = (LAS float*)lds;
    const int qrow = wq * 32 + r32;
    if (c == 1) {
        const float sc = -lam * inv;
#pragma unroll
        for (int vt = 0; vt < 4; ++vt)
#pragma unroll
            for (int g = 0; g < 4; ++g)
                *(LAS f32x4*)(img + qrow * AT_IMG_ROW + 32 * vt + 8 * g + 4 * hh) = (f32x4){o[vt][4 * g] * sc, o[vt][4 * g + 1] * sc, o[vt][4 * g + 2] * sc, o[vt][4 * g + 3] * sc};
    }
    __syncthreads();
    if (c == 0) {
#pragma unroll
        for (int vt = 0; vt < 4; ++vt)
#pragma unroll
            for (int g = 0; g < 4; ++g) {
                LAS f32x4* p = (LAS f32x4*)(img + qrow * AT_IMG_ROW + 32 * vt + 8 * g + 4 * hh);
                f32x4 t = *p;
                t.x += o[vt][4 * g] * inv; t.y += o[vt][4 * g + 1] * inv; t.z += o[vt][4 * g + 2] * inv; t.w += o[vt][4 * g + 3] * inv;
                *p = t;
            }
    }
    __syncthreads();
    {
        const int q = tid >> 2, part = tid & 3;
        float v[32]; float ss = 0.f;
#pragma unroll
        for (int i = 0; i < 8; ++i) { const f32x4 t = *(const LAS f32x4*)(img + q * AT_IMG_ROW + 32 * part + 4 * i); v[4 * i] = t.x; v[4 * i + 1] = t.y; v[4 * i + 2] = t.z; v[4 * i + 3] = t.w;
            ss += (t.x * t.x + t.y * t.y) + (t.z * t.z + t.w * t.w); }
        ss += __shfl_xor(ss, 1); ss += __shfl_xor(ss, 2);
        const float rs = rsqrtf(ss * (1.0f / 128.0f) + EPS) * one_minus_lam_init;
        const float* gp = gainA + h * 128 + 32 * part;
        bf16_t* dst = AO + ((size_t)(b * SEQ + qb * 128 + q)) * 1024 + h * 128 + 32 * part;
#pragma unroll
        for (int i = 0; i < 4; ++i) {
            const f32x4 g0 = *(const f32x4*)(gp + 8 * i), g1 = *(const f32x4*)(gp + 8 * i + 4);
            u32x4 w; w.x = pk2(v[8 * i] * rs * g0.x, v[8 * i + 1] * rs * g0.y); w.y = pk2(v[8 * i + 2] * rs * g0.z, v[8 * i + 3] * rs * g0.w);
            w.z = pk2(v[8 * i + 4] * rs * g1.x, v[8 * i + 5] * rs * g1.y); w.w = pk2(v[8 * i + 6] * rs * g1.z, v[8 * i + 7] * rs * g1.w);
            *(u32x4*)(dst + 8 * i) = w;
        }
    }
    __syncthreads();
}

constexpr int HG_SEG = 0;
constexpr int HG_F = 2048;
constexpr int HG_PART = 2560;
constexpr int HG_V = 4096;
constexpr int HG_VROW = 288;
constexpr int HG_A = HG_V + 64 * HG_VROW;
constexpr int HG_KTROW = 144, HG_QKROW = 272;
constexpr int HG_Bq = HG_A + 128 * HG_KTROW;

__device__ __forceinline__ void hg_cumsum(const float (&gv)[16], int dir, int k, int j, LAS unsigned char* lds, float (&d)[16], float& m_out, float& tot_out) {
    float run = 0.f;
    if (dir == 0) {
#pragma unroll
        for (int i = 0; i < 16; ++i) { run += gv[i]; d[i] = run; }
    } else {
#pragma unroll
        for (int i = 15; i >= 0; --i) { run += gv[i]; d[i] = run; }
    }
    LAS float* seg = (LAS float*)(lds + HG_SEG);
    seg[j * 128 + k] = run;
    __syncthreads();
    const float s0 = seg[k], s1 = seg[128 + k], s2 = seg[256 + k], s3 = seg[384 + k];
    float off, m;
    if (dir == 0) { off = (j > 0 ? s0 : 0.f) + (j > 1 ? s1 : 0.f) + (j > 2 ? s2 : 0.f); m = s0 + s1; }
    else { off = (j < 3 ? s3 : 0.f) + (j < 2 ? s2 : 0.f) + (j < 1 ? s1 : 0.f); m = s2 + s3; }
#pragma unroll
    for (int i = 0; i < 16; ++i) d[i] = d[i] + off - m;
    m_out = m; tot_out = (s0 + s1) + (s2 + s3);
}
__device__ __forceinline__ void hg_load_v(const bf16_t* HV, int tok0, int h, LAS unsigned char* lds, int tid) {
#pragma unroll
    for (int i = 0; i < 2; ++i) { const int ch = tid + 512 * i, p = ch >> 4, part = ch & 15;
        *(LAS u32x4*)(lds + HG_V + p * HG_VROW + part * 16) = *(const u32x4*)(HV + (size_t)(tok0 + p) * 512 + h * 128 + part * 8); }
}
__device__ __forceinline__ void hg_load_g(const float* G, int tok0, int h, int k, int j, float (&gv)[16]) {
    const float* gp = G + (size_t)(tok0 + 16 * j) * 512 + h * 128 + k;
#pragma unroll
    for (int i = 0; i < 16; ++i) gv[i] = gp[(size_t)i * 512];
}

__device__ __forceinline__ void hg1_phase(int bx, int G, const float* GF, const float* GB, const bf16_t* HV, bf16_t* UT, float* Dg, float* Eg, LAS unsigned char* lds) {
    int tid_ = threadIdx.x; asm volatile("" : "+v"(tid_));
    const int tid = tid_, wave = __builtin_amdgcn_readfirstlane(tid >> 6), lane = tid & 63;
    const int k = tid & 127, j = tid >> 7, i16 = lane & 15, g4 = lane >> 4;
    float gn[16];
    if (bx < 2048) { const int u = bx, dir = u & 1, cch = (u >> 1) & 63, bh = u >> 7; hg_load_g(dir ? GB : GF, (bh >> 2) * SEQ + cch * 64, bh & 3, k, j, gn); }
    for (int u = bx; u < 2048; u += G) {
        const int dir = u & 1, cch = (u >> 1) & 63, bh = u >> 7, b = bh >> 2, h = bh & 3;
        const int tok0 = b * SEQ + cch * 64;
        float gv[16], d[16], m, tot;
#pragma unroll
        for (int i = 0; i < 16; ++i) gv[i] = gn[i];
        u32x4 vr[2];
#pragma unroll
        for (int i = 0; i < 2; ++i) { const int ch = tid + 512 * i; vr[i] = *(const u32x4*)(HV + (size_t)(tok0 + (ch >> 4)) * 512 + h * 128 + (ch & 15) * 8); }
        hg_cumsum(gv, dir, k, j, lds, d, m, tot);
        float kt[16];
#pragma unroll
        for (int i = 0; i < 16; ++i) kt[i] = (1.0f - __expf(gv[i])) * __expf(fminf(-d[i], 40.f));
        { u32x4 w0, w1;
          w0.x = pk2(kt[0], kt[1]); w0.y = pk2(kt[2], kt[3]); w0.z = pk2(kt[4], kt[5]); w0.w = pk2(kt[6], kt[7]);
          w1.x = pk2(kt[8], kt[9]); w1.y = pk2(kt[10], kt[11]); w1.z = pk2(kt[12], kt[13]); w1.w = pk2(kt[14], kt[15]);
          *(LAS u32x4*)(lds + HG_A + k * HG_KTROW + j * 32) = w0; *(LAS u32x4*)(lds + HG_A + k * HG_KTROW + j * 32 + 16) = w1; }
#pragma unroll
        for (int i = 0; i < 2; ++i) { const int ch = tid + 512 * i; *(LAS u32x4*)(lds + HG_V + (ch >> 4) * HG_VROW + (ch & 15) * 16) = vr[i]; }
        if (j == 0) { ((LAS float*)(lds + HG_F))[k] = __expf(tot - m); Dg[(size_t)u * 128 + k] = __expf(tot); Eg[(size_t)u * 128 + k] = __expf(m); }
        __syncthreads();
        if (u + G < 2048) { const int u2 = u + G, dir2 = u2 & 1, cch2 = (u2 >> 1) & 63, bh2 = u2 >> 7; hg_load_g(dir2 ? GB : GF, (bh2 >> 2) * SEQ + cch2 * 64, bh2 & 3, k, j, gn); }
        bf16x8 af[2];
#pragma unroll
        for (int s = 0; s < 2; ++s) {
            const LAS unsigned char* ap = lds + HG_A + (16 * wave + i16) * HG_KTROW + (32 * s + 4 * g4) * 2;
            const u32x2 lo = *(const LAS u32x2*)ap, hi = *(const LAS u32x2*)(ap + 32);
            af[s] = __builtin_bit_cast(bf16x8, (u32x4){lo.x, lo.y, hi.x, hi.y});
        }
        const f32x4 fsc = *(const LAS f32x4*)(lds + HG_F + (16 * wave + 4 * g4) * 4);
        const LAS unsigned char* vbase = lds + HG_V + (4 * g4 + (i16 >> 2)) * HG_VROW + (i16 & 3) * 8;
#pragma unroll
        for (int vt = 0; vt < 8; ++vt) {
            f32x4 acc = {0.f, 0.f, 0.f, 0.f};
#pragma unroll
            for (int s = 0; s < 2; ++s) {
                const s16x4 t0 = tr_read(vbase + (32 * s) * HG_VROW + vt * 32), t1 = tr_read(vbase + (32 * s + 16) * HG_VROW + vt * 32);
                const bf16x8 bv = {t0[0], t0[1], t0[2], t0[3], t1[0], t1[1], t1[2], t1[3]};
                acc = __builtin_amdgcn_mfma_f32_16x16x32_bf16(af[s], bv, acc, 0, 0, 0);
            }
            u32x2 w; w.x = pk2(acc[0] * fsc[0], acc[1] * fsc[1]); w.y = pk2(acc[2] * fsc[2], acc[3] * fsc[3]);
            *(u32x2*)(UT + ((size_t)u * 128 + 16 * vt + i16) * 128 + 16 * wave + 4 * g4) = w;
        }
        __syncthreads();
    }
}

__device__ __forceinline__ void hg2_scan(bf16_t* UT, const float* Dg, const float* Eg, int gthread, int nthreads) {
    for (int idx = gthread; idx < 32 * 4096; idx += nthreads) {
        const int chain = idx >> 12, e4 = idx & 4095, v = e4 >> 5, k0 = (e4 & 31) * 4;
        const int dir = chain & 1, bh = chain >> 1;
        float S0 = 0.f, S1 = 0.f, S2 = 0.f, S3 = 0.f;
        int u = (bh * 64 + (dir ? 63 : 0)) * 2 + dir;
        const int ustep = dir ? -2 : 2;
        u32x2 uu[4]; f32x4 dd[4], ee[4];
#pragma unroll
        for (int r = 0; r < 4; ++r) { const int ur = u + r * ustep; uu[r] = *(const u32x2*)(UT + ((size_t)ur * 128 + v) * 128 + k0); dd[r] = *(const f32x4*)(Dg + (size_t)ur * 128 + k0); ee[r] = *(const f32x4*)(Eg + (size_t)ur * 128 + k0); }
        for (int cc = 0; cc < 64; cc += 4) {
#pragma unroll
            for (int r = 0; r < 4; ++r) {
                const u32x2 uc = uu[r]; const f32x4 dc = dd[r], ec = ee[r];
                if (cc + 4 < 64) { const int un = u + 4 * ustep; uu[r] = *(const u32x2*)(UT + ((size_t)un * 128 + v) * 128 + k0); dd[r] = *(const f32x4*)(Dg + (size_t)un * 128 + k0); ee[r] = *(const f32x4*)(Eg + (size_t)un * 128 + k0); }
                u32x2 w; w.x = pk2(ec.x * S0, ec.y * S1); w.y = pk2(ec.z * S2, ec.w * S3);
                *(u32x2*)(UT + ((size_t)u * 128 + v) * 128 + k0) = w;
                S0 = dc.x * S0 + bflo(uc.x); S1 = dc.y * S1 + bfhi(uc.x); S2 = dc.z * S2 + bflo(uc.y); S3 = dc.w * S3 + bfhi(uc.y);
                u += ustep;
            }
        }
    }
}

constexpr int HG_OUT = HG_Bq + 64 * HG_QKROW;
__device__ __forceinline__ void hg3_unit(int u3, const float* GF, const float* GB, const bf16_t* HQ, const bf16_t* HV, const bf16_t* ST, const bf16_t* BG, const float* gainH, bf16_t* AO, LAS unsigned char* lds) {
    int tid_ = threadIdx.x; asm volatile("" : "+v"(tid_));
    const int tid = tid_, wave = __builtin_amdgcn_readfirstlane(tid >> 6), lane = tid & 63;
    const int cch = u3 & 63, bh = u3 >> 6, b = bh >> 2, h = bh & 3;
    const int tok0 = b * SEQ + cch * 64, k = tid & 127, j = tid >> 7;
    const int tb = wave & 3, vh = wave >> 2, i16 = lane & 15, g4 = lane >> 4;
    float gf[16], gb[16]; unsigned short qr[16];
    hg_load_g(GF, tok0, h, k, j, gf); hg_load_g(GB, tok0, h, k, j, gb);
    { const bf16_t* qp = HQ + (size_t)(tok0 + 16 * j) * 512 + h * 128 + k;
#pragma unroll
      for (int i = 0; i < 16; ++i) qr[i] = qp[(size_t)i * 512]; }
    hg_load_v(HV, tok0, h, lds, tid);
    u32x4 bgq[2];
    { const bf16_t* bgp0 = BG + (size_t)(tok0 + (tid >> 3)) * 512 + h * 128 + 16 * (tid & 7); bgq[0] = *(const u32x4*)bgp0; bgq[1] = *(const u32x4*)(bgp0 + 8); }
    bf16x8 sb[16];
    { const bf16_t* stp = ST + ((size_t)((bh * 64 + cch) * 2 + 0) * 128) * 128;
#pragma unroll
      for (int vv = 0; vv < 4; ++vv)
#pragma unroll
        for (int ks = 0; ks < 4; ++ks) sb[vv * 4 + ks] = *(const bf16x8*)(stp + (size_t)(16 * (4 * vh + vv) + i16) * 128 + 32 * ks + 8 * g4); }
    f32x4 oacc[4];
#pragma unroll
    for (int i = 0; i < 4; ++i) oacc[i] = (f32x4){0.f, 0.f, 0.f, 0.f};
#pragma unroll
    for (int dir = 0; dir < 2; ++dir) {
        float d[16], m, tot;
        hg_cumsum(dir ? gb : gf, dir, k, j, lds, d, m, tot);
#pragma unroll
        for (int i = 0; i < 16; ++i) {
            const float gvi = dir ? gb[i] : gf[i];
            const float kt = (1.0f - __expf(gvi)) * __expf(fminf(-d[i], 40.f));
            const float qt = bf2f(qr[i]) * __expf(fminf(d[i], 40.f));
            *(LAS unsigned short*)(lds + HG_A + (16 * j + i) * HG_QKROW + k * 2) = (unsigned short)f2bf(kt);
            *(LAS unsigned short*)(lds + HG_Bq + (16 * j + i) * HG_QKROW + k * 2) = (unsigned short)f2bf(qt);
        }
        __syncthreads();
        f32x4 pt[4];
#pragma unroll
        for (int sg = 0; sg < 4; ++sg) pt[sg] = (f32x4){0.f, 0.f, 0.f, 0.f};
        bf16x8 qa[4];
#pragma unroll
        for (int ks = 0; ks < 4; ++ks) qa[ks] = *(const LAS bf16x8*)(lds + HG_Bq + (16 * tb + i16) * HG_QKROW + (32 * ks + 8 * g4) * 2);
#pragma unroll
        for (int sg = 0; sg < 4; ++sg)
#pragma unroll
            for (int ks = 0; ks < 4; ++ks) {
                const bf16x8 ka = *(const LAS bf16x8*)(lds + HG_A + (16 * sg + i16) * HG_QKROW + (32 * ks + 8 * g4) * 2);
                pt[sg] = __builtin_amdgcn_mfma_f32_16x16x32_bf16(ka, qa[ks], pt[sg], 0, 0, 0);
            }
        const int tcol = 16 * tb + i16;
#pragma unroll
        for (int sg = 0; sg < 4; ++sg)
#pragma unroll
            for (int e = 0; e < 4; ++e) { const int srow = 16 * sg + 4 * g4 + e; const bool keep = dir ? (srow >= tcol) : (srow <= tcol); pt[sg][e] = keep ? pt[sg][e] : 0.f; }
        bf16x8 pa[2];
#pragma unroll
        for (int s2 = 0; s2 < 2; ++s2) {
            u32x4 w; w.x = pk2(pt[2 * s2][0], pt[2 * s2][1]); w.y = pk2(pt[2 * s2][2], pt[2 * s2][3]); w.z = pk2(pt[2 * s2 + 1][0], pt[2 * s2 + 1][1]); w.w = pk2(pt[2 * s2 + 1][2], pt[2 * s2 + 1][3]);
            pa[s2] = __builtin_bit_cast(bf16x8, w);
        }
        const LAS unsigned char* vbase = lds + HG_V + (4 * g4 + (i16 >> 2)) * HG_VROW + (i16 & 3) * 8;
#pragma unroll
        for (int vv = 0; vv < 4; ++vv) {
            const int vt = 4 * vh + vv;
#pragma unroll
            for (int s2 = 0; s2 < 2; ++s2) {
                const s16x4 t0 = tr_read(vbase + (32 * s2) * HG_VROW + vt * 32), t1 = tr_read(vbase + (32 * s2 + 16) * HG_VROW + vt * 32);
                const bf16x8 bv = {t0[0], t0[1], t0[2], t0[3], t1[0], t1[1], t1[2], t1[3]};
                oacc[vv] = __builtin_amdgcn_mfma_f32_16x16x32_bf16(pa[s2], bv, oacc[vv], 0, 0, 0);
            }
#pragma unroll
            for (int ks = 0; ks < 4; ++ks) oacc[vv] = __builtin_amdgcn_mfma_f32_16x16x32_bf16(qa[ks], sb[vv * 4 + ks], oacc[vv], 0, 0, 0);
        }
        if (dir == 0) {
            const bf16_t* stp = ST + ((size_t)((bh * 64 + cch) * 2 + 1) * 128) * 128;
#pragma unroll
            for (int vv = 0; vv < 4; ++vv)
#pragma unroll
                for (int ks = 0; ks < 4; ++ks) sb[vv * 4 + ks] = *(const bf16x8*)(stp + (size_t)(16 * (4 * vh + vv) + i16) * 128 + 32 * ks + 8 * g4);
        }
        __syncthreads();
    }
    LAS float* ot = (LAS float*)(lds + HG_OUT);
#pragma unroll
    for (int vv = 0; vv < 4; ++vv)
#pragma unroll
        for (int e = 0; e < 4; ++e) ot[(16 * tb + 4 * g4 + e) * 132 + 16 * (4 * vh + vv) + i16] = oacc[vv][e];
    __syncthreads();
    {
        const int t = tid >> 3, part = tid & 7;
        float v[16]; float ss = 0.f;
#pragma unroll
        for (int i = 0; i < 4; ++i) { const f32x4 x = *(const LAS f32x4*)(ot + t * 132 + 16 * part + 4 * i); v[4 * i] = x.x; v[4 * i + 1] = x.y; v[4 * i + 2] = x.z; v[4 * i + 3] = x.w; ss += (x.x * x.x + x.y * x.y) + (x.z * x.z + x.w * x.w); }
        ss += __shfl_xor(ss, 1); ss += __shfl_xor(ss, 2); ss += __shfl_xor(ss, 4);
        const float rs = rsqrtf(ss * (1.0f / 128.0f) + EPS);
        const float* gp = gainH + h * 128 + 16 * part;
        bf16_t* dst = AO + (size_t)(tok0 + t) * 1024 + 512 + h * 128 + 16 * part;
#pragma unroll
        for (int i = 0; i < 2; ++i) {
            const u32x4 gq = bgq[i];
            const f32x4 g0 = *(const f32x4*)(gp + 8 * i), g1 = *(const f32x4*)(gp + 8 * i + 4);
            u32x4 w;
            w.x = pk2(v[8 * i] * rs * g0.x * bflo(gq.x), v[8 * i + 1] * rs * g0.y * bfhi(gq.x)); w.y = pk2(v[8 * i + 2] * rs * g0.z * bflo(gq.y), v[8 * i + 3] * rs * g0.w * bfhi(gq.y));
            w.z = pk2(v[8 * i + 4] * rs * g1.x * bflo(gq.z), v[8 * i + 5] * rs * g1.y * bfhi(gq.z)); w.w = pk2(v[8 * i + 6] * rs * g1.z * bflo(gq.w), v[8 * i + 7] * rs * g1.w * bfhi(gq.w));
            *(u32x4*)(dst + 8 * i) = w;
        }
    }
    __syncthreads();
}

#define XB_TMO      128
#define XB_XCNT(j)  (256  + 64 * (j))
#define XB_XSUB(j)  (1280 + 64 * (j))
#define XB_XGEN(j)  (2304 + 64 * (j))
#define XB_TOP      3328
#define XB_TOPGEN   3392
#define XCD_BAR_WORDS 3456
#define XB_SPIN_CAP (1u << 18)

__device__ __forceinline__ unsigned xb_ld(unsigned* p)              { return __hip_atomic_load(p, __ATOMIC_RELAXED, __HIP_MEMORY_SCOPE_AGENT); }
__device__ __forceinline__ unsigned xb_add(unsigned* p, unsigned v) { return __hip_atomic_fetch_add(p, v, __ATOMIC_RELAXED, __HIP_MEMORY_SCOPE_AGENT); }
__device__ __forceinline__ unsigned xb_xcc_id() { return (unsigned)__builtin_amdgcn_s_getreg((3 << 11) | 20) & 0xFu; }
#define XB_SPIN(cond, bar) do { unsigned _sp = 0; while (cond) { __builtin_amdgcn_s_sleep(1); \
    if ((++_sp & 255u) == 0u) { if (xb_ld(&(bar)[XB_TMO])) break; if (_sp > XB_SPIN_CAP) { atomicAdd(&(bar)[XB_TMO], 1u); break; } } } } while (0)

struct XcdBarrier {
    unsigned* bar; unsigned x;
    volatile LAS unsigned* st;
};

__device__ __forceinline__ XcdBarrier xcd_barrier_post(unsigned* bar, volatile LAS unsigned* st) {
    XcdBarrier b; b.bar = bar; b.x = xb_xcc_id(); b.st = st;
    if (threadIdx.x == 0) (void)xb_add(&bar[XB_XCNT(b.x)], 1u);
    return b;
}
__device__ __forceinline__ void xcd_barrier_complete(unsigned* bar, unsigned x, unsigned& nloc, unsigned& nx) {
    const unsigned G = gridDim.x * gridDim.y * gridDim.z;
    unsigned sum, cnt, mine, sp = 0u;
    for (;;) {
        sum = 0u; cnt = 0u; mine = 0u;
#pragma unroll
        for (unsigned j = 0; j < 16; ++j) { const unsigned c = xb_ld(&bar[XB_XCNT(j)]); sum += c; cnt += (c > 0u) ? 1u : 0u; mine = (j == x) ? c : mine; }
        if (sum == G) break;
        __builtin_amdgcn_s_sleep(1);
        if ((++sp & 255u) == 0u) { if (xb_ld(&bar[XB_TMO])) break; if (sp > XB_SPIN_CAP) { atomicAdd(&bar[XB_TMO], 1u); break; } }
    }
    nloc = mine > 0u ? mine : 1u; nx = cnt > 0u ? cnt : 1u;
}

__device__ __forceinline__ void xcd_barrier(const XcdBarrier& b) {
    asm volatile("s_waitcnt vmcnt(0)" ::: "memory");
    __syncthreads();
    if (threadIdx.x == 0) {
        unsigned* bar = b.bar;
        __builtin_amdgcn_s_waitcnt(0);
        unsigned nloc = b.st[0], nx = b.st[1];
        if (nloc == 0u) { xcd_barrier_complete(bar, b.x, nloc, nx); b.st[0] = nloc; b.st[1] = nx; }
        const unsigned old = xb_add(&bar[XB_XSUB(b.x)], 1u);
        const unsigned gen = old / nloc;
        if (old + 1u == (gen + 1u) * nloc) {
            __builtin_amdgcn_fence(__ATOMIC_RELEASE, "agent");
            asm volatile("s_waitcnt vmcnt(0)" ::: "memory");
            const unsigned og = xb_add(&bar[XB_TOP], 1u);
            const unsigned tg = og / nx;
            if (og + 1u == (tg + 1u) * nx) xb_add(&bar[XB_TOPGEN], 1u);
            else XB_SPIN(xb_ld(&bar[XB_TOPGEN]) == tg, bar);
            __builtin_amdgcn_fence(__ATOMIC_ACQUIRE, "agent");
            xb_add(&bar[XB_XGEN(b.x)], 1u);
            asm volatile("s_waitcnt vmcnt(0)" ::: "memory");
        } else {
            XB_SPIN(xb_ld(&bar[XB_XGEN(b.x)]) == gen, bar);
            __builtin_amdgcn_fence(__ATOMIC_ACQUIRE, "agent");
            asm volatile("s_waitcnt vmcnt(0)" ::: "memory");
        }
    }
    __syncthreads();
}

__global__ void __launch_bounds__(512, 2) fwd_kernel(Ptrs Pk) {
    extern __shared__ __attribute__((aligned(16))) unsigned char lds_raw[];
    LAS unsigned char* lds = (LAS unsigned char*)lds_raw;
    cg::grid_group grid = cg::this_grid();
    const int G = gridDim.x, bx = blockIdx.x;
    const int lo = Pk.ph_lo, hi = Pk.ph_hi;
    int ph = 0;
    if (threadIdx.x < 4) ((LAS unsigned*)(lds + 131072 + 1024))[threadIdx.x] = 0u;
    __syncthreads();
    XcdBarrier xbar = xcd_barrier_post((unsigned*)(Pk.ws + OFF_BAR), (volatile LAS unsigned*)(lds + 131072 + 1024));
#ifdef TS_A
    if (threadIdx.x == 0) { LAS unsigned long long* TS_ = (LAS unsigned long long*)(lds + 131072); for (int i = 0; i < 15; ++i) TS_[i] = 0ull; TS_[15] = __builtin_amdgcn_s_memrealtime(); }
#endif
#ifndef PH_MASK
#define PH_MASK 0xFFFFFFFFu
#endif
#define ON(id) constexpr (((PH_MASK) >> (id)) & 1u)
#if defined(__HIP_DEVICE_COMPILE__)
#define LOAD_ARGS(P) int zoff_ = 0; asm volatile("" : "+s"(zoff_)); const Ptrs P = *(const __attribute__((address_space(4))) Ptrs*)((const __attribute__((address_space(4))) char*)__builtin_amdgcn_kernarg_segment_ptr() + zoff_);
#else
#define LOAD_ARGS(P) const Ptrs P = Pk;
#endif
#define PHASE_BEGIN if (ph >= lo && ph < hi) { LOAD_ARGS(P) unsigned char* ws = P.ws; asm volatile("" : "+s"(ws)); int tid = threadIdx.x; asm volatile("" : "+v"(tid)); \
    const int lane = tid & 63, wave = __builtin_amdgcn_readfirstlane(tid >> 6), gw = bx * 8 + wave, ngw = G * 8; (void)lane; (void)gw; (void)ngw;
#define XB ((bf16_t*)(ws + OFF_XB))
#define RSA ((float*)(ws + OFF_RSA))
#define RSB ((float*)(ws + OFF_RSB))
#define CS ((const float*)(ws + OFF_CS))
#define LB ((const float*)(ws + OFF_LB))
#define LAM ((const float*)(ws + OFF_LAM))
#define Dg ((float*)(ws + OFF_DG))
#define Eg ((float*)(ws + OFF_EG))
#define GATE ((bf16_t*)(ws + OFF_GATE))
#define Qb ((bf16_t*)(ws + OFF_Q))
#define Kb ((bf16_t*)(ws + OFF_K))
#define Vb ((bf16_t*)(ws + OFF_V))
#define HQ ((bf16_t*)(ws + OFF_HQ))
#define HV ((bf16_t*)(ws + OFF_HV))
#define GF ((float*)(ws + OFF_GF))
#define GB ((float*)(ws + OFF_GB))
#define Yb ((bf16_t*)(ws + OFF_Y))
#define BG ((bf16_t*)(ws + OFF_BG))
#define AO ((bf16_t*)(ws + OFF_AO))
#define UT ((bf16_t*)(ws + OFF_UT))
#define Hb ((bf16_t*)(ws + OFF_H))
#ifdef TS_A
#define TICK(cat) do { if (bx == 0 && threadIdx.x == 0) { LAS unsigned long long* TS_ = (LAS unsigned long long*)(lds + 131072); const unsigned long long t_ = __builtin_amdgcn_s_memrealtime(); TS_[cat] += t_ - TS_[15]; TS_[15] = t_; } } while (0)
#else
#define TICK(cat) do { } while (0)
#endif
#define PHASE_END(cat)   TICK(cat); if (ph + 1 < hi) { if (ph == 0) grid.sync(); else xcd_barrier(xbar); TICK(13); } } ++ph;

    PHASE_BEGIN
        if ON(0) prologue(P, lds, gw, ngw, wave, lane);
        if ON(6) convert_layer(P, 0, ws, lds, gw, ngw, wave, lane);
    PHASE_END(0)

    for (int layer = 0; layer < DEPTH; ++layer) {
        PHASE_BEGIN
            pg8::Gemm g{XB, (const bf16_t*)(ws + (size_t)(layer & 1) * WSZ + W_IN), Dm, Dm, Dm, 1 << 30, 0, -1};
            pg8::StaticOrder S; S.init(M, 4096, G, bx);
            EpiMix E{RSB, CS, LB + (0 * 4 + layer) * 512, LB + (1 * 4 + layer) * 512, Qb, Kb, Vb, HQ, HV, BG, GF, GB};
            if ON(1) pg8::gemm_phase(lds, g, S, E);
        PHASE_END(1)
        PHASE_BEGIN
            const float lam_init = 0.8f - 0.6f * __expf(-0.3f * (float)layer);
            const float lam = LAM[layer];
            if ON(2) for (int i = 0; i * G + bx < 512; ++i) {
                const int uid = i * G + bx; const int round = uid >> 8, r = uid & 255;
                const int bhh = round * 8 + (r & 7), qb = r >> 3;
                attn_unit(bhh >> 2, bhh & 3, qb, Qb, Kb, Vb, AO, P.da_norm + layer * 512, 1.0f - lam_init, lam, lds);
            }
            TICK(2);
            if ON(3) hg1_phase(bx, G, GF, GB, HV, UT, Dg, Eg, lds);
        PHASE_END(3)
        PHASE_BEGIN
            {
                pg8::Gemm g{XB, (const bf16_t*)(ws + (size_t)(layer & 1) * WSZ + W_IN) + (size_t)4096 * Dm, Dm, Dm, Dm, 1 << 30, 0, -1};
                pg8::StaticOrder S; S.init(M, 2048, G, bx);
                EpiGate E{RSB, GATE};
                if ON(4) pg8::gemm_phase(lds, g, S, E);
            }
            TICK(4);
            if ON(5) hg2_scan(UT, Dg, Eg, bx * 512 + tid, G * 512);
            TICK(5);
            if ON(6) if (layer + 1 < DEPTH) convert_layer(P, layer + 1, ws + (size_t)((layer + 1) & 1) * WSZ, lds, gw, ngw, wave, lane);
        PHASE_END(6)
        PHASE_BEGIN
            if ON(7) for (int u = bx; u < 1024; u += G) hg3_unit(u, GF, GB, HQ, HV, UT, BG, P.hg_norm + layer * 512, AO, lds);
        PHASE_END(7)
        PHASE_BEGIN
            pg8::Gemm g{AO, (const bf16_t*)(ws + (size_t)(layer & 1) * WSZ + W_AB), 1024, 1024, 1024, 1 << 30, 0, 8};
            pg8::StaticOrder S; S.init(M, 1024, G, bx);
            EpiY E{GATE, Yb};
            if ON(8) pg8::gemm_phase(lds, g, S, E);
        PHASE_END(8)
        PHASE_BEGIN
            pg8::Gemm g{Yb, (const bf16_t*)(ws + (size_t)(layer & 1) * WSZ + W_O2), 1024, 1024, 1024, 1 << 30, 0, -1};
            pg8::StaticOrder S; S.init(M, Dm, G, bx);
            EpiRes E{layer == 0 ? P.x : P.out, P.out, XB, RSA};
            if ON(9) pg8::gemm_phase(lds, g, S, E);
        PHASE_END(9)
        PHASE_BEGIN
            pg8::Gemm g{XB, (const bf16_t*)(ws + (size_t)(layer & 1) * WSZ + W_GU), Dm, Dm, Dm, 1 << 30, 0, -1};
            pg8::StaticOrder S; S.init(M, 2 * FF, G, bx);
            EpiGU E{RSA, Hb};
            if ON(10) pg8::gemm_phase(lds, g, S, E);
        PHASE_END(10)
        PHASE_BEGIN
            pg8::Gemm g{Hb, (const bf16_t*)(ws + (size_t)(layer & 1) * WSZ + W_D), FF, FF, FF, 1 << 30, 0, -1};
            pg8::StaticOrder S; S.init(M, Dm, G, bx);
            EpiRes E{P.out, P.out, XB, RSB};
            if ON(11) pg8::gemm_phase(lds, g, S, E);
        PHASE_END(11)
    }
    PHASE_BEGIN
        if ON(12) for (int r = gw; r < M; r += ngw) {
            f32x4* xr = (f32x4*)(P.out + (size_t)r * Dm) + lane;
            f32x4 v[4]; float ss = 0.f;
#pragma unroll
            for (int j = 0; j < 4; ++j) { v[j] = xr[64 * j]; ss += (v[j].x * v[j].x + v[j].y * v[j].y) + (v[j].z * v[j].z + v[j].w * v[j].w); }
            const float rs = rsqrtf(wave_sum(ss) * (1.0f / Dm) + EPS);
#pragma unroll
            for (int j = 0; j < 4; ++j) { const f32x4 gn = *((const f32x4*)P.final_norm + lane + 64 * j); xr[64 * j] = (f32x4){v[j].x * rs * gn.x, v[j].y * rs * gn.y, v[j].z * rs * gn.z, v[j].w * rs * gn.w}; }
        }
    PHASE_END(12)
#ifdef TS_A
    if (bx == 0 && threadIdx.x == 0) {
        LAS unsigned long long* TS_ = (LAS unsigned long long*)(lds + 131072);
        unsigned long long a = 0;
        for (int i = 0; i < 15; ++i) { if ((TS_A >> i) & 1) a += TS_[i]; }
        const unsigned long long t_end = __builtin_amdgcn_s_memrealtime() + a;
        while (__builtin_amdgcn_s_memrealtime() < t_end) __builtin_amdgcn_s_sleep(20);
    }
#endif
}
constexpr int NPHASES = 2 + 8 * DEPTH;

#ifndef MK_PER_PHASE
#define MK_PER_PHASE 0
#endif

extern "C" void kernel_launch(void* const* d_in, const int* in_sizes, int n_in, void* d_out, int out_size, void* d_ws, size_t ws_size, hipStream_t stream) {
    static int grid = 0;
    if (grid == 0) {
        if (n_in != 16 || out_size != M * Dm || ws_size < WS_END) { fprintf(stderr, "kernel_launch: unexpected sizes (n_in %d, out %d, ws %zu, need %zu)\n", n_in, out_size, ws_size, (size_t)WS_END); grid = -1; return; }
        int dev = 0, cus = 0, per_cu = 0;
        (void)hipGetDevice(&dev);
        (void)hipDeviceGetAttribute(&cus, hipDeviceAttributeMultiprocessorCount, dev);
        if (hipFuncSetAttribute((const void*)fwd_kernel, hipFuncAttributeMaxDynamicSharedMemorySize, LDS_BYTES) != hipSuccess) { fprintf(stderr, "kernel_launch: hipFuncSetAttribute failed\n"); grid = -1; return; }
        (void)hipOccupancyMaxActiveBlocksPerMultiprocessor(&per_cu, (const void*)fwd_kernel, 512, LDS_BYTES);
        (void)hipGetLastError();
        if (per_cu < 1) per_cu = 1;
        grid = cus * 1;
        fprintf(stderr, "kernel_launch: grid %d (per_cu %d), ws %zu need %zu\n", grid, per_cu, ws_size, (size_t)WS_END);
    }
    if (grid < 0) return;
    Ptrs p{};
    p.x = (const float*)d_in[0]; p.pos = (const int*)d_in[1]; p.w_in = (const float*)d_in[2]; p.da_lambda = (const float*)d_in[3]; p.da_norm = (const float*)d_in[4];
    p.hg_lb = (const float*)d_in[5]; p.hg_norm = (const float*)d_in[6]; p.w_a = (const float*)d_in[7]; p.w_b = (const float*)d_in[8]; p.w_o = (const float*)d_in[9];
    p.attn_norm = (const float*)d_in[10]; p.ffn_norm = (const float*)d_in[11]; p.w_gate = (const float*)d_in[12]; p.w_up = (const float*)d_in[13]; p.w_down = (const float*)d_in[14];
    p.final_norm = (const float*)d_in[15];
    p.out = (float*)d_out; p.ws = (unsigned char*)d_ws;
    (void)hipMemsetAsync((char*)d_ws + OFF_BAR, 0, BAR_BYTES, stream);
#if MK_PER_PHASE
    for (int ph = 0; ph < NPHASES; ++ph) {
        p.ph_lo = ph; p.ph_hi = ph + 1;
        hipLaunchKernelGGL(fwd_kernel, dim3(grid), dim3(512), LDS_BYTES, stream, p);
    }
#else
    p.ph_lo = 0; p.ph_hi = NPHASES;
    void* args[] = {&p};
    hipError_t e = hipLaunchCooperativeKernel((const void*)fwd_kernel, dim3(grid), dim3(512), args, LDS_BYTES, stream);
    if (e != hipSuccess) fprintf(stderr, "cooperative launch failed: %s (grid %d)\n", hipGetErrorString(e), grid);
#endif
}
```

```cpp
#include <hip/hip_runtime.h>
#include <hip/hip_cooperative_groups.h>
#include <cstdio>
#include <cstdint>
namespace cg = cooperative_groups;

#define LAS __attribute__((address_space(3)))
typedef unsigned short bf16_t;
typedef short bf16x8 __attribute__((ext_vector_type(8)));
typedef short s16x4 __attribute__((ext_vector_type(4)));
typedef float f32x4 __attribute__((ext_vector_type(4)));
typedef float f32x16 __attribute__((ext_vector_type(16)));
typedef unsigned u32x4 __attribute__((ext_vector_type(4)));
typedef unsigned u32x2 __attribute__((ext_vector_type(2)));

constexpr int Dm = 1024, NB = 4, SEQ = 4096, M = NB * SEQ, DEPTH = 4, FF = 2816, INW = 6144;
constexpr float EPS = 1e-6f;
constexpr float LOG2E = 1.4426950408889634f;

constexpr size_t W_IN = 0, W_AB = 12582912, W_O2 = 14680064, W_GU = 18874368, W_D = 30408704, WSZ = 36175872;
constexpr size_t MiB = 1048576;
constexpr size_t OFF_XB = 2 * WSZ;
constexpr size_t OFF_RSA = OFF_XB + 32 * MiB;
constexpr size_t OFF_RSB = OFF_RSA + MiB;
constexpr size_t OFF_CS = OFF_RSB + MiB;
constexpr size_t OFF_LB = OFF_CS + MiB;
constexpr size_t OFF_LAM = OFF_LB + 16384;
constexpr size_t OFF_DG = OFF_LAM + 256;
constexpr size_t OFF_EG = OFF_DG + MiB;
constexpr size_t OFF_B = OFF_EG + MiB;
constexpr size_t OFF_GATE = OFF_B;
constexpr size_t OFF_Q = OFF_B, OFF_K = OFF_B + 16 * MiB, OFF_V = OFF_B + 32 * MiB;
constexpr size_t OFF_HQ = OFF_B + 64 * MiB;
constexpr size_t OFF_HV = OFF_HQ + 16 * MiB;
constexpr size_t OFF_GF = OFF_HV + 16 * MiB;
constexpr size_t OFF_GB = OFF_GF + 32 * MiB;
constexpr size_t OFF_Y = OFF_GF;
constexpr size_t OFF_BG = OFF_GB + 32 * MiB;
constexpr size_t OFF_AO = OFF_BG + 16 * MiB;
constexpr size_t OFF_UT = OFF_AO + 32 * MiB;
constexpr size_t OFF_H = OFF_B;
constexpr size_t OFF_BAR = OFF_UT + 64 * MiB;
constexpr size_t BAR_BYTES = 16384;
constexpr size_t WS_END = OFF_BAR + BAR_BYTES;

constexpr int LDS_BYTES = 131072 + 2048;

__device__ __forceinline__ unsigned f2bf(float f) { unsigned u = __builtin_bit_cast(unsigned, f); return (u + 0x7fffu + ((u >> 16) & 1u)) >> 16; }
typedef float f32x2_t __attribute__((ext_vector_type(2)));
typedef __bf16 bf16x2_t __attribute__((ext_vector_type(2)));
__device__ __forceinline__ unsigned pk2(float lo, float hi) { f32x2_t v = {lo, hi}; bf16x2_t b = __builtin_convertvector(v, bf16x2_t); return __builtin_bit_cast(unsigned, b); }
__device__ __forceinline__ float bf2f(unsigned short b) { return __builtin_bit_cast(float, (unsigned)b << 16); }
__device__ __forceinline__ float bflo(unsigned u) { return __builtin_bit_cast(float, u << 16); }
__device__ __forceinline__ float bfhi(unsigned u) { return __builtin_bit_cast(float, u & 0xffff0000u); }
__device__ __forceinline__ float sigmoidf_(float x) { return 1.0f / (1.0f + __expf(-x)); }

namespace pg8 {
constexpr int BM = 256, BK = 64, HALF = 128, HTB = HALF * BK * 2, STAGE_BYTES = 8 * HTB, NXCD = 8, WGM = 8;
__host__ __device__ __forceinline__ int lds_byte(int r, int c) { const int st = (r >> 4) * 2 + (c >> 5), rr = r & 15, cc = c & 31, ob = rr * 64 + cc * 2; return st * 1024 + (ob ^ (((ob >> 9) & 1) << 5)); }
__host__ __device__ __forceinline__ void stage_rc(int b, int& R, int& C) { const int st = b / 1024, sb = b % 1024, swz = sb ^ (((sb >> 9) & 1) << 5); R = (st >> 1) * 16 + swz / 64; C = (st & 1) * 32 + (swz % 64) / 2; }
__host__ __device__ __forceinline__ int perm32(int rho) { const int n = rho >> 4, i = rho & 15; return 8 * (i >> 2) + 4 * n + (i & 3); }

struct Unit { int pm, pn; };
struct Gemm { const bf16_t* A; const bf16_t* Bt; int lda, ldb, K; int split_pn; int split_aoff; int mid_t; };

struct StaticOrder {
    int nM, nN, nwg, G, c;
    __device__ __forceinline__ void init(int M_, int N_, int G_, int c_) { nM = M_ / BM; nN = N_ / BM; nwg = nM * nN; G = G_; c = c_; }
    __device__ bool next(int i, Unit& u) const {
        const long L = (long)i * G + c; if (L >= nwg) return false;
        int wgid = (int)L; { const int q = nwg / NXCD, r = nwg % NXCD, xcd = wgid % NXCD, off = wgid / NXCD; wgid = (xcd < r ? xcd * (q + 1) : r * (q + 1) + (xcd - r) * q) + off; }
        const int nig = WGM * nN, gid = wgid / nig, fm = gid * WGM, gsz = (nM - fm) < WGM ? (nM - fm) : WGM;
        u.pm = fm + ((wgid % nig) % gsz); u.pn = (wgid % nig) / gsz; return true;
    }
};

template <class Epi>
__device__ __forceinline__ void gemm_phase(LAS unsigned char* lds, const Gemm g, const StaticOrder& S, const Epi& E) {
    int tid_ = threadIdx.x; asm volatile("" : "+v"(tid_));
    const int tid = tid_, wid = __builtin_amdgcn_readfirstlane(tid >> 6), lane = tid & 63, wr = wid >> 2, wc = wid & 3, fr = lane & 15, fq = lane >> 4;
    const int K = g.K, nt = K / BK;
    unsigned voffA[2], voffB[2];
#pragma unroll
    for (int i = 0; i < 2; ++i) { int R, C; stage_rc(tid * 16 + i * 8192, R, C); const int Rb = (R & ~31) + perm32(R & 31);
        voffA[i] = (unsigned)(R * g.lda + C) * 2u; voffB[i] = (unsigned)(Rb * g.ldb + C) * 2u; }
    const size_t kstep = (size_t)(BK * 2);
    const size_t hstepA = (size_t)HALF * g.lda * 2, hstepB = (size_t)HALF * g.ldb * 2;
    const size_t tstepA = 2 * hstepA, tstepB = 2 * hstepB;
    const unsigned ldsw = (unsigned)wid * 1024u;
    const int aoff = lds_byte(wr * 64 + fr, fq * 8), boff = lds_byte(wc * 32 + fr, fq * 8);
#define PG8_SA(b, h) (((b) * 2 + (h)) * HTB)
#define PG8_SB(b, h) ((4 + (b) * 2 + (h)) * HTB)
#define PG8_STAGE(bufoff, gbase, voff) do { _Pragma("unroll") for (int _i = 0; _i < 2; ++_i) \
        __builtin_amdgcn_global_load_lds((const unsigned*)((const char*)(gbase) + (voff)[_i]), (LAS unsigned*)(lds + (bufoff) + ldsw + _i * 8192), 16, 0, 0); } while (0)
#define PG8_LDA(dst, b, h) do { _Pragma("unroll") for (int m = 0; m < 4; ++m) _Pragma("unroll") for (int k = 0; k < 2; ++k) dst[m][k] = *(const LAS bf16x8*)(lds + PG8_SA(b, h) + aoff + m * 2048 + k * 1024); } while (0)
#define PG8_LDB(dst, b, h) do { _Pragma("unroll") for (int n = 0; n < 2; ++n) _Pragma("unroll") for (int k = 0; k < 2; ++k) dst[n][k] = *(const LAS bf16x8*)(lds + PG8_SB(b, h) + boff + n * 2048 + k * 1024); } while (0)
#define PG8_MMA(ai, bj, At, Bt) do { __builtin_amdgcn_s_setprio(1); _Pragma("unroll") for (int m = 0; m < 4; ++m) _Pragma("unroll") for (int n = 0; n < 2; ++n) _Pragma("unroll") for (int k = 0; k < 2; ++k) \
        acc[ai][bj][m][n] = __builtin_amdgcn_mfma_f32_16x16x32_bf16(Bt[n][k], At[m][k], acc[ai][bj][m][n], 0, 0, 0); __builtin_amdgcn_s_setprio(0); } while (0)
#define PG8_WAIT_V(n) asm volatile("s_waitcnt vmcnt(" #n ")" ::: "memory")
#define PG8_WAIT_L(n) asm volatile("s_waitcnt lgkmcnt(" #n ")" ::: "memory")
#define PG8_BAR __builtin_amdgcn_s_barrier()
#define PG8_SCHED __builtin_amdgcn_sched_barrier(0)
#define PG8_UA(u) ((const char*)g.A + (size_t)(u).pm * tstepA + (((u).pn >= g.split_pn) ? (size_t)g.split_aoff * 2 : (size_t)0))
    Unit cur, nxt; int ui = 0;
    if (!S.next(0, cur)) return;
    f32x4 acc[2][2][4][2];
#pragma unroll
    for (int a = 0; a < 2; ++a)
#pragma unroll
        for (int b = 0; b < 2; ++b)
#pragma unroll
            for (int m = 0; m < 4; ++m)
#pragma unroll
                for (int n = 0; n < 2; ++n) acc[a][b][m][n] = (f32x4){0.f, 0.f, 0.f, 0.f};
    bf16x8 At[4][2], B0[2][2], B1[2][2];
    const char* cA = PG8_UA(cur); const char* cB = (const char*)g.Bt + (size_t)cur.pn * tstepB;
    PG8_STAGE(PG8_SB(0, 0), cB, voffB); PG8_STAGE(PG8_SB(0, 1), cB + hstepB, voffB); PG8_STAGE(PG8_SA(0, 0), cA, voffA); PG8_STAGE(PG8_SA(0, 1), cA + hstepA, voffA);
    if (wr == 1) PG8_BAR;
    PG8_WAIT_V(2); PG8_BAR;
    PG8_STAGE(PG8_SB(1, 0), cB + kstep, voffB); PG8_STAGE(PG8_SA(1, 0), cA + kstep, voffA); PG8_STAGE(PG8_SB(1, 1), cB + hstepB + kstep, voffB);
    PG8_WAIT_V(6); PG8_BAR;
    for (;;) {
        const bool has_next = S.next(ui + 1, nxt);
        const char* nA = has_next ? PG8_UA(nxt) : cA; const char* nB = has_next ? (const char*)g.Bt + (size_t)nxt.pn * tstepB : cB;
        for (int t = 0; t < nt; t += 2) {
            if constexpr (Epi::HAS_MID) { if (t == g.mid_t) E.mid(acc, cur, wr, wc, fr, fq); }
            const bool last = (t == nt - 2);
            const char* a1 = cA + (size_t)(t + 1) * kstep;
            const char* a2 = last ? nA : cA + (size_t)(t + 2) * kstep; const char* b2 = last ? nB : cB + (size_t)(t + 2) * kstep;
            const char* a3 = a2 + kstep; const char* b3 = b2 + kstep;
            PG8_LDB(B0, 0, 0); PG8_LDB(B1, 0, 1); PG8_SCHED; PG8_LDA(At, 0, 0); PG8_STAGE(PG8_SA(1, 1), a1 + hstepA, voffA);
            PG8_WAIT_V(8); PG8_WAIT_L(0); PG8_BAR; PG8_MMA(0, 0, At, B0); PG8_MMA(0, 1, At, B1); PG8_BAR; PG8_SCHED;
            PG8_LDA(At, 0, 1); PG8_STAGE(PG8_SB(0, 0), b2, voffB); PG8_STAGE(PG8_SB(0, 1), b2 + hstepB, voffB); PG8_STAGE(PG8_SA(0, 0), a2, voffA);
            PG8_WAIT_V(8); PG8_WAIT_L(0); PG8_BAR; PG8_MMA(1, 0, At, B0); PG8_MMA(1, 1, At, B1); PG8_BAR; PG8_SCHED;
            PG8_LDB(B0, 1, 0); PG8_LDB(B1, 1, 1); PG8_SCHED; PG8_LDA(At, 1, 0); PG8_STAGE(PG8_SA(0, 1), a2 + hstepA, voffA);
            PG8_WAIT_V(8); PG8_WAIT_L(0); PG8_BAR; PG8_MMA(0, 0, At, B0); PG8_MMA(0, 1, At, B1); PG8_BAR; PG8_SCHED;
            PG8_LDA(At, 1, 1); PG8_STAGE(PG8_SB(1, 0), b3, voffB); PG8_STAGE(PG8_SB(1, 1), b3 + hstepB, voffB); PG8_STAGE(PG8_SA(1, 0), a3, voffA);
            PG8_WAIT_V(8); PG8_WAIT_L(0); PG8_BAR; PG8_MMA(1, 0, At, B0); PG8_MMA(1, 1, At, B1); PG8_BAR; PG8_SCHED;
        }
        if (wr == 0) PG8_BAR;
        E(acc, cur, wr, wc, fr, fq);
        if (!has_next) break;
#pragma unroll
        for (int a = 0; a < 2; ++a)
#pragma unroll
            for (int b = 0; b < 2; ++b)
#pragma unroll
                for (int m = 0; m < 4; ++m)
#pragma unroll
                    for (int n = 0; n < 2; ++n) acc[a][b][m][n] = (f32x4){0.f, 0.f, 0.f, 0.f};
        cur = nxt; cA = nA; cB = nB; ++ui;
        if (wr == 1) PG8_BAR;
    }
    PG8_WAIT_V(0);
    PG8_BAR;
#undef PG8_SA
#undef PG8_SB
#undef PG8_STAGE
#undef PG8_LDA
#undef PG8_LDB
#undef PG8_MMA
#undef PG8_UA
}
}

__device__ __forceinline__ float row_rs(const float* rsp, int row) {
    const f32x4* p = (const f32x4*)(rsp + (size_t)row * 16);
    f32x4 a = p[0], b = p[1], c = p[2], d = p[3];
    float s = ((a.x + a.y) + (a.z + a.w)) + ((b.x + b.y) + (b.z + b.w)) + ((c.x + c.y) + (c.z + c.w)) + ((d.x + d.y) + (d.z + d.w));
    return rsqrtf(s * (1.0f / Dm) + EPS);
}
__device__ __forceinline__ void rows_rs4(const float* rsp, int row0  , float (&rs)[4]) {
#pragma unroll
    for (int mp = 0; mp < 2; ++mp) {
        f32x4 p[2][4];
#pragma unroll
        for (int m = 0; m < 2; ++m) { const f32x4* q = (const f32x4*)(rsp + (size_t)(row0 + 16 * (2 * mp + m)) * 16);
#pragma unroll
            for (int i = 0; i < 4; ++i) p[m][i] = q[i]; }
#pragma unroll
        for (int m = 0; m < 2; ++m) { float t = 0.f;
#pragma unroll
            for (int i = 0; i < 4; ++i) t += (p[m][i].x + p[m][i].y) + (p[m][i].z + p[m][i].w);
            rs[2 * mp + m] = rsqrtf(t * (1.0f / Dm) + EPS); }
        __builtin_amdgcn_sched_barrier(0);
    }
}
__device__ __forceinline__ void rows_rs2(const float* rsp, int row0, float (&rs)[2]) {
    f32x4 p[2][4];
#pragma unroll
    for (int m = 0; m < 2; ++m) { const f32x4* q = (const f32x4*)(rsp + (size_t)(row0 + 16 * m) * 16);
#pragma unroll
        for (int i = 0; i < 4; ++i) p[m][i] = q[i]; }
#pragma unroll
    for (int m = 0; m < 2; ++m) { float t = 0.f;
#pragma unroll
        for (int i = 0; i < 4; ++i) t += (p[m][i].x + p[m][i].y) + (p[m][i].z + p[m][i].w);
        rs[m] = rsqrtf(t * (1.0f / Dm) + EPS); }
}
__device__ __forceinline__ u32x4 pack8(const float* v) { u32x4 w; w.x = pk2(v[0], v[1]); w.y = pk2(v[2], v[3]); w.z = pk2(v[4], v[5]); w.w = pk2(v[6], v[7]); return w; }

struct EpiMix {
    static constexpr bool HAS_MID = false;
    const float* rsp; const float* cs; const float* lbF; const float* lbB;
    bf16_t *Q, *Kk, *V, *HQ, *HV, *BG; float *GF, *GB;
    template <int GRP>
    __device__ __forceinline__ void run(const f32x4 (&acc)[2][2][4][2], const pg8::Unit& u, int wr, int wc, int fr, int fq) const {
#pragma unroll
        for (int ai = 0; ai < 2; ++ai)
#pragma unroll
        for (int mp = 0; mp < 2; ++mp) {
            const int row0 = u.pm * 256 + ai * 128 + wr * 64 + mp * 32 + fr;
            float rs4[2]; rows_rs2(rsp, row0, rs4);
            const int d0r = (wc * 32 + fq * 8) & 63;
            f32x4 c4r[2], s4r[2];
            if constexpr (GRP <= 1) {
                if (d0r < 16) {
#pragma unroll
                    for (int mm = 0; mm < 2; ++mm) { const float* cp = cs + (size_t)(row0 + 16 * mm) * 16 + (d0r >> 3) * 4; c4r[mm] = *(const f32x4*)cp; s4r[mm] = *(const f32x4*)(cp + 8); }
                }
            }
            __builtin_amdgcn_sched_barrier(0);
#pragma unroll
            for (int mm = 0; mm < 2; ++mm) {
                const int m = 2 * mp + mm;
                const int row = row0 + mm * 16;
                const float rs = rs4[mm];
                const int b = row >> 12, s = row & 4095;
#pragma unroll
                for (int bj = 0; bj < 2; ++bj) {
                    const int col = u.pn * 256 + bj * 128 + wc * 32 + fq * 8;
                    const int jj = col & 511;
                    float v[8];
#pragma unroll
                    for (int e = 0; e < 4; ++e) { v[e] = acc[ai][bj][m][0][e] * rs; v[4 + e] = acc[ai][bj][m][1][e] * rs; }
                    if constexpr (GRP <= 1) {
                        const int d0 = jj & 63;
                        if (d0 < 16) {
                            const f32x4 c4 = c4r[mm], s4 = s4r[mm];
#pragma unroll
                            for (int e = 0; e < 4; ++e) { const float t1 = v[e], t2 = v[4 + e]; v[e] = t1 * c4[e] - t2 * s4[e]; v[4 + e] = t2 * c4[e] + t1 * s4[e]; }
                        }
                        if constexpr (GRP == 0) {
#pragma unroll
                            for (int e = 0; e < 8; ++e) v[e] *= 0.125f * LOG2E;
                        }
                        const int h = jj >> 7, c = (jj >> 6) & 1;
                        bf16_t* dst = (GRP == 0 ? Q : Kk) + ((size_t)(((b * 4 + h) * 2 + c) * SEQ + s)) * 64 + d0;
                        *(u32x4*)dst = pack8(v);
                    } else if constexpr (GRP == 2) {
                        const int h = jj >> 7, d0 = jj & 127;
                        *(u32x4*)(V + ((size_t)((b * 4 + h) * SEQ + s)) * 128 + d0) = pack8(v);
                    } else if constexpr (GRP == 3) {
                        *(u32x4*)(HQ + (size_t)row * 512 + jj) = pack8(v);
                    } else if constexpr (GRP == 4 || GRP == 5) {
                        const float* lbp = (GRP == 4 ? lbF : lbB) + jj;
                        const f32x4 l0 = *(const f32x4*)lbp, l1 = *(const f32x4*)(lbp + 4);
                        float gl[8];
#pragma unroll
                        for (int e = 0; e < 8; ++e) { const float lb = e < 4 ? l0[e] : l1[e - 4]; const float f = lb + (1.0f - lb) * sigmoidf_(v[e]); gl[e] = __logf(fmaxf(f, 1e-37f)); }
                        float* dst = (GRP == 4 ? GF : GB) + (size_t)row * 512 + jj;
                        *(f32x4*)dst = (f32x4){gl[0], gl[1], gl[2], gl[3]}; *(f32x4*)(dst + 4) = (f32x4){gl[4], gl[5], gl[6], gl[7]};
                    } else if constexpr (GRP == 6) {
                        *(u32x4*)(HV + (size_t)row * 512 + jj) = pack8(v);
                    } else {
#pragma unroll
                        for (int e = 0; e < 8; ++e) v[e] = sigmoidf_(v[e]);
                        *(u32x4*)(BG + (size_t)row * 512 + jj) = pack8(v);
                    }
                }
            }
            __builtin_amdgcn_sched_barrier(0);
        }
    }
    __device__ __forceinline__ void operator()(const f32x4 (&acc)[2][2][4][2], const pg8::Unit& u, int wr, int wc, int fr, int fq) const {
        switch (u.pn >> 1) {
            case 0: run<0>(acc, u, wr, wc, fr, fq); break;
            case 1: run<1>(acc, u, wr, wc, fr, fq); break;
            case 2: run<2>(acc, u, wr, wc, fr, fq); break;
            case 3: run<3>(acc, u, wr, wc, fr, fq); break;
            case 4: run<4>(acc, u, wr, wc, fr, fq); break;
            case 5: run<5>(acc, u, wr, wc, fr, fq); break;
            case 6: run<6>(acc, u, wr, wc, fr, fq); break;
            default: run<7>(acc, u, wr, wc, fr, fq); break;
        }
    }
};

struct EpiGate {
    static constexpr bool HAS_MID = false;
    const float* rsp; bf16_t* G;
    __device__ __forceinline__ void operator()(const f32x4 (&acc)[2][2][4][2], const pg8::Unit& u, int wr, int wc, int fr, int fq) const {
#pragma unroll
        for (int ai = 0; ai < 2; ++ai) {
            const int row0 = u.pm * 256 + ai * 128 + wr * 64 + fr;
            float rs4[4]; rows_rs4(rsp, row0, rs4);
            __builtin_amdgcn_sched_barrier(0);
#pragma unroll
            for (int m = 0; m < 4; ++m) {
                const int row = row0 + m * 16;
                const float rs = rs4[m];
                const int col = u.pn * 128 + wc * 32 + fq * 8;
                float r[8], sb[8];
#pragma unroll
                for (int n = 0; n < 2; ++n)
#pragma unroll
                    for (int e = 0; e < 4; ++e) {
                        const float ea = __expf(fminf(-acc[ai][0][m][n][e] * rs, 60.f)), eb = __expf(fminf(-acc[ai][1][m][n][e] * rs, 60.f));
                        sb[n * 4 + e] = 1.0f / (1.0f + eb); r[n * 4 + e] = (1.0f + eb) / (1.0f + ea);
                    }
                *(u32x4*)(G + (size_t)row * 2048 + col) = pack8(r);
                *(u32x4*)(G + (size_t)row * 2048 + 1024 + col) = pack8(sb);
            }
            __builtin_amdgcn_sched_barrier(0);
        }
    }
};

struct EpiY {
    static constexpr bool HAS_MID = true;
    const bf16_t* G; bf16_t* Y;
    __device__ __forceinline__ void mid(f32x4 (&acc)[2][2][4][2], const pg8::Unit& u, int wr, int wc, int fr, int fq) const {
        int fr_ = fr; asm volatile("" : "+v"(fr_));
#pragma unroll
        for (int ai = 0; ai < 2; ++ai) {
            __builtin_amdgcn_sched_barrier(0);
#pragma unroll
            for (int m = 0; m < 4; ++m) {
                const int row = u.pm * 256 + ai * 128 + wr * 64 + m * 16 + fr_;
#pragma unroll
                for (int bj = 0; bj < 2; ++bj) {
                    const int col = u.pn * 256 + bj * 128 + wc * 32 + fq * 8;
                    const u32x4 gq = *(const u32x4*)(G + (size_t)row * 2048 + col);
                    acc[ai][bj][m][0][0] *= bflo(gq.x); acc[ai][bj][m][0][1] *= bfhi(gq.x); acc[ai][bj][m][0][2] *= bflo(gq.y); acc[ai][bj][m][0][3] *= bfhi(gq.y);
                    acc[ai][bj][m][1][0] *= bflo(gq.z); acc[ai][bj][m][1][1] *= bfhi(gq.z); acc[ai][bj][m][1][2] *= bflo(gq.w); acc[ai][bj][m][1][3] *= bfhi(gq.w);
                }
            }
        }
        __builtin_amdgcn_sched_barrier(0);
    }
    __device__ __forceinline__ void operator()(const f32x4 (&acc)[2][2][4][2], const pg8::Unit& u, int wr, int wc, int fr, int fq) const {
#pragma unroll
        for (int ai = 0; ai < 2; ++ai) {
            u32x4 gqr[4][2];
#pragma unroll
            for (int m = 0; m < 4; ++m)
#pragma unroll
                for (int bj = 0; bj < 2; ++bj) gqr[m][bj] = *(const u32x4*)(G + (size_t)(u.pm * 256 + ai * 128 + wr * 64 + m * 16 + fr) * 2048 + 1024 + u.pn * 256 + bj * 128 + wc * 32 + fq * 8);
            __builtin_amdgcn_sched_barrier(0);
#pragma unroll
            for (int m = 0; m < 4; ++m) {
                const int row = u.pm * 256 + ai * 128 + wr * 64 + m * 16 + fr;
#pragma unroll
                for (int bj = 0; bj < 2; ++bj) {
                    const int col = u.pn * 256 + bj * 128 + wc * 32 + fq * 8;
                    const u32x4 gq = gqr[m][bj];
                    float v[8];
                    v[0] = acc[ai][bj][m][0][0] * bflo(gq.x); v[1] = acc[ai][bj][m][0][1] * bfhi(gq.x);
                    v[2] = acc[ai][bj][m][0][2] * bflo(gq.y); v[3] = acc[ai][bj][m][0][3] * bfhi(gq.y);
                    v[4] = acc[ai][bj][m][1][0] * bflo(gq.z); v[5] = acc[ai][bj][m][1][1] * bfhi(gq.z);
                    v[6] = acc[ai][bj][m][1][2] * bflo(gq.w); v[7] = acc[ai][bj][m][1][3] * bfhi(gq.w);
                    *(u32x4*)(Y + (size_t)row * 1024 + col) = pack8(v);
                }
            }
            __builtin_amdgcn_sched_barrier(0);
        }
    }
};

struct EpiRes {
    static constexpr bool HAS_MID = false;
    const float* xres; float* xout; bf16_t* XB; float* rsp;
    __device__ __forceinline__ void operator()(const f32x4 (&acc)[2][2][4][2], const pg8::Unit& u, int wr, int wc, int fr, int fq) const {
#pragma unroll
        for (int ai = 0; ai < 2; ++ai)
#pragma unroll
        for (int mp = 0; mp < 2; ++mp) {
            f32x4 xr0[2][2], xr1[2][2];
#pragma unroll
            for (int mm = 0; mm < 2; ++mm)
#pragma unroll
                for (int bj = 0; bj < 2; ++bj) { const float* xr = xres + (size_t)(u.pm * 256 + ai * 128 + wr * 64 + (2 * mp + mm) * 16 + fr) * Dm + u.pn * 256 + bj * 128 + wc * 32 + fq * 8;
                    xr0[mm][bj] = *(const f32x4*)xr; xr1[mm][bj] = *(const f32x4*)(xr + 4); }
            __builtin_amdgcn_sched_barrier(0);
#pragma unroll
            for (int mm = 0; mm < 2; ++mm) {
                const int m = 2 * mp + mm;
                const int row = u.pm * 256 + ai * 128 + wr * 64 + m * 16 + fr;
                float ss = 0.f;
#pragma unroll
                for (int bj = 0; bj < 2; ++bj) {
                    const int col = u.pn * 256 + bj * 128 + wc * 32 + fq * 8;
                    const f32x4 x0 = xr0[mm][bj], x1 = xr1[mm][bj];
                    float v[8];
#pragma unroll
                    for (int e = 0; e < 4; ++e) { v[e] = x0[e] + acc[ai][bj][m][0][e]; v[4 + e] = x1[e] + acc[ai][bj][m][1][e]; }
#pragma unroll
                    for (int e = 0; e < 8; ++e) ss += v[e] * v[e];
                    float* xo = xout + (size_t)row * Dm + col;
                    *(f32x4*)xo = (f32x4){v[0], v[1], v[2], v[3]}; *(f32x4*)(xo + 4) = (f32x4){v[4], v[5], v[6], v[7]};
                    *(u32x4*)(XB + (size_t)row * Dm + col) = pack8(v);
                }
                ss += __shfl_xor(ss, 16); ss += __shfl_xor(ss, 32);
                if (fq == 0) rsp[(size_t)row * 16 + u.pn * 4 + wc] = ss;
            }
            __builtin_amdgcn_sched_barrier(0);
        }
    }
};

struct EpiGU {
    static constexpr bool HAS_MID = false;
    const float* rsp; bf16_t* H;
    __device__ __forceinline__ void operator()(const f32x4 (&acc)[2][2][4][2], const pg8::Unit& u, int wr, int wc, int fr, int fq) const {
#pragma unroll
        for (int ai = 0; ai < 2; ++ai) {
            const int row0 = u.pm * 256 + ai * 128 + wr * 64 + fr;
            float rs4[4]; rows_rs4(rsp, row0, rs4);
            __builtin_amdgcn_sched_barrier(0);
#pragma unroll
            for (int m = 0; m < 4; ++m) {
                const int row = row0 + m * 16;
                const float rs = rs4[m];
                const int col = u.pn * 128 + wc * 32 + fq * 8;
                float v[8];
#pragma unroll
                for (int n = 0; n < 2; ++n)
#pragma unroll
                    for (int e = 0; e < 4; ++e) { const float gg = acc[ai][0][m][n][e] * rs, uu = acc[ai][1][m][n][e] * rs; v[n * 4 + e] = gg * sigmoidf_(gg) * uu; }
                *(u32x4*)(H + (size_t)row * FF + col) = pack8(v);
            }
            __builtin_amdgcn_sched_barrier(0);
        }
    }
};

__device__ __forceinline__ int rope_perm(int n) {
    const int d = n & 63; if (d >= 16) return n;
    const int g = d >> 3, e = d & 7; return (n & ~63) + ((e < 4) ? 4 * g + e : 8 + 4 * g + (e - 4));
}
__device__ __forceinline__ void conv_item(const float* src, int ld_src, int ks0, int c0  , int mode  ,
                                          const float* gain, bf16_t* dst, int ld_dst, int n0, int kd0, LAS float* scr, int lane) {
    const int n4 = lane & 7, kr = lane >> 3;
    int sc = c0 + 4 * n4;
    if (mode) { const int q = (sc & 63) >> 2; if (q == 1) sc += 4; else if (q == 2) sc -= 4; }
#pragma unroll
    for (int i = 0; i < 8; ++i) { const int kk = kr + 8 * i; f32x4 w = *(const f32x4*)(src + (size_t)(ks0 + kk) * ld_src + sc);
        if (gain) { const float gg = gain[ks0 + kk]; w.x *= gg; w.y *= gg; w.z *= gg; w.w *= gg; }
        LAS float* d = scr + kk * 33 + 4 * n4; d[0] = w.x; d[1] = w.y; d[2] = w.z; d[3] = w.w; }
    asm volatile("s_waitcnt lgkmcnt(0)" ::: "memory");
    const int c = lane & 7;
#pragma unroll
    for (int j = 0; j < 4; ++j) { const int n = (lane >> 3) + 8 * j; const LAS float* s = scr + (8 * c) * 33 + n;
        u32x4 o; o.x = pk2(s[0 * 33], s[1 * 33]); o.y = pk2(s[2 * 33], s[3 * 33]); o.z = pk2(s[4 * 33], s[5 * 33]); o.w = pk2(s[6 * 33], s[7 * 33]);
        *(u32x4*)(dst + (size_t)(n0 + n) * ld_dst + kd0 + 8 * c) = o; }
    asm volatile("s_waitcnt lgkmcnt(0)" ::: "memory");
}

struct Ptrs {
    const float *x; const int* pos; const float *w_in, *da_lambda, *da_norm, *hg_lb, *hg_norm, *w_a, *w_b, *w_o, *attn_norm, *ffn_norm, *w_gate, *w_up, *w_down, *final_norm;
    float* out; unsigned char* ws; int ph_lo, ph_hi;
};

__device__ __forceinline__ void convert_layer(const Ptrs& P, int layer, unsigned char* wbuf, LAS unsigned char* lds, int gw, int ngw, int wave, int lane) {
    LAS float* scr = (LAS float*)(lds + wave * 8704);
    constexpr int I_IN = 16 * 192, I_A = 8 * 32, I_B = 8 * 32, I_O = 16 * 32, I_GU = 16 * 176, I_D = 44 * 32;
    constexpr int NIT = I_IN + I_A + I_B + I_O + I_GU + I_D;
    for (int it = gw; it < NIT; it += ngw) {
        int r = it;
        if (r < I_IN) { const int kb = r / 192, nb = r % 192, n0 = nb * 32;
            int c0 = n0; if (n0 >= 4096) { const int q = n0 - 4096, tile = q >> 8, rr = q & 255; c0 = (rr < 128 ? 4096 : 5120) + tile * 128 + (rr & 127); }
            conv_item(P.w_in + (size_t)layer * Dm * INW, INW, kb * 64, c0, n0 < 1024 ? 1 : 0, P.attn_norm + layer * Dm, (bf16_t*)(wbuf + W_IN), Dm, n0, kb * 64, scr, lane); continue; }
        r -= I_IN;
        if (r < I_A) { const int kb = r / 32, nb = r % 32;
            conv_item(P.w_a + (size_t)layer * 512 * Dm, Dm, kb * 64, nb * 32, 0, nullptr, (bf16_t*)(wbuf + W_AB), 1024, nb * 32, kb * 64, scr, lane); continue; }
        r -= I_A;
        if (r < I_B) { const int kb = r / 32, nb = r % 32;
            conv_item(P.w_b + (size_t)layer * 512 * Dm, Dm, kb * 64, nb * 32, 0, nullptr, (bf16_t*)(wbuf + W_AB), 1024, nb * 32, 512 + kb * 64, scr, lane); continue; }
        r -= I_B;
        if (r < I_O) { const int kb = r / 32, nb = r % 32;
            conv_item(P.w_o + (size_t)layer * Dm * Dm, Dm, kb * 64, nb * 32, 0, nullptr, (bf16_t*)(wbuf + W_O2), Dm, nb * 32, kb * 64, scr, lane); continue; }
        r -= I_O;
        if (r < I_GU) { const int kb = r / 176, nb = r % 176, n0 = nb * 32, tile = n0 >> 8, rr = n0 & 255;
            const float* srcm = (rr < 128 ? P.w_gate : P.w_up) + (size_t)layer * Dm * FF;
            conv_item(srcm, FF, kb * 64, tile * 128 + (rr & 127), 0, P.ffn_norm + layer * Dm, (bf16_t*)(wbuf + W_GU), Dm, n0, kb * 64, scr, lane); continue; }
        r -= I_GU;
        { const int kb = r / 32, nb = r % 32;
            conv_item(P.w_down + (size_t)layer * FF * Dm, Dm, kb * 64, nb * 32, 0, nullptr, (bf16_t*)(wbuf + W_D), FF, nb * 32, kb * 64, scr, lane); }
    }
}

__device__ __forceinline__ float wave_sum(float v) {
#pragma unroll
    for (int o = 1; o < 64; o <<= 1) v += __shfl_xor(v, o);
    return v;
}
__device__ __forceinline__ void prologue(const Ptrs& P, LAS unsigned char* lds, int gw, int ngw, int wave, int lane) {
    unsigned char* ws = P.ws;
    bf16_t* XB = (bf16_t*)(ws + OFF_XB); float* rsb = (float*)(ws + OFF_RSB);
    for (int r = gw; r < M; r += ngw) {
        const f32x4* xr = (const f32x4*)(P.x + (size_t)r * Dm) + lane;
        float ss = 0.f;
#pragma unroll
        for (int j = 0; j < 4; ++j) { const f32x4 v = xr[64 * j]; ss += (v.x * v.x + v.y * v.y) + (v.z * v.z + v.w * v.w);
            u32x2 o; o.x = pk2(v.x, v.y); o.y = pk2(v.z, v.w); *((u32x2*)(XB + (size_t)r * Dm) + lane + 64 * j) = o; }
        ss = wave_sum(ss);
        if (lane < 16) rsb[(size_t)r * 16 + lane] = (lane == 0) ? ss : 0.f;
    }
    const int gt = gw * 64 + lane, ngt = ngw * 64;
    float* cs = (float*)(ws + OFF_CS);
    for (int i = gt; i < M * 8; i += ngt) {
        const int tok = i >> 3, f = i & 7;
        const double invf[8] = {1.0, 0.19392274474868576, 0.03760603093086393, 0.007292664737217109, 0.001414213562373095, 0.0002742481756762073, 5.318295896944988e-05, 1.031338537721246e-05};
        double fr;
        switch (f) { case 0: fr = invf[0]; break; case 1: fr = invf[1]; break; case 2: fr = invf[2]; break; case 3: fr = invf[3]; break; case 4: fr = invf[4]; break; case 5: fr = invf[5]; break; case 6: fr = invf[6]; break; default: fr = invf[7]; }
        const float ang32 = (float)P.pos[tok] * (float)fr;
        const double ang = (double)ang32;
        const double rev = ang * 0.15915494309189535;
        const double fracrev = rev - __builtin_floor(rev + 0.5);
        const float a = (float)(fracrev * 6.283185307179586);
        cs[(size_t)tok * 16 + f] = __cosf(a); cs[(size_t)tok * 16 + 8 + f] = __sinf(a);
    }
    float* LB = (float*)(ws + OFF_LB);
    for (int i = gt; i < 2 * 512; i += ngt) {
        const int d = i >> 9, k = i & 511;
        float l[4], mx = -1e30f;
#pragma unroll
        for (int j = 0; j < 4; ++j) { l[j] = P.hg_lb[(size_t)(d * 4 + j) * 512 + k]; mx = fmaxf(mx, l[j]); }
        float e[4], sum = 0.f;
#pragma unroll
        for (int j = 0; j < 4; ++j) { e[j] = __expf(l[j] - mx); sum += e[j]; }
        float cum = 0.f;
#pragma unroll
        for (int j = 0; j < 4; ++j) { if (j > 0) cum += e[j] / sum; LB[(size_t)(d * 4 + j) * 512 + k] = cum; }
    }
    if (gw == 0) {
        float* LAM = (float*)(ws + OFF_LAM);
        for (int l = 0; l < 4; ++l) {
            const float* p = P.da_lambda + l * 256;
            float a = wave_sum(p[lane] * p[64 + lane]), b = wave_sum(p[128 + lane] * p[192 + lane]);
            const float lam_init = 0.8f - 0.6f * __expf(-0.3f * (float)l);
            if (lane == 0) LAM[l] = __expf(a) - __expf(b) + lam_init;
        }
    }
}

constexpr int AT_KROW = 144, AT_VROW = 320, AT_K1 = 64 * AT_KROW, AT_V = 2 * AT_K1, AT_STG = AT_V + 64 * AT_VROW;
constexpr int AT_IMG_ROW = 132;
__device__ __forceinline__ s16x4 tr_read(const LAS unsigned char* p) { return __builtin_bit_cast(s16x4, __builtin_amdgcn_ds_read_tr16_b64_v4i16((LAS s16x4*)p)); }

__device__ __forceinline__ void attn_unit(int b, int h, int qb, const bf16_t* Q, const bf16_t* Kk, const bf16_t* V, bf16_t* AO, const float* gainA  , float one_minus_lam_init, float lam, LAS unsigned char* lds) {
    int tid_ = threadIdx.x; asm volatile("" : "+v"(tid_));
    const int tid = tid_, wave = __builtin_amdgcn_readfirstlane(tid >> 6), lane = tid & 63, c = wave >> 2, wq = wave & 3, r32 = lane & 31, hh = lane >> 5;
    const int q0 = qb * 128 + wq * 32;
    bf16x8 qf[4];
    { const bf16_t* Qp = Q + ((size_t)(((b * 4 + h) * 2 + c) * SEQ + q0 + r32)) * 64 + 8 * hh;
#pragma unroll
      for (int s = 0; s < 4; ++s) qf[s] = *(const bf16x8*)(Qp + 16 * s); }
    f32x16 o[4];
#pragma unroll
    for (int i = 0; i < 4; ++i)
#pragma unroll
        for (int e = 0; e < 16; ++e) o[i][e] = 0.f;
    float mrow = -1e30f, lrow = 0.f;
    const unsigned char* Kg0 = (const unsigned char*)(Kk + ((size_t)((b * 4 + h) * 2 + 0) * SEQ) * 64);
    const unsigned char* Kg1 = (const unsigned char*)(Kk + ((size_t)((b * 4 + h) * 2 + 1) * SEQ) * 64);
    const unsigned char* Vg = (const unsigned char*)(V + ((size_t)(b * 4 + h) * SEQ) * 128);
    const int lk = (tid >> 3) * AT_KROW + (tid & 7) * 16;
    const int lv0 = AT_V + (tid >> 4) * AT_VROW + (tid & 15) * 16, lv1 = lv0 + 32 * AT_VROW;
    u32x4 r0, r1, r2, r3;
    r0 = *(const u32x4*)(Kg0 + tid * 16); r1 = *(const u32x4*)(Kg1 + tid * 16); r2 = *(const u32x4*)(Vg + tid * 16); r3 = *(const u32x4*)(Vg + 8192 + tid * 16);
    *(LAS u32x4*)(lds + lk) = r0; *(LAS u32x4*)(lds + AT_K1 + lk) = r1; *(LAS u32x4*)(lds + lv0) = r2; *(LAS u32x4*)(lds + lv1) = r3;
    r0 = *(const u32x4*)(Kg0 + 8192 + tid * 16); r1 = *(const u32x4*)(Kg1 + 8192 + tid * 16);
    *(LAS u32x4*)(lds + AT_STG + lk) = r0; *(LAS u32x4*)(lds + AT_STG + AT_K1 + lk) = r1;
    __syncthreads();
    const int ka = c * AT_K1 + r32 * AT_KROW + hh * 16;
    const int va = AT_V + (4 * hh + ((lane & 15) >> 2)) * AT_VROW + ((lane >> 4) & 1) * 32 + (lane & 3) * 8;

#define AT_QK(sv, st) do { f32x16 t0_, t1_; _Pragma("unroll") for (int e = 0; e < 16; ++e) { t0_[e] = 0.f; t1_[e] = 0.f; } \
        _Pragma("unroll") for (int ks = 0; ks < 4; ++ks) { \
            const bf16x8 a0 = *(const LAS bf16x8*)(lds + (st) + ka + ks * 32), a1 = *(const LAS bf16x8*)(lds + (st) + ka + 32 * AT_KROW + ks * 32); \
            t0_ = __builtin_amdgcn_mfma_f32_32x32x16_bf16(a0, qf[ks], t0_, 0, 0, 0); t1_ = __builtin_amdgcn_mfma_f32_32x32x16_bf16(a1, qf[ks], t1_, 0, 0, 0); } \
        sv##0 = t0_; sv##1 = t1_; } while (0)
    f32x16 sA0, sA1, sB0, sB1;
    AT_QK(sA, 0);
#define AT_VFRAG(dst, STC, g) do { const LAS unsigned char* vb_ = lds + (STC) + va + (16 * (g)) * AT_VROW; \
        _Pragma("unroll") for (int vt = 0; vt < 4; ++vt) { const s16x4 t0 = tr_read(vb_ + vt * 64), t1 = tr_read(vb_ + vt * 64 + 8 * AT_VROW); \
            dst[vt] = (bf16x8){t0[0], t0[1], t0[2], t0[3], t1[0], t1[1], t1[2], t1[3]}; } } while (0)
#define AT_PV(vf, p) do { __builtin_amdgcn_s_setprio(1); _Pragma("unroll") for (int vt = 0; vt < 4; ++vt) o[vt] = __builtin_amdgcn_mfma_f32_32x32x16_bf16(vf[vt], p, o[vt], 0, 0, 0); __builtin_amdgcn_s_setprio(0); } while (0)
#define AT_SB __builtin_amdgcn_sched_barrier(0)
#define AT_TILE(j, s0, s1, sn, STC  , STN  ) do { \
        if ((j) + 2 < 64) { const size_t go = (size_t)((j) + 2) * 8192; r0 = *(const u32x4*)(Kg0 + go + tid * 16); r1 = *(const u32x4*)(Kg1 + go + tid * 16); } \
        if ((j) + 1 < 64) { const size_t go = (size_t)((j) + 1) * 16384; r2 = *(const u32x4*)(Vg + go + tid * 16); r3 = *(const u32x4*)(Vg + go + 8192 + tid * 16); } \
        bf16x8 kf[4], kg[4], vA[4]; \
        if ((j) + 1 < 64) { _Pragma("unroll") for (int ks = 0; ks < 2; ++ks) { kf[2 * ks] = *(const LAS bf16x8*)(lds + (STN) + ka + ks * 32); kf[2 * ks + 1] = *(const LAS bf16x8*)(lds + (STN) + ka + 32 * AT_KROW + ks * 32); } } \
        AT_SB; \
        float mx = fmaxf(s0[0], s1[0]); \
        _Pragma("unroll") for (int e = 1; e < 16; ++e) mx = fmaxf(mx, fmaxf(s0[e], s1[e])); \
        mx = fmaxf(mx, __shfl_xor(mx, 32)); \
        if (__builtin_amdgcn_ballot_w64(mx > mrow + 8.0f) != 0ull) { \
            const float mnew = fmaxf(mrow, mx), alpha = __builtin_amdgcn_exp2f(mrow - mnew); mrow = mnew; lrow *= alpha; \
            _Pragma("unroll") for (int i = 0; i < 4; ++i) _Pragma("unroll") for (int e = 0; e < 16; ++e) o[i][e] *= alpha; } \
        AT_SB; \
        if ((j) + 1 < 64) { f32x16 t0_, t1_; _Pragma("unroll") for (int e = 0; e < 16; ++e) { t0_[e] = 0.f; t1_[e] = 0.f; } \
            __builtin_amdgcn_s_setprio(1); \
            _Pragma("unroll") for (int ks = 0; ks < 2; ++ks) { t0_ = __builtin_amdgcn_mfma_f32_32x32x16_bf16(kf[2 * ks], qf[ks], t0_, 0, 0, 0); t1_ = __builtin_amdgcn_mfma_f32_32x32x16_bf16(kf[2 * ks + 1], qf[ks], t1_, 0, 0, 0); } \
            AT_SB; \
            _Pragma("unroll") for (int ks = 0; ks < 2; ++ks) { kg[2 * ks] = *(const LAS bf16x8*)(lds + (STN) + ka + (ks + 2) * 32); kg[2 * ks + 1] = *(const LAS bf16x8*)(lds + (STN) + ka + 32 * AT_KROW + (ks + 2) * 32); } \
            AT_SB; \
            _Pragma("unroll") for (int ks = 0; ks < 2; ++ks) { t0_ = __builtin_amdgcn_mfma_f32_32x32x16_bf16(kg[2 * ks], qf[ks + 2], t0_, 0, 0, 0); t1_ = __builtin_amdgcn_mfma_f32_32x32x16_bf16(kg[2 * ks + 1], qf[ks + 2], t1_, 0, 0, 0); } \
            __builtin_amdgcn_s_setprio(0); sn##0 = t0_; sn##1 = t1_; } \
        AT_VFRAG(vA, STC, 0); \
        AT_SB; \
        float ls = 0.f; \
        _Pragma("unroll") for (int e = 0; e < 16; ++e) { s0[e] = __builtin_amdgcn_exp2f(s0[e] - mrow); s1[e] = __builtin_amdgcn_exp2f(s1[e] - mrow); ls += s0[e] + s1[e]; } \
        lrow += ls; \
        bf16x8 pf[2][2]; \
        _Pragma("unroll") for (int s = 0; s < 2; ++s) { u32x4 w0, w1; \
            w0.x = pk2(s0[8 * s + 0], s0[8 * s + 1]); w0.y = pk2(s0[8 * s + 2], s0[8 * s + 3]); w0.z = pk2(s0[8 * s + 4], s0[8 * s + 5]); w0.w = pk2(s0[8 * s + 6], s0[8 * s + 7]); \
            w1.x = pk2(s1[8 * s + 0], s1[8 * s + 1]); w1.y = pk2(s1[8 * s + 2], s1[8 * s + 3]); w1.z = pk2(s1[8 * s + 4], s1[8 * s + 5]); w1.w = pk2(s1[8 * s + 6], s1[8 * s + 7]); \
            pf[0][s] = __builtin_bit_cast(bf16x8, w0); pf[1][s] = __builtin_bit_cast(bf16x8, w1); } \
        AT_SB; \
        AT_PV(vA, pf[0][0]); \
        AT_SB; \
        AT_VFRAG(vA, STC, 1); \
        AT_SB; \
        AT_PV(vA, pf[0][1]); \
        AT_SB; \
        AT_VFRAG(vA, STC, 2); \
        AT_SB; \
        AT_PV(vA, pf[1][0]); \
        AT_SB; \
        AT_VFRAG(vA, STC, 3); \
        AT_SB; \
        AT_PV(vA, pf[1][1]); \
        if ((j) + 2 < 64) { *(LAS u32x4*)(lds + (STC) + lk) = r0; *(LAS u32x4*)(lds + (STC) + AT_K1 + lk) = r1; } \
        if ((j) + 1 < 64) { *(LAS u32x4*)(lds + (STN) + lv0) = r2; *(LAS u32x4*)(lds + (STN) + lv1) = r3; } \
        __syncthreads(); } while (0)
    for (int j = 0; j < 64; j += 2) {
        AT_TILE(j, sA0, sA1, sB, 0, AT_STG);
        AT_TILE(j + 1, sB0, sB1, sA, AT_STG, 0);
    }
#undef AT_TILE
#undef AT_QK
#undef AT_VFRAG
#undef AT_PV
#undef AT_SB
    const float inv = 1.0f / (lrow + __shfl_xor(lrow, 32));
    LAS float* img = (LAS float*)lds;
    const int qrow = wq * 32 + r32;
    if (c == 1) {
        const float sc = -lam * inv;
#pragma unroll
        for (int vt = 0; vt < 4; ++vt)
#pragma unroll
            for (int g = 0; g < 4; ++g)
                *(LAS f32x4*)(img + qrow * AT_IMG_ROW + 32 * vt + 8 * g + 4 * hh) = (f32x4){o[vt][4 * g] * sc, o[vt][4 * g + 1] * sc, o[vt][4 * g + 2] * sc, o[vt][4 * g + 3] * sc};
    }
    __syncthreads();
    if (c == 0) {
#pragma unroll
        for (int vt = 0; vt < 4; ++vt)
#pragma unroll
            for (int g = 0; g < 4; ++g) {
                LAS f32x4* p = (LAS f32x4*)(img + qrow * AT_IMG_ROW + 32 * vt + 8 * g + 4 * hh);
                f32x4 t = *p;
                t.x += o[vt][4 * g] * inv; t.y += o[vt][4 * g + 1] * inv; t.z += o[vt][4 * g + 2] * inv; t.w += o[vt][4 * g + 3] * inv;
                *p = t;
            }
    }
    __syncthreads();
    {
        const int q = tid >> 2, part = tid & 3;
        float v[32]; float ss = 0.f;
#pragma unroll
        for (int i = 0; i < 8; ++i) { const f32x4 t = *(const LAS f32x4*)(img + q * AT_IMG_ROW + 32 * part + 4 * i); v[4 * i] = t.x; v[4 * i + 1] = t.y; v[4 * i + 2] = t.z; v[4 * i + 3] = t.w;
            ss += (t.x * t.x + t.y * t.y) + (t.z * t.z + t.w * t.w); }
        ss += __shfl_xor(ss, 1); ss += __shfl_xor(ss, 2);
        const float rs = rsqrtf(ss * (1.0f / 128.0f) + EPS) * one_minus_lam_init;
        const float* gp = gainA + h * 128 + 32 * part;
        bf16_t* dst = AO + ((size_t)(b * SEQ + qb * 128 + q)) * 1024 + h * 128 + 32 * part;
#pragma unroll
        for (int i = 0; i < 4; ++i) {
            const f32x4 g0 = *(const f32x4*)(gp + 8 * i), g1 = *(const f32x4*)(gp + 8 * i + 4);
            u32x4 w; w.x = pk2(v[8 * i] * rs * g0.x, v[8 * i + 1] * rs * g0.y); w.y = pk2(v[8 * i + 2] * rs * g0.z, v[8 * i + 3] * rs * g0.w);
            w.z = pk2(v[8 * i + 4] * rs * g1.x, v[8 * i + 5] * rs * g1.y); w.w = pk2(v[8 * i + 6] * rs * g1.z, v[8 * i + 7] * rs * g1.w);
            *(u32x4*)(dst + 8 * i) = w;
        }
    }
    __syncthreads();
}

constexpr int HG_SEG = 0;
constexpr int HG_F = 2048;
constexpr int HG_PART = 2560;
constexpr int HG_V = 4096;
constexpr int HG_VROW = 288;
constexpr int HG_A = HG_V + 64 * HG_VROW;
constexpr int HG_KTROW = 144, HG_QKROW = 272;
constexpr int HG_Bq = HG_A + 128 * HG_KTROW;

__device__ __forceinline__ void hg_cumsum(const float (&gv)[16], int dir, int k, int j, LAS unsigned char* lds, float (&d)[16], float& m_out, float& tot_out) {
    float run = 0.f;
    if (dir == 0) {
#pragma unroll
        for (int i = 0; i < 16; ++i) { run += gv[i]; d[i] = run; }
    } else {
#pragma unroll
        for (int i = 15; i >= 0; --i) { run += gv[i]; d[i] = run; }
    }
    LAS float* seg = (LAS float*)(lds + HG_SEG);
    seg[j * 128 + k] = run;
    __syncthreads();
    const float s0 = seg[k], s1 = seg[128 + k], s2 = seg[256 + k], s3 = seg[384 + k];
    float off, m;
    if (dir == 0) { off = (j > 0 ? s0 : 0.f) + (j > 1 ? s1 : 0.f) + (j > 2 ? s2 : 0.f); m = s0 + s1; }
    else { off = (j < 3 ? s3 : 0.f) + (j < 2 ? s2 : 0.f) + (j < 1 ? s1 : 0.f); m = s2 + s3; }
#pragma unroll
    for (int i = 0; i < 16; ++i) d[i] = d[i] + off - m;
    m_out = m; tot_out = (s0 + s1) + (s2 + s3);
}
__device__ __forceinline__ void hg_load_v(const bf16_t* HV, int tok0, int h, LAS unsigned char* lds, int tid) {
#pragma unroll
    for (int i = 0; i < 2; ++i) { const int ch = tid + 512 * i, p = ch >> 4, part = ch & 15;
        *(LAS u32x4*)(lds + HG_V + p * HG_VROW + part * 16) = *(const u32x4*)(HV + (size_t)(tok0 + p) * 512 + h * 128 + part * 8); }
}
__device__ __forceinline__ void hg_load_g(const float* G, int tok0, int h, int k, int j, float (&gv)[16]) {
    const float* gp = G + (size_t)(tok0 + 16 * j) * 512 + h * 128 + k;
#pragma unroll
    for (int i = 0; i < 16; ++i) gv[i] = gp[(size_t)i * 512];
}

__device__ __forceinline__ void hg1_phase(int bx, int G, const float* GF, const float* GB, const bf16_t* HV, bf16_t* UT, float* Dg, float* Eg, LAS unsigned char* lds) {
    int tid_ = threadIdx.x; asm volatile("" : "+v"(tid_));
    const int tid = tid_, wave = __builtin_amdgcn_readfirstlane(tid >> 6), lane = tid & 63;
    const int k = tid & 127, j = tid >> 7, i16 = lane & 15, g4 = lane >> 4;
    float gn[16];
    if (bx < 2048) { const int u = bx, dir = u & 1, cch = (u >> 1) & 63, bh = u >> 7; hg_load_g(dir ? GB : GF, (bh >> 2) * SEQ + cch * 64, bh & 3, k, j, gn); }
    for (int u = bx; u < 2048; u += G) {
        const int dir = u & 1, cch = (u >> 1) & 63, bh = u >> 7, b = bh >> 2, h = bh & 3;
        const int tok0 = b * SEQ + cch * 64;
        float gv[16], d[16], m, tot;
#pragma unroll
        for (int i = 0; i < 16; ++i) gv[i] = gn[i];
        u32x4 vr[2];
#pragma unroll
        for (int i = 0; i < 2; ++i) { const int ch = tid + 512 * i; vr[i] = *(const u32x4*)(HV + (size_t)(tok0 + (ch >> 4)) * 512 + h * 128 + (ch & 15) * 8); }
        hg_cumsum(gv, dir, k, j, lds, d, m, tot);
        float kt[16];
#pragma unroll
        for (int i = 0; i < 16; ++i) kt[i] = (1.0f - __expf(gv[i])) * __expf(fminf(-d[i], 40.f));
        { u32x4 w0, w1;
          w0.x = pk2(kt[0], kt[1]); w0.y = pk2(kt[2], kt[3]); w0.z = pk2(kt[4], kt[5]); w0.w = pk2(kt[6], kt[7]);
          w1.x = pk2(kt[8], kt[9]); w1.y = pk2(kt[10], kt[11]); w1.z = pk2(kt[12], kt[13]); w1.w = pk2(kt[14], kt[15]);
          *(LAS u32x4*)(lds + HG_A + k * HG_KTROW + j * 32) = w0; *(LAS u32x4*)(lds + HG_A + k * HG_KTROW + j * 32 + 16) = w1; }
#pragma unroll
        for (int i = 0; i < 2; ++i) { const int ch = tid + 512 * i; *(LAS u32x4*)(lds + HG_V + (ch >> 4) * HG_VROW + (ch & 15) * 16) = vr[i]; }
        if (j == 0) { ((LAS float*)(lds + HG_F))[k] = __expf(tot - m); Dg[(size_t)u * 128 + k] = __expf(tot); Eg[(size_t)u * 128 + k] = __expf(m); }
        __syncthreads();
        if (u + G < 2048) { const int u2 = u + G, dir2 = u2 & 1, cch2 = (u2 >> 1) & 63, bh2 = u2 >> 7; hg_load_g(dir2 ? GB : GF, (bh2 >> 2) * SEQ + cch2 * 64, bh2 & 3, k, j, gn); }
        bf16x8 af[2];
#pragma unroll
        for (int s = 0; s < 2; ++s) {
            const LAS unsigned char* ap = lds + HG_A + (16 * wave + i16) * HG_KTROW + (32 * s + 4 * g4) * 2;
            const u32x2 lo = *(const LAS u32x2*)ap, hi = *(const LAS u32x2*)(ap + 32);
            af[s] = __builtin_bit_cast(bf16x8, (u32x4){lo.x, lo.y, hi.x, hi.y});
        }
        const f32x4 fsc = *(const LAS f32x4*)(lds + HG_F + (16 * wave + 4 * g4) * 4);
        const LAS unsigned char* vbase = lds + HG_V + (4 * g4 + (i16 >> 2)) * HG_VROW + (i16 & 3) * 8;
#pragma unroll
        for (int vt = 0; vt < 8; ++vt) {
            f32x4 acc = {0.f, 0.f, 0.f, 0.f};
#pragma unroll
            for (int s = 0; s < 2; ++s) {
                const s16x4 t0 = tr_read(vbase + (32 * s) * HG_VROW + vt * 32), t1 = tr_read(vbase + (32 * s + 16) * HG_VROW + vt * 32);
                const bf16x8 bv = {t0[0], t0[1], t0[2], t0[3], t1[0], t1[1], t1[2], t1[3]};
                acc = __builtin_amdgcn_mfma_f32_16x16x32_bf16(af[s], bv, acc, 0, 0, 0);
            }
            u32x2 w; w.x = pk2(acc[0] * fsc[0], acc[1] * fsc[1]); w.y = pk2(acc[2] * fsc[2], acc[3] * fsc[3]);
            *(u32x2*)(UT + ((size_t)u * 128 + 16 * vt + i16) * 128 + 16 * wave + 4 * g4) = w;
        }
        __syncthreads();
    }
}

__device__ __forceinline__ void hg2_scan(bf16_t* UT, const float* Dg, const float* Eg, int gthread, int nthreads) {
    for (int idx = gthread; idx < 32 * 4096; idx += nthreads) {
        const int chain = idx >> 12, e4 = idx & 4095, v = e4 >> 5, k0 = (e4 & 31) * 4;
        const int dir = chain & 1, bh = chain >> 1;
        float S0 = 0.f, S1 = 0.f, S2 = 0.f, S3 = 0.f;
        int u = (bh * 64 + (dir ? 63 : 0)) * 2 + dir;
        const int ustep = dir ? -2 : 2;
        u32x2 uu[4]; f32x4 dd[4], ee[4];
#pragma unroll
        for (int r = 0; r < 4; ++r) { const int ur = u + r * ustep; uu[r] = *(const u32x2*)(UT + ((size_t)ur * 128 + v) * 128 + k0); dd[r] = *(const f32x4*)(Dg + (size_t)ur * 128 + k0); ee[r] = *(const f32x4*)(Eg + (size_t)ur * 128 + k0); }
        for (int cc = 0; cc < 64; cc += 4) {
#pragma unroll
            for (int r = 0; r < 4; ++r) {
                const u32x2 uc = uu[r]; const f32x4 dc = dd[r], ec = ee[r];
                if (cc + 4 < 64) { const int un = u + 4 * ustep; uu[r] = *(const u32x2*)(UT + ((size_t)un * 128 + v) * 128 + k0); dd[r] = *(const f32x4*)(Dg + (size_t)un * 128 + k0); ee[r] = *(const f32x4*)(Eg + (size_t)un * 128 + k0); }
                u32x2 w; w.x = pk2(ec.x * S0, ec.y * S1); w.y = pk2(ec.z * S2, ec.w * S3);
                *(u32x2*)(UT + ((size_t)u * 128 + v) * 128 + k0) = w;
                S0 = dc.x * S0 + bflo(uc.x); S1 = dc.y * S1 + bfhi(uc.x); S2 = dc.z * S2 + bflo(uc.y); S3 = dc.w * S3 + bfhi(uc.y);
                u += ustep;
            }
        }
    }
}

constexpr int HG_OUT = HG_Bq + 64 * HG_QKROW;
__device__ __forceinline__ void hg3_unit(int u3, const float* GF, const float* GB, const bf16_t* HQ, const bf16_t* HV, const bf16_t* ST, const bf16_t* BG, const float* gainH, bf16_t* AO, LAS unsigned char* lds) {
    int tid_ = threadIdx.x; asm volatile("" : "+v"(tid_));
    const int tid = tid_, wave = __builtin_amdgcn_readfirstlane(tid >> 6), lane = tid & 63;
    const int cch = u3 & 63, bh = u3 >> 6, b = bh >> 2, h = bh & 3;
    const int tok0 = b * SEQ + cch * 64, k = tid & 127, j = tid >> 7;
    const int tb = wave & 3, vh = wave >> 2, i16 = lane & 15, g4 = lane >> 4;
    float gf[16], gb[16]; unsigned short qr[16];
    hg_load_g(GF, tok0, h, k, j, gf); hg_load_g(GB, tok0, h, k, j, gb);
    { const bf16_t* qp = HQ + (size_t)(tok0 + 16 * j) * 512 + h * 128 + k;
#pragma unroll
      for (int i = 0; i < 16; ++i) qr[i] = qp[(size_t)i * 512]; }
    hg_load_v(HV, tok0, h, lds, tid);
    u32x4 bgq[2];
    { const bf16_t* bgp0 = BG + (size_t)(tok0 + (tid >> 3)) * 512 + h * 128 + 16 * (tid & 7); bgq[0] = *(const u32x4*)bgp0; bgq[1] = *(const u32x4*)(bgp0 + 8); }
    bf16x8 sb[16];
    { const bf16_t* stp = ST + ((size_t)((bh * 64 + cch) * 2 + 0) * 128) * 128;
#pragma unroll
      for (int vv = 0; vv < 4; ++vv)
#pragma unroll
        for (int ks = 0; ks < 4; ++ks) sb[vv * 4 + ks] = *(const bf16x8*)(stp + (size_t)(16 * (4 * vh + vv) + i16) * 128 + 32 * ks + 8 * g4); }
    f32x4 oacc[4];
#pragma unroll
    for (int i = 0; i < 4; ++i) oacc[i] = (f32x4){0.f, 0.f, 0.f, 0.f};
#pragma unroll
    for (int dir = 0; dir < 2; ++dir) {
        float d[16], m, tot;
        hg_cumsum(dir ? gb : gf, dir, k, j, lds, d, m, tot);
#pragma unroll
        for (int i = 0; i < 16; ++i) {
            const float gvi = dir ? gb[i] : gf[i];
            const float kt = (1.0f - __expf(gvi)) * __expf(fminf(-d[i], 40.f));
            const float qt = bf2f(qr[i]) * __expf(fminf(d[i], 40.f));
            *(LAS unsigned short*)(lds + HG_A + (16 * j + i) * HG_QKROW + k * 2) = (unsigned short)f2bf(kt);
            *(LAS unsigned short*)(lds + HG_Bq + (16 * j + i) * HG_QKROW + k * 2) = (unsigned short)f2bf(qt);
        }
        __syncthreads();
        f32x4 pt[4];
#pragma unroll
        for (int sg = 0; sg < 4; ++sg) pt[sg] = (f32x4){0.f, 0.f, 0.f, 0.f};
        bf16x8 qa[4];
#pragma unroll
        for (int ks = 0; ks < 4; ++ks) qa[ks] = *(const LAS bf16x8*)(lds + HG_Bq + (16 * tb + i16) * HG_QKROW + (32 * ks + 8 * g4) * 2);
#pragma unroll
        for (int sg = 0; sg < 4; ++sg)
#pragma unroll
            for (int ks = 0; ks < 4; ++ks) {
                const bf16x8 ka = *(const LAS bf16x8*)(lds + HG_A + (16 * sg + i16) * HG_QKROW + (32 * ks + 8 * g4) * 2);
                pt[sg] = __builtin_amdgcn_mfma_f32_16x16x32_bf16(ka, qa[ks], pt[sg], 0, 0, 0);
            }
        const int tcol = 16 * tb + i16;
#pragma unroll
        for (int sg = 0; sg < 4; ++sg)
#pragma unroll
            for (int e = 0; e < 4; ++e) { const int srow = 16 * sg + 4 * g4 + e; const bool keep = dir ? (srow >= tcol) : (srow <= tcol); pt[sg][e] = keep ? pt[sg][e] : 0.f; }
        bf16x8 pa[2];
#pragma unroll
        for (int s2 = 0; s2 < 2; ++s2) {
            u32x4 w; w.x = pk2(pt[2 * s2][0], pt[2 * s2][1]); w.y = pk2(pt[2 * s2][2], pt[2 * s2][3]); w.z = pk2(pt[2 * s2 + 1][0], pt[2 * s2 + 1][1]); w.w = pk2(pt[2 * s2 + 1][2], pt[2 * s2 + 1][3]);
            pa[s2] = __builtin_bit_cast(bf16x8, w);
        }
        const LAS unsigned char* vbase = lds + HG_V + (4 * g4 + (i16 >> 2)) * HG_VROW + (i16 & 3) * 8;
#pragma unroll
        for (int vv = 0; vv < 4; ++vv) {
            const int vt = 4 * vh + vv;
#pragma unroll
            for (int s2 = 0; s2 < 2; ++s2) {
                const s16x4 t0 = tr_read(vbase + (32 * s2) * HG_VROW + vt * 32), t1 = tr_read(vbase + (32 * s2 + 16) * HG_VROW + vt * 32);
                const bf16x8 bv = {t0[0], t0[1], t0[2], t0[3], t1[0], t1[1], t1[2], t1[3]};
                oacc[vv] = __builtin_amdgcn_mfma_f32_16x16x32_bf16(pa[s2], bv, oacc[vv], 0, 0, 0);
            }
#pragma unroll
            for (int ks = 0; ks < 4; ++ks) oacc[vv] = __builtin_amdgcn_mfma_f32_16x16x32_bf16(qa[ks], sb[vv * 4 + ks], oacc[vv], 0, 0, 0);
        }
        if (dir == 0) {
            const bf16_t* stp = ST + ((size_t)((bh * 64 + cch) * 2 + 1) * 128) * 128;
#pragma unroll
            for (int vv = 0; vv < 4; ++vv)
#pragma unroll
                for (int ks = 0; ks < 4; ++ks) sb[vv * 4 + ks] = *(const bf16x8*)(stp + (size_t)(16 * (4 * vh + vv) + i16) * 128 + 32 * ks + 8 * g4);
        }
        __syncthreads();
    }
    LAS float* ot = (LAS float*)(lds + HG_OUT);
#pragma unroll
    for (int vv = 0; vv < 4; ++vv)
#pragma unroll
        for (int e = 0; e < 4; ++e) ot[(16 * tb + 4 * g4 + e) * 132 + 16 * (4 * vh + vv) + i16] = oacc[vv][e];
    __syncthreads();
    {
        const int t = tid >> 3, part = tid & 7;
        float v[16]; float ss = 0.f;
#pragma unroll
        for (int i = 0; i < 4; ++i) { const f32x4 x = *(const LAS f32x4*)(ot + t * 132 + 16 * part + 4 * i); v[4 * i] = x.x; v[4 * i + 1] = x.y; v[4 * i + 2] = x.z; v[4 * i + 3] = x.w; ss += (x.x * x.x + x.y * x.y) + (x.z * x.z + x.w * x.w); }
        ss += __shfl_xor(ss, 1); ss += __shfl_xor(ss, 2); ss += __shfl_xor(ss, 4);
        const float rs = rsqrtf(ss * (1.0f / 128.0f) + EPS);
        const float* gp = gainH + h * 128 + 16 * part;
        bf16_t* dst = AO + (size_t)(tok0 + t) * 1024 + 512 + h * 128 + 16 * part;
#pragma unroll
        for (int i = 0; i < 2; ++i) {
            const u32x4 gq = bgq[i];
            const f32x4 g0 = *(const f32x4*)(gp + 8 * i), g1 = *(const f32x4*)(gp + 8 * i + 4);
            u32x4 w;
            w.x = pk2(v[8 * i] * rs * g0.x * bflo(gq.x), v[8 * i + 1] * rs * g0.y * bfhi(gq.x)); w.y = pk2(v[8 * i + 2] * rs * g0.z * bflo(gq.y), v[8 * i + 3] * rs * g0.w * bfhi(gq.y));
            w.z = pk2(v[8 * i + 4] * rs * g1.x * bflo(gq.z), v[8 * i + 5] * rs * g1.y * bfhi(gq.z)); w.w = pk2(v[8 * i + 6] * rs * g1.z * bflo(gq.w), v[8 * i + 7] * rs * g1.w * bfhi(gq.w));
            *(u32x4*)(dst + 8 * i) = w;
        }
    }
    __syncthreads();
}

#define XB_TMO      128
#define XB_XCNT(j)  (256  + 64 * (j))
#define XB_XSUB(j)  (1280 + 64 * (j))
#define XB_XGEN(j)  (2304 + 64 * (j))
#define XB_TOP      3328
#define XB_TOPGEN   3392
#define XCD_BAR_WORDS 3456
#define XB_SPIN_CAP (1u << 18)

__device__ __forceinline__ unsigned xb_ld(unsigned* p)              { return __hip_atomic_load(p, __ATOMIC_RELAXED, __HIP_MEMORY_SCOPE_AGENT); }
__device__ __forceinline__ unsigned xb_add(unsigned* p, unsigned v) { return __hip_atomic_fetch_add(p, v, __ATOMIC_RELAXED, __HIP_MEMORY_SCOPE_AGENT); }
__device__ __forceinline__ unsigned xb_xcc_id() { return (unsigned)__builtin_amdgcn_s_getreg((3 << 11) | 20) & 0xFu; }
#define XB_SPIN(cond, bar) do { unsigned _sp = 0; while (cond) { __builtin_amdgcn_s_sleep(1); \
    if ((++_sp & 255u) == 0u) { if (xb_ld(&(bar)[XB_TMO])) break; if (_sp > XB_SPIN_CAP) { atomicAdd(&(bar)[XB_TMO], 1u); break; } } } } while (0)

struct XcdBarrier {
    unsigned* bar; unsigned x;
    volatile LAS unsigned* st;
};

__device__ __forceinline__ XcdBarrier xcd_barrier_post(unsigned* bar, volatile LAS unsigned* st) {
    XcdBarrier b; b.bar = bar; b.x = xb_xcc_id(); b.st = st;
    if (threadIdx.x == 0) (void)xb_add(&bar[XB_XCNT(b.x)], 1u);
    return b;
}
__device__ __forceinline__ void xcd_barrier_complete(unsigned* bar, unsigned x, unsigned& nloc, unsigned& nx) {
    const unsigned G = gridDim.x * gridDim.y * gridDim.z;
    unsigned sum, cnt, mine, sp = 0u;
    for (;;) {
        sum = 0u; cnt = 0u; mine = 0u;
#pragma unroll
        for (unsigned j = 0; j < 16; ++j) { const unsigned c = xb_ld(&bar[XB_XCNT(j)]); sum += c; cnt += (c > 0u) ? 1u : 0u; mine = (j == x) ? c : mine; }
        if (sum == G) break;
        __builtin_amdgcn_s_sleep(1);
        if ((++sp & 255u) == 0u) { if (xb_ld(&bar[XB_TMO])) break; if (sp > XB_SPIN_CAP) { atomicAdd(&bar[XB_TMO], 1u); break; } }
    }
    nloc = mine > 0u ? mine : 1u; nx = cnt > 0u ? cnt : 1u;
}

__device__ __forceinline__ void xcd_barrier(const XcdBarrier& b) {
    asm volatile("s_waitcnt vmcnt(0)" ::: "memory");
    __syncthreads();
    if (threadIdx.x == 0) {
        unsigned* bar = b.bar;
        __builtin_amdgcn_s_waitcnt(0);
        unsigned nloc = b.st[0], nx = b.st[1];
        if (nloc == 0u) { xcd_barrier_complete(bar, b.x, nloc, nx); b.st[0] = nloc; b.st[1] = nx; }
        const unsigned old = xb_add(&bar[XB_XSUB(b.x)], 1u);
        const unsigned gen = old / nloc;
        if (old + 1u == (gen + 1u) * nloc) {
            __builtin_amdgcn_fence(__ATOMIC_RELEASE, "agent");
            asm volatile("s_waitcnt vmcnt(0)" ::: "memory");
            const unsigned og = xb_add(&bar[XB_TOP], 1u);
            const unsigned tg = og / nx;
            if (og + 1u == (tg + 1u) * nx) xb_add(&bar[XB_TOPGEN], 1u);
            else XB_SPIN(xb_ld(&bar[XB_TOPGEN]) == tg, bar);
            __builtin_amdgcn_fence(__ATOMIC_ACQUIRE, "agent");
            xb_add(&bar[XB_XGEN(b.x)], 1u);
            asm volatile("s_waitcnt vmcnt(0)" ::: "memory");
        } else {
            XB_SPIN(xb_ld(&bar[XB_XGEN(b.x)]) == gen, bar);
            __builtin_amdgcn_fence(__ATOMIC_ACQUIRE, "agent");
            asm volatile("s_waitcnt vmcnt(0)" ::: "memory");
        }
    }
    __syncthreads();
}

__global__ void __launch_bounds__(512, 2) fwd_kernel(Ptrs Pk) {
    extern __shared__ __attribute__((aligned(16))) unsigned char lds_raw[];
    LAS unsigned char* lds = (LAS unsigned char*)lds_raw;
    cg::grid_group grid = cg::this_grid();
    const int G = gridDim.x, bx = blockIdx.x;
    const int lo = Pk.ph_lo, hi = Pk.ph_hi;
    int ph = 0;
    if (threadIdx.x < 4) ((LAS unsigned*)(lds + 131072 + 1024))[threadIdx.x] = 0u;
    __syncthreads();
    XcdBarrier xbar = xcd_barrier_post((unsigned*)(Pk.ws + OFF_BAR), (volatile LAS unsigned*)(lds + 131072 + 1024));
#ifdef TS_A
    if (threadIdx.x == 0) { LAS unsigned long long* TS_ = (LAS unsigned long long*)(lds + 131072); for (int i = 0; i < 15; ++i) TS_[i] = 0ull; TS_[15] = __builtin_amdgcn_s_memrealtime(); }
#endif
#ifndef PH_MASK
#define PH_MASK 0xFFFFFFFFu
#endif
#define ON(id) constexpr (((PH_MASK) >> (id)) & 1u)
#if defined(__HIP_DEVICE_COMPILE__)
#define LOAD_ARGS(P) int zoff_ = 0; asm volatile("" : "+s"(zoff_)); const Ptrs P = *(const __attribute__((address_space(4))) Ptrs*)((const __attribute__((address_space(4))) char*)__builtin_amdgcn_kernarg_segment_ptr() + zoff_);
#else
#define LOAD_ARGS(P) const Ptrs P = Pk;
#endif
#define PHASE_BEGIN if (ph >= lo && ph < hi) { LOAD_ARGS(P) unsigned char* ws = P.ws; asm volatile("" : "+s"(ws)); int tid = threadIdx.x; asm volatile("" : "+v"(tid)); \
    const int lane = tid & 63, wave = __builtin_amdgcn_readfirstlane(tid >> 6), gw = bx * 8 + wave, ngw = G * 8; (void)lane; (void)gw; (void)ngw;
#define XB ((bf16_t*)(ws + OFF_XB))
#define RSA ((float*)(ws + OFF_RSA))
#define RSB ((float*)(ws + OFF_RSB))
#define CS ((const float*)(ws + OFF_CS))
#define LB ((const float*)(ws + OFF_LB))
#define LAM ((const float*)(ws + OFF_LAM))
#define Dg ((float*)(ws + OFF_DG))
#define Eg ((float*)(ws + OFF_EG))
#define GATE ((bf16_t*)(ws + OFF_GATE))
#define Qb ((bf16_t*)(ws + OFF_Q))
#define Kb ((bf16_t*)(ws + OFF_K))
#define Vb ((bf16_t*)(ws + OFF_V))
#define HQ ((bf16_t*)(ws + OFF_HQ))
#define HV ((bf16_t*)(ws + OFF_HV))
#define GF ((float*)(ws + OFF_GF))
#define GB ((float*)(ws + OFF_GB))
#define Yb ((bf16_t*)(ws + OFF_Y))
#define BG ((bf16_t*)(ws + OFF_BG))
#define AO ((bf16_t*)(ws + OFF_AO))
#define UT ((bf16_t*)(ws + OFF_UT))
#define Hb ((bf16_t*)(ws + OFF_H))
#ifdef TS_A
#define TICK(cat) do { if (bx == 0 && threadIdx.x == 0) { LAS unsigned long long* TS_ = (LAS unsigned long long*)(lds + 131072); const unsigned long long t_ = __builtin_amdgcn_s_memrealtime(); TS_[cat] += t_ - TS_[15]; TS_[15] = t_; } } while (0)
#else
#define TICK(cat) do { } while (0)
#endif
#define PHASE_END(cat)   TICK(cat); if (ph + 1 < hi) { if (ph == 0) grid.sync(); else xcd_barrier(xbar); TICK(13); } } ++ph;

    PHASE_BEGIN
        if ON(0) prologue(P, lds, gw, ngw, wave, lane);
        if ON(6) convert_layer(P, 0, ws, lds, gw, ngw, wave, lane);
    PHASE_END(0)

    for (int layer = 0; layer < DEPTH; ++layer) {
        PHASE_BEGIN
            pg8::Gemm g{XB, (const bf16_t*)(ws + (size_t)(layer & 1) * WSZ + W_IN), Dm, Dm, Dm, 1 << 30, 0, -1};
            pg8::StaticOrder S; S.init(M, 4096, G, bx);
            EpiMix E{RSB, CS, LB + (0 * 4 + layer) * 512, LB + (1 * 4 + layer) * 512, Qb, Kb, Vb, HQ, HV, BG, GF, GB};
            if ON(1) pg8::gemm_phase(lds, g, S, E);
        PHASE_END(1)
        PHASE_BEGIN
            const float lam_init = 0.8f - 0.6f * __expf(-0.3f * (float)layer);
            const float lam = LAM[layer];
            if ON(2) for (int i = 0; i * G + bx < 512; ++i) {
                const int uid = i * G + bx; const int round = uid >> 8, r = uid & 255;
                const int bhh = round * 8 + (r & 7), qb = r >> 3;
                attn_unit(bhh >> 2, bhh & 3, qb, Qb, Kb, Vb, AO, P.da_norm + layer * 512, 1.0f - lam_init, lam, lds);
            }
            TICK(2);
            if ON(3) hg1_phase(bx, G, GF, GB, HV, UT, Dg, Eg, lds);
        PHASE_END(3)
        PHASE_BEGIN
            {
                pg8::Gemm g{XB, (const bf16_t*)(ws + (size_t)(layer & 1) * WSZ + W_IN) + (size_t)4096 * Dm, Dm, Dm, Dm, 1 << 30, 0, -1};
                pg8::StaticOrder S; S.init(M, 2048, G, bx);
                EpiGate E{RSB, GATE};
                if ON(4) pg8::gemm_phase(lds, g, S, E);
            }
            TICK(4);
            if ON(5) hg2_scan(UT, Dg, Eg, bx * 512 + tid, G * 512);
            TICK(5);
            if ON(6) if (layer + 1 < DEPTH) convert_layer(P, layer + 1, ws + (size_t)((layer + 1) & 1) * WSZ, lds, gw, ngw, wave, lane);
        PHASE_END(6)
        PHASE_BEGIN
            if ON(7) for (int u = bx; u < 1024; u += G) hg3_unit(u, GF, GB, HQ, HV, UT, BG, P.hg_norm + layer * 512, AO, lds);
        PHASE_END(7)
        PHASE_BEGIN
            pg8::Gemm g{AO, (const bf16_t*)(ws + (size_t)(layer & 1) * WSZ + W_AB), 1024, 1024, 1024, 1 << 30, 0, 8};
            pg8::StaticOrder S; S.init(M, 1024, G, bx);
            EpiY E{GATE, Yb};
            if ON(8) pg8::gemm_phase(lds, g, S, E);
        PHASE_END(8)
        PHASE_BEGIN
            pg8::Gemm g{Yb, (const bf16_t*)(ws + (size_t)(layer & 1) * WSZ + W_O2), 1024, 1024, 1024, 1 << 30, 0, -1};
            pg8::StaticOrder S; S.init(M, Dm, G, bx);
            EpiRes E{layer == 0 ? P.x : P.out, P.out, XB, RSA};
            if ON(9) pg8::gemm_phase(lds, g, S, E);
        PHASE_END(9)
        PHASE_BEGIN
            pg8::Gemm g{XB, (const bf16_t*)(ws + (size_t)(layer & 1) * WSZ + W_GU), Dm, Dm, Dm, 1 << 30, 0, -1};
            pg8::StaticOrder S; S.init(M, 2 * FF, G, bx);
            EpiGU E{RSA, Hb};
            if ON(10) pg8::gemm_phase(lds, g, S, E);
        PHASE_END(10)
        PHASE_BEGIN
            pg8::Gemm g{Hb, (const bf16_t*)(ws + (size_t)(layer & 1) * WSZ + W_D), FF, FF, FF, 1 << 30, 0, -1};
            pg8::StaticOrder S; S.init(M, Dm, G, bx);
            EpiRes E{P.out, P.out, XB, RSB};
            if ON(11) pg8::gemm_phase(lds, g, S, E);
        PHASE_END(11)
    }
    PHASE_BEGIN
        if ON(12) for (int r = gw; r < M; r += ngw) {
            f32x4* xr = (f32x4*)(P.out + (size_t)r * Dm) + lane;
            f32x4 v[4]; float ss = 0.f;
#pragma unroll
            for (int j = 0; j < 4; ++j) { v[j] = xr[64 * j]; ss += (v[j].x * v[j].x + v[j].y * v[j].y) + (v[j].z * v[j].z + v[j].w * v[j].w); }
            const float rs = rsqrtf(wave_sum(ss) * (1.0f / Dm) + EPS);
#pragma unroll
            for (int j = 0; j < 4; ++j) { const f32x4 gn = *((const f32x4*)P.final_norm + lane + 64 * j); xr[64 * j] = (f32x4){v[j].x * rs * gn.x, v[j].y * rs * gn.y, v[j].z * rs * gn.z, v[j].w * rs * gn.w}; }
        }
    PHASE_END(12)
#ifdef TS_A
    if (bx == 0 && threadIdx.x == 0) {
        LAS unsigned long long* TS_ = (LAS unsigned long long*)(lds + 131072);
        unsigned long long a = 0;
        for (int i = 0; i < 15; ++i) { if ((TS_A >> i) & 1) a += TS_[i]; }
        const unsigned long long t_end = __builtin_amdgcn_s_memrealtime() + a;
        while (__builtin_amdgcn_s_memrealtime() < t_end) __builtin_amdgcn_s_sleep(20);
    }
#endif
}
constexpr int NPHASES = 2 + 8 * DEPTH;

#ifndef MK_PER_PHASE
#define MK_PER_PHASE 0
#endif

extern "C" void kernel_launch(void* const* d_in, const int* in_sizes, int n_in, void* d_out, int out_size, void* d_ws, size_t ws_size, hipStream_t stream) {
    static int grid = 0;
    if (grid == 0) {
        if (n_in != 16 || out_size != M * Dm || ws_size < WS_END) { fprintf(stderr, "kernel_launch: unexpected sizes (n_in %d, out %d, ws %zu, need %zu)\n", n_in, out_size, ws_size, (size_t)WS_END); grid = -1; return; }
        int dev = 0, cus = 0, per_cu = 0;
        (void)hipGetDevice(&dev);
        (void)hipDeviceGetAttribute(&cus, hipDeviceAttributeMultiprocessorCount, dev);
        if (hipFuncSetAttribute((const void*)fwd_kernel, hipFuncAttributeMaxDynamicSharedMemorySize, LDS_BYTES) != hipSuccess) { fprintf(stderr, "kernel_launch: hipFuncSetAttribute failed\n"); grid = -1; return; }
        (void)hipOccupancyMaxActiveBlocksPerMultiprocessor(&per_cu, (const void*)fwd_kernel, 512, LDS_BYTES);
        (void)hipGetLastError();
        if (per_cu < 1) per_cu = 1;
        grid = cus * 1;
        fprintf(stderr, "kernel_launch: grid %d (per_cu %d), ws %zu need %zu\n", grid, per_cu, ws_size, (size_t)WS_END);
    }
    if (grid < 0) return;
    Ptrs p{};
    p.x = (const float*)d_in[0]; p.pos = (const int*)d_in[1]; p.w_in = (const float*)d_in[2]; p.da_lambda = (const float*)d_in[3]; p.da_norm = (const float*)d_in[4];
    p.hg_lb = (const float*)d_in[5]; p.hg_norm = (const float*)d_in[6]; p.w_a = (const float*)d_in[7]; p.w_b = (const float*)d_in[8]; p.w_o = (const float*)d_in[9];
    p.attn_norm = (const float*)d_in[10]; p.ffn_norm = (const float*)d_in[11]; p.w_gate = (const float*)d_in[12]; p.w_up = (const float*)d_in[13]; p.w_down = (const float*)d_in[14];
    p.final_norm = (const float*)d_in[15];
    p.out = (float*)d_out; p.ws = (unsigned char*)d_ws;
    (void)hipMemsetAsync((char*)d_ws + OFF_BAR, 0, BAR_BYTES, stream);
#if MK_PER_PHASE
    for (int ph = 0; ph < NPHASES; ++ph) {
        p.ph_lo = ph; p.ph_hi = ph + 1;
        hipLaunchKernelGGL(fwd_kernel, dim3(grid), dim3(512), LDS_BYTES, stream, p);
    }
#else
    p.ph_lo = 0; p.ph_hi = NPHASES;
    void* args[] = {&p};
    hipError_t e = hipLaunchCooperativeKernel((const void*)fwd_kernel, dim3(grid), dim3(512), args, LDS_BYTES, stream);
    if (e != hipSuccess) fprintf(stderr, "cooperative launch failed: %s (grid %d)\n", hipGetErrorString(e), grid);
#endif
}
```

```cpp
#include <hip/hip_runtime.h>
#include <hip/hip_cooperative_groups.h>
#include <cstdio>
#include <cstdint>
namespace cg = cooperative_groups;

#define LAS __attribute__((address_space(3)))
typedef unsigned short bf16_t;
typedef short bf16x8 __attribute__((ext_vector_type(8)));
typedef short s16x4 __attribute__((ext_vector_type(4)));
typedef float f32x4 __attribute__((ext_vector_type(4)));
typedef float f32x16 __attribute__((ext_vector_type(16)));
typedef unsigned u32x4 __attribute__((ext_vector_type(4)));
typedef unsigned u32x2 __attribute__((ext_vector_type(2)));

constexpr int Dm = 1024, NB = 4, SEQ = 4096, M = NB * SEQ, DEPTH = 4, FF = 2816, INW = 6144;
constexpr float EPS = 1e-6f;
constexpr float LOG2E = 1.4426950408889634f;

constexpr size_t W_IN = 0, W_AB = 12582912, W_O2 = 14680064, W_GU = 18874368, W_D = 30408704, WSZ = 36175872;
constexpr size_t MiB = 1048576;
constexpr size_t OFF_XB = 2 * WSZ;
constexpr size_t OFF_RSA = OFF_XB + 32 * MiB;
constexpr size_t OFF_RSB = OFF_RSA + MiB;
constexpr size_t OFF_CS = OFF_RSB + MiB;
constexpr size_t OFF_LB = OFF_CS + MiB;
constexpr size_t OFF_LAM = OFF_LB + 16384;
constexpr size_t OFF_DG = OFF_LAM + 256;
constexpr size_t OFF_EG = OFF_DG + MiB;
constexpr size_t OFF_B = OFF_EG + MiB;
constexpr size_t OFF_GATE = OFF_B;
constexpr size_t OFF_Q = OFF_B, OFF_K = OFF_B + 16 * MiB, OFF_V = OFF_B + 32 * MiB;
constexpr size_t OFF_HQ = OFF_B + 64 * MiB;
constexpr size_t OFF_HV = OFF_HQ + 16 * MiB;
constexpr size_t OFF_GF = OFF_HV + 16 * MiB;
constexpr size_t OFF_GB = OFF_GF + 32 * MiB;
constexpr size_t OFF_Y = OFF_GF;
constexpr size_t OFF_BG = OFF_GB + 32 * MiB;
constexpr size_t OFF_AO = OFF_BG + 16 * MiB;
constexpr size_t OFF_UT = OFF_AO + 32 * MiB;
constexpr size_t OFF_H = OFF_B;
constexpr size_t OFF_BAR = OFF_UT + 64 * MiB;
constexpr size_t BAR_BYTES = 16384;
constexpr size_t WS_END = OFF_BAR + BAR_BYTES;

constexpr int LDS_BYTES = 131072 + 2048;

__device__ __forceinline__ unsigned f2bf(float f) { unsigned u = __builtin_bit_cast(unsigned, f); return (u + 0x7fffu + ((u >> 16) & 1u)) >> 16; }
typedef float f32x2_t __attribute__((ext_vector_type(2)));
typedef __bf16 bf16x2_t __attribute__((ext_vector_type(2)));
__device__ __forceinline__ unsigned pk2(float lo, float hi) { f32x2_t v = {lo, hi}; bf16x2_t b = __builtin_convertvector(v, bf16x2_t); return __builtin_bit_cast(unsigned, b); }
__device__ __forceinline__ float bf2f(unsigned short b) { return __builtin_bit_cast(float, (unsigned)b << 16); }
__device__ __forceinline__ float bflo(unsigned u) { return __builtin_bit_cast(float, u << 16); }
__device__ __forceinline__ float bfhi(unsigned u) { return __builtin_bit_cast(float, u & 0xffff0000u); }
__device__ __forceinline__ float sigmoidf_(float x) { return 1.0f / (1.0f + __expf(-x)); }

namespace pg8 {
constexpr int BM = 256, BK = 64, HALF = 128, HTB = HALF * BK * 2, STAGE_BYTES = 8 * HTB, NXCD = 8, WGM = 8;
__host__ __device__ __forceinline__ int lds_byte(int r, int c) { const int st = (r >> 4) * 2 + (c >> 5), rr = r & 15, cc = c & 31, ob = rr * 64 + cc * 2; return st * 1024 + (ob ^ (((ob >> 9) & 1) << 5)); }
__host__ __device__ __forceinline__ void stage_rc(int b, int& R, int& C) { const int st = b / 1024, sb = b % 1024, swz = sb ^ (((sb >> 9) & 1) << 5); R = (st >> 1) * 16 + swz / 64; C = (st & 1) * 32 + (swz % 64) / 2; }
__host__ __device__ __forceinline__ int perm32(int rho) { const int n = rho >> 4, i = rho & 15; return 8 * (i >> 2) + 4 * n + (i & 3); }

struct Unit { int pm, pn; };
struct Gemm { const bf16_t* A; const bf16_t* Bt; int lda, ldb, K; int split_pn; int split_aoff; int mid_t; };

struct StaticOrder {
    int nM, nN, nwg, G, c;
    __device__ __forceinline__ void init(int M_, int N_, int G_, int c_) { nM = M_ / BM; nN = N_ / BM; nwg = nM * nN; G = G_; c = c_; }
    __device__ bool next(int i, Unit& u) const {
        const long L = (long)i * G + c; if (L >= nwg) return false;
        int wgid = (int)L; { const int q = nwg / NXCD, r = nwg % NXCD, xcd = wgid % NXCD, off = wgid / NXCD; wgid = (xcd < r ? xcd * (q + 1) : r * (q + 1) + (xcd - r) * q) + off; }
        const int nig = WGM * nN, gid = wgid / nig, fm = gid * WGM, gsz = (nM - fm) < WGM ? (nM - fm) : WGM;
        u.pm = fm + ((wgid % nig) % gsz); u.pn = (wgid % nig) / gsz; return true;
    }
};

template <class Epi>
__device__ __forceinline__ void gemm_phase(LAS unsigned char* lds, const Gemm g, const StaticOrder& S, const Epi& E) {
    int tid_ = threadIdx.x; asm volatile("" : "+v"(tid_));
    const int tid = tid_, wid = __builtin_amdgcn_readfirstlane(tid >> 6), lane = tid & 63, wr = wid >> 2, wc = wid & 3, fr = lane & 15, fq = lane >> 4;
    const int K = g.K, nt = K / BK;
    unsigned voffA[2], voffB[2];
#pragma unroll
    for (int i = 0; i < 2; ++i) { int R, C; stage_rc(tid * 16 + i * 8192, R, C); const int Rb = (R & ~31) + perm32(R & 31);
        voffA[i] = (unsigned)(R * g.lda + C) * 2u; voffB[i] = (unsigned)(Rb * g.ldb + C) * 2u; }
    const size_t kstep = (size_t)(BK * 2);
    const size_t hstepA = (size_t)HALF * g.lda * 2, hstepB = (size_t)HALF * g.ldb * 2;
    const size_t tstepA = 2 * hstepA, tstepB = 2 * hstepB;
    const unsigned ldsw = (unsigned)wid * 1024u;
    const int aoff = lds_byte(wr * 64 + fr, fq * 8), boff = lds_byte(wc * 32 + fr, fq * 8);
#define PG8_SA(b, h) (((b) * 2 + (h)) * HTB)
#define PG8_SB(b, h) ((4 + (b) * 2 + (h)) * HTB)
#define PG8_STAGE(bufoff, gbase, voff) do { _Pragma("unroll") for (int _i = 0; _i < 2; ++_i) \
        __builtin_amdgcn_global_load_lds((const unsigned*)((const char*)(gbase) + (voff)[_i]), (LAS unsigned*)(lds + (bufoff) + ldsw + _i * 8192), 16, 0, 0); } while (0)
#define PG8_LDA(dst, b, h) do { _Pragma("unroll") for (int m = 0; m < 4; ++m) _Pragma("unroll") for (int k = 0; k < 2; ++k) dst[m][k] = *(const LAS bf16x8*)(lds + PG8_SA(b, h) + aoff + m * 2048 + k * 1024); } while (0)
#define PG8_LDB(dst, b, h) do { _Pragma("unroll") for (int n = 0; n < 2; ++n) _Pragma("unroll") for (int k = 0; k < 2; ++k) dst[n][k] = *(const LAS bf16x8*)(lds + PG8_SB(b, h) + boff + n * 2048 + k * 1024); } while (0)
#define PG8_MMA(ai, bj, At, Bt) do { __builtin_amdgcn_s_setprio(1); _Pragma("unroll") for (int m = 0; m < 4; ++m) _Pragma("unroll") for (int n = 0; n < 2; ++n) _Pragma("unroll") for (int k = 0; k < 2; ++k) \
        acc[ai][bj][m][n] = __builtin_amdgcn_mfma_f32_16x16x32_bf16(Bt[n][k], At[m][k], acc[ai][bj][m][n], 0, 0, 0); __builtin_amdgcn_s_setprio(0); } while (0)
#define PG8_WAIT_V(n) asm volatile("s_waitcnt vmcnt(" #n ")" ::: "memory")
#define PG8_WAIT_L(n) asm volatile("s_waitcnt lgkmcnt(" #n ")" ::: "memory")
#define PG8_BAR __builtin_amdgcn_s_barrier()
#define PG8_SCHED __builtin_amdgcn_sched_barrier(0)
#define PG8_UA(u) ((const char*)g.A + (size_t)(u).pm * tstepA + (((u).pn >= g.split_pn) ? (size_t)g.split_aoff * 2 : (size_t)0))
    Unit cur, nxt; int ui = 0;
    if (!S.next(0, cur)) return;
    f32x4 acc[2][2][4][2];
#pragma unroll
    for (int a = 0; a < 2; ++a)
#pragma unroll
        for (int b = 0; b < 2; ++b)
#pragma unroll
            for (int m = 0; m < 4; ++m)
#pragma unroll
                for (int n = 0; n < 2; ++n) acc[a][b][m][n] = (f32x4){0.f, 0.f, 0.f, 0.f};
    bf16x8 At[4][2], B0[2][2], B1[2][2];
    const char* cA = PG8_UA(cur); const char* cB = (const char*)g.Bt + (size_t)cur.pn * tstepB;
    PG8_STAGE(PG8_SB(0, 0), cB, voffB); PG8_STAGE(PG8_SB(0, 1), cB + hstepB, voffB); PG8_STAGE(PG8_SA(0, 0), cA, voffA); PG8_STAGE(PG8_SA(0, 1), cA + hstepA, voffA);
    if (wr == 1) PG8_BAR;
    PG8_WAIT_V(2); PG8_BAR;
    PG8_STAGE(PG8_SB(1, 0), cB + kstep, voffB); PG8_STAGE(PG8_SA(1, 0), cA + kstep, voffA); PG8_STAGE(PG8_SB(1, 1), cB + hstepB + kstep, voffB);
    PG8_WAIT_V(6); PG8_BAR;
    for (;;) {
        const bool has_next = S.next(ui + 1, nxt);
        const char* nA = has_next ? PG8_UA(nxt) : cA; const char* nB = has_next ? (const char*)g.Bt + (size_t)nxt.pn * tstepB : cB;
        for (int t = 0; t < nt; t += 2) {
            if constexpr (Epi::HAS_MID) { if (t == g.mid_t) E.mid(acc, cur, wr, wc, fr, fq); }
            const bool last = (t == nt - 2);
            const char* a1 = cA + (size_t)(t + 1) * kstep;
            const char* a2 = last ? nA : cA + (size_t)(t + 2) * kstep; const char* b2 = last ? nB : cB + (size_t)(t + 2) * kstep;
            const char* a3 = a2 + kstep; const char* b3 = b2 + kstep;
            PG8_LDB(B0, 0, 0); PG8_LDB(B1, 0, 1); PG8_SCHED; PG8_LDA(At, 0, 0); PG8_STAGE(PG8_SA(1, 1), a1 + hstepA, voffA);
            PG8_WAIT_V(8); PG8_WAIT_L(0); PG8_BAR; PG8_MMA(0, 0, At, B0); PG8_MMA(0, 1, At, B1); PG8_BAR; PG8_SCHED;
            PG8_LDA(At, 0, 1); PG8_STAGE(PG8_SB(0, 0), b2, voffB); PG8_STAGE(PG8_SB(0, 1), b2 + hstepB, voffB); PG8_STAGE(PG8_SA(0, 0), a2, voffA);
            PG8_WAIT_V(8); PG8_WAIT_L(0); PG8_BAR; PG8_MMA(1, 0, At, B0); PG8_MMA(1, 1, At, B1); PG8_BAR; PG8_SCHED;
            PG8_LDB(B0, 1, 0); PG8_LDB(B1, 1, 1); PG8_SCHED; PG8_LDA(At, 1, 0); PG8_STAGE(PG8_SA(0, 1), a2 + hstepA, voffA);
            PG8_WAIT_V(8); PG8_WAIT_L(0); PG8_BAR; PG8_MMA(0, 0, At, B0); PG8_MMA(0, 1, At, B1); PG8_BAR; PG8_SCHED;
            PG8_LDA(At, 1, 1); PG8_STAGE(PG8_SB(1, 0), b3, voffB); PG8_STAGE(PG8_SB(1, 1), b3 + hstepB, voffB); PG8_STAGE(PG8_SA(1, 0), a3, voffA);
            PG8_WAIT_V(8); PG8_WAIT_L(0); PG8_BAR; PG8_MMA(1, 0, At, B0); PG8_MMA(1, 1, At, B1); PG8_BAR; PG8_SCHED;
        }
        if (wr == 0) PG8_BAR;
        E(acc, cur, wr, wc, fr, fq);
        if (!has_next) break;
#pragma unroll
        for (int a = 0; a < 2; ++a)
#pragma unroll
            for (int b = 0; b < 2; ++b)
#pragma unroll
                for (int m = 0; m < 4; ++m)
#pragma unroll
                    for (int n = 0; n < 2; ++n) acc[a][b][m][n] = (f32x4){0.f, 0.f, 0.f, 0.f};
        cur = nxt; cA = nA; cB = nB; ++ui;
        if (wr == 1) PG8_BAR;
    }
    PG8_WAIT_V(0);
    PG8_BAR;
#undef PG8_SA
#undef PG8_SB
#undef PG8_STAGE
#undef PG8_LDA
#undef PG8_LDB
#undef PG8_MMA
#undef PG8_UA
}
}

__device__ __forceinline__ float row_rs(const float* rsp, int row) {
    const f32x4* p = (const f32x4*)(rsp + (size_t)row * 16);
    f32x4 a = p[0], b = p[1], c = p[2], d = p[3];
    float s = ((a.x + a.y) + (a.z + a.w)) + ((b.x + b.y) + (b.z + b.w)) + ((c.x + c.y) + (c.z + c.w)) + ((d.x + d.y) + (d.z + d.w));
    return rsqrtf(s * (1.0f / Dm) + EPS);
}
__device__ __forceinline__ void rows_rs4(const float* rsp, int row0  , float (&rs)[4]) {
#pragma unroll
    for (int mp = 0; mp < 2; ++mp) {
        f32x4 p[2][4];
#pragma unroll
        for (int m = 0; m < 2; ++m) { const f32x4* q = (const f32x4*)(rsp + (size_t)(row0 + 16 * (2 * mp + m)) * 16);
#pragma unroll
            for (int i = 0; i < 4; ++i) p[m][i] = q[i]; }
#pragma unroll
        for (int m = 0; m < 2; ++m) { float t = 0.f;
#pragma unroll
            for (int i = 0; i < 4; ++i) t += (p[m][i].x + p[m][i].y) + (p[m][i].z + p[m][i].w);
            rs[2 * mp + m] = rsqrtf(t * (1.0f / Dm) + EPS); }
        __builtin_amdgcn_sched_barrier(0);
    }
}
__device__ __forceinline__ void rows_rs2(const float* rsp, int row0, float (&rs)[2]) {
    f32x4 p[2][4];
#pragma unroll
    for (int m = 0; m < 2; ++m) { const f32x4* q = (const f32x4*)(rsp + (size_t)(row0 + 16 * m) * 16);
#pragma unroll
        for (int i = 0; i < 4; ++i) p[m][i] = q[i]; }
#pragma unroll
    for (int m = 0; m < 2; ++m) { float t = 0.f;
#pragma unroll
        for (int i = 0; i < 4; ++i) t += (p[m][i].x + p[m][i].y) + (p[m][i].z + p[m][i].w);
        rs[m] = rsqrtf(t * (1.0f / Dm) + EPS); }
}
__device__ __forceinline__ u32x4 pack8(const float* v) { u32x4 w; w.x = pk2(v[0], v[1]); w.y = pk2(v[2], v[3]); w.z = pk2(v[4], v[5]); w.w = pk2(v[6], v[7]); return w; }

struct EpiMix {
    static constexpr bool HAS_MID = false;
    const float* rsp; const float* cs; const float* lbF; const float* lbB;
    bf16_t *Q, *Kk, *V, *HQ, *HV, *BG; float *GF, *GB;
    template <int GRP>
    __device__ __forceinline__ void run(const f32x4 (&acc)[2][2][4][2], const pg8::Unit& u, int wr, int wc, int fr, int fq) const {
#pragma unroll
        for (int ai = 0; ai < 2; ++ai)
#pragma unroll
        for (int mp = 0; mp < 2; ++mp) {
            const int row0 = u.pm * 256 + ai * 128 + wr * 64 + mp * 32 + fr;
            float rs4[2]; rows_rs2(rsp, row0, rs4);
            const int d0r = (wc * 32 + fq * 8) & 63;
            f32x4 c4r[2], s4r[2];
            if constexpr (GRP <= 1) {
                if (d0r < 16) {
#pragma unroll
                    for (int mm = 0; mm < 2; ++mm) { const float* cp = cs + (size_t)(row0 + 16 * mm) * 16 + (d0r >> 3) * 4; c4r[mm] = *(const f32x4*)cp; s4r[mm] = *(const f32x4*)(cp + 8); }
                }
            }
            __builtin_amdgcn_sched_barrier(0);
#pragma unroll
            for (int mm = 0; mm < 2; ++mm) {
                const int m = 2 * mp + mm;
                const int row = row0 + mm * 16;
                const float rs = rs4[mm];
                const int b = row >> 12, s = row & 4095;
#pragma unroll
                for (int bj = 0; bj < 2; ++bj) {
                    const int col = u.pn * 256 + bj * 128 + wc * 32 + fq * 8;
                    const int jj = col & 511;
                    float v[8];
#pragma unroll
                    for (int e = 0; e < 4; ++e) { v[e] = acc[ai][bj][m][0][e] * rs; v[4 + e] = acc[ai][bj][m][1][e] * rs; }
                    if constexpr (GRP <= 1) {
                        const int d0 = jj & 63;
                        if (d0 < 16) {
                            const f32x4 c4 = c4r[mm], s4 = s4r[mm];
#pragma unroll
                            for (int e = 0; e < 4; ++e) { const float t1 = v[e], t2 = v[4 + e]; v[e] = t1 * c4[e] - t2 * s4[e]; v[4 + e] = t2 * c4[e] + t1 * s4[e]; }
                        }
                        if constexpr (GRP == 0) {
#pragma unroll
                            for (int e = 0; e < 8; ++e) v[e] *= 0.125f * LOG2E;
                        }
                        const int h = jj >> 7, c = (jj >> 6) & 1;
                        bf16_t* dst = (GRP == 0 ? Q : Kk) + ((size_t)(((b * 4 + h) * 2 + c) * SEQ + s)) * 64 + d0;
                        *(u32x4*)dst = pack8(v);
                    } else if constexpr (GRP == 2) {
                        const int h = jj >> 7, d0 = jj & 127;
                        *(u32x4*)(V + ((size_t)((b * 4 + h) * SEQ + s)) * 128 + d0) = pack8(v);
                    } else if constexpr (GRP == 3) {
                        *(u32x4*)(HQ + (size_t)row * 512 + jj) = pack8(v);
                    } else if constexpr (GRP == 4 || GRP == 5) {
                        const float* lbp = (GRP == 4 ? lbF : lbB) + jj;
                        const f32x4 l0 = *(const f32x4*)lbp, l1 = *(const f32x4*)(lbp + 4);
                        float gl[8];
#pragma unroll
                        for (int e = 0; e < 8; ++e) { const float lb = e < 4 ? l0[e] : l1[e - 4]; const float f = lb + (1.0f - lb) * sigmoidf_(v[e]); gl[e] = __logf(fmaxf(f, 1e-37f)); }
                        float* dst = (GRP == 4 ? GF : GB) + (size_t)row * 512 + jj;
                        *(f32x4*)dst = (f32x4){gl[0], gl[1], gl[2], gl[3]}; *(f32x4*)(dst + 4) = (f32x4){gl[4], gl[5], gl[6], gl[7]};
                    } else if constexpr (GRP == 6) {
                        *(u32x4*)(HV + (size_t)row * 512 + jj) = pack8(v);
                    } else {
#pragma unroll
                        for (int e = 0; e < 8; ++e) v[e] = sigmoidf_(v[e]);
                        *(u32x4*)(BG + (size_t)row * 512 + jj) = pack8(v);
                    }
                }
            }
            __builtin_amdgcn_sched_barrier(0);
        }
    }
    __device__ __forceinline__ void operator()(const f32x4 (&acc)[2][2][4][2], const pg8::Unit& u, int wr, int wc, int fr, int fq) const {
        switch (u.pn >> 1) {
            case 0: run<0>(acc, u, wr, wc, fr, fq); break;
            case 1: run<1>(acc, u, wr, wc, fr, fq); break;
            case 2: run<2>(acc, u, wr, wc, fr, fq); break;
            case 3: run<3>(acc, u, wr, wc, fr, fq); break;
            case 4: run<4>(acc, u, wr, wc, fr, fq); break;
            case 5: run<5>(acc, u, wr, wc, fr, fq); break;
            case 6: run<6>(acc, u, wr, wc, fr, fq); break;
            default: run<7>(acc, u, wr, wc, fr, fq); break;
        }
    }
};

struct EpiGate {
    static constexpr bool HAS_MID = false;
    const float* rsp; bf16_t* G;
    __device__ __forceinline__ void operator()(const f32x4 (&acc)[2][2][4][2], const pg8::Unit& u, int wr, int wc, int fr, int fq) const {
#pragma unroll
        for (int ai = 0; ai < 2; ++ai) {
            const int row0 = u.pm * 256 + ai * 128 + wr * 64 + fr;
            float rs4[4]; rows_rs4(rsp, row0, rs4);
            __builtin_amdgcn_sched_barrier(0);
#pragma unroll
            for (int m = 0; m < 4; ++m) {
                const int row = row0 + m * 16;
                const float rs = rs4[m];
                const int col = u.pn * 128 + wc * 32 + fq * 8;
                float r[8], sb[8];
#pragma unroll
                for (int n = 0; n < 2; ++n)
#pragma unroll
                    for (int e = 0; e < 4; ++e) {
                        const float ea = __expf(fminf(-acc[ai][0][m][n][e] * rs, 60.f)), eb = __expf(fminf(-acc[ai][1][m][n][e] * rs, 60.f));
                        sb[n * 4 + e] = 1.0f / (1.0f + eb); r[n * 4 + e] = (1.0f + eb) / (1.0f + ea);
                    }
                *(u32x4*)(G + (size_t)row * 2048 + col) = pack8(r);
                *(u32x4*)(G + (size_t)row * 2048 + 1024 + col) = pack8(sb);
            }
            __builtin_amdgcn_sched_barrier(0);
        }
    }
};

struct EpiY {
    static constexpr bool HAS_MID = true;
    const bf16_t* G; bf16_t* Y;
    __device__ __forceinline__ void mid(f32x4 (&acc)[2][2][4][2], const pg8::Unit& u, int wr, int wc, int fr, int fq) const {
        int fr_ = fr; asm volatile("" : "+v"(fr_));
#pragma unroll
        for (int ai = 0; ai < 2; ++ai) {
            __builtin_amdgcn_sched_barrier(0);
#pragma unroll
            for (int m = 0; m < 4; ++m) {
                const int row = u.pm * 256 + ai * 128 + wr * 64 + m * 16 + fr_;
#pragma unroll
                for (int bj = 0; bj < 2; ++bj) {
                    const int col = u.pn * 256 + bj * 128 + wc * 32 + fq * 8;
                    const u32x4 gq = *(const u32x4*)(G + (size_t)row * 2048 + col);
                    acc[ai][bj][m][0][0] *= bflo(gq.x); acc[ai][bj][m][0][1] *= bfhi(gq.x); acc[ai][bj][m][0][2] *= bflo(gq.y); acc[ai][bj][m][0][3] *= bfhi(gq.y);
                    acc[ai][bj][m][1][0] *= bflo(gq.z); acc[ai][bj][m][1][1] *= bfhi(gq.z); acc[ai][bj][m][1][2] *= bflo(gq.w); acc[ai][bj][m][1][3] *= bfhi(gq.w);
                }
            }
        }
        __builtin_amdgcn_sched_barrier(0);
    }
    __device__ __forceinline__ void operator()(const f32x4 (&acc)[2][2][4][2], const pg8::Unit& u, int wr, int wc, int fr, int fq) const {
#pragma unroll
        for (int ai = 0; ai < 2; ++ai) {
            u32x4 gqr[4][2];
#pragma unroll
            for (int m = 0; m < 4; ++m)
#pragma unroll
                for (int bj = 0; bj < 2; ++bj) gqr[m][bj] = *(const u32x4*)(G + (size_t)(u.pm * 256 + ai * 128 + wr * 64 + m * 16 + fr) * 2048 + 1024 + u.pn * 256 + bj * 128 + wc * 32 + fq * 8);
            __builtin_amdgcn_sched_barrier(0);
#pragma unroll
            for (int m = 0; m < 4; ++m) {
                const int row = u.pm * 256 + ai * 128 + wr * 64 + m * 16 + fr;
#pragma unroll
                for (int bj = 0; bj < 2; ++bj) {
                    const int col = u.pn * 256 + bj * 128 + wc * 32 + fq * 8;
                    const u32x4 gq = gqr[m][bj];
                    float v[8];
                    v[0] = acc[ai][bj][m][0][0] * bflo(gq.x); v[1] = acc[ai][bj][m][0][1] * bfhi(gq.x);
                    v[2] = acc[ai][bj][m][0][2] * bflo(gq.y); v[3] = acc[ai][bj][m][0][3] * bfhi(gq.y);
                    v[4] = acc[ai][bj][m][1][0] * bflo(gq.z); v[5] = acc[ai][bj][m][1][1] * bfhi(gq.z);
                    v[6] = acc[ai][bj][m][1][2] * bflo(gq.w); v[7] = acc[ai][bj][m][1][3] * bfhi(gq.w);
                    *(u32x4*)(Y + (size_t)row * 1024 + col) = pack8(v);
                }
            }
            __builtin_amdgcn_sched_barrier(0);
        }
    }
};

struct EpiRes {
    static constexpr bool HAS_MID = false;
    const float* xres; float* xout; bf16_t* XB; float* rsp;
    __device__ __forceinline__ void operator()(const f32x4 (&acc)[2][2][4][2], const pg8::Unit& u, int wr, int wc, int fr, int fq) const {
#pragma unroll
        for (int ai = 0; ai < 2; ++ai)
#pragma unroll
        for (int mp = 0; mp < 2; ++mp) {
            f32x4 xr0[2][2], xr1[2][2];
#pragma unroll
            for (int mm = 0; mm < 2; ++mm)
#pragma unroll
                for (int bj = 0; bj < 2; ++bj) { const float* xr = xres + (size_t)(u.pm * 256 + ai * 128 + wr * 64 + (2 * mp + mm) * 16 + fr) * Dm + u.pn * 256 + bj * 128 + wc * 32 + fq * 8;
                    xr0[mm][bj] = *(const f32x4*)xr; xr1[mm][bj] = *(const f32x4*)(xr + 4); }
            __builtin_amdgcn_sched_barrier(0);
#pragma unroll
            for (int mm = 0; mm < 2; ++mm) {
                const int m = 2 * mp + mm;
                const int row = u.pm * 256 + ai * 128 + wr * 64 + m * 16 + fr;
                float ss = 0.f;
#pragma unroll
                for (int bj = 0; bj < 2; ++bj) {
                    const int col = u.pn * 256 + bj * 128 + wc * 32 + fq * 8;
                    const f32x4 x0 = xr0[mm][bj], x1 = xr1[mm][bj];
                    float v[8];
#pragma unroll
                    for (int e = 0; e < 4; ++e) { v[e] = x0[e] + acc[ai][bj][m][0][e]; v[4 + e] = x1[e] + acc[ai][bj][m][1][e]; }
#pragma unroll
                    for (int e = 0; e < 8; ++e) ss += v[e] * v[e];
                    float* xo = xout + (size_t)row * Dm + col;
                    *(f32x4*)xo = (f32x4){v[0], v[1], v[2], v[3]}; *(f32x4*)(xo + 4) = (f32x4){v[4], v[5], v[6], v[7]};
                    *(u32x4*)(XB + (size_t)row * Dm + col) = pack8(v);
                }
                ss += __shfl_xor(ss, 16); ss += __shfl_xor(ss, 32);
                if (fq == 0) rsp[(size_t)row * 16 + u.pn * 4 + wc] = ss;
            }
            __builtin_amdgcn_sched_barrier(0);
        }
    }
};

struct EpiGU {
    static constexpr bool HAS_MID = false;
    const float* rsp; bf16_t* H;
    __device__ __forceinline__ void operator()(const f32x4 (&acc)[2][2][4][2], const pg8::Unit& u, int wr, int wc, int fr, int fq) const {
#pragma unroll
        for (int ai = 0; ai < 2; ++ai) {
            const int row0 = u.pm * 256 + ai * 128 + wr * 64 + fr;
            float rs4[4]; rows_rs4(rsp, row0, rs4);
            __builtin_amdgcn_sched_barrier(0);
#pragma unroll
            for (int m = 0; m < 4; ++m) {
                const int row = row0 + m * 16;
                const float rs = rs4[m];
                const int col = u.pn * 128 + wc * 32 + fq * 8;
                float v[8];
#pragma unroll
                for (int n = 0; n < 2; ++n)
#pragma unroll
                    for (int e = 0; e < 4; ++e) { const float gg = acc[ai][0][m][n][e] * rs, uu = acc[ai][1][m][n][e] * rs; v[n * 4 + e] = gg * sigmoidf_(gg) * uu; }
                *(u32x4*)(H + (size_t)row * FF + col) = pack8(v);
            }
            __builtin_amdgcn_sched_barrier(0);
        }
    }
};

__device__ __forceinline__ int rope_perm(int n) {
    const int d = n & 63; if (d >= 16) return n;
    const int g = d >> 3, e = d & 7; return (n & ~63) + ((e < 4) ? 4 * g + e : 8 + 4 * g + (e - 4));
}
__device__ __forceinline__ void conv_item(const float* src, int ld_src, int ks0, int c0  , int mode  ,
                                          const float* gain, bf16_t* dst, int ld_dst, int n0, int kd0, LAS float* scr, int lane) {
    const int n4 = lane & 7, kr = lane >> 3;
    int sc = c0 + 4 * n4;
    if (mode) { const int q = (sc & 63) >> 2; if (q == 1) sc += 4; else if (q == 2) sc -= 4; }
#pragma unroll
    for (int i = 0; i < 8; ++i) { const int kk = kr + 8 * i; f32x4 w = *(const f32x4*)(src + (size_t)(ks0 + kk) * ld_src + sc);
        if (gain) { const float gg = gain[ks0 + kk]; w.x *= gg; w.y *= gg; w.z *= gg; w.w *= gg; }
        LAS float* d = scr + kk * 33 + 4 * n4; d[0] = w.x; d[1] = w.y; d[2] = w.z; d[3] = w.w; }
    asm volatile("s_waitcnt lgkmcnt(0)" ::: "memory");
    const int c = lane & 7;
#pragma unroll
    for (int j = 0; j < 4; ++j) { const int n = (lane >> 3) + 8 * j; const LAS float* s = scr + (8 * c) * 33 + n;
        u32x4 o; o.x = pk2(s[0 * 33], s[1 * 33]); o.y = pk2(s[2 * 33], s[3 * 33]); o.z = pk2(s[4 * 33], s[5 * 33]); o.w = pk2(s[6 * 33], s[7 * 33]);
        *(u32x4*)(dst + (size_t)(n0 + n) * ld_dst + kd0 + 8 * c) = o; }
    asm volatile("s_waitcnt lgkmcnt(0)" ::: "memory");
}

struct Ptrs {
    const float *x; const int* pos; const float *w_in, *da_lambda, *da_norm, *hg_lb, *hg_norm, *w_a, *w_b, *w_o, *attn_norm, *ffn_norm, *w_gate, *w_up, *w_down, *final_norm;
    float* out; unsigned char* ws; int ph_lo, ph_hi;
};

__device__ __forceinline__ void convert_layer(const Ptrs& P, int layer, unsigned char* wbuf, LAS unsigned char* lds, int gw, int ngw, int wave, int lane) {
    LAS float* scr = (LAS float*)(lds + wave * 8704);
    constexpr int I_IN = 16 * 192, I_A = 8 * 32, I_B = 8 * 32, I_O = 16 * 32, I_GU = 16 * 176, I_D = 44 * 32;
    constexpr int NIT = I_IN + I_A + I_B + I_O + I_GU + I_D;
    for (int it = gw; it < NIT; it += ngw) {
        int r = it;
        if (r < I_IN) { const int kb = r / 192, nb = r % 192, n0 = nb * 32;
            int c0 = n0; if (n0 >= 4096) { const int q = n0 - 4096, tile = q >> 8, rr = q & 255; c0 = (rr < 128 ? 4096 : 5120) + tile * 128 + (rr & 127); }
            conv_item(P.w_in + (size_t)layer * Dm * INW, INW, kb * 64, c0, n0 < 1024 ? 1 : 0, P.attn_norm + layer * Dm, (bf16_t*)(wbuf + W_IN), Dm, n0, kb * 64, scr, lane); continue; }
        r -= I_IN;
        if (r < I_A) { const int kb = r / 32, nb = r % 32;
            conv_item(P.w_a + (size_t)layer * 512 * Dm, Dm, kb * 64, nb * 32, 0, nullptr, (bf16_t*)(wbuf + W_AB), 1024, nb * 32, kb * 64, scr, lane); continue; }
        r -= I_A;
        if (r < I_B) { const int kb = r / 32, nb = r % 32;
            conv_item(P.w_b + (size_t)layer * 512 * Dm, Dm, kb * 64, nb * 32, 0, nullptr, (bf16_t*)(wbuf + W_AB), 1024, nb * 32, 512 + kb * 64, scr, lane); continue; }
        r -= I_B;
        if (r < I_O) { const int kb = r / 32, nb = r % 32;
            conv_item(P.w_o + (size_t)layer * Dm * Dm, Dm, kb * 64, nb * 32, 0, nullptr, (bf16_t*)(wbuf + W_O2), Dm, nb * 32, kb * 64, scr, lane); continue; }
        r -= I_O;
        if (r < I_GU) { const int kb = r / 176, nb = r % 176, n0 = nb * 32, tile = n0 >> 8, rr = n0 & 255;
            const float* srcm = (rr < 128 ? P.w_gate : P.w_up) + (size_t)layer * Dm * FF;
            conv_item(srcm, FF, kb * 64, tile * 128 + (rr & 127), 0, P.ffn_norm + layer * Dm, (bf16_t*)(wbuf + W_GU), Dm, n0, kb * 64, scr, lane); continue; }
        r -= I_GU;
        { const int kb = r / 32, nb = r % 32;
            conv_item(P.w_down + (size_t)layer * FF * Dm, Dm, kb * 64, nb * 32, 0, nullptr, (bf16_t*)(wbuf + W_D), FF, nb * 32, kb * 64, scr, lane); }
    }
}

__device__ __forceinline__ float wave_sum(float v) {
#pragma unroll
    for (int o = 1; o < 64; o <<= 1) v += __shfl_xor(v, o);
    return v;
}
__device__ __forceinline__ void prologue(const Ptrs& P, LAS unsigned char* lds, int gw, int ngw, int wave, int lane) {
    unsigned char* ws = P.ws;
    bf16_t* XB = (bf16_t*)(ws + OFF_XB); float* rsb = (float*)(ws + OFF_RSB);
    for (int r = gw; r < M; r += ngw) {
        const f32x4* xr = (const f32x4*)(P.x + (size_t)r * Dm) + lane;
        float ss = 0.f;
#pragma unroll
        for (int j = 0; j < 4; ++j) { const f32x4 v = xr[64 * j]; ss += (v.x * v.x + v.y * v.y) + (v.z * v.z + v.w * v.w);
            u32x2 o; o.x = pk2(v.x, v.y); o.y = pk2(v.z, v.w); *((u32x2*)(XB + (size_t)r * Dm) + lane + 64 * j) = o; }
        ss = wave_sum(ss);
        if (lane < 16) rsb[(size_t)r * 16 + lane] = (lane == 0) ? ss : 0.f;
    }
    const int gt = gw * 64 + lane, ngt = ngw * 64;
    float* cs = (float*)(ws + OFF_CS);
    for (int i = gt; i < M * 8; i += ngt) {
        const int tok = i >> 3, f = i & 7;
        const double invf[8] = {1.0, 0.19392274474868576, 0.03760603093086393, 0.007292664737217109, 0.001414213562373095, 0.0002742481756762073, 5.318295896944988e-05, 1.031338537721246e-05};
        double fr;
        switch (f) { case 0: fr = invf[0]; break; case 1: fr = invf[1]; break; case 2: fr = invf[2]; break; case 3: fr = invf[3]; break; case 4: fr = invf[4]; break; case 5: fr = invf[5]; break; case 6: fr = invf[6]; break; default: fr = invf[7]; }
        const float ang32 = (float)P.pos[tok] * (float)fr;
        const double ang = (double)ang32;
        const double rev = ang * 0.15915494309189535;
        const double fracrev = rev - __builtin_floor(rev + 0.5);
        const float a = (float)(fracrev * 6.283185307179586);
        cs[(size_t)tok * 16 + f] = __cosf(a); cs[(size_t)tok * 16 + 8 + f] = __sinf(a);
    }
    float* LB = (float*)(ws + OFF_LB);
    for (int i = gt; i < 2 * 512; i += ngt) {
        const int d = i >> 9, k = i & 511;
        float l[4], mx = -1e30f;
#pragma unroll
        for (int j = 0; j < 4; ++j) { l[j] = P.hg_lb[(size_t)(d * 4 + j) * 512 + k]; mx = fmaxf(mx, l[j]); }
        float e[4], sum = 0.f;
#pragma unroll
        for (int j = 0; j < 4; ++j) { e[j] = __expf(l[j] - mx); sum += e[j]; }
        float cum = 0.f;
#pragma unroll
        for (int j = 0; j < 4; ++j) { if (j > 0) cum += e[j] / sum; LB[(size_t)(d * 4 + j) * 512 + k] = cum; }
    }
    if (gw == 0) {
        float* LAM = (float*)(ws + OFF_LAM);
        for (int l = 0; l < 4; ++l) {
            const float* p = P.da_lambda + l * 256;
            float a = wave_sum(p[lane] * p[64 + lane]), b = wave_sum(p[128 + lane] * p[192 + lane]);
            const float lam_init = 0.8f - 0.6f * __expf(-0.3f * (float)l);
            if (lane == 0) LAM[l] = __expf(a) - __expf(b) + lam_init;
        }
    }
}

constexpr int AT_KROW = 144, AT_VROW = 320, AT_K1 = 64 * AT_KROW, AT_V = 2 * AT_K1, AT_STG = AT_V + 64 * AT_VROW;
constexpr int AT_IMG_ROW = 132;
__device__ __forceinline__ s16x4 tr_read(const LAS unsigned char* p) { return __builtin_bit_cast(s16x4, __builtin_amdgcn_ds_read_tr16_b64_v4i16((LAS s16x4*)p)); }

__device__ __forceinline__ void attn_unit(int b, int h, int qb, const bf16_t* Q, const bf16_t* Kk, const bf16_t* V, bf16_t* AO, const float* gainA  , float one_minus_lam_init, float lam, LAS unsigned char* lds) {
    int tid_ = threadIdx.x; asm volatile("" : "+v"(tid_));
    const int tid = tid_, wave = __builtin_amdgcn_readfirstlane(tid >> 6), lane = tid & 63, c = wave >> 2, wq = wave & 3, r32 = lane & 31, hh = lane >> 5;
    const int q0 = qb * 128 + wq * 32;
    bf16x8 qf[4];
    { const bf16_t* Qp = Q + ((size_t)(((b * 4 + h) * 2 + c) * SEQ + q0 + r32)) * 64 + 8 * hh;
#pragma unroll
      for (int s = 0; s < 4; ++s) qf[s] = *(const bf16x8*)(Qp + 16 * s); }
    f32x16 o[4];
#pragma unroll
    for (int i = 0; i < 4; ++i)
#pragma unroll
        for (int e = 0; e < 16; ++e) o[i][e] = 0.f;
    float mrow = -1e30f, lrow = 0.f;
    const unsigned char* Kg0 = (const unsigned char*)(Kk + ((size_t)((b * 4 + h) * 2 + 0) * SEQ) * 64);
    const unsigned char* Kg1 = (const unsigned char*)(Kk + ((size_t)((b * 4 + h) * 2 + 1) * SEQ) * 64);
    const unsigned char* Vg = (const unsigned char*)(V + ((size_t)(b * 4 + h) * SEQ) * 128);
    const int lk = (tid >> 3) * AT_KROW + (tid & 7) * 16;
    const int lv0 = AT_V + (tid >> 4) * AT_VROW + (tid & 15) * 16, lv1 = lv0 + 32 * AT_VROW;
    u32x4 r0, r1, r2, r3;
    r0 = *(const u32x4*)(Kg0 + tid * 16); r1 = *(const u32x4*)(Kg1 + tid * 16); r2 = *(const u32x4*)(Vg + tid * 16); r3 = *(const u32x4*)(Vg + 8192 + tid * 16);
    *(LAS u32x4*)(lds + lk) = r0; *(LAS u32x4*)(lds + AT_K1 + lk) = r1; *(LAS u32x4*)(lds + lv0) = r2; *(LAS u32x4*)(lds + lv1) = r3;
    r0 = *(const u32x4*)(Kg0 + 8192 + tid * 16); r1 = *(const u32x4*)(Kg1 + 8192 + tid * 16);
    *(LAS u32x4*)(lds + AT_STG + lk) = r0; *(LAS u32x4*)(lds + AT_STG + AT_K1 + lk) = r1;
    __syncthreads();
    const int ka = c * AT_K1 + r32 * AT_KROW + hh * 16;
    const int va = AT_V + (4 * hh + ((lane & 15) >> 2)) * AT_VROW + ((lane >> 4) & 1) * 32 + (lane & 3) * 8;

#define AT_QK(sv, st) do { f32x16 t0_, t1_; _Pragma("unroll") for (int e = 0; e < 16; ++e) { t0_[e] = 0.f; t1_[e] = 0.f; } \
        _Pragma("unroll") for (int ks = 0; ks < 4; ++ks) { \
            const bf16x8 a0 = *(const LAS bf16x8*)(lds + (st) + ka + ks * 32), a1 = *(const LAS bf16x8*)(lds + (st) + ka + 32 * AT_KROW + ks * 32); \
            t0_ = __builtin_amdgcn_mfma_f32_32x32x16_bf16(a0, qf[ks], t0_, 0, 0, 0); t1_ = __builtin_amdgcn_mfma_f32_32x32x16_bf16(a1, qf[ks], t1_, 0, 0, 0); } \
        sv##0 = t0_; sv##1 = t1_; } while (0)
    f32x16 sA0, sA1, sB0, sB1;
    AT_QK(sA, 0);
#define AT_VFRAG(dst, STC, g) do { const LAS unsigned char* vb_ = lds + (STC) + va + (16 * (g)) * AT_VROW; \
        _Pragma("unroll") for (int vt = 0; vt < 4; ++vt) { const s16x4 t0 = tr_read(vb_ + vt * 64), t1 = tr_read(vb_ + vt * 64 + 8 * AT_VROW); \
            dst[vt] = (bf16x8){t0[0], t0[1], t0[2], t0[3], t1[0], t1[1], t1[2], t1[3]}; } } while (0)
#define AT_PV(vf, p) do { __builtin_amdgcn_s_setprio(1); _Pragma("unroll") for (int vt = 0; vt < 4; ++vt) o[vt] = __builtin_amdgcn_mfma_f32_32x32x16_bf16(vf[vt], p, o[vt], 0, 0, 0); __builtin_amdgcn_s_setprio(0); } while (0)
#define AT_SB __builtin_amdgcn_sched_barrier(0)
#define AT_TILE(j, s0, s1, sn, STC  , STN  ) do { \
        if ((j) + 2 < 64) { const size_t go = (size_t)((j) + 2) * 8192; r0 = *(const u32x4*)(Kg0 + go + tid * 16); r1 = *(const u32x4*)(Kg1 + go + tid * 16); } \
        if ((j) + 1 < 64) { const size_t go = (size_t)((j) + 1) * 16384; r2 = *(const u32x4*)(Vg + go + tid * 16); r3 = *(const u32x4*)(Vg + go + 8192 + tid * 16); } \
        bf16x8 kf[4], kg[4], vA[4]; \
        if ((j) + 1 < 64) { _Pragma("unroll") for (int ks = 0; ks < 2; ++ks) { kf[2 * ks] = *(const LAS bf16x8*)(lds + (STN) + ka + ks * 32); kf[2 * ks + 1] = *(const LAS bf16x8*)(lds + (STN) + ka + 32 * AT_KROW + ks * 32); } } \
        AT_SB; \
        float mx = fmaxf(s0[0], s1[0]); \
        _Pragma("unroll") for (int e = 1; e < 16; ++e) mx = fmaxf(mx, fmaxf(s0[e], s1[e])); \
        mx = fmaxf(mx, __shfl_xor(mx, 32)); \
        if (__builtin_amdgcn_ballot_w64(mx > mrow + 8.0f) != 0ull) { \
            const float mnew = fmaxf(mrow, mx), alpha = __builtin_amdgcn_exp2f(mrow - mnew); mrow = mnew; lrow *= alpha; \
            _Pragma("unroll") for (int i = 0; i < 4; ++i) _Pragma("unroll") for (int e = 0; e < 16; ++e) o[i][e] *= alpha; } \
        AT_SB; \
        if ((j) + 1 < 64) { f32x16 t0_, t1_; _Pragma("unroll") for (int e = 0; e < 16; ++e) { t0_[e] = 0.f; t1_[e] = 0.f; } \
            __builtin_amdgcn_s_setprio(1); \
            _Pragma("unroll") for (int ks = 0; ks < 2; ++ks) { t0_ = __builtin_amdgcn_mfma_f32_32x32x16_bf16(kf[2 * ks], qf[ks], t0_, 0, 0, 0); t1_ = __builtin_amdgcn_mfma_f32_32x32x16_bf16(kf[2 * ks + 1], qf[ks], t1_, 0, 0, 0); } \
            AT_SB; \
            _Pragma("unroll") for (int ks = 0; ks < 2; ++ks) { kg[2 * ks] = *(const LAS bf16x8*)(lds + (STN) + ka + (ks + 2) * 32); kg[2 * ks + 1] = *(const LAS bf16x8*)(lds + (STN) + ka + 32 * AT_KROW + (ks + 2) * 32); } \
            AT_SB; \
            _Pragma("unroll") for (int ks = 0; ks < 2; ++ks) { t0_ = __builtin_amdgcn_mfma_f32_32x32x16_bf16(kg[2 * ks], qf[ks + 2], t0_, 0, 0, 0); t1_ = __builtin_amdgcn_mfma_f32_32x32x16_bf16(kg[2 * ks + 1], qf[ks + 2], t1_, 0, 0, 0); } \
            __builtin_amdgcn_s_setprio(0); sn##0 = t0_; sn##1 = t1_; } \
        AT_VFRAG(vA, STC, 0); \
        AT_SB; \
        float ls = 0.f; \
        _Pragma("unroll") for (int e = 0; e < 16; ++e) { s0[e] = __builtin_amdgcn_exp2f(s0[e] - mrow); s1[e] = __builtin_amdgcn_exp2f(s1[e] - mrow); ls += s0[e] + s1[e]; } \
        lrow += ls; \
        bf16x8 pf[2][2]; \
        _Pragma("unroll") for (int s = 0; s < 2; ++s) { u32x4 w0, w1; \
            w0.x = pk2(s0[8 * s + 0], s0[8 * s + 1]); w0.y = pk2(s0[8 * s + 2], s0[8 * s + 3]); w0.z = pk2(s0[8 * s + 4], s0[8 * s + 5]); w0.w = pk2(s0[8 * s + 6], s0[8 * s + 7]); \
            w1.x = pk2(s1[8 * s + 0], s1[8 * s + 1]); w1.y = pk2(s1[8 * s + 2], s1[8 * s + 3]); w1.z = pk2(s1[8 * s + 4], s1[8 * s + 5]); w1.w = pk2(s1[8 * s + 6], s1[8 * s + 7]); \
            pf[0][s] = __builtin_bit_cast(bf16x8, w0); pf[1][s] = __builtin_bit_cast(bf16x8, w1); } \
        AT_SB; \
        AT_PV(vA, pf[0][0]); \
        AT_SB; \
        AT_VFRAG(vA, STC, 1); \
        AT_SB; \
        AT_PV(vA, pf[0][1]); \
        AT_SB; \
          \
        if ((j) + 2 < 64) { *(LAS u32x4*)(lds + (STC) + lk) = r0; *(LAS u32x4*)(lds + (STC) + AT_K1 + lk) = r1; } \
        if ((j) + 1 < 64) { *(LAS u32x4*)(lds + (STN) + lv0) = r2; *(LAS u32x4*)(lds + (STN) + lv1) = r3; } \
        AT_SB; \
        AT_VFRAG(vA, STC, 2); \
        AT_SB; \
        AT_PV(vA, pf[1][0]); \
        AT_SB; \
        AT_VFRAG(vA, STC, 3); \
        AT_SB; \
        AT_PV(vA, pf[1][1]); \
        __syncthreads(); } while (0)
    for (int j = 0; j < 64; j += 2) {
        AT_TILE(j, sA0, sA1, sB, 0, AT_STG);
        AT_TILE(j + 1, sB0, sB1, sA, AT_STG, 0);
    }
#undef AT_TILE
#undef AT_QK
#undef AT_VFRAG
#undef AT_PV
#undef AT_SB
    const float inv = 1.0f / (lrow + __shfl_xor(lrow, 32));
    LAS float* img = (LAS float*)lds;
    const int qrow = wq * 32 + r32;
    if (c == 1) {
        const float sc = -lam * inv;
#pragma unroll
        for (int vt = 0; vt < 4; ++vt)
#pragma unroll
            for (int g = 0; g < 4; ++g)
                *(LAS f32x4*)(img + qrow * AT_IMG_ROW + 32 * vt + 8 * g + 4 * hh) = (f32x4){o[vt][4 * g] * sc, o[vt][4 * g + 1] * sc, o[vt][4 * g + 2] * sc, o[vt][4 * g + 3] * sc};
    }
    __syncthreads();
    if (c == 0) {
#pragma unroll
        for (int vt = 0; vt < 4; ++vt)
#pragma unroll
            for (int g = 0; g < 4; ++g) {
                LAS f32x4* p = (LAS f32x4*)(img + qrow * AT_IMG_ROW + 32 * vt + 8 * g + 4 * hh);
                f32x4 t = *p;
                t.x += o[vt][4 * g] * inv; t.y += o[vt][4 * g + 1] * inv; t.z += o[vt][4 * g + 2] * inv; t.w += o[vt][4 * g + 3] * inv;
                *p = t;
            }
    }
    __syncthreads();
    {
        const int q = tid >> 2, part = tid & 3;
        float v[32]; float ss = 0.f;
#pragma unroll
        for (int i = 0; i < 8; ++i) { const f32x4 t = *(const LAS f32x4*)(img + q * AT_IMG_ROW + 32 * part + 4 * i); v[4 * i] = t.x; v[4 * i + 1] = t.y; v[4 * i + 2] = t.z; v[4 * i + 3] = t.w;
            ss += (t.x * t.x + t.y * t.y) + (t.z * t.z + t.w * t.w); }
        ss += __shfl_xor(ss, 1); ss += __shfl_xor(ss, 2);
        const float rs = rsqrtf(ss * (1.0f / 128.0f) + EPS) * one_minus_lam_init;
        const float* gp = gainA + h * 128 + 32 * part;
        bf16_t* dst = AO + ((size_t)(b * SEQ + qb * 128 + q)) * 1024 + h * 128 + 32 * part;
#pragma unroll
        for (int i = 0; i < 4; ++i) {
            const f32x4 g0 = *(const f32x4*)(gp + 8 * i), g1 = *(const f32x4*)(gp + 8 * i + 4);
            u32x4 w; w.x = pk2(v[8 * i] * rs * g0.x, v[8 * i + 1] * rs * g0.y); w.y = pk2(v[8 * i + 2] * rs * g0.z, v[8 * i + 3] * rs * g0.w);
            w.z = pk2(v[8 * i + 4] * rs * g1.x, v[8 * i + 5] * rs * g1.y); w.w = pk2(v[8 * i + 6] * rs * g1.z, v[8 * i + 7] * rs * g1.w);
            *(u32x4*)(dst + 8 * i) = w;
        }
    }
    __syncthreads();
}

constexpr int HG_SEG = 0;
constexpr int HG_F = 2048;
constexpr int HG_PART = 2560;
constexpr int HG_V = 4096;
constexpr int HG_VROW = 288;
constexpr int HG_A = HG_V + 64 * HG_VROW;
constexpr int HG_KTROW = 144, HG_QKROW = 272;
constexpr int HG_Bq = HG_A + 128 * HG_KTROW;

__device__ __forceinline__ void hg_cumsum(const float (&gv)[16], int dir, int k, int j, LAS unsigned char* lds, float (&d)[16], float& m_out, float& tot_out) {
    float run = 0.f;
    if (dir == 0) {
#pragma unroll
        for (int i = 0; i < 16; ++i) { run += gv[i]; d[i] = run; }
    } else {
#pragma unroll
        for (int i = 15; i >= 0; --i) { run += gv[i]; d[i] = run; }
    }
    LAS float* seg = (LAS float*)(lds + HG_SEG);
    seg[j * 128 + k] = run;
    __syncthreads();
    const float s0 = seg[k], s1 = seg[128 + k], s2 = seg[256 + k], s3 = seg[384 + k];
    float off, m;
    if (dir == 0) { off = (j > 0 ? s0 : 0.f) + (j > 1 ? s1 : 0.f) + (j > 2 ? s2 : 0.f); m = s0 + s1; }
    else { off = (j < 3 ? s3 : 0.f) + (j < 2 ? s2 : 0.f) + (j < 1 ? s1 : 0.f); m = s2 + s3; }
#pragma unroll
    for (int i = 0; i < 16; ++i) d[i] = d[i] + off - m;
    m_out = m; tot_out = (s0 + s1) + (s2 + s3);
}
__device__ __forceinline__ void hg_load_v(const bf16_t* HV, int tok0, int h, LAS unsigned char* lds, int tid) {
#pragma unroll
    for (int i = 0; i < 2; ++i) { const int ch = tid + 512 * i, p = ch >> 4, part = ch & 15;
        *(LAS u32x4*)(lds + HG_V + p * HG_VROW + part * 16) = *(const u32x4*)(HV + (size_t)(tok0 + p) * 512 + h * 128 + part * 8); }
}
__device__ __forceinline__ void hg_load_g(const float* G, int tok0, int h, int k, int j, float (&gv)[16]) {
    const float* gp = G + (size_t)(tok0 + 16 * j) * 512 + h * 128 + k;
#pragma unroll
    for (int i = 0; i < 16; ++i) gv[i] = gp[(size_t)i * 512];
}

__device__ __forceinline__ void hg1_phase(int bx, int G, const float* GF, const float* GB, const bf16_t* HV, bf16_t* UT, float* Dg, float* Eg, LAS unsigned char* lds) {
    int tid_ = threadIdx.x; asm volatile("" : "+v"(tid_));
    const int tid = tid_, wave = __builtin_amdgcn_readfirstlane(tid >> 6), lane = tid & 63;
    const int k = tid & 127, j = tid >> 7, i16 = lane & 15, g4 = lane >> 4;
    float gn[16];
    if (bx < 2048) { const int u = bx, dir = u & 1, cch = (u >> 1) & 63, bh = u >> 7; hg_load_g(dir ? GB : GF, (bh >> 2) * SEQ + cch * 64, bh & 3, k, j, gn); }
    for (int u = bx; u < 2048; u += G) {
        const int dir = u & 1, cch = (u >> 1) & 63, bh = u >> 7, b = bh >> 2, h = bh & 3;
        const int tok0 = b * SEQ + cch * 64;
        float gv[16], d[16], m, tot;
#pragma unroll
        for (int i = 0; i < 16; ++i) gv[i] = gn[i];
        u32x4 vr[2];
#pragma unroll
        for (int i = 0; i < 2; ++i) { const int ch = tid + 512 * i; vr[i] = *(const u32x4*)(HV + (size_t)(tok0 + (ch >> 4)) * 512 + h * 128 + (ch & 15) * 8); }
        hg_cumsum(gv, dir, k, j, lds, d, m, tot);
        float kt[16];
#pragma unroll
        for (int i = 0; i < 16; ++i) kt[i] = (1.0f - __expf(gv[i])) * __expf(fminf(-d[i], 40.f));
        { u32x4 w0, w1;
          w0.x = pk2(kt[0], kt[1]); w0.y = pk2(kt[2], kt[3]); w0.z = pk2(kt[4], kt[5]); w0.w = pk2(kt[6], kt[7]);
          w1.x = pk2(kt[8], kt[9]); w1.y = pk2(kt[10], kt[11]); w1.z = pk2(kt[12], kt[13]); w1.w = pk2(kt[14], kt[15]);
          *(LAS u32x4*)(lds + HG_A + k * HG_KTROW + j * 32) = w0; *(LAS u32x4*)(lds + HG_A + k * HG_KTROW + j * 32 + 16) = w1; }
#pragma unroll
        for (int i = 0; i < 2; ++i) { const int ch = tid + 512 * i; *(LAS u32x4*)(lds + HG_V + (ch >> 4) * HG_VROW + (ch & 15) * 16) = vr[i]; }
        if (j == 0) { ((LAS float*)(lds + HG_F))[k] = __expf(tot - m); Dg[(size_t)u * 128 + k] = __expf(tot); Eg[(size_t)u * 128 + k] = __expf(m); }
        __syncthreads();
        if (u + G < 2048) { const int u2 = u + G, dir2 = u2 & 1, cch2 = (u2 >> 1) & 63, bh2 = u2 >> 7; hg_load_g(dir2 ? GB : GF, (bh2 >> 2) * SEQ + cch2 * 64, bh2 & 3, k, j, gn); }
        bf16x8 af[2];
#pragma unroll
        for (int s = 0; s < 2; ++s) {
            const LAS unsigned char* ap = lds + HG_A + (16 * wave + i16) * HG_KTROW + (32 * s + 4 * g4) * 2;
            const u32x2 lo = *(const LAS u32x2*)ap, hi = *(const LAS u32x2*)(ap + 32);
            af[s] = __builtin_bit_cast(bf16x8, (u32x4){lo.x, lo.y, hi.x, hi.y});
        }
        const f32x4 fsc = *(const LAS f32x4*)(lds + HG_F + (16 * wave + 4 * g4) * 4);
        const LAS unsigned char* vbase = lds + HG_V + (4 * g4 + (i16 >> 2)) * HG_VROW + (i16 & 3) * 8;
#pragma unroll
        for (int vt = 0; vt < 8; ++vt) {
            f32x4 acc = {0.f, 0.f, 0.f, 0.f};
#pragma unroll
            for (int s = 0; s < 2; ++s) {
                const s16x4 t0 = tr_read(vbase + (32 * s) * HG_VROW + vt * 32), t1 = tr_read(vbase + (32 * s + 16) * HG_VROW + vt * 32);
                const bf16x8 bv = {t0[0], t0[1], t0[2], t0[3], t1[0], t1[1], t1[2], t1[3]};
                acc = __builtin_amdgcn_mfma_f32_16x16x32_bf16(af[s], bv, acc, 0, 0, 0);
            }
            u32x2 w; w.x = pk2(acc[0] * fsc[0], acc[1] * fsc[1]); w.y = pk2(acc[2] * fsc[2], acc[3] * fsc[3]);
            *(u32x2*)(UT + ((size_t)u * 128 + 16 * vt + i16) * 128 + 16 * wave + 4 * g4) = w;
        }
        __syncthreads();
    }
}

__device__ __forceinline__ void hg2_scan(bf16_t* UT, const float* Dg, const float* Eg, int gthread, int nthreads) {
    for (int idx = gthread; idx < 32 * 4096; idx += nthreads) {
        const int chain = idx >> 12, e4 = idx & 4095, v = e4 >> 5, k0 = (e4 & 31) * 4;
        const int dir = chain & 1, bh = chain >> 1;
        float S0 = 0.f, S1 = 0.f, S2 = 0.f, S3 = 0.f;
        int u = (bh * 64 + (dir ? 63 : 0)) * 2 + dir;
        const int ustep = dir ? -2 : 2;
        u32x2 uu[4]; f32x4 dd[4], ee[4];
#pragma unroll
        for (int r = 0; r < 4; ++r) { const int ur = u + r * ustep; uu[r] = *(const u32x2*)(UT + ((size_t)ur * 128 + v) * 128 + k0); dd[r] = *(const f32x4*)(Dg + (size_t)ur * 128 + k0); ee[r] = *(const f32x4*)(Eg + (size_t)ur * 128 + k0); }
        for (int cc = 0; cc < 64; cc += 4) {
#pragma unroll
            for (int r = 0; r < 4; ++r) {
                const u32x2 uc = uu[r]; const f32x4 dc = dd[r], ec = ee[r];
                if (cc + 4 < 64) { const int un = u + 4 * ustep; uu[r] = *(const u32x2*)(UT + ((size_t)un * 128 + v) * 128 + k0); dd[r] = *(const f32x4*)(Dg + (size_t)un * 128 + k0); ee[r] = *(const f32x4*)(Eg + (size_t)un * 128 + k0); }
                u32x2 w; w.x = pk2(ec.x * S0, ec.y * S1); w.y = pk2(ec.z * S2, ec.w * S3);
                *(u32x2*)(UT + ((size_t)u * 128 + v) * 128 + k0) = w;
                S0 = dc.x * S0 + bflo(uc.x); S1 = dc.y * S1 + bfhi(uc.x); S2 = dc.z * S2 + bflo(uc.y); S3 = dc.w * S3 + bfhi(uc.y);
                u += ustep;
            }
        }
    }
}

constexpr int HG_OUT = HG_Bq + 64 * HG_QKROW;
__device__ __forceinline__ void hg3_unit(int u3, const float* GF, const float* GB, const bf16_t* HQ, const bf16_t* HV, const bf16_t* ST, const bf16_t* BG, const float* gainH, bf16_t* AO, LAS unsigned char* lds) {
    int tid_ = threadIdx.x; asm volatile("" : "+v"(tid_));
    const int tid = tid_, wave = __builtin_amdgcn_readfirstlane(tid >> 6), lane = tid & 63;
    const int cch = u3 & 63, bh = u3 >> 6, b = bh >> 2, h = bh & 3;
    const int tok0 = b * SEQ + cch * 64, k = tid & 127, j = tid >> 7;
    const int tb = wave & 3, vh = wave >> 2, i16 = lane & 15, g4 = lane >> 4;
    float gf[16], gb[16]; unsigned short qr[16];
    hg_load_g(GF, tok0, h, k, j, gf); hg_load_g(GB, tok0, h, k, j, gb);
    { const bf16_t* qp = HQ + (size_t)(tok0 + 16 * j) * 512 + h * 128 + k;
#pragma unroll
      for (int i = 0; i < 16; ++i) qr[i] = qp[(size_t)i * 512]; }
    hg_load_v(HV, tok0, h, lds, tid);
    u32x4 bgq[2];
    { const bf16_t* bgp0 = BG + (size_t)(tok0 + (tid >> 3)) * 512 + h * 128 + 16 * (tid & 7); bgq[0] = *(const u32x4*)bgp0; bgq[1] = *(const u32x4*)(bgp0 + 8); }
    bf16x8 sb[16];
    { const bf16_t* stp = ST + ((size_t)((bh * 64 + cch) * 2 + 0) * 128) * 128;
#pragma unroll
      for (int vv = 0; vv < 4; ++vv)
#pragma unroll
        for (int ks = 0; ks < 4; ++ks) sb[vv * 4 + ks] = *(const bf16x8*)(stp + (size_t)(16 * (4 * vh + vv) + i16) * 128 + 32 * ks + 8 * g4); }
    f32x4 oacc[4];
#pragma unroll
    for (int i = 0; i < 4; ++i) oacc[i] = (f32x4){0.f, 0.f, 0.f, 0.f};
#pragma unroll
    for (int dir = 0; dir < 2; ++dir) {
        float d[16], m, tot;
        hg_cumsum(dir ? gb : gf, dir, k, j, lds, d, m, tot);
#pragma unroll
        for (int i = 0; i < 16; ++i) {
            const float gvi = dir ? gb[i] : gf[i];
            const float kt = (1.0f - __expf(gvi)) * __expf(fminf(-d[i], 40.f));
            const float qt = bf2f(qr[i]) * __expf(fminf(d[i], 40.f));
            *(LAS unsigned short*)(lds + HG_A + (16 * j + i) * HG_QKROW + k * 2) = (unsigned short)f2bf(kt);
            *(LAS unsigned short*)(lds + HG_Bq + (16 * j + i) * HG_QKROW + k * 2) = (unsigned short)f2bf(qt);
        }
        __syncthreads();
        f32x4 pt[4];
#pragma unroll
        for (int sg = 0; sg < 4; ++sg) pt[sg] = (f32x4){0.f, 0.f, 0.f, 0.f};
        bf16x8 qa[4];
#pragma unroll
        for (int ks = 0; ks < 4; ++ks) qa[ks] = *(const LAS bf16x8*)(lds + HG_Bq + (16 * tb + i16) * HG_QKROW + (32 * ks + 8 * g4) * 2);
#pragma unroll
        for (int sg = 0; sg < 4; ++sg)
#pragma unroll
            for (int ks = 0; ks < 4; ++ks) {
                const bf16x8 ka = *(const LAS bf16x8*)(lds + HG_A + (16 * sg + i16) * HG_QKROW + (32 * ks + 8 * g4) * 2);
                pt[sg] = __builtin_amdgcn_mfma_f32_16x16x32_bf16(ka, qa[ks], pt[sg], 0, 0, 0);
            }
        const int tcol = 16 * tb + i16;
#pragma unroll
        for (int sg = 0; sg < 4; ++sg)
#pragma unroll
            for (int e = 0; e < 4; ++e) { const int srow = 16 * sg + 4 * g4 + e; const bool keep = dir ? (srow >= tcol) : (srow <= tcol); pt[sg][e] = keep ? pt[sg][e] : 0.f; }
        bf16x8 pa[2];
#pragma unroll
        for (int s2 = 0; s2 < 2; ++s2) {
            u32x4 w; w.x = pk2(pt[2 * s2][0], pt[2 * s2][1]); w.y = pk2(pt[2 * s2][2], pt[2 * s2][3]); w.z = pk2(pt[2 * s2 + 1][0], pt[2 * s2 + 1][1]); w.w = pk2(pt[2 * s2 + 1][2], pt[2 * s2 + 1][3]);
            pa[s2] = __builtin_bit_cast(bf16x8, w);
        }
        const LAS unsigned char* vbase = lds + HG_V + (4 * g4 + (i16 >> 2)) * HG_VROW + (i16 & 3) * 8;
#pragma unroll
        for (int vv = 0; vv < 4; ++vv) {
            const int vt = 4 * vh + vv;
#pragma unroll
            for (int s2 = 0; s2 < 2; ++s2) {
                const s16x4 t0 = tr_read(vbase + (32 * s2) * HG_VROW + vt * 32), t1 = tr_read(vbase + (32 * s2 + 16) * HG_VROW + vt * 32);
                const bf16x8 bv = {t0[0], t0[1], t0[2], t0[3], t1[0], t1[1], t1[2], t1[3]};
                oacc[vv] = __builtin_amdgcn_mfma_f32_16x16x32_bf16(pa[s2], bv, oacc[vv], 0, 0, 0);
            }
#pragma unroll
            for (int ks = 0; ks < 4; ++ks) oacc[vv] = __builtin_amdgcn_mfma_f32_16x16x32_bf16(qa[ks], sb[vv * 4 + ks], oacc[vv], 0, 0, 0);
        }
        if (dir == 0) {
            const bf16_t* stp = ST + ((size_t)((bh * 64 + cch) * 2 + 1) * 128) * 128;
#pragma unroll
            for (int vv = 0; vv < 4; ++vv)
#pragma unroll
                for (int ks = 0; ks < 4; ++ks) sb[vv * 4 + ks] = *(const bf16x8*)(stp + (size_t)(16 * (4 * vh + vv) + i16) * 128 + 32 * ks + 8 * g4);
        }
        __syncthreads();
    }
    LAS float* ot = (LAS float*)(lds + HG_OUT);
#pragma unroll
    for (int vv = 0; vv < 4; ++vv)
#pragma unroll
        for (int e = 0; e < 4; ++e) ot[(16 * tb + 4 * g4 + e) * 132 + 16 * (4 * vh + vv) + i16] = oacc[vv][e];
    __syncthreads();
    {
        const int t = tid >> 3, part = tid & 7;
        float v[16]; float ss = 0.f;
#pragma unroll
        for (int i = 0; i < 4; ++i) { const f32x4 x = *(const LAS f32x4*)(ot + t * 132 + 16 * part + 4 * i); v[4 * i] = x.x; v[4 * i + 1] = x.y; v[4 * i + 2] = x.z; v[4 * i + 3] = x.w; ss += (x.x * x.x + x.y * x.y) + (x.z * x.z + x.w * x.w); }
        ss += __shfl_xor(ss, 1); ss += __shfl_xor(ss, 2); ss += __shfl_xor(ss, 4);
        const float rs = rsqrtf(ss * (1.0f / 128.0f) + EPS);
        const float* gp = gainH + h * 128 + 16 * part;
        bf16_t* dst = AO + (size_t)(tok0 + t) * 1024 + 512 + h * 128 + 16 * part;
#pragma unroll
        for (int i = 0; i < 2; ++i) {
            const u32x4 gq = bgq[i];
            const f32x4 g0 = *(const f32x4*)(gp + 8 * i), g1 = *(const f32x4*)(gp + 8 * i + 4);
            u32x4 w;
            w.x = pk2(v[8 * i] * rs * g0.x * bflo(gq.x), v[8 * i + 1] * rs * g0.y * bfhi(gq.x)); w.y = pk2(v[8 * i + 2] * rs * g0.z * bflo(gq.y), v[8 * i + 3] * rs * g0.w * bfhi(gq.y));
            w.z = pk2(v[8 * i + 4] * rs * g1.x * bflo(gq.z), v[8 * i + 5] * rs * g1.y * bfhi(gq.z)); w.w = pk2(v[8 * i + 6] * rs * g1.z * bflo(gq.w), v[8 * i + 7] * rs * g1.w * bfhi(gq.w));
            *(u32x4*)(dst + 8 * i) = w;
        }
    }
    __syncthreads();
}

#define XB_TMO      128
#define XB_XCNT(j)  (256  + 64 * (j))
#define XB_XSUB(j)  (1280 + 64 * (j))
#define XB_XGEN(j)  (2304 + 64 * (j))
#define XB_TOP      3328
#define XB_TOPGEN   3392
#define XCD_BAR_WORDS 3456
#define XB_SPIN_CAP (1u << 18)

__device__ __forceinline__ unsigned xb_ld(unsigned* p)              { return __hip_atomic_load(p, __ATOMIC_RELAXED, __HIP_MEMORY_SCOPE_AGENT); }
__device__ __forceinline__ unsigned xb_add(unsigned* p, unsigned v) { return __hip_atomic_fetch_add(p, v, __ATOMIC_RELAXED, __HIP_MEMORY_SCOPE_AGENT); }
__device__ __forceinline__ unsigned xb_xcc_id() { return (unsigned)__builtin_amdgcn_s_getreg((3 << 11) | 20) & 0xFu; }
#define XB_SPIN(cond, bar) do { unsigned _sp = 0; while (cond) { __builtin_amdgcn_s_sleep(1); \
    if ((++_sp & 255u) == 0u) { if (xb_ld(&(bar)[XB_TMO])) break; if (_sp > XB_SPIN_CAP) { atomicAdd(&(bar)[XB_TMO], 1u); break; } } } } while (0)

struct XcdBarrier {
    unsigned* bar; unsigned x;
    volatile LAS unsigned* st;
};

__device__ __forceinline__ XcdBarrier xcd_barrier_post(unsigned* bar, volatile LAS unsigned* st) {
    XcdBarrier b; b.bar = bar; b.x = xb_xcc_id(); b.st = st;
    if (threadIdx.x == 0) (void)xb_add(&bar[XB_XCNT(b.x)], 1u);
    return b;
}
__device__ __forceinline__ void xcd_barrier_complete(unsigned* bar, unsigned x, unsigned& nloc, unsigned& nx) {
    const unsigned G = gridDim.x * gridDim.y * gridDim.z;
    unsigned sum, cnt, mine, sp = 0u;
    for (;;) {
        sum = 0u; cnt = 0u; mine = 0u;
#pragma unroll
        for (unsigned j = 0; j < 16; ++j) { const unsigned c = xb_ld(&bar[XB_XCNT(j)]); sum += c; cnt += (c > 0u) ? 1u : 0u; mine = (j == x) ? c : mine; }
        if (sum == G) break;
        __builtin_amdgcn_s_sleep(1);
        if ((++sp & 255u) == 0u) { if (xb_ld(&bar[XB_TMO])) break; if (sp > XB_SPIN_CAP) { atomicAdd(&bar[XB_TMO], 1u); break; } }
    }
    nloc = mine > 0u ? mine : 1u; nx = cnt > 0u ? cnt : 1u;
}

__device__ __forceinline__ void xcd_barrier(const XcdBarrier& b) {
    asm volatile("s_waitcnt vmcnt(0)" ::: "memory");
    __syncthreads();
    if (threadIdx.x == 0) {
        unsigned* bar = b.bar;
        __builtin_amdgcn_s_waitcnt(0);
        unsigned nloc = b.st[0], nx = b.st[1];
        if (nloc == 0u) { xcd_barrier_complete(bar, b.x, nloc, nx); b.st[0] = nloc; b.st[1] = nx; }
        const unsigned old = xb_add(&bar[XB_XSUB(b.x)], 1u);
        const unsigned gen = old / nloc;
        if (old + 1u == (gen + 1u) * nloc) {
            __builtin_amdgcn_fence(__ATOMIC_RELEASE, "agent");
            asm volatile("s_waitcnt vmcnt(0)" ::: "memory");
            const unsigned og = xb_add(&bar[XB_TOP], 1u);
            const unsigned tg = og / nx;
            if (og + 1u == (tg + 1u) * nx) xb_add(&bar[XB_TOPGEN], 1u);
            else XB_SPIN(xb_ld(&bar[XB_TOPGEN]) == tg, bar);
            __builtin_amdgcn_fence(__ATOMIC_ACQUIRE, "agent");
            xb_add(&bar[XB_XGEN(b.x)], 1u);
            asm volatile("s_waitcnt vmcnt(0)" ::: "memory");
        } else {
            XB_SPIN(xb_ld(&bar[XB_XGEN(b.x)]) == gen, bar);
            __builtin_amdgcn_fence(__ATOMIC_ACQUIRE, "agent");
            asm volatile("s_waitcnt vmcnt(0)" ::: "memory");
        }
    }
    __syncthreads();
}

__global__ void __launch_bounds__(512, 2) fwd_kernel(Ptrs Pk) {
    extern __shared__ __attribute__((aligned(16))) unsigned char lds_raw[];
    LAS unsigned char* lds = (LAS unsigned char*)lds_raw;
    cg::grid_group grid = cg::this_grid();
    const int G = gridDim.x, bx = blockIdx.x;
    const int lo = Pk.ph_lo, hi = Pk.ph_hi;
    int ph = 0;
    if (threadIdx.x < 4) ((LAS unsigned*)(lds + 131072 + 1024))[threadIdx.x] = 0u;
    __syncthreads();
    XcdBarrier xbar = xcd_barrier_post((unsigned*)(Pk.ws + OFF_BAR), (volatile LAS unsigned*)(lds + 131072 + 1024));
#ifdef TS_A
    if (threadIdx.x == 0) { LAS unsigned long long* TS_ = (LAS unsigned long long*)(lds + 131072); for (int i = 0; i < 15; ++i) TS_[i] = 0ull; TS_[15] = __builtin_amdgcn_s_memrealtime(); }
#endif
#ifndef PH_MASK
#define PH_MASK 0xFFFFFFFFu
#endif
#define ON(id) constexpr (((PH_MASK) >> (id)) & 1u)
#if defined(__HIP_DEVICE_COMPILE__)
#define LOAD_ARGS(P) int zoff_ = 0; asm volatile("" : "+s"(zoff_)); const Ptrs P = *(const __attribute__((address_space(4))) Ptrs*)((const __attribute__((address_space(4))) char*)__builtin_amdgcn_kernarg_segment_ptr() + zoff_);
#else
#define LOAD_ARGS(P) const Ptrs P = Pk;
#endif
#define PHASE_BEGIN if (ph >= lo && ph < hi) { LOAD_ARGS(P) unsigned char* ws = P.ws; asm volatile("" : "+s"(ws)); int tid = threadIdx.x; asm volatile("" : "+v"(tid)); \
    const int lane = tid & 63, wave = __builtin_amdgcn_readfirstlane(tid >> 6), gw = bx * 8 + wave, ngw = G * 8; (void)lane; (void)gw; (void)ngw;
#define XB ((bf16_t*)(ws + OFF_XB))
#define RSA ((float*)(ws + OFF_RSA))
#define RSB ((float*)(ws + OFF_RSB))
#define CS ((const float*)(ws + OFF_CS))
#define LB ((const float*)(ws + OFF_LB))
#define LAM ((const float*)(ws + OFF_LAM))
#define Dg ((float*)(ws + OFF_DG))
#define Eg ((float*)(ws + OFF_EG))
#define GATE ((bf16_t*)(ws + OFF_GATE))
#define Qb ((bf16_t*)(ws + OFF_Q))
#define Kb ((bf16_t*)(ws + OFF_K))
#define Vb ((bf16_t*)(ws + OFF_V))
#define HQ ((bf16_t*)(ws + OFF_HQ))
#define HV ((bf16_t*)(ws + OFF_HV))
#define GF ((float*)(ws + OFF_GF))
#define GB ((float*)(ws + OFF_GB))
#define Yb ((bf16_t*)(ws + OFF_Y))
#define BG ((bf16_t*)(ws + OFF_BG))
#define AO ((bf16_t*)(ws + OFF_AO))
#define UT ((bf16_t*)(ws + OFF_UT))
#define Hb ((bf16_t*)(ws + OFF_H))
#ifdef TS_A
#define TICK(cat) do { if (bx == 0 && threadIdx.x == 0) { LAS unsigned long long* TS_ = (LAS unsigned long long*)(lds + 131072); const unsigned long long t_ = __builtin_amdgcn_s_memrealtime(); TS_[cat] += t_ - TS_[15]; TS_[15] = t_; } } while (0)
#else
#define TICK(cat) do { } while (0)
#endif
#define PHASE_END(cat)   TICK(cat); if (ph + 1 < hi) { if (ph == 0) grid.sync(); else xcd_barrier(xbar); TICK(13); } } ++ph;

    PHASE_BEGIN
        if ON(0) prologue(P, lds, gw, ngw, wave, lane);
        if ON(6) convert_layer(P, 0, ws, lds, gw, ngw, wave, lane);
    PHASE_END(0)

    for (int layer = 0; layer < DEPTH; ++layer) {
        PHASE_BEGIN
            pg8::Gemm g{XB, (const bf16_t*)(ws + (size_t)(layer & 1) * WSZ + W_IN), Dm, Dm, Dm, 1 << 30, 0, -1};
            pg8::StaticOrder S; S.init(M, 4096, G, bx);
            EpiMix E{RSB, CS, LB + (0 * 4 + layer) * 512, LB + (1 * 4 + layer) * 512, Qb, Kb, Vb, HQ, HV, BG, GF, GB};
            if ON(1) pg8::gemm_phase(lds, g, S, E);
        PHASE_END(1)
        PHASE_BEGIN
            const float lam_init = 0.8f - 0.6f * __expf(-0.3f * (float)layer);
            const float lam = LAM[layer];
            if ON(2) for (int i = 0; i * G + bx < 512; ++i) {
                const int uid = i * G + bx; const int round = uid >> 8, r = uid & 255;
                const int bhh = round * 8 + (r & 7), qb = r >> 3;
                attn_unit(bhh >> 2, bhh & 3, qb, Qb, Kb, Vb, AO, P.da_norm + layer * 512, 1.0f - lam_init, lam, lds);
            }
            TICK(2);
            if ON(3) hg1_phase(bx, G, GF, GB, HV, UT, Dg, Eg, lds);
        PHASE_END(3)
        PHASE_BEGIN
            {
                pg8::Gemm g{XB, (const bf16_t*)(ws + (size_t)(layer & 1) * WSZ + W_IN) + (size_t)4096 * Dm, Dm, Dm, Dm, 1 << 30, 0, -1};
                pg8::StaticOrder S; S.init(M, 2048, G, bx);
                EpiGate E{RSB, GATE};
                if ON(4) pg8::gemm_phase(lds, g, S, E);
            }
            TICK(4);
            if ON(5) hg2_scan(UT, Dg, Eg, bx * 512 + tid, G * 512);
            TICK(5);
            if ON(6) if (layer + 1 < DEPTH) convert_layer(P, layer + 1, ws + (size_t)((layer + 1) & 1) * WSZ, lds, gw, ngw, wave, lane);
        PHASE_END(6)
        PHASE_BEGIN
            if ON(7) for (int u = bx; u < 1024; u += G) hg3_unit(u, GF, GB, HQ, HV, UT, BG, P.hg_norm + layer * 512, AO, lds);
        PHASE_END(7)
        PHASE_BEGIN
            pg8::Gemm g{AO, (const bf16_t*)(ws + (size_t)(layer & 1) * WSZ + W_AB), 1024, 1024, 1024, 1 << 30, 0, 8};
            pg8::StaticOrder S; S.init(M, 1024, G, bx);
            EpiY E{GATE, Yb};
            if ON(8) pg8::gemm_phase(lds, g, S, E);
        PHASE_END(8)
        PHASE_BEGIN
            pg8::Gemm g{Yb, (const bf16_t*)(ws + (size_t)(layer & 1) * WSZ + W_O2), 1024, 1024, 1024, 1 << 30, 0, -1};
            pg8::StaticOrder S; S.init(M, Dm, G, bx);
            EpiRes E{layer == 0 ? P.x : P.out, P.out, XB, RSA};
            if ON(9) pg8::gemm_phase(lds, g, S, E);
        PHASE_END(9)
        PHASE_BEGIN
            pg8::Gemm g{XB, (const bf16_t*)(ws + (size_t)(layer & 1) * WSZ + W_GU), Dm, Dm, Dm, 1 << 30, 0, -1};
            pg8::StaticOrder S; S.init(M, 2 * FF, G, bx);
            EpiGU E{RSA, Hb};
            if ON(10) pg8::gemm_phase(lds, g, S, E);
        PHASE_END(10)
        PHASE_BEGIN
            pg8::Gemm g{Hb, (const bf16_t*)(ws + (size_t)(layer & 1) * WSZ + W_D), FF, FF, FF, 1 << 30, 0, -1};
            pg8::StaticOrder S; S.init(M, Dm, G, bx);
            EpiRes E{P.out, P.out, XB, RSB};
            if ON(11) pg8::gemm_phase(lds, g, S, E);
        PHASE_END(11)
    }
    PHASE_BEGIN
        if ON(12) for (int r = gw; r < M; r += ngw) {
            f32x4* xr = (f32x4*)(P.out + (size_t)r * Dm) + lane;
            f32x4 v[4]; float ss = 0.f;
#pragma unroll
            for (int j = 0; j < 4; ++j) { v[j] = xr[64 * j]; ss += (v[j].x * v[j].x + v[j].y * v[j].y) + (v[j].z * v[j].z + v[j].w * v[j].w); }
            const float rs = rsqrtf(wave_sum(ss) * (1.0f / Dm) + EPS);
#pragma unroll
            for (int j = 0; j < 4; ++j) { const f32x4 gn = *((const f32x4*)P.final_norm + lane + 64 * j); xr[64 * j] = (f32x4){v[j].x * rs * gn.x, v[j].y * rs * gn.y, v[j].z * rs * gn.z, v[j].w * rs * gn.w}; }
        }
    PHASE_END(12)
#ifdef TS_A
    if (bx == 0 && threadIdx.x == 0) {
        LAS unsigned long long* TS_ = (LAS unsigned long long*)(lds + 131072);
        unsigned long long a = 0;
        for (int i = 0; i < 15; ++i) { if ((TS_A >> i) & 1) a += TS_[i]; }
        const unsigned long long t_end = __builtin_amdgcn_s_memrealtime() + a;
        while (__builtin_amdgcn_s_memrealtime() < t_end) __builtin_amdgcn_s_sleep(20);
    }
#endif
}
constexpr int NPHASES = 2 + 8 * DEPTH;

#ifndef MK_PER_PHASE
#define MK_PER_PHASE 0
#endif

extern "C" void kernel_launch(void* const* d_in, const int* in_sizes, int n_in, void* d_out, int out_size, void* d_ws, size_t ws_size, hipStream_t stream) {
    static int grid = 0;
    if (grid == 0) {
        if (n_in != 16 || out_size != M * Dm || ws_size < WS_END) { fprintf(stderr, "kernel_launch: unexpected sizes (n_in %d, out %d, ws %zu, need %zu)\n", n_in, out_size, ws_size, (size_t)WS_END); grid = -1; return; }
        int dev = 0, cus = 0, per_cu = 0;
        (void)hipGetDevice(&dev);
        (void)hipDeviceGetAttribute(&cus, hipDeviceAttributeMultiprocessorCount, dev);
        if (hipFuncSetAttribute((const void*)fwd_kernel, hipFuncAttributeMaxDynamicSharedMemorySize, LDS_BYTES) != hipSuccess) { fprintf(stderr, "kernel_launch: hipFuncSetAttribute failed\n"); grid = -1; return; }
        (void)hipOccupancyMaxActiveBlocksPerMultiprocessor(&per_cu, (const void*)fwd_kernel, 512, LDS_BYTES);
        (void)hipGetLastError();
        if (per_cu < 1) per_cu = 1;
        grid = cus * 1;
        fprintf(stderr, "kernel_launch: grid %d (per_cu %d), ws %zu need %zu\n", grid, per_cu, ws_size, (size_t)WS_END);
    }
    if (grid < 0) return;
    Ptrs p{};
    p.x = (const float*)d_in[0]; p.pos = (const int*)d_in[1]; p.w_in = (const float*)d_in[2]; p.da_lambda = (const float*)d_in[3]; p.da_norm = (const float*)d_in[4];
    p.hg_lb = (const float*)d_in[5]; p.hg_norm = (const float*)d_in[6]; p.w_a = (const float*)d_in[7]; p.w_b = (const float*)d_in[8]; p.w_o = (const float*)d_in[9];
    p.attn_norm = (const float*)d_in[10]; p.ffn_norm = (const float*)d_in[11]; p.w_gate = (const float*)d_in[12]; p.w_up = (const float*)d_in[13]; p.w_down = (const float*)d_in[14];
    p.final_norm = (const float*)d_in[15];
    p.out = (float*)d_out; p.ws = (unsigned char*)d_ws;
    (void)hipMemsetAsync((char*)d_ws + OFF_BAR, 0, BAR_BYTES, stream);
#if MK_PER_PHASE
    for (int ph = 0; ph < NPHASES; ++ph) {
        p.ph_lo = ph; p.ph_hi = ph + 1;
        hipLaunchKernelGGL(fwd_kernel, dim3(grid), dim3(512), LDS_BYTES, stream, p);
    }
#else
    p.ph_lo = 0; p.ph_hi = NPHASES;
    void* args[] = {&p};
    hipError_t e = hipLaunchCooperativeKernel((const void*)fwd_kernel, dim3(grid), dim3(512), args, LDS_BYTES, stream);
    if (e != hipSuccess) fprintf(stderr, "cooperative launch failed: %s (grid %d)\n", hipGetErrorString(e), grid);
#endif
}
```

```cpp
#include <hip/hip_runtime.h>
#include <hip/hip_cooperative_groups.h>
#include <cstdio>
#include <cstdint>
namespace cg = cooperative_groups;

#define LAS __attribute__((address_space(3)))
typedef unsigned short bf16_t;
typedef short bf16x8 __attribute__((ext_vector_type(8)));
typedef short s16x4 __attribute__((ext_vector_type(4)));
typedef float f32x4 __attribute__((ext_vector_type(4)));
typedef float f32x16 __attribute__((ext_vector_type(16)));
typedef unsigned u32x4 __attribute__((ext_vector_type(4)));
typedef unsigned u32x2 __attribute__((ext_vector_type(2)));

constexpr int Dm = 1024, NB = 4, SEQ = 4096, M = NB * SEQ, DEPTH = 4, FF = 2816, INW = 6144;
constexpr float EPS = 1e-6f;
constexpr float LOG2E = 1.4426950408889634f;

constexpr size_t W_IN = 0, W_AB = 12582912, W_O2 = 14680064, W_GU = 18874368, W_D = 30408704, WSZ = 36175872;
constexpr size_t MiB = 1048576;
constexpr size_t OFF_XB = 2 * WSZ;
constexpr size_t OFF_RSA = OFF_XB + 32 * MiB;
constexpr size_t OFF_RSB = OFF_RSA + MiB;
constexpr size_t OFF_CS = OFF_RSB + MiB;
constexpr size_t OFF_LB = OFF_CS + MiB;
constexpr size_t OFF_LAM = OFF_LB + 16384;
constexpr size_t OFF_DG = OFF_LAM + 256;
constexpr size_t OFF_EG = OFF_DG + MiB;
constexpr size_t OFF_B = OFF_EG + MiB;
constexpr size_t OFF_GATE = OFF_B;
constexpr size_t OFF_Q = OFF_B, OFF_K = OFF_B + 16 * MiB, OFF_V = OFF_B + 32 * MiB;
constexpr size_t OFF_HQ = OFF_B + 64 * MiB;
constexpr size_t OFF_HV = OFF_HQ + 16 * MiB;
constexpr size_t OFF_GF = OFF_HV + 16 * MiB;
constexpr size_t OFF_GB = OFF_GF + 32 * MiB;
constexpr size_t OFF_Y = OFF_GF;
constexpr size_t OFF_BG = OFF_GB + 32 * MiB;
constexpr size_t OFF_AO = OFF_BG + 16 * MiB;
constexpr size_t OFF_UT = OFF_AO + 32 * MiB;
constexpr size_t OFF_H = OFF_B;
constexpr size_t OFF_BAR = OFF_UT + 64 * MiB;
constexpr size_t BAR_BYTES = 16384;
constexpr size_t WS_END = OFF_BAR + BAR_BYTES;

constexpr int LDS_BYTES = 131072 + 2048;

__device__ __forceinline__ unsigned f2bf(float f) { unsigned u = __builtin_bit_cast(unsigned, f); return (u + 0x7fffu + ((u >> 16) & 1u)) >> 16; }
typedef float f32x2_t __attribute__((ext_vector_type(2)));
typedef __bf16 bf16x2_t __attribute__((ext_vector_type(2)));
__device__ __forceinline__ unsigned pk2(float lo, float hi) { f32x2_t v = {lo, hi}; bf16x2_t b = __builtin_convertvector(v, bf16x2_t); return __builtin_bit_cast(unsigned, b); }
__device__ __forceinline__ float bf2f(unsigned short b) { return __builtin_bit_cast(float, (unsigned)b << 16); }
__device__ __forceinline__ float bflo(unsigned u) { return __builtin_bit_cast(float, u << 16); }
__device__ __forceinline__ float bfhi(unsigned u) { return __builtin_bit_cast(float, u & 0xffff0000u); }
__device__ __forceinline__ float sigmoidf_(float x) { return __builtin_amdgcn_rcpf(1.0f + __expf(-x)); }

namespace pg8 {
constexpr int BM = 256, BK = 64, HALF = 128, HTB = HALF * BK * 2, STAGE_BYTES = 8 * HTB, NXCD = 8, WGM = 8;
__host__ __device__ __forceinline__ int lds_byte(int r, int c) { const int st = (r >> 4) * 2 + (c >> 5), rr = r & 15, cc = c & 31, ob = rr * 64 + cc * 2; return st * 1024 + (ob ^ (((ob >> 9) & 1) << 5)); }
__host__ __device__ __forceinline__ void stage_rc(int b, int& R, int& C) { const int st = b / 1024, sb = b % 1024, swz = sb ^ (((sb >> 9) & 1) << 5); R = (st >> 1) * 16 + swz / 64; C = (st & 1) * 32 + (swz % 64) / 2; }
__host__ __device__ __forceinline__ int perm32(int rho) { const int n = rho >> 4, i = rho & 15; return 8 * (i >> 2) + 4 * n + (i & 3); }

struct Unit { int pm, pn; };
struct Gemm { const bf16_t* A; const bf16_t* Bt; int lda, ldb, K; int split_pn; int split_aoff; int mid_t; };

struct StaticOrder {
    int nM, nN, nwg, G, c;
    __device__ __forceinline__ void init(int M_, int N_, int G_, int c_) { nM = M_ / BM; nN = N_ / BM; nwg = nM * nN; G = G_; c = c_; }
    __device__ bool next(int i, Unit& u) const {
        const long L = (long)i * G + c; if (L >= nwg) return false;
        int wgid = (int)L; { const int q = nwg / NXCD, r = nwg % NXCD, xcd = wgid % NXCD, off = wgid / NXCD; wgid = (xcd < r ? xcd * (q + 1) : r * (q + 1) + (xcd - r) * q) + off; }
        const int nig = WGM * nN, gid = wgid / nig, fm = gid * WGM, gsz = (nM - fm) < WGM ? (nM - fm) : WGM;
        u.pm = fm + ((wgid % nig) % gsz); u.pn = (wgid % nig) / gsz; return true;
    }
};

template <class Epi>
__device__ __forceinline__ void gemm_phase(LAS unsigned char* lds, const Gemm g, const StaticOrder& S, const Epi& E) {
    int tid_ = threadIdx.x; asm volatile("" : "+v"(tid_));
    const int tid = tid_, wid = __builtin_amdgcn_readfirstlane(tid >> 6), lane = tid & 63, wr = wid >> 2, wc = wid & 3, fr = lane & 15, fq = lane >> 4;
    const int K = g.K, nt = K / BK;
    unsigned voffA[2], voffB[2];
#pragma unroll
    for (int i = 0; i < 2; ++i) { int R, C; stage_rc(tid * 16 + i * 8192, R, C); const int Rb = (R & ~31) + perm32(R & 31);
        voffA[i] = (unsigned)(R * g.lda + C) * 2u; voffB[i] = (unsigned)(Rb * g.ldb + C) * 2u; }
    const size_t kstep = (size_t)(BK * 2);
    const size_t hstepA = (size_t)HALF * g.lda * 2, hstepB = (size_t)HALF * g.ldb * 2;
    const size_t tstepA = 2 * hstepA, tstepB = 2 * hstepB;
    const unsigned ldsw = (unsigned)wid * 1024u;
    const int aoff = lds_byte(wr * 64 + fr, fq * 8), boff = lds_byte(wc * 32 + fr, fq * 8);
#define PG8_SA(b, h) (((b) * 2 + (h)) * HTB)
#define PG8_SB(b, h) ((4 + (b) * 2 + (h)) * HTB)
#define PG8_STAGE(bufoff, gbase, voff) do { _Pragma("unroll") for (int _i = 0; _i < 2; ++_i) \
        __builtin_amdgcn_global_load_lds((const unsigned*)((const char*)(gbase) + (voff)[_i]), (LAS unsigned*)(lds + (bufoff) + ldsw + _i * 8192), 16, 0, 0); } while (0)
#define PG8_LDA(dst, b, h) do { _Pragma("unroll") for (int m = 0; m < 4; ++m) _Pragma("unroll") for (int k = 0; k < 2; ++k) dst[m][k] = *(const LAS bf16x8*)(lds + PG8_SA(b, h) + aoff + m * 2048 + k * 1024); } while (0)
#define PG8_LDB(dst, b, h) do { _Pragma("unroll") for (int n = 0; n < 2; ++n) _Pragma("unroll") for (int k = 0; k < 2; ++k) dst[n][k] = *(const LAS bf16x8*)(lds + PG8_SB(b, h) + boff + n * 2048 + k * 1024); } while (0)
#define PG8_MMA(ai, bj, At, Bt) do { __builtin_amdgcn_s_setprio(1); _Pragma("unroll") for (int m = 0; m < 4; ++m) _Pragma("unroll") for (int n = 0; n < 2; ++n) _Pragma("unroll") for (int k = 0; k < 2; ++k) \
        acc[ai][bj][m][n] = __builtin_amdgcn_mfma_f32_16x16x32_bf16(Bt[n][k], At[m][k], acc[ai][bj][m][n], 0, 0, 0); __builtin_amdgcn_s_setprio(0); } while (0)
#define PG8_WAIT_V(n) asm volatile("s_waitcnt vmcnt(" #n ")" ::: "memory")
#define PG8_WAIT_L(n) asm volatile("s_waitcnt lgkmcnt(" #n ")" ::: "memory")
#define PG8_BAR __builtin_amdgcn_s_barrier()
#define PG8_SCHED __builtin_amdgcn_sched_barrier(0)
#define PG8_UA(u) ((const char*)g.A + (size_t)(u).pm * tstepA + (((u).pn >= g.split_pn) ? (size_t)g.split_aoff * 2 : (size_t)0))
    Unit cur, nxt; int ui = 0;
    if (!S.next(0, cur)) return;
    f32x4 acc[2][2][4][2];
#pragma unroll
    for (int a = 0; a < 2; ++a)
#pragma unroll
        for (int b = 0; b < 2; ++b)
#pragma unroll
            for (int m = 0; m < 4; ++m)
#pragma unroll
                for (int n = 0; n < 2; ++n) acc[a][b][m][n] = (f32x4){0.f, 0.f, 0.f, 0.f};
    bf16x8 At[4][2], B0[2][2], B1[2][2];
    const char* cA = PG8_UA(cur); const char* cB = (const char*)g.Bt + (size_t)cur.pn * tstepB;
    PG8_STAGE(PG8_SB(0, 0), cB, voffB); PG8_STAGE(PG8_SB(0, 1), cB + hstepB, voffB); PG8_STAGE(PG8_SA(0, 0), cA, voffA); PG8_STAGE(PG8_SA(0, 1), cA + hstepA, voffA);
    if (wr == 1) PG8_BAR;
    PG8_WAIT_V(2); PG8_BAR;
    PG8_STAGE(PG8_SB(1, 0), cB + kstep, voffB); PG8_STAGE(PG8_SA(1, 0), cA + kstep, voffA); PG8_STAGE(PG8_SB(1, 1), cB + hstepB + kstep, voffB);
    PG8_WAIT_V(6); PG8_BAR;
    for (;;) {
        const bool has_next = S.next(ui + 1, nxt);
        const char* nA = has_next ? PG8_UA(nxt) : cA; const char* nB = has_next ? (const char*)g.Bt + (size_t)nxt.pn * tstepB : cB;
        for (int t = 0; t < nt; t += 2) {
            if constexpr (Epi::HAS_MID) { if (t == g.mid_t) E.mid(acc, cur, wr, wc, fr, fq); }
            const bool last = (t == nt - 2);
            const char* a1 = cA + (size_t)(t + 1) * kstep;
            const char* a2 = last ? nA : cA + (size_t)(t + 2) * kstep; const char* b2 = last ? nB : cB + (size_t)(t + 2) * kstep;
            const char* a3 = a2 + kstep; const char* b3 = b2 + kstep;
            PG8_LDB(B0, 0, 0); PG8_LDB(B1, 0, 1); PG8_SCHED; PG8_LDA(At, 0, 0); PG8_STAGE(PG8_SA(1, 1), a1 + hstepA, voffA);
            PG8_WAIT_V(8); PG8_WAIT_L(0); PG8_BAR; PG8_MMA(0, 0, At, B0); PG8_MMA(0, 1, At, B1); PG8_BAR; PG8_SCHED;
            PG8_LDA(At, 0, 1); PG8_STAGE(PG8_SB(0, 0), b2, voffB); PG8_STAGE(PG8_SB(0, 1), b2 + hstepB, voffB); PG8_STAGE(PG8_SA(0, 0), a2, voffA);
            PG8_WAIT_V(8); PG8_WAIT_L(0); PG8_BAR; PG8_MMA(1, 0, At, B0); PG8_MMA(1, 1, At, B1); PG8_BAR; PG8_SCHED;
            PG8_LDB(B0, 1, 0); PG8_LDB(B1, 1, 1); PG8_SCHED; PG8_LDA(At, 1, 0); PG8_STAGE(PG8_SA(0, 1), a2 + hstepA, voffA);
            PG8_WAIT_V(8); PG8_WAIT_L(0); PG8_BAR; PG8_MMA(0, 0, At, B0); PG8_MMA(0, 1, At, B1); PG8_BAR; PG8_SCHED;
            PG8_LDA(At, 1, 1); PG8_STAGE(PG8_SB(1, 0), b3, voffB); PG8_STAGE(PG8_SB(1, 1), b3 + hstepB, voffB); PG8_STAGE(PG8_SA(1, 0), a3, voffA);
            PG8_WAIT_V(8); PG8_WAIT_L(0); PG8_BAR; PG8_MMA(1, 0, At, B0); PG8_MMA(1, 1, At, B1); PG8_BAR; PG8_SCHED;
        }
        if (wr == 0) PG8_BAR;
        E(acc, cur, wr, wc, fr, fq);
        if (!has_next) break;
#pragma unroll
        for (int a = 0; a < 2; ++a)
#pragma unroll
            for (int b = 0; b < 2; ++b)
#pragma unroll
                for (int m = 0; m < 4; ++m)
#pragma unroll
                    for (int n = 0; n < 2; ++n) acc[a][b][m][n] = (f32x4){0.f, 0.f, 0.f, 0.f};
        cur = nxt; cA = nA; cB = nB; ++ui;
        if (wr == 1) PG8_BAR;
    }
    PG8_WAIT_V(0);
    PG8_BAR;
#undef PG8_SA
#undef PG8_SB
#undef PG8_STAGE
#undef PG8_LDA
#undef PG8_LDB
#undef PG8_MMA
#undef PG8_UA
}
}

__device__ __forceinline__ float row_rs(const float* rsp, int row) {
    const f32x4* p = (const f32x4*)(rsp + (size_t)row * 16);
    f32x4 a = p[0], b = p[1], c = p[2], d = p[3];
    float s = ((a.x + a.y) + (a.z + a.w)) + ((b.x + b.y) + (b.z + b.w)) + ((c.x + c.y) + (c.z + c.w)) + ((d.x + d.y) + (d.z + d.w));
    return __builtin_amdgcn_rsqf(s * (1.0f / Dm) + EPS);
}
__device__ __forceinline__ void rows_rs4(const float* rsp, int row0  , float (&rs)[4]) {
#pragma unroll
    for (int mp = 0; mp < 2; ++mp) {
        f32x4 p[2][4];
#pragma unroll
        for (int m = 0; m < 2; ++m) { const f32x4* q = (const f32x4*)(rsp + (size_t)(row0 + 16 * (2 * mp + m)) * 16);
#pragma unroll
            for (int i = 0; i < 4; ++i) p[m][i] = q[i]; }
#pragma unroll
        for (int m = 0; m < 2; ++m) { float t = 0.f;
#pragma unroll
            for (int i = 0; i < 4; ++i) t += (p[m][i].x + p[m][i].y) + (p[m][i].z + p[m][i].w);
            rs[2 * mp + m] = __builtin_amdgcn_rsqf(t * (1.0f / Dm) + EPS); }
        __builtin_amdgcn_sched_barrier(0);
    }
}
__device__ __forceinline__ void rows_rs2(const float* rsp, int row0, float (&rs)[2]) {
    f32x4 p[2][4];
#pragma unroll
    for (int m = 0; m < 2; ++m) { const f32x4* q = (const f32x4*)(rsp + (size_t)(row0 + 16 * m) * 16);
#pragma unroll
        for (int i = 0; i < 4; ++i) p[m][i] = q[i]; }
#pragma unroll
    for (int m = 0; m < 2; ++m) { float t = 0.f;
#pragma unroll
        for (int i = 0; i < 4; ++i) t += (p[m][i].x + p[m][i].y) + (p[m][i].z + p[m][i].w);
        rs[m] = __builtin_amdgcn_rsqf(t * (1.0f / Dm) + EPS); }
}
__device__ __forceinline__ u32x4 pack8(const float* v) { u32x4 w; w.x = pk2(v[0], v[1]); w.y = pk2(v[2], v[3]); w.z = pk2(v[4], v[5]); w.w = pk2(v[6], v[7]); return w; }

struct EpiMix {
    static constexpr bool HAS_MID = false;
    const float* rsp; const float* cs; const float* lbF; const float* lbB;
    bf16_t *Q, *Kk, *V, *HQ, *HV, *BG; float *GF, *GB;
    template <int GRP>
    __device__ __forceinline__ void run(const f32x4 (&acc)[2][2][4][2], const pg8::Unit& u, int wr, int wc, int fr, int fq) const {
#pragma unroll
        for (int ai = 0; ai < 2; ++ai)
#pragma unroll
        for (int mp = 0; mp < 2; ++mp) {
            const int row0 = u.pm * 256 + ai * 128 + wr * 64 + mp * 32 + fr;
            float rs4[2]; rows_rs2(rsp, row0, rs4);
            const int d0r = (wc * 32 + fq * 8) & 63;
            f32x4 c4r[2], s4r[2];
            if constexpr (GRP <= 1) {
                if (d0r < 16) {
#pragma unroll
                    for (int mm = 0; mm < 2; ++mm) { const float* cp = cs + (size_t)(row0 + 16 * mm) * 16 + (d0r >> 3) * 4; c4r[mm] = *(const f32x4*)cp; s4r[mm] = *(const f32x4*)(cp + 8); }
                }
            }
            __builtin_amdgcn_sched_barrier(0);
#pragma unroll
            for (int mm = 0; mm < 2; ++mm) {
                const int m = 2 * mp + mm;
                const int row = row0 + mm * 16;
                const float rs = rs4[mm];
                const int b = row >> 12, s = row & 4095;
#pragma unroll
                for (int bj = 0; bj < 2; ++bj) {
                    const int col = u.pn * 256 + bj * 128 + wc * 32 + fq * 8;
                    const int jj = col & 511;
                    float v[8];
#pragma unroll
                    for (int e = 0; e < 4; ++e) { v[e] = acc[ai][bj][m][0][e] * rs; v[4 + e] = acc[ai][bj][m][1][e] * rs; }
                    if constexpr (GRP <= 1) {
                        const int d0 = jj & 63;
                        if (d0 < 16) {
                            const f32x4 c4 = c4r[mm], s4 = s4r[mm];
#pragma unroll
                            for (int e = 0; e < 4; ++e) { const float t1 = v[e], t2 = v[4 + e]; v[e] = t1 * c4[e] - t2 * s4[e]; v[4 + e] = t2 * c4[e] + t1 * s4[e]; }
                        }
                        if constexpr (GRP == 0) {
#pragma unroll
                            for (int e = 0; e < 8; ++e) v[e] *= 0.125f * LOG2E;
                        }
                        const int h = jj >> 7, c = (jj >> 6) & 1;
                        bf16_t* dst = (GRP == 0 ? Q : Kk) + ((size_t)(((b * 4 + h) * 2 + c) * SEQ + s)) * 64 + d0;
                        *(u32x4*)dst = pack8(v);
                    } else if constexpr (GRP == 2) {
                        const int h = jj >> 7, d0 = jj & 127;
                        *(u32x4*)(V + ((size_t)((b * 4 + h) * SEQ + s)) * 128 + d0) = pack8(v);
                    } else if constexpr (GRP == 3) {
                        *(u32x4*)(HQ + (size_t)row * 512 + jj) = pack8(v);
                    } else if constexpr (GRP == 4 || GRP == 5) {
                        const float* lbp = (GRP == 4 ? lbF : lbB) + jj;
                        const f32x4 l0 = *(const f32x4*)lbp, l1 = *(const f32x4*)(lbp + 4);
                        float gl[8];
#pragma unroll
                        for (int e = 0; e < 8; ++e) { const float lb = e < 4 ? l0[e] : l1[e - 4]; const float f = lb + (1.0f - lb) * sigmoidf_(v[e]); gl[e] = __builtin_amdgcn_logf(fmaxf(f, 1e-37f)) * 0.6931471805599453f; }
                        float* dst = (GRP == 4 ? GF : GB) + (size_t)row * 512 + jj;
                        *(f32x4*)dst = (f32x4){gl[0], gl[1], gl[2], gl[3]}; *(f32x4*)(dst + 4) = (f32x4){gl[4], gl[5], gl[6], gl[7]};
                    } else if constexpr (GRP == 6) {
                        *(u32x4*)(HV + (size_t)row * 512 + jj) = pack8(v);
                    } else {
#pragma unroll
                        for (int e = 0; e < 8; ++e) v[e] = sigmoidf_(v[e]);
                        *(u32x4*)(BG + (size_t)row * 512 + jj) = pack8(v);
                    }
                }
            }
            __builtin_amdgcn_sched_barrier(0);
        }
    }
    __device__ __forceinline__ void operator()(const f32x4 (&acc)[2][2][4][2], const pg8::Unit& u, int wr, int wc, int fr, int fq) const {
        switch (u.pn >> 1) {
            case 0: run<0>(acc, u, wr, wc, fr, fq); break;
            case 1: run<1>(acc, u, wr, wc, fr, fq); break;
            case 2: run<2>(acc, u, wr, wc, fr, fq); break;
            case 3: run<3>(acc, u, wr, wc, fr, fq); break;
            case 4: run<4>(acc, u, wr, wc, fr, fq); break;
            case 5: run<5>(acc, u, wr, wc, fr, fq); break;
            case 6: run<6>(acc, u, wr, wc, fr, fq); break;
            default: run<7>(acc, u, wr, wc, fr, fq); break;
        }
    }
};

struct EpiGate {
    static constexpr bool HAS_MID = false;
    const float* rsp; bf16_t* G;
    __device__ __forceinline__ void operator()(const f32x4 (&acc)[2][2][4][2], const pg8::Unit& u, int wr, int wc, int fr, int fq) const {
#pragma unroll
        for (int ai = 0; ai < 2; ++ai) {
            const int row0 = u.pm * 256 + ai * 128 + wr * 64 + fr;
            float rs4[4]; rows_rs4(rsp, row0, rs4);
            __builtin_amdgcn_sched_barrier(0);
#pragma unroll
            for (int m = 0; m < 4; ++m) {
                const int row = row0 + m * 16;
                const float rs = rs4[m];
                const int col = u.pn * 128 + wc * 32 + fq * 8;
                float r[8], sb[8];
                const float nrl = -rs * LOG2E;
#pragma unroll
                for (int n = 0; n < 2; ++n) {
                    f32x4 ta = acc[ai][0][m][n] * nrl, tb = acc[ai][1][m][n] * nrl;
                    ta = __builtin_elementwise_min(ta, (f32x4){86.f, 86.f, 86.f, 86.f}); tb = __builtin_elementwise_min(tb, (f32x4){86.f, 86.f, 86.f, 86.f});
                    ta.x = __builtin_amdgcn_exp2f(ta.x); ta.y = __builtin_amdgcn_exp2f(ta.y); ta.z = __builtin_amdgcn_exp2f(ta.z); ta.w = __builtin_amdgcn_exp2f(ta.w);
                    tb.x = __builtin_amdgcn_exp2f(tb.x); tb.y = __builtin_amdgcn_exp2f(tb.y); tb.z = __builtin_amdgcn_exp2f(tb.z); tb.w = __builtin_amdgcn_exp2f(tb.w);
                    ta = ta + 1.0f; tb = tb + 1.0f;
                    f32x4 ia, ib;
                    ia.x = __builtin_amdgcn_rcpf(ta.x); ia.y = __builtin_amdgcn_rcpf(ta.y); ia.z = __builtin_amdgcn_rcpf(ta.z); ia.w = __builtin_amdgcn_rcpf(ta.w);
                    ib.x = __builtin_amdgcn_rcpf(tb.x); ib.y = __builtin_amdgcn_rcpf(tb.y); ib.z = __builtin_amdgcn_rcpf(tb.z); ib.w = __builtin_amdgcn_rcpf(tb.w);
                    const f32x4 rr = tb * ia;
                    r[n * 4] = rr.x; r[n * 4 + 1] = rr.y; r[n * 4 + 2] = rr.z; r[n * 4 + 3] = rr.w;
                    sb[n * 4] = ib.x; sb[n * 4 + 1] = ib.y; sb[n * 4 + 2] = ib.z; sb[n * 4 + 3] = ib.w;
                }
                *(u32x4*)(G + (size_t)row * 2048 + col) = pack8(r);
                *(u32x4*)(G + (size_t)row * 2048 + 1024 + col) = pack8(sb);
            }
            __builtin_amdgcn_sched_barrier(0);
        }
    }
};

struct EpiY {
    static constexpr bool HAS_MID = true;
    const bf16_t* G; bf16_t* Y;
    __device__ __forceinline__ void mid(f32x4 (&acc)[2][2][4][2], const pg8::Unit& u, int wr, int wc, int fr, int fq) const {
        int fr_ = fr; asm volatile("" : "+v"(fr_));
#pragma unroll
        for (int ai = 0; ai < 2; ++ai) {
            __builtin_amdgcn_sched_barrier(0);
#pragma unroll
            for (int m = 0; m < 4; ++m) {
                const int row = u.pm * 256 + ai * 128 + wr * 64 + m * 16 + fr_;
#pragma unroll
                for (int bj = 0; bj < 2; ++bj) {
                    const int col = u.pn * 256 + bj * 128 + wc * 32 + fq * 8;
                    const u32x4 gq = *(const u32x4*)(G + (size_t)row * 2048 + col);
                    acc[ai][bj][m][0][0] *= bflo(gq.x); acc[ai][bj][m][0][1] *= bfhi(gq.x); acc[ai][bj][m][0][2] *= bflo(gq.y); acc[ai][bj][m][0][3] *= bfhi(gq.y);
                    acc[ai][bj][m][1][0] *= bflo(gq.z); acc[ai][bj][m][1][1] *= bfhi(gq.z); acc[ai][bj][m][1][2] *= bflo(gq.w); acc[ai][bj][m][1][3] *= bfhi(gq.w);
                }
            }
        }
        __builtin_amdgcn_sched_barrier(0);
    }
    __device__ __forceinline__ void operator()(const f32x4 (&acc)[2][2][4][2], const pg8::Unit& u, int wr, int wc, int fr, int fq) const {
#pragma unroll
        for (int ai = 0; ai < 2; ++ai) {
            u32x4 gqr[4][2];
#pragma unroll
            for (int m = 0; m < 4; ++m)
#pragma unroll
                for (int bj = 0; bj < 2; ++bj) gqr[m][bj] = *(const u32x4*)(G + (size_t)(u.pm * 256 + ai * 128 + wr * 64 + m * 16 + fr) * 2048 + 1024 + u.pn * 256 + bj * 128 + wc * 32 + fq * 8);
            __builtin_amdgcn_sched_barrier(0);
#pragma unroll
            for (int m = 0; m < 4; ++m) {
                const int row = u.pm * 256 + ai * 128 + wr * 64 + m * 16 + fr;
#pragma unroll
                for (int bj = 0; bj < 2; ++bj) {
                    const int col = u.pn * 256 + bj * 128 + wc * 32 + fq * 8;
                    const u32x4 gq = gqr[m][bj];
                    float v[8];
                    v[0] = acc[ai][bj][m][0][0] * bflo(gq.x); v[1] = acc[ai][bj][m][0][1] * bfhi(gq.x);
                    v[2] = acc[ai][bj][m][0][2] * bflo(gq.y); v[3] = acc[ai][bj][m][0][3] * bfhi(gq.y);
                    v[4] = acc[ai][bj][m][1][0] * bflo(gq.z); v[5] = acc[ai][bj][m][1][1] * bfhi(gq.z);
                    v[6] = acc[ai][bj][m][1][2] * bflo(gq.w); v[7] = acc[ai][bj][m][1][3] * bfhi(gq.w);
                    *(u32x4*)(Y + (size_t)row * 1024 + col) = pack8(v);
                }
            }
            __builtin_amdgcn_sched_barrier(0);
        }
    }
};

struct EpiRes {
    static constexpr bool HAS_MID = false;
    const float* xres; float* xout; bf16_t* XB; float* rsp;
    __device__ __forceinline__ void operator()(const f32x4 (&acc)[2][2][4][2], const pg8::Unit& u, int wr, int wc, int fr, int fq) const {
#pragma unroll
        for (int ai = 0; ai < 2; ++ai)
#pragma unroll
        for (int mp = 0; mp < 2; ++mp) {
            f32x4 xr0[2][2], xr1[2][2];
#pragma unroll
            for (int mm = 0; mm < 2; ++mm)
#pragma unroll
                for (int bj = 0; bj < 2; ++bj) { const float* xr = xres + (size_t)(u.pm * 256 + ai * 128 + wr * 64 + (2 * mp + mm) * 16 + fr) * Dm + u.pn * 256 + bj * 128 + wc * 32 + fq * 8;
                    xr0[mm][bj] = *(const f32x4*)xr; xr1[mm][bj] = *(const f32x4*)(xr + 4); }
            __builtin_amdgcn_sched_barrier(0);
#pragma unroll
            for (int mm = 0; mm < 2; ++mm) {
                const int m = 2 * mp + mm;
                const int row = u.pm * 256 + ai * 128 + wr * 64 + m * 16 + fr;
                float ss = 0.f;
#pragma unroll
                for (int bj = 0; bj < 2; ++bj) {
                    const int col = u.pn * 256 + bj * 128 + wc * 32 + fq * 8;
                    const f32x4 x0 = xr0[mm][bj], x1 = xr1[mm][bj];
                    float v[8];
#pragma unroll
                    for (int e = 0; e < 4; ++e) { v[e] = x0[e] + acc[ai][bj][m][0][e]; v[4 + e] = x1[e] + acc[ai][bj][m][1][e]; }
#pragma unroll
                    for (int e = 0; e < 8; ++e) ss += v[e] * v[e];
                    float* xo = xout + (size_t)row * Dm + col;
                    *(f32x4*)xo = (f32x4){v[0], v[1], v[2], v[3]}; *(f32x4*)(xo + 4) = (f32x4){v[4], v[5], v[6], v[7]};
                    *(u32x4*)(XB + (size_t)row * Dm + col) = pack8(v);
                }
                ss += __shfl_xor(ss, 16); ss += __shfl_xor(ss, 32);
                if (fq == 0) rsp[(size_t)row * 16 + u.pn * 4 + wc] = ss;
            }
            __builtin_amdgcn_sched_barrier(0);
        }
    }
};

struct EpiGU {
    static constexpr bool HAS_MID = false;
    const float* rsp; bf16_t* H;
    __device__ __forceinline__ void operator()(const f32x4 (&acc)[2][2][4][2], const pg8::Unit& u, int wr, int wc, int fr, int fq) const {
#pragma unroll
        for (int ai = 0; ai < 2; ++ai) {
            const int row0 = u.pm * 256 + ai * 128 + wr * 64 + fr;
            float rs4[4]; rows_rs4(rsp, row0, rs4);
            __builtin_amdgcn_sched_barrier(0);
#pragma unroll
            for (int m = 0; m < 4; ++m) {
                const int row = row0 + m * 16;
                const float rs = rs4[m];
                const int col = u.pn * 128 + wc * 32 + fq * 8;
                float v[8];
                const float nrl = -rs * LOG2E, rs2 = rs * rs;
#pragma unroll
                for (int n = 0; n < 2; ++n) {
                    const f32x4 a = acc[ai][0][m][n], b = acc[ai][1][m][n];
                    f32x4 t = a * nrl;
                    t.x = __builtin_amdgcn_exp2f(t.x); t.y = __builtin_amdgcn_exp2f(t.y); t.z = __builtin_amdgcn_exp2f(t.z); t.w = __builtin_amdgcn_exp2f(t.w);
                    t = t + 1.0f;
                    t.x = __builtin_amdgcn_rcpf(t.x); t.y = __builtin_amdgcn_rcpf(t.y); t.z = __builtin_amdgcn_rcpf(t.z); t.w = __builtin_amdgcn_rcpf(t.w);
                    const f32x4 o = ((a * b) * rs2) * t;
                    v[n * 4] = o.x; v[n * 4 + 1] = o.y; v[n * 4 + 2] = o.z; v[n * 4 + 3] = o.w;
                }
                *(u32x4*)(H + (size_t)row * FF + col) = pack8(v);
            }
            __builtin_amdgcn_sched_barrier(0);
        }
    }
};

__device__ __forceinline__ int rope_perm(int n) {
    const int d = n & 63; if (d >= 16) return n;
    const int g = d >> 3, e = d & 7; return (n & ~63) + ((e < 4) ? 4 * g + e : 8 + 4 * g + (e - 4));
}
__device__ __forceinline__ void conv_item(const float* src, int ld_src, int ks0, int c0  , int mode  ,
                                          const float* gain, bf16_t* dst, int ld_dst, int n0, int kd0, LAS float* scr, int lane) {
    const int n4 = lane & 7, kr = lane >> 3;
    int sc = c0 + 4 * n4;
    if (mode) { const int q = (sc & 63) >> 2; if (q == 1) sc += 4; else if (q == 2) sc -= 4; }
#pragma unroll
    for (int i = 0; i < 8; ++i) { const int kk = kr + 8 * i; f32x4 w = *(const f32x4*)(src + (size_t)(ks0 + kk) * ld_src + sc);
        if (gain) { const float gg = gain[ks0 + kk]; w.x *= gg; w.y *= gg; w.z *= gg; w.w *= gg; }
        LAS float* d = scr + kk * 33 + 4 * n4; d[0] = w.x; d[1] = w.y; d[2] = w.z; d[3] = w.w; }
    asm volatile("s_waitcnt lgkmcnt(0)" ::: "memory");
    const int c = lane & 7;
#pragma unroll
    for (int j = 0; j < 4; ++j) { const int n = (lane >> 3) + 8 * j; const LAS float* s = scr + (8 * c) * 33 + n;
        u32x4 o; o.x = pk2(s[0 * 33], s[1 * 33]); o.y = pk2(s[2 * 33], s[3 * 33]); o.z = pk2(s[4 * 33], s[5 * 33]); o.w = pk2(s[6 * 33], s[7 * 33]);
        *(u32x4*)(dst + (size_t)(n0 + n) * ld_dst + kd0 + 8 * c) = o; }
    asm volatile("s_waitcnt lgkmcnt(0)" ::: "memory");
}

struct Ptrs {
    const float *x; const int* pos; const float *w_in, *da_lambda, *da_norm, *hg_lb, *hg_norm, *w_a, *w_b, *w_o, *attn_norm, *ffn_norm, *w_gate, *w_up, *w_down, *final_norm;
    float* out; unsigned char* ws; int ph_lo, ph_hi;
};

__device__ __forceinline__ void convert_layer(const Ptrs& P, int layer, unsigned char* wbuf, LAS unsigned char* lds, int gw, int ngw, int wave, int lane) {
    LAS float* scr = (LAS float*)(lds + wave * 8704);
    constexpr int I_IN = 16 * 192, I_A = 8 * 32, I_B = 8 * 32, I_O = 16 * 32, I_GU = 16 * 176, I_D = 44 * 32;
    constexpr int NIT = I_IN + I_A + I_B + I_O + I_GU + I_D;
    for (int it = gw; it < NIT; it += ngw) {
        int r = it;
        if (r < I_IN) { const int kb = r / 192, nb = r % 192, n0 = nb * 32;
            int c0 = n0; if (n0 >= 4096) { const int q = n0 - 4096, tile = q >> 8, rr = q & 255; c0 = (rr < 128 ? 4096 : 5120) + tile * 128 + (rr & 127); }
            conv_item(P.w_in + (size_t)layer * Dm * INW, INW, kb * 64, c0, n0 < 1024 ? 1 : 0, P.attn_norm + layer * Dm, (bf16_t*)(wbuf + W_IN), Dm, n0, kb * 64, scr, lane); continue; }
        r -= I_IN;
        if (r < I_A) { const int kb = r / 32, nb = r % 32;
            conv_item(P.w_a + (size_t)layer * 512 * Dm, Dm, kb * 64, nb * 32, 0, nullptr, (bf16_t*)(wbuf + W_AB), 1024, nb * 32, kb * 64, scr, lane); continue; }
        r -= I_A;
        if (r < I_B) { const int kb = r / 32, nb = r % 32;
            conv_item(P.w_b + (size_t)layer * 512 * Dm, Dm, kb * 64, nb * 32, 0, nullptr, (bf16_t*)(wbuf + W_AB), 1024, nb * 32, 512 + kb * 64, scr, lane); continue; }
        r -= I_B;
        if (r < I_O) { const int kb = r / 32, nb = r % 32;
            conv_item(P.w_o + (size_t)layer * Dm * Dm, Dm, kb * 64, nb * 32, 0, nullptr, (bf16_t*)(wbuf + W_O2), Dm, nb * 32, kb * 64, scr, lane); continue; }
        r -= I_O;
        if (r < I_GU) { const int kb = r / 176, nb = r % 176, n0 = nb * 32, tile = n0 >> 8, rr = n0 & 255;
            const float* srcm = (rr < 128 ? P.w_gate : P.w_up) + (size_t)layer * Dm * FF;
            conv_item(srcm, FF, kb * 64, tile * 128 + (rr & 127), 0, P.ffn_norm + layer * Dm, (bf16_t*)(wbuf + W_GU), Dm, n0, kb * 64, scr, lane); continue; }
        r -= I_GU;
        { const int kb = r / 32, nb = r % 32;
            conv_item(P.w_down + (size_t)layer * FF * Dm, Dm, kb * 64, nb * 32, 0, nullptr, (bf16_t*)(wbuf + W_D), FF, nb * 32, kb * 64, scr, lane); }
    }
}

__device__ __forceinline__ float wave_sum(float v) {
#pragma unroll
    for (int o = 1; o < 64; o <<= 1) v += __shfl_xor(v, o);
    return v;
}
__device__ __forceinline__ void prologue(const Ptrs& P, LAS unsigned char* lds, int gw, int ngw, int wave, int lane) {
    unsigned char* ws = P.ws;
    bf16_t* XB = (bf16_t*)(ws + OFF_XB); float* rsb = (float*)(ws + OFF_RSB);
    for (int r = gw; r < M; r += ngw) {
        const f32x4* xr = (const f32x4*)(P.x + (size_t)r * Dm) + lane;
        float ss = 0.f;
#pragma unroll
        for (int j = 0; j < 4; ++j) { const f32x4 v = xr[64 * j]; ss += (v.x * v.x + v.y * v.y) + (v.z * v.z + v.w * v.w);
            u32x2 o; o.x = pk2(v.x, v.y); o.y = pk2(v.z, v.w); *((u32x2*)(XB + (size_t)r * Dm) + lane + 64 * j) = o; }
        ss = wave_sum(ss);
        if (lane < 16) rsb[(size_t)r * 16 + lane] = (lane == 0) ? ss : 0.f;
    }
    const int gt = gw * 64 + lane, ngt = ngw * 64;
    float* cs = (float*)(ws + OFF_CS);
    for (int i = gt; i < M * 8; i += ngt) {
        const int tok = i >> 3, f = i & 7;
        const double invf[8] = {1.0, 0.19392274474868576, 0.03760603093086393, 0.007292664737217109, 0.001414213562373095, 0.0002742481756762073, 5.318295896944988e-05, 1.031338537721246e-05};
        double fr;
        switch (f) { case 0: fr = invf[0]; break; case 1: fr = invf[1]; break; case 2: fr = invf[2]; break; case 3: fr = invf[3]; break; case 4: fr = invf[4]; break; case 5: fr = invf[5]; break; case 6: fr = invf[6]; break; default: fr = invf[7]; }
        const float ang32 = (float)P.pos[tok] * (float)fr;
        const double ang = (double)ang32;
        const double rev = ang * 0.15915494309189535;
        const double fracrev = rev - __builtin_floor(rev + 0.5);
        const float a = (float)(fracrev * 6.283185307179586);
        cs[(size_t)tok * 16 + f] = __cosf(a); cs[(size_t)tok * 16 + 8 + f] = __sinf(a);
    }
    float* LB = (float*)(ws + OFF_LB);
    for (int i = gt; i < 2 * 512; i += ngt) {
        const int d = i >> 9, k = i & 511;
        float l[4], mx = -1e30f;
#pragma unroll
        for (int j = 0; j < 4; ++j) { l[j] = P.hg_lb[(size_t)(d * 4 + j) * 512 + k]; mx = fmaxf(mx, l[j]); }
        float e[4], sum = 0.f;
#pragma unroll
        for (int j = 0; j < 4; ++j) { e[j] = __expf(l[j] - mx); sum += e[j]; }
        float cum = 0.f;
#pragma unroll
        for (int j = 0; j < 4; ++j) { if (j > 0) cum += e[j] / sum; LB[(size_t)(d * 4 + j) * 512 + k] = cum; }
    }
    if (gw == 0) {
        float* LAM = (float*)(ws + OFF_LAM);
        for (int l = 0; l < 4; ++l) {
            const float* p = P.da_lambda + l * 256;
            float a = wave_sum(p[lane] * p[64 + lane]), b = wave_sum(p[128 + lane] * p[192 + lane]);
            const float lam_init = 0.8f - 0.6f * __expf(-0.3f * (float)l);
            if (lane == 0) LAM[l] = __expf(a) - __expf(b) + lam_init;
        }
    }
}

constexpr int AT_KROW = 144, AT_VROW = 320, AT_K1 = 64 * AT_KROW, AT_V = 2 * AT_K1, AT_STG = AT_V + 64 * AT_VROW;
constexpr int AT_IMG_ROW = 132;
__device__ __forceinline__ s16x4 tr_read(const LAS unsigned char* p) { return __builtin_bit_cast(s16x4, __builtin_amdgcn_ds_read_tr16_b64_v4i16((LAS s16x4*)p)); }

__device__ __forceinline__ void attn_unit(int b, int h, int qb, const bf16_t* Q, const bf16_t* Kk, const bf16_t* V, bf16_t* AO, const float* gainA  , float one_minus_lam_init, float lam, LAS unsigned char* lds) {
    int tid_ = threadIdx.x; asm volatile("" : "+v"(tid_));
    const int tid = tid_, wave = __builtin_amdgcn_readfirstlane(tid >> 6), lane = tid & 63, c = wave >> 2, wq = wave & 3, r32 = lane & 31, hh = lane >> 5;
    const int q0 = qb * 128 + wq * 32;
    bf16x8 qf[4];
    { const bf16_t* Qp = Q + ((size_t)(((b * 4 + h) * 2 + c) * SEQ + q0 + r32)) * 64 + 8 * hh;
#pragma unroll
      for (int s = 0; s < 4; ++s) qf[s] = *(const bf16x8*)(Qp + 16 * s); }
    f32x16 o[4];
#pragma unroll
    for (int i = 0; i < 4; ++i)
#pragma unroll
        for (int e = 0; e < 16; ++e) o[i][e] = 0.f;
    float mrow = -1e30f, lrow = 0.f;
    const unsigned char* Kg0 = (const unsigned char*)(Kk + ((size_t)((b * 4 + h) * 2 + 0) * SEQ) * 64);
    const unsigned char* Kg1 = (const unsigned char*)(Kk + ((size_t)((b * 4 + h) * 2 + 1) * SEQ) * 64);
    const unsigned char* Vg = (const unsigned char*)(V + ((size_t)(b * 4 + h) * SEQ) * 128);
    const int lk = (tid >> 3) * AT_KROW + (tid & 7) * 16;
    const int lv0 = AT_V + (tid >> 4) * AT_VROW + (tid & 15) * 16, lv1 = lv0 + 32 * AT_VROW;
    u32x4 r0, r1, r2, r3;
    r0 = *(const u32x4*)(Kg0 + tid * 16); r1 = *(const u32x4*)(Kg1 + tid * 16); r2 = *(const u32x4*)(Vg + tid * 16); r3 = *(const u32x4*)(Vg + 8192 + tid * 16);
    *(LAS u32x4*)(lds + lk) = r0; *(LAS u32x4*)(lds + AT_K1 + lk) = r1; *(LAS u32x4*)(lds + lv0) = r2; *(LAS u32x4*)(lds + lv1) = r3;
    r0 = *(const u32x4*)(Kg0 + 8192 + tid * 16); r1 = *(const u32x4*)(Kg1 + 8192 + tid * 16);
    *(LAS u32x4*)(lds + AT_STG + lk) = r0; *(LAS u32x4*)(lds + AT_STG + AT_K1 + lk) = r1;
    __syncthreads();
    const int ka = c * AT_K1 + r32 * AT_KROW + hh * 16;
    const int va = AT_V + (4 * hh + ((lane & 15) >> 2)) * AT_VROW + ((lane >> 4) & 1) * 32 + (lane & 3) * 8;

#define AT_QK(sv, st) do { f32x16 t0_, t1_; _Pragma("unroll") for (int e = 0; e < 16; ++e) { t0_[e] = 0.f; t1_[e] = 0.f; } \
        _Pragma("unroll") for (int ks = 0; ks < 4; ++ks) { \
            const bf16x8 a0 = *(const LAS bf16x8*)(lds + (st) + ka + ks * 32), a1 = *(const LAS bf16x8*)(lds + (st) + ka + 32 * AT_KROW + ks * 32); \
            t0_ = __builtin_amdgcn_mfma_f32_32x32x16_bf16(a0, qf[ks], t0_, 0, 0, 0); t1_ = __builtin_amdgcn_mfma_f32_32x32x16_bf16(a1, qf[ks], t1_, 0, 0, 0); } \
        sv##0 = t0_; sv##1 = t1_; } while (0)
    f32x16 sA0, sA1, sB0, sB1;
    AT_QK(sA, 0);
#define AT_VFRAG(dst, STC, g) do { const LAS unsigned char* vb_ = lds + (STC) + va + (16 * (g)) * AT_VROW; \
        _Pragma("unroll") for (int vt = 0; vt < 4; ++vt) { const s16x4 t0 = tr_read(vb_ + vt * 64), t1 = tr_read(vb_ + vt * 64 + 8 * AT_VROW); \
            dst[vt] = (bf16x8){t0[0], t0[1], t0[2], t0[3], t1[0], t1[1], t1[2], t1[3]}; } } while (0)
#define AT_PV(vf, p) do { __builtin_amdgcn_s_setprio(1); _Pragma("unroll") for (int vt = 0; vt < 4; ++vt) o[vt] = __builtin_amdgcn_mfma_f32_32x32x16_bf16(vf[vt], p, o[vt], 0, 0, 0); __builtin_amdgcn_s_setprio(0); } while (0)
#define AT_SB __builtin_amdgcn_sched_barrier(0)
#define AT_TILE(j, s0, s1, sn, STC  , STN  ) do { \
        if ((j) + 2 < 64) { const size_t go = (size_t)((j) + 2) * 8192; r0 = *(const u32x4*)(Kg0 + go + tid * 16); r1 = *(const u32x4*)(Kg1 + go + tid * 16); } \
        if ((j) + 1 < 64) { const size_t go = (size_t)((j) + 1) * 16384; r2 = *(const u32x4*)(Vg + go + tid * 16); r3 = *(const u32x4*)(Vg + go + 8192 + tid * 16); } \
        bf16x8 kf[4], kg[4], vA[4]; \
        if ((j) + 1 < 64) { _Pragma("unroll") for (int ks = 0; ks < 2; ++ks) { kf[2 * ks] = *(const LAS bf16x8*)(lds + (STN) + ka + ks * 32); kf[2 * ks + 1] = *(const LAS bf16x8*)(lds + (STN) + ka + 32 * AT_KROW + ks * 32); } } \
        AT_SB; \
        float mx = fmaxf(s0[0], s1[0]); \
        _Pragma("unroll") for (int e = 1; e < 16; ++e) mx = fmaxf(mx, fmaxf(s0[e], s1[e])); \
        mx = fmaxf(mx, __shfl_xor(mx, 32)); \
        if (__builtin_amdgcn_ballot_w64(mx > mrow + 8.0f) != 0ull) { \
            const float mnew = fmaxf(mrow, mx), alpha = __builtin_amdgcn_exp2f(mrow - mnew); mrow = mnew; lrow *= alpha; \
            _Pragma("unroll") for (int i = 0; i < 4; ++i) _Pragma("unroll") for (int e = 0; e < 16; ++e) o[i][e] *= alpha; } \
        AT_SB; \
        if ((j) + 1 < 64) { f32x16 t0_, t1_; _Pragma("unroll") for (int e = 0; e < 16; ++e) { t0_[e] = 0.f; t1_[e] = 0.f; } \
            __builtin_amdgcn_s_setprio(1); \
            _Pragma("unroll") for (int ks = 0; ks < 2; ++ks) { t0_ = __builtin_amdgcn_mfma_f32_32x32x16_bf16(kf[2 * ks], qf[ks], t0_, 0, 0, 0); t1_ = __builtin_amdgcn_mfma_f32_32x32x16_bf16(kf[2 * ks + 1], qf[ks], t1_, 0, 0, 0); } \
            AT_SB; \
            _Pragma("unroll") for (int ks = 0; ks < 2; ++ks) { kg[2 * ks] = *(const LAS bf16x8*)(lds + (STN) + ka + (ks + 2) * 32); kg[2 * ks + 1] = *(const LAS bf16x8*)(lds + (STN) + ka + 32 * AT_KROW + (ks + 2) * 32); } \
            AT_SB; \
            _Pragma("unroll") for (int ks = 0; ks < 2; ++ks) { t0_ = __builtin_amdgcn_mfma_f32_32x32x16_bf16(kg[2 * ks], qf[ks + 2], t0_, 0, 0, 0); t1_ = __builtin_amdgcn_mfma_f32_32x32x16_bf16(kg[2 * ks + 1], qf[ks + 2], t1_, 0, 0, 0); } \
            __builtin_amdgcn_s_setprio(0); sn##0 = t0_; sn##1 = t1_; } \
        AT_VFRAG(vA, STC, 0); \
        AT_SB; \
        float ls = 0.f; \
        _Pragma("unroll") for (int e = 0; e < 16; ++e) { s0[e] = __builtin_amdgcn_exp2f(s0[e] - mrow); s1[e] = __builtin_amdgcn_exp2f(s1[e] - mrow); ls += s0[e] + s1[e]; } \
        lrow += ls; \
        bf16x8 pf[2][2]; \
        _Pragma("unroll") for (int s = 0; s < 2; ++s) { u32x4 w0, w1; \
            w0.x = pk2(s0[8 * s + 0], s0[8 * s + 1]); w0.y = pk2(s0[8 * s + 2], s0[8 * s + 3]); w0.z = pk2(s0[8 * s + 4], s0[8 * s + 5]); w0.w = pk2(s0[8 * s + 6], s0[8 * s + 7]); \
            w1.x = pk2(s1[8 * s + 0], s1[8 * s + 1]); w1.y = pk2(s1[8 * s + 2], s1[8 * s + 3]); w1.z = pk2(s1[8 * s + 4], s1[8 * s + 5]); w1.w = pk2(s1[8 * s + 6], s1[8 * s + 7]); \
            pf[0][s] = __builtin_bit_cast(bf16x8, w0); pf[1][s] = __builtin_bit_cast(bf16x8, w1); } \
        AT_SB; \
        AT_PV(vA, pf[0][0]); \
        AT_SB; \
        AT_VFRAG(vA, STC, 1); \
        AT_SB; \
        AT_PV(vA, pf[0][1]); \
        AT_SB; \
          \
        if ((j) + 2 < 64) { *(LAS u32x4*)(lds + (STC) + lk) = r0; *(LAS u32x4*)(lds + (STC) + AT_K1 + lk) = r1; } \
        if ((j) + 1 < 64) { *(LAS u32x4*)(lds + (STN) + lv0) = r2; *(LAS u32x4*)(lds + (STN) + lv1) = r3; } \
        AT_SB; \
        AT_VFRAG(vA, STC, 2); \
        AT_SB; \
        AT_PV(vA, pf[1][0]); \
        AT_SB; \
        AT_VFRAG(vA, STC, 3); \
        AT_SB; \
        AT_PV(vA, pf[1][1]); \
        __syncthreads(); } while (0)
    for (int j = 0; j < 64; j += 2) {
        AT_TILE(j, sA0, sA1, sB, 0, AT_STG);
        AT_TILE(j + 1, sB0, sB1, sA, AT_STG, 0);
    }
#undef AT_TILE
#undef AT_QK
#undef AT_VFRAG
#undef AT_PV
#undef AT_SB
    const float inv = __builtin_amdgcn_rcpf(lrow + __shfl_xor(lrow, 32));
    LAS float* img = (LAS float*)lds;
    const int qrow = wq * 32 + r32;
    if (c == 1) {
        const float sc = -lam * inv;
#pragma unroll
        for (int vt = 0; vt < 4; ++vt)
#pragma unroll
            for (int g = 0; g < 4; ++g)
                *(LAS f32x4*)(img + qrow * AT_IMG_ROW + 32 * vt + 8 * g + 4 * hh) = (f32x4){o[vt][4 * g] * sc, o[vt][4 * g + 1] * sc, o[vt][4 * g + 2] * sc, o[vt][4 * g + 3] * sc};
    }
    __syncthreads();
    if (c == 0) {
#pragma unroll
        for (int vt = 0; vt < 4; ++vt)
#pragma unroll
            for (int g = 0; g < 4; ++g) {
                LAS f32x4* p = (LAS f32x4*)(img + qrow * AT_IMG_ROW + 32 * vt + 8 * g + 4 * hh);
                f32x4 t = *p;
                t.x += o[vt][4 * g] * inv; t.y += o[vt][4 * g + 1] * inv; t.z += o[vt][4 * g + 2] * inv; t.w += o[vt][4 * g + 3] * inv;
                *p = t;
            }
    }
    __syncthreads();
    {
        const int q = tid >> 2, part = tid & 3;
        float v[32]; float ss = 0.f;
#pragma unroll
        for (int i = 0; i < 8; ++i) { const f32x4 t = *(const LAS f32x4*)(img + q * AT_IMG_ROW + 32 * part + 4 * i); v[4 * i] = t.x; v[4 * i + 1] = t.y; v[4 * i + 2] = t.z; v[4 * i + 3] = t.w;
            ss += (t.x * t.x + t.y * t.y) + (t.z * t.z + t.w * t.w); }
        ss += __shfl_xor(ss, 1); ss += __shfl_xor(ss, 2);
        const float rs = rsqrtf(ss * (1.0f / 128.0f) + EPS) * one_minus_lam_init;
        const float* gp = gainA + h * 128 + 32 * part;
        bf16_t* dst = AO + ((size_t)(b * SEQ + qb * 128 + q)) * 1024 + h * 128 + 32 * part;
#pragma unroll
        for (int i = 0; i < 4; ++i) {
            const f32x4 g0 = *(const f32x4*)(gp + 8 * i), g1 = *(const f32x4*)(gp + 8 * i + 4);
            u32x4 w; w.x = pk2(v[8 * i] * rs * g0.x, v[8 * i + 1] * rs * g0.y); w.y = pk2(v[8 * i + 2] * rs * g0.z, v[8 * i + 3] * rs * g0.w);
            w.z = pk2(v[8 * i + 4] * rs * g1.x, v[8 * i + 5] * rs * g1.y); w.w = pk2(v[8 * i + 6] * rs * g1.z, v[8 * i + 7] * rs * g1.w);
            *(u32x4*)(dst + 8 * i) = w;
        }
    }
    __syncthreads();
}

constexpr int HG_SEG = 0;
constexpr int HG_F = 2048;
constexpr int HG_PART = 2560;
constexpr int HG_V = 4096;
constexpr int HG_VROW = 288;
constexpr int HG_A = HG_V + 64 * HG_VROW;
constexpr int HG_KTROW = 144, HG_QKROW = 272;
constexpr int HG_Bq = HG_A + 128 * HG_KTROW;

__device__ __forceinline__ void hg_cumsum(const float (&gv)[16], int dir, int k, int j, LAS unsigned char* lds, float (&d)[16], float& m_out, float& tot_out) {
    float run = 0.f;
    if (dir == 0) {
#pragma unroll
        for (int i = 0; i < 16; ++i) { run += gv[i]; d[i] = run; }
    } else {
#pragma unroll
        for (int i = 15; i >= 0; --i) { run += gv[i]; d[i] = run; }
    }
    LAS float* seg = (LAS float*)(lds + HG_SEG);
    seg[j * 128 + k] = run;
    __syncthreads();
    const float s0 = seg[k], s1 = seg[128 + k], s2 = seg[256 + k], s3 = seg[384 + k];
    float off, m;
    if (dir == 0) { off = (j > 0 ? s0 : 0.f) + (j > 1 ? s1 : 0.f) + (j > 2 ? s2 : 0.f); m = s0 + s1; }
    else { off = (j < 3 ? s3 : 0.f) + (j < 2 ? s2 : 0.f) + (j < 1 ? s1 : 0.f); m = s2 + s3; }
#pragma unroll
    for (int i = 0; i < 16; ++i) d[i] = d[i] + off - m;
    m_out = m; tot_out = (s0 + s1) + (s2 + s3);
}
__device__ __forceinline__ void hg_load_v(const bf16_t* HV, int tok0, int h, LAS unsigned char* lds, int tid) {
#pragma unroll
    for (int i = 0; i < 2; ++i) { const int ch = tid + 512 * i, p = ch >> 4, part = ch & 15;
        *(LAS u32x4*)(lds + HG_V + p * HG_VROW + part * 16) = *(const u32x4*)(HV + (size_t)(tok0 + p) * 512 + h * 128 + part * 8); }
}
__device__ __forceinline__ void hg_load_g(const float* G, int tok0, int h, int k, int j, float (&gv)[16]) {
    const float* gp = G + (size_t)(tok0 + 16 * j) * 512 + h * 128 + k;
#pragma unroll
    for (int i = 0; i < 16; ++i) gv[i] = gp[(size_t)i * 512];
}

__device__ __forceinline__ void hg1_phase(int bx, int G, const float* GF, const float* GB, const bf16_t* HV, bf16_t* UT, float* Dg, float* Eg, LAS unsigned char* lds) {
    int tid_ = threadIdx.x; asm volatile("" : "+v"(tid_));
    const int tid = tid_, wave = __builtin_amdgcn_readfirstlane(tid >> 6), lane = tid & 63;
    const int k = tid & 127, j = tid >> 7, i16 = lane & 15, g4 = lane >> 4;
    float gn[16];
    if (bx < 2048) { const int u = bx, dir = u & 1, cch = (u >> 1) & 63, bh = u >> 7; hg_load_g(dir ? GB : GF, (bh >> 2) * SEQ + cch * 64, bh & 3, k, j, gn); }
    for (int u = bx; u < 2048; u += G) {
        const int dir = u & 1, cch = (u >> 1) & 63, bh = u >> 7, b = bh >> 2, h = bh & 3;
        const int tok0 = b * SEQ + cch * 64;
        float gv[16], d[16], m, tot;
#pragma unroll
        for (int i = 0; i < 16; ++i) gv[i] = gn[i];
        u32x4 vr[2];
#pragma unroll
        for (int i = 0; i < 2; ++i) { const int ch = tid + 512 * i; vr[i] = *(const u32x4*)(HV + (size_t)(tok0 + (ch >> 4)) * 512 + h * 128 + (ch & 15) * 8); }
        hg_cumsum(gv, dir, k, j, lds, d, m, tot);
        float kt[16];
#pragma unroll
        for (int i = 0; i < 16; ++i) kt[i] = (1.0f - __expf(gv[i])) * __expf(fminf(-d[i], 40.f));
        { u32x4 w0, w1;
          w0.x = pk2(kt[0], kt[1]); w0.y = pk2(kt[2], kt[3]); w0.z = pk2(kt[4], kt[5]); w0.w = pk2(kt[6], kt[7]);
          w1.x = pk2(kt[8], kt[9]); w1.y = pk2(kt[10], kt[11]); w1.z = pk2(kt[12], kt[13]); w1.w = pk2(kt[14], kt[15]);
          *(LAS u32x4*)(lds + HG_A + k * HG_KTROW + j * 32) = w0; *(LAS u32x4*)(lds + HG_A + k * HG_KTROW + j * 32 + 16) = w1; }
#pragma unroll
        for (int i = 0; i < 2; ++i) { const int ch = tid + 512 * i; *(LAS u32x4*)(lds + HG_V + (ch >> 4) * HG_VROW + (ch & 15) * 16) = vr[i]; }
        if (j == 0) { ((LAS float*)(lds + HG_F))[k] = __expf(tot - m); Dg[(size_t)u * 128 + k] = __expf(tot); Eg[(size_t)u * 128 + k] = __expf(m); }
        __syncthreads();
        if (u + G < 2048) { const int u2 = u + G, dir2 = u2 & 1, cch2 = (u2 >> 1) & 63, bh2 = u2 >> 7; hg_load_g(dir2 ? GB : GF, (bh2 >> 2) * SEQ + cch2 * 64, bh2 & 3, k, j, gn); }
        bf16x8 af[2];
#pragma unroll
        for (int s = 0; s < 2; ++s) {
            const LAS unsigned char* ap = lds + HG_A + (16 * wave + i16) * HG_KTROW + (32 * s + 4 * g4) * 2;
            const u32x2 lo = *(const LAS u32x2*)ap, hi = *(const LAS u32x2*)(ap + 32);
            af[s] = __builtin_bit_cast(bf16x8, (u32x4){lo.x, lo.y, hi.x, hi.y});
        }
        const f32x4 fsc = *(const LAS f32x4*)(lds + HG_F + (16 * wave + 4 * g4) * 4);
        const LAS unsigned char* vbase = lds + HG_V + (4 * g4 + (i16 >> 2)) * HG_VROW + (i16 & 3) * 8;
#pragma unroll
        for (int vt = 0; vt < 8; ++vt) {
            f32x4 acc = {0.f, 0.f, 0.f, 0.f};
#pragma unroll
            for (int s = 0; s < 2; ++s) {
                const s16x4 t0 = tr_read(vbase + (32 * s) * HG_VROW + vt * 32), t1 = tr_read(vbase + (32 * s + 16) * HG_VROW + vt * 32);
                const bf16x8 bv = {t0[0], t0[1], t0[2], t0[3], t1[0], t1[1], t1[2], t1[3]};
                acc = __builtin_amdgcn_mfma_f32_16x16x32_bf16(af[s], bv, acc, 0, 0, 0);
            }
            u32x2 w; w.x = pk2(acc[0] * fsc[0], acc[1] * fsc[1]); w.y = pk2(acc[2] * fsc[2], acc[3] * fsc[3]);
            *(u32x2*)(UT + ((size_t)u * 128 + 16 * vt + i16) * 128 + 16 * wave + 4 * g4) = w;
        }
        __syncthreads();
    }
}

__device__ __forceinline__ void hg2_scan(bf16_t* UT, const float* Dg, const float* Eg, int gthread, int nthreads) {
    for (int idx = gthread; idx < 32 * 4096; idx += nthreads) {
        const int chain = idx >> 12, e4 = idx & 4095, v = e4 >> 5, k0 = (e4 & 31) * 4;
        const int dir = chain & 1, bh = chain >> 1;
        float S0 = 0.f, S1 = 0.f, S2 = 0.f, S3 = 0.f;
        int u = (bh * 64 + (dir ? 63 : 0)) * 2 + dir;
        const int ustep = dir ? -2 : 2;
        u32x2 uu[4]; f32x4 dd[4], ee[4];
#pragma unroll
        for (int r = 0; r < 4; ++r) { const int ur = u + r * ustep; uu[r] = *(const u32x2*)(UT + ((size_t)ur * 128 + v) * 128 + k0); dd[r] = *(const f32x4*)(Dg + (size_t)ur * 128 + k0); ee[r] = *(const f32x4*)(Eg + (size_t)ur * 128 + k0); }
        for (int cc = 0; cc < 64; cc += 4) {
#pragma unroll
            for (int r = 0; r < 4; ++r) {
                const u32x2 uc = uu[r]; const f32x4 dc = dd[r], ec = ee[r];
                if (cc + 4 < 64) { const int un = u + 4 * ustep; uu[r] = *(const u32x2*)(UT + ((size_t)un * 128 + v) * 128 + k0); dd[r] = *(const f32x4*)(Dg + (size_t)un * 128 + k0); ee[r] = *(const f32x4*)(Eg + (size_t)un * 128 + k0); }
                u32x2 w; w.x = pk2(ec.x * S0, ec.y * S1); w.y = pk2(ec.z * S2, ec.w * S3);
                *(u32x2*)(UT + ((size_t)u * 128 + v) * 128 + k0) = w;
                S0 = dc.x * S0 + bflo(uc.x); S1 = dc.y * S1 + bfhi(uc.x); S2 = dc.z * S2 + bflo(uc.y); S3 = dc.w * S3 + bfhi(uc.y);
                u += ustep;
            }
        }
    }
}

constexpr int HG_OUT = HG_Bq + 64 * HG_QKROW;
__device__ __forceinline__ void hg3_unit(int u3, const float* GF, const float* GB, const bf16_t* HQ, const bf16_t* HV, const bf16_t* ST, const bf16_t* BG, const float* gainH, bf16_t* AO, LAS unsigned char* lds) {
    int tid_ = threadIdx.x; asm volatile("" : "+v"(tid_));
    const int tid = tid_, wave = __builtin_amdgcn_readfirstlane(tid >> 6), lane = tid & 63;
    const int cch = u3 & 63, bh = u3 >> 6, b = bh >> 2, h = bh & 3;
    const int tok0 = b * SEQ + cch * 64, k = tid & 127, j = tid >> 7;
    const int tb = wave & 3, vh = wave >> 2, i16 = lane & 15, g4 = lane >> 4;
    float gf[16], gb[16]; unsigned short qr[16];
    hg_load_g(GF, tok0, h, k, j, gf); hg_load_g(GB, tok0, h, k, j, gb);
    { const bf16_t* qp = HQ + (size_t)(tok0 + 16 * j) * 512 + h * 128 + k;
#pragma unroll
      for (int i = 0; i < 16; ++i) qr[i] = qp[(size_t)i * 512]; }
    hg_load_v(HV, tok0, h, lds, tid);
    u32x4 bgq[2];
    { const bf16_t* bgp0 = BG + (size_t)(tok0 + (tid >> 3)) * 512 + h * 128 + 16 * (tid & 7); bgq[0] = *(const u32x4*)bgp0; bgq[1] = *(const u32x4*)(bgp0 + 8); }
    bf16x8 sb[16];
    { const bf16_t* stp = ST + ((size_t)((bh * 64 + cch) * 2 + 0) * 128) * 128;
#pragma unroll
      for (int vv = 0; vv < 4; ++vv)
#pragma unroll
        for (int ks = 0; ks < 4; ++ks) sb[vv * 4 + ks] = *(const bf16x8*)(stp + (size_t)(16 * (4 * vh + vv) + i16) * 128 + 32 * ks + 8 * g4); }
    f32x4 oacc[4];
#pragma unroll
    for (int i = 0; i < 4; ++i) oacc[i] = (f32x4){0.f, 0.f, 0.f, 0.f};
#pragma unroll
    for (int dir = 0; dir < 2; ++dir) {
        float d[16], m, tot;
        hg_cumsum(dir ? gb : gf, dir, k, j, lds, d, m, tot);
#pragma unroll
        for (int i = 0; i < 16; ++i) {
            const float gvi = dir ? gb[i] : gf[i];
            const float kt = (1.0f - __expf(gvi)) * __expf(fminf(-d[i], 40.f));
            const float qt = bf2f(qr[i]) * __expf(fminf(d[i], 40.f));
            *(LAS unsigned short*)(lds + HG_A + (16 * j + i) * HG_QKROW + k * 2) = (unsigned short)f2bf(kt);
            *(LAS unsigned short*)(lds + HG_Bq + (16 * j + i) * HG_QKROW + k * 2) = (unsigned short)f2bf(qt);
        }
        __syncthreads();
        f32x4 pt[4];
#pragma unroll
        for (int sg = 0; sg < 4; ++sg) pt[sg] = (f32x4){0.f, 0.f, 0.f, 0.f};
        bf16x8 qa[4];
#pragma unroll
        for (int ks = 0; ks < 4; ++ks) qa[ks] = *(const LAS bf16x8*)(lds + HG_Bq + (16 * tb + i16) * HG_QKROW + (32 * ks + 8 * g4) * 2);
#pragma unroll
        for (int sg = 0; sg < 4; ++sg)
#pragma unroll
            for (int ks = 0; ks < 4; ++ks) {
                const bf16x8 ka = *(const LAS bf16x8*)(lds + HG_A + (16 * sg + i16) * HG_QKROW + (32 * ks + 8 * g4) * 2);
                pt[sg] = __builtin_amdgcn_mfma_f32_16x16x32_bf16(ka, qa[ks], pt[sg], 0, 0, 0);
            }
        const int tcol = 16 * tb + i16;
#pragma unroll
        for (int sg = 0; sg < 4; ++sg)
#pragma unroll
            for (int e = 0; e < 4; ++e) { const int srow = 16 * sg + 4 * g4 + e; const bool keep = dir ? (srow >= tcol) : (srow <= tcol); pt[sg][e] = keep ? pt[sg][e] : 0.f; }
        bf16x8 pa[2];
#pragma unroll
        for (int s2 = 0; s2 < 2; ++s2) {
            u32x4 w; w.x = pk2(pt[2 * s2][0], pt[2 * s2][1]); w.y = pk2(pt[2 * s2][2], pt[2 * s2][3]); w.z = pk2(pt[2 * s2 + 1][0], pt[2 * s2 + 1][1]); w.w = pk2(pt[2 * s2 + 1][2], pt[2 * s2 + 1][3]);
            pa[s2] = __builtin_bit_cast(bf16x8, w);
        }
        const LAS unsigned char* vbase = lds + HG_V + (4 * g4 + (i16 >> 2)) * HG_VROW + (i16 & 3) * 8;
#pragma unroll
        for (int vv = 0; vv < 4; ++vv) {
            const int vt = 4 * vh + vv;
#pragma unroll
            for (int s2 = 0; s2 < 2; ++s2) {
                const s16x4 t0 = tr_read(vbase + (32 * s2) * HG_VROW + vt * 32), t1 = tr_read(vbase + (32 * s2 + 16) * HG_VROW + vt * 32);
                const bf16x8 bv = {t0[0], t0[1], t0[2], t0[3], t1[0], t1[1], t1[2], t1[3]};
                oacc[vv] = __builtin_amdgcn_mfma_f32_16x16x32_bf16(pa[s2], bv, oacc[vv], 0, 0, 0);
            }
#pragma unroll
            for (int ks = 0; ks < 4; ++ks) oacc[vv] = __builtin_amdgcn_mfma_f32_16x16x32_bf16(qa[ks], sb[vv * 4 + ks], oacc[vv], 0, 0, 0);
        }
        if (dir == 0) {
            const bf16_t* stp = ST + ((size_t)((bh * 64 + cch) * 2 + 1) * 128) * 128;
#pragma unroll
            for (int vv = 0; vv < 4; ++vv)
#pragma unroll
                for (int ks = 0; ks < 4; ++ks) sb[vv * 4 + ks] = *(const bf16x8*)(stp + (size_t)(16 * (4 * vh + vv) + i16) * 128 + 32 * ks + 8 * g4);
        }
        __syncthreads();
    }
    LAS float* ot = (LAS float*)(lds + HG_OUT);
#pragma unroll
    for (int vv = 0; vv < 4; ++vv)
#pragma unroll
        for (int e = 0; e < 4; ++e) ot[(16 * tb + 4 * g4 + e) * 132 + 16 * (4 * vh + vv) + i16] = oacc[vv][e];
    __syncthreads();
    {
        const int t = tid >> 3, part = tid & 7;
        float v[16]; float ss = 0.f;
#pragma unroll
        for (int i = 0; i < 4; ++i) { const f32x4 x = *(const LAS f32x4*)(ot + t * 132 + 16 * part + 4 * i); v[4 * i] = x.x; v[4 * i + 1] = x.y; v[4 * i + 2] = x.z; v[4 * i + 3] = x.w; ss += (x.x * x.x + x.y * x.y) + (x.z * x.z + x.w * x.w); }
        ss += __shfl_xor(ss, 1); ss += __shfl_xor(ss, 2); ss += __shfl_xor(ss, 4);
        const float rs = rsqrtf(ss * (1.0f / 128.0f) + EPS);
        const float* gp = gainH + h * 128 + 16 * part;
        bf16_t* dst = AO + (size_t)(tok0 + t) * 1024 + 512 + h * 128 + 16 * part;
#pragma unroll
        for (int i = 0; i < 2; ++i) {
            const u32x4 gq = bgq[i];
            const f32x4 g0 = *(const f32x4*)(gp + 8 * i), g1 = *(const f32x4*)(gp + 8 * i + 4);
            u32x4 w;
            w.x = pk2(v[8 * i] * rs * g0.x * bflo(gq.x), v[8 * i + 1] * rs * g0.y * bfhi(gq.x)); w.y = pk2(v[8 * i + 2] * rs * g0.z * bflo(gq.y), v[8 * i + 3] * rs * g0.w * bfhi(gq.y));
            w.z = pk2(v[8 * i + 4] * rs * g1.x * bflo(gq.z), v[8 * i + 5] * rs * g1.y * bfhi(gq.z)); w.w = pk2(v[8 * i + 6] * rs * g1.z * bflo(gq.w), v[8 * i + 7] * rs * g1.w * bfhi(gq.w));
            *(u32x4*)(dst + 8 * i) = w;
        }
    }
    __syncthreads();
}

#define XB_TMO      128
#define XB_XCNT(j)  (256  + 64 * (j))
#define XB_XSUB(j)  (1280 + 64 * (j))
#define XB_XGEN(j)  (2304 + 64 * (j))
#define XB_TOP      3328
#define XB_TOPGEN   3392
#define XCD_BAR_WORDS 3456
#define XB_SPIN_CAP (1u << 18)

__device__ __forceinline__ unsigned xb_ld(unsigned* p)              { return __hip_atomic_load(p, __ATOMIC_RELAXED, __HIP_MEMORY_SCOPE_AGENT); }
__device__ __forceinline__ unsigned xb_add(unsigned* p, unsigned v) { return __hip_atomic_fetch_add(p, v, __ATOMIC_RELAXED, __HIP_MEMORY_SCOPE_AGENT); }
__device__ __forceinline__ unsigned xb_xcc_id() { return (unsigned)__builtin_amdgcn_s_getreg((3 << 11) | 20) & 0xFu; }
#define XB_SPIN(cond, bar) do { unsigned _sp = 0; while (cond) { __builtin_amdgcn_s_sleep(1); \
    if ((++_sp & 255u) == 0u) { if (xb_ld(&(bar)[XB_TMO])) break; if (_sp > XB_SPIN_CAP) { atomicAdd(&(bar)[XB_TMO], 1u); break; } } } } while (0)

struct XcdBarrier {
    unsigned* bar; unsigned x;
    volatile LAS unsigned* st;
};

__device__ __forceinline__ XcdBarrier xcd_barrier_post(unsigned* bar, volatile LAS unsigned* st) {
    XcdBarrier b; b.bar = bar; b.x = xb_xcc_id(); b.st = st;
    if (threadIdx.x == 0) (void)xb_add(&bar[XB_XCNT(b.x)], 1u);
    return b;
}
__device__ __forceinline__ void xcd_barrier_complete(unsigned* bar, unsigned x, unsigned& nloc, unsigned& nx) {
    const unsigned G = gridDim.x * gridDim.y * gridDim.z;
    unsigned sum, cnt, mine, sp = 0u;
    for (;;) {
        sum = 0u; cnt = 0u; mine = 0u;
#pragma unroll
        for (unsigned j = 0; j < 16; ++j) { const unsigned c = xb_ld(&bar[XB_XCNT(j)]); sum += c; cnt += (c > 0u) ? 1u : 0u; mine = (j == x) ? c : mine; }
        if (sum == G) break;
        __builtin_amdgcn_s_sleep(1);
        if ((++sp & 255u) == 0u) { if (xb_ld(&bar[XB_TMO])) break; if (sp > XB_SPIN_CAP) { atomicAdd(&bar[XB_TMO], 1u); break; } }
    }
    nloc = mine > 0u ? mine : 1u; nx = cnt > 0u ? cnt : 1u;
}

__device__ __forceinline__ void xcd_barrier(const XcdBarrier& b) {
    asm volatile("s_waitcnt vmcnt(0)" ::: "memory");
    __syncthreads();
    if (threadIdx.x == 0) {
        unsigned* bar = b.bar;
        __builtin_amdgcn_s_waitcnt(0);
        unsigned nloc = b.st[0], nx = b.st[1];
        if (nloc == 0u) { xcd_barrier_complete(bar, b.x, nloc, nx); b.st[0] = nloc; b.st[1] = nx; }
        const unsigned old = xb_add(&bar[XB_XSUB(b.x)], 1u);
        const unsigned gen = old / nloc;
        if (old + 1u == (gen + 1u) * nloc) {
            __builtin_amdgcn_fence(__ATOMIC_RELEASE, "agent");
            asm volatile("s_waitcnt vmcnt(0)" ::: "memory");
            const unsigned og = xb_add(&bar[XB_TOP], 1u);
            const unsigned tg = og / nx;
            if (og + 1u == (tg + 1u) * nx) xb_add(&bar[XB_TOPGEN], 1u);
            else XB_SPIN(xb_ld(&bar[XB_TOPGEN]) == tg, bar);
            __builtin_amdgcn_fence(__ATOMIC_ACQUIRE, "agent");
            xb_add(&bar[XB_XGEN(b.x)], 1u);
            asm volatile("s_waitcnt vmcnt(0)" ::: "memory");
        } else {
            XB_SPIN(xb_ld(&bar[XB_XGEN(b.x)]) == gen, bar);
            __builtin_amdgcn_fence(__ATOMIC_ACQUIRE, "agent");
            asm volatile("s_waitcnt vmcnt(0)" ::: "memory");
        }
    }
    __syncthreads();
}

__global__ void __launch_bounds__(512, 2) fwd_kernel(Ptrs Pk) {
    extern __shared__ __attribute__((aligned(16))) unsigned char lds_raw[];
    LAS unsigned char* lds = (LAS unsigned char*)lds_raw;
    cg::grid_group grid = cg::this_grid();
    const int G = gridDim.x, bx = blockIdx.x;
    const int lo = Pk.ph_lo, hi = Pk.ph_hi;
    int ph = 0;
    if (threadIdx.x < 4) ((LAS unsigned*)(lds + 131072 + 1024))[threadIdx.x] = 0u;
    __syncthreads();
    XcdBarrier xbar = xcd_barrier_post((unsigned*)(Pk.ws + OFF_BAR), (volatile LAS unsigned*)(lds + 131072 + 1024));
#ifdef TS_A
    if (threadIdx.x == 0) { LAS unsigned long long* TS_ = (LAS unsigned long long*)(lds + 131072); for (int i = 0; i < 15; ++i) TS_[i] = 0ull; TS_[15] = __builtin_amdgcn_s_memrealtime(); }
#endif
#ifndef PH_MASK
#define PH_MASK 0xFFFFFFFFu
#endif
#define ON(id) constexpr (((PH_MASK) >> (id)) & 1u)
#if defined(__HIP_DEVICE_COMPILE__)
#define LOAD_ARGS(P) int zoff_ = 0; asm volatile("" : "+s"(zoff_)); const Ptrs P = *(const __attribute__((address_space(4))) Ptrs*)((const __attribute__((address_space(4))) char*)__builtin_amdgcn_kernarg_segment_ptr() + zoff_);
#else
#define LOAD_ARGS(P) const Ptrs P = Pk;
#endif
#define PHASE_BEGIN if (ph >= lo && ph < hi) { LOAD_ARGS(P) unsigned char* ws = P.ws; asm volatile("" : "+s"(ws)); int tid = threadIdx.x; asm volatile("" : "+v"(tid)); \
    const int lane = tid & 63, wave = __builtin_amdgcn_readfirstlane(tid >> 6), gw = bx * 8 + wave, ngw = G * 8; (void)lane; (void)gw; (void)ngw;
#define XB ((bf16_t*)(ws + OFF_XB))
#define RSA ((float*)(ws + OFF_RSA))
#define RSB ((float*)(ws + OFF_RSB))
#define CS ((const float*)(ws + OFF_CS))
#define LB ((const float*)(ws + OFF_LB))
#define LAM ((const float*)(ws + OFF_LAM))
#define Dg ((float*)(ws + OFF_DG))
#define Eg ((float*)(ws + OFF_EG))
#define GATE ((bf16_t*)(ws + OFF_GATE))
#define Qb ((bf16_t*)(ws + OFF_Q))
#define Kb ((bf16_t*)(ws + OFF_K))
#define Vb ((bf16_t*)(ws + OFF_V))
#define HQ ((bf16_t*)(ws + OFF_HQ))
#define HV ((bf16_t*)(ws + OFF_HV))
#define GF ((float*)(ws + OFF_GF))
#define GB ((float*)(ws + OFF_GB))
#define Yb ((bf16_t*)(ws + OFF_Y))
#define BG ((bf16_t*)(ws + OFF_BG))
#define AO ((bf16_t*)(ws + OFF_AO))
#define UT ((bf16_t*)(ws + OFF_UT))
#define Hb ((bf16_t*)(ws + OFF_H))
#ifdef TS_A
#define TICK(cat) do { if (bx == 0 && threadIdx.x == 0) { LAS unsigned long long* TS_ = (LAS unsigned long long*)(lds + 131072); const unsigned long long t_ = __builtin_amdgcn_s_memrealtime(); TS_[cat] += t_ - TS_[15]; TS_[15] = t_; } } while (0)
#else
#define TICK(cat) do { } while (0)
#endif
#define PHASE_END(cat)   TICK(cat); if (ph + 1 < hi) { if (ph == 0) grid.sync(); else xcd_barrier(xbar); TICK(13); } } ++ph;

    PHASE_BEGIN
        if ON(0) prologue(P, lds, gw, ngw, wave, lane);
        if ON(6) convert_layer(P, 0, ws, lds, gw, ngw, wave, lane);
    PHASE_END(0)

    for (int layer = 0; layer < DEPTH; ++layer) {
        PHASE_BEGIN
            pg8::Gemm g{XB, (const bf16_t*)(ws + (size_t)(layer & 1) * WSZ + W_IN), Dm, Dm, Dm, 1 << 30, 0, -1};
            pg8::StaticOrder S; S.init(M, 4096, G, bx);
            EpiMix E{RSB, CS, LB + (0 * 4 + layer) * 512, LB + (1 * 4 + layer) * 512, Qb, Kb, Vb, HQ, HV, BG, GF, GB};
            if ON(1) pg8::gemm_phase(lds, g, S, E);
        PHASE_END(1)
        PHASE_BEGIN
            const float lam_init = 0.8f - 0.6f * __expf(-0.3f * (float)layer);
            const float lam = LAM[layer];
            if ON(2) for (int i = 0; i * G + bx < 512; ++i) {
                const int uid = i * G + bx; const int round = uid >> 8, r = uid & 255;
                const int bhh = round * 8 + (r & 7), qb = r >> 3;
                attn_unit(bhh >> 2, bhh & 3, qb, Qb, Kb, Vb, AO, P.da_norm + layer * 512, 1.0f - lam_init, lam, lds);
            }
            TICK(2);
            if ON(3) hg1_phase(bx, G, GF, GB, HV, UT, Dg, Eg, lds);
        PHASE_END(3)
        PHASE_BEGIN
            {
                pg8::Gemm g{XB, (const bf16_t*)(ws + (size_t)(layer & 1) * WSZ + W_IN) + (size_t)4096 * Dm, Dm, Dm, Dm, 1 << 30, 0, -1};
                pg8::StaticOrder S; S.init(M, 2048, G, bx);
                EpiGate E{RSB, GATE};
                if ON(4) pg8::gemm_phase(lds, g, S, E);
            }
            TICK(4);
            if ON(5) hg2_scan(UT, Dg, Eg, bx * 512 + tid, G * 512);
            TICK(5);
            if ON(6) if (layer + 1 < DEPTH) convert_layer(P, layer + 1, ws + (size_t)((layer + 1) & 1) * WSZ, lds, gw, ngw, wave, lane);
        PHASE_END(6)
        PHASE_BEGIN
            if ON(7) for (int u = bx; u < 1024; u += G) hg3_unit(u, GF, GB, HQ, HV, UT, BG, P.hg_norm + layer * 512, AO, lds);
        PHASE_END(7)
        PHASE_BEGIN
            pg8::Gemm g{AO, (const bf16_t*)(ws + (size_t)(layer & 1) * WSZ + W_AB), 1024, 1024, 1024, 1 << 30, 0, 8};
            pg8::StaticOrder S; S.init(M, 1024, G, bx);
            EpiY E{GATE, Yb};
            if ON(8) pg8::gemm_phase(lds, g, S, E);
        PHASE_END(8)
        PHASE_BEGIN
            pg8::Gemm g{Yb, (const bf16_t*)(ws + (size_t)(layer & 1) * WSZ + W_O2), 1024, 1024, 1024, 1 << 30, 0, -1};
            pg8::StaticOrder S; S.init(M, Dm, G, bx);
            EpiRes E{layer == 0 ? P.x : P.out, P.out, XB, RSA};
            if ON(9) pg8::gemm_phase(lds, g, S, E);
        PHASE_END(9)
        PHASE_BEGIN
            pg8::Gemm g{XB, (const bf16_t*)(ws + (size_t)(layer & 1) * WSZ + W_GU), Dm, Dm, Dm, 1 << 30, 0, -1};
            pg8::StaticOrder S; S.init(M, 2 * FF, G, bx);
            EpiGU E{RSA, Hb};
            if ON(10) pg8::gemm_phase(lds, g, S, E);
        PHASE_END(10)
        PHASE_BEGIN
            pg8::Gemm g{Hb, (const bf16_t*)(ws + (size_t)(layer & 1) * WSZ + W_D), FF, FF, FF, 1 << 30, 0, -1};
            pg8::StaticOrder S; S.init(M, Dm, G, bx);
            EpiRes E{P.out, P.out, XB, RSB};
            if ON(11) pg8::gemm_phase(lds, g, S, E);
        PHASE_END(11)
    }
    PHASE_BEGIN
        if ON(12) for (int r = gw; r < M; r += ngw) {
            f32x4* xr = (f32x4*)(P.out + (size_t)r * Dm) + lane;
            f32x4 v[4]; float ss = 0.f;
#pragma unroll
            for (int j = 0; j < 4; ++j) { v[j] = xr[64 * j]; ss += (v[j].x * v[j].x + v[j].y * v[j].y) + (v[j].z * v[j].z + v[j].w * v[j].w); }
            const float rs = rsqrtf(wave_sum(ss) * (1.0f / Dm) + EPS);
#pragma unroll
            for (int j = 0; j < 4; ++j) { const f32x4 gn = *((const f32x4*)P.final_norm + lane + 64 * j); xr[64 * j] = (f32x4){v[j].x * rs * gn.x, v[j].y * rs * gn.y, v[j].z * rs * gn.z, v[j].w * rs * gn.w}; }
        }
    PHASE_END(12)
#ifdef TS_A
    if (bx == 0 && threadIdx.x == 0) {
        LAS unsigned long long* TS_ = (LAS unsigned long long*)(lds + 131072);
        unsigned long long a = 0;
        for (int i = 0; i < 15; ++i) { if ((TS_A >> i) & 1) a += TS_[i]; }
        const unsigned long long t_end = __builtin_amdgcn_s_memrealtime() + a;
        while (__builtin_amdgcn_s_memrealtime() < t_end) __builtin_amdgcn_s_sleep(20);
    }
#endif
}
constexpr int NPHASES = 2 + 8 * DEPTH;

#ifndef MK_PER_PHASE
#define MK_PER_PHASE 0
#endif

extern "C" void kernel_launch(void* const* d_in, const int* in_sizes, int n_in, void* d_out, int out_size, void* d_ws, size_t ws_size, hipStream_t stream) {
    static int grid = 0;
    if (grid == 0) {
        if (n_in != 16 || out_size != M * Dm || ws_size < WS_END) { fprintf(stderr, "kernel_launch: unexpected sizes (n_in %d, out %d, ws %zu, need %zu)\n", n_in, out_size, ws_size, (size_t)WS_END); grid = -1; return; }
        int dev = 0, cus = 0, per_cu = 0;
        (void)hipGetDevice(&dev);
        (void)hipDeviceGetAttribute(&cus, hipDeviceAttributeMultiprocessorCount, dev);
        if (hipFuncSetAttribute((const void*)fwd_kernel, hipFuncAttributeMaxDynamicSharedMemorySize, LDS_BYTES) != hipSuccess) { fprintf(stderr, "kernel_launch: hipFuncSetAttribute failed\n"); grid = -1; return; }
        (void)hipOccupancyMaxActiveBlocksPerMultiprocessor(&per_cu, (const void*)fwd_kernel, 512, LDS_BYTES);
        (void)hipGetLastError();
        if (per_cu < 1) per_cu = 1;
        grid = cus * 1;
        fprintf(stderr, "kernel_launch: grid %d (per_cu %d), ws %zu need %zu\n", grid, per_cu, ws_size, (size_t)WS_END);
    }
    if (grid < 0) return;
    Ptrs p{};
    p.x = (const float*)d_in[0]; p.pos = (const int*)d_in[1]; p.w_in = (const float*)d_in[2]; p.da_lambda = (const float*)d_in[3]; p.da_norm = (const float*)d_in[4];
    p.hg_lb = (const float*)d_in[5]; p.hg_norm = (const float*)d_in[6]; p.w_a = (const float*)d_in[7]; p.w_b = (const float*)d_in[8]; p.w_o = (const float*)d_in[9];
    p.attn_norm = (const float*)d_in[10]; p.ffn_norm = (const float*)d_in[11]; p.w_gate = (const float*)d_in[12]; p.w_up = (const float*)d_in[13]; p.w_down = (const float*)d_in[14];
    p.final_norm = (const float*)d_in[15];
    p.out = (float*)d_out; p.ws = (unsigned char*)d_ws;
    (void)hipMemsetAsync((char*)d_ws + OFF_BAR, 0, BAR_BYTES, stream);
#if MK_PER_PHASE
    for (int ph = 0; ph < NPHASES; ++ph) {
        p.ph_lo = ph; p.ph_hi = ph + 1;
        hipLaunchKernelGGL(fwd_kernel, dim3(grid), dim3(512), LDS_BYTES, stream, p);
    }
#else
    p.ph_lo = 0; p.ph_hi = NPHASES;
    void* args[] = {&p};
    hipError_t e = hipLaunchCooperativeKernel((const void*)fwd_kernel, dim3(grid), dim3(512), args, LDS_BYTES, stream);
    if (e != hipSuccess) fprintf(stderr, "cooperative launch failed: %s (grid %d)\n", hipGetErrorString(e), grid);
#endif
}
```

```cpp
#include <hip/hip_runtime.h>
#include <hip/hip_cooperative_groups.h>
#include <cstdio>
#include <cstdint>
namespace cg = cooperative_groups;

#define LAS __attribute__((address_space(3)))
typedef unsigned short bf16_t;
typedef short bf16x8 __attribute__((ext_vector_type(8)));
typedef short s16x4 __attribute__((ext_vector_type(4)));
typedef float f32x4 __attribute__((ext_vector_type(4)));
typedef float f32x16 __attribute__((ext_vector_type(16)));
typedef unsigned u32x4 __attribute__((ext_vector_type(4)));
typedef unsigned u32x2 __attribute__((ext_vector_type(2)));

constexpr int Dm = 1024, NB = 4, SEQ = 4096, M = NB * SEQ, DEPTH = 4, FF = 2816, INW = 6144;
constexpr float EPS = 1e-6f;
constexpr float LOG2E = 1.4426950408889634f;

constexpr size_t W_IN = 0, W_AB = 12582912, W_O2 = 14680064, W_GU = 18874368, W_D = 30408704, WSZ = 36175872;
constexpr size_t MiB = 1048576;
constexpr size_t OFF_XB = 2 * WSZ;
constexpr size_t OFF_RSA = OFF_XB + 32 * MiB;
constexpr size_t OFF_RSB = OFF_RSA + MiB;
constexpr size_t OFF_CS = OFF_RSB + MiB;
constexpr size_t OFF_LB = OFF_CS + MiB;
constexpr size_t OFF_LAM = OFF_LB + 16384;
constexpr size_t OFF_DG = OFF_LAM + 256;
constexpr size_t OFF_EG = OFF_DG + MiB;
constexpr size_t OFF_B = OFF_EG + MiB;
constexpr size_t OFF_GATE = OFF_B;
constexpr size_t OFF_Q = OFF_B, OFF_K = OFF_B + 16 * MiB, OFF_V = OFF_B + 32 * MiB;
constexpr size_t OFF_HQ = OFF_B + 64 * MiB;
constexpr size_t OFF_HV = OFF_HQ + 16 * MiB;
constexpr size_t OFF_GF = OFF_HV + 16 * MiB;
constexpr size_t OFF_GB = OFF_GF + 32 * MiB;
constexpr size_t OFF_Y = OFF_GF;
constexpr size_t OFF_BG = OFF_GB + 32 * MiB;
constexpr size_t OFF_AO = OFF_BG + 16 * MiB;
constexpr size_t OFF_UT = OFF_AO + 32 * MiB;
constexpr size_t OFF_H = OFF_B;
constexpr size_t OFF_BAR = OFF_UT + 64 * MiB;
constexpr size_t BAR_BYTES = 16384;
constexpr size_t WS_END = OFF_BAR + BAR_BYTES;

constexpr int LDS_BYTES = 131072 + 2048;

__device__ __forceinline__ unsigned f2bf(float f) { unsigned u = __builtin_bit_cast(unsigned, f); return (u + 0x7fffu + ((u >> 16) & 1u)) >> 16; }
typedef float f32x2_t __attribute__((ext_vector_type(2)));
typedef __bf16 bf16x2_t __attribute__((ext_vector_type(2)));
__device__ __forceinline__ unsigned pk2(float lo, float hi) { f32x2_t v = {lo, hi}; bf16x2_t b = __builtin_convertvector(v, bf16x2_t); return __builtin_bit_cast(unsigned, b); }
__device__ __forceinline__ float bf2f(unsigned short b) { return __builtin_bit_cast(float, (unsigned)b << 16); }
__device__ __forceinline__ float bflo(unsigned u) { return __builtin_bit_cast(float, u << 16); }
__device__ __forceinline__ float bfhi(unsigned u) { return __builtin_bit_cast(float, u & 0xffff0000u); }
__device__ __forceinline__ float sigmoidf_(float x) { return __builtin_amdgcn_rcpf(1.0f + __expf(-x)); }

namespace pg8 {
constexpr int BM = 256, BK = 64, HALF = 128, HTB = HALF * BK * 2, STAGE_BYTES = 8 * HTB, NXCD = 8, WGM = 8;
__host__ __device__ __forceinline__ int lds_byte(int r, int c) { const int st = (r >> 4) * 2 + (c >> 5), rr = r & 15, cc = c & 31, ob = rr * 64 + cc * 2; return st * 1024 + (ob ^ (((ob >> 9) & 1) << 5)); }
__host__ __device__ __forceinline__ void stage_rc(int b, int& R, int& C) { const int st = b / 1024, sb = b % 1024, swz = sb ^ (((sb >> 9) & 1) << 5); R = (st >> 1) * 16 + swz / 64; C = (st & 1) * 32 + (swz % 64) / 2; }
__host__ __device__ __forceinline__ int perm32(int rho) { const int n = rho >> 4, i = rho & 15; return 8 * (i >> 2) + 4 * n + (i & 3); }

struct Unit { int pm, pn; };
struct Gemm { const bf16_t* A; const bf16_t* Bt; int lda, ldb, K; int split_pn; int split_aoff; int mid_t; };

struct StaticOrder {
    int nM, nN, nwg, G, c;
    __device__ __forceinline__ void init(int M_, int N_, int G_, int c_) { nM = M_ / BM; nN = N_ / BM; nwg = nM * nN; G = G_; c = c_; }
    __device__ bool next(int i, Unit& u) const {
        const long L = (long)i * G + c; if (L >= nwg) return false;
        int wgid = (int)L; { const int q = nwg / NXCD, r = nwg % NXCD, xcd = wgid % NXCD, off = wgid / NXCD; wgid = (xcd < r ? xcd * (q + 1) : r * (q + 1) + (xcd - r) * q) + off; }
        const int nig = WGM * nN, gid = wgid / nig, fm = gid * WGM, gsz = (nM - fm) < WGM ? (nM - fm) : WGM;
        u.pm = fm + ((wgid % nig) % gsz); u.pn = (wgid % nig) / gsz; return true;
    }
};

template <class Epi>
__device__ __forceinline__ void gemm_phase(LAS unsigned char* lds, const Gemm g, const StaticOrder& S, const Epi& E) {
    int tid_ = threadIdx.x; asm volatile("" : "+v"(tid_));
    const int tid = tid_, wid = __builtin_amdgcn_readfirstlane(tid >> 6), lane = tid & 63, wr = wid >> 2, wc = wid & 3, fr = lane & 15, fq = lane >> 4;
    const int K = g.K, nt = K / BK;
    unsigned voffA[2], voffB[2];
#pragma unroll
    for (int i = 0; i < 2; ++i) { int R, C; stage_rc(tid * 16 + i * 8192, R, C); const int Rb = (R & ~31) + perm32(R & 31);
        voffA[i] = (unsigned)(R * g.lda + C) * 2u; voffB[i] = (unsigned)(Rb * g.ldb + C) * 2u; }
    const size_t kstep = (size_t)(BK * 2);
    const size_t hstepA = (size_t)HALF * g.lda * 2, hstepB = (size_t)HALF * g.ldb * 2;
    const size_t tstepA = 2 * hstepA, tstepB = 2 * hstepB;
    const unsigned ldsw = (unsigned)wid * 1024u;
    const int aoff = lds_byte(wr * 64 + fr, fq * 8), boff = lds_byte(wc * 32 + fr, fq * 8);
#define PG8_SA(b, h) (((b) * 2 + (h)) * HTB)
#define PG8_SB(b, h) ((4 + (b) * 2 + (h)) * HTB)
#define PG8_STAGE(bufoff, gbase, voff) do { _Pragma("unroll") for (int _i = 0; _i < 2; ++_i) \
        __builtin_amdgcn_global_load_lds((const unsigned*)((const char*)(gbase) + (voff)[_i]), (LAS unsigned*)(lds + (bufoff) + ldsw + _i * 8192), 16, 0, 0); } while (0)
#define PG8_LDA(dst, b, h) do { _Pragma("unroll") for (int m = 0; m < 4; ++m) _Pragma("unroll") for (int k = 0; k < 2; ++k) dst[m][k] = *(const LAS bf16x8*)(lds + PG8_SA(b, h) + aoff + m * 2048 + k * 1024); } while (0)
#define PG8_LDB(dst, b, h) do { _Pragma("unroll") for (int n = 0; n < 2; ++n) _Pragma("unroll") for (int k = 0; k < 2; ++k) dst[n][k] = *(const LAS bf16x8*)(lds + PG8_SB(b, h) + boff + n * 2048 + k * 1024); } while (0)
#define PG8_MMA(ai, bj, At, Bt) do { __builtin_amdgcn_s_setprio(1); _Pragma("unroll") for (int m = 0; m < 4; ++m) _Pragma("unroll") for (int n = 0; n < 2; ++n) _Pragma("unroll") for (int k = 0; k < 2; ++k) \
        acc[ai][bj][m][n] = __builtin_amdgcn_mfma_f32_16x16x32_bf16(Bt[n][k], At[m][k], acc[ai][bj][m][n], 0, 0, 0); __builtin_amdgcn_s_setprio(0); } while (0)
#define PG8_WAIT_V(n) asm volatile("s_waitcnt vmcnt(" #n ")" ::: "memory")
#define PG8_WAIT_L(n) asm volatile("s_waitcnt lgkmcnt(" #n ")" ::: "memory")
#define PG8_BAR __builtin_amdgcn_s_barrier()
#define PG8_SCHED __builtin_amdgcn_sched_barrier(0)
#define PG8_UA(u) ((const char*)g.A + (size_t)(u).pm * tstepA + (((u).pn >= g.split_pn) ? (size_t)g.split_aoff * 2 : (size_t)0))
    Unit cur, nxt; int ui = 0;
    if (!S.next(0, cur)) return;
    f32x4 acc[2][2][4][2];
#pragma unroll
    for (int a = 0; a < 2; ++a)
#pragma unroll
        for (int b = 0; b < 2; ++b)
#pragma unroll
            for (int m = 0; m < 4; ++m)
#pragma unroll
                for (int n = 0; n < 2; ++n) acc[a][b][m][n] = (f32x4){0.f, 0.f, 0.f, 0.f};
    bf16x8 At[4][2], B0[2][2], B1[2][2];
    const char* cA = PG8_UA(cur); const char* cB = (const char*)g.Bt + (size_t)cur.pn * tstepB;
    PG8_STAGE(PG8_SB(0, 0), cB, voffB); PG8_STAGE(PG8_SB(0, 1), cB + hstepB, voffB); PG8_STAGE(PG8_SA(0, 0), cA, voffA); PG8_STAGE(PG8_SA(0, 1), cA + hstepA, voffA);
    if (wr == 1) PG8_BAR;
    PG8_WAIT_V(2); PG8_BAR;
    PG8_STAGE(PG8_SB(1, 0), cB + kstep, voffB); PG8_STAGE(PG8_SA(1, 0), cA + kstep, voffA); PG8_STAGE(PG8_SB(1, 1), cB + hstepB + kstep, voffB);
    PG8_WAIT_V(6); PG8_BAR;
    for (;;) {
        const bool has_next = S.next(ui + 1, nxt);
        const char* nA = has_next ? PG8_UA(nxt) : cA; const char* nB = has_next ? (const char*)g.Bt + (size_t)nxt.pn * tstepB : cB;
        for (int t = 0; t < nt; t += 2) {
            if constexpr (Epi::HAS_MID) { if (t == g.mid_t) E.mid(acc, cur, wr, wc, fr, fq); }
            const bool last = (t == nt - 2);
            const char* a1 = cA + (size_t)(t + 1) * kstep;
            const char* a2 = last ? nA : cA + (size_t)(t + 2) * kstep; const char* b2 = last ? nB : cB + (size_t)(t + 2) * kstep;
            const char* a3 = a2 + kstep; const char* b3 = b2 + kstep;
            PG8_LDB(B0, 0, 0); PG8_LDB(B1, 0, 1); PG8_SCHED; PG8_LDA(At, 0, 0); PG8_STAGE(PG8_SA(1, 1), a1 + hstepA, voffA);
            PG8_WAIT_V(8); PG8_WAIT_L(0); PG8_BAR; PG8_MMA(0, 0, At, B0); PG8_MMA(0, 1, At, B1); PG8_BAR; PG8_SCHED;
            PG8_LDA(At, 0, 1); PG8_STAGE(PG8_SB(0, 0), b2, voffB); PG8_STAGE(PG8_SB(0, 1), b2 + hstepB, voffB); PG8_STAGE(PG8_SA(0, 0), a2, voffA);
            PG8_WAIT_V(8); PG8_WAIT_L(0); PG8_BAR; PG8_MMA(1, 0, At, B0); PG8_MMA(1, 1, At, B1); PG8_BAR; PG8_SCHED;
            PG8_LDB(B0, 1, 0); PG8_LDB(B1, 1, 1); PG8_SCHED; PG8_LDA(At, 1, 0); PG8_STAGE(PG8_SA(0, 1), a2 + hstepA, voffA);
            PG8_WAIT_V(8); PG8_WAIT_L(0); PG8_BAR; PG8_MMA(0, 0, At, B0); PG8_MMA(0, 1, At, B1); PG8_BAR; PG8_SCHED;
            PG8_LDA(At, 1, 1); PG8_STAGE(PG8_SB(1, 0), b3, voffB); PG8_STAGE(PG8_SB(1, 1), b3 + hstepB, voffB); PG8_STAGE(PG8_SA(1, 0), a3, voffA);
            PG8_WAIT_V(8); PG8_WAIT_L(0); PG8_BAR; PG8_MMA(1, 0, At, B0); PG8_MMA(1, 1, At, B1); PG8_BAR; PG8_SCHED;
        }
        if (wr == 0) PG8_BAR;
        E(acc, cur, wr, wc, fr, fq);
        if (!has_next) break;
#pragma unroll
        for (int a = 0; a < 2; ++a)
#pragma unroll
            for (int b = 0; b < 2; ++b)
#pragma unroll
                for (int m = 0; m < 4; ++m)
#pragma unroll
                    for (int n = 0; n < 2; ++n) acc[a][b][m][n] = (f32x4){0.f, 0.f, 0.f, 0.f};
        cur = nxt; cA = nA; cB = nB; ++ui;
        if (wr == 1) PG8_BAR;
    }
    PG8_WAIT_V(0);
    PG8_BAR;
#undef PG8_SA
#undef PG8_SB
#undef PG8_STAGE
#undef PG8_LDA
#undef PG8_LDB
#undef PG8_MMA
#undef PG8_UA
}
}

__device__ __forceinline__ float row_rs(const float* rsp, int row) {
    const f32x4* p = (const f32x4*)(rsp + (size_t)row * 16);
    f32x4 a = p[0], b = p[1], c = p[2], d = p[3];
    float s = ((a.x + a.y) + (a.z + a.w)) + ((b.x + b.y) + (b.z + b.w)) + ((c.x + c.y) + (c.z + c.w)) + ((d.x + d.y) + (d.z + d.w));
    return __builtin_amdgcn_rsqf(s * (1.0f / Dm) + EPS);
}
__device__ __forceinline__ void rows_rs4(const float* rsp, int row0  , float (&rs)[4]) {
#pragma unroll
    for (int mp = 0; mp < 2; ++mp) {
        f32x4 p[2][4];
#pragma unroll
        for (int m = 0; m < 2; ++m) { const f32x4* q = (const f32x4*)(rsp + (size_t)(row0 + 16 * (2 * mp + m)) * 16);
#pragma unroll
            for (int i = 0; i < 4; ++i) p[m][i] = q[i]; }
#pragma unroll
        for (int m = 0; m < 2; ++m) { float t = 0.f;
#pragma unroll
            for (int i = 0; i < 4; ++i) t += (p[m][i].x + p[m][i].y) + (p[m][i].z + p[m][i].w);
            rs[2 * mp + m] = __builtin_amdgcn_rsqf(t * (1.0f / Dm) + EPS); }
        __builtin_amdgcn_sched_barrier(0);
    }
}
__device__ __forceinline__ void rows_rs2(const float* rsp, int row0, float (&rs)[2]) {
    f32x4 p[2][4];
#pragma unroll
    for (int m = 0; m < 2; ++m) { const f32x4* q = (const f32x4*)(rsp + (size_t)(row0 + 16 * m) * 16);
#pragma unroll
        for (int i = 0; i < 4; ++i) p[m][i] = q[i]; }
#pragma unroll
    for (int m = 0; m < 2; ++m) { float t = 0.f;
#pragma unroll
        for (int i = 0; i < 4; ++i) t += (p[m][i].x + p[m][i].y) + (p[m][i].z + p[m][i].w);
        rs[m] = __builtin_amdgcn_rsqf(t * (1.0f / Dm) + EPS); }
}
__device__ __forceinline__ u32x4 pack8(const float* v) { u32x4 w; w.x = pk2(v[0], v[1]); w.y = pk2(v[2], v[3]); w.z = pk2(v[4], v[5]); w.w = pk2(v[6], v[7]); return w; }

struct EpiMix {
    static constexpr bool HAS_MID = false;
    const float* rsp; const float* cs; const float* lbF; const float* lbB;
    bf16_t *Q, *Kk, *V, *HQ, *HV, *BG; float *GF, *GB;
    template <int GRP>
    __device__ __forceinline__ void run(const f32x4 (&acc)[2][2][4][2], const pg8::Unit& u, int wr, int wc, int fr, int fq) const {
#pragma unroll
        for (int ai = 0; ai < 2; ++ai)
#pragma unroll
        for (int mp = 0; mp < 2; ++mp) {
            const int row0 = u.pm * 256 + ai * 128 + wr * 64 + mp * 32 + fr;
            float rs4[2]; rows_rs2(rsp, row0, rs4);
            const int d0r = (wc * 32 + fq * 8) & 63;
            f32x4 c4r[2], s4r[2];
            if constexpr (GRP <= 1) {
                if (d0r < 16) {
#pragma unroll
                    for (int mm = 0; mm < 2; ++mm) { const float* cp = cs + (size_t)(row0 + 16 * mm) * 16 + (d0r >> 3) * 4; c4r[mm] = *(const f32x4*)cp; s4r[mm] = *(const f32x4*)(cp + 8); }
                }
            }
            __builtin_amdgcn_sched_barrier(0);
#pragma unroll
            for (int mm = 0; mm < 2; ++mm) {
                const int m = 2 * mp + mm;
                const int row = row0 + mm * 16;
                const float rs = rs4[mm];
                const int b = row >> 12, s = row & 4095;
#pragma unroll
                for (int bj = 0; bj < 2; ++bj) {
                    const int col = u.pn * 256 + bj * 128 + wc * 32 + fq * 8;
                    const int jj = col & 511;
                    float v[8];
#pragma unroll
                    for (int e = 0; e < 4; ++e) { v[e] = acc[ai][bj][m][0][e] * rs; v[4 + e] = acc[ai][bj][m][1][e] * rs; }
                    if constexpr (GRP <= 1) {
                        const int d0 = jj & 63;
                        if (d0 < 16) {
                            const f32x4 c4 = c4r[mm], s4 = s4r[mm];
#pragma unroll
                            for (int e = 0; e < 4; ++e) { const float t1 = v[e], t2 = v[4 + e]; v[e] = t1 * c4[e] - t2 * s4[e]; v[4 + e] = t2 * c4[e] + t1 * s4[e]; }
                        }
                        if constexpr (GRP == 0) {
#pragma unroll
                            for (int e = 0; e < 8; ++e) v[e] *= 0.125f * LOG2E;
                        }
                        const int h = jj >> 7, c = (jj >> 6) & 1;
                        bf16_t* dst = (GRP == 0 ? Q : Kk) + ((size_t)(((b * 4 + h) * 2 + c) * SEQ + s)) * 64 + d0;
                        *(u32x4*)dst = pack8(v);
                    } else if constexpr (GRP == 2) {
                        const int h = jj >> 7, d0 = jj & 127;
                        *(u32x4*)(V + ((size_t)((b * 4 + h) * SEQ + s)) * 128 + d0) = pack8(v);
                    } else if constexpr (GRP == 3) {
                        *(u32x4*)(HQ + (size_t)row * 512 + jj) = pack8(v);
                    } else if constexpr (GRP == 4 || GRP == 5) {
                        const float* lbp = (GRP == 4 ? lbF : lbB) + jj;
                        const f32x4 l0 = *(const f32x4*)lbp, l1 = *(const f32x4*)(lbp + 4);
                        float gl[8];
#pragma unroll
                        for (int e = 0; e < 8; ++e) { const float lb = e < 4 ? l0[e] : l1[e - 4]; const float f = lb + (1.0f - lb) * sigmoidf_(v[e]); gl[e] = __builtin_amdgcn_logf(fmaxf(f, 1e-37f)) * 0.6931471805599453f; }
                        float* dst = (GRP == 4 ? GF : GB) + (size_t)row * 512 + jj;
                        *(f32x4*)dst = (f32x4){gl[0], gl[1], gl[2], gl[3]}; *(f32x4*)(dst + 4) = (f32x4){gl[4], gl[5], gl[6], gl[7]};
                    } else if constexpr (GRP == 6) {
                        *(u32x4*)(HV + (size_t)row * 512 + jj) = pack8(v);
                    } else {
#pragma unroll
                        for (int e = 0; e < 8; ++e) v[e] = sigmoidf_(v[e]);
                        *(u32x4*)(BG + (size_t)row * 512 + jj) = pack8(v);
                    }
                }
            }
            __builtin_amdgcn_sched_barrier(0);
        }
    }
    __device__ __forceinline__ void operator()(const f32x4 (&acc)[2][2][4][2], const pg8::Unit& u, int wr, int wc, int fr, int fq) const {
        switch (u.pn >> 1) {
            case 0: run<0>(acc, u, wr, wc, fr, fq); break;
            case 1: run<1>(acc, u, wr, wc, fr, fq); break;
            case 2: run<2>(acc, u, wr, wc, fr, fq); break;
            case 3: run<3>(acc, u, wr, wc, fr, fq); break;
            case 4: run<4>(acc, u, wr, wc, fr, fq); break;
            case 5: run<5>(acc, u, wr, wc, fr, fq); break;
            case 6: run<6>(acc, u, wr, wc, fr, fq); break;
            default: run<7>(acc, u, wr, wc, fr, fq); break;
        }
    }
};

struct EpiGate {
    static constexpr bool HAS_MID = false;
    const float* rsp; bf16_t* G;
    __device__ __forceinline__ void operator()(const f32x4 (&acc)[2][2][4][2], const pg8::Unit& u, int wr, int wc, int fr, int fq) const {
#pragma unroll
        for (int ai = 0; ai < 2; ++ai) {
            const int row0 = u.pm * 256 + ai * 128 + wr * 64 + fr;
            float rs4[4]; rows_rs4(rsp, row0, rs4);
            __builtin_amdgcn_sched_barrier(0);
#pragma unroll
            for (int m = 0; m < 4; ++m) {
                const int row = row0 + m * 16;
                const float rs = rs4[m];
                const int col = u.pn * 128 + wc * 32 + fq * 8;
                float r[8], sb[8];
                const float nrl = -rs * LOG2E;
#pragma unroll
                for (int n = 0; n < 2; ++n) {
                    f32x4 ta = acc[ai][0][m][n] * nrl, tb = acc[ai][1][m][n] * nrl;
                    ta = __builtin_elementwise_min(ta, (f32x4){86.f, 86.f, 86.f, 86.f}); tb = __builtin_elementwise_min(tb, (f32x4){86.f, 86.f, 86.f, 86.f});
                    ta.x = __builtin_amdgcn_exp2f(ta.x); ta.y = __builtin_amdgcn_exp2f(ta.y); ta.z = __builtin_amdgcn_exp2f(ta.z); ta.w = __builtin_amdgcn_exp2f(ta.w);
                    tb.x = __builtin_amdgcn_exp2f(tb.x); tb.y = __builtin_amdgcn_exp2f(tb.y); tb.z = __builtin_amdgcn_exp2f(tb.z); tb.w = __builtin_amdgcn_exp2f(tb.w);
                    ta = ta + 1.0f; tb = tb + 1.0f;
                    f32x4 ia, ib;
                    ia.x = __builtin_amdgcn_rcpf(ta.x); ia.y = __builtin_amdgcn_rcpf(ta.y); ia.z = __builtin_amdgcn_rcpf(ta.z); ia.w = __builtin_amdgcn_rcpf(ta.w);
                    ib.x = __builtin_amdgcn_rcpf(tb.x); ib.y = __builtin_amdgcn_rcpf(tb.y); ib.z = __builtin_amdgcn_rcpf(tb.z); ib.w = __builtin_amdgcn_rcpf(tb.w);
                    const f32x4 rr = tb * ia;
                    r[n * 4] = rr.x; r[n * 4 + 1] = rr.y; r[n * 4 + 2] = rr.z; r[n * 4 + 3] = rr.w;
                    sb[n * 4] = ib.x; sb[n * 4 + 1] = ib.y; sb[n * 4 + 2] = ib.z; sb[n * 4 + 3] = ib.w;
                }
                *(u32x4*)(G + (size_t)row * 2048 + col) = pack8(r);
                *(u32x4*)(G + (size_t)row * 2048 + 1024 + col) = pack8(sb);
            }
            __builtin_amdgcn_sched_barrier(0);
        }
    }
};

struct EpiY {
    static constexpr bool HAS_MID = true;
    const bf16_t* G; bf16_t* Y;
    __device__ __forceinline__ void mid(f32x4 (&acc)[2][2][4][2], const pg8::Unit& u, int wr, int wc, int fr, int fq) const {
        int fr_ = fr; asm volatile("" : "+v"(fr_));
#pragma unroll
        for (int ai = 0; ai < 2; ++ai) {
            __builtin_amdgcn_sched_barrier(0);
#pragma unroll
            for (int m = 0; m < 4; ++m) {
                const int row = u.pm * 256 + ai * 128 + wr * 64 + m * 16 + fr_;
#pragma unroll
                for (int bj = 0; bj < 2; ++bj) {
                    const int col = u.pn * 256 + bj * 128 + wc * 32 + fq * 8;
                    const u32x4 gq = *(const u32x4*)(G + (size_t)row * 2048 + col);
                    acc[ai][bj][m][0][0] *= bflo(gq.x); acc[ai][bj][m][0][1] *= bfhi(gq.x); acc[ai][bj][m][0][2] *= bflo(gq.y); acc[ai][bj][m][0][3] *= bfhi(gq.y);
                    acc[ai][bj][m][1][0] *= bflo(gq.z); acc[ai][bj][m][1][1] *= bfhi(gq.z); acc[ai][bj][m][1][2] *= bflo(gq.w); acc[ai][bj][m][1][3] *= bfhi(gq.w);
                }
            }
        }
        __builtin_amdgcn_sched_barrier(0);
    }
    __device__ __forceinline__ void operator()(const f32x4 (&acc)[2][2][4][2], const pg8::Unit& u, int wr, int wc, int fr, int fq) const {
#pragma unroll
        for (int ai = 0; ai < 2; ++ai) {
            u32x4 gqr[4][2];
#pragma unroll
            for (int m = 0; m < 4; ++m)
#pragma unroll
                for (int bj = 0; bj < 2; ++bj) gqr[m][bj] = *(const u32x4*)(G + (size_t)(u.pm * 256 + ai * 128 + wr * 64 + m * 16 + fr) * 2048 + 1024 + u.pn * 256 + bj * 128 + wc * 32 + fq * 8);
            __builtin_amdgcn_sched_barrier(0);
#pragma unroll
            for (int m = 0; m < 4; ++m) {
                const int row = u.pm * 256 + ai * 128 + wr * 64 + m * 16 + fr;
#pragma unroll
                for (int bj = 0; bj < 2; ++bj) {
                    const int col = u.pn * 256 + bj * 128 + wc * 32 + fq * 8;
                    const u32x4 gq = gqr[m][bj];
                    float v[8];
                    v[0] = acc[ai][bj][m][0][0] * bflo(gq.x); v[1] = acc[ai][bj][m][0][1] * bfhi(gq.x);
                    v[2] = acc[ai][bj][m][0][2] * bflo(gq.y); v[3] = acc[ai][bj][m][0][3] * bfhi(gq.y);
                    v[4] = acc[ai][bj][m][1][0] * bflo(gq.z); v[5] = acc[ai][bj][m][1][1] * bfhi(gq.z);
                    v[6] = acc[ai][bj][m][1][2] * bflo(gq.w); v[7] = acc[ai][bj][m][1][3] * bfhi(gq.w);
                    *(u32x4*)(Y + (size_t)row * 1024 + col) = pack8(v);
                }
            }
            __builtin_amdgcn_sched_barrier(0);
        }
    }
};

struct EpiRes {
    static constexpr bool HAS_MID = false;
    const float* xres; float* xout; bf16_t* XB; float* rsp;
    __device__ __forceinline__ void operator()(const f32x4 (&acc)[2][2][4][2], const pg8::Unit& u, int wr, int wc, int fr, int fq) const {
#pragma unroll
        for (int ai = 0; ai < 2; ++ai)
#pragma unroll
        for (int mp = 0; mp < 2; ++mp) {
            f32x4 xr0[2][2], xr1[2][2];
#pragma unroll
            for (int mm = 0; mm < 2; ++mm)
#pragma unroll
                for (int bj = 0; bj < 2; ++bj) { const float* xr = xres + (size_t)(u.pm * 256 + ai * 128 + wr * 64 + (2 * mp + mm) * 16 + fr) * Dm + u.pn * 256 + bj * 128 + wc * 32 + fq * 8;
                    xr0[mm][bj] = *(const f32x4*)xr; xr1[mm][bj] = *(const f32x4*)(xr + 4); }
            __builtin_amdgcn_sched_barrier(0);
#pragma unroll
            for (int mm = 0; mm < 2; ++mm) {
                const int m = 2 * mp + mm;
                const int row = u.pm * 256 + ai * 128 + wr * 64 + m * 16 + fr;
                float ss = 0.f;
#pragma unroll
                for (int bj = 0; bj < 2; ++bj) {
                    const int col = u.pn * 256 + bj * 128 + wc * 32 + fq * 8;
                    const f32x4 x0 = xr0[mm][bj], x1 = xr1[mm][bj];
                    float v[8];
#pragma unroll
                    for (int e = 0; e < 4; ++e) { v[e] = x0[e] + acc[ai][bj][m][0][e]; v[4 + e] = x1[e] + acc[ai][bj][m][1][e]; }
#pragma unroll
                    for (int e = 0; e < 8; ++e) ss += v[e] * v[e];
                    float* xo = xout + (size_t)row * Dm + col;
                    *(f32x4*)xo = (f32x4){v[0], v[1], v[2], v[3]}; *(f32x4*)(xo + 4) = (f32x4){v[4], v[5], v[6], v[7]};
                    *(u32x4*)(XB + (size_t)row * Dm + col) = pack8(v);
                }
                ss += __shfl_xor(ss, 16); ss += __shfl_xor(ss, 32);
                if (fq == 0) rsp[(size_t)row * 16 + u.pn * 4 + wc] = ss;
            }
            __builtin_amdgcn_sched_barrier(0);
        }
    }
};

struct EpiGU {
    static constexpr bool HAS_MID = false;
    const float* rsp; bf16_t* H;
    __device__ __forceinline__ void operator()(const f32x4 (&acc)[2][2][4][2], const pg8::Unit& u, int wr, int wc, int fr, int fq) const {
#pragma unroll
        for (int ai = 0; ai < 2; ++ai) {
            const int row0 = u.pm * 256 + ai * 128 + wr * 64 + fr;
            float rs4[4]; rows_rs4(rsp, row0, rs4);
            __builtin_amdgcn_sched_barrier(0);
#pragma unroll
            for (int m = 0; m < 4; ++m) {
                const int row = row0 + m * 16;
                const float rs = rs4[m];
                const int col = u.pn * 128 + wc * 32 + fq * 8;
                float v[8];
                const float nrl = -rs * LOG2E, rs2 = rs * rs;
#pragma unroll
                for (int n = 0; n < 2; ++n) {
                    const f32x4 a = acc[ai][0][m][n], b = acc[ai][1][m][n];
                    f32x4 t = a * nrl;
                    t.x = __builtin_amdgcn_exp2f(t.x); t.y = __builtin_amdgcn_exp2f(t.y); t.z = __builtin_amdgcn_exp2f(t.z); t.w = __builtin_amdgcn_exp2f(t.w);
                    t = t + 1.0f;
                    t.x = __builtin_amdgcn_rcpf(t.x); t.y = __builtin_amdgcn_rcpf(t.y); t.z = __builtin_amdgcn_rcpf(t.z); t.w = __builtin_amdgcn_rcpf(t.w);
                    const f32x4 o = ((a * b) * rs2) * t;
                    v[n * 4] = o.x; v[n * 4 + 1] = o.y; v[n * 4 + 2] = o.z; v[n * 4 + 3] = o.w;
                }
                *(u32x4*)(H + (size_t)row * FF + col) = pack8(v);
            }
            __builtin_amdgcn_sched_barrier(0);
        }
    }
};

__device__ __forceinline__ int rope_perm(int n) {
    const int d = n & 63; if (d >= 16) return n;
    const int g = d >> 3, e = d & 7; return (n & ~63) + ((e < 4) ? 4 * g + e : 8 + 4 * g + (e - 4));
}
__device__ __forceinline__ void conv_item(const float* src, int ld_src, int ks0, int c0  , int mode  ,
                                          const float* gain, bf16_t* dst, int ld_dst, int n0, int kd0, LAS float* scr, int lane) {
    const int n4 = lane & 7, kr = lane >> 3;
    int sc = c0 + 4 * n4;
    if (mode) { const int q = (sc & 63) >> 2; if (q == 1) sc += 4; else if (q == 2) sc -= 4; }
#pragma unroll
    for (int i = 0; i < 8; ++i) { const int kk = kr + 8 * i; f32x4 w = *(const f32x4*)(src + (size_t)(ks0 + kk) * ld_src + sc);
        if (gain) { const float gg = gain[ks0 + kk]; w.x *= gg; w.y *= gg; w.z *= gg; w.w *= gg; }
        LAS float* d = scr + kk * 33 + 4 * n4; d[0] = w.x; d[1] = w.y; d[2] = w.z; d[3] = w.w; }
    asm volatile("s_waitcnt lgkmcnt(0)" ::: "memory");
    const int c = lane & 7;
#pragma unroll
    for (int j = 0; j < 4; ++j) { const int n = (lane >> 3) + 8 * j; const LAS float* s = scr + (8 * c) * 33 + n;
        u32x4 o; o.x = pk2(s[0 * 33], s[1 * 33]); o.y = pk2(s[2 * 33], s[3 * 33]); o.z = pk2(s[4 * 33], s[5 * 33]); o.w = pk2(s[6 * 33], s[7 * 33]);
        *(u32x4*)(dst + (size_t)(n0 + n) * ld_dst + kd0 + 8 * c) = o; }
    asm volatile("s_waitcnt lgkmcnt(0)" ::: "memory");
}

struct Ptrs {
    const float *x; const int* pos; const float *w_in, *da_lambda, *da_norm, *hg_lb, *hg_norm, *w_a, *w_b, *w_o, *attn_norm, *ffn_norm, *w_gate, *w_up, *w_down, *final_norm;
    float* out; unsigned char* ws; int ph_lo, ph_hi;
};

__device__ __forceinline__ void convert_layer(const Ptrs& P, int layer, unsigned char* wbuf, LAS unsigned char* lds, int gw, int ngw, int wave, int lane) {
    LAS float* scr = (LAS float*)(lds + wave * 8704);
    constexpr int I_IN = 16 * 192, I_A = 8 * 32, I_B = 8 * 32, I_O = 16 * 32, I_GU = 16 * 176, I_D = 44 * 32;
    constexpr int NIT = I_IN + I_A + I_B + I_O + I_GU + I_D;
    for (int it = gw; it < NIT; it += ngw) {
        int r = it;
        if (r < I_IN) { const int kb = r / 192, nb = r % 192, n0 = nb * 32;
            int c0 = n0; if (n0 >= 4096) { const int q = n0 - 4096, tile = q >> 8, rr = q & 255; c0 = (rr < 128 ? 4096 : 5120) + tile * 128 + (rr & 127); }
            conv_item(P.w_in + (size_t)layer * Dm * INW, INW, kb * 64, c0, n0 < 1024 ? 1 : 0, P.attn_norm + layer * Dm, (bf16_t*)(wbuf + W_IN), Dm, n0, kb * 64, scr, lane); continue; }
        r -= I_IN;
        if (r < I_A) { const int kb = r / 32, nb = r % 32;
            conv_item(P.w_a + (size_t)layer * 512 * Dm, Dm, kb * 64, nb * 32, 0, nullptr, (bf16_t*)(wbuf + W_AB), 1024, nb * 32, kb * 64, scr, lane); continue; }
        r -= I_A;
        if (r < I_B) { const int kb = r / 32, nb = r % 32;
            conv_item(P.w_b + (size_t)layer * 512 * Dm, Dm, kb * 64, nb * 32, 0, nullptr, (bf16_t*)(wbuf + W_AB), 1024, nb * 32, 512 + kb * 64, scr, lane); continue; }
        r -= I_B;
        if (r < I_O) { const int kb = r / 32, nb = r % 32;
            conv_item(P.w_o + (size_t)layer * Dm * Dm, Dm, kb * 64, nb * 32, 0, nullptr, (bf16_t*)(wbuf + W_O2), Dm, nb * 32, kb * 64, scr, lane); continue; }
        r -= I_O;
        if (r < I_GU) { const int kb = r / 176, nb = r % 176, n0 = nb * 32, tile = n0 >> 8, rr = n0 & 255;
            const float* srcm = (rr < 128 ? P.w_gate : P.w_up) + (size_t)layer * Dm * FF;
            conv_item(srcm, FF, kb * 64, tile * 128 + (rr & 127), 0, P.ffn_norm + layer * Dm, (bf16_t*)(wbuf + W_GU), Dm, n0, kb * 64, scr, lane); continue; }
        r -= I_GU;
        { const int kb = r / 32, nb = r % 32;
            conv_item(P.w_down + (size_t)layer * FF * Dm, Dm, kb * 64, nb * 32, 0, nullptr, (bf16_t*)(wbuf + W_D), FF, nb * 32, kb * 64, scr, lane); }
    }
}

__device__ __forceinline__ float wave_sum(float v) {
#pragma unroll
    for (int o = 1; o < 64; o <<= 1) v += __shfl_xor(v, o);
    return v;
}
__device__ __forceinline__ void prologue(const Ptrs& P, LAS unsigned char* lds, int gw, int ngw, int wave, int lane) {
    unsigned char* ws = P.ws;
    bf16_t* XB = (bf16_t*)(ws + OFF_XB); float* rsb = (float*)(ws + OFF_RSB);
    for (int r = gw; r < M; r += ngw) {
        const f32x4* xr = (const f32x4*)(P.x + (size_t)r * Dm) + lane;
        float ss = 0.f;
#pragma unroll
        for (int j = 0; j < 4; ++j) { const f32x4 v = xr[64 * j]; ss += (v.x * v.x + v.y * v.y) + (v.z * v.z + v.w * v.w);
            u32x2 o; o.x = pk2(v.x, v.y); o.y = pk2(v.z, v.w); *((u32x2*)(XB + (size_t)r * Dm) + lane + 64 * j) = o; }
        ss = wave_sum(ss);
        if (lane < 16) rsb[(size_t)r * 16 + lane] = (lane == 0) ? ss : 0.f;
    }
    const int gt = gw * 64 + lane, ngt = ngw * 64;
    float* cs = (float*)(ws + OFF_CS);
    for (int i = gt; i < M * 8; i += ngt) {
        const int tok = i >> 3, f = i & 7;
        const double invf[8] = {1.0, 0.19392274474868576, 0.03760603093086393, 0.007292664737217109, 0.001414213562373095, 0.0002742481756762073, 5.318295896944988e-05, 1.031338537721246e-05};
        double fr;
        switch (f) { case 0: fr = invf[0]; break; case 1: fr = invf[1]; break; case 2: fr = invf[2]; break; case 3: fr = invf[3]; break; case 4: fr = invf[4]; break; case 5: fr = invf[5]; break; case 6: fr = invf[6]; break; default: fr = invf[7]; }
        const float ang32 = (float)P.pos[tok] * (float)fr;
        const double ang = (double)ang32;
        const double rev = ang * 0.15915494309189535;
        const double fracrev = rev - __builtin_floor(rev + 0.5);
        const float a = (float)(fracrev * 6.283185307179586);
        cs[(size_t)tok * 16 + f] = __cosf(a); cs[(size_t)tok * 16 + 8 + f] = __sinf(a);
    }
    float* LB = (float*)(ws + OFF_LB);
    for (int i = gt; i < 2 * 512; i += ngt) {
        const int d = i >> 9, k = i & 511;
        float l[4], mx = -1e30f;
#pragma unroll
        for (int j = 0; j < 4; ++j) { l[j] = P.hg_lb[(size_t)(d * 4 + j) * 512 + k]; mx = fmaxf(mx, l[j]); }
        float e[4], sum = 0.f;
#pragma unroll
        for (int j = 0; j < 4; ++j) { e[j] = __expf(l[j] - mx); sum += e[j]; }
        float cum = 0.f;
#pragma unroll
        for (int j = 0; j < 4; ++j) { if (j > 0) cum += e[j] / sum; LB[(size_t)(d * 4 + j) * 512 + k] = cum; }
    }
    if (gw == 0) {
        float* LAM = (float*)(ws + OFF_LAM);
        for (int l = 0; l < 4; ++l) {
            const float* p = P.da_lambda + l * 256;
            float a = wave_sum(p[lane] * p[64 + lane]), b = wave_sum(p[128 + lane] * p[192 + lane]);
            const float lam_init = 0.8f - 0.6f * __expf(-0.3f * (float)l);
            if (lane == 0) LAM[l] = __expf(a) - __expf(b) + lam_init;
        }
    }
}

constexpr int AT_KROW = 144, AT_VROW = 320, AT_K1 = 64 * AT_KROW, AT_V = 2 * AT_K1, AT_STG = AT_V + 64 * AT_VROW;
constexpr int AT_IMG_ROW = 132;
__device__ __forceinline__ s16x4 tr_read(const LAS unsigned char* p) { return __builtin_bit_cast(s16x4, __builtin_amdgcn_ds_read_tr16_b64_v4i16((LAS s16x4*)p)); }

__device__ __forceinline__ void attn_unit(int b, int h, int qb, const bf16_t* Q, const bf16_t* Kk, const bf16_t* V, bf16_t* AO, const float* gainA  , float one_minus_lam_init, float lam, LAS unsigned char* lds) {
    int tid_ = threadIdx.x; asm volatile("" : "+v"(tid_));
    const int tid = tid_, wave = __builtin_amdgcn_readfirstlane(tid >> 6), lane = tid & 63, c = wave >> 2, wq = wave & 3, r32 = lane & 31, hh = lane >> 5;
    const int q0 = qb * 128 + wq * 32;
    bf16x8 qf[4];
    { const bf16_t* Qp = Q + ((size_t)(((b * 4 + h) * 2 + c) * SEQ + q0 + r32)) * 64 + 8 * hh;
#pragma unroll
      for (int s = 0; s < 4; ++s) qf[s] = *(const bf16x8*)(Qp + 16 * s); }
    f32x16 o[4];
#pragma unroll
    for (int i = 0; i < 4; ++i)
#pragma unroll
        for (int e = 0; e < 16; ++e) o[i][e] = 0.f;
    float mrow = -1e30f, lrow = 0.f;
    const unsigned char* Kg0 = (const unsigned char*)(Kk + ((size_t)((b * 4 + h) * 2 + 0) * SEQ) * 64);
    const unsigned char* Kg1 = (const unsigned char*)(Kk + ((size_t)((b * 4 + h) * 2 + 1) * SEQ) * 64);
    const unsigned char* Vg = (const unsigned char*)(V + ((size_t)(b * 4 + h) * SEQ) * 128);
    const int lk = (tid >> 3) * AT_KROW + (tid & 7) * 16;
    const int lv0 = AT_V + (tid >> 4) * AT_VROW + (tid & 15) * 16, lv1 = lv0 + 32 * AT_VROW;
    u32x4 r0, r1, r2, r3;
    r0 = *(const u32x4*)(Kg0 + tid * 16); r1 = *(const u32x4*)(Kg1 + tid * 16); r2 = *(const u32x4*)(Vg + tid * 16); r3 = *(const u32x4*)(Vg + 8192 + tid * 16);
    *(LAS u32x4*)(lds + lk) = r0; *(LAS u32x4*)(lds + AT_K1 + lk) = r1; *(LAS u32x4*)(lds + lv0) = r2; *(LAS u32x4*)(lds + lv1) = r3;
    r0 = *(const u32x4*)(Kg0 + 8192 + tid * 16); r1 = *(const u32x4*)(Kg1 + 8192 + tid * 16);
    *(LAS u32x4*)(lds + AT_STG + lk) = r0; *(LAS u32x4*)(lds + AT_STG + AT_K1 + lk) = r1;
    __syncthreads();
    const int ka = c * AT_K1 + r32 * AT_KROW + hh * 16;
    const int va = AT_V + (4 * hh + ((lane & 15) >> 2)) * AT_VROW + ((lane >> 4) & 1) * 32 + (lane & 3) * 8;

#define AT_QK(sv, st) do { f32x16 t0_, t1_; _Pragma("unroll") for (int e = 0; e < 16; ++e) { t0_[e] = 0.f; t1_[e] = 0.f; } \
        _Pragma("unroll") for (int ks = 0; ks < 4; ++ks) { \
            const bf16x8 a0 = *(const LAS bf16x8*)(lds + (st) + ka + ks * 32), a1 = *(const LAS bf16x8*)(lds + (st) + ka + 32 * AT_KROW + ks * 32); \
            t0_ = __builtin_amdgcn_mfma_f32_32x32x16_bf16(a0, qf[ks], t0_, 0, 0, 0); t1_ = __builtin_amdgcn_mfma_f32_32x32x16_bf16(a1, qf[ks], t1_, 0, 0, 0); } \
        sv##0 = t0_; sv##1 = t1_; } while (0)
    f32x16 sA0, sA1, sB0, sB1;
    AT_QK(sA, 0);
#define AT_VFRAG(dst, STC, g) do { const LAS unsigned char* vb_ = lds + (STC) + va + (16 * (g)) * AT_VROW; \
        _Pragma("unroll") for (int vt = 0; vt < 4; ++vt) { const s16x4 t0 = tr_read(vb_ + vt * 64), t1 = tr_read(vb_ + vt * 64 + 8 * AT_VROW); \
            dst[vt] = (bf16x8){t0[0], t0[1], t0[2], t0[3], t1[0], t1[1], t1[2], t1[3]}; } } while (0)
#define AT_PV(vf, p) do { __builtin_amdgcn_s_setprio(1); _Pragma("unroll") for (int vt = 0; vt < 4; ++vt) o[vt] = __builtin_amdgcn_mfma_f32_32x32x16_bf16(vf[vt], p, o[vt], 0, 0, 0); __builtin_amdgcn_s_setprio(0); } while (0)
#define AT_SB __builtin_amdgcn_sched_barrier(0)
#define AT_TILE(j, s0, s1, sn, STC  , STN  ) do { \
        if ((j) + 2 < 64) { const size_t go = (size_t)((j) + 2) * 8192; r0 = *(const u32x4*)(Kg0 + go + tid * 16); r1 = *(const u32x4*)(Kg1 + go + tid * 16); } \
        if ((j) + 1 < 64) { const size_t go = (size_t)((j) + 1) * 16384; r2 = *(const u32x4*)(Vg + go + tid * 16); r3 = *(const u32x4*)(Vg + go + 8192 + tid * 16); } \
        bf16x8 kf[4], kg[4], vA[4]; \
        if ((j) + 1 < 64) { _Pragma("unroll") for (int ks = 0; ks < 2; ++ks) { kf[2 * ks] = *(const LAS bf16x8*)(lds + (STN) + ka + ks * 32); kf[2 * ks + 1] = *(const LAS bf16x8*)(lds + (STN) + ka + 32 * AT_KROW + ks * 32); } } \
        AT_SB; \
        float mx = fmaxf(s0[0], s1[0]); \
        _Pragma("unroll") for (int e = 1; e < 16; ++e) mx = fmaxf(mx, fmaxf(s0[e], s1[e])); \
        mx = fmaxf(mx, __shfl_xor(mx, 32)); \
        if (__builtin_amdgcn_ballot_w64(mx > mrow + 8.0f) != 0ull) { \
            const float mnew = fmaxf(mrow, mx), alpha = __builtin_amdgcn_exp2f(mrow - mnew); mrow = mnew; lrow *= alpha; \
            _Pragma("unroll") for (int i = 0; i < 4; ++i) _Pragma("unroll") for (int e = 0; e < 16; ++e) o[i][e] *= alpha; } \
        AT_SB; \
        if ((j) + 1 < 64) { f32x16 t0_, t1_; _Pragma("unroll") for (int e = 0; e < 16; ++e) { t0_[e] = 0.f; t1_[e] = 0.f; } \
            __builtin_amdgcn_s_setprio(1); \
            _Pragma("unroll") for (int ks = 0; ks < 2; ++ks) { t0_ = __builtin_amdgcn_mfma_f32_32x32x16_bf16(kf[2 * ks], qf[ks], t0_, 0, 0, 0); t1_ = __builtin_amdgcn_mfma_f32_32x32x16_bf16(kf[2 * ks + 1], qf[ks], t1_, 0, 0, 0); } \
            AT_SB; \
            _Pragma("unroll") for (int ks = 0; ks < 2; ++ks) { kg[2 * ks] = *(const LAS bf16x8*)(lds + (STN) + ka + (ks + 2) * 32); kg[2 * ks + 1] = *(const LAS bf16x8*)(lds + (STN) + ka + 32 * AT_KROW + (ks + 2) * 32); } \
            AT_SB; \
            _Pragma("unroll") for (int ks = 0; ks < 2; ++ks) { t0_ = __builtin_amdgcn_mfma_f32_32x32x16_bf16(kg[2 * ks], qf[ks + 2], t0_, 0, 0, 0); t1_ = __builtin_amdgcn_mfma_f32_32x32x16_bf16(kg[2 * ks + 1], qf[ks + 2], t1_, 0, 0, 0); } \
            __builtin_amdgcn_s_setprio(0); sn##0 = t0_; sn##1 = t1_; } \
        AT_VFRAG(vA, STC, 0); \
        AT_SB; \
        float ls = 0.f; \
        _Pragma("unroll") for (int e = 0; e < 16; ++e) { s0[e] = __builtin_amdgcn_exp2f(s0[e] - mrow); s1[e] = __builtin_amdgcn_exp2f(s1[e] - mrow); ls += s0[e] + s1[e]; } \
        lrow += ls; \
        bf16x8 pf[2][2]; \
        _Pragma("unroll") for (int s = 0; s < 2; ++s) { u32x4 w0, w1; \
            w0.x = pk2(s0[8 * s + 0], s0[8 * s + 1]); w0.y = pk2(s0[8 * s + 2], s0[8 * s + 3]); w0.z = pk2(s0[8 * s + 4], s0[8 * s + 5]); w0.w = pk2(s0[8 * s + 6], s0[8 * s + 7]); \
            w1.x = pk2(s1[8 * s + 0], s1[8 * s + 1]); w1.y = pk2(s1[8 * s + 2], s1[8 * s + 3]); w1.z = pk2(s1[8 * s + 4], s1[8 * s + 5]); w1.w = pk2(s1[8 * s + 6], s1[8 * s + 7]); \
            pf[0][s] = __builtin_bit_cast(bf16x8, w0); pf[1][s] = __builtin_bit_cast(bf16x8, w1); } \
        AT_SB; \
        AT_PV(vA, pf[0][0]); \
        AT_SB; \
        AT_VFRAG(vA, STC, 1); \
        AT_SB; \
        AT_PV(vA, pf[0][1]); \
        AT_SB; \
          \
        if ((j) + 2 < 64) { *(LAS u32x4*)(lds + (STC) + lk) = r0; *(LAS u32x4*)(lds + (STC) + AT_K1 + lk) = r1; } \
        if ((j) + 1 < 64) { *(LAS u32x4*)(lds + (STN) + lv0) = r2; *(LAS u32x4*)(lds + (STN) + lv1) = r3; } \
        AT_SB; \
        AT_VFRAG(vA, STC, 2); \
        AT_SB; \
        AT_PV(vA, pf[1][0]); \
        AT_SB; \
        AT_VFRAG(vA, STC, 3); \
        AT_SB; \
        AT_PV(vA, pf[1][1]); \
        __syncthreads(); } while (0)
    for (int j = 0; j < 64; j += 2) {
        AT_TILE(j, sA0, sA1, sB, 0, AT_STG);
        AT_TILE(j + 1, sB0, sB1, sA, AT_STG, 0);
    }
#undef AT_TILE
#undef AT_QK
#undef AT_VFRAG
#undef AT_PV
#undef AT_SB
    const float inv = __builtin_amdgcn_rcpf(lrow + __shfl_xor(lrow, 32));
    LAS float* img = (LAS float*)lds;
    const int qrow = wq * 32 + r32;
    if (c == 1) {
        const float sc = -lam * inv;
#pragma unroll
        for (int vt = 0; vt < 4; ++vt)
#pragma unroll
            for (int g = 0; g < 4; ++g)
                *(LAS f32x4*)(img + qrow * AT_IMG_ROW + 32 * vt + 8 * g + 4 * hh) = (f32x4){o[vt][4 * g] * sc, o[vt][4 * g + 1] * sc, o[vt][4 * g + 2] * sc, o[vt][4 * g + 3] * sc};
    }
    __syncthreads();
    if (c == 0) {
#pragma unroll
        for (int vt = 0; vt < 4; ++vt)
#pragma unroll
            for (int g = 0; g < 4; ++g) {
                LAS f32x4* p = (LAS f32x4*)(img + qrow * AT_IMG_ROW + 32 * vt + 8 * g + 4 * hh);
                f32x4 t = *p;
                t.x += o[vt][4 * g] * inv; t.y += o[vt][4 * g + 1] * inv; t.z += o[vt][4 * g + 2] * inv; t.w += o[vt][4 * g + 3] * inv;
                *p = t;
            }
    }
    __syncthreads();
    {
        const int q = tid >> 2, part = tid & 3;
        float v[32]; float ss = 0.f;
#pragma unroll
        for (int i = 0; i < 8; ++i) { const f32x4 t = *(const LAS f32x4*)(img + q * AT_IMG_ROW + 32 * part + 4 * i); v[4 * i] = t.x; v[4 * i + 1] = t.y; v[4 * i + 2] = t.z; v[4 * i + 3] = t.w;
            ss += (t.x * t.x + t.y * t.y) + (t.z * t.z + t.w * t.w); }
        ss += __shfl_xor(ss, 1); ss += __shfl_xor(ss, 2);
        const float rs = rsqrtf(ss * (1.0f / 128.0f) + EPS) * one_minus_lam_init;
        const float* gp = gainA + h * 128 + 32 * part;
        bf16_t* dst = AO + ((size_t)(b * SEQ + qb * 128 + q)) * 1024 + h * 128 + 32 * part;
#pragma unroll
        for (int i = 0; i < 4; ++i) {
            const f32x4 g0 = *(const f32x4*)(gp + 8 * i), g1 = *(const f32x4*)(gp + 8 * i + 4);
            u32x4 w; w.x = pk2(v[8 * i] * rs * g0.x, v[8 * i + 1] * rs * g0.y); w.y = pk2(v[8 * i + 2] * rs * g0.z, v[8 * i + 3] * rs * g0.w);
            w.z = pk2(v[8 * i + 4] * rs * g1.x, v[8 * i + 5] * rs * g1.y); w.w = pk2(v[8 * i + 6] * rs * g1.z, v[8 * i + 7] * rs * g1.w);
            *(u32x4*)(dst + 8 * i) = w;
        }
    }
    __syncthreads();
}

constexpr int HG_SEG = 0;
constexpr int HG_F = 2048;
constexpr int HG_PART = 2560;
constexpr int HG_V = 4096;
constexpr int HG_VROW = 288;
constexpr int HG_A = HG_V + 64 * HG_VROW;
constexpr int HG_KTROW = 144, HG_QKROW = 272;
constexpr int HG_Bq = HG_A + 128 * HG_KTROW;

__device__ __forceinline__ void hg_cumsum(const float (&gv)[16], int dir, int k, int j, LAS unsigned char* lds, float (&d)[16], float& m_out, float& tot_out) {
    float run = 0.f;
    if (dir == 0) {
#pragma unroll
        for (int i = 0; i < 16; ++i) { run += gv[i]; d[i] = run; }
    } else {
#pragma unroll
        for (int i = 15; i >= 0; --i) { run += gv[i]; d[i] = run; }
    }
    LAS float* seg = (LAS float*)(lds + HG_SEG);
    seg[j * 128 + k] = run;
    __syncthreads();
    const float s0 = seg[k], s1 = seg[128 + k], s2 = seg[256 + k], s3 = seg[384 + k];
    float off, m;
    if (dir == 0) { off = (j > 0 ? s0 : 0.f) + (j > 1 ? s1 : 0.f) + (j > 2 ? s2 : 0.f); m = s0 + s1; }
    else { off = (j < 3 ? s3 : 0.f) + (j < 2 ? s2 : 0.f) + (j < 1 ? s1 : 0.f); m = s2 + s3; }
#pragma unroll
    for (int i = 0; i < 16; ++i) d[i] = d[i] + off - m;
    m_out = m; tot_out = (s0 + s1) + (s2 + s3);
}
__device__ __forceinline__ void hg_load_v(const bf16_t* HV, int tok0, int h, LAS unsigned char* lds, int tid) {
#pragma unroll
    for (int i = 0; i < 2; ++i) { const int ch = tid + 512 * i, p = ch >> 4, part = ch & 15;
        *(LAS u32x4*)(lds + HG_V + p * HG_VROW + part * 16) = *(const u32x4*)(HV + (size_t)(tok0 + p) * 512 + h * 128 + part * 8); }
}
__device__ __forceinline__ void hg_load_g(const float* G, int tok0, int h, int k, int j, float (&gv)[16]) {
    const float* gp = G + (size_t)(tok0 + 16 * j) * 512 + h * 128 + k;
#pragma unroll
    for (int i = 0; i < 16; ++i) gv[i] = gp[(size_t)i * 512];
}

__device__ __forceinline__ void hg1_phase(int bx, int G, const float* GF, const float* GB, const bf16_t* HV, bf16_t* UT, float* Dg, float* Eg, LAS unsigned char* lds) {
    int tid_ = threadIdx.x; asm volatile("" : "+v"(tid_));
    const int tid = tid_, wave = __builtin_amdgcn_readfirstlane(tid >> 6), lane = tid & 63;
    const int k = tid & 127, j = tid >> 7, i16 = lane & 15, g4 = lane >> 4;
    float gn[16]; u32x4 vn[2];
#define HG1_LOAD(uu) do { const int u_ = (uu), dir_ = u_ & 1, cch_ = (u_ >> 1) & 63, bh_ = u_ >> 7, tok_ = (bh_ >> 2) * SEQ + cch_ * 64; \
        hg_load_g(dir_ ? GB : GF, tok_, bh_ & 3, k, j, gn); \
        _Pragma("unroll") for (int i = 0; i < 2; ++i) { const int ch = tid + 512 * i; vn[i] = *(const u32x4*)(HV + (size_t)(tok_ + (ch >> 4)) * 512 + (bh_ & 3) * 128 + (ch & 15) * 8); } } while (0)
    if (bx < 2048) HG1_LOAD(bx);
    for (int u = bx; u < 2048; u += G) {
        const int dir = u & 1, cch = (u >> 1) & 63, bh = u >> 7, b = bh >> 2, h = bh & 3;
        const int tok0 = b * SEQ + cch * 64;
        float gv[16], d[16], m, tot;
#pragma unroll
        for (int i = 0; i < 16; ++i) gv[i] = gn[i];
        u32x4 vr[2];
#pragma unroll
        for (int i = 0; i < 2; ++i) vr[i] = vn[i];
        if (u + G < 2048) HG1_LOAD(u + G);
        hg_cumsum(gv, dir, k, j, lds, d, m, tot);
        float kt[16];
#pragma unroll
        for (int i = 0; i < 16; ++i) kt[i] = (1.0f - __expf(gv[i])) * __expf(fminf(-d[i], 40.f));
        { u32x4 w0, w1;
          w0.x = pk2(kt[0], kt[1]); w0.y = pk2(kt[2], kt[3]); w0.z = pk2(kt[4], kt[5]); w0.w = pk2(kt[6], kt[7]);
          w1.x = pk2(kt[8], kt[9]); w1.y = pk2(kt[10], kt[11]); w1.z = pk2(kt[12], kt[13]); w1.w = pk2(kt[14], kt[15]);
          *(LAS u32x4*)(lds + HG_A + k * HG_KTROW + j * 32) = w0; *(LAS u32x4*)(lds + HG_A + k * HG_KTROW + j * 32 + 16) = w1; }
#pragma unroll
        for (int i = 0; i < 2; ++i) { const int ch = tid + 512 * i; *(LAS u32x4*)(lds + HG_V + (ch >> 4) * HG_VROW + (ch & 15) * 16) = vr[i]; }
        if (j == 0) { ((LAS float*)(lds + HG_F))[k] = __expf(tot - m); Dg[(size_t)u * 128 + k] = __expf(tot); Eg[(size_t)u * 128 + k] = __expf(m); }
        __syncthreads();
        bf16x8 af[2];
#pragma unroll
        for (int s = 0; s < 2; ++s) {
            const LAS unsigned char* ap = lds + HG_A + (16 * wave + i16) * HG_KTROW + (32 * s + 4 * g4) * 2;
            const u32x2 lo = *(const LAS u32x2*)ap, hi = *(const LAS u32x2*)(ap + 32);
            af[s] = __builtin_bit_cast(bf16x8, (u32x4){lo.x, lo.y, hi.x, hi.y});
        }
        const f32x4 fsc = *(const LAS f32x4*)(lds + HG_F + (16 * wave + 4 * g4) * 4);
        const LAS unsigned char* vbase = lds + HG_V + (4 * g4 + (i16 >> 2)) * HG_VROW + (i16 & 3) * 8;
#pragma unroll
        for (int vt = 0; vt < 8; ++vt) {
            f32x4 acc = {0.f, 0.f, 0.f, 0.f};
#pragma unroll
            for (int s = 0; s < 2; ++s) {
                const s16x4 t0 = tr_read(vbase + (32 * s) * HG_VROW + vt * 32), t1 = tr_read(vbase + (32 * s + 16) * HG_VROW + vt * 32);
                const bf16x8 bv = {t0[0], t0[1], t0[2], t0[3], t1[0], t1[1], t1[2], t1[3]};
                acc = __builtin_amdgcn_mfma_f32_16x16x32_bf16(af[s], bv, acc, 0, 0, 0);
            }
            u32x2 w; w.x = pk2(acc[0] * fsc[0], acc[1] * fsc[1]); w.y = pk2(acc[2] * fsc[2], acc[3] * fsc[3]);
            *(u32x2*)(UT + ((size_t)u * 128 + 16 * vt + i16) * 128 + 16 * wave + 4 * g4) = w;
        }
        __syncthreads();
    }
}

__device__ __forceinline__ void hg2_scan(bf16_t* UT, const float* Dg, const float* Eg, int gthread, int nthreads) {
    for (int idx = gthread; idx < 32 * 4096; idx += nthreads) {
        const int chain = idx >> 12, e4 = idx & 4095, v = e4 >> 5, k0 = (e4 & 31) * 4;
        const int dir = chain & 1, bh = chain >> 1;
        float S0 = 0.f, S1 = 0.f, S2 = 0.f, S3 = 0.f;
        int u = (bh * 64 + (dir ? 63 : 0)) * 2 + dir;
        const int ustep = dir ? -2 : 2;
        u32x2 uu[4]; f32x4 dd[4], ee[4];
#pragma unroll
        for (int r = 0; r < 4; ++r) { const int ur = u + r * ustep; uu[r] = *(const u32x2*)(UT + ((size_t)ur * 128 + v) * 128 + k0); dd[r] = *(const f32x4*)(Dg + (size_t)ur * 128 + k0); ee[r] = *(const f32x4*)(Eg + (size_t)ur * 128 + k0); }
        for (int cc = 0; cc < 64; cc += 4) {
#pragma unroll
            for (int r = 0; r < 4; ++r) {
                const u32x2 uc = uu[r]; const f32x4 dc = dd[r], ec = ee[r];
                if (cc + 4 < 64) { const int un = u + 4 * ustep; uu[r] = *(const u32x2*)(UT + ((size_t)un * 128 + v) * 128 + k0); dd[r] = *(const f32x4*)(Dg + (size_t)un * 128 + k0); ee[r] = *(const f32x4*)(Eg + (size_t)un * 128 + k0); }
                u32x2 w; w.x = pk2(ec.x * S0, ec.y * S1); w.y = pk2(ec.z * S2, ec.w * S3);
                *(u32x2*)(UT + ((size_t)u * 128 + v) * 128 + k0) = w;
                S0 = dc.x * S0 + bflo(uc.x); S1 = dc.y * S1 + bfhi(uc.x); S2 = dc.z * S2 + bflo(uc.y); S3 = dc.w * S3 + bfhi(uc.y);
                u += ustep;
            }
        }
    }
}

constexpr int HG_OUT = HG_Bq + 64 * HG_QKROW;
__device__ __forceinline__ void hg3_phase(int bx, int G, const float* GF, const float* GB, const bf16_t* HQ, const bf16_t* HV, const bf16_t* ST, const bf16_t* BG, const float* gainH, bf16_t* AO, LAS unsigned char* lds) {
    int tid_ = threadIdx.x; asm volatile("" : "+v"(tid_));
    const int tid = tid_, wave = __builtin_amdgcn_readfirstlane(tid >> 6), lane = tid & 63;
    const int k = tid & 127, j = tid >> 7;
    const int tb = wave & 3, vh = wave >> 2, i16 = lane & 15, g4 = lane >> 4;
    float gf[16], gb[16]; unsigned short qr[16];
#define HG3_LOAD(uu) do { const int u_ = (uu), cch_ = u_ & 63, bh_ = u_ >> 6, tok_ = (bh_ >> 2) * SEQ + cch_ * 64, h_ = bh_ & 3; \
        hg_load_g(GF, tok_, h_, k, j, gf); hg_load_g(GB, tok_, h_, k, j, gb); \
        const bf16_t* qp = HQ + (size_t)(tok_ + 16 * j) * 512 + h_ * 128 + k; \
        _Pragma("unroll") for (int i = 0; i < 16; ++i) qr[i] = qp[(size_t)i * 512]; } while (0)
    if (bx < 1024) HG3_LOAD(bx);
  for (int u3 = bx; u3 < 1024; u3 += G) {
    const int cch = u3 & 63, bh = u3 >> 6, b = bh >> 2, h = bh & 3;
    const int tok0 = b * SEQ + cch * 64;
    hg_load_v(HV, tok0, h, lds, tid);
    u32x4 bgq[2];
    { const bf16_t* bgp0 = BG + (size_t)(tok0 + (tid >> 3)) * 512 + h * 128 + 16 * (tid & 7); bgq[0] = *(const u32x4*)bgp0; bgq[1] = *(const u32x4*)(bgp0 + 8); }
    bf16x8 sb[16];
    { const bf16_t* stp = ST + ((size_t)((bh * 64 + cch) * 2 + 0) * 128) * 128;
#pragma unroll
      for (int vv = 0; vv < 4; ++vv)
#pragma unroll
        for (int ks = 0; ks < 4; ++ks) sb[vv * 4 + ks] = *(const bf16x8*)(stp + (size_t)(16 * (4 * vh + vv) + i16) * 128 + 32 * ks + 8 * g4); }
    f32x4 oacc[4];
#pragma unroll
    for (int i = 0; i < 4; ++i) oacc[i] = (f32x4){0.f, 0.f, 0.f, 0.f};
#pragma unroll
    for (int dir = 0; dir < 2; ++dir) {
        float d[16], m, tot;
        hg_cumsum(dir ? gb : gf, dir, k, j, lds, d, m, tot);
#pragma unroll
        for (int i = 0; i < 16; ++i) {
            const float gvi = dir ? gb[i] : gf[i];
            const float kt = (1.0f - __expf(gvi)) * __expf(fminf(-d[i], 40.f));
            const float qt = bf2f(qr[i]) * __expf(fminf(d[i], 40.f));
            *(LAS unsigned short*)(lds + HG_A + (16 * j + i) * HG_QKROW + k * 2) = (unsigned short)f2bf(kt);
            *(LAS unsigned short*)(lds + HG_Bq + (16 * j + i) * HG_QKROW + k * 2) = (unsigned short)f2bf(qt);
        }
        if (dir == 1 && u3 + G < 1024) HG3_LOAD(u3 + G);
        __syncthreads();
        f32x4 pt[4];
#pragma unroll
        for (int sg = 0; sg < 4; ++sg) pt[sg] = (f32x4){0.f, 0.f, 0.f, 0.f};
        bf16x8 qa[4];
#pragma unroll
        for (int ks = 0; ks < 4; ++ks) qa[ks] = *(const LAS bf16x8*)(lds + HG_Bq + (16 * tb + i16) * HG_QKROW + (32 * ks + 8 * g4) * 2);
#pragma unroll
        for (int sg = 0; sg < 4; ++sg)
#pragma unroll
            for (int ks = 0; ks < 4; ++ks) {
                const bf16x8 ka = *(const LAS bf16x8*)(lds + HG_A + (16 * sg + i16) * HG_QKROW + (32 * ks + 8 * g4) * 2);
                pt[sg] = __builtin_amdgcn_mfma_f32_16x16x32_bf16(ka, qa[ks], pt[sg], 0, 0, 0);
            }
        const int tcol = 16 * tb + i16;
#pragma unroll
        for (int sg = 0; sg < 4; ++sg)
#pragma unroll
            for (int e = 0; e < 4; ++e) { const int srow = 16 * sg + 4 * g4 + e; const bool keep = dir ? (srow >= tcol) : (srow <= tcol); pt[sg][e] = keep ? pt[sg][e] : 0.f; }
        bf16x8 pa[2];
#pragma unroll
        for (int s2 = 0; s2 < 2; ++s2) {
            u32x4 w; w.x = pk2(pt[2 * s2][0], pt[2 * s2][1]); w.y = pk2(pt[2 * s2][2], pt[2 * s2][3]); w.z = pk2(pt[2 * s2 + 1][0], pt[2 * s2 + 1][1]); w.w = pk2(pt[2 * s2 + 1][2], pt[2 * s2 + 1][3]);
            pa[s2] = __builtin_bit_cast(bf16x8, w);
        }
        const LAS unsigned char* vbase = lds + HG_V + (4 * g4 + (i16 >> 2)) * HG_VROW + (i16 & 3) * 8;
#pragma unroll
        for (int vv = 0; vv < 4; ++vv) {
            const int vt = 4 * vh + vv;
#pragma unroll
            for (int s2 = 0; s2 < 2; ++s2) {
                const s16x4 t0 = tr_read(vbase + (32 * s2) * HG_VROW + vt * 32), t1 = tr_read(vbase + (32 * s2 + 16) * HG_VROW + vt * 32);
                const bf16x8 bv = {t0[0], t0[1], t0[2], t0[3], t1[0], t1[1], t1[2], t1[3]};
                oacc[vv] = __builtin_amdgcn_mfma_f32_16x16x32_bf16(pa[s2], bv, oacc[vv], 0, 0, 0);
            }
#pragma unroll
            for (int ks = 0; ks < 4; ++ks) oacc[vv] = __builtin_amdgcn_mfma_f32_16x16x32_bf16(qa[ks], sb[vv * 4 + ks], oacc[vv], 0, 0, 0);
        }
        if (dir == 0) {
            const bf16_t* stp = ST + ((size_t)((bh * 64 + cch) * 2 + 1) * 128) * 128;
#pragma unroll
            for (int vv = 0; vv < 4; ++vv)
#pragma unroll
                for (int ks = 0; ks < 4; ++ks) sb[vv * 4 + ks] = *(const bf16x8*)(stp + (size_t)(16 * (4 * vh + vv) + i16) * 128 + 32 * ks + 8 * g4);
        }
        __syncthreads();
    }
    LAS float* ot = (LAS float*)(lds + HG_OUT);
#pragma unroll
    for (int vv = 0; vv < 4; ++vv)
#pragma unroll
        for (int e = 0; e < 4; ++e) ot[(16 * tb + 4 * g4 + e) * 132 + 16 * (4 * vh + vv) + i16] = oacc[vv][e];
    __syncthreads();
    {
        const int t = tid >> 3, part = tid & 7;
        float v[16]; float ss = 0.f;
#pragma unroll
        for (int i = 0; i < 4; ++i) { const f32x4 x = *(const LAS f32x4*)(ot + t * 132 + 16 * part + 4 * i); v[4 * i] = x.x; v[4 * i + 1] = x.y; v[4 * i + 2] = x.z; v[4 * i + 3] = x.w; ss += (x.x * x.x + x.y * x.y) + (x.z * x.z + x.w * x.w); }
        ss += __shfl_xor(ss, 1); ss += __shfl_xor(ss, 2); ss += __shfl_xor(ss, 4);
        const float rs = rsqrtf(ss * (1.0f / 128.0f) + EPS);
        const float* gp = gainH + h * 128 + 16 * part;
        bf16_t* dst = AO + (size_t)(tok0 + t) * 1024 + 512 + h * 128 + 16 * part;
#pragma unroll
        for (int i = 0; i < 2; ++i) {
            const u32x4 gq = bgq[i];
            const f32x4 g0 = *(const f32x4*)(gp + 8 * i), g1 = *(const f32x4*)(gp + 8 * i + 4);
            u32x4 w;
            w.x = pk2(v[8 * i] * rs * g0.x * bflo(gq.x), v[8 * i + 1] * rs * g0.y * bfhi(gq.x)); w.y = pk2(v[8 * i + 2] * rs * g0.z * bflo(gq.y), v[8 * i + 3] * rs * g0.w * bfhi(gq.y));
            w.z = pk2(v[8 * i + 4] * rs * g1.x * bflo(gq.z), v[8 * i + 5] * rs * g1.y * bfhi(gq.z)); w.w = pk2(v[8 * i + 6] * rs * g1.z * bflo(gq.w), v[8 * i + 7] * rs * g1.w * bfhi(gq.w));
            *(u32x4*)(dst + 8 * i) = w;
        }
    }
    __syncthreads();
  }
#undef HG3_LOAD
}

#define XB_TMO      128
#define XB_XCNT(j)  (256  + 64 * (j))
#define XB_XSUB(j)  (1280 + 64 * (j))
#define XB_XGEN(j)  (2304 + 64 * (j))
#define XB_TOP      3328
#define XB_TOPGEN   3392
#define XCD_BAR_WORDS 3456
#define XB_SPIN_CAP (1u << 18)

__device__ __forceinline__ unsigned xb_ld(unsigned* p)              { return __hip_atomic_load(p, __ATOMIC_RELAXED, __HIP_MEMORY_SCOPE_AGENT); }
__device__ __forceinline__ unsigned xb_add(unsigned* p, unsigned v) { return __hip_atomic_fetch_add(p, v, __ATOMIC_RELAXED, __HIP_MEMORY_SCOPE_AGENT); }
__device__ __forceinline__ unsigned xb_xcc_id() { return (unsigned)__builtin_amdgcn_s_getreg((3 << 11) | 20) & 0xFu; }
#define XB_SPIN(cond, bar) do { unsigned _sp = 0; while (cond) { __builtin_amdgcn_s_sleep(1); \
    if ((++_sp & 255u) == 0u) { if (xb_ld(&(bar)[XB_TMO])) break; if (_sp > XB_SPIN_CAP) { atomicAdd(&(bar)[XB_TMO], 1u); break; } } } } while (0)

struct XcdBarrier {
    unsigned* bar; unsigned x;
    volatile LAS unsigned* st;
};

__device__ __forceinline__ XcdBarrier xcd_barrier_post(unsigned* bar, volatile LAS unsigned* st) {
    XcdBarrier b; b.bar = bar; b.x = xb_xcc_id(); b.st = st;
    if (threadIdx.x == 0) (void)xb_add(&bar[XB_XCNT(b.x)], 1u);
    return b;
}
__device__ __forceinline__ void xcd_barrier_complete(unsigned* bar, unsigned x, unsigned& nloc, unsigned& nx) {
    const unsigned G = gridDim.x * gridDim.y * gridDim.z;
    unsigned sum, cnt, mine, sp = 0u;
    for (;;) {
        sum = 0u; cnt = 0u; mine = 0u;
#pragma unroll
        for (unsigned j = 0; j < 16; ++j) { const unsigned c = xb_ld(&bar[XB_XCNT(j)]); sum += c; cnt += (c > 0u) ? 1u : 0u; mine = (j == x) ? c : mine; }
        if (sum == G) break;
        __builtin_amdgcn_s_sleep(1);
        if ((++sp & 255u) == 0u) { if (xb_ld(&bar[XB_TMO])) break; if (sp > XB_SPIN_CAP) { atomicAdd(&bar[XB_TMO], 1u); break; } }
    }
    nloc = mine > 0u ? mine : 1u; nx = cnt > 0u ? cnt : 1u;
}

__device__ __forceinline__ void xcd_barrier(const XcdBarrier& b) {
    asm volatile("s_waitcnt vmcnt(0)" ::: "memory");
    __syncthreads();
    if (threadIdx.x == 0) {
        unsigned* bar = b.bar;
        __builtin_amdgcn_s_waitcnt(0);
        unsigned nloc = b.st[0], nx = b.st[1];
        if (nloc == 0u) { xcd_barrier_complete(bar, b.x, nloc, nx); b.st[0] = nloc; b.st[1] = nx; }
        const unsigned old = xb_add(&bar[XB_XSUB(b.x)], 1u);
        const unsigned gen = old / nloc;
        if (old + 1u == (gen + 1u) * nloc) {
            __builtin_amdgcn_fence(__ATOMIC_RELEASE, "agent");
            asm volatile("s_waitcnt vmcnt(0)" ::: "memory");
            const unsigned og = xb_add(&bar[XB_TOP], 1u);
            const unsigned tg = og / nx;
            if (og + 1u == (tg + 1u) * nx) xb_add(&bar[XB_TOPGEN], 1u);
            else XB_SPIN(xb_ld(&bar[XB_TOPGEN]) == tg, bar);
            __builtin_amdgcn_fence(__ATOMIC_ACQUIRE, "agent");
            xb_add(&bar[XB_XGEN(b.x)], 1u);
            asm volatile("s_waitcnt vmcnt(0)" ::: "memory");
        } else {
            XB_SPIN(xb_ld(&bar[XB_XGEN(b.x)]) == gen, bar);
            __builtin_amdgcn_fence(__ATOMIC_ACQUIRE, "agent");
            asm volatile("s_waitcnt vmcnt(0)" ::: "memory");
        }
    }
    __syncthreads();
}

__global__ void __launch_bounds__(512, 2) fwd_kernel(Ptrs Pk) {
    extern __shared__ __attribute__((aligned(16))) unsigned char lds_raw[];
    LAS unsigned char* lds = (LAS unsigned char*)lds_raw;
    cg::grid_group grid = cg::this_grid();
    const int G = gridDim.x, bx = blockIdx.x;
    const int lo = Pk.ph_lo, hi = Pk.ph_hi;
    int ph = 0;
    if (threadIdx.x < 4) ((LAS unsigned*)(lds + 131072 + 1024))[threadIdx.x] = 0u;
    __syncthreads();
    XcdBarrier xbar = xcd_barrier_post((unsigned*)(Pk.ws + OFF_BAR), (volatile LAS unsigned*)(lds + 131072 + 1024));
#ifdef TS_A
    if (threadIdx.x == 0) { LAS unsigned long long* TS_ = (LAS unsigned long long*)(lds + 131072); for (int i = 0; i < 15; ++i) TS_[i] = 0ull; TS_[15] = __builtin_amdgcn_s_memrealtime(); }
#endif
#ifndef PH_MASK
#define PH_MASK 0xFFFFFFFFu
#endif
#define ON(id) constexpr (((PH_MASK) >> (id)) & 1u)
#if defined(__HIP_DEVICE_COMPILE__)
#define LOAD_ARGS(P) int zoff_ = 0; asm volatile("" : "+s"(zoff_)); const Ptrs P = *(const __attribute__((address_space(4))) Ptrs*)((const __attribute__((address_space(4))) char*)__builtin_amdgcn_kernarg_segment_ptr() + zoff_);
#else
#define LOAD_ARGS(P) const Ptrs P = Pk;
#endif
#define PHASE_BEGIN if (ph >= lo && ph < hi) { LOAD_ARGS(P) unsigned char* ws = P.ws; asm volatile("" : "+s"(ws)); int tid = threadIdx.x; asm volatile("" : "+v"(tid)); \
    const int lane = tid & 63, wave = __builtin_amdgcn_readfirstlane(tid >> 6), gw = bx * 8 + wave, ngw = G * 8; (void)lane; (void)gw; (void)ngw;
#define XB ((bf16_t*)(ws + OFF_XB))
#define RSA ((float*)(ws + OFF_RSA))
#define RSB ((float*)(ws + OFF_RSB))
#define CS ((const float*)(ws + OFF_CS))
#define LB ((const float*)(ws + OFF_LB))
#define LAM ((const float*)(ws + OFF_LAM))
#define Dg ((float*)(ws + OFF_DG))
#define Eg ((float*)(ws + OFF_EG))
#define GATE ((bf16_t*)(ws + OFF_GATE))
#define Qb ((bf16_t*)(ws + OFF_Q))
#define Kb ((bf16_t*)(ws + OFF_K))
#define Vb ((bf16_t*)(ws + OFF_V))
#define HQ ((bf16_t*)(ws + OFF_HQ))
#define HV ((bf16_t*)(ws + OFF_HV))
#define GF ((float*)(ws + OFF_GF))
#define GB ((float*)(ws + OFF_GB))
#define Yb ((bf16_t*)(ws + OFF_Y))
#define BG ((bf16_t*)(ws + OFF_BG))
#define AO ((bf16_t*)(ws + OFF_AO))
#define UT ((bf16_t*)(ws + OFF_UT))
#define Hb ((bf16_t*)(ws + OFF_H))
#ifdef TS_A
#define TICK(cat) do { if (bx == 0 && threadIdx.x == 0) { LAS unsigned long long* TS_ = (LAS unsigned long long*)(lds + 131072); const unsigned long long t_ = __builtin_amdgcn_s_memrealtime(); TS_[cat] += t_ - TS_[15]; TS_[15] = t_; } } while (0)
#else
#define TICK(cat) do { } while (0)
#endif
#define PHASE_END(cat)   TICK(cat); if (ph + 1 < hi) { if (ph == 0) grid.sync(); else xcd_barrier(xbar); TICK(13); } } ++ph;

    PHASE_BEGIN
        if ON(0) prologue(P, lds, gw, ngw, wave, lane);
        if ON(6) convert_layer(P, 0, ws, lds, gw, ngw, wave, lane);
    PHASE_END(0)

    for (int layer = 0; layer < DEPTH; ++layer) {
        PHASE_BEGIN
            pg8::Gemm g{XB, (const bf16_t*)(ws + (size_t)(layer & 1) * WSZ + W_IN), Dm, Dm, Dm, 1 << 30, 0, -1};
            pg8::StaticOrder S; S.init(M, 4096, G, bx);
            EpiMix E{RSB, CS, LB + (0 * 4 + layer) * 512, LB + (1 * 4 + layer) * 512, Qb, Kb, Vb, HQ, HV, BG, GF, GB};
            if ON(1) pg8::gemm_phase(lds, g, S, E);
        PHASE_END(1)
        PHASE_BEGIN
            const float lam_init = 0.8f - 0.6f * __expf(-0.3f * (float)layer);
            const float lam = LAM[layer];
            if ON(2) for (int i = 0; i * G + bx < 512; ++i) {
                const int uid = i * G + bx; const int round = uid >> 8, r = uid & 255;
                const int bhh = round * 8 + (r & 7), qb = r >> 3;
                attn_unit(bhh >> 2, bhh & 3, qb, Qb, Kb, Vb, AO, P.da_norm + layer * 512, 1.0f - lam_init, lam, lds);
            }
            TICK(2);
            if ON(3) hg1_phase(bx, G, GF, GB, HV, UT, Dg, Eg, lds);
        PHASE_END(3)
        PHASE_BEGIN
            {
                pg8::Gemm g{XB, (const bf16_t*)(ws + (size_t)(layer & 1) * WSZ + W_IN) + (size_t)4096 * Dm, Dm, Dm, Dm, 1 << 30, 0, -1};
                pg8::StaticOrder S; S.init(M, 2048, G, bx);
                EpiGate E{RSB, GATE};
                if ON(4) pg8::gemm_phase(lds, g, S, E);
            }
            TICK(4);
            if ON(5) hg2_scan(UT, Dg, Eg, bx * 512 + tid, G * 512);
            TICK(5);
            if ON(6) if (layer + 1 < DEPTH) convert_layer(P, layer + 1, ws + (size_t)((layer + 1) & 1) * WSZ, lds, gw, ngw, wave, lane);
        PHASE_END(6)
        PHASE_BEGIN
            if ON(7) hg3_phase(bx, G, GF, GB, HQ, HV, UT, BG, P.hg_norm + layer * 512, AO, lds);
        PHASE_END(7)
        PHASE_BEGIN
            pg8::Gemm g{AO, (const bf16_t*)(ws + (size_t)(layer & 1) * WSZ + W_AB), 1024, 1024, 1024, 1 << 30, 0, 8};
            pg8::StaticOrder S; S.init(M, 1024, G, bx);
            EpiY E{GATE, Yb};
            if ON(8) pg8::gemm_phase(lds, g, S, E);
        PHASE_END(8)
        PHASE_BEGIN
            pg8::Gemm g{Yb, (const bf16_t*)(ws + (size_t)(layer & 1) * WSZ + W_O2), 1024, 1024, 1024, 1 << 30, 0, -1};
            pg8::StaticOrder S; S.init(M, Dm, G, bx);
            EpiRes E{layer == 0 ? P.x : P.out, P.out, XB, RSA};
            if ON(9) pg8::gemm_phase(lds, g, S, E);
        PHASE_END(9)
        PHASE_BEGIN
            pg8::Gemm g{XB, (const bf16_t*)(ws + (size_t)(layer & 1) * WSZ + W_GU), Dm, Dm, Dm, 1 << 30, 0, -1};
            pg8::StaticOrder S; S.init(M, 2 * FF, G, bx);
            EpiGU E{RSA, Hb};
            if ON(10) pg8::gemm_phase(lds, g, S, E);
        PHASE_END(10)
        PHASE_BEGIN
            pg8::Gemm g{Hb, (const bf16_t*)(ws + (size_t)(layer & 1) * WSZ + W_D), FF, FF, FF, 1 << 30, 0, -1};
            pg8::StaticOrder S; S.init(M, Dm, G, bx);
            EpiRes E{P.out, P.out, XB, RSB};
            if ON(11) pg8::gemm_phase(lds, g, S, E);
        PHASE_END(11)
    }
    PHASE_BEGIN
        if ON(12) for (int r = gw; r < M; r += ngw) {
            f32x4* xr = (f32x4*)(P.out + (size_t)r * Dm) + lane;
            f32x4 v[4]; float ss = 0.f;
#pragma unroll
            for (int j = 0; j < 4; ++j) { v[j] = xr[64 * j]; ss += (v[j].x * v[j].x + v[j].y * v[j].y) + (v[j].z * v[j].z + v[j].w * v[j].w); }
            const float rs = rsqrtf(wave_sum(ss) * (1.0f / Dm) + EPS);
#pragma unroll
            for (int j = 0; j < 4; ++j) { const f32x4 gn = *((const f32x4*)P.final_norm + lane + 64 * j); xr[64 * j] = (f32x4){v[j].x * rs * gn.x, v[j].y * rs * gn.y, v[j].z * rs * gn.z, v[j].w * rs * gn.w}; }
        }
    PHASE_END(12)
#ifdef TS_A
    if (bx == 0 && threadIdx.x == 0) {
        LAS unsigned long long* TS_ = (LAS unsigned long long*)(lds + 131072);
        unsigned long long a = 0;
        for (int i = 0; i < 15; ++i) { if ((TS_A >> i) & 1) a += TS_[i]; }
        const unsigned long long t_end = __builtin_amdgcn_s_memrealtime() + a;
        while (__builtin_amdgcn_s_memrealtime() < t_end) __builtin_amdgcn_s_sleep(20);
    }
#endif
}
constexpr int NPHASES = 2 + 8 * DEPTH;

#ifndef MK_PER_PHASE
#define MK_PER_PHASE 0
#endif

extern "C" void kernel_launch(void* const* d_in, const int* in_sizes, int n_in, void* d_out, int out_size, void* d_ws, size_t ws_size, hipStream_t stream) {
    static int grid = 0;
    if (grid == 0) {
        if (n_in != 16 || out_size != M * Dm || ws_size < WS_END) { fprintf(stderr, "kernel_launch: unexpected sizes (n_in %d, out %d, ws %zu, need %zu)\n", n_in, out_size, ws_size, (size_t)WS_END); grid = -1; return; }
        int dev = 0, cus = 0, per_cu = 0;
        (void)hipGetDevice(&dev);
        (void)hipDeviceGetAttribute(&cus, hipDeviceAttributeMultiprocessorCount, dev);
        if (hipFuncSetAttribute((const void*)fwd_kernel, hipFuncAttributeMaxDynamicSharedMemorySize, LDS_BYTES) != hipSuccess) { fprintf(stderr, "kernel_launch: hipFuncSetAttribute failed\n"); grid = -1; return; }
        (void)hipOccupancyMaxActiveBlocksPerMultiprocessor(&per_cu, (const void*)fwd_kernel, 512, LDS_BYTES);
        (void)hipGetLastError();
        if (per_cu < 1) per_cu = 1;
        grid = cus * 1;
        fprintf(stderr, "kernel_launch: grid %d (per_cu %d), ws %zu need %zu\n", grid, per_cu, ws_size, (size_t)WS_END);
    }
    if (grid < 0) return;
    Ptrs p{};
    p.x = (const float*)d_in[0]; p.pos = (const int*)d_in[1]; p.w_in = (const float*)d_in[2]; p.da_lambda = (const float*)d_in[3]; p.da_norm = (const float*)d_in[4];
    p.hg_lb = (const float*)d_in[5]; p.hg_norm = (const float*)d_in[6]; p.w_a = (const float*)d_in[7]; p.w_b = (const float*)d_in[8]; p.w_o = (const float*)d_in[9];
    p.attn_norm = (const float*)d_in[10]; p.ffn_norm = (const float*)d_in[11]; p.w_gate = (const float*)d_in[12]; p.w_up = (const float*)d_in[13]; p.w_down = (const float*)d_in[14];
    p.final_norm = (const float*)d_in[15];
    p.out = (float*)d_out; p.ws = (unsigned char*)d_ws;
    (void)hipMemsetAsync((char*)d_ws + OFF_BAR, 0, BAR_BYTES, stream);
#if MK_PER_PHASE
    for (int ph = 0; ph < NPHASES; ++ph) {
        p.ph_lo = ph; p.ph_hi = ph + 1;
        hipLaunchKernelGGL(fwd_kernel, dim3(grid), dim3(512), LDS_BYTES, stream, p);
    }
#else
    p.ph_lo = 0; p.ph_hi = NPHASES;
    void* args[] = {&p};
    hipError_t e = hipLaunchCooperativeKernel((const void*)fwd_kernel, dim3(grid), dim3(512), args, LDS_BYTES, stream);
    if (e != hipSuccess) fprintf(stderr, "cooperative launch failed: %s (grid %d)\n", hipGetErrorString(e), grid);
#endif
}
```

```cpp
#include <hip/hip_runtime.h>
#include <hip/hip_cooperative_groups.h>
#include <cstdio>
#include <cstdint>
namespace cg = cooperative_groups;

#define LAS __attribute__((address_space(3)))
typedef unsigned short bf16_t;
typedef short bf16x8 __attribute__((ext_vector_type(8)));
typedef short s16x4 __attribute__((ext_vector_type(4)));
typedef float f32x4 __attribute__((ext_vector_type(4)));
typedef float f32x16 __attribute__((ext_vector_type(16)));
typedef unsigned u32x4 __attribute__((ext_vector_type(4)));
typedef unsigned u32x2 __attribute__((ext_vector_type(2)));

constexpr int Dm = 1024, NB = 4, SEQ = 4096, M = NB * SEQ, DEPTH = 4, FF = 2816, INW = 6144;
constexpr float EPS = 1e-6f;
constexpr float LOG2E = 1.4426950408889634f;

constexpr size_t W_IN = 0, W_AB = 12582912, W_O2 = 14680064, W_GU = 18874368, W_D = 30408704, WSZ = 36175872;
constexpr size_t MiB = 1048576;
constexpr size_t OFF_XB = 2 * WSZ;
constexpr size_t OFF_RSA = OFF_XB + 32 * MiB;
constexpr size_t OFF_RSB = OFF_RSA + MiB;
constexpr size_t OFF_CS = OFF_RSB + MiB;
constexpr size_t OFF_LB = OFF_CS + MiB;
constexpr size_t OFF_LAM = OFF_LB + 16384;
constexpr size_t OFF_DG = OFF_LAM + 256;
constexpr size_t OFF_EG = OFF_DG + MiB;
constexpr size_t OFF_B = OFF_EG + MiB;
constexpr size_t OFF_GATE = OFF_B;
constexpr size_t OFF_Q = OFF_B, OFF_K = OFF_B + 16 * MiB, OFF_V = OFF_B + 32 * MiB;
constexpr size_t OFF_HQ = OFF_B + 64 * MiB;
constexpr size_t OFF_HV = OFF_HQ + 16 * MiB;
constexpr size_t OFF_GF = OFF_HV + 16 * MiB;
constexpr size_t OFF_GB = OFF_GF + 32 * MiB;
constexpr size_t OFF_Y = OFF_GF;
constexpr size_t OFF_BG = OFF_GB + 32 * MiB;
constexpr size_t OFF_AO = OFF_BG + 16 * MiB;
constexpr size_t OFF_UT = OFF_AO + 32 * MiB;
constexpr size_t OFF_H = OFF_B;
constexpr size_t OFF_BAR = OFF_UT + 64 * MiB;
constexpr size_t BAR_BYTES = 16384;
constexpr size_t WS_END = OFF_BAR + BAR_BYTES;

constexpr int LDS_BYTES = 131072 + 2048;

__device__ __forceinline__ unsigned f2bf(float f) { unsigned u = __builtin_bit_cast(unsigned, f); return (u + 0x7fffu + ((u >> 16) & 1u)) >> 16; }
typedef float f32x2_t __attribute__((ext_vector_type(2)));
typedef __bf16 bf16x2_t __attribute__((ext_vector_type(2)));
__device__ __forceinline__ unsigned pk2(float lo, float hi) { f32x2_t v = {lo, hi}; bf16x2_t b = __builtin_convertvector(v, bf16x2_t); return __builtin_bit_cast(unsigned, b); }
__device__ __forceinline__ float bf2f(unsigned short b) { return __builtin_bit_cast(float, (unsigned)b << 16); }
__device__ __forceinline__ float bflo(unsigned u) { return __builtin_bit_cast(float, u << 16); }
__device__ __forceinline__ float bfhi(unsigned u) { return __builtin_bit_cast(float, u & 0xffff0000u); }
__device__ __forceinline__ float sigmoidf_(float x) { return __builtin_amdgcn_rcpf(1.0f + __expf(-x)); }

namespace pg8 {
constexpr int BM = 256, BK = 64, HALF = 128, HTB = HALF * BK * 2, STAGE_BYTES = 8 * HTB, NXCD = 8, WGM = 8;
__host__ __device__ __forceinline__ int lds_byte(int r, int c) { const int st = (r >> 4) * 2 + (c >> 5), rr = r & 15, cc = c & 31, ob = rr * 64 + cc * 2; return st * 1024 + (ob ^ (((ob >> 9) & 1) << 5)); }
__host__ __device__ __forceinline__ void stage_rc(int b, int& R, int& C) { const int st = b / 1024, sb = b % 1024, swz = sb ^ (((sb >> 9) & 1) << 5); R = (st >> 1) * 16 + swz / 64; C = (st & 1) * 32 + (swz % 64) / 2; }
__host__ __device__ __forceinline__ int perm32(int rho) { const int n = rho >> 4, i = rho & 15; return 8 * (i >> 2) + 4 * n + (i & 3); }

struct Unit { int pm, pn; };
struct Gemm { const bf16_t* A; const bf16_t* Bt; int lda, ldb, K; int split_pn; int split_aoff; int mid_t; };

struct StaticOrder {
    int nM, nN, nwg, G, c;
    __device__ __forceinline__ void init(int M_, int N_, int G_, int c_) { nM = M_ / BM; nN = N_ / BM; nwg = nM * nN; G = G_; c = c_; }
    __device__ bool next(int i, Unit& u) const {
        const long L = (long)i * G + c; if (L >= nwg) return false;
        int wgid = (int)L; { const int q = nwg / NXCD, r = nwg % NXCD, xcd = wgid % NXCD, off = wgid / NXCD; wgid = (xcd < r ? xcd * (q + 1) : r * (q + 1) + (xcd - r) * q) + off; }
        const int nig = WGM * nN, gid = wgid / nig, fm = gid * WGM, gsz = (nM - fm) < WGM ? (nM - fm) : WGM;
        u.pm = fm + ((wgid % nig) % gsz); u.pn = (wgid % nig) / gsz; return true;
    }
};

template <class Epi>
__device__ __forceinline__ void gemm_phase(LAS unsigned char* lds, const Gemm g, const StaticOrder& S, const Epi& E) {
    int tid_ = threadIdx.x; asm volatile("" : "+v"(tid_));
    const int tid = tid_, wid = __builtin_amdgcn_readfirstlane(tid >> 6), lane = tid & 63, wr = wid >> 2, wc = wid & 3, fr = lane & 15, fq = lane >> 4;
    const int K = g.K, nt = K / BK;
    unsigned voffA[2], voffB[2];
#pragma unroll
    for (int i = 0; i < 2; ++i) { int R, C; stage_rc(tid * 16 + i * 8192, R, C); const int Rb = (R & ~31) + perm32(R & 31);
        voffA[i] = (unsigned)(R * g.lda + C) * 2u; voffB[i] = (unsigned)(Rb * g.ldb + C) * 2u; }
    const size_t kstep = (size_t)(BK * 2);
    const size_t hstepA = (size_t)HALF * g.lda * 2, hstepB = (size_t)HALF * g.ldb * 2;
    const size_t tstepA = 2 * hstepA, tstepB = 2 * hstepB;
    const unsigned ldsw = (unsigned)wid * 1024u;
    const int aoff = lds_byte(wr * 64 + fr, fq * 8), boff = lds_byte(wc * 32 + fr, fq * 8);
#define PG8_SA(b, h) (((b) * 2 + (h)) * HTB)
#define PG8_SB(b, h) ((4 + (b) * 2 + (h)) * HTB)
#define PG8_STAGE(bufoff, gbase, voff) do { _Pragma("unroll") for (int _i = 0; _i < 2; ++_i) \
        __builtin_amdgcn_global_load_lds((const unsigned*)((const char*)(gbase) + (voff)[_i]), (LAS unsigned*)(lds + (bufoff) + ldsw + _i * 8192), 16, 0, 0); } while (0)
#define PG8_LDA(dst, b, h) do { _Pragma("unroll") for (int m = 0; m < 4; ++m) _Pragma("unroll") for (int k = 0; k < 2; ++k) dst[m][k] = *(const LAS bf16x8*)(lds + PG8_SA(b, h) + aoff + m * 2048 + k * 1024); } while (0)
#define PG8_LDB(dst, b, h) do { _Pragma("unroll") for (int n = 0; n < 2; ++n) _Pragma("unroll") for (int k = 0; k < 2; ++k) dst[n][k] = *(const LAS bf16x8*)(lds + PG8_SB(b, h) + boff + n * 2048 + k * 1024); } while (0)
#define PG8_MMA(ai, bj, At, Bt) do { __builtin_amdgcn_s_setprio(1); _Pragma("unroll") for (int m = 0; m < 4; ++m) _Pragma("unroll") for (int n = 0; n < 2; ++n) _Pragma("unroll") for (int k = 0; k < 2; ++k) \
        acc[ai][bj][m][n] = __builtin_amdgcn_mfma_f32_16x16x32_bf16(Bt[n][k], At[m][k], acc[ai][bj][m][n], 0, 0, 0); __builtin_amdgcn_s_setprio(0); } while (0)
#define PG8_WAIT_V(n) asm volatile("s_waitcnt vmcnt(" #n ")" ::: "memory")
#define PG8_WAIT_L(n) asm volatile("s_waitcnt lgkmcnt(" #n ")" ::: "memory")
#define PG8_BAR __builtin_amdgcn_s_barrier()
#define PG8_SCHED __builtin_amdgcn_sched_barrier(0)
#define PG8_UA(u) ((const char*)g.A + (size_t)(u).pm * tstepA + (((u).pn >= g.split_pn) ? (size_t)g.split_aoff * 2 : (size_t)0))
    Unit cur, nxt; int ui = 0;
    if (!S.next(0, cur)) return;
    f32x4 acc[2][2][4][2];
#pragma unroll
    for (int a = 0; a < 2; ++a)
#pragma unroll
        for (int b = 0; b < 2; ++b)
#pragma unroll
            for (int m = 0; m < 4; ++m)
#pragma unroll
                for (int n = 0; n < 2; ++n) acc[a][b][m][n] = (f32x4){0.f, 0.f, 0.f, 0.f};
    bf16x8 At[4][2], B0[2][2], B1[2][2];
    const char* cA = PG8_UA(cur); const char* cB = (const char*)g.Bt + (size_t)cur.pn * tstepB;
    PG8_STAGE(PG8_SB(0, 0), cB, voffB); PG8_STAGE(PG8_SB(0, 1), cB + hstepB, voffB); PG8_STAGE(PG8_SA(0, 0), cA, voffA); PG8_STAGE(PG8_SA(0, 1), cA + hstepA, voffA);
    if (wr == 1) PG8_BAR;
    PG8_WAIT_V(2); PG8_BAR;
    PG8_STAGE(PG8_SB(1, 0), cB + kstep, voffB); PG8_STAGE(PG8_SA(1, 0), cA + kstep, voffA); PG8_STAGE(PG8_SB(1, 1), cB + hstepB + kstep, voffB);
    PG8_WAIT_V(6); PG8_BAR;
    for (;;) {
        const bool has_next = S.next(ui + 1, nxt);
        const char* nA = has_next ? PG8_UA(nxt) : cA; const char* nB = has_next ? (const char*)g.Bt + (size_t)nxt.pn * tstepB : cB;
        for (int t = 0; t < nt; t += 2) {
            if constexpr (Epi::HAS_MID) { if (t == g.mid_t) E.mid(acc, cur, wr, wc, fr, fq); }
            const bool last = (t == nt - 2);
            const char* a1 = cA + (size_t)(t + 1) * kstep;
            const char* a2 = last ? nA : cA + (size_t)(t + 2) * kstep; const char* b2 = last ? nB : cB + (size_t)(t + 2) * kstep;
            const char* a3 = a2 + kstep; const char* b3 = b2 + kstep;
            PG8_LDB(B0, 0, 0); PG8_LDB(B1, 0, 1); PG8_SCHED; PG8_LDA(At, 0, 0); PG8_STAGE(PG8_SA(1, 1), a1 + hstepA, voffA);
            PG8_WAIT_V(8); PG8_WAIT_L(0); PG8_BAR; PG8_MMA(0, 0, At, B0); PG8_MMA(0, 1, At, B1); PG8_BAR; PG8_SCHED;
            PG8_LDA(At, 0, 1); PG8_STAGE(PG8_SB(0, 0), b2, voffB); PG8_STAGE(PG8_SB(0, 1), b2 + hstepB, voffB); PG8_STAGE(PG8_SA(0, 0), a2, voffA);
            PG8_WAIT_V(8); PG8_WAIT_L(0); PG8_BAR; PG8_MMA(1, 0, At, B0); PG8_MMA(1, 1, At, B1); PG8_BAR; PG8_SCHED;
            PG8_LDB(B0, 1, 0); PG8_LDB(B1, 1, 1); PG8_SCHED; PG8_LDA(At, 1, 0); PG8_STAGE(PG8_SA(0, 1), a2 + hstepA, voffA);
            PG8_WAIT_V(8); PG8_WAIT_L(0); PG8_BAR; PG8_MMA(0, 0, At, B0); PG8_MMA(0, 1, At, B1); PG8_BAR; PG8_SCHED;
            PG8_LDA(At, 1, 1); PG8_STAGE(PG8_SB(1, 0), b3, voffB); PG8_STAGE(PG8_SB(1, 1), b3 + hstepB, voffB); PG8_STAGE(PG8_SA(1, 0), a3, voffA);
            PG8_WAIT_V(8); PG8_WAIT_L(0); PG8_BAR; PG8_MMA(1, 0, At, B0); PG8_MMA(1, 1, At, B1); PG8_BAR; PG8_SCHED;
        }
        if (wr == 0) PG8_BAR;
        E(acc, cur, wr, wc, fr, fq);
        if (!has_next) break;
#pragma unroll
        for (int a = 0; a < 2; ++a)
#pragma unroll
            for (int b = 0; b < 2; ++b)
#pragma unroll
                for (int m = 0; m < 4; ++m)
#pragma unroll
                    for (int n = 0; n < 2; ++n) acc[a][b][m][n] = (f32x4){0.f, 0.f, 0.f, 0.f};
        cur = nxt; cA = nA; cB = nB; ++ui;
        if (wr == 1) PG8_BAR;
    }
    PG8_WAIT_V(0);
    PG8_BAR;
#undef PG8_SA
#undef PG8_SB
#undef PG8_STAGE
#undef PG8_LDA
#undef PG8_LDB
#undef PG8_MMA
#undef PG8_UA
}
}

__device__ __forceinline__ float row_rs(const float* rsp, int row) {
    const f32x4* p = (const f32x4*)(rsp + (size_t)row * 16);
    f32x4 a = p[0], b = p[1], c = p[2], d = p[3];
    float s = ((a.x + a.y) + (a.z + a.w)) + ((b.x + b.y) + (b.z + b.w)) + ((c.x + c.y) + (c.z + c.w)) + ((d.x + d.y) + (d.z + d.w));
    return __builtin_amdgcn_rsqf(s * (1.0f / Dm) + EPS);
}
__device__ __forceinline__ void rows_rs4(const float* rsp, int row0  , float (&rs)[4]) {
#pragma unroll
    for (int mp = 0; mp < 2; ++mp) {
        f32x4 p[2][4];
#pragma unroll
        for (int m = 0; m < 2; ++m) { const f32x4* q = (const f32x4*)(rsp + (size_t)(row0 + 16 * (2 * mp + m)) * 16);
#pragma unroll
            for (int i = 0; i < 4; ++i) p[m][i] = q[i]; }
#pragma unroll
        for (int m = 0; m < 2; ++m) { float t = 0.f;
#pragma unroll
            for (int i = 0; i < 4; ++i) t += (p[m][i].x + p[m][i].y) + (p[m][i].z + p[m][i].w);
            rs[2 * mp + m] = __builtin_amdgcn_rsqf(t * (1.0f / Dm) + EPS); }
        __builtin_amdgcn_sched_barrier(0);
    }
}
__device__ __forceinline__ void rows_rs2(const float* rsp, int row0, float (&rs)[2]) {
    f32x4 p[2][4];
#pragma unroll
    for (int m = 0; m < 2; ++m) { const f32x4* q = (const f32x4*)(rsp + (size_t)(row0 + 16 * m) * 16);
#pragma unroll
        for (int i = 0; i < 4; ++i) p[m][i] = q[i]; }
#pragma unroll
    for (int m = 0; m < 2; ++m) { float t = 0.f;
#pragma unroll
        for (int i = 0; i < 4; ++i) t += (p[m][i].x + p[m][i].y) + (p[m][i].z + p[m][i].w);
        rs[m] = __builtin_amdgcn_rsqf(t * (1.0f / Dm) + EPS); }
}
__device__ __forceinline__ u32x4 pack8(const float* v) { u32x4 w; w.x = pk2(v[0], v[1]); w.y = pk2(v[2], v[3]); w.z = pk2(v[4], v[5]); w.w = pk2(v[6], v[7]); return w; }

struct EpiMix {
    static constexpr bool HAS_MID = false;
    const float* rsp; const float* cs; const float* lbF; const float* lbB;
    bf16_t *Q, *Kk, *V, *HQ, *HV, *BG; float *GF, *GB;
    template <int GRP>
    __device__ __forceinline__ void run(const f32x4 (&acc)[2][2][4][2], const pg8::Unit& u, int wr, int wc, int fr, int fq) const {
#pragma unroll
        for (int ai = 0; ai < 2; ++ai)
#pragma unroll
        for (int mp = 0; mp < 2; ++mp) {
            const int row0 = u.pm * 256 + ai * 128 + wr * 64 + mp * 32 + fr;
            float rs4[2]; rows_rs2(rsp, row0, rs4);
            const int d0r = (wc * 32 + fq * 8) & 63;
            f32x4 c4r[2], s4r[2];
            if constexpr (GRP <= 1) {
                if (d0r < 16) {
#pragma unroll
                    for (int mm = 0; mm < 2; ++mm) { const float* cp = cs + (size_t)(row0 + 16 * mm) * 16 + (d0r >> 3) * 4; c4r[mm] = *(const f32x4*)cp; s4r[mm] = *(const f32x4*)(cp + 8); }
                }
            }
            __builtin_amdgcn_sched_barrier(0);
#pragma unroll
            for (int mm = 0; mm < 2; ++mm) {
                const int m = 2 * mp + mm;
                const int row = row0 + mm * 16;
                const float rs = rs4[mm];
                const int b = row >> 12, s = row & 4095;
#pragma unroll
                for (int bj = 0; bj < 2; ++bj) {
                    const int col = u.pn * 256 + bj * 128 + wc * 32 + fq * 8;
                    const int jj = col & 511;
                    float v[8];
#pragma unroll
                    for (int e = 0; e < 4; ++e) { v[e] = acc[ai][bj][m][0][e] * rs; v[4 + e] = acc[ai][bj][m][1][e] * rs; }
                    if constexpr (GRP <= 1) {
                        const int d0 = jj & 63;
                        if (d0 < 16) {
                            const f32x4 c4 = c4r[mm], s4 = s4r[mm];
#pragma unroll
                            for (int e = 0; e < 4; ++e) { const float t1 = v[e], t2 = v[4 + e]; v[e] = t1 * c4[e] - t2 * s4[e]; v[4 + e] = t2 * c4[e] + t1 * s4[e]; }
                        }
                        if constexpr (GRP == 0) {
#pragma unroll
                            for (int e = 0; e < 8; ++e) v[e] *= 0.125f * LOG2E;
                        }
                        const int h = jj >> 7, c = (jj >> 6) & 1;
                        bf16_t* dst = (GRP == 0 ? Q : Kk) + ((size_t)(((b * 4 + h) * 2 + c) * SEQ + s)) * 64 + d0;
                        *(u32x4*)dst = pack8(v);
                    } else if constexpr (GRP == 2) {
                        const int h = jj >> 7, d0 = jj & 127;
                        *(u32x4*)(V + ((size_t)((b * 4 + h) * SEQ + s)) * 128 + d0) = pack8(v);
                    } else if constexpr (GRP == 3) {
                        *(u32x4*)(HQ + (size_t)row * 512 + jj) = pack8(v);
                    } else if constexpr (GRP == 4 || GRP == 5) {
                        const float* lbp = (GRP == 4 ? lbF : lbB) + jj;
                        const f32x4 l0 = *(const f32x4*)lbp, l1 = *(const f32x4*)(lbp + 4);
                        float gl[8];
#pragma unroll
                        for (int e = 0; e < 8; ++e) { const float lb = e < 4 ? l0[e] : l1[e - 4]; const float f = lb + (1.0f - lb) * sigmoidf_(v[e]); gl[e] = __builtin_amdgcn_logf(fmaxf(f, 1e-37f)) * 0.6931471805599453f; }
                        float* dst = (GRP == 4 ? GF : GB) + (size_t)row * 512 + jj;
                        *(f32x4*)dst = (f32x4){gl[0], gl[1], gl[2], gl[3]}; *(f32x4*)(dst + 4) = (f32x4){gl[4], gl[5], gl[6], gl[7]};
                    } else if constexpr (GRP == 6) {
                        *(u32x4*)(HV + (size_t)row * 512 + jj) = pack8(v);
                    } else {
#pragma unroll
                        for (int e = 0; e < 8; ++e) v[e] = sigmoidf_(v[e]);
                        *(u32x4*)(BG + (size_t)row * 512 + jj) = pack8(v);
                    }
                }
            }
            __builtin_amdgcn_sched_barrier(0);
        }
    }
    __device__ __forceinline__ void operator()(const f32x4 (&acc)[2][2][4][2], const pg8::Unit& u, int wr, int wc, int fr, int fq) const {
        switch (u.pn >> 1) {
            case 0: run<0>(acc, u, wr, wc, fr, fq); break;
            case 1: run<1>(acc, u, wr, wc, fr, fq); break;
            case 2: run<2>(acc, u, wr, wc, fr, fq); break;
            case 3: run<3>(acc, u, wr, wc, fr, fq); break;
            case 4: run<4>(acc, u, wr, wc, fr, fq); break;
            case 5: run<5>(acc, u, wr, wc, fr, fq); break;
            case 6: run<6>(acc, u, wr, wc, fr, fq); break;
            default: run<7>(acc, u, wr, wc, fr, fq); break;
        }
    }
};

struct EpiGate {
    static constexpr bool HAS_MID = false;
    const float* rsp; bf16_t* G;
    __device__ __forceinline__ void operator()(const f32x4 (&acc)[2][2][4][2], const pg8::Unit& u, int wr, int wc, int fr, int fq) const {
#pragma unroll
        for (int ai = 0; ai < 2; ++ai) {
            const int row0 = u.pm * 256 + ai * 128 + wr * 64 + fr;
            float rs4[4]; rows_rs4(rsp, row0, rs4);
            __builtin_amdgcn_sched_barrier(0);
#pragma unroll
            for (int m = 0; m < 4; ++m) {
                const int row = row0 + m * 16;
                const float rs = rs4[m];
                const int col = u.pn * 128 + wc * 32 + fq * 8;
                float r[8], sb[8];
                const float nrl = -rs * LOG2E;
#pragma unroll
                for (int n = 0; n < 2; ++n) {
                    f32x4 ta = acc[ai][0][m][n] * nrl, tb = acc[ai][1][m][n] * nrl;
                    ta = __builtin_elementwise_min(ta, (f32x4){86.f, 86.f, 86.f, 86.f}); tb = __builtin_elementwise_min(tb, (f32x4){86.f, 86.f, 86.f, 86.f});
                    ta.x = __builtin_amdgcn_exp2f(ta.x); ta.y = __builtin_amdgcn_exp2f(ta.y); ta.z = __builtin_amdgcn_exp2f(ta.z); ta.w = __builtin_amdgcn_exp2f(ta.w);
                    tb.x = __builtin_amdgcn_exp2f(tb.x); tb.y = __builtin_amdgcn_exp2f(tb.y); tb.z = __builtin_amdgcn_exp2f(tb.z); tb.w = __builtin_amdgcn_exp2f(tb.w);
                    ta = ta + 1.0f; tb = tb + 1.0f;
                    f32x4 ia, ib;
                    ia.x = __builtin_amdgcn_rcpf(ta.x); ia.y = __builtin_amdgcn_rcpf(ta.y); ia.z = __builtin_amdgcn_rcpf(ta.z); ia.w = __builtin_amdgcn_rcpf(ta.w);
                    ib.x = __builtin_amdgcn_rcpf(tb.x); ib.y = __builtin_amdgcn_rcpf(tb.y); ib.z = __builtin_amdgcn_rcpf(tb.z); ib.w = __builtin_amdgcn_rcpf(tb.w);
                    const f32x4 rr = tb * ia;
                    r[n * 4] = rr.x; r[n * 4 + 1] = rr.y; r[n * 4 + 2] = rr.z; r[n * 4 + 3] = rr.w;
                    sb[n * 4] = ib.x; sb[n * 4 + 1] = ib.y; sb[n * 4 + 2] = ib.z; sb[n * 4 + 3] = ib.w;
                }
                *(u32x4*)(G + (size_t)row * 2048 + col) = pack8(r);
                *(u32x4*)(G + (size_t)row * 2048 + 1024 + col) = pack8(sb);
            }
            __builtin_amdgcn_sched_barrier(0);
        }
    }
};

struct EpiY {
    static constexpr bool HAS_MID = true;
    const bf16_t* G; bf16_t* Y;
    __device__ __forceinline__ void mid(f32x4 (&acc)[2][2][4][2], const pg8::Unit& u, int wr, int wc, int fr, int fq) const {
        int fr_ = fr; asm volatile("" : "+v"(fr_));
#pragma unroll
        for (int ai = 0; ai < 2; ++ai) {
            __builtin_amdgcn_sched_barrier(0);
#pragma unroll
            for (int m = 0; m < 4; ++m) {
                const int row = u.pm * 256 + ai * 128 + wr * 64 + m * 16 + fr_;
#pragma unroll
                for (int bj = 0; bj < 2; ++bj) {
                    const int col = u.pn * 256 + bj * 128 + wc * 32 + fq * 8;
                    const u32x4 gq = *(const u32x4*)(G + (size_t)row * 2048 + col);
                    acc[ai][bj][m][0][0] *= bflo(gq.x); acc[ai][bj][m][0][1] *= bfhi(gq.x); acc[ai][bj][m][0][2] *= bflo(gq.y); acc[ai][bj][m][0][3] *= bfhi(gq.y);
                    acc[ai][bj][m][1][0] *= bflo(gq.z); acc[ai][bj][m][1][1] *= bfhi(gq.z); acc[ai][bj][m][1][2] *= bflo(gq.w); acc[ai][bj][m][1][3] *= bfhi(gq.w);
                }
            }
        }
        __builtin_amdgcn_sched_barrier(0);
    }
    __device__ __forceinline__ void operator()(const f32x4 (&acc)[2][2][4][2], const pg8::Unit& u, int wr, int wc, int fr, int fq) const {
#pragma unroll
        for (int ai = 0; ai < 2; ++ai) {
            u32x4 gqr[4][2];
#pragma unroll
            for (int m = 0; m < 4; ++m)
#pragma unroll
                for (int bj = 0; bj < 2; ++bj) gqr[m][bj] = *(const u32x4*)(G + (size_t)(u.pm * 256 + ai * 128 + wr * 64 + m * 16 + fr) * 2048 + 1024 + u.pn * 256 + bj * 128 + wc * 32 + fq * 8);
            __builtin_amdgcn_sched_barrier(0);
#pragma unroll
            for (int m = 0; m < 4; ++m) {
                const int row = u.pm * 256 + ai * 128 + wr * 64 + m * 16 + fr;
#pragma unroll
                for (int bj = 0; bj < 2; ++bj) {
                    const int col = u.pn * 256 + bj * 128 + wc * 32 + fq * 8;
                    const u32x4 gq = gqr[m][bj];
                    float v[8];
                    v[0] = acc[ai][bj][m][0][0] * bflo(gq.x); v[1] = acc[ai][bj][m][0][1] * bfhi(gq.x);
                    v[2] = acc[ai][bj][m][0][2] * bflo(gq.y); v[3] = acc[ai][bj][m][0][3] * bfhi(gq.y);
                    v[4] = acc[ai][bj][m][1][0] * bflo(gq.z); v[5] = acc[ai][bj][m][1][1] * bfhi(gq.z);
                    v[6] = acc[ai][bj][m][1][2] * bflo(gq.w); v[7] = acc[ai][bj][m][1][3] * bfhi(gq.w);
                    *(u32x4*)(Y + (size_t)row * 1024 + col) = pack8(v);
                }
            }
            __builtin_amdgcn_sched_barrier(0);
        }
    }
};

struct EpiRes {
    static constexpr bool HAS_MID = false;
    const float* xres; float* xout; bf16_t* XB; float* rsp;
    __device__ __forceinline__ void operator()(const f32x4 (&acc)[2][2][4][2], const pg8::Unit& u, int wr, int wc, int fr, int fq) const {
#pragma unroll
        for (int ai = 0; ai < 2; ++ai)
#pragma unroll
        for (int mp = 0; mp < 2; ++mp) {
            f32x4 xr0[2][2], xr1[2][2];
#pragma unroll
            for (int mm = 0; mm < 2; ++mm)
#pragma unroll
                for (int bj = 0; bj < 2; ++bj) { const float* xr = xres + (size_t)(u.pm * 256 + ai * 128 + wr * 64 + (2 * mp + mm) * 16 + fr) * Dm + u.pn * 256 + bj * 128 + wc * 32 + fq * 8;
                    xr0[mm][bj] = *(const f32x4*)xr; xr1[mm][bj] = *(const f32x4*)(xr + 4); }
            __builtin_amdgcn_sched_barrier(0);
#pragma unroll
            for (int mm = 0; mm < 2; ++mm) {
                const int m = 2 * mp + mm;
                const int row = u.pm * 256 + ai * 128 + wr * 64 + m * 16 + fr;
                float ss = 0.f;
#pragma unroll
                for (int bj = 0; bj < 2; ++bj) {
                    const int col = u.pn * 256 + bj * 128 + wc * 32 + fq * 8;
                    const f32x4 x0 = xr0[mm][bj], x1 = xr1[mm][bj];
                    float v[8];
#pragma unroll
                    for (int e = 0; e < 4; ++e) { v[e] = x0[e] + acc[ai][bj][m][0][e]; v[4 + e] = x1[e] + acc[ai][bj][m][1][e]; }
#pragma unroll
                    for (int e = 0; e < 8; ++e) ss += v[e] * v[e];
                    float* xo = xout + (size_t)row * Dm + col;
                    *(f32x4*)xo = (f32x4){v[0], v[1], v[2], v[3]}; *(f32x4*)(xo + 4) = (f32x4){v[4], v[5], v[6], v[7]};
                    *(u32x4*)(XB + (size_t)row * Dm + col) = pack8(v);
                }
                ss += __shfl_xor(ss, 16); ss += __shfl_xor(ss, 32);
                if (fq == 0) rsp[(size_t)row * 16 + u.pn * 4 + wc] = ss;
            }
            __builtin_amdgcn_sched_barrier(0);
        }
    }
};

struct EpiGU {
    static constexpr bool HAS_MID = false;
    const float* rsp; bf16_t* H;
    __device__ __forceinline__ void operator()(const f32x4 (&acc)[2][2][4][2], const pg8::Unit& u, int wr, int wc, int fr, int fq) const {
#pragma unroll
        for (int ai = 0; ai < 2; ++ai) {
            const int row0 = u.pm * 256 + ai * 128 + wr * 64 + fr;
            float rs4[4]; rows_rs4(rsp, row0, rs4);
            __builtin_amdgcn_sched_barrier(0);
#pragma unroll
            for (int m = 0; m < 4; ++m) {
                const int row = row0 + m * 16;
                const float rs = rs4[m];
                const int col = u.pn * 128 + wc * 32 + fq * 8;
                float v[8];
                const float nrl = -rs * LOG2E, rs2 = rs * rs;
#pragma unroll
                for (int n = 0; n < 2; ++n) {
                    const f32x4 a = acc[ai][0][m][n], b = acc[ai][1][m][n];
                    f32x4 t = a * nrl;
                    t.x = __builtin_amdgcn_exp2f(t.x); t.y = __builtin_amdgcn_exp2f(t.y); t.z = __builtin_amdgcn_exp2f(t.z); t.w = __builtin_amdgcn_exp2f(t.w);
                    t = t + 1.0f;
                    t.x = __builtin_amdgcn_rcpf(t.x); t.y = __builtin_amdgcn_rcpf(t.y); t.z = __builtin_amdgcn_rcpf(t.z); t.w = __builtin_amdgcn_rcpf(t.w);
                    const f32x4 o = ((a * b) * rs2) * t;
                    v[n * 4] = o.x; v[n * 4 + 1] = o.y; v[n * 4 + 2] = o.z; v[n * 4 + 3] = o.w;
                }
                *(u32x4*)(H + (size_t)row * FF + col) = pack8(v);
            }
            __builtin_amdgcn_sched_barrier(0);
        }
    }
};

__device__ __forceinline__ int rope_perm(int n) {
    const int d = n & 63; if (d >= 16) return n;
    const int g = d >> 3, e = d & 7; return (n & ~63) + ((e < 4) ? 4 * g + e : 8 + 4 * g + (e - 4));
}
__device__ __forceinline__ void conv_item(const float* src, int ld_src, int ks0, int c0  , int mode  ,
                                          const float* gain, bf16_t* dst, int ld_dst, int n0, int kd0, LAS float* scr, int lane) {
    const int n4 = lane & 7, kr = lane >> 3;
    int sc = c0 + 4 * n4;
    if (mode) { const int q = (sc & 63) >> 2; if (q == 1) sc += 4; else if (q == 2) sc -= 4; }
#pragma unroll
    for (int i = 0; i < 8; ++i) { const int kk = kr + 8 * i; f32x4 w = *(const f32x4*)(src + (size_t)(ks0 + kk) * ld_src + sc);
        if (gain) { const float gg = gain[ks0 + kk]; w.x *= gg; w.y *= gg; w.z *= gg; w.w *= gg; }
        LAS float* d = scr + kk * 33 + 4 * n4; d[0] = w.x; d[1] = w.y; d[2] = w.z; d[3] = w.w; }
    asm volatile("s_waitcnt lgkmcnt(0)" ::: "memory");
    const int c = lane & 7;
#pragma unroll
    for (int j = 0; j < 4; ++j) { const int n = (lane >> 3) + 8 * j; const LAS float* s = scr + (8 * c) * 33 + n;
        u32x4 o; o.x = pk2(s[0 * 33], s[1 * 33]); o.y = pk2(s[2 * 33], s[3 * 33]); o.z = pk2(s[4 * 33], s[5 * 33]); o.w = pk2(s[6 * 33], s[7 * 33]);
        *(u32x4*)(dst + (size_t)(n0 + n) * ld_dst + kd0 + 8 * c) = o; }
    asm volatile("s_waitcnt lgkmcnt(0)" ::: "memory");
}

struct Ptrs {
    const float *x; const int* pos; const float *w_in, *da_lambda, *da_norm, *hg_lb, *hg_norm, *w_a, *w_b, *w_o, *attn_norm, *ffn_norm, *w_gate, *w_up, *w_down, *final_norm;
    float* out; unsigned char* ws; int ph_lo, ph_hi;
};

__device__ __forceinline__ void convert_layer(const Ptrs& P, int layer, unsigned char* wbuf, LAS unsigned char* lds, int gw, int ngw, int wave, int lane) {
    LAS float* scr = (LAS float*)(lds + wave * 8704);
    constexpr int I_IN = 16 * 192, I_A = 8 * 32, I_B = 8 * 32, I_O = 16 * 32, I_GU = 16 * 176, I_D = 44 * 32;
    constexpr int NIT = I_IN + I_A + I_B + I_O + I_GU + I_D;
    for (int it = gw; it < NIT; it += ngw) {
        int r = it;
        if (r < I_IN) { const int kb = r / 192, nb = r % 192, n0 = nb * 32;
            int c0 = n0; if (n0 >= 4096) { const int q = n0 - 4096, tile = q >> 8, rr = q & 255; c0 = (rr < 128 ? 4096 : 5120) + tile * 128 + (rr & 127); }
            conv_item(P.w_in + (size_t)layer * Dm * INW, INW, kb * 64, c0, n0 < 1024 ? 1 : 0, P.attn_norm + layer * Dm, (bf16_t*)(wbuf + W_IN), Dm, n0, kb * 64, scr, lane); continue; }
        r -= I_IN;
        if (r < I_A) { const int kb = r / 32, nb = r % 32;
            conv_item(P.w_a + (size_t)layer * 512 * Dm, Dm, kb * 64, nb * 32, 0, nullptr, (bf16_t*)(wbuf + W_AB), 1024, nb * 32, kb * 64, scr, lane); continue; }
        r -= I_A;
        if (r < I_B) { const int kb = r / 32, nb = r % 32;
            conv_item(P.w_b + (size_t)layer * 512 * Dm, Dm, kb * 64, nb * 32, 0, nullptr, (bf16_t*)(wbuf + W_AB), 1024, nb * 32, 512 + kb * 64, scr, lane); continue; }
        r -= I_B;
        if (r < I_O) { const int kb = r / 32, nb = r % 32;
            conv_item(P.w_o + (size_t)layer * Dm * Dm, Dm, kb * 64, nb * 32, 0, nullptr, (bf16_t*)(wbuf + W_O2), Dm, nb * 32, kb * 64, scr, lane); continue; }
        r -= I_O;
        if (r < I_GU) { const int kb = r / 176, nb = r % 176, n0 = nb * 32, tile = n0 >> 8, rr = n0 & 255;
            const float* srcm = (rr < 128 ? P.w_gate : P.w_up) + (size_t)layer * Dm * FF;
            conv_item(srcm, FF, kb * 64, tile * 128 + (rr & 127), 0, P.ffn_norm + layer * Dm, (bf16_t*)(wbuf + W_GU), Dm, n0, kb * 64, scr, lane); continue; }
        r -= I_GU;
        { const int kb = r / 32, nb = r % 32;
            conv_item(P.w_down + (size_t)layer * FF * Dm, Dm, kb * 64, nb * 32, 0, nullptr, (bf16_t*)(wbuf + W_D), FF, nb * 32, kb * 64, scr, lane); }
    }
}

__device__ __forceinline__ float wave_sum(float v) {
#pragma unroll
    for (int o = 1; o < 64; o <<= 1) v += __shfl_xor(v, o);
    return v;
}
__device__ __forceinline__ void prologue(const Ptrs& P, LAS unsigned char* lds, int gw, int ngw, int wave, int lane) {
    unsigned char* ws = P.ws;
    bf16_t* XB = (bf16_t*)(ws + OFF_XB); float* rsb = (float*)(ws + OFF_RSB);
    for (int r = gw; r < M; r += ngw) {
        const f32x4* xr = (const f32x4*)(P.x + (size_t)r * Dm) + lane;
        float ss = 0.f;
#pragma unroll
        for (int j = 0; j < 4; ++j) { const f32x4 v = xr[64 * j]; ss += (v.x * v.x + v.y * v.y) + (v.z * v.z + v.w * v.w);
            u32x2 o; o.x = pk2(v.x, v.y); o.y = pk2(v.z, v.w); *((u32x2*)(XB + (size_t)r * Dm) + lane + 64 * j) = o; }
        ss = wave_sum(ss);
        if (lane < 16) rsb[(size_t)r * 16 + lane] = (lane == 0) ? ss : 0.f;
    }
    const int gt = gw * 64 + lane, ngt = ngw * 64;
    float* cs = (float*)(ws + OFF_CS);
    for (int i = gt; i < M * 8; i += ngt) {
        const int tok = i >> 3, f = i & 7;
        const double invf[8] = {1.0, 0.19392274474868576, 0.03760603093086393, 0.007292664737217109, 0.001414213562373095, 0.0002742481756762073, 5.318295896944988e-05, 1.031338537721246e-05};
        double fr;
        switch (f) { case 0: fr = invf[0]; break; case 1: fr = invf[1]; break; case 2: fr = invf[2]; break; case 3: fr = invf[3]; break; case 4: fr = invf[4]; break; case 5: fr = invf[5]; break; case 6: fr = invf[6]; break; default: fr = invf[7]; }
        const float ang32 = (float)P.pos[tok] * (float)fr;
        const double ang = (double)ang32;
        const double rev = ang * 0.15915494309189535;
        const double fracrev = rev - __builtin_floor(rev + 0.5);
        const float a = (float)(fracrev * 6.283185307179586);
        cs[(size_t)tok * 16 + f] = __cosf(a); cs[(size_t)tok * 16 + 8 + f] = __sinf(a);
    }
    float* LB = (float*)(ws + OFF_LB);
    for (int i = gt; i < 2 * 512; i += ngt) {
        const int d = i >> 9, k = i & 511;
        float l[4], mx = -1e30f;
#pragma unroll
        for (int j = 0; j < 4; ++j) { l[j] = P.hg_lb[(size_t)(d * 4 + j) * 512 + k]; mx = fmaxf(mx, l[j]); }
        float e[4], sum = 0.f;
#pragma unroll
        for (int j = 0; j < 4; ++j) { e[j] = __expf(l[j] - mx); sum += e[j]; }
        float cum = 0.f;
#pragma unroll
        for (int j = 0; j < 4; ++j) { if (j > 0) cum += e[j] / sum; LB[(size_t)(d * 4 + j) * 512 + k] = cum; }
    }
    if (gw == 0) {
        float* LAM = (float*)(ws + OFF_LAM);
        for (int l = 0; l < 4; ++l) {
            const float* p = P.da_lambda + l * 256;
            float a = wave_sum(p[lane] * p[64 + lane]), b = wave_sum(p[128 + lane] * p[192 + lane]);
            const float lam_init = 0.8f - 0.6f * __expf(-0.3f * (float)l);
            if (lane == 0) LAM[l] = __expf(a) - __expf(b) + lam_init;
        }
    }
}

constexpr int AT_KROW = 144, AT_VROW = 320, AT_K1 = 64 * AT_KROW, AT_V = 2 * AT_K1, AT_STG = AT_V + 64 * AT_VROW;
constexpr int AT_IMG_ROW = 132;
__device__ __forceinline__ s16x4 tr_read(const LAS unsigned char* p) { return __builtin_bit_cast(s16x4, __builtin_amdgcn_ds_read_tr16_b64_v4i16((LAS s16x4*)p)); }

__device__ __forceinline__ void attn_unit(int b, int h, int qb, const bf16_t* Q, const bf16_t* Kk, const bf16_t* V, bf16_t* AO, const float* gainA  , float one_minus_lam_init, float lam, LAS unsigned char* lds) {
    int tid_ = threadIdx.x; asm volatile("" : "+v"(tid_));
    const int tid = tid_, wave = __builtin_amdgcn_readfirstlane(tid >> 6), lane = tid & 63, c = wave >> 2, wq = wave & 3, r32 = lane & 31, hh = lane >> 5;
    const int q0 = qb * 128 + wq * 32;
    bf16x8 qf[4];
    { const bf16_t* Qp = Q + ((size_t)(((b * 4 + h) * 2 + c) * SEQ + q0 + r32)) * 64 + 8 * hh;
#pragma unroll
      for (int s = 0; s < 4; ++s) qf[s] = *(const bf16x8*)(Qp + 16 * s); }
    f32x16 o[4];
#pragma unroll
    for (int i = 0; i < 4; ++i)
#pragma unroll
        for (int e = 0; e < 16; ++e) o[i][e] = 0.f;
    float mrow = -1e30f, lrow = 0.f;
    const unsigned char* Kg0 = (const unsigned char*)(Kk + ((size_t)((b * 4 + h) * 2 + 0) * SEQ) * 64);
    const unsigned char* Kg1 = (const unsigned char*)(Kk + ((size_t)((b * 4 + h) * 2 + 1) * SEQ) * 64);
    const unsigned char* Vg = (const unsigned char*)(V + ((size_t)(b * 4 + h) * SEQ) * 128);
    const int lk = (tid >> 3) * AT_KROW + (tid & 7) * 16;
    const int lv0 = AT_V + (tid >> 4) * AT_VROW + (tid & 15) * 16, lv1 = lv0 + 32 * AT_VROW;
    u32x4 r0, r1, r2, r3;
    r0 = *(const u32x4*)(Kg0 + tid * 16); r1 = *(const u32x4*)(Kg1 + tid * 16); r2 = *(const u32x4*)(Vg + tid * 16); r3 = *(const u32x4*)(Vg + 8192 + tid * 16);
    *(LAS u32x4*)(lds + lk) = r0; *(LAS u32x4*)(lds + AT_K1 + lk) = r1; *(LAS u32x4*)(lds + lv0) = r2; *(LAS u32x4*)(lds + lv1) = r3;
    r0 = *(const u32x4*)(Kg0 + 8192 + tid * 16); r1 = *(const u32x4*)(Kg1 + 8192 + tid * 16);
    *(LAS u32x4*)(lds + AT_STG + lk) = r0; *(LAS u32x4*)(lds + AT_STG + AT_K1 + lk) = r1;
    __syncthreads();
    const int ka = c * AT_K1 + r32 * AT_KROW + hh * 16;
    const int va = AT_V + (4 * hh + ((lane & 15) >> 2)) * AT_VROW + ((lane >> 4) & 1) * 32 + (lane & 3) * 8;

#define AT_QK(sv, st) do { f32x16 t0_, t1_; _Pragma("unroll") for (int e = 0; e < 16; ++e) { t0_[e] = 0.f; t1_[e] = 0.f; } \
        _Pragma("unroll") for (int ks = 0; ks < 4; ++ks) { \
            const bf16x8 a0 = *(const LAS bf16x8*)(lds + (st) + ka + ks * 32), a1 = *(const LAS bf16x8*)(lds + (st) + ka + 32 * AT_KROW + ks * 32); \
            t0_ = __builtin_amdgcn_mfma_f32_32x32x16_bf16(a0, qf[ks], t0_, 0, 0, 0); t1_ = __builtin_amdgcn_mfma_f32_32x32x16_bf16(a1, qf[ks], t1_, 0, 0, 0); } \
        sv##0 = t0_; sv##1 = t1_; } while (0)
    f32x16 sA0, sA1, sB0, sB1;
    AT_QK(sA, 0);
#define AT_VFRAG(dst, STC, g) do { const LAS unsigned char* vb_ = lds + (STC) + va + (16 * (g)) * AT_VROW; \
        _Pragma("unroll") for (int vt = 0; vt < 4; ++vt) { const s16x4 t0 = tr_read(vb_ + vt * 64), t1 = tr_read(vb_ + vt * 64 + 8 * AT_VROW); \
            dst[vt] = (bf16x8){t0[0], t0[1], t0[2], t0[3], t1[0], t1[1], t1[2], t1[3]}; } } while (0)
#define AT_PV(vf, p) do { __builtin_amdgcn_s_setprio(1); _Pragma("unroll") for (int vt = 0; vt < 4; ++vt) o[vt] = __builtin_amdgcn_mfma_f32_32x32x16_bf16(vf[vt], p, o[vt], 0, 0, 0); __builtin_amdgcn_s_setprio(0); } while (0)
#define AT_SB __builtin_amdgcn_sched_barrier(0)
#define AT_TILE(j, s0, s1, sn, STC  , STN  ) do { \
        if ((j) + 2 < 64) { const size_t go = (size_t)((j) + 2) * 8192; r0 = *(const u32x4*)(Kg0 + go + tid * 16); r1 = *(const u32x4*)(Kg1 + go + tid * 16); } \
        if ((j) + 1 < 64) { const size_t go = (size_t)((j) + 1) * 16384; r2 = *(const u32x4*)(Vg + go + tid * 16); r3 = *(const u32x4*)(Vg + go + 8192 + tid * 16); } \
        bf16x8 kf[4], kg[4], vA[4]; \
        if ((j) + 1 < 64) { _Pragma("unroll") for (int ks = 0; ks < 2; ++ks) { kf[2 * ks] = *(const LAS bf16x8*)(lds + (STN) + ka + ks * 32); kf[2 * ks + 1] = *(const LAS bf16x8*)(lds + (STN) + ka + 32 * AT_KROW + ks * 32); } } \
        AT_SB; \
        float mx = fmaxf(s0[0], s1[0]); \
        _Pragma("unroll") for (int e = 1; e < 16; ++e) mx = fmaxf(mx, fmaxf(s0[e], s1[e])); \
        mx = fmaxf(mx, __shfl_xor(mx, 32)); \
        if (__builtin_amdgcn_ballot_w64(mx > mrow + 8.0f) != 0ull) { \
            const float mnew = fmaxf(mrow, mx), alpha = __builtin_amdgcn_exp2f(mrow - mnew); mrow = mnew; lrow *= alpha; \
            _Pragma("unroll") for (int i = 0; i < 4; ++i) _Pragma("unroll") for (int e = 0; e < 16; ++e) o[i][e] *= alpha; } \
        AT_SB; \
        if ((j) + 1 < 64) { f32x16 t0_, t1_; _Pragma("unroll") for (int e = 0; e < 16; ++e) { t0_[e] = 0.f; t1_[e] = 0.f; } \
            __builtin_amdgcn_s_setprio(1); \
            _Pragma("unroll") for (int ks = 0; ks < 2; ++ks) { t0_ = __builtin_amdgcn_mfma_f32_32x32x16_bf16(kf[2 * ks], qf[ks], t0_, 0, 0, 0); t1_ = __builtin_amdgcn_mfma_f32_32x32x16_bf16(kf[2 * ks + 1], qf[ks], t1_, 0, 0, 0); } \
            AT_SB; \
            _Pragma("unroll") for (int ks = 0; ks < 2; ++ks) { kg[2 * ks] = *(const LAS bf16x8*)(lds + (STN) + ka + (ks + 2) * 32); kg[2 * ks + 1] = *(const LAS bf16x8*)(lds + (STN) + ka + 32 * AT_KROW + (ks + 2) * 32); } \
            AT_SB; \
            _Pragma("unroll") for (int ks = 0; ks < 2; ++ks) { t0_ = __builtin_amdgcn_mfma_f32_32x32x16_bf16(kg[2 * ks], qf[ks + 2], t0_, 0, 0, 0); t1_ = __builtin_amdgcn_mfma_f32_32x32x16_bf16(kg[2 * ks + 1], qf[ks + 2], t1_, 0, 0, 0); } \
            __builtin_amdgcn_s_setprio(0); sn##0 = t0_; sn##1 = t1_; } \
        AT_VFRAG(vA, STC, 0); \
        AT_SB; \
        float ls = 0.f; \
        _Pragma("unroll") for (int e = 0; e < 16; ++e) { s0[e] = __builtin_amdgcn_exp2f(s0[e] - mrow); s1[e] = __builtin_amdgcn_exp2f(s1[e] - mrow); ls += s0[e] + s1[e]; } \
        lrow += ls; \
        bf16x8 pf[2][2]; \
        _Pragma("unroll") for (int s = 0; s < 2; ++s) { u32x4 w0, w1; \
            w0.x = pk2(s0[8 * s + 0], s0[8 * s + 1]); w0.y = pk2(s0[8 * s + 2], s0[8 * s + 3]); w0.z = pk2(s0[8 * s + 4], s0[8 * s + 5]); w0.w = pk2(s0[8 * s + 6], s0[8 * s + 7]); \
            w1.x = pk2(s1[8 * s + 0], s1[8 * s + 1]); w1.y = pk2(s1[8 * s + 2], s1[8 * s + 3]); w1.z = pk2(s1[8 * s + 4], s1[8 * s + 5]); w1.w = pk2(s1[8 * s + 6], s1[8 * s + 7]); \
            pf[0][s] = __builtin_bit_cast(bf16x8, w0); pf[1][s] = __builtin_bit_cast(bf16x8, w1); } \
        AT_SB; \
        AT_PV(vA, pf[0][0]); \
        AT_SB; \
        AT_VFRAG(vA, STC, 1); \
        AT_SB; \
        AT_PV(vA, pf[0][1]); \
        AT_SB; \
          \
        if ((j) + 2 < 64) { *(LAS u32x4*)(lds + (STC) + lk) = r0; *(LAS u32x4*)(lds + (STC) + AT_K1 + lk) = r1; } \
        if ((j) + 1 < 64) { *(LAS u32x4*)(lds + (STN) + lv0) = r2; *(LAS u32x4*)(lds + (STN) + lv1) = r3; } \
        AT_SB; \
        AT_VFRAG(vA, STC, 2); \
        AT_SB; \
        AT_PV(vA, pf[1][0]); \
        AT_SB; \
        AT_VFRAG(vA, STC, 3); \
        AT_SB; \
        AT_PV(vA, pf[1][1]); \
        __syncthreads(); } while (0)
    for (int j = 0; j < 64; j += 2) {
        AT_TILE(j, sA0, sA1, sB, 0, AT_STG);
        AT_TILE(j + 1, sB0, sB1, sA, AT_STG, 0);
    }
#undef AT_TILE
#undef AT_QK
#undef AT_VFRAG
#undef AT_PV
#undef AT_SB
    const float inv = __builtin_amdgcn_rcpf(lrow + __shfl_xor(lrow, 32));
    LAS float* img = (LAS float*)lds;
    const int qrow = wq * 32 + r32;
    if (c == 1) {
        const float sc = -lam * inv;
#pragma unroll
        for (int vt = 0; vt < 4; ++vt)
#pragma unroll
            for (int g = 0; g < 4; ++g)
                *(LAS f32x4*)(img + qrow * AT_IMG_ROW + 32 * vt + 8 * g + 4 * hh) = (f32x4){o[vt][4 * g] * sc, o[vt][4 * g + 1] * sc, o[vt][4 * g + 2] * sc, o[vt][4 * g + 3] * sc};
    }
    __syncthreads();
    if (c == 0) {
#pragma unroll
        for (int vt = 0; vt < 4; ++vt)
#pragma unroll
            for (int g = 0; g < 4; ++g) {
                LAS f32x4* p = (LAS f32x4*)(img + qrow * AT_IMG_ROW + 32 * vt + 8 * g + 4 * hh);
                f32x4 t = *p;
                t.x += o[vt][4 * g] * inv; t.y += o[vt][4 * g + 1] * inv; t.z += o[vt][4 * g + 2] * inv; t.w += o[vt][4 * g + 3] * inv;
                *p = t;
            }
    }
    __syncthreads();
    {
        const int q = tid >> 2, part = tid & 3;
        float v[32]; float ss = 0.f;
#pragma unroll
        for (int i = 0; i < 8; ++i) { const f32x4 t = *(const LAS f32x4*)(img + q * AT_IMG_ROW + 32 * part + 4 * i); v[4 * i] = t.x; v[4 * i + 1] = t.y; v[4 * i + 2] = t.z; v[4 * i + 3] = t.w;
            ss += (t.x * t.x + t.y * t.y) + (t.z * t.z + t.w * t.w); }
        ss += __shfl_xor(ss, 1); ss += __shfl_xor(ss, 2);
        const float rs = rsqrtf(ss * (1.0f / 128.0f) + EPS) * one_minus_lam_init;
        const float* gp = gainA + h * 128 + 32 * part;
        bf16_t* dst = AO + ((size_t)(b * SEQ + qb * 128 + q)) * 1024 + h * 128 + 32 * part;
#pragma unroll
        for (int i = 0; i < 4; ++i) {
            const f32x4 g0 = *(const f32x4*)(gp + 8 * i), g1 = *(const f32x4*)(gp + 8 * i + 4);
            u32x4 w; w.x = pk2(v[8 * i] * rs * g0.x, v[8 * i + 1] * rs * g0.y); w.y = pk2(v[8 * i + 2] * rs * g0.z, v[8 * i + 3] * rs * g0.w);
            w.z = pk2(v[8 * i + 4] * rs * g1.x, v[8 * i + 5] * rs * g1.y); w.w = pk2(v[8 * i + 6] * rs * g1.z, v[8 * i + 7] * rs * g1.w);
            *(u32x4*)(dst + 8 * i) = w;
        }
    }
    __syncthreads();
}

constexpr int HG_SEG = 0;
constexpr int HG_F = 2048;
constexpr int HG_PART = 2560;
constexpr int HG_V = 4096;
constexpr int HG_VROW = 288;
constexpr int HG_A = HG_V + 64 * HG_VROW;
constexpr int HG_KTROW = 144, HG_QKROW = 272;
constexpr int HG_Bq = HG_A + 128 * HG_KTROW;

__device__ __forceinline__ void hg_cumsum(const float (&gv)[16], int dir, int k, int j, LAS unsigned char* lds, float (&d)[16], float& m_out, float& tot_out) {
    float run = 0.f;
    if (dir == 0) {
#pragma unroll
        for (int i = 0; i < 16; ++i) { run += gv[i]; d[i] = run; }
    } else {
#pragma unroll
        for (int i = 15; i >= 0; --i) { run += gv[i]; d[i] = run; }
    }
    LAS float* seg = (LAS float*)(lds + HG_SEG);
    seg[j * 128 + k] = run;
    __syncthreads();
    const float s0 = seg[k], s1 = seg[128 + k], s2 = seg[256 + k], s3 = seg[384 + k];
    float off, m;
    if (dir == 0) { off = (j > 0 ? s0 : 0.f) + (j > 1 ? s1 : 0.f) + (j > 2 ? s2 : 0.f); m = s0 + s1; }
    else { off = (j < 3 ? s3 : 0.f) + (j < 2 ? s2 : 0.f) + (j < 1 ? s1 : 0.f); m = s2 + s3; }
#pragma unroll
    for (int i = 0; i < 16; ++i) d[i] = d[i] + off - m;
    m_out = m; tot_out = (s0 + s1) + (s2 + s3);
}
__device__ __forceinline__ void hg_load_v(const bf16_t* HV, int tok0, int h, LAS unsigned char* lds, int tid) {
#pragma unroll
    for (int i = 0; i < 2; ++i) { const int ch = tid + 512 * i, p = ch >> 4, part = ch & 15;
        *(LAS u32x4*)(lds + HG_V + p * HG_VROW + part * 16) = *(const u32x4*)(HV + (size_t)(tok0 + p) * 512 + h * 128 + part * 8); }
}
__device__ __forceinline__ void hg_load_g(const float* G, int tok0, int h, int k, int j, float (&gv)[16]) {
    const float* gp = G + (size_t)(tok0 + 16 * j) * 512 + h * 128 + k;
#pragma unroll
    for (int i = 0; i < 16; ++i) gv[i] = gp[(size_t)i * 512];
}

__device__ __forceinline__ void hg1_phase(int bx, int G, const float* GF, const float* GB, const bf16_t* HV, bf16_t* UT, float* Dg, float* Eg, LAS unsigned char* lds) {
    int tid_ = threadIdx.x; asm volatile("" : "+v"(tid_));
    const int tid = tid_, wave = __builtin_amdgcn_readfirstlane(tid >> 6), lane = tid & 63;
    const int k = tid & 127, j = tid >> 7, i16 = lane & 15, g4 = lane >> 4;
    float gn[16]; u32x4 vn[2];
#define HG1_LOAD(uu) do { const int u_ = (uu), dir_ = u_ & 1, cch_ = (u_ >> 1) & 63, bh_ = u_ >> 7, tok_ = (bh_ >> 2) * SEQ + cch_ * 64; \
        hg_load_g(dir_ ? GB : GF, tok_, bh_ & 3, k, j, gn); \
        _Pragma("unroll") for (int i = 0; i < 2; ++i) { const int ch = tid + 512 * i; vn[i] = *(const u32x4*)(HV + (size_t)(tok_ + (ch >> 4)) * 512 + (bh_ & 3) * 128 + (ch & 15) * 8); } } while (0)
    if (bx < 2048) HG1_LOAD(bx);
    for (int u = bx; u < 2048; u += G) {
        const int dir = u & 1, cch = (u >> 1) & 63, bh = u >> 7, b = bh >> 2, h = bh & 3;
        const int tok0 = b * SEQ + cch * 64;
        float gv[16], d[16], m, tot;
#pragma unroll
        for (int i = 0; i < 16; ++i) gv[i] = gn[i];
        u32x4 vr[2];
#pragma unroll
        for (int i = 0; i < 2; ++i) vr[i] = vn[i];
        if (u + G < 2048) HG1_LOAD(u + G);
        hg_cumsum(gv, dir, k, j, lds, d, m, tot);
        float kt[16];
#pragma unroll
        for (int i = 0; i < 16; ++i) kt[i] = (1.0f - __expf(gv[i])) * __expf(fminf(-d[i], 40.f));
        { u32x4 w0, w1;
          w0.x = pk2(kt[0], kt[1]); w0.y = pk2(kt[2], kt[3]); w0.z = pk2(kt[4], kt[5]); w0.w = pk2(kt[6], kt[7]);
          w1.x = pk2(kt[8], kt[9]); w1.y = pk2(kt[10], kt[11]); w1.z = pk2(kt[12], kt[13]); w1.w = pk2(kt[14], kt[15]);
          *(LAS u32x4*)(lds + HG_A + k * HG_KTROW + j * 32) = w0; *(LAS u32x4*)(lds + HG_A + k * HG_KTROW + j * 32 + 16) = w1; }
#pragma unroll
        for (int i = 0; i < 2; ++i) { const int ch = tid + 512 * i; *(LAS u32x4*)(lds + HG_V + (ch >> 4) * HG_VROW + (ch & 15) * 16) = vr[i]; }
        if (j == 0) { ((LAS float*)(lds + HG_F))[k] = __expf(tot - m); Dg[(size_t)u * 128 + k] = __expf(tot); Eg[(size_t)u * 128 + k] = __expf(m); }
        __syncthreads();
        bf16x8 af[2];
#pragma unroll
        for (int s = 0; s < 2; ++s) {
            const LAS unsigned char* ap = lds + HG_A + (16 * wave + i16) * HG_KTROW + (32 * s + 4 * g4) * 2;
            const u32x2 lo = *(const LAS u32x2*)ap, hi = *(const LAS u32x2*)(ap + 32);
            af[s] = __builtin_bit_cast(bf16x8, (u32x4){lo.x, lo.y, hi.x, hi.y});
        }
        const f32x4 fsc = *(const LAS f32x4*)(lds + HG_F + (16 * wave + 4 * g4) * 4);
        const LAS unsigned char* vbase = lds + HG_V + (4 * g4 + (i16 >> 2)) * HG_VROW + (i16 & 3) * 8;
#pragma unroll
        for (int vt = 0; vt < 8; ++vt) {
            f32x4 acc = {0.f, 0.f, 0.f, 0.f};
#pragma unroll
            for (int s = 0; s < 2; ++s) {
                const s16x4 t0 = tr_read(vbase + (32 * s) * HG_VROW + vt * 32), t1 = tr_read(vbase + (32 * s + 16) * HG_VROW + vt * 32);
                const bf16x8 bv = {t0[0], t0[1], t0[2], t0[3], t1[0], t1[1], t1[2], t1[3]};
                acc = __builtin_amdgcn_mfma_f32_16x16x32_bf16(af[s], bv, acc, 0, 0, 0);
            }
            u32x2 w; w.x = pk2(acc[0] * fsc[0], acc[1] * fsc[1]); w.y = pk2(acc[2] * fsc[2], acc[3] * fsc[3]);
            *(u32x2*)(UT + ((size_t)u * 128 + 16 * vt + i16) * 128 + 16 * wave + 4 * g4) = w;
        }
        __syncthreads();
    }
}

__device__ __forceinline__ void hg2_scan(bf16_t* UT, const float* Dg, const float* Eg, int gthread, int nthreads) {
    for (int idx = gthread; idx < 32 * 4096; idx += nthreads) {
        const int chain = idx >> 12, e4 = idx & 4095, v = e4 >> 5, k0 = (e4 & 31) * 4;
        const int dir = chain & 1, bh = chain >> 1;
        float S0 = 0.f, S1 = 0.f, S2 = 0.f, S3 = 0.f;
        int u = (bh * 64 + (dir ? 63 : 0)) * 2 + dir;
        const int ustep = dir ? -2 : 2;
        u32x2 uu[4]; f32x4 dd[4], ee[4];
#pragma unroll
        for (int r = 0; r < 4; ++r) { const int ur = u + r * ustep; uu[r] = *(const u32x2*)(UT + ((size_t)ur * 128 + v) * 128 + k0); dd[r] = *(const f32x4*)(Dg + (size_t)ur * 128 + k0); ee[r] = *(const f32x4*)(Eg + (size_t)ur * 128 + k0); }
        for (int cc = 0; cc < 64; cc += 4) {
#pragma unroll
            for (int r = 0; r < 4; ++r) {
                const u32x2 uc = uu[r]; const f32x4 dc = dd[r], ec = ee[r];
                if (cc + 4 < 64) { const int un = u + 4 * ustep; uu[r] = *(const u32x2*)(UT + ((size_t)un * 128 + v) * 128 + k0); dd[r] = *(const f32x4*)(Dg + (size_t)un * 128 + k0); ee[r] = *(const f32x4*)(Eg + (size_t)un * 128 + k0); }
                u32x2 w; w.x = pk2(ec.x * S0, ec.y * S1); w.y = pk2(ec.z * S2, ec.w * S3);
                *(u32x2*)(UT + ((size_t)u * 128 + v) * 128 + k0) = w;
                S0 = dc.x * S0 + bflo(uc.x); S1 = dc.y * S1 + bfhi(uc.x); S2 = dc.z * S2 + bflo(uc.y); S3 = dc.w * S3 + bfhi(uc.y);
                u += ustep;
            }
        }
    }
}

constexpr int HG_OUT = HG_Bq + 64 * HG_QKROW;
__device__ __forceinline__ void hg3_phase(int bx, int G, const float* GF, const float* GB, const bf16_t* HQ, const bf16_t* HV, const bf16_t* ST, const bf16_t* BG, const float* gainH, bf16_t* AO, LAS unsigned char* lds) {
    int tid_ = threadIdx.x; asm volatile("" : "+v"(tid_));
    const int tid = tid_, wave = __builtin_amdgcn_readfirstlane(tid >> 6), lane = tid & 63;
    const int k = tid & 127, j = tid >> 7;
    const int tb = wave & 3, vh = wave >> 2, i16 = lane & 15, g4 = lane >> 4;
    float gf[16], gb[16]; unsigned short qr[16];
#define HG3_LOAD(uu) do { const int u_ = (uu), cch_ = u_ & 63, bh_ = u_ >> 6, tok_ = (bh_ >> 2) * SEQ + cch_ * 64, h_ = bh_ & 3; \
        hg_load_g(GF, tok_, h_, k, j, gf); hg_load_g(GB, tok_, h_, k, j, gb); \
        const bf16_t* qp = HQ + (size_t)(tok_ + 16 * j) * 512 + h_ * 128 + k; \
        _Pragma("unroll") for (int i = 0; i < 16; ++i) qr[i] = qp[(size_t)i * 512]; } while (0)
    if (bx < 1024) HG3_LOAD(bx);
  for (int u3 = bx; u3 < 1024; u3 += G) {
    const int cch = u3 & 63, bh = u3 >> 6, b = bh >> 2, h = bh & 3;
    const int tok0 = b * SEQ + cch * 64;
    hg_load_v(HV, tok0, h, lds, tid);
    u32x4 bgq[2];
    { const bf16_t* bgp0 = BG + (size_t)(tok0 + (tid >> 3)) * 512 + h * 128 + 16 * (tid & 7); bgq[0] = *(const u32x4*)bgp0; bgq[1] = *(const u32x4*)(bgp0 + 8); }
    bf16x8 sb[16];
    { const bf16_t* stp = ST + ((size_t)((bh * 64 + cch) * 2 + 0) * 128) * 128;
#pragma unroll
      for (int vv = 0; vv < 4; ++vv)
#pragma unroll
        for (int ks = 0; ks < 4; ++ks) sb[vv * 4 + ks] = *(const bf16x8*)(stp + (size_t)(16 * (4 * vh + vv) + i16) * 128 + 32 * ks + 8 * g4); }
    f32x4 oacc[4];
#pragma unroll
    for (int i = 0; i < 4; ++i) oacc[i] = (f32x4){0.f, 0.f, 0.f, 0.f};
#pragma unroll
    for (int dir = 0; dir < 2; ++dir) {
        float d[16], m, tot;
        hg_cumsum(dir ? gb : gf, dir, k, j, lds, d, m, tot);
#pragma unroll
        for (int i = 0; i < 16; ++i) {
            const float gvi = dir ? gb[i] : gf[i];
            const float kt = (1.0f - __expf(gvi)) * __expf(fminf(-d[i], 40.f));
            const float qt = bf2f(qr[i]) * __expf(fminf(d[i], 40.f));
            *(LAS unsigned short*)(lds + HG_A + (16 * j + i) * HG_QKROW + k * 2) = (unsigned short)f2bf(kt);
            *(LAS unsigned short*)(lds + HG_Bq + (16 * j + i) * HG_QKROW + k * 2) = (unsigned short)f2bf(qt);
        }
        if (dir == 1 && u3 + G < 1024) HG3_LOAD(u3 + G);
        __syncthreads();
        f32x4 pt[4];
#pragma unroll
        for (int sg = 0; sg < 4; ++sg) pt[sg] = (f32x4){0.f, 0.f, 0.f, 0.f};
        bf16x8 qa[4];
#pragma unroll
        for (int ks = 0; ks < 4; ++ks) qa[ks] = *(const LAS bf16x8*)(lds + HG_Bq + (16 * tb + i16) * HG_QKROW + (32 * ks + 8 * g4) * 2);
#pragma unroll
        for (int sg = 0; sg < 4; ++sg)
#pragma unroll
            for (int ks = 0; ks < 4; ++ks) {
                const bf16x8 ka = *(const LAS bf16x8*)(lds + HG_A + (16 * sg + i16) * HG_QKROW + (32 * ks + 8 * g4) * 2);
                pt[sg] = __builtin_amdgcn_mfma_f32_16x16x32_bf16(ka, qa[ks], pt[sg], 0, 0, 0);
            }
        const int tcol = 16 * tb + i16;
#pragma unroll
        for (int sg = 0; sg < 4; ++sg)
#pragma unroll
            for (int e = 0; e < 4; ++e) { const int srow = 16 * sg + 4 * g4 + e; const bool keep = dir ? (srow >= tcol) : (srow <= tcol); pt[sg][e] = keep ? pt[sg][e] : 0.f; }
        bf16x8 pa[2];
#pragma unroll
        for (int s2 = 0; s2 < 2; ++s2) {
            u32x4 w; w.x = pk2(pt[2 * s2][0], pt[2 * s2][1]); w.y = pk2(pt[2 * s2][2], pt[2 * s2][3]); w.z = pk2(pt[2 * s2 + 1][0], pt[2 * s2 + 1][1]); w.w = pk2(pt[2 * s2 + 1][2], pt[2 * s2 + 1][3]);
            pa[s2] = __builtin_bit_cast(bf16x8, w);
        }
        const LAS unsigned char* vbase = lds + HG_V + (4 * g4 + (i16 >> 2)) * HG_VROW + (i16 & 3) * 8;
#pragma unroll
        for (int vv = 0; vv < 4; ++vv) {
            const int vt = 4 * vh + vv;
#pragma unroll
            for (int s2 = 0; s2 < 2; ++s2) {
                const s16x4 t0 = tr_read(vbase + (32 * s2) * HG_VROW + vt * 32), t1 = tr_read(vbase + (32 * s2 + 16) * HG_VROW + vt * 32);
                const bf16x8 bv = {t0[0], t0[1], t0[2], t0[3], t1[0], t1[1], t1[2], t1[3]};
                oacc[vv] = __builtin_amdgcn_mfma_f32_16x16x32_bf16(pa[s2], bv, oacc[vv], 0, 0, 0);
            }
#pragma unroll
            for (int ks = 0; ks < 4; ++ks) oacc[vv] = __builtin_amdgcn_mfma_f32_16x16x32_bf16(qa[ks], sb[vv * 4 + ks], oacc[vv], 0, 0, 0);
        }
        if (dir == 0) {
            const bf16_t* stp = ST + ((size_t)((bh * 64 + cch) * 2 + 1) * 128) * 128;
#pragma unroll
            for (int vv = 0; vv < 4; ++vv)
#pragma unroll
                for (int ks = 0; ks < 4; ++ks) sb[vv * 4 + ks] = *(const bf16x8*)(stp + (size_t)(16 * (4 * vh + vv) + i16) * 128 + 32 * ks + 8 * g4);
        }
        __syncthreads();
    }
    LAS float* ot = (LAS float*)(lds + HG_OUT);
#pragma unroll
    for (int vv = 0; vv < 4; ++vv)
#pragma unroll
        for (int e = 0; e < 4; ++e) ot[(16 * tb + 4 * g4 + e) * 132 + 16 * (4 * vh + vv) + i16] = oacc[vv][e];
    __syncthreads();
    {
        const int t = tid >> 3, part = tid & 7;
        float v[16]; float ss = 0.f;
#pragma unroll
        for (int i = 0; i < 4; ++i) { const f32x4 x = *(const LAS f32x4*)(ot + t * 132 + 16 * part + 4 * i); v[4 * i] = x.x; v[4 * i + 1] = x.y; v[4 * i + 2] = x.z; v[4 * i + 3] = x.w; ss += (x.x * x.x + x.y * x.y) + (x.z * x.z + x.w * x.w); }
        ss += __shfl_xor(ss, 1); ss += __shfl_xor(ss, 2); ss += __shfl_xor(ss, 4);
        const float rs = rsqrtf(ss * (1.0f / 128.0f) + EPS);
        const float* gp = gainH + h * 128 + 16 * part;
        bf16_t* dst = AO + (size_t)(tok0 + t) * 1024 + 512 + h * 128 + 16 * part;
#pragma unroll
        for (int i = 0; i < 2; ++i) {
            const u32x4 gq = bgq[i];
            const f32x4 g0 = *(const f32x4*)(gp + 8 * i), g1 = *(const f32x4*)(gp + 8 * i + 4);
            u32x4 w;
            w.x = pk2(v[8 * i] * rs * g0.x * bflo(gq.x), v[8 * i + 1] * rs * g0.y * bfhi(gq.x)); w.y = pk2(v[8 * i + 2] * rs * g0.z * bflo(gq.y), v[8 * i + 3] * rs * g0.w * bfhi(gq.y));
            w.z = pk2(v[8 * i + 4] * rs * g1.x * bflo(gq.z), v[8 * i + 5] * rs * g1.y * bfhi(gq.z)); w.w = pk2(v[8 * i + 6] * rs * g1.z * bflo(gq.w), v[8 * i + 7] * rs * g1.w * bfhi(gq.w));
            *(u32x4*)(dst + 8 * i) = w;
        }
    }
    __syncthreads();
  }
#undef HG3_LOAD
}

#define XB_TMO      128
#define XB_XCNT(j)  (256  + 64 * (j))
#define XB_XSUB(j)  (1280 + 64 * (j))
#define XB_XGEN(j)  (2304 + 64 * (j))
#define XB_TOP      3328
#define XB_TOPGEN   3392
#define XCD_BAR_WORDS 3456
#define XB_SPIN_CAP (1u << 18)

__device__ __forceinline__ unsigned xb_ld(unsigned* p)              { return __hip_atomic_load(p, __ATOMIC_RELAXED, __HIP_MEMORY_SCOPE_AGENT); }
__device__ __forceinline__ unsigned xb_add(unsigned* p, unsigned v) { return __hip_atomic_fetch_add(p, v, __ATOMIC_RELAXED, __HIP_MEMORY_SCOPE_AGENT); }
__device__ __forceinline__ unsigned xb_xcc_id() { return (unsigned)__builtin_amdgcn_s_getreg((3 << 11) | 20) & 0xFu; }
#define XB_SPIN(cond, bar) do { unsigned _sp = 0; while (cond) { __builtin_amdgcn_s_sleep(1); \
    if ((++_sp & 255u) == 0u) { if (xb_ld(&(bar)[XB_TMO])) break; if (_sp > XB_SPIN_CAP) { atomicAdd(&(bar)[XB_TMO], 1u); break; } } } } while (0)

struct XcdBarrier {
    unsigned* bar; unsigned x;
    volatile LAS unsigned* st;
};

__device__ __forceinline__ XcdBarrier xcd_barrier_post(unsigned* bar, volatile LAS unsigned* st) {
    XcdBarrier b; b.bar = bar; b.x = xb_xcc_id(); b.st = st;
    if (threadIdx.x == 0) (void)xb_add(&bar[XB_XCNT(b.x)], 1u);
    return b;
}
__device__ __forceinline__ void xcd_barrier_complete(unsigned* bar, unsigned x, unsigned& nloc, unsigned& nx) {
    const unsigned G = gridDim.x * gridDim.y * gridDim.z;
    unsigned sum, cnt, mine, sp = 0u;
    for (;;) {
        sum = 0u; cnt = 0u; mine = 0u;
#pragma unroll
        for (unsigned j = 0; j < 16; ++j) { const unsigned c = xb_ld(&bar[XB_XCNT(j)]); sum += c; cnt += (c > 0u) ? 1u : 0u; mine = (j == x) ? c : mine; }
        if (sum == G) break;
        __builtin_amdgcn_s_sleep(1);
        if ((++sp & 255u) == 0u) { if (xb_ld(&bar[XB_TMO])) break; if (sp > XB_SPIN_CAP) { atomicAdd(&bar[XB_TMO], 1u); break; } }
    }
    nloc = mine > 0u ? mine : 1u; nx = cnt > 0u ? cnt : 1u;
}

__device__ __forceinline__ void xcd_barrier(const XcdBarrier& b) {
    asm volatile("s_waitcnt vmcnt(0)" ::: "memory");
    __syncthreads();
    if (threadIdx.x == 0) {
        unsigned* bar = b.bar;
        __builtin_amdgcn_s_waitcnt(0);
        unsigned nloc = b.st[0], nx = b.st[1];
        if (nloc == 0u) { xcd_barrier_complete(bar, b.x, nloc, nx); b.st[0] = nloc; b.st[1] = nx; }
        const unsigned old = xb_add(&bar[XB_XSUB(b.x)], 1u);
        const unsigned gen = old / nloc;
        if (old + 1u == (gen + 1u) * nloc) {
            __builtin_amdgcn_fence(__ATOMIC_RELEASE, "agent");
            asm volatile("s_waitcnt vmcnt(0)" ::: "memory");
            const unsigned og = xb_add(&bar[XB_TOP], 1u);
            const unsigned tg = og / nx;
            if (og + 1u == (tg + 1u) * nx) xb_add(&bar[XB_TOPGEN], 1u);
            else XB_SPIN(xb_ld(&bar[XB_TOPGEN]) == tg, bar);
            __builtin_amdgcn_fence(__ATOMIC_ACQUIRE, "agent");
            xb_add(&bar[XB_XGEN(b.x)], 1u);
            asm volatile("s_waitcnt vmcnt(0)" ::: "memory");
        } else {
            XB_SPIN(xb_ld(&bar[XB_XGEN(b.x)]) == gen, bar);
            __builtin_amdgcn_fence(__ATOMIC_ACQUIRE, "agent");
            asm volatile("s_waitcnt vmcnt(0)" ::: "memory");
        }
    }
    __syncthreads();
}

__global__ void __launch_bounds__(512, 2) fwd_kernel(Ptrs Pk) {
    extern __shared__ __attribute__((aligned(16))) unsigned char lds_raw[];
    LAS unsigned char* lds = (LAS unsigned char*)lds_raw;
    cg::grid_group grid = cg::this_grid();
    const int G = gridDim.x, bx = blockIdx.x;
    const int lo = Pk.ph_lo, hi = Pk.ph_hi;
    int ph = 0;
    if (threadIdx.x < 4) ((LAS unsigned*)(lds + 131072 + 1024))[threadIdx.x] = 0u;
    __syncthreads();
    XcdBarrier xbar = xcd_barrier_post((unsigned*)(Pk.ws + OFF_BAR), (volatile LAS unsigned*)(lds + 131072 + 1024));
#ifdef TS_A
    if (threadIdx.x == 0) { LAS unsigned long long* TS_ = (LAS unsigned long long*)(lds + 131072); for (int i = 0; i < 15; ++i) TS_[i] = 0ull; TS_[15] = __builtin_amdgcn_s_memrealtime(); }
#endif
#ifndef PH_MASK
#define PH_MASK 0xFFFFFFFFu
#endif
#define ON(id) constexpr (((PH_MASK) >> (id)) & 1u)
#if defined(__HIP_DEVICE_COMPILE__)
#define LOAD_ARGS(P) int zoff_ = 0; asm volatile("" : "+s"(zoff_)); const Ptrs P = *(const __attribute__((address_space(4))) Ptrs*)((const __attribute__((address_space(4))) char*)__builtin_amdgcn_kernarg_segment_ptr() + zoff_);
#else
#define LOAD_ARGS(P) const Ptrs P = Pk;
#endif
#define PHASE_BEGIN if (ph >= lo && ph < hi) { LOAD_ARGS(P) unsigned char* ws = P.ws; asm volatile("" : "+s"(ws)); int tid = threadIdx.x; asm volatile("" : "+v"(tid)); \
    const int lane = tid & 63, wave = __builtin_amdgcn_readfirstlane(tid >> 6), gw = bx * 8 + wave, ngw = G * 8; (void)lane; (void)gw; (void)ngw;
#define XB ((bf16_t*)(ws + OFF_XB))
#define RSA ((float*)(ws + OFF_RSA))
#define RSB ((float*)(ws + OFF_RSB))
#define CS ((const float*)(ws + OFF_CS))
#define LB ((const float*)(ws + OFF_LB))
#define LAM ((const float*)(ws + OFF_LAM))
#define Dg ((float*)(ws + OFF_DG))
#define Eg ((float*)(ws + OFF_EG))
#define GATE ((bf16_t*)(ws + OFF_GATE))
#define Qb ((bf16_t*)(ws + OFF_Q))
#define Kb ((bf16_t*)(ws + OFF_K))
#define Vb ((bf16_t*)(ws + OFF_V))
#define HQ ((bf16_t*)(ws + OFF_HQ))
#define HV ((bf16_t*)(ws + OFF_HV))
#define GF ((float*)(ws + OFF_GF))
#define GB ((float*)(ws + OFF_GB))
#define Yb ((bf16_t*)(ws + OFF_Y))
#define BG ((bf16_t*)(ws + OFF_BG))
#define AO ((bf16_t*)(ws + OFF_AO))
#define UT ((bf16_t*)(ws + OFF_UT))
#define Hb ((bf16_t*)(ws + OFF_H))
#ifdef TS_A
#define TICK(cat) do { if (bx == 0 && threadIdx.x == 0) { LAS unsigned long long* TS_ = (LAS unsigned long long*)(lds + 131072); const unsigned long long t_ = __builtin_amdgcn_s_memrealtime(); TS_[cat] += t_ - TS_[15]; TS_[15] = t_; } } while (0)
#else
#define TICK(cat) do { } while (0)
#endif
#define PHASE_END(cat)   TICK(cat); if (ph + 1 < hi) { if (ph == 0) grid.sync(); else xcd_barrier(xbar); TICK(13); } } ++ph;

    PHASE_BEGIN
        if ON(0) prologue(P, lds, gw, ngw, wave, lane);
        if ON(6) convert_layer(P, 0, ws, lds, gw, ngw, wave, lane);
    PHASE_END(0)

    for (int layer = 0; layer < DEPTH; ++layer) {
        PHASE_BEGIN
            pg8::Gemm g{XB, (const bf16_t*)(ws + (size_t)(layer & 1) * WSZ + W_IN), Dm, Dm, Dm, 1 << 30, 0, -1};
            pg8::StaticOrder S; S.init(M, 4096, G, bx);
            EpiMix E{RSB, CS, LB + (0 * 4 + layer) * 512, LB + (1 * 4 + layer) * 512, Qb, Kb, Vb, HQ, HV, BG, GF, GB};
            if ON(1) pg8::gemm_phase(lds, g, S, E);
        PHASE_END(1)
        PHASE_BEGIN
            const float lam_init = 0.8f - 0.6f * __expf(-0.3f * (float)layer);
            const float lam = LAM[layer];
            if ON(2) for (int i = 0; i * G + bx < 512; ++i) {
                const int uid = i * G + bx; const int round = uid >> 8, r = uid & 255;
                const int bhh = round * 8 + (r & 7), qb = r >> 3;
                attn_unit(bhh >> 2, bhh & 3, qb, Qb, Kb, Vb, AO, P.da_norm + layer * 512, 1.0f - lam_init, lam, lds);
            }
            TICK(2);
            if ON(3) hg1_phase(bx, G, GF, GB, HV, UT, Dg, Eg, lds);
        PHASE_END(3)
        PHASE_BEGIN
            if ON(5) hg2_scan(UT, Dg, Eg, bx * 512 + tid, G * 512);
            TICK(5);
            {
                pg8::Gemm g{XB, (const bf16_t*)(ws + (size_t)(layer & 1) * WSZ + W_IN) + (size_t)4096 * Dm, Dm, Dm, Dm, 1 << 30, 0, -1};
                pg8::StaticOrder S; S.init(M, 2048, G, bx);
                EpiGate E{RSB, GATE};
                if ON(4) pg8::gemm_phase(lds, g, S, E);
            }
            TICK(4);
            if ON(6) if (layer + 1 < DEPTH) convert_layer(P, layer + 1, ws + (size_t)((layer + 1) & 1) * WSZ, lds, gw, ngw, wave, lane);
        PHASE_END(6)
        PHASE_BEGIN
            if ON(7) hg3_phase(bx, G, GF, GB, HQ, HV, UT, BG, P.hg_norm + layer * 512, AO, lds);
        PHASE_END(7)
        PHASE_BEGIN
            pg8::Gemm g{AO, (const bf16_t*)(ws + (size_t)(layer & 1) * WSZ + W_AB), 1024, 1024, 1024, 1 << 30, 0, 8};
            pg8::StaticOrder S; S.init(M, 1024, G, bx);
            EpiY E{GATE, Yb};
            if ON(8) pg8::gemm_phase(lds, g, S, E);
        PHASE_END(8)
        PHASE_BEGIN
            pg8::Gemm g{Yb, (const bf16_t*)(ws + (size_t)(layer & 1) * WSZ + W_O2), 1024, 1024, 1024, 1 << 30, 0, -1};
            pg8::StaticOrder S; S.init(M, Dm, G, bx);
            EpiRes E{layer == 0 ? P.x : P.out, P.out, XB, RSA};
            if ON(9) pg8::gemm_phase(lds, g, S, E);
        PHASE_END(9)
        PHASE_BEGIN
            pg8::Gemm g{XB, (const bf16_t*)(ws + (size_t)(layer & 1) * WSZ + W_GU), Dm, Dm, Dm, 1 << 30, 0, -1};
            pg8::StaticOrder S; S.init(M, 2 * FF, G, bx);
            EpiGU E{RSA, Hb};
            if ON(10) pg8::gemm_phase(lds, g, S, E);
        PHASE_END(10)
        PHASE_BEGIN
            pg8::Gemm g{Hb, (const bf16_t*)(ws + (size_t)(layer & 1) * WSZ + W_D), FF, FF, FF, 1 << 30, 0, -1};
            pg8::StaticOrder S; S.init(M, Dm, G, bx);
            EpiRes E{P.out, P.out, XB, RSB};
            if ON(11) pg8::gemm_phase(lds, g, S, E);
        PHASE_END(11)
    }
    PHASE_BEGIN
        if ON(12) for (int r = gw; r < M; r += ngw) {
            f32x4* xr = (f32x4*)(P.out + (size_t)r * Dm) + lane;
            f32x4 v[4]; float ss = 0.f;
#pragma unroll
            for (int j = 0; j < 4; ++j) { v[j] = xr[64 * j]; ss += (v[j].x * v[j].x + v[j].y * v[j].y) + (v[j].z * v[j].z + v[j].w * v[j].w); }
            const float rs = rsqrtf(wave_sum(ss) * (1.0f / Dm) + EPS);
#pragma unroll
            for (int j = 0; j < 4; ++j) { const f32x4 gn = *((const f32x4*)P.final_norm + lane + 64 * j); xr[64 * j] = (f32x4){v[j].x * rs * gn.x, v[j].y * rs * gn.y, v[j].z * rs * gn.z, v[j].w * rs * gn.w}; }
        }
    PHASE_END(12)
#ifdef TS_A
    if (bx == 0 && threadIdx.x == 0) {
        LAS unsigned long long* TS_ = (LAS unsigned long long*)(lds + 131072);
        unsigned long long a = 0;
        for (int i = 0; i < 15; ++i) { if ((TS_A >> i) & 1) a += TS_[i]; }
        const unsigned long long t_end = __builtin_amdgcn_s_memrealtime() + a;
        while (__builtin_amdgcn_s_memrealtime() < t_end) __builtin_amdgcn_s_sleep(20);
    }
#endif
}
constexpr int NPHASES = 2 + 8 * DEPTH;

#ifndef MK_PER_PHASE
#define MK_PER_PHASE 0
#endif

extern "C" void kernel_launch(void* const* d_in, const int* in_sizes, int n_in, void* d_out, int out_size, void* d_ws, size_t ws_size, hipStream_t stream) {
    static int grid = 0;
    if (grid == 0) {
        if (n_in != 16 || out_size != M * Dm || ws_size < WS_END) { fprintf(stderr, "kernel_launch: unexpected sizes (n_in %d, out %d, ws %zu, need %zu)\n", n_in, out_size, ws_size, (size_t)WS_END); grid = -1; return; }
        int dev = 0, cus = 0, per_cu = 0;
        (void)hipGetDevice(&dev);
        (void)hipDeviceGetAttribute(&cus, hipDeviceAttributeMultiprocessorCount, dev);
        if (hipFuncSetAttribute((const void*)fwd_kernel, hipFuncAttributeMaxDynamicSharedMemorySize, LDS_BYTES) != hipSuccess) { fprintf(stderr, "kernel_launch: hipFuncSetAttribute failed\n"); grid = -1; return; }
        (void)hipOccupancyMaxActiveBlocksPerMultiprocessor(&per_cu, (const void*)fwd_kernel, 512, LDS_BYTES);
        (void)hipGetLastError();
        if (per_cu < 1) per_cu = 1;
        grid = cus * 1;
        fprintf(stderr, "kernel_launch: grid %d (per_cu %d), ws %zu need %zu\n", grid, per_cu, ws_size, (size_t)WS_END);
    }
    if (grid < 0) return;
    Ptrs p{};
    p.x = (const float*)d_in[0]; p.pos = (const int*)d_in[1]; p.w_in = (const float*)d_in[2]; p.da_lambda = (const float*)d_in[3]; p.da_norm = (const float*)d_in[4];
    p.hg_lb = (const float*)d_in[5]; p.hg_norm = (const float*)d_in[6]; p.w_a = (const float*)d_in[7]; p.w_b = (const float*)d_in[8]; p.w_o = (const float*)d_in[9];
    p.attn_norm = (const float*)d_in[10]; p.ffn_norm = (const float*)d_in[11]; p.w_gate = (const float*)d_in[12]; p.w_up = (const float*)d_in[13]; p.w_down = (const float*)d_in[14];
    p.final_norm = (const float*)d_in[15];
    p.out = (float*)d_out; p.ws = (unsigned char*)d_ws;
    (void)hipMemsetAsync((char*)d_ws + OFF_BAR, 0, BAR_BYTES, stream);
#if MK_PER_PHASE
    for (int ph = 0; ph < NPHASES; ++ph) {
        p.ph_lo = ph; p.ph_hi = ph + 1;
        hipLaunchKernelGGL(fwd_kernel, dim3(grid), dim3(512), LDS_BYTES, stream, p);
    }
#else
    p.ph_lo = 0; p.ph_hi = NPHASES;
    void* args[] = {&p};
    hipError_t e = hipLaunchCooperativeKernel((const void*)fwd_kernel, dim3(grid), dim3(512), args, LDS_BYTES, stream);
    if (e != hipSuccess) fprintf(stderr, "cooperative launch failed: %s (grid %d)\n", hipGetErrorString(e), grid);
#endif
}
```

```cpp
#include <hip/hip_runtime.h>
#include <hip/hip_cooperative_groups.h>
#include <cstdio>
#include <cstdint>
namespace cg = cooperative_groups;

#define LAS __attribute__((address_space(3)))
typedef unsigned short bf16_t;
typedef short bf16x8 __attribute__((ext_vector_type(8)));
typedef short s16x4 __attribute__((ext_vector_type(4)));
typedef float f32x4 __attribute__((ext_vector_type(4)));
typedef float f32x16 __attribute__((ext_vector_type(16)));
typedef unsigned u32x4 __attribute__((ext_vector_type(4)));
typedef unsigned u32x2 __attribute__((ext_vector_type(2)));

constexpr int Dm = 1024, NB = 4, SEQ = 4096, M = NB * SEQ, DEPTH = 4, FF = 2816, INW = 6144;
constexpr float EPS = 1e-6f;
constexpr float LOG2E = 1.4426950408889634f;

constexpr size_t W_IN = 0, W_AB = 12582912, W_O2 = 14680064, W_GU = 18874368, W_D = 30408704, WSZ = 36175872;
constexpr size_t MiB = 1048576;
constexpr size_t OFF_XB = 2 * WSZ;
constexpr size_t OFF_RSA = OFF_XB + 32 * MiB;
constexpr size_t OFF_RSB = OFF_RSA + MiB;
constexpr size_t OFF_CS = OFF_RSB + MiB;
constexpr size_t OFF_LB = OFF_CS + MiB;
constexpr size_t OFF_LAM = OFF_LB + 16384;
constexpr size_t OFF_DG = OFF_LAM + 256;
constexpr size_t OFF_EG = OFF_DG + MiB;
constexpr size_t OFF_B = OFF_EG + MiB;
constexpr size_t OFF_GATE = OFF_B;
constexpr size_t OFF_Q = OFF_B, OFF_K = OFF_B + 16 * MiB, OFF_V = OFF_B + 32 * MiB;
constexpr size_t OFF_HQ = OFF_B + 64 * MiB;
constexpr size_t OFF_HV = OFF_HQ + 16 * MiB;
constexpr size_t OFF_GF = OFF_HV + 16 * MiB;
constexpr size_t OFF_GB = OFF_GF + 32 * MiB;
constexpr size_t OFF_Y = OFF_GF;
constexpr size_t OFF_BG = OFF_GB + 32 * MiB;
constexpr size_t OFF_AO = OFF_BG + 16 * MiB;
constexpr size_t OFF_UT = OFF_AO + 32 * MiB;
constexpr size_t OFF_H = OFF_B;
constexpr size_t OFF_BAR = OFF_UT + 64 * MiB;
constexpr size_t BAR_BYTES = 16384;
constexpr size_t WS_END = OFF_BAR + BAR_BYTES;

constexpr int LDS_BYTES = 131072 + 2048;

__device__ __forceinline__ unsigned f2bf(float f) { unsigned u = __builtin_bit_cast(unsigned, f); return (u + 0x7fffu + ((u >> 16) & 1u)) >> 16; }
typedef float f32x2_t __attribute__((ext_vector_type(2)));
typedef __bf16 bf16x2_t __attribute__((ext_vector_type(2)));
__device__ __forceinline__ unsigned pk2(float lo, float hi) { f32x2_t v = {lo, hi}; bf16x2_t b = __builtin_convertvector(v, bf16x2_t); return __builtin_bit_cast(unsigned, b); }
__device__ __forceinline__ float bf2f(unsigned short b) { return __builtin_bit_cast(float, (unsigned)b << 16); }
__device__ __forceinline__ float bflo(unsigned u) { return __builtin_bit_cast(float, u << 16); }
__device__ __forceinline__ float bfhi(unsigned u) { return __builtin_bit_cast(float, u & 0xffff0000u); }
__device__ __forceinline__ float sigmoidf_(float x) { return __builtin_amdgcn_rcpf(1.0f + __expf(-x)); }

namespace pg8 {
constexpr int BM = 256, BK = 64, HALF = 128, HTB = HALF * BK * 2, STAGE_BYTES = 8 * HTB, NXCD = 8, WGM = 8;
__host__ __device__ __forceinline__ int lds_byte(int r, int c) { const int st = (r >> 4) * 2 + (c >> 5), rr = r & 15, cc = c & 31, ob = rr * 64 + cc * 2; return st * 1024 + (ob ^ (((ob >> 9) & 1) << 5)); }
__host__ __device__ __forceinline__ void stage_rc(int b, int& R, int& C) { const int st = b / 1024, sb = b % 1024, swz = sb ^ (((sb >> 9) & 1) << 5); R = (st >> 1) * 16 + swz / 64; C = (st & 1) * 32 + (swz % 64) / 2; }
__host__ __device__ __forceinline__ int perm32(int rho) { const int n = rho >> 4, i = rho & 15; return 8 * (i >> 2) + 4 * n + (i & 3); }

struct Unit { int pm, pn; };
struct Gemm { const bf16_t* A; const bf16_t* Bt; int lda, ldb, K; int split_pn; int split_aoff; int mid_t; };

struct StaticOrder {
    int nM, nN, nwg, G, c;
    __device__ __forceinline__ void init(int M_, int N_, int G_, int c_) { nM = M_ / BM; nN = N_ / BM; nwg = nM * nN; G = G_; c = c_; }
    __device__ bool next(int i, Unit& u) const {
        const long L = (long)i * G + c; if (L >= nwg) return false;
        int wgid = (int)L; { const int q = nwg / NXCD, r = nwg % NXCD, xcd = wgid % NXCD, off = wgid / NXCD; wgid = (xcd < r ? xcd * (q + 1) : r * (q + 1) + (xcd - r) * q) + off; }
        const int nig = WGM * nN, gid = wgid / nig, fm = gid * WGM, gsz = (nM - fm) < WGM ? (nM - fm) : WGM;
        u.pm = fm + ((wgid % nig) % gsz); u.pn = (wgid % nig) / gsz; return true;
    }
};

template <class Epi>
__device__ __forceinline__ void gemm_phase(LAS unsigned char* lds, const Gemm g, const StaticOrder& S, const Epi& E) {
    int tid_ = threadIdx.x; asm volatile("" : "+v"(tid_));
    const int tid = tid_, wid = __builtin_amdgcn_readfirstlane(tid >> 6), lane = tid & 63, wr = wid >> 2, wc = wid & 3, fr = lane & 15, fq = lane >> 4;
    const int K = g.K, nt = K / BK;
    unsigned voffA[2], voffB[2];
#pragma unroll
    for (int i = 0; i < 2; ++i) { int R, C; stage_rc(tid * 16 + i * 8192, R, C); const int Rb = (R & ~31) + perm32(R & 31);
        voffA[i] = (unsigned)(R * g.lda + C) * 2u; voffB[i] = (unsigned)(Rb * g.ldb + C) * 2u; }
    const size_t kstep = (size_t)(BK * 2);
    const size_t hstepA = (size_t)HALF * g.lda * 2, hstepB = (size_t)HALF * g.ldb * 2;
    const size_t tstepA = 2 * hstepA, tstepB = 2 * hstepB;
    const unsigned ldsw = (unsigned)wid * 1024u;
    const int aoff = lds_byte(wr * 64 + fr, fq * 8), boff = lds_byte(wc * 32 + fr, fq * 8);
#define PG8_SA(b, h) (((b) * 2 + (h)) * HTB)
#define PG8_SB(b, h) ((4 + (b) * 2 + (h)) * HTB)
#define PG8_STAGE(bufoff, gbase, voff) do { _Pragma("unroll") for (int _i = 0; _i < 2; ++_i) \
        __builtin_amdgcn_global_load_lds((const unsigned*)((const char*)(gbase) + (voff)[_i]), (LAS unsigned*)(lds + (bufoff) + ldsw + _i * 8192), 16, 0, 0); } while (0)
#define PG8_LDA(dst, b, h) do { _Pragma("unroll") for (int m = 0; m < 4; ++m) _Pragma("unroll") for (int k = 0; k < 2; ++k) dst[m][k] = *(const LAS bf16x8*)(lds + PG8_SA(b, h) + aoff + m * 2048 + k * 1024); } while (0)
#define PG8_LDB(dst, b, h) do { _Pragma("unroll") for (int n = 0; n < 2; ++n) _Pragma("unroll") for (int k = 0; k < 2; ++k) dst[n][k] = *(const LAS bf16x8*)(lds + PG8_SB(b, h) + boff + n * 2048 + k * 1024); } while (0)
#define PG8_MMA(ai, bj, At, Bt) do { __builtin_amdgcn_s_setprio(1); _Pragma("unroll") for (int m = 0; m < 4; ++m) _Pragma("unroll") for (int n = 0; n < 2; ++n) _Pragma("unroll") for (int k = 0; k < 2; ++k) \
        acc[ai][bj][m][n] = __builtin_amdgcn_mfma_f32_16x16x32_bf16(Bt[n][k], At[m][k], acc[ai][bj][m][n], 0, 0, 0); __builtin_amdgcn_s_setprio(0); } while (0)
#define PG8_WAIT_V(n) asm volatile("s_waitcnt vmcnt(" #n ")" ::: "memory")
#define PG8_WAIT_L(n) asm volatile("s_waitcnt lgkmcnt(" #n ")" ::: "memory")
#define PG8_BAR __builtin_amdgcn_s_barrier()
#define PG8_SCHED __builtin_amdgcn_sched_barrier(0)
#define PG8_UA(u) ((const char*)g.A + (size_t)(u).pm * tstepA + (((u).pn >= g.split_pn) ? (size_t)g.split_aoff * 2 : (size_t)0))
    Unit cur, nxt; int ui = 0;
    if (!S.next(0, cur)) return;
    f32x4 acc[2][2][4][2];
#pragma unroll
    for (int a = 0; a < 2; ++a)
#pragma unroll
        for (int b = 0; b < 2; ++b)
#pragma unroll
            for (int m = 0; m < 4; ++m)
#pragma unroll
                for (int n = 0; n < 2; ++n) acc[a][b][m][n] = (f32x4){0.f, 0.f, 0.f, 0.f};
    bf16x8 At[4][2], B0[2][2], B1[2][2];
    const char* cA = PG8_UA(cur); const char* cB = (const char*)g.Bt + (size_t)cur.pn * tstepB;
    PG8_STAGE(PG8_SB(0, 0), cB, voffB); PG8_STAGE(PG8_SB(0, 1), cB + hstepB, voffB); PG8_STAGE(PG8_SA(0, 0), cA, voffA); PG8_STAGE(PG8_SA(0, 1), cA + hstepA, voffA);
    if (wr == 1) PG8_BAR;
    PG8_WAIT_V(2); PG8_BAR;
    PG8_STAGE(PG8_SB(1, 0), cB + kstep, voffB); PG8_STAGE(PG8_SA(1, 0), cA + kstep, voffA); PG8_STAGE(PG8_SB(1, 1), cB + hstepB + kstep, voffB);
    PG8_WAIT_V(6); PG8_BAR;
    for (;;) {
        const bool has_next = S.next(ui + 1, nxt);
        const char* nA = has_next ? PG8_UA(nxt) : cA; const char* nB = has_next ? (const char*)g.Bt + (size_t)nxt.pn * tstepB : cB;
        for (int t = 0; t < nt; t += 2) {
            if constexpr (Epi::HAS_MID) { if (t == g.mid_t) E.mid(acc, cur, wr, wc, fr, fq); }
            const bool last = (t == nt - 2);
            const char* a1 = cA + (size_t)(t + 1) * kstep;
            const char* a2 = last ? nA : cA + (size_t)(t + 2) * kstep; const char* b2 = last ? nB : cB + (size_t)(t + 2) * kstep;
            const char* a3 = a2 + kstep; const char* b3 = b2 + kstep;
            PG8_LDB(B0, 0, 0); PG8_LDB(B1, 0, 1); PG8_SCHED; PG8_LDA(At, 0, 0); PG8_STAGE(PG8_SA(1, 1), a1 + hstepA, voffA);
            PG8_WAIT_V(8); PG8_WAIT_L(0); PG8_BAR; PG8_MMA(0, 0, At, B0); PG8_MMA(0, 1, At, B1); PG8_BAR; PG8_SCHED;
            PG8_LDA(At, 0, 1); PG8_STAGE(PG8_SB(0, 0), b2, voffB); PG8_STAGE(PG8_SB(0, 1), b2 + hstepB, voffB); PG8_STAGE(PG8_SA(0, 0), a2, voffA);
            PG8_WAIT_V(8); PG8_WAIT_L(0); PG8_BAR; PG8_MMA(1, 0, At, B0); PG8_MMA(1, 1, At, B1); PG8_BAR; PG8_SCHED;
            PG8_LDB(B0, 1, 0); PG8_LDB(B1, 1, 1); PG8_SCHED; PG8_LDA(At, 1, 0); PG8_STAGE(PG8_SA(0, 1), a2 + hstepA, voffA);
            PG8_WAIT_V(8); PG8_WAIT_L(0); PG8_BAR; PG8_MMA(0, 0, At, B0); PG8_MMA(0, 1, At, B1); PG8_BAR; PG8_SCHED;
            PG8_LDA(At, 1, 1); PG8_STAGE(PG8_SB(1, 0), b3, voffB); PG8_STAGE(PG8_SB(1, 1), b3 + hstepB, voffB); PG8_STAGE(PG8_SA(1, 0), a3, voffA);
            PG8_WAIT_V(8); PG8_WAIT_L(0); PG8_BAR; PG8_MMA(1, 0, At, B0); PG8_MMA(1, 1, At, B1); PG8_BAR; PG8_SCHED;
        }
        if (wr == 0) PG8_BAR;
        E(acc, cur, wr, wc, fr, fq);
        if (!has_next) break;
#pragma unroll
        for (int a = 0; a < 2; ++a)
#pragma unroll
            for (int b = 0; b < 2; ++b)
#pragma unroll
                for (int m = 0; m < 4; ++m)
#pragma unroll
                    for (int n = 0; n < 2; ++n) acc[a][b][m][n] = (f32x4){0.f, 0.f, 0.f, 0.f};
        cur = nxt; cA = nA; cB = nB; ++ui;
        if (wr == 1) PG8_BAR;
    }
    PG8_WAIT_V(0);
    PG8_BAR;
#undef PG8_SA
#undef PG8_SB
#undef PG8_STAGE
#undef PG8_LDA
#undef PG8_LDB
#undef PG8_MMA
#undef PG8_UA
}
}

__device__ __forceinline__ float row_rs(const float* rsp, int row) {
    const f32x4* p = (const f32x4*)(rsp + (size_t)row * 16);
    f32x4 a = p[0], b = p[1], c = p[2], d = p[3];
    float s = ((a.x + a.y) + (a.z + a.w)) + ((b.x + b.y) + (b.z + b.w)) + ((c.x + c.y) + (c.z + c.w)) + ((d.x + d.y) + (d.z + d.w));
    return __builtin_amdgcn_rsqf(s * (1.0f / Dm) + EPS);
}
__device__ __forceinline__ void rows_rs4(const float* rsp, int row0  , float (&rs)[4]) {
#pragma unroll
    for (int mp = 0; mp < 2; ++mp) {
        f32x4 p[2][4];
#pragma unroll
        for (int m = 0; m < 2; ++m) { const f32x4* q = (const f32x4*)(rsp + (size_t)(row0 + 16 * (2 * mp + m)) * 16);
#pragma unroll
            for (int i = 0; i < 4; ++i) p[m][i] = q[i]; }
#pragma unroll
        for (int m = 0; m < 2; ++m) { float t = 0.f;
#pragma unroll
            for (int i = 0; i < 4; ++i) t += (p[m][i].x + p[m][i].y) + (p[m][i].z + p[m][i].w);
            rs[2 * mp + m] = __builtin_amdgcn_rsqf(t * (1.0f / Dm) + EPS); }
        __builtin_amdgcn_sched_barrier(0);
    }
}
__device__ __forceinline__ void rows_rs2(const float* rsp, int row0, float (&rs)[2]) {
    f32x4 p[2][4];
#pragma unroll
    for (int m = 0; m < 2; ++m) { const f32x4* q = (const f32x4*)(rsp + (size_t)(row0 + 16 * m) * 16);
#pragma unroll
        for (int i = 0; i < 4; ++i) p[m][i] = q[i]; }
#pragma unroll
    for (int m = 0; m < 2; ++m) { float t = 0.f;
#pragma unroll
        for (int i = 0; i < 4; ++i) t += (p[m][i].x + p[m][i].y) + (p[m][i].z + p[m][i].w);
        rs[m] = __builtin_amdgcn_rsqf(t * (1.0f / Dm) + EPS); }
}
__device__ __forceinline__ u32x4 pack8(const float* v) { u32x4 w; w.x = pk2(v[0], v[1]); w.y = pk2(v[2], v[3]); w.z = pk2(v[4], v[5]); w.w = pk2(v[6], v[7]); return w; }

struct EpiMix {
    static constexpr bool HAS_MID = false;
    const float* rsp; const float* cs; const float* lbF; const float* lbB;
    bf16_t *Q, *Kk, *V, *HQ, *HV, *BG; float *GF, *GB;
    template <int GRP>
    __device__ __forceinline__ void run(const f32x4 (&acc)[2][2][4][2], const pg8::Unit& u, int wr, int wc, int fr, int fq) const {
#pragma unroll
        for (int ai = 0; ai < 2; ++ai)
#pragma unroll
        for (int mp = 0; mp < 2; ++mp) {
            const int row0 = u.pm * 256 + ai * 128 + wr * 64 + mp * 32 + fr;
            float rs4[2]; rows_rs2(rsp, row0, rs4);
            const int d0r = (wc * 32 + fq * 8) & 63;
            f32x4 c4r[2], s4r[2];
            if constexpr (GRP <= 1) {
                if (d0r < 16) {
#pragma unroll
                    for (int mm = 0; mm < 2; ++mm) { const float* cp = cs + (size_t)(row0 + 16 * mm) * 16 + (d0r >> 3) * 4; c4r[mm] = *(const f32x4*)cp; s4r[mm] = *(const f32x4*)(cp + 8); }
                }
            }
            __builtin_amdgcn_sched_barrier(0);
#pragma unroll
            for (int mm = 0; mm < 2; ++mm) {
                const int m = 2 * mp + mm;
                const int row = row0 + mm * 16;
                const float rs = rs4[mm];
                const int b = row >> 12, s = row & 4095;
#pragma unroll
                for (int bj = 0; bj < 2; ++bj) {
                    const int col = u.pn * 256 + bj * 128 + wc * 32 + fq * 8;
                    const int jj = col & 511;
                    float v[8];
#pragma unroll
                    for (int e = 0; e < 4; ++e) { v[e] = acc[ai][bj][m][0][e] * rs; v[4 + e] = acc[ai][bj][m][1][e] * rs; }
                    if constexpr (GRP <= 1) {
                        const int d0 = jj & 63;
                        if (d0 < 16) {
                            const f32x4 c4 = c4r[mm], s4 = s4r[mm];
#pragma unroll
                            for (int e = 0; e < 4; ++e) { const float t1 = v[e], t2 = v[4 + e]; v[e] = t1 * c4[e] - t2 * s4[e]; v[4 + e] = t2 * c4[e] + t1 * s4[e]; }
                        }
                        if constexpr (GRP == 0) {
#pragma unroll
                            for (int e = 0; e < 8; ++e) v[e] *= 0.125f * LOG2E;
                        }
                        const int h = jj >> 7, c = (jj >> 6) & 1;
                        bf16_t* dst = (GRP == 0 ? Q : Kk) + ((size_t)(((b * 4 + h) * 2 + c) * SEQ + s)) * 64 + d0;
                        *(u32x4*)dst = pack8(v);
                    } else if constexpr (GRP == 2) {
                        const int h = jj >> 7, d0 = jj & 127;
                        *(u32x4*)(V + ((size_t)((b * 4 + h) * SEQ + s)) * 128 + d0) = pack8(v);
                    } else if constexpr (GRP == 3) {
                        *(u32x4*)(HQ + (size_t)row * 512 + jj) = pack8(v);
                    } else if constexpr (GRP == 4 || GRP == 5) {
                        const float* lbp = (GRP == 4 ? lbF : lbB) + jj;
                        const f32x4 l0 = *(const f32x4*)lbp, l1 = *(const f32x4*)(lbp + 4);
                        float gl[8];
#pragma unroll
                        for (int e = 0; e < 8; ++e) { const float lb = e < 4 ? l0[e] : l1[e - 4]; const float f = lb + (1.0f - lb) * sigmoidf_(v[e]); gl[e] = __builtin_amdgcn_logf(fmaxf(f, 1e-37f)) * 0.6931471805599453f; }
                        float* dst = (GRP == 4 ? GF : GB) + (size_t)row * 512 + jj;
                        *(f32x4*)dst = (f32x4){gl[0], gl[1], gl[2], gl[3]}; *(f32x4*)(dst + 4) = (f32x4){gl[4], gl[5], gl[6], gl[7]};
                    } else if constexpr (GRP == 6) {
                        *(u32x4*)(HV + (size_t)row * 512 + jj) = pack8(v);
                    } else {
#pragma unroll
                        for (int e = 0; e < 8; ++e) v[e] = sigmoidf_(v[e]);
                        *(u32x4*)(BG + (size_t)row * 512 + jj) = pack8(v);
                    }
                }
            }
            __builtin_amdgcn_sched_barrier(0);
        }
    }
    __device__ __forceinline__ void operator()(const f32x4 (&acc)[2][2][4][2], const pg8::Unit& u, int wr, int wc, int fr, int fq) const {
        switch (u.pn >> 1) {
            case 0: run<0>(acc, u, wr, wc, fr, fq); break;
            case 1: run<1>(acc, u, wr, wc, fr, fq); break;
            case 2: run<2>(acc, u, wr, wc, fr, fq); break;
            case 3: run<3>(acc, u, wr, wc, fr, fq); break;
            case 4: run<4>(acc, u, wr, wc, fr, fq); break;
            case 5: run<5>(acc, u, wr, wc, fr, fq); break;
            case 6: run<6>(acc, u, wr, wc, fr, fq); break;
            default: run<7>(acc, u, wr, wc, fr, fq); break;
        }
    }
};

struct EpiGate {
    static constexpr bool HAS_MID = false;
    const float* rsp; bf16_t* G;
    __device__ __forceinline__ void operator()(const f32x4 (&acc)[2][2][4][2], const pg8::Unit& u, int wr, int wc, int fr, int fq) const {
#pragma unroll
        for (int ai = 0; ai < 2; ++ai) {
            const int row0 = u.pm * 256 + ai * 128 + wr * 64 + fr;
            float rs4[4]; rows_rs4(rsp, row0, rs4);
            __builtin_amdgcn_sched_barrier(0);
#pragma unroll
            for (int m = 0; m < 4; ++m) {
                const int row = row0 + m * 16;
                const float rs = rs4[m];
                const int col = u.pn * 128 + wc * 32 + fq * 8;
                float r[8], sb[8];
                const float nrl = -rs * LOG2E;
#pragma unroll
                for (int n = 0; n < 2; ++n) {
                    f32x4 ta = acc[ai][0][m][n] * nrl, tb = acc[ai][1][m][n] * nrl;
                    ta = __builtin_elementwise_min(ta, (f32x4){86.f, 86.f, 86.f, 86.f}); tb = __builtin_elementwise_min(tb, (f32x4){86.f, 86.f, 86.f, 86.f});
                    ta.x = __builtin_amdgcn_exp2f(ta.x); ta.y = __builtin_amdgcn_exp2f(ta.y); ta.z = __builtin_amdgcn_exp2f(ta.z); ta.w = __builtin_amdgcn_exp2f(ta.w);
                    tb.x = __builtin_amdgcn_exp2f(tb.x); tb.y = __builtin_amdgcn_exp2f(tb.y); tb.z = __builtin_amdgcn_exp2f(tb.z); tb.w = __builtin_amdgcn_exp2f(tb.w);
                    ta = ta + 1.0f; tb = tb + 1.0f;
                    f32x4 ia, ib;
                    ia.x = __builtin_amdgcn_rcpf(ta.x); ia.y = __builtin_amdgcn_rcpf(ta.y); ia.z = __builtin_amdgcn_rcpf(ta.z); ia.w = __builtin_amdgcn_rcpf(ta.w);
                    ib.x = __builtin_amdgcn_rcpf(tb.x); ib.y = __builtin_amdgcn_rcpf(tb.y); ib.z = __builtin_amdgcn_rcpf(tb.z); ib.w = __builtin_amdgcn_rcpf(tb.w);
                    const f32x4 rr = tb * ia;
                    r[n * 4] = rr.x; r[n * 4 + 1] = rr.y; r[n * 4 + 2] = rr.z; r[n * 4 + 3] = rr.w;
                    sb[n * 4] = ib.x; sb[n * 4 + 1] = ib.y; sb[n * 4 + 2] = ib.z; sb[n * 4 + 3] = ib.w;
                }
                *(u32x4*)(G + (size_t)row * 2048 + col) = pack8(r);
                *(u32x4*)(G + (size_t)row * 2048 + 1024 + col) = pack8(sb);
            }
            __builtin_amdgcn_sched_barrier(0);
        }
    }
};

struct EpiY {
    static constexpr bool HAS_MID = true;
    const bf16_t* G; bf16_t* Y;
    __device__ __forceinline__ void mid(f32x4 (&acc)[2][2][4][2], const pg8::Unit& u, int wr, int wc, int fr, int fq) const {
        int fr_ = fr; asm volatile("" : "+v"(fr_));
#pragma unroll
        for (int ai = 0; ai < 2; ++ai) {
            __builtin_amdgcn_sched_barrier(0);
#pragma unroll
            for (int m = 0; m < 4; ++m) {
                const int row = u.pm * 256 + ai * 128 + wr * 64 + m * 16 + fr_;
#pragma unroll
                for (int bj = 0; bj < 2; ++bj) {
                    const int col = u.pn * 256 + bj * 128 + wc * 32 + fq * 8;
                    const u32x4 gq = *(const u32x4*)(G + (size_t)row * 2048 + col);
                    acc[ai][bj][m][0][0] *= bflo(gq.x); acc[ai][bj][m][0][1] *= bfhi(gq.x); acc[ai][bj][m][0][2] *= bflo(gq.y); acc[ai][bj][m][0][3] *= bfhi(gq.y);
                    acc[ai][bj][m][1][0] *= bflo(gq.z); acc[ai][bj][m][1][1] *= bfhi(gq.z); acc[ai][bj][m][1][2] *= bflo(gq.w); acc[ai][bj][m][1][3] *= bfhi(gq.w);
                }
            }
        }
        __builtin_amdgcn_sched_barrier(0);
    }
    __device__ __forceinline__ void operator()(const f32x4 (&acc)[2][2][4][2], const pg8::Unit& u, int wr, int wc, int fr, int fq) const {
#pragma unroll
        for (int ai = 0; ai < 2; ++ai) {
            u32x4 gqr[4][2];
#pragma unroll
            for (int m = 0; m < 4; ++m)
#pragma unroll
                for (int bj = 0; bj < 2; ++bj) gqr[m][bj] = *(const u32x4*)(G + (size_t)(u.pm * 256 + ai * 128 + wr * 64 + m * 16 + fr) * 2048 + 1024 + u.pn * 256 + bj * 128 + wc * 32 + fq * 8);
            __builtin_amdgcn_sched_barrier(0);
#pragma unroll
            for (int m = 0; m < 4; ++m) {
                const int row = u.pm * 256 + ai * 128 + wr * 64 + m * 16 + fr;
#pragma unroll
                for (int bj = 0; bj < 2; ++bj) {
                    const int col = u.pn * 256 + bj * 128 + wc * 32 + fq * 8;
                    const u32x4 gq = gqr[m][bj];
                    float v[8];
                    v[0] = acc[ai][bj][m][0][0] * bflo(gq.x); v[1] = acc[ai][bj][m][0][1] * bfhi(gq.x);
                    v[2] = acc[ai][bj][m][0][2] * bflo(gq.y); v[3] = acc[ai][bj][m][0][3] * bfhi(gq.y);
                    v[4] = acc[ai][bj][m][1][0] * bflo(gq.z); v[5] = acc[ai][bj][m][1][1] * bfhi(gq.z);
                    v[6] = acc[ai][bj][m][1][2] * bflo(gq.w); v[7] = acc[ai][bj][m][1][3] * bfhi(gq.w);
                    *(u32x4*)(Y + (size_t)row * 1024 + col) = pack8(v);
                }
            }
            __builtin_amdgcn_sched_barrier(0);
        }
    }
};

struct EpiRes {
    static constexpr bool HAS_MID = false;
    const float* xres; float* xout; bf16_t* XB; float* rsp;
    __device__ __forceinline__ void operator()(const f32x4 (&acc)[2][2][4][2], const pg8::Unit& u, int wr, int wc, int fr, int fq) const {
#pragma unroll
        for (int ai = 0; ai < 2; ++ai)
#pragma unroll
        for (int mp = 0; mp < 2; ++mp) {
            f32x4 xr0[2][2], xr1[2][2];
#pragma unroll
            for (int mm = 0; mm < 2; ++mm)
#pragma unroll
                for (int bj = 0; bj < 2; ++bj) { const float* xr = xres + (size_t)(u.pm * 256 + ai * 128 + wr * 64 + (2 * mp + mm) * 16 + fr) * Dm + u.pn * 256 + bj * 128 + wc * 32 + fq * 8;
                    xr0[mm][bj] = *(const f32x4*)xr; xr1[mm][bj] = *(const f32x4*)(xr + 4); }
            __builtin_amdgcn_sched_barrier(0);
#pragma unroll
            for (int mm = 0; mm < 2; ++mm) {
                const int m = 2 * mp + mm;
                const int row = u.pm * 256 + ai * 128 + wr * 64 + m * 16 + fr;
                float ss = 0.f;
#pragma unroll
                for (int bj = 0; bj < 2; ++bj) {
                    const int col = u.pn * 256 + bj * 128 + wc * 32 + fq * 8;
                    const f32x4 x0 = xr0[mm][bj], x1 = xr1[mm][bj];
                    float v[8];
#pragma unroll
                    for (int e = 0; e < 4; ++e) { v[e] = x0[e] + acc[ai][bj][m][0][e]; v[4 + e] = x1[e] + acc[ai][bj][m][1][e]; }
#pragma unroll
                    for (int e = 0; e < 8; ++e) ss += v[e] * v[e];
                    float* xo = xout + (size_t)row * Dm + col;
                    *(f32x4*)xo = (f32x4){v[0], v[1], v[2], v[3]}; *(f32x4*)(xo + 4) = (f32x4){v[4], v[5], v[6], v[7]};
                    *(u32x4*)(XB + (size_t)row * Dm + col) = pack8(v);
                }
                ss += __shfl_xor(ss, 16); ss += __shfl_xor(ss, 32);
                if (fq == 0) rsp[(size_t)row * 16 + u.pn * 4 + wc] = ss;
            }
            __builtin_amdgcn_sched_barrier(0);
        }
    }
};

struct EpiGU {
    static constexpr bool HAS_MID = false;
    const float* rsp; bf16_t* H;
    __device__ __forceinline__ void operator()(const f32x4 (&acc)[2][2][4][2], const pg8::Unit& u, int wr, int wc, int fr, int fq) const {
#pragma unroll
        for (int ai = 0; ai < 2; ++ai) {
            const int row0 = u.pm * 256 + ai * 128 + wr * 64 + fr;
            float rs4[4]; rows_rs4(rsp, row0, rs4);
            __builtin_amdgcn_sched_barrier(0);
#pragma unroll
            for (int m = 0; m < 4; ++m) {
                const int row = row0 + m * 16;
                const float rs = rs4[m];
                const int col = u.pn * 128 + wc * 32 + fq * 8;
                float v[8];
                const float nrl = -rs * LOG2E, rs2 = rs * rs;
#pragma unroll
                for (int n = 0; n < 2; ++n) {
                    const f32x4 a = acc[ai][0][m][n], b = acc[ai][1][m][n];
                    f32x4 t = a * nrl;
                    t.x = __builtin_amdgcn_exp2f(t.x); t.y = __builtin_amdgcn_exp2f(t.y); t.z = __builtin_amdgcn_exp2f(t.z); t.w = __builtin_amdgcn_exp2f(t.w);
                    t = t + 1.0f;
                    t.x = __builtin_amdgcn_rcpf(t.x); t.y = __builtin_amdgcn_rcpf(t.y); t.z = __builtin_amdgcn_rcpf(t.z); t.w = __builtin_amdgcn_rcpf(t.w);
                    const f32x4 o = ((a * b) * rs2) * t;
                    v[n * 4] = o.x; v[n * 4 + 1] = o.y; v[n * 4 + 2] = o.z; v[n * 4 + 3] = o.w;
                }
                *(u32x4*)(H + (size_t)row * FF + col) = pack8(v);
            }
            __builtin_amdgcn_sched_barrier(0);
        }
    }
};

__device__ __forceinline__ int rope_perm(int n) {
    const int d = n & 63; if (d >= 16) return n;
    const int g = d >> 3, e = d & 7; return (n & ~63) + ((e < 4) ? 4 * g + e : 8 + 4 * g + (e - 4));
}
__device__ __forceinline__ void conv_item(const float* src, int ld_src, int ks0, int c0  , int mode  ,
                                          const float* gain, bf16_t* dst, int ld_dst, int n0, int kd0, LAS float* scr, int lane) {
    const int n4 = lane & 7, kr = lane >> 3;
    int sc = c0 + 4 * n4;
    if (mode) { const int q = (sc & 63) >> 2; if (q == 1) sc += 4; else if (q == 2) sc -= 4; }
#pragma unroll
    for (int i = 0; i < 8; ++i) { const int kk = kr + 8 * i; f32x4 w = *(const f32x4*)(src + (size_t)(ks0 + kk) * ld_src + sc);
        if (gain) { const float gg = gain[ks0 + kk]; w.x *= gg; w.y *= gg; w.z *= gg; w.w *= gg; }
        LAS float* d = scr + kk * 33 + 4 * n4; d[0] = w.x; d[1] = w.y; d[2] = w.z; d[3] = w.w; }
    asm volatile("s_waitcnt lgkmcnt(0)" ::: "memory");
    const int c = lane & 7;
#pragma unroll
    for (int j = 0; j < 4; ++j) { const int n = (lane >> 3) + 8 * j; const LAS float* s = scr + (8 * c) * 33 + n;
        u32x4 o; o.x = pk2(s[0 * 33], s[1 * 33]); o.y = pk2(s[2 * 33], s[3 * 33]); o.z = pk2(s[4 * 33], s[5 * 33]); o.w = pk2(s[6 * 33], s[7 * 33]);
        *(u32x4*)(dst + (size_t)(n0 + n) * ld_dst + kd0 + 8 * c) = o; }
    asm volatile("s_waitcnt lgkmcnt(0)" ::: "memory");
}

struct Ptrs {
    const float *x; const int* pos; const float *w_in, *da_lambda, *da_norm, *hg_lb, *hg_norm, *w_a, *w_b, *w_o, *attn_norm, *ffn_norm, *w_gate, *w_up, *w_down, *final_norm;
    float* out; unsigned char* ws; int ph_lo, ph_hi;
};

__device__ __forceinline__ void convert_layer(const Ptrs& P, int layer, unsigned char* wbuf, LAS unsigned char* lds, int gw, int ngw, int wave, int lane) {
    LAS float* scr = (LAS float*)(lds + wave * 8704);
    constexpr int I_IN = 16 * 192, I_A = 8 * 32, I_B = 8 * 32, I_O = 16 * 32, I_GU = 16 * 176, I_D = 44 * 32;
    constexpr int NIT = I_IN + I_A + I_B + I_O + I_GU + I_D;
    for (int it = gw; it < NIT; it += ngw) {
        int r = it;
        if (r < I_IN) { const int kb = r / 192, nb = r % 192, n0 = nb * 32;
            int c0 = n0; if (n0 >= 4096) { const int q = n0 - 4096, tile = q >> 8, rr = q & 255; c0 = (rr < 128 ? 4096 : 5120) + tile * 128 + (rr & 127); }
            conv_item(P.w_in + (size_t)layer * Dm * INW, INW, kb * 64, c0, n0 < 1024 ? 1 : 0, P.attn_norm + layer * Dm, (bf16_t*)(wbuf + W_IN), Dm, n0, kb * 64, scr, lane); continue; }
        r -= I_IN;
        if (r < I_A) { const int kb = r / 32, nb = r % 32;
            conv_item(P.w_a + (size_t)layer * 512 * Dm, Dm, kb * 64, nb * 32, 0, nullptr, (bf16_t*)(wbuf + W_AB), 1024, nb * 32, kb * 64, scr, lane); continue; }
        r -= I_A;
        if (r < I_B) { const int kb = r / 32, nb = r % 32;
            conv_item(P.w_b + (size_t)layer * 512 * Dm, Dm, kb * 64, nb * 32, 0, nullptr, (bf16_t*)(wbuf + W_AB), 1024, nb * 32, 512 + kb * 64, scr, lane); continue; }
        r -= I_B;
        if (r < I_O) { const int kb = r / 32, nb = r % 32;
            conv_item(P.w_o + (size_t)layer * Dm * Dm, Dm, kb * 64, nb * 32, 0, nullptr, (bf16_t*)(wbuf + W_O2), Dm, nb * 32, kb * 64, scr, lane); continue; }
        r -= I_O;
        if (r < I_GU) { const int kb = r / 176, nb = r % 176, n0 = nb * 32, tile = n0 >> 8, rr = n0 & 255;
            const float* srcm = (rr < 128 ? P.w_gate : P.w_up) + (size_t)layer * Dm * FF;
            conv_item(srcm, FF, kb * 64, tile * 128 + (rr & 127), 0, P.ffn_norm + layer * Dm, (bf16_t*)(wbuf + W_GU), Dm, n0, kb * 64, scr, lane); continue; }
        r -= I_GU;
        { const int kb = r / 32, nb = r % 32;
            conv_item(P.w_down + (size_t)layer * FF * Dm, Dm, kb * 64, nb * 32, 0, nullptr, (bf16_t*)(wbuf + W_D), FF, nb * 32, kb * 64, scr, lane); }
    }
}

__device__ __forceinline__ float wave_sum(float v) {
#pragma unroll
    for (int o = 1; o < 64; o <<= 1) v += __shfl_xor(v, o);
    return v;
}
__device__ __forceinline__ void prologue(const Ptrs& P, LAS unsigned char* lds, int gw, int ngw, int wave, int lane) {
    unsigned char* ws = P.ws;
    bf16_t* XB = (bf16_t*)(ws + OFF_XB); float* rsb = (float*)(ws + OFF_RSB);
    for (int r = gw; r < M; r += ngw) {
        const f32x4* xr = (const f32x4*)(P.x + (size_t)r * Dm) + lane;
        float ss = 0.f;
#pragma unroll
        for (int j = 0; j < 4; ++j) { const f32x4 v = xr[64 * j]; ss += (v.x * v.x + v.y * v.y) + (v.z * v.z + v.w * v.w);
            u32x2 o; o.x = pk2(v.x, v.y); o.y = pk2(v.z, v.w); *((u32x2*)(XB + (size_t)r * Dm) + lane + 64 * j) = o; }
        ss = wave_sum(ss);
        if (lane < 16) rsb[(size_t)r * 16 + lane] = (lane == 0) ? ss : 0.f;
    }
    const int gt = gw * 64 + lane, ngt = ngw * 64;
    float* cs = (float*)(ws + OFF_CS);
    for (int i = gt; i < M * 8; i += ngt) {
        const int tok = i >> 3, f = i & 7;
        const double invf[8] = {1.0, 0.19392274474868576, 0.03760603093086393, 0.007292664737217109, 0.001414213562373095, 0.0002742481756762073, 5.318295896944988e-05, 1.031338537721246e-05};
        double fr;
        switch (f) { case 0: fr = invf[0]; break; case 1: fr = invf[1]; break; case 2: fr = invf[2]; break; case 3: fr = invf[3]; break; case 4: fr = invf[4]; break; case 5: fr = invf[5]; break; case 6: fr = invf[6]; break; default: fr = invf[7]; }
        const float ang32 = (float)P.pos[tok] * (float)fr;
        const double ang = (double)ang32;
        const double rev = ang * 0.15915494309189535;
        const double fracrev = rev - __builtin_floor(rev + 0.5);
        const float a = (float)(fracrev * 6.283185307179586);
        cs[(size_t)tok * 16 + f] = __cosf(a); cs[(size_t)tok * 16 + 8 + f] = __sinf(a);
    }
    float* LB = (float*)(ws + OFF_LB);
    for (int i = gt; i < 2 * 512; i += ngt) {
        const int d = i >> 9, k = i & 511;
        float l[4], mx = -1e30f;
#pragma unroll
        for (int j = 0; j < 4; ++j) { l[j] = P.hg_lb[(size_t)(d * 4 + j) * 512 + k]; mx = fmaxf(mx, l[j]); }
        float e[4], sum = 0.f;
#pragma unroll
        for (int j = 0; j < 4; ++j) { e[j] = __expf(l[j] - mx); sum += e[j]; }
        float cum = 0.f;
#pragma unroll
        for (int j = 0; j < 4; ++j) { if (j > 0) cum += e[j] / sum; LB[(size_t)(d * 4 + j) * 512 + k] = cum; }
    }
    if (gw == 0) {
        float* LAM = (float*)(ws + OFF_LAM);
        for (int l = 0; l < 4; ++l) {
            const float* p = P.da_lambda + l * 256;
            float a = wave_sum(p[lane] * p[64 + lane]), b = wave_sum(p[128 + lane] * p[192 + lane]);
            const float lam_init = 0.8f - 0.6f * __expf(-0.3f * (float)l);
            if (lane == 0) LAM[l] = __expf(a) - __expf(b) + lam_init;
        }
    }
}

constexpr int AT_KROW = 144, AT_VROW = 320, AT_K1 = 64 * AT_KROW, AT_V = 2 * AT_K1, AT_STG = AT_V + 64 * AT_VROW;
constexpr int AT_IMG_ROW = 132;
__device__ __forceinline__ s16x4 tr_read(const LAS unsigned char* p) { return __builtin_bit_cast(s16x4, __builtin_amdgcn_ds_read_tr16_b64_v4i16((LAS s16x4*)p)); }

__device__ __forceinline__ void attn_unit(int b, int h, int qb, const bf16_t* Q, const bf16_t* Kk, const bf16_t* V, bf16_t* AO, const float* gainA  , float one_minus_lam_init, float lam, LAS unsigned char* lds) {
    int tid_ = threadIdx.x; asm volatile("" : "+v"(tid_));
    const int tid = tid_, wave = __builtin_amdgcn_readfirstlane(tid >> 6), lane = tid & 63, c = wave >> 2, wq = wave & 3, r32 = lane & 31, hh = lane >> 5;
    const int q0 = qb * 128 + wq * 32;
    bf16x8 qf[4];
    { const bf16_t* Qp = Q + ((size_t)(((b * 4 + h) * 2 + c) * SEQ + q0 + r32)) * 64 + 8 * hh;
#pragma unroll
      for (int s = 0; s < 4; ++s) qf[s] = *(const bf16x8*)(Qp + 16 * s); }
    f32x16 o[4];
#pragma unroll
    for (int i = 0; i < 4; ++i)
#pragma unroll
        for (int e = 0; e < 16; ++e) o[i][e] = 0.f;
    float mrow = -1e30f, lrow = 0.f;
    const unsigned char* Kg0 = (const unsigned char*)(Kk + ((size_t)((b * 4 + h) * 2 + 0) * SEQ) * 64);
    const unsigned char* Kg1 = (const unsigned char*)(Kk + ((size_t)((b * 4 + h) * 2 + 1) * SEQ) * 64);
    const unsigned char* Vg = (const unsigned char*)(V + ((size_t)(b * 4 + h) * SEQ) * 128);
    const int lk = (tid >> 3) * AT_KROW + (tid & 7) * 16;
    const int lv0 = AT_V + (tid >> 4) * AT_VROW + (tid & 15) * 16, lv1 = lv0 + 32 * AT_VROW;
    u32x4 r0, r1, r2, r3;
    r0 = *(const u32x4*)(Kg0 + tid * 16); r1 = *(const u32x4*)(Kg1 + tid * 16); r2 = *(const u32x4*)(Vg + tid * 16); r3 = *(const u32x4*)(Vg + 8192 + tid * 16);
    *(LAS u32x4*)(lds + lk) = r0; *(LAS u32x4*)(lds + AT_K1 + lk) = r1; *(LAS u32x4*)(lds + lv0) = r2; *(LAS u32x4*)(lds + lv1) = r3;
    r0 = *(const u32x4*)(Kg0 + 8192 + tid * 16); r1 = *(const u32x4*)(Kg1 + 8192 + tid * 16);
    *(LAS u32x4*)(lds + AT_STG + lk) = r0; *(LAS u32x4*)(lds + AT_STG + AT_K1 + lk) = r1;
    __syncthreads();
    const int ka = c * AT_K1 + r32 * AT_KROW + hh * 16;
    const int va = AT_V + (4 * hh + ((lane & 15) >> 2)) * AT_VROW + ((lane >> 4) & 1) * 32 + (lane & 3) * 8;

#define AT_QK(sv, st) do { f32x16 t0_, t1_; _Pragma("unroll") for (int e = 0; e < 16; ++e) { t0_[e] = 0.f; t1_[e] = 0.f; } \
        _Pragma("unroll") for (int ks = 0; ks < 4; ++ks) { \
            const bf16x8 a0 = *(const LAS bf16x8*)(lds + (st) + ka + ks * 32), a1 = *(const LAS bf16x8*)(lds + (st) + ka + 32 * AT_KROW + ks * 32); \
            t0_ = __builtin_amdgcn_mfma_f32_32x32x16_bf16(a0, qf[ks], t0_, 0, 0, 0); t1_ = __builtin_amdgcn_mfma_f32_32x32x16_bf16(a1, qf[ks], t1_, 0, 0, 0); } \
        sv##0 = t0_; sv##1 = t1_; } while (0)
    f32x16 sA0, sA1, sB0, sB1;
    AT_QK(sA, 0);
#define AT_VFRAG(dst, STC, g) do { const LAS unsigned char* vb_ = lds + (STC) + va + (16 * (g)) * AT_VROW; \
        _Pragma("unroll") for (int vt = 0; vt < 4; ++vt) { const s16x4 t0 = tr_read(vb_ + vt * 64), t1 = tr_read(vb_ + vt * 64 + 8 * AT_VROW); \
            dst[vt] = (bf16x8){t0[0], t0[1], t0[2], t0[3], t1[0], t1[1], t1[2], t1[3]}; } } while (0)
#define AT_PV(vf, p) do { __builtin_amdgcn_s_setprio(1); _Pragma("unroll") for (int vt = 0; vt < 4; ++vt) o[vt] = __builtin_amdgcn_mfma_f32_32x32x16_bf16(vf[vt], p, o[vt], 0, 0, 0); __builtin_amdgcn_s_setprio(0); } while (0)
#define AT_SB __builtin_amdgcn_sched_barrier(0)
#define AT_TILE(j, s0, s1, sn, STC  , STN  ) do { \
        if ((j) + 2 < 64) { const size_t go = (size_t)((j) + 2) * 8192; r0 = *(const u32x4*)(Kg0 + go + tid * 16); r1 = *(const u32x4*)(Kg1 + go + tid * 16); } \
        if ((j) + 1 < 64) { const size_t go = (size_t)((j) + 1) * 16384; r2 = *(const u32x4*)(Vg + go + tid * 16); r3 = *(const u32x4*)(Vg + go + 8192 + tid * 16); } \
        bf16x8 kf[4], kg[4], vA[4]; \
        if ((j) + 1 < 64) { _Pragma("unroll") for (int ks = 0; ks < 2; ++ks) { kf[2 * ks] = *(const LAS bf16x8*)(lds + (STN) + ka + ks * 32); kf[2 * ks + 1] = *(const LAS bf16x8*)(lds + (STN) + ka + 32 * AT_KROW + ks * 32); } } \
        AT_SB; \
        float mx = fmaxf(s0[0], s1[0]); \
        _Pragma("unroll") for (int e = 1; e < 16; ++e) mx = fmaxf(mx, fmaxf(s0[e], s1[e])); \
        mx = fmaxf(mx, __shfl_xor(mx, 32)); \
        if (__builtin_amdgcn_ballot_w64(mx > mrow + 8.0f) != 0ull) { \
            const float mnew = fmaxf(mrow, mx), alpha = __builtin_amdgcn_exp2f(mrow - mnew); mrow = mnew; lrow *= alpha; \
            _Pragma("unroll") for (int i = 0; i < 4; ++i) _Pragma("unroll") for (int e = 0; e < 16; ++e) o[i][e] *= alpha; } \
        AT_SB; \
        if ((j) + 1 < 64) { f32x16 t0_, t1_; _Pragma("unroll") for (int e = 0; e < 16; ++e) { t0_[e] = 0.f; t1_[e] = 0.f; } \
            __builtin_amdgcn_s_setprio(1); \
            _Pragma("unroll") for (int ks = 0; ks < 2; ++ks) { t0_ = __builtin_amdgcn_mfma_f32_32x32x16_bf16(kf[2 * ks], qf[ks], t0_, 0, 0, 0); t1_ = __builtin_amdgcn_mfma_f32_32x32x16_bf16(kf[2 * ks + 1], qf[ks], t1_, 0, 0, 0); } \
            AT_SB; \
            _Pragma("unroll") for (int ks = 0; ks < 2; ++ks) { kg[2 * ks] = *(const LAS bf16x8*)(lds + (STN) + ka + (ks + 2) * 32); kg[2 * ks + 1] = *(const LAS bf16x8*)(lds + (STN) + ka + 32 * AT_KROW + (ks + 2) * 32); } \
            AT_SB; \
            _Pragma("unroll") for (int ks = 0; ks < 2; ++ks) { t0_ = __builtin_amdgcn_mfma_f32_32x32x16_bf16(kg[2 * ks], qf[ks + 2], t0_, 0, 0, 0); t1_ = __builtin_amdgcn_mfma_f32_32x32x16_bf16(kg[2 * ks + 1], qf[ks + 2], t1_, 0, 0, 0); } \
            __builtin_amdgcn_s_setprio(0); sn##0 = t0_; sn##1 = t1_; } \
        AT_VFRAG(vA, STC, 0); \
        AT_SB; \
        float ls = 0.f; \
        _Pragma("unroll") for (int e = 0; e < 16; ++e) { s0[e] = __builtin_amdgcn_exp2f(s0[e] - mrow); s1[e] = __builtin_amdgcn_exp2f(s1[e] - mrow); ls += s0[e] + s1[e]; } \
        lrow += ls; \
        bf16x8 pf[2][2]; \
        _Pragma("unroll") for (int s = 0; s < 2; ++s) { u32x4 w0, w1; \
            w0.x = pk2(s0[8 * s + 0], s0[8 * s + 1]); w0.y = pk2(s0[8 * s + 2], s0[8 * s + 3]); w0.z = pk2(s0[8 * s + 4], s0[8 * s + 5]); w0.w = pk2(s0[8 * s + 6], s0[8 * s + 7]); \
            w1.x = pk2(s1[8 * s + 0], s1[8 * s + 1]); w1.y = pk2(s1[8 * s + 2], s1[8 * s + 3]); w1.z = pk2(s1[8 * s + 4], s1[8 * s + 5]); w1.w = pk2(s1[8 * s + 6], s1[8 * s + 7]); \
            pf[0][s] = __builtin_bit_cast(bf16x8, w0); pf[1][s] = __builtin_bit_cast(bf16x8, w1); } \
        AT_SB; \
        AT_PV(vA, pf[0][0]); \
        AT_SB; \
        AT_VFRAG(vA, STC, 1); \
        AT_SB; \
        AT_PV(vA, pf[0][1]); \
        AT_SB; \
          \
        if ((j) + 2 < 64) { *(LAS u32x4*)(lds + (STC) + lk) = r0; *(LAS u32x4*)(lds + (STC) + AT_K1 + lk) = r1; } \
        if ((j) + 1 < 64) { *(LAS u32x4*)(lds + (STN) + lv0) = r2; *(LAS u32x4*)(lds + (STN) + lv1) = r3; } \
        AT_SB; \
        AT_VFRAG(vA, STC, 2); \
        AT_SB; \
        AT_PV(vA, pf[1][0]); \
        AT_SB; \
        AT_VFRAG(vA, STC, 3); \
        AT_SB; \
        AT_PV(vA, pf[1][1]); \
        __syncthreads(); } while (0)
    for (int j = 0; j < 64; j += 2) {
        AT_TILE(j, sA0, sA1, sB, 0, AT_STG);
        AT_TILE(j + 1, sB0, sB1, sA, AT_STG, 0);
    }
#undef AT_TILE
#undef AT_QK
#undef AT_VFRAG
#undef AT_PV
#undef AT_SB
    const float inv = __builtin_amdgcn_rcpf(lrow + __shfl_xor(lrow, 32));
    LAS float* img = (LAS float*)lds;
    const int qrow = wq * 32 + r32;
    if (c == 1) {
        const float sc = -lam * inv;
#pragma unroll
        for (int vt = 0; vt < 4; ++vt)
#pragma unroll
            for (int g = 0; g < 4; ++g)
                *(LAS f32x4*)(img + qrow * AT_IMG_ROW + 32 * vt + 8 * g + 4 * hh) = (f32x4){o[vt][4 * g] * sc, o[vt][4 * g + 1] * sc, o[vt][4 * g + 2] * sc, o[vt][4 * g + 3] * sc};
    }
    __syncthreads();
    if (c == 0) {
#pragma unroll
        for (int vt = 0; vt < 4; ++vt)
#pragma unroll
            for (int g = 0; g < 4; ++g) {
                LAS f32x4* p = (LAS f32x4*)(img + qrow * AT_IMG_ROW + 32 * vt + 8 * g + 4 * hh);
                f32x4 t = *p;
                t.x += o[vt][4 * g] * inv; t.y += o[vt][4 * g + 1] * inv; t.z += o[vt][4 * g + 2] * inv; t.w += o[vt][4 * g + 3] * inv;
                *p = t;
            }
    }
    __syncthreads();
    {
        const int q = tid >> 2, part = tid & 3;
        float v[32]; float ss = 0.f;
#pragma unroll
        for (int i = 0; i < 8; ++i) { const f32x4 t = *(const LAS f32x4*)(img + q * AT_IMG_ROW + 32 * part + 4 * i); v[4 * i] = t.x; v[4 * i + 1] = t.y; v[4 * i + 2] = t.z; v[4 * i + 3] = t.w;
            ss += (t.x * t.x + t.y * t.y) + (t.z * t.z + t.w * t.w); }
        ss += __shfl_xor(ss, 1); ss += __shfl_xor(ss, 2);
        const float rs = rsqrtf(ss * (1.0f / 128.0f) + EPS) * one_minus_lam_init;
        const float* gp = gainA + h * 128 + 32 * part;
        bf16_t* dst = AO + ((size_t)(b * SEQ + qb * 128 + q)) * 1024 + h * 128 + 32 * part;
#pragma unroll
        for (int i = 0; i < 4; ++i) {
            const f32x4 g0 = *(const f32x4*)(gp + 8 * i), g1 = *(const f32x4*)(gp + 8 * i + 4);
            u32x4 w; w.x = pk2(v[8 * i] * rs * g0.x, v[8 * i + 1] * rs * g0.y); w.y = pk2(v[8 * i + 2] * rs * g0.z, v[8 * i + 3] * rs * g0.w);
            w.z = pk2(v[8 * i + 4] * rs * g1.x, v[8 * i + 5] * rs * g1.y); w.w = pk2(v[8 * i + 6] * rs * g1.z, v[8 * i + 7] * rs * g1.w);
            *(u32x4*)(dst + 8 * i) = w;
        }
    }
    __syncthreads();
}

constexpr int HG_SEG = 0;
constexpr int HG_F = 2048;
constexpr int HG_PART = 2560;
constexpr int HG_V = 4096;
constexpr int HG_VROW = 288;
constexpr int HG_A = HG_V + 64 * HG_VROW;
constexpr int HG_KTROW = 144, HG_QKROW = 272;
constexpr int HG_Bq = HG_A + 128 * HG_KTROW;

__device__ __forceinline__ void hg_cumsum(const float (&gv)[16], int dir, int k, int j, LAS unsigned char* lds, float (&d)[16], float& m_out, float& tot_out) {
    float run = 0.f;
    if (dir == 0) {
#pragma unroll
        for (int i = 0; i < 16; ++i) { run += gv[i]; d[i] = run; }
    } else {
#pragma unroll
        for (int i = 15; i >= 0; --i) { run += gv[i]; d[i] = run; }
    }
    LAS float* seg = (LAS float*)(lds + HG_SEG);
    seg[j * 128 + k] = run;
    __syncthreads();
    const float s0 = seg[k], s1 = seg[128 + k], s2 = seg[256 + k], s3 = seg[384 + k];
    float off, m;
    if (dir == 0) { off = (j > 0 ? s0 : 0.f) + (j > 1 ? s1 : 0.f) + (j > 2 ? s2 : 0.f); m = s0 + s1; }
    else { off = (j < 3 ? s3 : 0.f) + (j < 2 ? s2 : 0.f) + (j < 1 ? s1 : 0.f); m = s2 + s3; }
#pragma unroll
    for (int i = 0; i < 16; ++i) d[i] = d[i] + off - m;
    m_out = m; tot_out = (s0 + s1) + (s2 + s3);
}
__device__ __forceinline__ void hg_load_v(const bf16_t* HV, int tok0, int h, LAS unsigned char* lds, int tid) {
#pragma unroll
    for (int i = 0; i < 2; ++i) { const int ch = tid + 512 * i, p = ch >> 4, part = ch & 15;
        *(LAS u32x4*)(lds + HG_V + p * HG_VROW + part * 16) = *(const u32x4*)(HV + (size_t)(tok0 + p) * 512 + h * 128 + part * 8); }
}
__device__ __forceinline__ void hg_load_g(const float* G, int tok0, int h, int k, int j, float (&gv)[16]) {
    const float* gp = G + (size_t)(tok0 + 16 * j) * 512 + h * 128 + k;
#pragma unroll
    for (int i = 0; i < 16; ++i) gv[i] = gp[(size_t)i * 512];
}

__device__ __forceinline__ void hg1_phase(int bx, int G, const float* GF, const float* GB, const bf16_t* HV, bf16_t* UT, float* Dg, float* Eg, LAS unsigned char* lds) {
    int tid_ = threadIdx.x; asm volatile("" : "+v"(tid_));
    const int tid = tid_, wave = __builtin_amdgcn_readfirstlane(tid >> 6), lane = tid & 63;
    const int k = tid & 127, j = tid >> 7, i16 = lane & 15, g4 = lane >> 4;
    float gn[16]; u32x4 vn[2];
#define HG1_LOAD(uu) do { const int u_ = (uu), dir_ = u_ & 1, cch_ = (u_ >> 1) & 63, bh_ = u_ >> 7, tok_ = (bh_ >> 2) * SEQ + cch_ * 64; \
        hg_load_g(dir_ ? GB : GF, tok_, bh_ & 3, k, j, gn); \
        _Pragma("unroll") for (int i = 0; i < 2; ++i) { const int ch = tid + 512 * i; vn[i] = *(const u32x4*)(HV + (size_t)(tok_ + (ch >> 4)) * 512 + (bh_ & 3) * 128 + (ch & 15) * 8); } } while (0)
    if (bx < 2048) HG1_LOAD(bx);
    for (int u = bx; u < 2048; u += G) {
        const int dir = u & 1, cch = (u >> 1) & 63, bh = u >> 7, b = bh >> 2, h = bh & 3;
        const int tok0 = b * SEQ + cch * 64;
        float gv[16], d[16], m, tot;
#pragma unroll
        for (int i = 0; i < 16; ++i) gv[i] = gn[i];
        u32x4 vr[2];
#pragma unroll
        for (int i = 0; i < 2; ++i) vr[i] = vn[i];
        if (u + G < 2048) HG1_LOAD(u + G);
        hg_cumsum(gv, dir, k, j, lds, d, m, tot);
        float kt[16];
#pragma unroll
        for (int i = 0; i < 16; ++i) kt[i] = (1.0f - __expf(gv[i])) * __expf(fminf(-d[i], 40.f));
        { u32x4 w0, w1;
          w0.x = pk2(kt[0], kt[1]); w0.y = pk2(kt[2], kt[3]); w0.z = pk2(kt[4], kt[5]); w0.w = pk2(kt[6], kt[7]);
          w1.x = pk2(kt[8], kt[9]); w1.y = pk2(kt[10], kt[11]); w1.z = pk2(kt[12], kt[13]); w1.w = pk2(kt[14], kt[15]);
          *(LAS u32x4*)(lds + HG_A + k * HG_KTROW + j * 32) = w0; *(LAS u32x4*)(lds + HG_A + k * HG_KTROW + j * 32 + 16) = w1; }
#pragma unroll
        for (int i = 0; i < 2; ++i) { const int ch = tid + 512 * i; *(LAS u32x4*)(lds + HG_V + (ch >> 4) * HG_VROW + (ch & 15) * 16) = vr[i]; }
        if (j == 0) { ((LAS float*)(lds + HG_F))[k] = __expf(tot - m); Dg[(size_t)u * 128 + k] = __expf(tot); Eg[(size_t)u * 128 + k] = __expf(m); }
        __syncthreads();
        bf16x8 af[2];
#pragma unroll
        for (int s = 0; s < 2; ++s) {
            const LAS unsigned char* ap = lds + HG_A + (16 * wave + i16) * HG_KTROW + (32 * s + 4 * g4) * 2;
            const u32x2 lo = *(const LAS u32x2*)ap, hi = *(const LAS u32x2*)(ap + 32);
            af[s] = __builtin_bit_cast(bf16x8, (u32x4){lo.x, lo.y, hi.x, hi.y});
        }
        const f32x4 fsc = *(const LAS f32x4*)(lds + HG_F + (16 * wave + 4 * g4) * 4);
        const LAS unsigned char* vbase = lds + HG_V + (4 * g4 + (i16 >> 2)) * HG_VROW + (i16 & 3) * 8;
#pragma unroll
        for (int vt = 0; vt < 8; ++vt) {
            f32x4 acc = {0.f, 0.f, 0.f, 0.f};
#pragma unroll
            for (int s = 0; s < 2; ++s) {
                const s16x4 t0 = tr_read(vbase + (32 * s) * HG_VROW + vt * 32), t1 = tr_read(vbase + (32 * s + 16) * HG_VROW + vt * 32);
                const bf16x8 bv = {t0[0], t0[1], t0[2], t0[3], t1[0], t1[1], t1[2], t1[3]};
                acc = __builtin_amdgcn_mfma_f32_16x16x32_bf16(af[s], bv, acc, 0, 0, 0);
            }
            u32x2 w; w.x = pk2(acc[0] * fsc[0], acc[1] * fsc[1]); w.y = pk2(acc[2] * fsc[2], acc[3] * fsc[3]);
            *(u32x2*)(UT + ((size_t)u * 128 + 16 * vt + i16) * 128 + 16 * wave + 4 * g4) = w;
        }
        __syncthreads();
    }
}

__device__ __forceinline__ void hg2_scan(bf16_t* UT, const float* Dg, const float* Eg, int gthread, int nthreads) {
    for (int idx = gthread; idx < 32 * 4096; idx += nthreads) {
        const int chain = idx >> 12, e4 = idx & 4095, v = e4 >> 5, k0 = (e4 & 31) * 4;
        const int dir = chain & 1, bh = chain >> 1;
        float S0 = 0.f, S1 = 0.f, S2 = 0.f, S3 = 0.f;
        int u = (bh * 64 + (dir ? 63 : 0)) * 2 + dir;
        const int ustep = dir ? -2 : 2;
        u32x2 uu[4]; f32x4 dd[4], ee[4];
#pragma unroll
        for (int r = 0; r < 4; ++r) { const int ur = u + r * ustep; uu[r] = *(const u32x2*)(UT + ((size_t)ur * 128 + v) * 128 + k0); dd[r] = *(const f32x4*)(Dg + (size_t)ur * 128 + k0); ee[r] = *(const f32x4*)(Eg + (size_t)ur * 128 + k0); }
        for (int cc = 0; cc < 64; cc += 4) {
#pragma unroll
            for (int r = 0; r < 4; ++r) {
                const u32x2 uc = uu[r]; const f32x4 dc = dd[r], ec = ee[r];
                if (cc + 4 < 64) { const int un = u + 4 * ustep; uu[r] = *(const u32x2*)(UT + ((size_t)un * 128 + v) * 128 + k0); dd[r] = *(const f32x4*)(Dg + (size_t)un * 128 + k0); ee[r] = *(const f32x4*)(Eg + (size_t)un * 128 + k0); }
                u32x2 w; w.x = pk2(ec.x * S0, ec.y * S1); w.y = pk2(ec.z * S2, ec.w * S3);
                *(u32x2*)(UT + ((size_t)u * 128 + v) * 128 + k0) = w;
                S0 = dc.x * S0 + bflo(uc.x); S1 = dc.y * S1 + bfhi(uc.x); S2 = dc.z * S2 + bflo(uc.y); S3 = dc.w * S3 + bfhi(uc.y);
                u += ustep;
            }
        }
    }
}

constexpr int HG_OUT = HG_Bq + 64 * HG_QKROW;
__device__ __forceinline__ void hg3_phase(int bx, int G, const float* GF, const float* GB, const bf16_t* HQ, const bf16_t* HV, const bf16_t* ST, const bf16_t* BG, const float* gainH, bf16_t* AO, LAS unsigned char* lds) {
    int tid_ = threadIdx.x; asm volatile("" : "+v"(tid_));
    const int tid = tid_, wave = __builtin_amdgcn_readfirstlane(tid >> 6), lane = tid & 63;
    const int k = tid & 127, j = tid >> 7;
    const int tb = wave & 3, vh = wave >> 2, i16 = lane & 15, g4 = lane >> 4;
    float gf[16], gb[16]; unsigned short qr[16];
#define HG3_LOAD(uu) do { const int u_ = (uu), cch_ = u_ & 63, bh_ = u_ >> 6, tok_ = (bh_ >> 2) * SEQ + cch_ * 64, h_ = bh_ & 3; \
        hg_load_g(GF, tok_, h_, k, j, gf); hg_load_g(GB, tok_, h_, k, j, gb); \
        const bf16_t* qp = HQ + (size_t)(tok_ + 16 * j) * 512 + h_ * 128 + k; \
        _Pragma("unroll") for (int i = 0; i < 16; ++i) qr[i] = qp[(size_t)i * 512]; } while (0)
    if (bx < 1024) HG3_LOAD(bx);
  for (int u3 = bx; u3 < 1024; u3 += G) {
    const int cch = u3 & 63, bh = u3 >> 6, b = bh >> 2, h = bh & 3;
    const int tok0 = b * SEQ + cch * 64;
    hg_load_v(HV, tok0, h, lds, tid);
    u32x4 bgq[2];
    { const bf16_t* bgp0 = BG + (size_t)(tok0 + (tid >> 3)) * 512 + h * 128 + 16 * (tid & 7); bgq[0] = *(const u32x4*)bgp0; bgq[1] = *(const u32x4*)(bgp0 + 8); }
    bf16x8 sb[16];
    { const bf16_t* stp = ST + ((size_t)((bh * 64 + cch) * 2 + 0) * 128) * 128;
#pragma unroll
      for (int vv = 0; vv < 4; ++vv)
#pragma unroll
        for (int ks = 0; ks < 4; ++ks) sb[vv * 4 + ks] = *(const bf16x8*)(stp + (size_t)(16 * (4 * vh + vv) + i16) * 128 + 32 * ks + 8 * g4); }
    f32x4 oacc[4];
#pragma unroll
    for (int i = 0; i < 4; ++i) oacc[i] = (f32x4){0.f, 0.f, 0.f, 0.f};
#pragma unroll
    for (int dir = 0; dir < 2; ++dir) {
        float d[16], m, tot;
        hg_cumsum(dir ? gb : gf, dir, k, j, lds, d, m, tot);
#pragma unroll
        for (int i = 0; i < 16; ++i) {
            const float gvi = dir ? gb[i] : gf[i];
            const float kt = (1.0f - __expf(gvi)) * __expf(fminf(-d[i], 40.f));
            const float qt = bf2f(qr[i]) * __expf(fminf(d[i], 40.f));
            *(LAS unsigned short*)(lds + HG_A + (16 * j + i) * HG_QKROW + k * 2) = (unsigned short)f2bf(kt);
            *(LAS unsigned short*)(lds + HG_Bq + (16 * j + i) * HG_QKROW + k * 2) = (unsigned short)f2bf(qt);
        }
        if (dir == 1 && u3 + G < 1024) HG3_LOAD(u3 + G);
        __syncthreads();
        f32x4 pt[4];
#pragma unroll
        for (int sg = 0; sg < 4; ++sg) pt[sg] = (f32x4){0.f, 0.f, 0.f, 0.f};
        bf16x8 qa[4];
#pragma unroll
        for (int ks = 0; ks < 4; ++ks) qa[ks] = *(const LAS bf16x8*)(lds + HG_Bq + (16 * tb + i16) * HG_QKROW + (32 * ks + 8 * g4) * 2);
#pragma unroll
        for (int sg = 0; sg < 4; ++sg)
#pragma unroll
            for (int ks = 0; ks < 4; ++ks) {
                const bf16x8 ka = *(const LAS bf16x8*)(lds + HG_A + (16 * sg + i16) * HG_QKROW + (32 * ks + 8 * g4) * 2);
                pt[sg] = __builtin_amdgcn_mfma_f32_16x16x32_bf16(ka, qa[ks], pt[sg], 0, 0, 0);
            }
        const int tcol = 16 * tb + i16;
#pragma unroll
        for (int sg = 0; sg < 4; ++sg)
#pragma unroll
            for (int e = 0; e < 4; ++e) { const int srow = 16 * sg + 4 * g4 + e; const bool keep = dir ? (srow >= tcol) : (srow <= tcol); pt[sg][e] = keep ? pt[sg][e] : 0.f; }
        bf16x8 pa[2];
#pragma unroll
        for (int s2 = 0; s2 < 2; ++s2) {
            u32x4 w; w.x = pk2(pt[2 * s2][0], pt[2 * s2][1]); w.y = pk2(pt[2 * s2][2], pt[2 * s2][3]); w.z = pk2(pt[2 * s2 + 1][0], pt[2 * s2 + 1][1]); w.w = pk2(pt[2 * s2 + 1][2], pt[2 * s2 + 1][3]);
            pa[s2] = __builtin_bit_cast(bf16x8, w);
        }
        const LAS unsigned char* vbase = lds + HG_V + (4 * g4 + (i16 >> 2)) * HG_VROW + (i16 & 3) * 8;
#pragma unroll
        for (int vv = 0; vv < 4; ++vv) {
            const int vt = 4 * vh + vv;
#pragma unroll
            for (int s2 = 0; s2 < 2; ++s2) {
                const s16x4 t0 = tr_read(vbase + (32 * s2) * HG_VROW + vt * 32), t1 = tr_read(vbase + (32 * s2 + 16) * HG_VROW + vt * 32);
                const bf16x8 bv = {t0[0], t0[1], t0[2], t0[3], t1[0], t1[1], t1[2], t1[3]};
                oacc[vv] = __builtin_amdgcn_mfma_f32_16x16x32_bf16(pa[s2], bv, oacc[vv], 0, 0, 0);
            }
#pragma unroll
            for (int ks = 0; ks < 4; ++ks) oacc[vv] = __builtin_amdgcn_mfma_f32_16x16x32_bf16(qa[ks], sb[vv * 4 + ks], oacc[vv], 0, 0, 0);
        }
        if (dir == 0) {
            const bf16_t* stp = ST + ((size_t)((bh * 64 + cch) * 2 + 1) * 128) * 128;
#pragma unroll
            for (int vv = 0; vv < 4; ++vv)
#pragma unroll
                for (int ks = 0; ks < 4; ++ks) sb[vv * 4 + ks] = *(const bf16x8*)(stp + (size_t)(16 * (4 * vh + vv) + i16) * 128 + 32 * ks + 8 * g4);
        }
        __syncthreads();
    }
    LAS float* ot = (LAS float*)(lds + HG_OUT);
#pragma unroll
    for (int vv = 0; vv < 4; ++vv)
#pragma unroll
        for (int e = 0; e < 4; ++e) ot[(16 * tb + 4 * g4 + e) * 132 + 16 * (4 * vh + vv) + i16] = oacc[vv][e];
    __syncthreads();
    {
        const int t = tid >> 3, part = tid & 7;
        float v[16]; float ss = 0.f;
#pragma unroll
        for (int i = 0; i < 4; ++i) { const f32x4 x = *(const LAS f32x4*)(ot + t * 132 + 16 * part + 4 * i); v[4 * i] = x.x; v[4 * i + 1] = x.y; v[4 * i + 2] = x.z; v[4 * i + 3] = x.w; ss += (x.x * x.x + x.y * x.y) + (x.z * x.z + x.w * x.w); }
        ss += __shfl_xor(ss, 1); ss += __shfl_xor(ss, 2); ss += __shfl_xor(ss, 4);
        const float rs = rsqrtf(ss * (1.0f / 128.0f) + EPS);
        const float* gp = gainH + h * 128 + 16 * part;
        bf16_t* dst = AO + (size_t)(tok0 + t) * 1024 + 512 + h * 128 + 16 * part;
#pragma unroll
        for (int i = 0; i < 2; ++i) {
            const u32x4 gq = bgq[i];
            const f32x4 g0 = *(const f32x4*)(gp + 8 * i), g1 = *(const f32x4*)(gp + 8 * i + 4);
            u32x4 w;
            w.x = pk2(v[8 * i] * rs * g0.x * bflo(gq.x), v[8 * i + 1] * rs * g0.y * bfhi(gq.x)); w.y = pk2(v[8 * i + 2] * rs * g0.z * bflo(gq.y), v[8 * i + 3] * rs * g0.w * bfhi(gq.y));
            w.z = pk2(v[8 * i + 4] * rs * g1.x * bflo(gq.z), v[8 * i + 5] * rs * g1.y * bfhi(gq.z)); w.w = pk2(v[8 * i + 6] * rs * g1.z * bflo(gq.w), v[8 * i + 7] * rs * g1.w * bfhi(gq.w));
            *(u32x4*)(dst + 8 * i) = w;
        }
    }
    __syncthreads();
  }
#undef HG3_LOAD
}

#define XB_TMO      128
#define XB_XCNT(j)  (256  + 64 * (j))
#define XB_XSUB(j)  (1280 + 64 * (j))
#define XB_XGEN(j)  (2304 + 64 * (j))
#define XB_TOP      3328
#define XB_TOPGEN   3392
#define XCD_BAR_WORDS 3456
#define XB_SPIN_CAP (1u << 18)

__device__ __forceinline__ unsigned xb_ld(unsigned* p)              { return __hip_atomic_load(p, __ATOMIC_RELAXED, __HIP_MEMORY_SCOPE_AGENT); }
__device__ __forceinline__ unsigned xb_add(unsigned* p, unsigned v) { return __hip_atomic_fetch_add(p, v, __ATOMIC_RELAXED, __HIP_MEMORY_SCOPE_AGENT); }
__device__ __forceinline__ unsigned xb_xcc_id() { return (unsigned)__builtin_amdgcn_s_getreg((3 << 11) | 20) & 0xFu; }
#define XB_SPIN(cond, bar) do { unsigned _sp = 0; while (cond) { __builtin_amdgcn_s_sleep(1); \
    if ((++_sp & 255u) == 0u) { if (xb_ld(&(bar)[XB_TMO])) break; if (_sp > XB_SPIN_CAP) { atomicAdd(&(bar)[XB_TMO], 1u); break; } } } } while (0)

struct XcdBarrier {
    unsigned* bar; unsigned x;
    volatile LAS unsigned* st;
};

__device__ __forceinline__ XcdBarrier xcd_barrier_post(unsigned* bar, volatile LAS unsigned* st) {
    XcdBarrier b; b.bar = bar; b.x = xb_xcc_id(); b.st = st;
    if (threadIdx.x == 0) (void)xb_add(&bar[XB_XCNT(b.x)], 1u);
    return b;
}
__device__ __forceinline__ void xcd_barrier_complete(unsigned* bar, unsigned x, unsigned& nloc, unsigned& nx) {
    const unsigned G = gridDim.x * gridDim.y * gridDim.z;
    unsigned sum, cnt, mine, sp = 0u;
    for (;;) {
        sum = 0u; cnt = 0u; mine = 0u;
#pragma unroll
        for (unsigned j = 0; j < 16; ++j) { const unsigned c = xb_ld(&bar[XB_XCNT(j)]); sum += c; cnt += (c > 0u) ? 1u : 0u; mine = (j == x) ? c : mine; }
        if (sum == G) break;
        __builtin_amdgcn_s_sleep(1);
        if ((++sp & 255u) == 0u) { if (xb_ld(&bar[XB_TMO])) break; if (sp > XB_SPIN_CAP) { atomicAdd(&bar[XB_TMO], 1u); break; } }
    }
    nloc = mine > 0u ? mine : 1u; nx = cnt > 0u ? cnt : 1u;
}

__device__ __forceinline__ void xcd_barrier(const XcdBarrier& b) {
    asm volatile("s_waitcnt vmcnt(0)" ::: "memory");
    __syncthreads();
    if (threadIdx.x == 0) {
        unsigned* bar = b.bar;
        __builtin_amdgcn_s_waitcnt(0);
        unsigned nloc = b.st[0], nx = b.st[1];
        if (nloc == 0u) { xcd_barrier_complete(bar, b.x, nloc, nx); b.st[0] = nloc; b.st[1] = nx; }
        const unsigned old = xb_add(&bar[XB_XSUB(b.x)], 1u);
        const unsigned gen = old / nloc;
        if (old + 1u == (gen + 1u) * nloc) {
            __builtin_amdgcn_fence(__ATOMIC_RELEASE, "agent");
            asm volatile("s_waitcnt vmcnt(0)" ::: "memory");
            const unsigned og = xb_add(&bar[XB_TOP], 1u);
            const unsigned tg = og / nx;
            if (og + 1u == (tg + 1u) * nx) xb_add(&bar[XB_TOPGEN], 1u);
            else XB_SPIN(xb_ld(&bar[XB_TOPGEN]) == tg, bar);
            __builtin_amdgcn_fence(__ATOMIC_ACQUIRE, "agent");
            xb_add(&bar[XB_XGEN(b.x)], 1u);
            asm volatile("s_waitcnt vmcnt(0)" ::: "memory");
        } else {
            XB_SPIN(xb_ld(&bar[XB_XGEN(b.x)]) == gen, bar);
            __builtin_amdgcn_fence(__ATOMIC_ACQUIRE, "agent");
            asm volatile("s_waitcnt vmcnt(0)" ::: "memory");
        }
    }
    __syncthreads();
}

__global__ void __launch_bounds__(512, 2) fwd_kernel(Ptrs Pk) {
    extern __shared__ __attribute__((aligned(16))) unsigned char lds_raw[];
    LAS unsigned char* lds = (LAS unsigned char*)lds_raw;
    cg::grid_group grid = cg::this_grid();
    const int G = gridDim.x, bx = blockIdx.x;
    const int lo = Pk.ph_lo, hi = Pk.ph_hi;
    int ph = 0;
    if (threadIdx.x < 4) ((LAS unsigned*)(lds + 131072 + 1024))[threadIdx.x] = 0u;
    __syncthreads();
    XcdBarrier xbar = xcd_barrier_post((unsigned*)(Pk.ws + OFF_BAR), (volatile LAS unsigned*)(lds + 131072 + 1024));
#ifdef TS_A
    if (threadIdx.x == 0) { LAS unsigned long long* TS_ = (LAS unsigned long long*)(lds + 131072); for (int i = 0; i < 15; ++i) TS_[i] = 0ull; TS_[15] = __builtin_amdgcn_s_memrealtime(); }
#endif
#ifndef PH_MASK
#define PH_MASK 0xFFFFFFFFu
#endif
#define ON(id) constexpr (((PH_MASK) >> (id)) & 1u)
#if defined(__HIP_DEVICE_COMPILE__)
#define LOAD_ARGS(P) int zoff_ = 0; asm volatile("" : "+s"(zoff_)); const Ptrs P = *(const __attribute__((address_space(4))) Ptrs*)((const __attribute__((address_space(4))) char*)__builtin_amdgcn_kernarg_segment_ptr() + zoff_);
#else
#define LOAD_ARGS(P) const Ptrs P = Pk;
#endif
#define PHASE_BEGIN if (ph >= lo && ph < hi) { LOAD_ARGS(P) unsigned char* ws = P.ws; asm volatile("" : "+s"(ws)); int tid = threadIdx.x; asm volatile("" : "+v"(tid)); \
    const int lane = tid & 63, wave = __builtin_amdgcn_readfirstlane(tid >> 6), gw = bx * 8 + wave, ngw = G * 8; (void)lane; (void)gw; (void)ngw;
#define XB ((bf16_t*)(ws + OFF_XB))
#define RSA ((float*)(ws + OFF_RSA))
#define RSB ((float*)(ws + OFF_RSB))
#define CS ((const float*)(ws + OFF_CS))
#define LB ((const float*)(ws + OFF_LB))
#define LAM ((const float*)(ws + OFF_LAM))
#define Dg ((float*)(ws + OFF_DG))
#define Eg ((float*)(ws + OFF_EG))
#define GATE ((bf16_t*)(ws + OFF_GATE))
#define Qb ((bf16_t*)(ws + OFF_Q))
#define Kb ((bf16_t*)(ws + OFF_K))
#define Vb ((bf16_t*)(ws + OFF_V))
#define HQ ((bf16_t*)(ws + OFF_HQ))
#define HV ((bf16_t*)(ws + OFF_HV))
#define GF ((float*)(ws + OFF_GF))
#define GB ((float*)(ws + OFF_GB))
#define Yb ((bf16_t*)(ws + OFF_Y))
#define BG ((bf16_t*)(ws + OFF_BG))
#define AO ((bf16_t*)(ws + OFF_AO))
#define UT ((bf16_t*)(ws + OFF_UT))
#define Hb ((bf16_t*)(ws + OFF_H))
#ifdef TS_A
#define TICK(cat) do { if (bx == 0 && threadIdx.x == 0) { LAS unsigned long long* TS_ = (LAS unsigned long long*)(lds + 131072); const unsigned long long t_ = __builtin_amdgcn_s_memrealtime(); TS_[cat] += t_ - TS_[15]; TS_[15] = t_; } } while (0)
#else
#define TICK(cat) do { } while (0)
#endif
#define PHASE_END(cat)   TICK(cat); if (ph + 1 < hi) { if (ph == 0) grid.sync(); else xcd_barrier(xbar); TICK(13); } } ++ph;

    PHASE_BEGIN
        if ON(0) prologue(P, lds, gw, ngw, wave, lane);
        if ON(6) convert_layer(P, 0, ws, lds, gw, ngw, wave, lane);
    PHASE_END(0)

    for (int layer = 0; layer < DEPTH; ++layer) {
        PHASE_BEGIN
            pg8::Gemm g{XB, (const bf16_t*)(ws + (size_t)(layer & 1) * WSZ + W_IN), Dm, Dm, Dm, 1 << 30, 0, -1};
            pg8::StaticOrder S; S.init(M, 4096, G, bx);
            EpiMix E{RSB, CS, LB + (0 * 4 + layer) * 512, LB + (1 * 4 + layer) * 512, Qb, Kb, Vb, HQ, HV, BG, GF, GB};
            if ON(1) pg8::gemm_phase(lds, g, S, E);
        PHASE_END(1)
        PHASE_BEGIN
            const float lam_init = 0.8f - 0.6f * __expf(-0.3f * (float)layer);
            const float lam = LAM[layer];
            if ON(2) for (int i = 0; i * G + bx < 512; ++i) {
                const int uid = i * G + bx; const int round = uid >> 8, r = uid & 255;
                const int bhh = round * 8 + (r & 7), qb = r >> 3;
                attn_unit(bhh >> 2, bhh & 3, qb, Qb, Kb, Vb, AO, P.da_norm + layer * 512, 1.0f - lam_init, lam, lds);
            }
            TICK(2);
            if ON(3) hg1_phase(bx, G, GF, GB, HV, UT, Dg, Eg, lds);
        PHASE_END(3)
        PHASE_BEGIN
            if ON(5) hg2_scan(UT, Dg, Eg, bx * 512 + tid, G * 512);
            TICK(5);
            {
                pg8::Gemm g{XB, (const bf16_t*)(ws + (size_t)(layer & 1) * WSZ + W_IN) + (size_t)4096 * Dm, Dm, Dm, Dm, 1 << 30, 0, -1};
                pg8::StaticOrder S; S.init(M, 2048, G, bx);
                EpiGate E{RSB, GATE};
                if ON(4) pg8::gemm_phase(lds, g, S, E);
            }
            TICK(4);
        PHASE_END(4)
        PHASE_BEGIN
            if ON(7) hg3_phase(bx, G, GF, GB, HQ, HV, UT, BG, P.hg_norm + layer * 512, AO, lds);
            TICK(7);
            if ON(6) if (layer + 1 < DEPTH) convert_layer(P, layer + 1, ws + (size_t)((layer + 1) & 1) * WSZ, lds, gw, ngw, wave, lane);
        PHASE_END(6)
        PHASE_BEGIN
            pg8::Gemm g{AO, (const bf16_t*)(ws + (size_t)(layer & 1) * WSZ + W_AB), 1024, 1024, 1024, 1 << 30, 0, 8};
            pg8::StaticOrder S; S.init(M, 1024, G, bx);
            EpiY E{GATE, Yb};
            if ON(8) pg8::gemm_phase(lds, g, S, E);
        PHASE_END(8)
        PHASE_BEGIN
            pg8::Gemm g{Yb, (const bf16_t*)(ws + (size_t)(layer & 1) * WSZ + W_O2), 1024, 1024, 1024, 1 << 30, 0, -1};
            pg8::StaticOrder S; S.init(M, Dm, G, bx);
            EpiRes E{layer == 0 ? P.x : P.out, P.out, XB, RSA};
            if ON(9) pg8::gemm_phase(lds, g, S, E);
        PHASE_END(9)
        PHASE_BEGIN
            pg8::Gemm g{XB, (const bf16_t*)(ws + (size_t)(layer & 1) * WSZ + W_GU), Dm, Dm, Dm, 1 << 30, 0, -1};
            pg8::StaticOrder S; S.init(M, 2 * FF, G, bx);
            EpiGU E{RSA, Hb};
            if ON(10) pg8::gemm_phase(lds, g, S, E);
        PHASE_END(10)
        PHASE_BEGIN
            pg8::Gemm g{Hb, (const bf16_t*)(ws + (size_t)(layer & 1) * WSZ + W_D), FF, FF, FF, 1 << 30, 0, -1};
            pg8::StaticOrder S; S.init(M, Dm, G, bx);
            EpiRes E{P.out, P.out, XB, RSB};
            if ON(11) pg8::gemm_phase(lds, g, S, E);
        PHASE_END(11)
    }
    PHASE_BEGIN
        if ON(12) for (int r = gw; r < M; r += ngw) {
            f32x4* xr = (f32x4*)(P.out + (size_t)r * Dm) + lane;
            f32x4 v[4]; float ss = 0.f;
#pragma unroll
            for (int j = 0; j < 4; ++j) { v[j] = xr[64 * j]; ss += (v[j].x * v[j].x + v[j].y * v[j].y) + (v[j].z * v[j].z + v[j].w * v[j].w); }
            const float rs = rsqrtf(wave_sum(ss) * (1.0f / Dm) + EPS);
#pragma unroll
            for (int j = 0; j < 4; ++j) { const f32x4 gn = *((const f32x4*)P.final_norm + lane + 64 * j); xr[64 * j] = (f32x4){v[j].x * rs * gn.x, v[j].y * rs * gn.y, v[j].z * rs * gn.z, v[j].w * rs * gn.w}; }
        }
    PHASE_END(12)
#ifdef TS_A
    if (bx == 0 && threadIdx.x == 0) {
        LAS unsigned long long* TS_ = (LAS unsigned long long*)(lds + 131072);
        unsigned long long a = 0;
        for (int i = 0; i < 15; ++i) { if ((TS_A >> i) & 1) a += TS_[i]; }
        const unsigned long long t_end = __builtin_amdgcn_s_memrealtime() + a;
        while (__builtin_amdgcn_s_memrealtime() < t_end) __builtin_amdgcn_s_sleep(20);
    }
#endif
}
constexpr int NPHASES = 2 + 8 * DEPTH;

#ifndef MK_PER_PHASE
#define MK_PER_PHASE 0
#endif

extern "C" void kernel_launch(void* const* d_in, const int* in_sizes, int n_in, void* d_out, int out_size, void* d_ws, size_t ws_size, hipStream_t stream) {
    static int grid = 0;
    if (grid == 0) {
        if (n_in != 16 || out_size != M * Dm || ws_size < WS_END) { fprintf(stderr, "kernel_launch: unexpected sizes (n_in %d, out %d, ws %zu, need %zu)\n", n_in, out_size, ws_size, (size_t)WS_END); grid = -1; return; }
        int dev = 0, cus = 0, per_cu = 0;
        (void)hipGetDevice(&dev);
        (void)hipDeviceGetAttribute(&cus, hipDeviceAttributeMultiprocessorCount, dev);
        if (hipFuncSetAttribute((const void*)fwd_kernel, hipFuncAttributeMaxDynamicSharedMemorySize, LDS_BYTES) != hipSuccess) { fprintf(stderr, "kernel_launch: hipFuncSetAttribute failed\n"); grid = -1; return; }
        (void)hipOccupancyMaxActiveBlocksPerMultiprocessor(&per_cu, (const void*)fwd_kernel, 512, LDS_BYTES);
        (void)hipGetLastError();
        if (per_cu < 1) per_cu = 1;
        grid = cus * 1;
        fprintf(stderr, "kernel_launch: grid %d (per_cu %d), ws %zu need %zu\n", grid, per_cu, ws_size, (size_t)WS_END);
    }
    if (grid < 0) return;
    Ptrs p{};
    p.x = (const float*)d_in[0]; p.pos = (const int*)d_in[1]; p.w_in = (const float*)d_in[2]; p.da_lambda = (const float*)d_in[3]; p.da_norm = (const float*)d_in[4];
    p.hg_lb = (const float*)d_in[5]; p.hg_norm = (const float*)d_in[6]; p.w_a = (const float*)d_in[7]; p.w_b = (const float*)d_in[8]; p.w_o = (const float*)d_in[9];
    p.attn_norm = (const float*)d_in[10]; p.ffn_norm = (const float*)d_in[11]; p.w_gate = (const float*)d_in[12]; p.w_up = (const float*)d_in[13]; p.w_down = (const float*)d_in[14];
    p.final_norm = (const float*)d_in[15];
    p.out = (float*)d_out; p.ws = (unsigned char*)d_ws;
    (void)hipMemsetAsync((char*)d_ws + OFF_BAR, 0, BAR_BYTES, stream);
#if MK_PER_PHASE
    for (int ph = 0; ph < NPHASES; ++ph) {
        p.ph_lo = ph; p.ph_hi = ph + 1;
        hipLaunchKernelGGL(fwd_kernel, dim3(grid), dim3(512), LDS_BYTES, stream, p);
    }
#else
    p.ph_lo = 0; p.ph_hi = NPHASES;
    void* args[] = {&p};
    hipError_t e = hipLaunchCooperativeKernel((const void*)fwd_kernel, dim3(grid), dim3(512), args, LDS_BYTES, stream);
    if (e != hipSuccess) fprintf(stderr, "cooperative launch failed: %s (grid %d)\n", hipGetErrorString(e), grid);
#endif
}
```

```cpp
#include <hip/hip_runtime.h>
#include <hip/hip_cooperative_groups.h>
#include <cstdio>
#include <cstdint>
namespace cg = cooperative_groups;

#define LAS __attribute__((address_space(3)))
typedef unsigned short bf16_t;
typedef short bf16x8 __attribute__((ext_vector_type(8)));
typedef short s16x4 __attribute__((ext_vector_type(4)));
typedef float f32x4 __attribute__((ext_vector_type(4)));
typedef float f32x16 __attribute__((ext_vector_type(16)));
typedef unsigned u32x4 __attribute__((ext_vector_type(4)));
typedef unsigned u32x2 __attribute__((ext_vector_type(2)));

constexpr int Dm = 1024, NB = 4, SEQ = 4096, M = NB * SEQ, DEPTH = 4, FF = 2816, INW = 6144;
constexpr float EPS = 1e-6f;
constexpr float LOG2E = 1.4426950408889634f;

constexpr size_t W_IN = 0, W_AB = 12582912, W_O2 = 14680064, W_GU = 18874368, W_D = 30408704, WSZ = 36175872;
constexpr size_t MiB = 1048576;
constexpr size_t OFF_XB = 2 * WSZ;
constexpr size_t OFF_RSA = OFF_XB + 32 * MiB;
constexpr size_t OFF_RSB = OFF_RSA + MiB;
constexpr size_t OFF_CS = OFF_RSB + MiB;
constexpr size_t OFF_LB = OFF_CS + MiB;
constexpr size_t OFF_LAM = OFF_LB + 16384;
constexpr size_t OFF_DG = OFF_LAM + 256;
constexpr size_t OFF_EG = OFF_DG + MiB;
constexpr size_t OFF_B = OFF_EG + MiB;
constexpr size_t OFF_GATE = OFF_B;
constexpr size_t OFF_Q = OFF_B, OFF_K = OFF_B + 16 * MiB, OFF_V = OFF_B + 32 * MiB;
constexpr size_t OFF_HQ = OFF_B + 64 * MiB;
constexpr size_t OFF_HV = OFF_HQ + 16 * MiB;
constexpr size_t OFF_GF = OFF_HV + 16 * MiB;
constexpr size_t OFF_GB = OFF_GF + 32 * MiB;
constexpr size_t OFF_Y = OFF_GF;
constexpr size_t OFF_BG = OFF_GB + 32 * MiB;
constexpr size_t OFF_AO = OFF_BG + 16 * MiB;
constexpr size_t OFF_UT = OFF_AO + 32 * MiB;
constexpr size_t OFF_H = OFF_B;
constexpr size_t OFF_BAR = OFF_UT + 64 * MiB;
constexpr size_t BAR_BYTES = 16384;
constexpr size_t WS_END = OFF_BAR + BAR_BYTES;

constexpr int LDS_BYTES = 131072 + 2048;

__device__ __forceinline__ unsigned f2bf(float f) { unsigned u = __builtin_bit_cast(unsigned, f); return (u + 0x7fffu + ((u >> 16) & 1u)) >> 16; }
typedef float f32x2_t __attribute__((ext_vector_type(2)));
typedef __bf16 bf16x2_t __attribute__((ext_vector_type(2)));
__device__ __forceinline__ unsigned pk2(float lo, float hi) { f32x2_t v = {lo, hi}; bf16x2_t b = __builtin_convertvector(v, bf16x2_t); return __builtin_bit_cast(unsigned, b); }
__device__ __forceinline__ float bf2f(unsigned short b) { return __builtin_bit_cast(float, (unsigned)b << 16); }
__device__ __forceinline__ float bflo(unsigned u) { return __builtin_bit_cast(float, u << 16); }
__device__ __forceinline__ float bfhi(unsigned u) { return __builtin_bit_cast(float, u & 0xffff0000u); }
__device__ __forceinline__ float sigmoidf_(float x) { return __builtin_amdgcn_rcpf(1.0f + __expf(-x)); }

namespace pg8 {
constexpr int BM = 256, BK = 64, HALF = 128, HTB = HALF * BK * 2, STAGE_BYTES = 8 * HTB, NXCD = 8, WGM = 8;
__host__ __device__ __forceinline__ int lds_byte(int r, int c) { const int st = (r >> 4) * 2 + (c >> 5), rr = r & 15, cc = c & 31, ob = rr * 64 + cc * 2; return st * 1024 + (ob ^ (((ob >> 9) & 1) << 5)); }
__host__ __device__ __forceinline__ void stage_rc(int b, int& R, int& C) { const int st = b / 1024, sb = b % 1024, swz = sb ^ (((sb >> 9) & 1) << 5); R = (st >> 1) * 16 + swz / 64; C = (st & 1) * 32 + (swz % 64) / 2; }
__host__ __device__ __forceinline__ int perm32(int rho) { const int n = rho >> 4, i = rho & 15; return 8 * (i >> 2) + 4 * n + (i & 3); }

struct Unit { int pm, pn; };
struct Gemm { const bf16_t* A; const bf16_t* Bt; int lda, ldb, K; int split_pn; int split_aoff; int mid_t; };

struct StaticOrder {
    int nM, nN, nwg, G, c;
    __device__ __forceinline__ void init(int M_, int N_, int G_, int c_) { nM = M_ / BM; nN = N_ / BM; nwg = nM * nN; G = G_; c = c_; }
    __device__ bool next(int i, Unit& u) const {
        const long L = (long)i * G + c; if (L >= nwg) return false;
        int wgid = (int)L; { const int q = nwg / NXCD, r = nwg % NXCD, xcd = wgid % NXCD, off = wgid / NXCD; wgid = (xcd < r ? xcd * (q + 1) : r * (q + 1) + (xcd - r) * q) + off; }
        const int nig = WGM * nN, gid = wgid / nig, fm = gid * WGM, gsz = (nM - fm) < WGM ? (nM - fm) : WGM;
        u.pm = fm + ((wgid % nig) % gsz); u.pn = (wgid % nig) / gsz; return true;
    }
};

template <class Epi>
__device__ __forceinline__ void gemm_phase(LAS unsigned char* lds, const Gemm g, const StaticOrder& S, const Epi& E) {
    int tid_ = threadIdx.x; asm volatile("" : "+v"(tid_));
    const int tid = tid_, wid = __builtin_amdgcn_readfirstlane(tid >> 6), lane = tid & 63, wr = wid >> 2, wc = wid & 3, fr = lane & 15, fq = lane >> 4;
    const int K = g.K, nt = K / BK;
    unsigned voffA[2], voffB[2];
#pragma unroll
    for (int i = 0; i < 2; ++i) { int R, C; stage_rc(tid * 16 + i * 8192, R, C); const int Rb = (R & ~31) + perm32(R & 31);
        voffA[i] = (unsigned)(R * g.lda + C) * 2u; voffB[i] = (unsigned)(Rb * g.ldb + C) * 2u; }
    const size_t kstep = (size_t)(BK * 2);
    const size_t hstepA = (size_t)HALF * g.lda * 2, hstepB = (size_t)HALF * g.ldb * 2;
    const size_t tstepA = 2 * hstepA, tstepB = 2 * hstepB;
    const unsigned ldsw = (unsigned)wid * 1024u;
    const int aoff = lds_byte(wr * 64 + fr, fq * 8), boff = lds_byte(wc * 32 + fr, fq * 8);
#define PG8_SA(b, h) (((b) * 2 + (h)) * HTB)
#define PG8_SB(b, h) ((4 + (b) * 2 + (h)) * HTB)
#define PG8_STAGE(bufoff, gbase, voff) do { _Pragma("unroll") for (int _i = 0; _i < 2; ++_i) \
        __builtin_amdgcn_global_load_lds((const unsigned*)((const char*)(gbase) + (voff)[_i]), (LAS unsigned*)(lds + (bufoff) + ldsw + _i * 8192), 16, 0, 0); } while (0)
#define PG8_LDA(dst, b, h) do { _Pragma("unroll") for (int m = 0; m < 4; ++m) _Pragma("unroll") for (int k = 0; k < 2; ++k) dst[m][k] = *(const LAS bf16x8*)(lds + PG8_SA(b, h) + aoff + m * 2048 + k * 1024); } while (0)
#define PG8_LDB(dst, b, h) do { _Pragma("unroll") for (int n = 0; n < 2; ++n) _Pragma("unroll") for (int k = 0; k < 2; ++k) dst[n][k] = *(const LAS bf16x8*)(lds + PG8_SB(b, h) + boff + n * 2048 + k * 1024); } while (0)
#define PG8_MMA(ai, bj, At, Bt) do { __builtin_amdgcn_s_setprio(1); _Pragma("unroll") for (int m = 0; m < 4; ++m) _Pragma("unroll") for (int n = 0; n < 2; ++n) _Pragma("unroll") for (int k = 0; k < 2; ++k) \
        acc[ai][bj][m][n] = __builtin_amdgcn_mfma_f32_16x16x32_bf16(Bt[n][k], At[m][k], acc[ai][bj][m][n], 0, 0, 0); __builtin_amdgcn_s_setprio(0); } while (0)
#define PG8_WAIT_V(n) asm volatile("s_waitcnt vmcnt(" #n ")" ::: "memory")
#define PG8_WAIT_L(n) asm volatile("s_waitcnt lgkmcnt(" #n ")" ::: "memory")
#define PG8_BAR __builtin_amdgcn_s_barrier()
#define PG8_SCHED __builtin_amdgcn_sched_barrier(0)
#define PG8_UA(u) ((const char*)g.A + (size_t)(u).pm * tstepA + (((u).pn >= g.split_pn) ? (size_t)g.split_aoff * 2 : (size_t)0))
    Unit cur, nxt; int ui = 0;
    if (!S.next(0, cur)) return;
    f32x4 acc[2][2][4][2];
#pragma unroll
    for (int a = 0; a < 2; ++a)
#pragma unroll
        for (int b = 0; b < 2; ++b)
#pragma unroll
            for (int m = 0; m < 4; ++m)
#pragma unroll
                for (int n = 0; n < 2; ++n) acc[a][b][m][n] = (f32x4){0.f, 0.f, 0.f, 0.f};
    bf16x8 At[4][2], B0[2][2], B1[2][2];
    const char* cA = PG8_UA(cur); const char* cB = (const char*)g.Bt + (size_t)cur.pn * tstepB;
    PG8_STAGE(PG8_SB(0, 0), cB, voffB); PG8_STAGE(PG8_SB(0, 1), cB + hstepB, voffB); PG8_STAGE(PG8_SA(0, 0), cA, voffA); PG8_STAGE(PG8_SA(0, 1), cA + hstepA, voffA);
    if (wr == 1) PG8_BAR;
    PG8_WAIT_V(2); PG8_BAR;
    PG8_STAGE(PG8_SB(1, 0), cB + kstep, voffB); PG8_STAGE(PG8_SA(1, 0), cA + kstep, voffA); PG8_STAGE(PG8_SB(1, 1), cB + hstepB + kstep, voffB);
    PG8_WAIT_V(6); PG8_BAR;
    for (;;) {
        const bool has_next = S.next(ui + 1, nxt);
        const char* nA = has_next ? PG8_UA(nxt) : cA; const char* nB = has_next ? (const char*)g.Bt + (size_t)nxt.pn * tstepB : cB;
        for (int t = 0; t < nt; t += 2) {
            if constexpr (Epi::HAS_MID) { if (t == g.mid_t) E.mid(acc, cur, wr, wc, fr, fq); }
            const bool last = (t == nt - 2);
            const char* a1 = cA + (size_t)(t + 1) * kstep;
            const char* a2 = last ? nA : cA + (size_t)(t + 2) * kstep; const char* b2 = last ? nB : cB + (size_t)(t + 2) * kstep;
            const char* a3 = a2 + kstep; const char* b3 = b2 + kstep;
            PG8_LDB(B0, 0, 0); PG8_LDB(B1, 0, 1); PG8_SCHED; PG8_LDA(At, 0, 0); PG8_STAGE(PG8_SA(1, 1), a1 + hstepA, voffA);
            PG8_WAIT_V(8); PG8_WAIT_L(0); PG8_BAR; PG8_MMA(0, 0, At, B0); PG8_MMA(0, 1, At, B1); PG8_BAR; PG8_SCHED;
            PG8_LDA(At, 0, 1); PG8_STAGE(PG8_SB(0, 0), b2, voffB); PG8_STAGE(PG8_SB(0, 1), b2 + hstepB, voffB); PG8_STAGE(PG8_SA(0, 0), a2, voffA);
            PG8_WAIT_V(8); PG8_WAIT_L(0); PG8_BAR; PG8_MMA(1, 0, At, B0); PG8_MMA(1, 1, At, B1); PG8_BAR; PG8_SCHED;
            PG8_LDB(B0, 1, 0); PG8_LDB(B1, 1, 1); PG8_SCHED; PG8_LDA(At, 1, 0); PG8_STAGE(PG8_SA(0, 1), a2 + hstepA, voffA);
            PG8_WAIT_V(8); PG8_WAIT_L(0); PG8_BAR; PG8_MMA(0, 0, At, B0); PG8_MMA(0, 1, At, B1); PG8_BAR; PG8_SCHED;
            PG8_LDA(At, 1, 1); PG8_STAGE(PG8_SB(1, 0), b3, voffB); PG8_STAGE(PG8_SB(1, 1), b3 + hstepB, voffB); PG8_STAGE(PG8_SA(1, 0), a3, voffA);
            PG8_WAIT_V(8); PG8_WAIT_L(0); PG8_BAR; PG8_MMA(1, 0, At, B0); PG8_MMA(1, 1, At, B1); PG8_BAR; PG8_SCHED;
        }
        if (wr == 0) PG8_BAR;
        E(acc, cur, wr, wc, fr, fq);
        if (!has_next) break;
#pragma unroll
        for (int a = 0; a < 2; ++a)
#pragma unroll
            for (int b = 0; b < 2; ++b)
#pragma unroll
                for (int m = 0; m < 4; ++m)
#pragma unroll
                    for (int n = 0; n < 2; ++n) acc[a][b][m][n] = (f32x4){0.f, 0.f, 0.f, 0.f};
        cur = nxt; cA = nA; cB = nB; ++ui;
        if (wr == 1) PG8_BAR;
    }
    PG8_WAIT_V(0);
    PG8_BAR;
#undef PG8_SA
#undef PG8_SB
#undef PG8_STAGE
#undef PG8_LDA
#undef PG8_LDB
#undef PG8_MMA
#undef PG8_UA
}
}

__device__ __forceinline__ float row_rs(const float* rsp, int row) {
    const f32x4* p = (const f32x4*)(rsp + (size_t)row * 16);
    f32x4 a = p[0], b = p[1], c = p[2], d = p[3];
    float s = ((a.x + a.y) + (a.z + a.w)) + ((b.x + b.y) + (b.z + b.w)) + ((c.x + c.y) + (c.z + c.w)) + ((d.x + d.y) + (d.z + d.w));
    return __builtin_amdgcn_rsqf(s * (1.0f / Dm) + EPS);
}
__device__ __forceinline__ void rows_rs4(const float* rsp, int row0  , float (&rs)[4]) {
#pragma unroll
    for (int mp = 0; mp < 2; ++mp) {
        f32x4 p[2][4];
#pragma unroll
        for (int m = 0; m < 2; ++m) { const f32x4* q = (const f32x4*)(rsp + (size_t)(row0 + 16 * (2 * mp + m)) * 16);
#pragma unroll
            for (int i = 0; i < 4; ++i) p[m][i] = q[i]; }
#pragma unroll
        for (int m = 0; m < 2; ++m) { float t = 0.f;
#pragma unroll
            for (int i = 0; i < 4; ++i) t += (p[m][i].x + p[m][i].y) + (p[m][i].z + p[m][i].w);
            rs[2 * mp + m] = __builtin_amdgcn_rsqf(t * (1.0f / Dm) + EPS); }
        __builtin_amdgcn_sched_barrier(0);
    }
}
__device__ __forceinline__ void rows_rs2(const float* rsp, int row0, float (&rs)[2]) {
    f32x4 p[2][4];
#pragma unroll
    for (int m = 0; m < 2; ++m) { const f32x4* q = (const f32x4*)(rsp + (size_t)(row0 + 16 * m) * 16);
#pragma unroll
        for (int i = 0; i < 4; ++i) p[m][i] = q[i]; }
#pragma unroll
    for (int m = 0; m < 2; ++m) { float t = 0.f;
#pragma unroll
        for (int i = 0; i < 4; ++i) t += (p[m][i].x + p[m][i].y) + (p[m][i].z + p[m][i].w);
        rs[m] = __builtin_amdgcn_rsqf(t * (1.0f / Dm) + EPS); }
}
__device__ __forceinline__ u32x4 pack8(const float* v) { u32x4 w; w.x = pk2(v[0], v[1]); w.y = pk2(v[2], v[3]); w.z = pk2(v[4], v[5]); w.w = pk2(v[6], v[7]); return w; }

struct EpiMix {
    static constexpr bool HAS_MID = false;
    const float* rsp; const float* cs; const float* lbF; const float* lbB;
    bf16_t *Q, *Kk, *V, *HQ, *HV, *BG; float *GF, *GB;
    template <int GRP>
    __device__ __forceinline__ void run(const f32x4 (&acc)[2][2][4][2], const pg8::Unit& u, int wr, int wc, int fr, int fq) const {
#pragma unroll
        for (int ai = 0; ai < 2; ++ai)
#pragma unroll
        for (int mp = 0; mp < 2; ++mp) {
            const int row0 = u.pm * 256 + ai * 128 + wr * 64 + mp * 32 + fr;
            float rs4[2]; rows_rs2(rsp, row0, rs4);
            const int d0r = (wc * 32 + fq * 8) & 63;
            f32x4 c4r[2], s4r[2];
            if constexpr (GRP <= 1) {
                if (d0r < 16) {
#pragma unroll
                    for (int mm = 0; mm < 2; ++mm) { const float* cp = cs + (size_t)(row0 + 16 * mm) * 16 + (d0r >> 3) * 4; c4r[mm] = *(const f32x4*)cp; s4r[mm] = *(const f32x4*)(cp + 8); }
                }
            }
            __builtin_amdgcn_sched_barrier(0);
#pragma unroll
            for (int mm = 0; mm < 2; ++mm) {
                const int m = 2 * mp + mm;
                const int row = row0 + mm * 16;
                const float rs = rs4[mm];
                const int b = row >> 12, s = row & 4095;
#pragma unroll
                for (int bj = 0; bj < 2; ++bj) {
                    const int col = u.pn * 256 + bj * 128 + wc * 32 + fq * 8;
                    const int jj = col & 511;
                    float v[8];
#pragma unroll
                    for (int e = 0; e < 4; ++e) { v[e] = acc[ai][bj][m][0][e] * rs; v[4 + e] = acc[ai][bj][m][1][e] * rs; }
                    if constexpr (GRP <= 1) {
                        const int d0 = jj & 63;
                        if (d0 < 16) {
                            const f32x4 c4 = c4r[mm], s4 = s4r[mm];
#pragma unroll
                            for (int e = 0; e < 4; ++e) { const float t1 = v[e], t2 = v[4 + e]; v[e] = t1 * c4[e] - t2 * s4[e]; v[4 + e] = t2 * c4[e] + t1 * s4[e]; }
                        }
                        if constexpr (GRP == 0) {
#pragma unroll
                            for (int e = 0; e < 8; ++e) v[e] *= 0.125f * LOG2E;
                        }
                        const int h = jj >> 7, c = (jj >> 6) & 1;
                        bf16_t* dst = (GRP == 0 ? Q : Kk) + ((size_t)(((b * 4 + h) * 2 + c) * SEQ + s)) * 64 + d0;
                        *(u32x4*)dst = pack8(v);
                    } else if constexpr (GRP == 2) {
                        const int h = jj >> 7, d0 = jj & 127;
                        *(u32x4*)(V + ((size_t)((b * 4 + h) * SEQ + s)) * 128 + d0) = pack8(v);
                    } else if constexpr (GRP == 3) {
                        *(u32x4*)(HQ + (size_t)row * 512 + jj) = pack8(v);
                    } else if constexpr (GRP == 4 || GRP == 5) {
                        const float* lbp = (GRP == 4 ? lbF : lbB) + jj;
                        const f32x4 l0 = *(const f32x4*)lbp, l1 = *(const f32x4*)(lbp + 4);
                        float gl[8];
#pragma unroll
                        for (int e = 0; e < 8; ++e) { const float lb = e < 4 ? l0[e] : l1[e - 4]; const float f = lb + (1.0f - lb) * sigmoidf_(v[e]); gl[e] = __builtin_amdgcn_logf(fmaxf(f, 1e-37f)) * 0.6931471805599453f; }
                        float* dst = (GRP == 4 ? GF : GB) + (size_t)row * 512 + jj;
                        *(f32x4*)dst = (f32x4){gl[0], gl[1], gl[2], gl[3]}; *(f32x4*)(dst + 4) = (f32x4){gl[4], gl[5], gl[6], gl[7]};
                    } else if constexpr (GRP == 6) {
                        *(u32x4*)(HV + (size_t)row * 512 + jj) = pack8(v);
                    } else {
#pragma unroll
                        for (int e = 0; e < 8; ++e) v[e] = sigmoidf_(v[e]);
                        *(u32x4*)(BG + (size_t)row * 512 + jj) = pack8(v);
                    }
                }
            }
            __builtin_amdgcn_sched_barrier(0);
        }
    }
    __device__ __forceinline__ void operator()(const f32x4 (&acc)[2][2][4][2], const pg8::Unit& u, int wr, int wc, int fr, int fq) const {
        switch (u.pn >> 1) {
            case 0: run<0>(acc, u, wr, wc, fr, fq); break;
            case 1: run<1>(acc, u, wr, wc, fr, fq); break;
            case 2: run<2>(acc, u, wr, wc, fr, fq); break;
            case 3: run<3>(acc, u, wr, wc, fr, fq); break;
            case 4: run<4>(acc, u, wr, wc, fr, fq); break;
            case 5: run<5>(acc, u, wr, wc, fr, fq); break;
            case 6: run<6>(acc, u, wr, wc, fr, fq); break;
            default: run<7>(acc, u, wr, wc, fr, fq); break;
        }
    }
};

struct EpiGate {
    static constexpr bool HAS_MID = false;
    const float* rsp; bf16_t* G;
    __device__ __forceinline__ void operator()(const f32x4 (&acc)[2][2][4][2], const pg8::Unit& u, int wr, int wc, int fr, int fq) const {
#pragma unroll
        for (int ai = 0; ai < 2; ++ai) {
            const int row0 = u.pm * 256 + ai * 128 + wr * 64 + fr;
            float rs4[4]; rows_rs4(rsp, row0, rs4);
            __builtin_amdgcn_sched_barrier(0);
#pragma unroll
            for (int m = 0; m < 4; ++m) {
                const int row = row0 + m * 16;
                const float rs = rs4[m];
                const int col = u.pn * 128 + wc * 32 + fq * 8;
                float r[8], sb[8];
                const float nrl = -rs * LOG2E;
#pragma unroll
                for (int n = 0; n < 2; ++n) {
                    f32x4 ta = acc[ai][0][m][n] * nrl, tb = acc[ai][1][m][n] * nrl;
                    ta = __builtin_elementwise_min(ta, (f32x4){86.f, 86.f, 86.f, 86.f}); tb = __builtin_elementwise_min(tb, (f32x4){86.f, 86.f, 86.f, 86.f});
                    ta.x = __builtin_amdgcn_exp2f(ta.x); ta.y = __builtin_amdgcn_exp2f(ta.y); ta.z = __builtin_amdgcn_exp2f(ta.z); ta.w = __builtin_amdgcn_exp2f(ta.w);
                    tb.x = __builtin_amdgcn_exp2f(tb.x); tb.y = __builtin_amdgcn_exp2f(tb.y); tb.z = __builtin_amdgcn_exp2f(tb.z); tb.w = __builtin_amdgcn_exp2f(tb.w);
                    ta = ta + 1.0f; tb = tb + 1.0f;
                    f32x4 ia, ib;
                    ia.x = __builtin_amdgcn_rcpf(ta.x); ia.y = __builtin_amdgcn_rcpf(ta.y); ia.z = __builtin_amdgcn_rcpf(ta.z); ia.w = __builtin_amdgcn_rcpf(ta.w);
                    ib.x = __builtin_amdgcn_rcpf(tb.x); ib.y = __builtin_amdgcn_rcpf(tb.y); ib.z = __builtin_amdgcn_rcpf(tb.z); ib.w = __builtin_amdgcn_rcpf(tb.w);
                    const f32x4 rr = tb * ia;
                    r[n * 4] = rr.x; r[n * 4 + 1] = rr.y; r[n * 4 + 2] = rr.z; r[n * 4 + 3] = rr.w;
                    sb[n * 4] = ib.x; sb[n * 4 + 1] = ib.y; sb[n * 4 + 2] = ib.z; sb[n * 4 + 3] = ib.w;
                }
                *(u32x4*)(G + (size_t)row * 2048 + col) = pack8(r);
                *(u32x4*)(G + (size_t)row * 2048 + 1024 + col) = pack8(sb);
            }
            __builtin_amdgcn_sched_barrier(0);
        }
    }
};

struct EpiY {
    static constexpr bool HAS_MID = true;
    const bf16_t* G; bf16_t* Y;
    __device__ __forceinline__ void mid(f32x4 (&acc)[2][2][4][2], const pg8::Unit& u, int wr, int wc, int fr, int fq) const {
        int fr_ = fr; asm volatile("" : "+v"(fr_));
#pragma unroll
        for (int ai = 0; ai < 2; ++ai) {
            __builtin_amdgcn_sched_barrier(0);
#pragma unroll
            for (int m = 0; m < 4; ++m) {
                const int row = u.pm * 256 + ai * 128 + wr * 64 + m * 16 + fr_;
#pragma unroll
                for (int bj = 0; bj < 2; ++bj) {
                    const int col = u.pn * 256 + bj * 128 + wc * 32 + fq * 8;
                    const u32x4 gq = *(const u32x4*)(G + (size_t)row * 2048 + col);
                    acc[ai][bj][m][0][0] *= bflo(gq.x); acc[ai][bj][m][0][1] *= bfhi(gq.x); acc[ai][bj][m][0][2] *= bflo(gq.y); acc[ai][bj][m][0][3] *= bfhi(gq.y);
                    acc[ai][bj][m][1][0] *= bflo(gq.z); acc[ai][bj][m][1][1] *= bfhi(gq.z); acc[ai][bj][m][1][2] *= bflo(gq.w); acc[ai][bj][m][1][3] *= bfhi(gq.w);
                }
            }
        }
        __builtin_amdgcn_sched_barrier(0);
    }
    __device__ __forceinline__ void operator()(const f32x4 (&acc)[2][2][4][2], const pg8::Unit& u, int wr, int wc, int fr, int fq) const {
#pragma unroll
        for (int ai = 0; ai < 2; ++ai) {
            u32x4 gqr[4][2];
#pragma unroll
            for (int m = 0; m < 4; ++m)
#pragma unroll
                for (int bj = 0; bj < 2; ++bj) gqr[m][bj] = *(const u32x4*)(G + (size_t)(u.pm * 256 + ai * 128 + wr * 64 + m * 16 + fr) * 2048 + 1024 + u.pn * 256 + bj * 128 + wc * 32 + fq * 8);
            __builtin_amdgcn_sched_barrier(0);
#pragma unroll
            for (int m = 0; m < 4; ++m) {
                const int row = u.pm * 256 + ai * 128 + wr * 64 + m * 16 + fr;
#pragma unroll
                for (int bj = 0; bj < 2; ++bj) {
                    const int col = u.pn * 256 + bj * 128 + wc * 32 + fq * 8;
                    const u32x4 gq = gqr[m][bj];
                    float v[8];
                    v[0] = acc[ai][bj][m][0][0] * bflo(gq.x); v[1] = acc[ai][bj][m][0][1] * bfhi(gq.x);
                    v[2] = acc[ai][bj][m][0][2] * bflo(gq.y); v[3] = acc[ai][bj][m][0][3] * bfhi(gq.y);
                    v[4] = acc[ai][bj][m][1][0] * bflo(gq.z); v[5] = acc[ai][bj][m][1][1] * bfhi(gq.z);
                    v[6] = acc[ai][bj][m][1][2] * bflo(gq.w); v[7] = acc[ai][bj][m][1][3] * bfhi(gq.w);
                    *(u32x4*)(Y + (size_t)row * 1024 + col) = pack8(v);
                }
            }
            __builtin_amdgcn_sched_barrier(0);
        }
    }
};

struct EpiRes {
    static constexpr bool HAS_MID = false;
    const float* xres; float* xout; bf16_t* XB; float* rsp;
    __device__ __forceinline__ void operator()(const f32x4 (&acc)[2][2][4][2], const pg8::Unit& u, int wr, int wc, int fr, int fq) const {
#pragma unroll
        for (int ai = 0; ai < 2; ++ai)
#pragma unroll
        for (int mp = 0; mp < 2; ++mp) {
            f32x4 xr0[2][2], xr1[2][2];
#pragma unroll
            for (int mm = 0; mm < 2; ++mm)
#pragma unroll
                for (int bj = 0; bj < 2; ++bj) { const float* xr = xres + (size_t)(u.pm * 256 + ai * 128 + wr * 64 + (2 * mp + mm) * 16 + fr) * Dm + u.pn * 256 + bj * 128 + wc * 32 + fq * 8;
                    xr0[mm][bj] = *(const f32x4*)xr; xr1[mm][bj] = *(const f32x4*)(xr + 4); }
            __builtin_amdgcn_sched_barrier(0);
#pragma unroll
            for (int mm = 0; mm < 2; ++mm) {
                const int m = 2 * mp + mm;
                const int row = u.pm * 256 + ai * 128 + wr * 64 + m * 16 + fr;
                float ss = 0.f;
#pragma unroll
                for (int bj = 0; bj < 2; ++bj) {
                    const int col = u.pn * 256 + bj * 128 + wc * 32 + fq * 8;
                    const f32x4 x0 = xr0[mm][bj], x1 = xr1[mm][bj];
                    float v[8];
#pragma unroll
                    for (int e = 0; e < 4; ++e) { v[e] = x0[e] + acc[ai][bj][m][0][e]; v[4 + e] = x1[e] + acc[ai][bj][m][1][e]; }
#pragma unroll
                    for (int e = 0; e < 8; ++e) ss += v[e] * v[e];
                    float* xo = xout + (size_t)row * Dm + col;
                    *(f32x4*)xo = (f32x4){v[0], v[1], v[2], v[3]}; *(f32x4*)(xo + 4) = (f32x4){v[4], v[5], v[6], v[7]};
                    *(u32x4*)(XB + (size_t)row * Dm + col) = pack8(v);
                }
                ss += __shfl_xor(ss, 16); ss += __shfl_xor(ss, 32);
                if (fq == 0) rsp[(size_t)row * 16 + u.pn * 4 + wc] = ss;
            }
            __builtin_amdgcn_sched_barrier(0);
        }
    }
};

struct EpiGU {
    static constexpr bool HAS_MID = false;
    const float* rsp; bf16_t* H;
    __device__ __forceinline__ void operator()(const f32x4 (&acc)[2][2][4][2], const pg8::Unit& u, int wr, int wc, int fr, int fq) const {
#pragma unroll
        for (int ai = 0; ai < 2; ++ai) {
            const int row0 = u.pm * 256 + ai * 128 + wr * 64 + fr;
            float rs4[4]; rows_rs4(rsp, row0, rs4);
            __builtin_amdgcn_sched_barrier(0);
#pragma unroll
            for (int m = 0; m < 4; ++m) {
                const int row = row0 + m * 16;
                const float rs = rs4[m];
                const int col = u.pn * 128 + wc * 32 + fq * 8;
                float v[8];
                const float nrl = -rs * LOG2E, rs2 = rs * rs;
#pragma unroll
                for (int n = 0; n < 2; ++n) {
                    const f32x4 a = acc[ai][0][m][n], b = acc[ai][1][m][n];
                    f32x4 t = a * nrl;
                    t.x = __builtin_amdgcn_exp2f(t.x); t.y = __builtin_amdgcn_exp2f(t.y); t.z = __builtin_amdgcn_exp2f(t.z); t.w = __builtin_amdgcn_exp2f(t.w);
                    t = t + 1.0f;
                    t.x = __builtin_amdgcn_rcpf(t.x); t.y = __builtin_amdgcn_rcpf(t.y); t.z = __builtin_amdgcn_rcpf(t.z); t.w = __builtin_amdgcn_rcpf(t.w);
                    const f32x4 o = ((a * b) * rs2) * t;
                    v[n * 4] = o.x; v[n * 4 + 1] = o.y; v[n * 4 + 2] = o.z; v[n * 4 + 3] = o.w;
                }
                *(u32x4*)(H + (size_t)row * FF + col) = pack8(v);
            }
            __builtin_amdgcn_sched_barrier(0);
        }
    }
};

__device__ __forceinline__ int rope_perm(int n) {
    const int d = n & 63; if (d >= 16) return n;
    const int g = d >> 3, e = d & 7; return (n & ~63) + ((e < 4) ? 4 * g + e : 8 + 4 * g + (e - 4));
}
__device__ __forceinline__ void conv_item(const float* src, int ld_src, int ks0, int c0  , int mode  ,
                                          const float* gain, bf16_t* dst, int ld_dst, int n0, int kd0, LAS float* scr, int lane) {
    const int n4 = lane & 7, kr = lane >> 3;
    int sc = c0 + 4 * n4;
    if (mode) { const int q = (sc & 63) >> 2; if (q == 1) sc += 4; else if (q == 2) sc -= 4; }
#pragma unroll
    for (int i = 0; i < 8; ++i) { const int kk = kr + 8 * i; f32x4 w = *(const f32x4*)(src + (size_t)(ks0 + kk) * ld_src + sc);
        if (gain) { const float gg = gain[ks0 + kk]; w.x *= gg; w.y *= gg; w.z *= gg; w.w *= gg; }
        LAS float* d = scr + kk * 33 + 4 * n4; d[0] = w.x; d[1] = w.y; d[2] = w.z; d[3] = w.w; }
    asm volatile("s_waitcnt lgkmcnt(0)" ::: "memory");
    const int c = lane & 7;
#pragma unroll
    for (int j = 0; j < 4; ++j) { const int n = (lane >> 3) + 8 * j; const LAS float* s = scr + (8 * c) * 33 + n;
        u32x4 o; o.x = pk2(s[0 * 33], s[1 * 33]); o.y = pk2(s[2 * 33], s[3 * 33]); o.z = pk2(s[4 * 33], s[5 * 33]); o.w = pk2(s[6 * 33], s[7 * 33]);
        *(u32x4*)(dst + (size_t)(n0 + n) * ld_dst + kd0 + 8 * c) = o; }
    asm volatile("s_waitcnt lgkmcnt(0)" ::: "memory");
}

struct Ptrs {
    const float *x; const int* pos; const float *w_in, *da_lambda, *da_norm, *hg_lb, *hg_norm, *w_a, *w_b, *w_o, *attn_norm, *ffn_norm, *w_gate, *w_up, *w_down, *final_norm;
    float* out; unsigned char* ws; int ph_lo, ph_hi;
};

__device__ __forceinline__ void convert_layer(const Ptrs& P, int layer, unsigned char* wbuf, LAS unsigned char* lds, int gw, int ngw, int wave, int lane) {
    LAS float* scr = (LAS float*)(lds + wave * 8704);
    constexpr int I_IN = 16 * 192, I_A = 8 * 32, I_B = 8 * 32, I_O = 16 * 32, I_GU = 16 * 176, I_D = 44 * 32;
    constexpr int NIT = I_IN + I_A + I_B + I_O + I_GU + I_D;
    for (int it = gw; it < NIT; it += ngw) {
        int r = it;
        if (r < I_IN) { const int kb = r / 192, nb = r % 192, n0 = nb * 32;
            int c0 = n0; if (n0 >= 4096) { const int q = n0 - 4096, tile = q >> 8, rr = q & 255; c0 = (rr < 128 ? 4096 : 5120) + tile * 128 + (rr & 127); }
            conv_item(P.w_in + (size_t)layer * Dm * INW, INW, kb * 64, c0, n0 < 1024 ? 1 : 0, P.attn_norm + layer * Dm, (bf16_t*)(wbuf + W_IN), Dm, n0, kb * 64, scr, lane); continue; }
        r -= I_IN;
        if (r < I_A) { const int kb = r / 32, nb = r % 32;
            conv_item(P.w_a + (size_t)layer * 512 * Dm, Dm, kb * 64, nb * 32, 0, nullptr, (bf16_t*)(wbuf + W_AB), 1024, nb * 32, kb * 64, scr, lane); continue; }
        r -= I_A;
        if (r < I_B) { const int kb = r / 32, nb = r % 32;
            conv_item(P.w_b + (size_t)layer * 512 * Dm, Dm, kb * 64, nb * 32, 0, nullptr, (bf16_t*)(wbuf + W_AB), 1024, nb * 32, 512 + kb * 64, scr, lane); continue; }
        r -= I_B;
        if (r < I_O) { const int kb = r / 32, nb = r % 32;
            conv_item(P.w_o + (size_t)layer * Dm * Dm, Dm, kb * 64, nb * 32, 0, nullptr, (bf16_t*)(wbuf + W_O2), Dm, nb * 32, kb * 64, scr, lane); continue; }
        r -= I_O;
        if (r < I_GU) { const int kb = r / 176, nb = r % 176, n0 = nb * 32, tile = n0 >> 8, rr = n0 & 255;
            const float* srcm = (rr < 128 ? P.w_gate : P.w_up) + (size_t)layer * Dm * FF;
            conv_item(srcm, FF, kb * 64, tile * 128 + (rr & 127), 0, P.ffn_norm + layer * Dm, (bf16_t*)(wbuf + W_GU), Dm, n0, kb * 64, scr, lane); continue; }
        r -= I_GU;
        { const int kb = r / 32, nb = r % 32;
            conv_item(P.w_down + (size_t)layer * FF * Dm, Dm, kb * 64, nb * 32, 0, nullptr, (bf16_t*)(wbuf + W_D), FF, nb * 32, kb * 64, scr, lane); }
    }
}

__device__ __forceinline__ float wave_sum(float v) {
#pragma unroll
    for (int o = 1; o < 64; o <<= 1) v += __shfl_xor(v, o);
    return v;
}
__device__ __forceinline__ void prologue(const Ptrs& P, LAS unsigned char* lds, int gw, int ngw, int wave, int lane) {
    unsigned char* ws = P.ws;
    bf16_t* XB = (bf16_t*)(ws + OFF_XB); float* rsb = (float*)(ws + OFF_RSB);
    for (int r = gw; r < M; r += ngw) {
        const f32x4* xr = (const f32x4*)(P.x + (size_t)r * Dm) + lane;
        float ss = 0.f;
#pragma unroll
        for (int j = 0; j < 4; ++j) { const f32x4 v = xr[64 * j]; ss += (v.x * v.x + v.y * v.y) + (v.z * v.z + v.w * v.w);
            u32x2 o; o.x = pk2(v.x, v.y); o.y = pk2(v.z, v.w); *((u32x2*)(XB + (size_t)r * Dm) + lane + 64 * j) = o; }
        ss = wave_sum(ss);
        if (lane < 16) rsb[(size_t)r * 16 + lane] = (lane == 0) ? ss : 0.f;
    }
    const int gt = gw * 64 + lane, ngt = ngw * 64;
    float* cs = (float*)(ws + OFF_CS);
    for (int i = gt; i < M * 8; i += ngt) {
        const int tok = i >> 3, f = i & 7;
        const double invf[8] = {1.0, 0.19392274474868576, 0.03760603093086393, 0.007292664737217109, 0.001414213562373095, 0.0002742481756762073, 5.318295896944988e-05, 1.031338537721246e-05};
        double fr;
        switch (f) { case 0: fr = invf[0]; break; case 1: fr = invf[1]; break; case 2: fr = invf[2]; break; case 3: fr = invf[3]; break; case 4: fr = invf[4]; break; case 5: fr = invf[5]; break; case 6: fr = invf[6]; break; default: fr = invf[7]; }
        const float ang32 = (float)P.pos[tok] * (float)fr;
        const double ang = (double)ang32;
        const double rev = ang * 0.15915494309189535;
        const double fracrev = rev - __builtin_floor(rev + 0.5);
        const float a = (float)(fracrev * 6.283185307179586);
        cs[(size_t)tok * 16 + f] = __cosf(a); cs[(size_t)tok * 16 + 8 + f] = __sinf(a);
    }
    float* LB = (float*)(ws + OFF_LB);
    for (int i = gt; i < 2 * 512; i += ngt) {
        const int d = i >> 9, k = i & 511;
        float l[4], mx = -1e30f;
#pragma unroll
        for (int j = 0; j < 4; ++j) { l[j] = P.hg_lb[(size_t)(d * 4 + j) * 512 + k]; mx = fmaxf(mx, l[j]); }
        float e[4], sum = 0.f;
#pragma unroll
        for (int j = 0; j < 4; ++j) { e[j] = __expf(l[j] - mx); sum += e[j]; }
        float cum = 0.f;
#pragma unroll
        for (int j = 0; j < 4; ++j) { if (j > 0) cum += e[j] / sum; LB[(size_t)(d * 4 + j) * 512 + k] = cum; }
    }
    if (gw == 0) {
        float* LAM = (float*)(ws + OFF_LAM);
        for (int l = 0; l < 4; ++l) {
            const float* p = P.da_lambda + l * 256;
            float a = wave_sum(p[lane] * p[64 + lane]), b = wave_sum(p[128 + lane] * p[192 + lane]);
            const float lam_init = 0.8f - 0.6f * __expf(-0.3f * (float)l);
            if (lane == 0) LAM[l] = __expf(a) - __expf(b) + lam_init;
        }
    }
}

constexpr int AT_KROW = 144, AT_VROW = 320, AT_K1 = 64 * AT_KROW, AT_V = 2 * AT_K1, AT_STG = AT_V + 64 * AT_VROW;
constexpr int AT_IMG_ROW = 132;
__device__ __forceinline__ s16x4 tr_read(const LAS unsigned char* p) { return __builtin_bit_cast(s16x4, __builtin_amdgcn_ds_read_tr16_b64_v4i16((LAS s16x4*)p)); }

__device__ __forceinline__ void attn_unit(int b, int h, int qb, const bf16_t* Q, const bf16_t* Kk, const bf16_t* V, bf16_t* AO, const float* gainA  , float one_minus_lam_init, float lam, LAS unsigned char* lds) {
    int tid_ = threadIdx.x; asm volatile("" : "+v"(tid_));
    const int tid = tid_, wave = __builtin_amdgcn_readfirstlane(tid >> 6), lane = tid & 63, c = wave >> 2, wq = wave & 3, r32 = lane & 31, hh = lane >> 5;
    const int q0 = qb * 128 + wq * 32;
    bf16x8 qf[4];
    { const bf16_t* Qp = Q + ((size_t)(((b * 4 + h) * 2 + c) * SEQ + q0 + r32)) * 64 + 8 * hh;
#pragma unroll
      for (int s = 0; s < 4; ++s) qf[s] = *(const bf16x8*)(Qp + 16 * s); }
    f32x16 o[4];
#pragma unroll
    for (int i = 0; i < 4; ++i)
#pragma unroll
        for (int e = 0; e < 16; ++e) o[i][e] = 0.f;
    float mrow = -1e30f, lrow = 0.f;
    const unsigned char* Kg0 = (const unsigned char*)(Kk + ((size_t)((b * 4 + h) * 2 + 0) * SEQ) * 64);
    const unsigned char* Kg1 = (const unsigned char*)(Kk + ((size_t)((b * 4 + h) * 2 + 1) * SEQ) * 64);
    const unsigned char* Vg = (const unsigned char*)(V + ((size_t)(b * 4 + h) * SEQ) * 128);
    const int lk = (tid >> 3) * AT_KROW + (tid & 7) * 16;
    const int lv0 = AT_V + (tid >> 4) * AT_VROW + (tid & 15) * 16, lv1 = lv0 + 32 * AT_VROW;
    u32x4 r0, r1, r2, r3;
    r0 = *(const u32x4*)(Kg0 + tid * 16); r1 = *(const u32x4*)(Kg1 + tid * 16); r2 = *(const u32x4*)(Vg + tid * 16); r3 = *(const u32x4*)(Vg + 8192 + tid * 16);
    *(LAS u32x4*)(lds + lk) = r0; *(LAS u32x4*)(lds + AT_K1 + lk) = r1; *(LAS u32x4*)(lds + lv0) = r2; *(LAS u32x4*)(lds + lv1) = r3;
    r0 = *(const u32x4*)(Kg0 + 8192 + tid * 16); r1 = *(const u32x4*)(Kg1 + 8192 + tid * 16);
    *(LAS u32x4*)(lds + AT_STG + lk) = r0; *(LAS u32x4*)(lds + AT_STG + AT_K1 + lk) = r1;
    __syncthreads();
    const int ka = c * AT_K1 + r32 * AT_KROW + hh * 16;
    const int va = AT_V + (4 * hh + ((lane & 15) >> 2)) * AT_VROW + ((lane >> 4) & 1) * 32 + (lane & 3) * 8;

#define AT_QK(sv, st) do { f32x16 t0_, t1_; _Pragma("unroll") for (int e = 0; e < 16; ++e) { t0_[e] = 0.f; t1_[e] = 0.f; } \
        _Pragma("unroll") for (int ks = 0; ks < 4; ++ks) { \
            const bf16x8 a0 = *(const LAS bf16x8*)(lds + (st) + ka + ks * 32), a1 = *(const LAS bf16x8*)(lds + (st) + ka + 32 * AT_KROW + ks * 32); \
            t0_ = __builtin_amdgcn_mfma_f32_32x32x16_bf16(a0, qf[ks], t0_, 0, 0, 0); t1_ = __builtin_amdgcn_mfma_f32_32x32x16_bf16(a1, qf[ks], t1_, 0, 0, 0); } \
        sv##0 = t0_; sv##1 = t1_; } while (0)
    f32x16 sA0, sA1, sB0, sB1;
    AT_QK(sA, 0);
#define AT_VFRAG(dst, STC, g) do { const LAS unsigned char* vb_ = lds + (STC) + va + (16 * (g)) * AT_VROW; \
        _Pragma("unroll") for (int vt = 0; vt < 4; ++vt) { const s16x4 t0 = tr_read(vb_ + vt * 64), t1 = tr_read(vb_ + vt * 64 + 8 * AT_VROW); \
            dst[vt] = (bf16x8){t0[0], t0[1], t0[2], t0[3], t1[0], t1[1], t1[2], t1[3]}; } } while (0)
#define AT_PV(vf, p) do { __builtin_amdgcn_s_setprio(1); _Pragma("unroll") for (int vt = 0; vt < 4; ++vt) o[vt] = __builtin_amdgcn_mfma_f32_32x32x16_bf16(vf[vt], p, o[vt], 0, 0, 0); __builtin_amdgcn_s_setprio(0); } while (0)
#define AT_SB __builtin_amdgcn_sched_barrier(0)
#define AT_TILE(j, s0, s1, sn, STC  , STN  ) do { \
        if ((j) + 2 < 64) { const size_t go = (size_t)((j) + 2) * 8192; r0 = *(const u32x4*)(Kg0 + go + tid * 16); r1 = *(const u32x4*)(Kg1 + go + tid * 16); } \
        if ((j) + 1 < 64) { const size_t go = (size_t)((j) + 1) * 16384; r2 = *(const u32x4*)(Vg + go + tid * 16); r3 = *(const u32x4*)(Vg + go + 8192 + tid * 16); } \
        bf16x8 kf[4], kg[4], vA[4]; \
        if ((j) + 1 < 64) { _Pragma("unroll") for (int ks = 0; ks < 2; ++ks) { kf[2 * ks] = *(const LAS bf16x8*)(lds + (STN) + ka + ks * 32); kf[2 * ks + 1] = *(const LAS bf16x8*)(lds + (STN) + ka + 32 * AT_KROW + ks * 32); } } \
        AT_SB; \
        float mx = fmaxf(s0[0], s1[0]); \
        _Pragma("unroll") for (int e = 1; e < 16; ++e) mx = fmaxf(mx, fmaxf(s0[e], s1[e])); \
        mx = fmaxf(mx, __shfl_xor(mx, 32)); \
        if (__builtin_amdgcn_ballot_w64(mx > mrow + 8.0f) != 0ull) { \
            const float mnew = fmaxf(mrow, mx), alpha = __builtin_amdgcn_exp2f(mrow - mnew); mrow = mnew; lrow *= alpha; \
            _Pragma("unroll") for (int i = 0; i < 4; ++i) _Pragma("unroll") for (int e = 0; e < 16; ++e) o[i][e] *= alpha; } \
        AT_SB; \
        if ((j) + 1 < 64) { f32x16 t0_, t1_; _Pragma("unroll") for (int e = 0; e < 16; ++e) { t0_[e] = 0.f; t1_[e] = 0.f; } \
            __builtin_amdgcn_s_setprio(1); \
            _Pragma("unroll") for (int ks = 0; ks < 2; ++ks) { t0_ = __builtin_amdgcn_mfma_f32_32x32x16_bf16(kf[2 * ks], qf[ks], t0_, 0, 0, 0); t1_ = __builtin_amdgcn_mfma_f32_32x32x16_bf16(kf[2 * ks + 1], qf[ks], t1_, 0, 0, 0); } \
            AT_SB; \
            _Pragma("unroll") for (int ks = 0; ks < 2; ++ks) { kg[2 * ks] = *(const LAS bf16x8*)(lds + (STN) + ka + (ks + 2) * 32); kg[2 * ks + 1] = *(const LAS bf16x8*)(lds + (STN) + ka + 32 * AT_KROW + (ks + 2) * 32); } \
            AT_SB; \
            _Pragma("unroll") for (int ks = 0; ks < 2; ++ks) { t0_ = __builtin_amdgcn_mfma_f32_32x32x16_bf16(kg[2 * ks], qf[ks + 2], t0_, 0, 0, 0); t1_ = __builtin_amdgcn_mfma_f32_32x32x16_bf16(kg[2 * ks + 1], qf[ks + 2], t1_, 0, 0, 0); } \
            __builtin_amdgcn_s_setprio(0); sn##0 = t0_; sn##1 = t1_; } \
        AT_VFRAG(vA, STC, 0); \
        AT_SB; \
        float ls = 0.f; \
        _Pragma("unroll") for (int e = 0; e < 16; ++e) { s0[e] = __builtin_amdgcn_exp2f(s0[e] - mrow); s1[e] = __builtin_amdgcn_exp2f(s1[e] - mrow); ls += s0[e] + s1[e]; } \
        lrow += ls; \
        bf16x8 pf[2][2]; \
        _Pragma("unroll") for (int s = 0; s < 2; ++s) { u32x4 w0, w1; \
            w0.x = pk2(s0[8 * s + 0], s0[8 * s + 1]); w0.y = pk2(s0[8 * s + 2], s0[8 * s + 3]); w0.z = pk2(s0[8 * s + 4], s0[8 * s + 5]); w0.w = pk2(s0[8 * s + 6], s0[8 * s + 7]); \
            w1.x = pk2(s1[8 * s + 0], s1[8 * s + 1]); w1.y = pk2(s1[8 * s + 2], s1[8 * s + 3]); w1.z = pk2(s1[8 * s + 4], s1[8 * s + 5]); w1.w = pk2(s1[8 * s + 6], s1[8 * s + 7]); \
            pf[0][s] = __builtin_bit_cast(bf16x8, w0); pf[1][s] = __builtin_bit_cast(bf16x8, w1); } \
        AT_SB; \
        AT_PV(vA, pf[0][0]); \
        AT_SB; \
        AT_VFRAG(vA, STC, 1); \
        AT_SB; \
        AT_PV(vA, pf[0][1]); \
        AT_SB; \
          \
        if ((j) + 2 < 64) { *(LAS u32x4*)(lds + (STC) + lk) = r0; *(LAS u32x4*)(lds + (STC) + AT_K1 + lk) = r1; } \
        if ((j) + 1 < 64) { *(LAS u32x4*)(lds + (STN) + lv0) = r2; *(LAS u32x4*)(lds + (STN) + lv1) = r3; } \
        AT_SB; \
        AT_VFRAG(vA, STC, 2); \
        AT_SB; \
        AT_PV(vA, pf[1][0]); \
        AT_SB; \
        AT_VFRAG(vA, STC, 3); \
        AT_SB; \
        AT_PV(vA, pf[1][1]); \
        __syncthreads(); } while (0)
    for (int j = 0; j < 64; j += 2) {
        AT_TILE(j, sA0, sA1, sB, 0, AT_STG);
        AT_TILE(j + 1, sB0, sB1, sA, AT_STG, 0);
    }
#undef AT_TILE
#undef AT_QK
#undef AT_VFRAG
#undef AT_PV
#undef AT_SB
    const float inv = __builtin_amdgcn_rcpf(lrow + __shfl_xor(lrow, 32));
    LAS float* img = (LAS float*)lds;
    const int qrow = wq * 32 + r32;
    if (c == 1) {
        const float sc = -lam * inv;
#pragma unroll
        for (int vt = 0; vt < 4; ++vt)
#pragma unroll
            for (int g = 0; g < 4; ++g)
                *(LAS f32x4*)(img + qrow * AT_IMG_ROW + 32 * vt + 8 * g + 4 * hh) = (f32x4){o[vt][4 * g] * sc, o[vt][4 * g + 1] * sc, o[vt][4 * g + 2] * sc, o[vt][4 * g + 3] * sc};
    }
    __syncthreads();
    if (c == 0) {
#pragma unroll
        for (int vt = 0; vt < 4; ++vt)
#pragma unroll
            for (int g = 0; g < 4; ++g) {
                LAS f32x4* p = (LAS f32x4*)(img + qrow * AT_IMG_ROW + 32 * vt + 8 * g + 4 * hh);
                f32x4 t = *p;
                t.x += o[vt][4 * g] * inv; t.y += o[vt][4 * g + 1] * inv; t.z += o[vt][4 * g + 2] * inv; t.w += o[vt][4 * g + 3] * inv;
                *p = t;
            }
    }
    __syncthreads();
    {
        const int q = tid >> 2, part = tid & 3;
        float v[32]; float ss = 0.f;
#pragma unroll
        for (int i = 0; i < 8; ++i) { const f32x4 t = *(const LAS f32x4*)(img + q * AT_IMG_ROW + 32 * part + 4 * i); v[4 * i] = t.x; v[4 * i + 1] = t.y; v[4 * i + 2] = t.z; v[4 * i + 3] = t.w;
            ss += (t.x * t.x + t.y * t.y) + (t.z * t.z + t.w * t.w); }
        ss += __shfl_xor(ss, 1); ss += __shfl_xor(ss, 2);
        const float rs = rsqrtf(ss * (1.0f / 128.0f) + EPS) * one_minus_lam_init;
        const float* gp = gainA + h * 128 + 32 * part;
        bf16_t* dst = AO + ((size_t)(b * SEQ + qb * 128 + q)) * 1024 + h * 128 + 32 * part;
#pragma unroll
        for (int i = 0; i < 4; ++i) {
            const f32x4 g0 = *(const f32x4*)(gp + 8 * i), g1 = *(const f32x4*)(gp + 8 * i + 4);
            u32x4 w; w.x = pk2(v[8 * i] * rs * g0.x, v[8 * i + 1] * rs * g0.y); w.y = pk2(v[8 * i + 2] * rs * g0.z, v[8 * i + 3] * rs * g0.w);
            w.z = pk2(v[8 * i + 4] * rs * g1.x, v[8 * i + 5] * rs * g1.y); w.w = pk2(v[8 * i + 6] * rs * g1.z, v[8 * i + 7] * rs * g1.w);
            *(u32x4*)(dst + 8 * i) = w;
        }
    }
    __syncthreads();
}

constexpr int HG_SEG = 0;
constexpr int HG_F = 2048;
constexpr int HG_PART = 2560;
constexpr int HG_V = 4096;
constexpr int HG_VROW = 288;
constexpr int HG_A = HG_V + 64 * HG_VROW;
constexpr int HG_KTROW = 144, HG_QKROW = 272;
constexpr int HG_Bq = HG_A + 128 * HG_KTROW;

__device__ __forceinline__ void hg_cumsum(const float (&gv)[16], int dir, int k, int j, LAS unsigned char* lds, float (&d)[16], float& m_out, float& tot_out) {
    float run = 0.f;
    if (dir == 0) {
#pragma unroll
        for (int i = 0; i < 16; ++i) { run += gv[i]; d[i] = run; }
    } else {
#pragma unroll
        for (int i = 15; i >= 0; --i) { run += gv[i]; d[i] = run; }
    }
    LAS float* seg = (LAS float*)(lds + HG_SEG);
    seg[j * 128 + k] = run;
    __syncthreads();
    const float s0 = seg[k], s1 = seg[128 + k], s2 = seg[256 + k], s3 = seg[384 + k];
    float off, m;
    if (dir == 0) { off = (j > 0 ? s0 : 0.f) + (j > 1 ? s1 : 0.f) + (j > 2 ? s2 : 0.f); m = s0 + s1; }
    else { off = (j < 3 ? s3 : 0.f) + (j < 2 ? s2 : 0.f) + (j < 1 ? s1 : 0.f); m = s2 + s3; }
#pragma unroll
    for (int i = 0; i < 16; ++i) d[i] = d[i] + off - m;
    m_out = m; tot_out = (s0 + s1) + (s2 + s3);
}
__device__ __forceinline__ void hg_load_v(const bf16_t* HV, int tok0, int h, LAS unsigned char* lds, int tid) {
#pragma unroll
    for (int i = 0; i < 2; ++i) { const int ch = tid + 512 * i, p = ch >> 4, part = ch & 15;
        *(LAS u32x4*)(lds + HG_V + p * HG_VROW + part * 16) = *(const u32x4*)(HV + (size_t)(tok0 + p) * 512 + h * 128 + part * 8); }
}
__device__ __forceinline__ void hg_load_g(const float* G, int tok0, int h, int k, int j, float (&gv)[16]) {
    const float* gp = G + (size_t)(tok0 + 16 * j) * 512 + h * 128 + k;
#pragma unroll
    for (int i = 0; i < 16; ++i) gv[i] = gp[(size_t)i * 512];
}

__device__ __forceinline__ void hg1_phase(int bx, int G, const float* GF, const float* GB, const bf16_t* HV, bf16_t* UT, float* Dg, float* Eg, LAS unsigned char* lds) {
    int tid_ = threadIdx.x; asm volatile("" : "+v"(tid_));
    const int tid = tid_, wave = __builtin_amdgcn_readfirstlane(tid >> 6), lane = tid & 63;
    const int k = tid & 127, j = tid >> 7, i16 = lane & 15, g4 = lane >> 4;
    float gn[16]; u32x4 vn[2];
#define HG1_LOAD(uu) do { const int u_ = (uu), dir_ = u_ & 1, cch_ = (u_ >> 1) & 63, bh_ = u_ >> 7, tok_ = (bh_ >> 2) * SEQ + cch_ * 64; \
        hg_load_g(dir_ ? GB : GF, tok_, bh_ & 3, k, j, gn); \
        _Pragma("unroll") for (int i = 0; i < 2; ++i) { const int ch = tid + 512 * i; vn[i] = *(const u32x4*)(HV + (size_t)(tok_ + (ch >> 4)) * 512 + (bh_ & 3) * 128 + (ch & 15) * 8); } } while (0)
    if (bx < 2048) HG1_LOAD(bx);
    for (int u = bx; u < 2048; u += G) {
        const int dir = u & 1, cch = (u >> 1) & 63, bh = u >> 7, b = bh >> 2, h = bh & 3;
        const int tok0 = b * SEQ + cch * 64;
        float gv[16], d[16], m, tot;
#pragma unroll
        for (int i = 0; i < 16; ++i) gv[i] = gn[i];
        u32x4 vr[2];
#pragma unroll
        for (int i = 0; i < 2; ++i) vr[i] = vn[i];
        if (u + G < 2048) HG1_LOAD(u + G);
        hg_cumsum(gv, dir, k, j, lds, d, m, tot);
        float kt[16];
#pragma unroll
        for (int i = 0; i < 16; ++i) kt[i] = (1.0f - __expf(gv[i])) * __expf(fminf(-d[i], 40.f));
        { u32x4 w0, w1;
          w0.x = pk2(kt[0], kt[1]); w0.y = pk2(kt[2], kt[3]); w0.z = pk2(kt[4], kt[5]); w0.w = pk2(kt[6], kt[7]);
          w1.x = pk2(kt[8], kt[9]); w1.y = pk2(kt[10], kt[11]); w1.z = pk2(kt[12], kt[13]); w1.w = pk2(kt[14], kt[15]);
          *(LAS u32x4*)(lds + HG_A + k * HG_KTROW + j * 32) = w0; *(LAS u32x4*)(lds + HG_A + k * HG_KTROW + j * 32 + 16) = w1; }
#pragma unroll
        for (int i = 0; i < 2; ++i) { const int ch = tid + 512 * i; *(LAS u32x4*)(lds + HG_V + (ch >> 4) * HG_VROW + (ch & 15) * 16) = vr[i]; }
        if (j == 0) { ((LAS float*)(lds + HG_F))[k] = __expf(tot - m); Dg[(size_t)u * 128 + k] = __expf(tot); Eg[(size_t)u * 128 + k] = __expf(m); }
        __syncthreads();
        bf16x8 af[2];
#pragma unroll
        for (int s = 0; s < 2; ++s) {
            const LAS unsigned char* ap = lds + HG_A + (16 * wave + i16) * HG_KTROW + (32 * s + 4 * g4) * 2;
            const u32x2 lo = *(const LAS u32x2*)ap, hi = *(const LAS u32x2*)(ap + 32);
            af[s] = __builtin_bit_cast(bf16x8, (u32x4){lo.x, lo.y, hi.x, hi.y});
        }
        const f32x4 fsc = *(const LAS f32x4*)(lds + HG_F + (16 * wave + 4 * g4) * 4);
        const LAS unsigned char* vbase = lds + HG_V + (4 * g4 + (i16 >> 2)) * HG_VROW + (i16 & 3) * 8;
#pragma unroll
        for (int vt = 0; vt < 8; ++vt) {
            f32x4 acc = {0.f, 0.f, 0.f, 0.f};
#pragma unroll
            for (int s = 0; s < 2; ++s) {
                const s16x4 t0 = tr_read(vbase + (32 * s) * HG_VROW + vt * 32), t1 = tr_read(vbase + (32 * s + 16) * HG_VROW + vt * 32);
                const bf16x8 bv = {t0[0], t0[1], t0[2], t0[3], t1[0], t1[1], t1[2], t1[3]};
                acc = __builtin_amdgcn_mfma_f32_16x16x32_bf16(af[s], bv, acc, 0, 0, 0);
            }
            u32x2 w; w.x = pk2(acc[0] * fsc[0], acc[1] * fsc[1]); w.y = pk2(acc[2] * fsc[2], acc[3] * fsc[3]);
            *(u32x2*)(UT + ((size_t)u * 128 + 16 * vt + i16) * 128 + 16 * wave + 4 * g4) = w;
        }
        __syncthreads();
    }
}

__device__ __forceinline__ void hg2_scan(bf16_t* UT, const float* Dg, const float* Eg, int gthread, int nthreads) {
    for (int idx = gthread; idx < 32 * 4096; idx += nthreads) {
        const int chain = idx >> 12, e4 = idx & 4095, v = e4 >> 5, k0 = (e4 & 31) * 4;
        const int dir = chain & 1, bh = chain >> 1;
        float S0 = 0.f, S1 = 0.f, S2 = 0.f, S3 = 0.f;
        int u = (bh * 64 + (dir ? 63 : 0)) * 2 + dir;
        const int ustep = dir ? -2 : 2;
        u32x2 uu[4]; f32x4 dd[4], ee[4];
#pragma unroll
        for (int r = 0; r < 4; ++r) { const int ur = u + r * ustep; uu[r] = *(const u32x2*)(UT + ((size_t)ur * 128 + v) * 128 + k0); dd[r] = *(const f32x4*)(Dg + (size_t)ur * 128 + k0); ee[r] = *(const f32x4*)(Eg + (size_t)ur * 128 + k0); }
        for (int cc = 0; cc < 64; cc += 4) {
#pragma unroll
            for (int r = 0; r < 4; ++r) {
                const u32x2 uc = uu[r]; const f32x4 dc = dd[r], ec = ee[r];
                if (cc + 4 < 64) { const int un = u + 4 * ustep; uu[r] = *(const u32x2*)(UT + ((size_t)un * 128 + v) * 128 + k0); dd[r] = *(const f32x4*)(Dg + (size_t)un * 128 + k0); ee[r] = *(const f32x4*)(Eg + (size_t)un * 128 + k0); }
                u32x2 w; w.x = pk2(ec.x * S0, ec.y * S1); w.y = pk2(ec.z * S2, ec.w * S3);
                *(u32x2*)(UT + ((size_t)u * 128 + v) * 128 + k0) = w;
                S0 = dc.x * S0 + bflo(uc.x); S1 = dc.y * S1 + bfhi(uc.x); S2 = dc.z * S2 + bflo(uc.y); S3 = dc.w * S3 + bfhi(uc.y);
                u += ustep;
            }
        }
    }
}

constexpr int HG_OUT = HG_Bq + 64 * HG_QKROW;
__device__ __forceinline__ void hg3_phase(int bx, int G, const float* GF, const float* GB, const bf16_t* HQ, const bf16_t* HV, const bf16_t* ST, const bf16_t* BG, const float* gainH, bf16_t* AO, LAS unsigned char* lds) {
    int tid_ = threadIdx.x; asm volatile("" : "+v"(tid_));
    const int tid = tid_, wave = __builtin_amdgcn_readfirstlane(tid >> 6), lane = tid & 63;
    const int k = tid & 127, j = tid >> 7;
    const int tb = wave & 3, vh = wave >> 2, i16 = lane & 15, g4 = lane >> 4;
    float gf[16], gb[16]; unsigned short qr[16];
#define HG3_LOAD(uu) do { const int u_ = (uu), cch_ = u_ & 63, bh_ = u_ >> 6, tok_ = (bh_ >> 2) * SEQ + cch_ * 64, h_ = bh_ & 3; \
        hg_load_g(GF, tok_, h_, k, j, gf); hg_load_g(GB, tok_, h_, k, j, gb); \
        const bf16_t* qp = HQ + (size_t)(tok_ + 16 * j) * 512 + h_ * 128 + k; \
        _Pragma("unroll") for (int i = 0; i < 16; ++i) qr[i] = qp[(size_t)i * 512]; } while (0)
    if (bx < 1024) HG3_LOAD(bx);
  for (int u3 = bx; u3 < 1024; u3 += G) {
    const int cch = u3 & 63, bh = u3 >> 6, b = bh >> 2, h = bh & 3;
    const int tok0 = b * SEQ + cch * 64;
    hg_load_v(HV, tok0, h, lds, tid);
    u32x4 bgq[2];
    { const bf16_t* bgp0 = BG + (size_t)(tok0 + (tid >> 3)) * 512 + h * 128 + 16 * (tid & 7); bgq[0] = *(const u32x4*)bgp0; bgq[1] = *(const u32x4*)(bgp0 + 8); }
    bf16x8 sb[16];
    { const bf16_t* stp = ST + ((size_t)((bh * 64 + cch) * 2 + 0) * 128) * 128;
#pragma unroll
      for (int vv = 0; vv < 4; ++vv)
#pragma unroll
        for (int ks = 0; ks < 4; ++ks) sb[vv * 4 + ks] = *(const bf16x8*)(stp + (size_t)(16 * (4 * vh + vv) + i16) * 128 + 32 * ks + 8 * g4); }
    f32x4 oacc[4];
#pragma unroll
    for (int i = 0; i < 4; ++i) oacc[i] = (f32x4){0.f, 0.f, 0.f, 0.f};
#pragma unroll
    for (int dir = 0; dir < 2; ++dir) {
        float d[16], m, tot;
        hg_cumsum(dir ? gb : gf, dir, k, j, lds, d, m, tot);
#pragma unroll
        for (int i = 0; i < 16; ++i) {
            const float gvi = dir ? gb[i] : gf[i];
            const float kt = (1.0f - __expf(gvi)) * __expf(fminf(-d[i], 40.f));
            const float qt = bf2f(qr[i]) * __expf(fminf(d[i], 40.f));
            *(LAS unsigned short*)(lds + HG_A + (16 * j + i) * HG_QKROW + k * 2) = (unsigned short)f2bf(kt);
            *(LAS unsigned short*)(lds + HG_Bq + (16 * j + i) * HG_QKROW + k * 2) = (unsigned short)f2bf(qt);
        }
        if (dir == 1 && u3 + G < 1024) HG3_LOAD(u3 + G);
        __syncthreads();
        f32x4 pt[4];
#pragma unroll
        for (int sg = 0; sg < 4; ++sg) pt[sg] = (f32x4){0.f, 0.f, 0.f, 0.f};
        bf16x8 qa[4];
#pragma unroll
        for (int ks = 0; ks < 4; ++ks) qa[ks] = *(const LAS bf16x8*)(lds + HG_Bq + (16 * tb + i16) * HG_QKROW + (32 * ks + 8 * g4) * 2);
#pragma unroll
        for (int sg = 0; sg < 4; ++sg)
#pragma unroll
            for (int ks = 0; ks < 4; ++ks) {
                const bf16x8 ka = *(const LAS bf16x8*)(lds + HG_A + (16 * sg + i16) * HG_QKROW + (32 * ks + 8 * g4) * 2);
                pt[sg] = __builtin_amdgcn_mfma_f32_16x16x32_bf16(ka, qa[ks], pt[sg], 0, 0, 0);
            }
        const int tcol = 16 * tb + i16;
#pragma unroll
        for (int sg = 0; sg < 4; ++sg)
#pragma unroll
            for (int e = 0; e < 4; ++e) { const int srow = 16 * sg + 4 * g4 + e; const bool keep = dir ? (srow >= tcol) : (srow <= tcol); pt[sg][e] = keep ? pt[sg][e] : 0.f; }
        bf16x8 pa[2];
#pragma unroll
        for (int s2 = 0; s2 < 2; ++s2) {
            u32x4 w; w.x = pk2(pt[2 * s2][0], pt[2 * s2][1]); w.y = pk2(pt[2 * s2][2], pt[2 * s2][3]); w.z = pk2(pt[2 * s2 + 1][0], pt[2 * s2 + 1][1]); w.w = pk2(pt[2 * s2 + 1][2], pt[2 * s2 + 1][3]);
            pa[s2] = __builtin_bit_cast(bf16x8, w);
        }
        const LAS unsigned char* vbase = lds + HG_V + (4 * g4 + (i16 >> 2)) * HG_VROW + (i16 & 3) * 8;
#pragma unroll
        for (int vv = 0; vv < 4; ++vv) {
            const int vt = 4 * vh + vv;
#pragma unroll
            for (int s2 = 0; s2 < 2; ++s2) {
                const s16x4 t0 = tr_read(vbase + (32 * s2) * HG_VROW + vt * 32), t1 = tr_read(vbase + (32 * s2 + 16) * HG_VROW + vt * 32);
                const bf16x8 bv = {t0[0], t0[1], t0[2], t0[3], t1[0], t1[1], t1[2], t1[3]};
                oacc[vv] = __builtin_amdgcn_mfma_f32_16x16x32_bf16(pa[s2], bv, oacc[vv], 0, 0, 0);
            }
#pragma unroll
            for (int ks = 0; ks < 4; ++ks) oacc[vv] = __builtin_amdgcn_mfma_f32_16x16x32_bf16(qa[ks], sb[vv * 4 + ks], oacc[vv], 0, 0, 0);
        }
        if (dir == 0) {
            const bf16_t* stp = ST + ((size_t)((bh * 64 + cch) * 2 + 1) * 128) * 128;
#pragma unroll
            for (int vv = 0; vv < 4; ++vv)
#pragma unroll
                for (int ks = 0; ks < 4; ++ks) sb[vv * 4 + ks] = *(const bf16x8*)(stp + (size_t)(16 * (4 * vh + vv) + i16) * 128 + 32 * ks + 8 * g4);
        }
        __syncthreads();
    }
    LAS float* ot = (LAS float*)(lds + HG_OUT);
#pragma unroll
    for (int vv = 0; vv < 4; ++vv)
#pragma unroll
        for (int e = 0; e < 4; ++e) ot[(16 * tb + 4 * g4 + e) * 132 + 16 * (4 * vh + vv) + i16] = oacc[vv][e];
    __syncthreads();
    {
        const int t = tid >> 3, part = tid & 7;
        float v[16]; float ss = 0.f;
#pragma unroll
        for (int i = 0; i < 4; ++i) { const f32x4 x = *(const LAS f32x4*)(ot + t * 132 + 16 * part + 4 * i); v[4 * i] = x.x; v[4 * i + 1] = x.y; v[4 * i + 2] = x.z; v[4 * i + 3] = x.w; ss += (x.x * x.x + x.y * x.y) + (x.z * x.z + x.w * x.w); }
        ss += __shfl_xor(ss, 1); ss += __shfl_xor(ss, 2); ss += __shfl_xor(ss, 4);
        const float rs = rsqrtf(ss * (1.0f / 128.0f) + EPS);
        const float* gp = gainH + h * 128 + 16 * part;
        bf16_t* dst = AO + (size_t)(tok0 + t) * 1024 + 512 + h * 128 + 16 * part;
#pragma unroll
        for (int i = 0; i < 2; ++i) {
            const u32x4 gq = bgq[i];
            const f32x4 g0 = *(const f32x4*)(gp + 8 * i), g1 = *(const f32x4*)(gp + 8 * i + 4);
            u32x4 w;
            w.x = pk2(v[8 * i] * rs * g0.x * bflo(gq.x), v[8 * i + 1] * rs * g0.y * bfhi(gq.x)); w.y = pk2(v[8 * i + 2] * rs * g0.z * bflo(gq.y), v[8 * i + 3] * rs * g0.w * bfhi(gq.y));
            w.z = pk2(v[8 * i + 4] * rs * g1.x * bflo(gq.z), v[8 * i + 5] * rs * g1.y * bfhi(gq.z)); w.w = pk2(v[8 * i + 6] * rs * g1.z * bflo(gq.w), v[8 * i + 7] * rs * g1.w * bfhi(gq.w));
            *(u32x4*)(dst + 8 * i) = w;
        }
    }
    __syncthreads();
  }
#undef HG3_LOAD
}

#define XB_TMO      128
#define XB_XCNT(j)  (256  + 64 * (j))
#define XB_XSUB(j)  (1280 + 64 * (j))
#define XB_XGEN(j)  (2304 + 64 * (j))
#define XB_TOP      3328
#define XB_TOPGEN   3392
#define XCD_BAR_WORDS 3456
#define XB_SPIN_CAP (1u << 18)

__device__ __forceinline__ unsigned xb_ld(unsigned* p)              { return __hip_atomic_load(p, __ATOMIC_RELAXED, __HIP_MEMORY_SCOPE_AGENT); }
__device__ __forceinline__ unsigned xb_add(unsigned* p, unsigned v) { return __hip_atomic_fetch_add(p, v, __ATOMIC_RELAXED, __HIP_MEMORY_SCOPE_AGENT); }
__device__ __forceinline__ unsigned xb_xcc_id() { return (unsigned)__builtin_amdgcn_s_getreg((3 << 11) | 20) & 0xFu; }
#define XB_SPIN(cond, bar) do { unsigned _sp = 0; while (cond) { __builtin_amdgcn_s_sleep(1); \
    if ((++_sp & 255u) == 0u) { if (xb_ld(&(bar)[XB_TMO])) break; if (_sp > XB_SPIN_CAP) { atomicAdd(&(bar)[XB_TMO], 1u); break; } } } } while (0)

struct XcdBarrier {
    unsigned* bar; unsigned x;
    volatile LAS unsigned* st;
};

__device__ __forceinline__ XcdBarrier xcd_barrier_post(unsigned* bar, volatile LAS unsigned* st) {
    XcdBarrier b; b.bar = bar; b.x = xb_xcc_id(); b.st = st;
    if (threadIdx.x == 0) (void)xb_add(&bar[XB_XCNT(b.x)], 1u);
    return b;
}
__device__ __forceinline__ void xcd_barrier_complete(unsigned* bar, unsigned x, unsigned& nloc, unsigned& nx) {
    const unsigned G = gridDim.x * gridDim.y * gridDim.z;
    unsigned sum, cnt, mine, sp = 0u;
    for (;;) {
        sum = 0u; cnt = 0u; mine = 0u;
#pragma unroll
        for (unsigned j = 0; j < 16; ++j) { const unsigned c = xb_ld(&bar[XB_XCNT(j)]); sum += c; cnt += (c > 0u) ? 1u : 0u; mine = (j == x) ? c : mine; }
        if (sum == G) break;
        __builtin_amdgcn_s_sleep(1);
        if ((++sp & 255u) == 0u) { if (xb_ld(&bar[XB_TMO])) break; if (sp > XB_SPIN_CAP) { atomicAdd(&bar[XB_TMO], 1u); break; } }
    }
    nloc = mine > 0u ? mine : 1u; nx = cnt > 0u ? cnt : 1u;
}

__device__ __forceinline__ void xcd_barrier(const XcdBarrier& b) {
    asm volatile("s_waitcnt vmcnt(0)" ::: "memory");
    __syncthreads();
    if (threadIdx.x == 0) {
        unsigned* bar = b.bar;
        __builtin_amdgcn_s_waitcnt(0);
        unsigned nloc = b.st[0], nx = b.st[1];
        if (nloc == 0u) { xcd_barrier_complete(bar, b.x, nloc, nx); b.st[0] = nloc; b.st[1] = nx; }
        const unsigned old = xb_add(&bar[XB_XSUB(b.x)], 1u);
        const unsigned gen = old / nloc;
        if (old + 1u == (gen + 1u) * nloc) {
            __builtin_amdgcn_fence(__ATOMIC_RELEASE, "agent");
            asm volatile("s_waitcnt vmcnt(0)" ::: "memory");
            const unsigned og = xb_add(&bar[XB_TOP], 1u);
            const unsigned tg = og / nx;
            if (og + 1u == (tg + 1u) * nx) xb_add(&bar[XB_TOPGEN], 1u);
            else XB_SPIN(xb_ld(&bar[XB_TOPGEN]) == tg, bar);
            __builtin_amdgcn_fence(__ATOMIC_ACQUIRE, "agent");
            xb_add(&bar[XB_XGEN(b.x)], 1u);
            asm volatile("s_waitcnt vmcnt(0)" ::: "memory");
        } else {
            XB_SPIN(xb_ld(&bar[XB_XGEN(b.x)]) == gen, bar);
            __builtin_amdgcn_fence(__ATOMIC_ACQUIRE, "agent");
            asm volatile("s_waitcnt vmcnt(0)" ::: "memory");
        }
    }
    __syncthreads();
}

__global__ void __launch_bounds__(512, 2) fwd_kernel(Ptrs Pk) {
    extern __shared__ __attribute__((aligned(16))) unsigned char lds_raw[];
    LAS unsigned char* lds = (LAS unsigned char*)lds_raw;
    cg::grid_group grid = cg::this_grid();
    const int G = gridDim.x, bx = blockIdx.x;
    const int lo = Pk.ph_lo, hi = Pk.ph_hi;
    int ph = 0;
    if (threadIdx.x < 4) ((LAS unsigned*)(lds + 131072 + 1024))[threadIdx.x] = 0u;
    __syncthreads();
    XcdBarrier xbar = xcd_barrier_post((unsigned*)(Pk.ws + OFF_BAR), (volatile LAS unsigned*)(lds + 131072 + 1024));
#ifdef TS_A
    if (threadIdx.x == 0) { LAS unsigned long long* TS_ = (LAS unsigned long long*)(lds + 131072); for (int i = 0; i < 15; ++i) TS_[i] = 0ull; TS_[15] = __builtin_amdgcn_s_memrealtime(); }
#endif
#ifndef PH_MASK
#define PH_MASK 0xFFFFFFFFu
#endif
#define ON(id) constexpr (((PH_MASK) >> (id)) & 1u)
#if defined(__HIP_DEVICE_COMPILE__)
#define LOAD_ARGS(P) int zoff_ = 0; asm volatile("" : "+s"(zoff_)); const Ptrs P = *(const __attribute__((address_space(4))) Ptrs*)((const __attribute__((address_space(4))) char*)__builtin_amdgcn_kernarg_segment_ptr() + zoff_);
#else
#define LOAD_ARGS(P) const Ptrs P = Pk;
#endif
#define PHASE_BEGIN if (ph >= lo && ph < hi) { LOAD_ARGS(P) unsigned char* ws = P.ws; asm volatile("" : "+s"(ws)); int tid = threadIdx.x; asm volatile("" : "+v"(tid)); \
    const int lane = tid & 63, wave = __builtin_amdgcn_readfirstlane(tid >> 6), gw = bx * 8 + wave, ngw = G * 8; (void)lane; (void)gw; (void)ngw;
#define XB ((bf16_t*)(ws + OFF_XB))
#define RSA ((float*)(ws + OFF_RSA))
#define RSB ((float*)(ws + OFF_RSB))
#define CS ((const float*)(ws + OFF_CS))
#define LB ((const float*)(ws + OFF_LB))
#define LAM ((const float*)(ws + OFF_LAM))
#define Dg ((float*)(ws + OFF_DG))
#define Eg ((float*)(ws + OFF_EG))
#define GATE ((bf16_t*)(ws + OFF_GATE))
#define Qb ((bf16_t*)(ws + OFF_Q))
#define Kb ((bf16_t*)(ws + OFF_K))
#define Vb ((bf16_t*)(ws + OFF_V))
#define HQ ((bf16_t*)(ws + OFF_HQ))
#define HV ((bf16_t*)(ws + OFF_HV))
#define GF ((float*)(ws + OFF_GF))
#define GB ((float*)(ws + OFF_GB))
#define Yb ((bf16_t*)(ws + OFF_Y))
#define BG ((bf16_t*)(ws + OFF_BG))
#define AO ((bf16_t*)(ws + OFF_AO))
#define UT ((bf16_t*)(ws + OFF_UT))
#define Hb ((bf16_t*)(ws + OFF_H))
#ifdef TS_A
#define TICK(cat) do { if (bx == 0 && threadIdx.x == 0) { LAS unsigned long long* TS_ = (LAS unsigned long long*)(lds + 131072); const unsigned long long t_ = __builtin_amdgcn_s_memrealtime(); TS_[cat] += t_ - TS_[15]; TS_[15] = t_; } } while (0)
#else
#define TICK(cat) do { } while (0)
#endif
#define PHASE_END(cat)   TICK(cat); if (ph + 1 < hi) { if (ph == 0) grid.sync(); else xcd_barrier(xbar); TICK(13); } } ++ph;

    PHASE_BEGIN
        if ON(0) prologue(P, lds, gw, ngw, wave, lane);
        if ON(6) convert_layer(P, 0, ws, lds, gw, ngw, wave, lane);
    PHASE_END(0)

    for (int layer = 0; layer < DEPTH; ++layer) {
        PHASE_BEGIN
            pg8::Gemm g{XB, (const bf16_t*)(ws + (size_t)(layer & 1) * WSZ + W_IN), Dm, Dm, Dm, 1 << 30, 0, -1};
            pg8::StaticOrder S; S.init(M, 4096, G, bx);
            EpiMix E{RSB, CS, LB + (0 * 4 + layer) * 512, LB + (1 * 4 + layer) * 512, Qb, Kb, Vb, HQ, HV, BG, GF, GB};
            if ON(1) pg8::gemm_phase(lds, g, S, E);
        PHASE_END(1)
        PHASE_BEGIN
            const float lam_init = 0.8f - 0.6f * __expf(-0.3f * (float)layer);
            const float lam = LAM[layer];
            if ON(2) for (int i = 0; i * G + bx < 512; ++i) {
                const int uid = i * G + bx; const int round = uid >> 8, r = uid & 255;
                const int bhh = round * 8 + (r & 7), qb = r >> 3;
                attn_unit(bhh >> 2, bhh & 3, qb, Qb, Kb, Vb, AO, P.da_norm + layer * 512, 1.0f - lam_init, lam, lds);
            }
            TICK(2);
            if ON(3) hg1_phase(bx, G, GF, GB, HV, UT, Dg, Eg, lds);
        PHASE_END(3)
        PHASE_BEGIN
            if ON(5) hg2_scan(UT, Dg, Eg, bx * 512 + tid, G * 512);
            TICK(5);
            {
                pg8::Gemm g{XB, (const bf16_t*)(ws + (size_t)(layer & 1) * WSZ + W_IN) + (size_t)4096 * Dm, Dm, Dm, Dm, 1 << 30, 0, -1};
                pg8::StaticOrder S; S.init(M, 2048, G, bx);
                EpiGate E{RSB, GATE};
                if ON(4) pg8::gemm_phase(lds, g, S, E);
            }
            TICK(4);
        PHASE_END(4)
        PHASE_BEGIN
            if ON(7) hg3_phase(bx, G, GF, GB, HQ, HV, UT, BG, P.hg_norm + layer * 512, AO, lds);
        PHASE_END(7)
        PHASE_BEGIN
            pg8::Gemm g{AO, (const bf16_t*)(ws + (size_t)(layer & 1) * WSZ + W_AB), 1024, 1024, 1024, 1 << 30, 0, 8};
            pg8::StaticOrder S; S.init(M, 1024, G, bx);
            EpiY E{GATE, Yb};
            if ON(8) pg8::gemm_phase(lds, g, S, E);
        PHASE_END(8)
        PHASE_BEGIN
            pg8::Gemm g{Yb, (const bf16_t*)(ws + (size_t)(layer & 1) * WSZ + W_O2), 1024, 1024, 1024, 1 << 30, 0, -1};
            pg8::StaticOrder S; S.init(M, Dm, G, bx);
            EpiRes E{layer == 0 ? P.x : P.out, P.out, XB, RSA};
            if ON(9) pg8::gemm_phase(lds, g, S, E);
        PHASE_END(9)
        PHASE_BEGIN
            pg8::Gemm g{XB, (const bf16_t*)(ws + (size_t)(layer & 1) * WSZ + W_GU), Dm, Dm, Dm, 1 << 30, 0, -1};
            pg8::StaticOrder S; S.init(M, 2 * FF, G, bx);
            EpiGU E{RSA, Hb};
            if ON(10) pg8::gemm_phase(lds, g, S, E);
        PHASE_END(10)
        PHASE_BEGIN
            pg8::Gemm g{Hb, (const bf16_t*)(ws + (size_t)(layer & 1) * WSZ + W_D), FF, FF, FF, 1 << 30, 0, -1};
            pg8::StaticOrder S; S.init(M, Dm, G, bx);
            EpiRes E{P.out, P.out, XB, RSB};
            if ON(11) pg8::gemm_phase(lds, g, S, E);
            TICK(11);
            if ON(6) if (layer + 1 < DEPTH) convert_layer(P, layer + 1, ws + (size_t)((layer + 1) & 1) * WSZ, lds, gw, ngw, wave, lane);
        PHASE_END(6)
    }
    PHASE_BEGIN
        if ON(12) for (int r = gw; r < M; r += ngw) {
            f32x4* xr = (f32x4*)(P.out + (size_t)r * Dm) + lane;
            f32x4 v[4]; float ss = 0.f;
#pragma unroll
            for (int j = 0; j < 4; ++j) { v[j] = xr[64 * j]; ss += (v[j].x * v[j].x + v[j].y * v[j].y) + (v[j].z * v[j].z + v[j].w * v[j].w); }
            const float rs = rsqrtf(wave_sum(ss) * (1.0f / Dm) + EPS);
#pragma unroll
            for (int j = 0; j < 4; ++j) { const f32x4 gn = *((const f32x4*)P.final_norm + lane + 64 * j); xr[64 * j] = (f32x4){v[j].x * rs * gn.x, v[j].y * rs * gn.y, v[j].z * rs * gn.z, v[j].w * rs * gn.w}; }
        }
    PHASE_END(12)
#ifdef TS_A
    if (bx == 0 && threadIdx.x == 0) {
        LAS unsigned long long* TS_ = (LAS unsigned long long*)(lds + 131072);
        unsigned long long a = 0;
        for (int i = 0; i < 15; ++i) { if ((TS_A >> i) & 1) a += TS_[i]; }
        const unsigned long long t_end = __builtin_amdgcn_s_memrealtime() + a;
        while (__builtin_amdgcn_s_memrealtime() < t_end) __builtin_amdgcn_s_sleep(20);
    }
#endif
}
constexpr int NPHASES = 2 + 8 * DEPTH;

#ifndef MK_PER_PHASE
#define MK_PER_PHASE 0
#endif

extern "C" void kernel_launch(void* const* d_in, const int* in_sizes, int n_in, void* d_out, int out_size, void* d_ws, size_t ws_size, hipStream_t stream) {
    static int grid = 0;
    if (grid == 0) {
        if (n_in != 16 || out_size != M * Dm || ws_size < WS_END) { fprintf(stderr, "kernel_launch: unexpected sizes (n_in %d, out %d, ws %zu, need %zu)\n", n_in, out_size, ws_size, (size_t)WS_END); grid = -1; return; }
        int dev = 0, cus = 0, per_cu = 0;
        (void)hipGetDevice(&dev);
        (void)hipDeviceGetAttribute(&cus, hipDeviceAttributeMultiprocessorCount, dev);
        if (hipFuncSetAttribute((const void*)fwd_kernel, hipFuncAttributeMaxDynamicSharedMemorySize, LDS_BYTES) != hipSuccess) { fprintf(stderr, "kernel_launch: hipFuncSetAttribute failed\n"); grid = -1; return; }
        (void)hipOccupancyMaxActiveBlocksPerMultiprocessor(&per_cu, (const void*)fwd_kernel, 512, LDS_BYTES);
        (void)hipGetLastError();
        if (per_cu < 1) per_cu = 1;
        grid = cus * 1;
        fprintf(stderr, "kernel_launch: grid %d (per_cu %d), ws %zu need %zu\n", grid, per_cu, ws_size, (size_t)WS_END);
    }
    if (grid < 0) return;
    Ptrs p{};
    p.x = (const float*)d_in[0]; p.pos = (const int*)d_in[1]; p.w_in = (const float*)d_in[2]; p.da_lambda = (const float*)d_in[3]; p.da_norm = (const float*)d_in[4];
    p.hg_lb = (const float*)d_in[5]; p.hg_norm = (const float*)d_in[6]; p.w_a = (const float*)d_in[7]; p.w_b = (const float*)d_in[8]; p.w_o = (const float*)d_in[9];
    p.attn_norm = (const float*)d_in[10]; p.ffn_norm = (const float*)d_in[11]; p.w_gate = (const float*)d_in[12]; p.w_up = (const float*)d_in[13]; p.w_down = (const float*)d_in[14];
    p.final_norm = (const float*)d_in[15];
    p.out = (float*)d_out; p.ws = (unsigned char*)d_ws;
    (void)hipMemsetAsync((char*)d_ws + OFF_BAR, 0, BAR_BYTES, stream);
#if MK_PER_PHASE
    for (int ph = 0; ph < NPHASES; ++ph) {
        p.ph_lo = ph; p.ph_hi = ph + 1;
        hipLaunchKernelGGL(fwd_kernel, dim3(grid), dim3(512), LDS_BYTES, stream, p);
    }
#else
    p.ph_lo = 0; p.ph_hi = NPHASES;
    void* args[] = {&p};
    hipError_t e = hipLaunchCooperativeKernel((const void*)fwd_kernel, dim3(grid), dim3(512), args, LDS_BYTES, stream);
    if (e != hipSuccess) fprintf(stderr, "cooperative launch failed: %s (grid %d)\n", hipGetErrorString(e), grid);
#endif
}
```

```cpp
#include <hip/hip_runtime.h>
#include <hip/hip_cooperative_groups.h>
#include <cstdio>
#include <cstdint>
namespace cg = cooperative_groups;

#define LAS __attribute__((address_space(3)))
typedef unsigned short bf16_t;
typedef short bf16x8 __attribute__((ext_vector_type(8)));
typedef short s16x4 __attribute__((ext_vector_type(4)));
typedef float f32x4 __attribute__((ext_vector_type(4)));
typedef float f32x16 __attribute__((ext_vector_type(16)));
typedef unsigned u32x4 __attribute__((ext_vector_type(4)));
typedef unsigned u32x2 __attribute__((ext_vector_type(2)));

constexpr int Dm = 1024, NB = 4, SEQ = 4096, M = NB * SEQ, DEPTH = 4, FF = 2816, INW = 6144;
constexpr float EPS = 1e-6f;
constexpr float LOG2E = 1.4426950408889634f;

constexpr size_t W_IN = 0, W_AB = 12582912, W_O2 = 14680064, W_GU = 18874368, W_D = 30408704, WSZ = 36175872;
constexpr size_t MiB = 1048576;
constexpr size_t OFF_XB = 2 * WSZ;
constexpr size_t OFF_RSA = OFF_XB + 32 * MiB;
constexpr size_t OFF_RSB = OFF_RSA + MiB;
constexpr size_t OFF_CS = OFF_RSB + MiB;
constexpr size_t OFF_LB = OFF_CS + MiB;
constexpr size_t OFF_LAM = OFF_LB + 16384;
constexpr size_t OFF_DG = OFF_LAM + 256;
constexpr size_t OFF_EG = OFF_DG + MiB;
constexpr size_t OFF_B = OFF_EG + MiB;
constexpr size_t OFF_GATE = OFF_B;
constexpr size_t OFF_Q = OFF_B, OFF_K = OFF_B + 16 * MiB, OFF_V = OFF_B + 32 * MiB;
constexpr size_t OFF_HQ = OFF_B + 64 * MiB;
constexpr size_t OFF_HV = OFF_HQ + 16 * MiB;
constexpr size_t OFF_GF = OFF_HV + 16 * MiB;
constexpr size_t OFF_GB = OFF_GF + 16 * MiB;
constexpr size_t OFF_Y = OFF_GF;
constexpr size_t OFF_BG = OFF_GB + 16 * MiB;
constexpr size_t OFF_AO = OFF_BG + 16 * MiB;
constexpr size_t OFF_UT = OFF_AO + 32 * MiB;
constexpr size_t OFF_H = OFF_B;
constexpr size_t OFF_BAR = OFF_UT + 64 * MiB;
constexpr size_t BAR_BYTES = 16384;
constexpr size_t WS_END = OFF_BAR + BAR_BYTES;

constexpr int LDS_BYTES = 131072 + 2048;

__device__ __forceinline__ unsigned f2bf(float f) { unsigned u = __builtin_bit_cast(unsigned, f); return (u + 0x7fffu + ((u >> 16) & 1u)) >> 16; }
typedef float f32x2_t __attribute__((ext_vector_type(2)));
typedef __bf16 bf16x2_t __attribute__((ext_vector_type(2)));
__device__ __forceinline__ unsigned pk2(float lo, float hi) { f32x2_t v = {lo, hi}; bf16x2_t b = __builtin_convertvector(v, bf16x2_t); return __builtin_bit_cast(unsigned, b); }
__device__ __forceinline__ float bf2f(unsigned short b) { return __builtin_bit_cast(float, (unsigned)b << 16); }
__device__ __forceinline__ float bflo(unsigned u) { return __builtin_bit_cast(float, u << 16); }
__device__ __forceinline__ float bfhi(unsigned u) { return __builtin_bit_cast(float, u & 0xffff0000u); }
__device__ __forceinline__ float sigmoidf_(float x) { return __builtin_amdgcn_rcpf(1.0f + __expf(-x)); }

namespace pg8 {
constexpr int BM = 256, BK = 64, HALF = 128, HTB = HALF * BK * 2, STAGE_BYTES = 8 * HTB, NXCD = 8, WGM = 8;
__host__ __device__ __forceinline__ int lds_byte(int r, int c) { const int st = (r >> 4) * 2 + (c >> 5), rr = r & 15, cc = c & 31, ob = rr * 64 + cc * 2; return st * 1024 + (ob ^ (((ob >> 9) & 1) << 5)); }
__host__ __device__ __forceinline__ void stage_rc(int b, int& R, int& C) { const int st = b / 1024, sb = b % 1024, swz = sb ^ (((sb >> 9) & 1) << 5); R = (st >> 1) * 16 + swz / 64; C = (st & 1) * 32 + (swz % 64) / 2; }
__host__ __device__ __forceinline__ int perm32(int rho) { const int n = rho >> 4, i = rho & 15; return 8 * (i >> 2) + 4 * n + (i & 3); }

struct Unit { int pm, pn; };
struct Gemm { const bf16_t* A; const bf16_t* Bt; int lda, ldb, K; int split_pn; int split_aoff; int mid_t; };

struct StaticOrder {
    int nM, nN, nwg, G, c;
    __device__ __forceinline__ void init(int M_, int N_, int G_, int c_) { nM = M_ / BM; nN = N_ / BM; nwg = nM * nN; G = G_; c = c_; }
    __device__ bool next(int i, Unit& u) const {
        const long L = (long)i * G + c; if (L >= nwg) return false;
        int wgid = (int)L; { const int q = nwg / NXCD, r = nwg % NXCD, xcd = wgid % NXCD, off = wgid / NXCD; wgid = (xcd < r ? xcd * (q + 1) : r * (q + 1) + (xcd - r) * q) + off; }
        const int nig = WGM * nN, gid = wgid / nig, fm = gid * WGM, gsz = (nM - fm) < WGM ? (nM - fm) : WGM;
        u.pm = fm + ((wgid % nig) % gsz); u.pn = (wgid % nig) / gsz; return true;
    }
};

template <class Epi>
__device__ __forceinline__ void gemm_phase(LAS unsigned char* lds, const Gemm g, const StaticOrder& S, const Epi& E) {
    int tid_ = threadIdx.x; asm volatile("" : "+v"(tid_));
    const int tid = tid_, wid = __builtin_amdgcn_readfirstlane(tid >> 6), lane = tid & 63, wr = wid >> 2, wc = wid & 3, fr = lane & 15, fq = lane >> 4;
    const int K = g.K, nt = K / BK;
    unsigned voffA[2], voffB[2];
#pragma unroll
    for (int i = 0; i < 2; ++i) { int R, C; stage_rc(tid * 16 + i * 8192, R, C); const int Rb = (R & ~31) + perm32(R & 31);
        voffA[i] = (unsigned)(R * g.lda + C) * 2u; voffB[i] = (unsigned)(Rb * g.ldb + C) * 2u; }
    const size_t kstep = (size_t)(BK * 2);
    const size_t hstepA = (size_t)HALF * g.lda * 2, hstepB = (size_t)HALF * g.ldb * 2;
    const size_t tstepA = 2 * hstepA, tstepB = 2 * hstepB;
    const unsigned ldsw = (unsigned)wid * 1024u;
    const int aoff = lds_byte(wr * 64 + fr, fq * 8), boff = lds_byte(wc * 32 + fr, fq * 8);
#define PG8_SA(b, h) (((b) * 2 + (h)) * HTB)
#define PG8_SB(b, h) ((4 + (b) * 2 + (h)) * HTB)
#define PG8_STAGE(bufoff, gbase, voff) do { _Pragma("unroll") for (int _i = 0; _i < 2; ++_i) \
        __builtin_amdgcn_global_load_lds((const unsigned*)((const char*)(gbase) + (voff)[_i]), (LAS unsigned*)(lds + (bufoff) + ldsw + _i * 8192), 16, 0, 0); } while (0)
#define PG8_LDA(dst, b, h) do { _Pragma("unroll") for (int m = 0; m < 4; ++m) _Pragma("unroll") for (int k = 0; k < 2; ++k) dst[m][k] = *(const LAS bf16x8*)(lds + PG8_SA(b, h) + aoff + m * 2048 + k * 1024); } while (0)
#define PG8_LDB(dst, b, h) do { _Pragma("unroll") for (int n = 0; n < 2; ++n) _Pragma("unroll") for (int k = 0; k < 2; ++k) dst[n][k] = *(const LAS bf16x8*)(lds + PG8_SB(b, h) + boff + n * 2048 + k * 1024); } while (0)
#define PG8_MMA(ai, bj, At, Bt) do { __builtin_amdgcn_s_setprio(1); _Pragma("unroll") for (int m = 0; m < 4; ++m) _Pragma("unroll") for (int n = 0; n < 2; ++n) _Pragma("unroll") for (int k = 0; k < 2; ++k) \
        acc[ai][bj][m][n] = __builtin_amdgcn_mfma_f32_16x16x32_bf16(Bt[n][k], At[m][k], acc[ai][bj][m][n], 0, 0, 0); __builtin_amdgcn_s_setprio(0); } while (0)
#define PG8_WAIT_V(n) asm volatile("s_waitcnt vmcnt(" #n ")" ::: "memory")
#define PG8_WAIT_L(n) asm volatile("s_waitcnt lgkmcnt(" #n ")" ::: "memory")
#define PG8_BAR __builtin_amdgcn_s_barrier()
#define PG8_SCHED __builtin_amdgcn_sched_barrier(0)
#define PG8_UA(u) ((const char*)g.A + (size_t)(u).pm * tstepA + (((u).pn >= g.split_pn) ? (size_t)g.split_aoff * 2 : (size_t)0))
    Unit cur, nxt; int ui = 0;
    if (!S.next(0, cur)) return;
    f32x4 acc[2][2][4][2];
#pragma unroll
    for (int a = 0; a < 2; ++a)
#pragma unroll
        for (int b = 0; b < 2; ++b)
#pragma unroll
            for (int m = 0; m < 4; ++m)
#pragma unroll
                for (int n = 0; n < 2; ++n) acc[a][b][m][n] = (f32x4){0.f, 0.f, 0.f, 0.f};
    bf16x8 At[4][2], B0[2][2], B1[2][2];
    const char* cA = PG8_UA(cur); const char* cB = (const char*)g.Bt + (size_t)cur.pn * tstepB;
    PG8_STAGE(PG8_SB(0, 0), cB, voffB); PG8_STAGE(PG8_SB(0, 1), cB + hstepB, voffB); PG8_STAGE(PG8_SA(0, 0), cA, voffA); PG8_STAGE(PG8_SA(0, 1), cA + hstepA, voffA);
    if (wr == 1) PG8_BAR;
    PG8_WAIT_V(2); PG8_BAR;
    PG8_STAGE(PG8_SB(1, 0), cB + kstep, voffB); PG8_STAGE(PG8_SA(1, 0), cA + kstep, voffA); PG8_STAGE(PG8_SB(1, 1), cB + hstepB + kstep, voffB);
    PG8_WAIT_V(6); PG8_BAR;
    for (;;) {
        const bool has_next = S.next(ui + 1, nxt);
        const char* nA = has_next ? PG8_UA(nxt) : cA; const char* nB = has_next ? (const char*)g.Bt + (size_t)nxt.pn * tstepB : cB;
        for (int t = 0; t < nt; t += 2) {
            if constexpr (Epi::HAS_MID) { if (t == g.mid_t) E.mid(acc, cur, wr, wc, fr, fq); }
            const bool last = (t == nt - 2);
            const char* a1 = cA + (size_t)(t + 1) * kstep;
            const char* a2 = last ? nA : cA + (size_t)(t + 2) * kstep; const char* b2 = last ? nB : cB + (size_t)(t + 2) * kstep;
            const char* a3 = a2 + kstep; const char* b3 = b2 + kstep;
            PG8_LDB(B0, 0, 0); PG8_LDB(B1, 0, 1); PG8_SCHED; PG8_LDA(At, 0, 0); PG8_STAGE(PG8_SA(1, 1), a1 + hstepA, voffA);
            PG8_WAIT_V(8); PG8_WAIT_L(0); PG8_BAR; PG8_MMA(0, 0, At, B0); PG8_MMA(0, 1, At, B1); PG8_BAR; PG8_SCHED;
            PG8_LDA(At, 0, 1); PG8_STAGE(PG8_SB(0, 0), b2, voffB); PG8_STAGE(PG8_SB(0, 1), b2 + hstepB, voffB); PG8_STAGE(PG8_SA(0, 0), a2, voffA);
            PG8_WAIT_V(8); PG8_WAIT_L(0); PG8_BAR; PG8_MMA(1, 0, At, B0); PG8_MMA(1, 1, At, B1); PG8_BAR; PG8_SCHED;
            PG8_LDB(B0, 1, 0); PG8_LDB(B1, 1, 1); PG8_SCHED; PG8_LDA(At, 1, 0); PG8_STAGE(PG8_SA(0, 1), a2 + hstepA, voffA);
            PG8_WAIT_V(8); PG8_WAIT_L(0); PG8_BAR; PG8_MMA(0, 0, At, B0); PG8_MMA(0, 1, At, B1); PG8_BAR; PG8_SCHED;
            PG8_LDA(At, 1, 1); PG8_STAGE(PG8_SB(1, 0), b3, voffB); PG8_STAGE(PG8_SB(1, 1), b3 + hstepB, voffB); PG8_STAGE(PG8_SA(1, 0), a3, voffA);
            PG8_WAIT_V(8); PG8_WAIT_L(0); PG8_BAR; PG8_MMA(1, 0, At, B0); PG8_MMA(1, 1, At, B1); PG8_BAR; PG8_SCHED;
        }
        if (wr == 0) PG8_BAR;
        E(acc, cur, wr, wc, fr, fq);
        if (!has_next) break;
#pragma unroll
        for (int a = 0; a < 2; ++a)
#pragma unroll
            for (int b = 0; b < 2; ++b)
#pragma unroll
                for (int m = 0; m < 4; ++m)
#pragma unroll
                    for (int n = 0; n < 2; ++n) acc[a][b][m][n] = (f32x4){0.f, 0.f, 0.f, 0.f};
        cur = nxt; cA = nA; cB = nB; ++ui;
        if (wr == 1) PG8_BAR;
    }
    PG8_WAIT_V(0);
    PG8_BAR;
#undef PG8_SA
#undef PG8_SB
#undef PG8_STAGE
#undef PG8_LDA
#undef PG8_LDB
#undef PG8_MMA
#undef PG8_UA
}
}

__device__ __forceinline__ float row_rs(const float* rsp, int row) {
    const f32x4* p = (const f32x4*)(rsp + (size_t)row * 16);
    f32x4 a = p[0], b = p[1], c = p[2], d = p[3];
    float s = ((a.x + a.y) + (a.z + a.w)) + ((b.x + b.y) + (b.z + b.w)) + ((c.x + c.y) + (c.z + c.w)) + ((d.x + d.y) + (d.z + d.w));
    return __builtin_amdgcn_rsqf(s * (1.0f / Dm) + EPS);
}
__device__ __forceinline__ void rows_rs4(const float* rsp, int row0  , float (&rs)[4]) {
#pragma unroll
    for (int mp = 0; mp < 2; ++mp) {
        f32x4 p[2][4];
#pragma unroll
        for (int m = 0; m < 2; ++m) { const f32x4* q = (const f32x4*)(rsp + (size_t)(row0 + 16 * (2 * mp + m)) * 16);
#pragma unroll
            for (int i = 0; i < 4; ++i) p[m][i] = q[i]; }
#pragma unroll
        for (int m = 0; m < 2; ++m) { float t = 0.f;
#pragma unroll
            for (int i = 0; i < 4; ++i) t += (p[m][i].x + p[m][i].y) + (p[m][i].z + p[m][i].w);
            rs[2 * mp + m] = __builtin_amdgcn_rsqf(t * (1.0f / Dm) + EPS); }
        __builtin_amdgcn_sched_barrier(0);
    }
}
__device__ __forceinline__ void rows_rs2(const float* rsp, int row0, float (&rs)[2]) {
    f32x4 p[2][4];
#pragma unroll
    for (int m = 0; m < 2; ++m) { const f32x4* q = (const f32x4*)(rsp + (size_t)(row0 + 16 * m) * 16);
#pragma unroll
        for (int i = 0; i < 4; ++i) p[m][i] = q[i]; }
#pragma unroll
    for (int m = 0; m < 2; ++m) { float t = 0.f;
#pragma unroll
        for (int i = 0; i < 4; ++i) t += (p[m][i].x + p[m][i].y) + (p[m][i].z + p[m][i].w);
        rs[m] = __builtin_amdgcn_rsqf(t * (1.0f / Dm) + EPS); }
}
__device__ __forceinline__ u32x4 pack8(const float* v) { u32x4 w; w.x = pk2(v[0], v[1]); w.y = pk2(v[2], v[3]); w.z = pk2(v[4], v[5]); w.w = pk2(v[6], v[7]); return w; }

struct EpiMix {
    static constexpr bool HAS_MID = false;
    const float* rsp; const float* cs; const float* lbF; const float* lbB;
    bf16_t *Q, *Kk, *V, *HQ, *HV, *BG, *GF, *GB;
    template <int GRP>
    __device__ __forceinline__ void run(const f32x4 (&acc)[2][2][4][2], const pg8::Unit& u, int wr, int wc, int fr, int fq) const {
#pragma unroll
        for (int ai = 0; ai < 2; ++ai)
#pragma unroll
        for (int mp = 0; mp < 2; ++mp) {
            const int row0 = u.pm * 256 + ai * 128 + wr * 64 + mp * 32 + fr;
            float rs4[2]; rows_rs2(rsp, row0, rs4);
            const int d0r = (wc * 32 + fq * 8) & 63;
            f32x4 c4r[2], s4r[2];
            if constexpr (GRP <= 1) {
                if (d0r < 16) {
#pragma unroll
                    for (int mm = 0; mm < 2; ++mm) { const float* cp = cs + (size_t)(row0 + 16 * mm) * 16 + (d0r >> 3) * 4; c4r[mm] = *(const f32x4*)cp; s4r[mm] = *(const f32x4*)(cp + 8); }
                }
            }
            __builtin_amdgcn_sched_barrier(0);
#pragma unroll
            for (int mm = 0; mm < 2; ++mm) {
                const int m = 2 * mp + mm;
                const int row = row0 + mm * 16;
                const float rs = rs4[mm];
                const int b = row >> 12, s = row & 4095;
#pragma unroll
                for (int bj = 0; bj < 2; ++bj) {
                    const int col = u.pn * 256 + bj * 128 + wc * 32 + fq * 8;
                    const int jj = col & 511;
                    float v[8];
#pragma unroll
                    for (int e = 0; e < 4; ++e) { v[e] = acc[ai][bj][m][0][e] * rs; v[4 + e] = acc[ai][bj][m][1][e] * rs; }
                    if constexpr (GRP <= 1) {
                        const int d0 = jj & 63;
                        if (d0 < 16) {
                            const f32x4 c4 = c4r[mm], s4 = s4r[mm];
#pragma unroll
                            for (int e = 0; e < 4; ++e) { const float t1 = v[e], t2 = v[4 + e]; v[e] = t1 * c4[e] - t2 * s4[e]; v[4 + e] = t2 * c4[e] + t1 * s4[e]; }
                        }
                        if constexpr (GRP == 0) {
#pragma unroll
                            for (int e = 0; e < 8; ++e) v[e] *= 0.125f * LOG2E;
                        }
                        const int h = jj >> 7, c = (jj >> 6) & 1;
                        bf16_t* dst = (GRP == 0 ? Q : Kk) + ((size_t)(((b * 4 + h) * 2 + c) * SEQ + s)) * 64 + d0;
                        *(u32x4*)dst = pack8(v);
                    } else if constexpr (GRP == 2) {
                        const int h = jj >> 7, d0 = jj & 127;
                        *(u32x4*)(V + ((size_t)((b * 4 + h) * SEQ + s)) * 128 + d0) = pack8(v);
                    } else if constexpr (GRP == 3) {
                        *(u32x4*)(HQ + (size_t)row * 512 + jj) = pack8(v);
                    } else if constexpr (GRP == 4 || GRP == 5) {
                        const float* lbp = (GRP == 4 ? lbF : lbB) + jj;
                        const f32x4 l0 = *(const f32x4*)lbp, l1 = *(const f32x4*)(lbp + 4);
                        float gl[8];
#pragma unroll
                        for (int e = 0; e < 8; ++e) { const float lb = e < 4 ? l0[e] : l1[e - 4]; const float f = lb + (1.0f - lb) * sigmoidf_(v[e]); gl[e] = __builtin_amdgcn_logf(fmaxf(f, 1e-37f)) * 0.6931471805599453f; }
                        *(u32x4*)((GRP == 4 ? GF : GB) + (size_t)row * 512 + jj) = pack8(gl);
                    } else if constexpr (GRP == 6) {
                        *(u32x4*)(HV + (size_t)row * 512 + jj) = pack8(v);
                    } else {
#pragma unroll
                        for (int e = 0; e < 8; ++e) v[e] = sigmoidf_(v[e]);
                        *(u32x4*)(BG + (size_t)row * 512 + jj) = pack8(v);
                    }
                }
            }
            __builtin_amdgcn_sched_barrier(0);
        }
    }
    __device__ __forceinline__ void operator()(const f32x4 (&acc)[2][2][4][2], const pg8::Unit& u, int wr, int wc, int fr, int fq) const {
        switch (u.pn >> 1) {
            case 0: run<0>(acc, u, wr, wc, fr, fq); break;
            case 1: run<1>(acc, u, wr, wc, fr, fq); break;
            case 2: run<2>(acc, u, wr, wc, fr, fq); break;
            case 3: run<3>(acc, u, wr, wc, fr, fq); break;
            case 4: run<4>(acc, u, wr, wc, fr, fq); break;
            case 5: run<5>(acc, u, wr, wc, fr, fq); break;
            case 6: run<6>(acc, u, wr, wc, fr, fq); break;
            default: run<7>(acc, u, wr, wc, fr, fq); break;
        }
    }
};

struct EpiGate {
    static constexpr bool HAS_MID = false;
    const float* rsp; bf16_t* G;
    __device__ __forceinline__ void operator()(const f32x4 (&acc)[2][2][4][2], const pg8::Unit& u, int wr, int wc, int fr, int fq) const {
#pragma unroll
        for (int ai = 0; ai < 2; ++ai) {
            const int row0 = u.pm * 256 + ai * 128 + wr * 64 + fr;
            float rs4[4]; rows_rs4(rsp, row0, rs4);
            __builtin_amdgcn_sched_barrier(0);
#pragma unroll
            for (int m = 0; m < 4; ++m) {
                const int row = row0 + m * 16;
                const float rs = rs4[m];
                const int col = u.pn * 128 + wc * 32 + fq * 8;
                float r[8], sb[8];
                const float nrl = -rs * LOG2E;
#pragma unroll
                for (int n = 0; n < 2; ++n) {
                    f32x4 ta = acc[ai][0][m][n] * nrl, tb = acc[ai][1][m][n] * nrl;
                    ta = __builtin_elementwise_min(ta, (f32x4){86.f, 86.f, 86.f, 86.f}); tb = __builtin_elementwise_min(tb, (f32x4){86.f, 86.f, 86.f, 86.f});
                    ta.x = __builtin_amdgcn_exp2f(ta.x); ta.y = __builtin_amdgcn_exp2f(ta.y); ta.z = __builtin_amdgcn_exp2f(ta.z); ta.w = __builtin_amdgcn_exp2f(ta.w);
                    tb.x = __builtin_amdgcn_exp2f(tb.x); tb.y = __builtin_amdgcn_exp2f(tb.y); tb.z = __builtin_amdgcn_exp2f(tb.z); tb.w = __builtin_amdgcn_exp2f(tb.w);
                    ta = ta + 1.0f; tb = tb + 1.0f;
                    f32x4 ia, ib;
                    ia.x = __builtin_amdgcn_rcpf(ta.x); ia.y = __builtin_amdgcn_rcpf(ta.y); ia.z = __builtin_amdgcn_rcpf(ta.z); ia.w = __builtin_amdgcn_rcpf(ta.w);
                    ib.x = __builtin_amdgcn_rcpf(tb.x); ib.y = __builtin_amdgcn_rcpf(tb.y); ib.z = __builtin_amdgcn_rcpf(tb.z); ib.w = __builtin_amdgcn_rcpf(tb.w);
                    const f32x4 rr = tb * ia;
                    r[n * 4] = rr.x; r[n * 4 + 1] = rr.y; r[n * 4 + 2] = rr.z; r[n * 4 + 3] = rr.w;
                    sb[n * 4] = ib.x; sb[n * 4 + 1] = ib.y; sb[n * 4 + 2] = ib.z; sb[n * 4 + 3] = ib.w;
                }
                *(u32x4*)(G + (size_t)row * 2048 + col) = pack8(r);
                *(u32x4*)(G + (size_t)row * 2048 + 1024 + col) = pack8(sb);
            }
            __builtin_amdgcn_sched_barrier(0);
        }
    }
};

struct EpiY {
    static constexpr bool HAS_MID = true;
    const bf16_t* G; bf16_t* Y;
    __device__ __forceinline__ void mid(f32x4 (&acc)[2][2][4][2], const pg8::Unit& u, int wr, int wc, int fr, int fq) const {
        int fr_ = fr; asm volatile("" : "+v"(fr_));
#pragma unroll
        for (int ai = 0; ai < 2; ++ai) {
            __builtin_amdgcn_sched_barrier(0);
#pragma unroll
            for (int m = 0; m < 4; ++m) {
                const int row = u.pm * 256 + ai * 128 + wr * 64 + m * 16 + fr_;
#pragma unroll
                for (int bj = 0; bj < 2; ++bj) {
                    const int col = u.pn * 256 + bj * 128 + wc * 32 + fq * 8;
                    const u32x4 gq = *(const u32x4*)(G + (size_t)row * 2048 + col);
                    acc[ai][bj][m][0][0] *= bflo(gq.x); acc[ai][bj][m][0][1] *= bfhi(gq.x); acc[ai][bj][m][0][2] *= bflo(gq.y); acc[ai][bj][m][0][3] *= bfhi(gq.y);
                    acc[ai][bj][m][1][0] *= bflo(gq.z); acc[ai][bj][m][1][1] *= bfhi(gq.z); acc[ai][bj][m][1][2] *= bflo(gq.w); acc[ai][bj][m][1][3] *= bfhi(gq.w);
                }
            }
        }
        __builtin_amdgcn_sched_barrier(0);
    }
    __device__ __forceinline__ void operator()(const f32x4 (&acc)[2][2][4][2], const pg8::Unit& u, int wr, int wc, int fr, int fq) const {
#pragma unroll
        for (int ai = 0; ai < 2; ++ai) {
            u32x4 gqr[4][2];
#pragma unroll
            for (int m = 0; m < 4; ++m)
#pragma unroll
                for (int bj = 0; bj < 2; ++bj) gqr[m][bj] = *(const u32x4*)(G + (size_t)(u.pm * 256 + ai * 128 + wr * 64 + m * 16 + fr) * 2048 + 1024 + u.pn * 256 + bj * 128 + wc * 32 + fq * 8);
            __builtin_amdgcn_sched_barrier(0);
#pragma unroll
            for (int m = 0; m < 4; ++m) {
                const int row = u.pm * 256 + ai * 128 + wr * 64 + m * 16 + fr;
#pragma unroll
                for (int bj = 0; bj < 2; ++bj) {
                    const int col = u.pn * 256 + bj * 128 + wc * 32 + fq * 8;
                    const u32x4 gq = gqr[m][bj];
                    float v[8];
                    v[0] = acc[ai][bj][m][0][0] * bflo(gq.x); v[1] = acc[ai][bj][m][0][1] * bfhi(gq.x);
                    v[2] = acc[ai][bj][m][0][2] * bflo(gq.y); v[3] = acc[ai][bj][m][0][3] * bfhi(gq.y);
                    v[4] = acc[ai][bj][m][1][0] * bflo(gq.z); v[5] = acc[ai][bj][m][1][1] * bfhi(gq.z);
                    v[6] = acc[ai][bj][m][1][2] * bflo(gq.w); v[7] = acc[ai][bj][m][1][3] * bfhi(gq.w);
                    *(u32x4*)(Y + (size_t)row * 1024 + col) = pack8(v);
                }
            }
            __builtin_amdgcn_sched_barrier(0);
        }
    }
};

struct EpiRes {
    static constexpr bool HAS_MID = false;
    const float* xres; float* xout; bf16_t* XB; float* rsp;
    __device__ __forceinline__ void operator()(const f32x4 (&acc)[2][2][4][2], const pg8::Unit& u, int wr, int wc, int fr, int fq) const {
#pragma unroll
        for (int ai = 0; ai < 2; ++ai)
#pragma unroll
        for (int mp = 0; mp < 2; ++mp) {
            f32x4 xr0[2][2], xr1[2][2];
#pragma unroll
            for (int mm = 0; mm < 2; ++mm)
#pragma unroll
                for (int bj = 0; bj < 2; ++bj) { const float* xr = xres + (size_t)(u.pm * 256 + ai * 128 + wr * 64 + (2 * mp + mm) * 16 + fr) * Dm + u.pn * 256 + bj * 128 + wc * 32 + fq * 8;
                    xr0[mm][bj] = *(const f32x4*)xr; xr1[mm][bj] = *(const f32x4*)(xr + 4); }
            __builtin_amdgcn_sched_barrier(0);
#pragma unroll
            for (int mm = 0; mm < 2; ++mm) {
                const int m = 2 * mp + mm;
                const int row = u.pm * 256 + ai * 128 + wr * 64 + m * 16 + fr;
                float ss = 0.f;
#pragma unroll
                for (int bj = 0; bj < 2; ++bj) {
                    const int col = u.pn * 256 + bj * 128 + wc * 32 + fq * 8;
                    const f32x4 x0 = xr0[mm][bj], x1 = xr1[mm][bj];
                    float v[8];
#pragma unroll
                    for (int e = 0; e < 4; ++e) { v[e] = x0[e] + acc[ai][bj][m][0][e]; v[4 + e] = x1[e] + acc[ai][bj][m][1][e]; }
#pragma unroll
                    for (int e = 0; e < 8; ++e) ss += v[e] * v[e];
                    float* xo = xout + (size_t)row * Dm + col;
                    *(f32x4*)xo = (f32x4){v[0], v[1], v[2], v[3]}; *(f32x4*)(xo + 4) = (f32x4){v[4], v[5], v[6], v[7]};
                    *(u32x4*)(XB + (size_t)row * Dm + col) = pack8(v);
                }
                ss += __shfl_xor(ss, 16); ss += __shfl_xor(ss, 32);
                if (fq == 0) rsp[(size_t)row * 16 + u.pn * 4 + wc] = ss;
            }
            __builtin_amdgcn_sched_barrier(0);
        }
    }
};

struct EpiGU {
    static constexpr bool HAS_MID = false;
    const float* rsp; bf16_t* H;
    __device__ __forceinline__ void operator()(const f32x4 (&acc)[2][2][4][2], const pg8::Unit& u, int wr, int wc, int fr, int fq) const {
#pragma unroll
        for (int ai = 0; ai < 2; ++ai) {
            const int row0 = u.pm * 256 + ai * 128 + wr * 64 + fr;
            float rs4[4]; rows_rs4(rsp, row0, rs4);
            __builtin_amdgcn_sched_barrier(0);
#pragma unroll
            for (int m = 0; m < 4; ++m) {
                const int row = row0 + m * 16;
                const float rs = rs4[m];
                const int col = u.pn * 128 + wc * 32 + fq * 8;
                float v[8];
                const float nrl = -rs * LOG2E, rs2 = rs * rs;
#pragma unroll
                for (int n = 0; n < 2; ++n) {
                    const f32x4 a = acc[ai][0][m][n], b = acc[ai][1][m][n];
                    f32x4 t = a * nrl;
                    t.x = __builtin_amdgcn_exp2f(t.x); t.y = __builtin_amdgcn_exp2f(t.y); t.z = __builtin_amdgcn_exp2f(t.z); t.w = __builtin_amdgcn_exp2f(t.w);
                    t = t + 1.0f;
                    t.x = __builtin_amdgcn_rcpf(t.x); t.y = __builtin_amdgcn_rcpf(t.y); t.z = __builtin_amdgcn_rcpf(t.z); t.w = __builtin_amdgcn_rcpf(t.w);
                    const f32x4 o = ((a * b) * rs2) * t;
                    v[n * 4] = o.x; v[n * 4 + 1] = o.y; v[n * 4 + 2] = o.z; v[n * 4 + 3] = o.w;
                }
                *(u32x4*)(H + (size_t)row * FF + col) = pack8(v);
            }
            __builtin_amdgcn_sched_barrier(0);
        }
    }
};

__device__ __forceinline__ int rope_perm(int n) {
    const int d = n & 63; if (d >= 16) return n;
    const int g = d >> 3, e = d & 7; return (n & ~63) + ((e < 4) ? 4 * g + e : 8 + 4 * g + (e - 4));
}
__device__ __forceinline__ void conv_item(const float* src, int ld_src, int ks0, int c0  , int mode  ,
                                          const float* gain, bf16_t* dst, int ld_dst, int n0, int kd0, LAS float* scr, int lane) {
    const int n4 = lane & 7, kr = lane >> 3;
    int sc = c0 + 4 * n4;
    if (mode) { const int q = (sc & 63) >> 2; if (q == 1) sc += 4; else if (q == 2) sc -= 4; }
#pragma unroll
    for (int i = 0; i < 8; ++i) { const int kk = kr + 8 * i; f32x4 w = *(const f32x4*)(src + (size_t)(ks0 + kk) * ld_src + sc);
        if (gain) { const float gg = gain[ks0 + kk]; w.x *= gg; w.y *= gg; w.z *= gg; w.w *= gg; }
        LAS float* d = scr + kk * 33 + 4 * n4; d[0] = w.x; d[1] = w.y; d[2] = w.z; d[3] = w.w; }
    asm volatile("s_waitcnt lgkmcnt(0)" ::: "memory");
    const int c = lane & 7;
#pragma unroll
    for (int j = 0; j < 4; ++j) { const int n = (lane >> 3) + 8 * j; const LAS float* s = scr + (8 * c) * 33 + n;
        u32x4 o; o.x = pk2(s[0 * 33], s[1 * 33]); o.y = pk2(s[2 * 33], s[3 * 33]); o.z = pk2(s[4 * 33], s[5 * 33]); o.w = pk2(s[6 * 33], s[7 * 33]);
        *(u32x4*)(dst + (size_t)(n0 + n) * ld_dst + kd0 + 8 * c) = o; }
    asm volatile("s_waitcnt lgkmcnt(0)" ::: "memory");
}

struct Ptrs {
    const float *x; const int* pos; const float *w_in, *da_lambda, *da_norm, *hg_lb, *hg_norm, *w_a, *w_b, *w_o, *attn_norm, *ffn_norm, *w_gate, *w_up, *w_down, *final_norm;
    float* out; unsigned char* ws; int ph_lo, ph_hi;
};

__device__ __forceinline__ void convert_layer(const Ptrs& P, int layer, unsigned char* wbuf, LAS unsigned char* lds, int gw, int ngw, int wave, int lane) {
    LAS float* scr = (LAS float*)(lds + wave * 8704);
    constexpr int I_IN = 16 * 192, I_A = 8 * 32, I_B = 8 * 32, I_O = 16 * 32, I_GU = 16 * 176, I_D = 44 * 32;
    constexpr int NIT = I_IN + I_A + I_B + I_O + I_GU + I_D;
    for (int it = gw; it < NIT; it += ngw) {
        int r = it;
        if (r < I_IN) { const int kb = r / 192, nb = r % 192, n0 = nb * 32;
            int c0 = n0; if (n0 >= 4096) { const int q = n0 - 4096, tile = q >> 8, rr = q & 255; c0 = (rr < 128 ? 4096 : 5120) + tile * 128 + (rr & 127); }
            conv_item(P.w_in + (size_t)layer * Dm * INW, INW, kb * 64, c0, n0 < 1024 ? 1 : 0, P.attn_norm + layer * Dm, (bf16_t*)(wbuf + W_IN), Dm, n0, kb * 64, scr, lane); continue; }
        r -= I_IN;
        if (r < I_A) { const int kb = r / 32, nb = r % 32;
            conv_item(P.w_a + (size_t)layer * 512 * Dm, Dm, kb * 64, nb * 32, 0, nullptr, (bf16_t*)(wbuf + W_AB), 1024, nb * 32, kb * 64, scr, lane); continue; }
        r -= I_A;
        if (r < I_B) { const int kb = r / 32, nb = r % 32;
            conv_item(P.w_b + (size_t)layer * 512 * Dm, Dm, kb * 64, nb * 32, 0, nullptr, (bf16_t*)(wbuf + W_AB), 1024, nb * 32, 512 + kb * 64, scr, lane); continue; }
        r -= I_B;
        if (r < I_O) { const int kb = r / 32, nb = r % 32;
            conv_item(P.w_o + (size_t)layer * Dm * Dm, Dm, kb * 64, nb * 32, 0, nullptr, (bf16_t*)(wbuf + W_O2), Dm, nb * 32, kb * 64, scr, lane); continue; }
        r -= I_O;
        if (r < I_GU) { const int kb = r / 176, nb = r % 176, n0 = nb * 32, tile = n0 >> 8, rr = n0 & 255;
            const float* srcm = (rr < 128 ? P.w_gate : P.w_up) + (size_t)layer * Dm * FF;
            conv_item(srcm, FF, kb * 64, tile * 128 + (rr & 127), 0, P.ffn_norm + layer * Dm, (bf16_t*)(wbuf + W_GU), Dm, n0, kb * 64, scr, lane); continue; }
        r -= I_GU;
        { const int kb = r / 32, nb = r % 32;
            conv_item(P.w_down + (size_t)layer * FF * Dm, Dm, kb * 64, nb * 32, 0, nullptr, (bf16_t*)(wbuf + W_D), FF, nb * 32, kb * 64, scr, lane); }
    }
}

__device__ __forceinline__ float wave_sum(float v) {
#pragma unroll
    for (int o = 1; o < 64; o <<= 1) v += __shfl_xor(v, o);
    return v;
}
__device__ __forceinline__ void prologue(const Ptrs& P, LAS unsigned char* lds, int gw, int ngw, int wave, int lane) {
    unsigned char* ws = P.ws;
    bf16_t* XB = (bf16_t*)(ws + OFF_XB); float* rsb = (float*)(ws + OFF_RSB);
    for (int r = gw; r < M; r += ngw) {
        const f32x4* xr = (const f32x4*)(P.x + (size_t)r * Dm) + lane;
        float ss = 0.f;
#pragma unroll
        for (int j = 0; j < 4; ++j) { const f32x4 v = xr[64 * j]; ss += (v.x * v.x + v.y * v.y) + (v.z * v.z + v.w * v.w);
            u32x2 o; o.x = pk2(v.x, v.y); o.y = pk2(v.z, v.w); *((u32x2*)(XB + (size_t)r * Dm) + lane + 64 * j) = o; }
        ss = wave_sum(ss);
        if (lane < 16) rsb[(size_t)r * 16 + lane] = (lane == 0) ? ss : 0.f;
    }
    const int gt = gw * 64 + lane, ngt = ngw * 64;
    float* cs = (float*)(ws + OFF_CS);
    for (int i = gt; i < M * 8; i += ngt) {
        const int tok = i >> 3, f = i & 7;
        const double invf[8] = {1.0, 0.19392274474868576, 0.03760603093086393, 0.007292664737217109, 0.001414213562373095, 0.0002742481756762073, 5.318295896944988e-05, 1.031338537721246e-05};
        double fr;
        switch (f) { case 0: fr = invf[0]; break; case 1: fr = invf[1]; break; case 2: fr = invf[2]; break; case 3: fr = invf[3]; break; case 4: fr = invf[4]; break; case 5: fr = invf[5]; break; case 6: fr = invf[6]; break; default: fr = invf[7]; }
        const float ang32 = (float)P.pos[tok] * (float)fr;
        const double ang = (double)ang32;
        const double rev = ang * 0.15915494309189535;
        const double fracrev = rev - __builtin_floor(rev + 0.5);
        const float a = (float)(fracrev * 6.283185307179586);
        cs[(size_t)tok * 16 + f] = __cosf(a); cs[(size_t)tok * 16 + 8 + f] = __sinf(a);
    }
    float* LB = (float*)(ws + OFF_LB);
    for (int i = gt; i < 2 * 512; i += ngt) {
        const int d = i >> 9, k = i & 511;
        float l[4], mx = -1e30f;
#pragma unroll
        for (int j = 0; j < 4; ++j) { l[j] = P.hg_lb[(size_t)(d * 4 + j) * 512 + k]; mx = fmaxf(mx, l[j]); }
        float e[4], sum = 0.f;
#pragma unroll
        for (int j = 0; j < 4; ++j) { e[j] = __expf(l[j] - mx); sum += e[j]; }
        float cum = 0.f;
#pragma unroll
        for (int j = 0; j < 4; ++j) { if (j > 0) cum += e[j] / sum; LB[(size_t)(d * 4 + j) * 512 + k] = cum; }
    }
    if (gw == 0) {
        float* LAM = (float*)(ws + OFF_LAM);
        for (int l = 0; l < 4; ++l) {
            const float* p = P.da_lambda + l * 256;
            float a = wave_sum(p[lane] * p[64 + lane]), b = wave_sum(p[128 + lane] * p[192 + lane]);
            const float lam_init = 0.8f - 0.6f * __expf(-0.3f * (float)l);
            if (lane == 0) LAM[l] = __expf(a) - __expf(b) + lam_init;
        }
    }
}

constexpr int AT_KROW = 144, AT_VROW = 320, AT_K1 = 64 * AT_KROW, AT_V = 2 * AT_K1, AT_STG = AT_V + 64 * AT_VROW;
constexpr int AT_IMG_ROW = 132;
__device__ __forceinline__ s16x4 tr_read(const LAS unsigned char* p) { return __builtin_bit_cast(s16x4, __builtin_amdgcn_ds_read_tr16_b64_v4i16((LAS s16x4*)p)); }

__device__ __forceinline__ void attn_unit(int b, int h, int qb, const bf16_t* Q, const bf16_t* Kk, const bf16_t* V, bf16_t* AO, const float* gainA  , float one_minus_lam_init, float lam, LAS unsigned char* lds) {
    int tid_ = threadIdx.x; asm volatile("" : "+v"(tid_));
    const int tid = tid_, wave = __builtin_amdgcn_readfirstlane(tid >> 6), lane = tid & 63, c = wave >> 2, wq = wave & 3, r32 = lane & 31, hh = lane >> 5;
    const int q0 = qb * 128 + wq * 32;
    bf16x8 qf[4];
    { const bf16_t* Qp = Q + ((size_t)(((b * 4 + h) * 2 + c) * SEQ + q0 + r32)) * 64 + 8 * hh;
#pragma unroll
      for (int s = 0; s < 4; ++s) qf[s] = *(const bf16x8*)(Qp + 16 * s); }
    f32x16 o[4];
#pragma unroll
    for (int i = 0; i < 4; ++i)
#pragma unroll
        for (int e = 0; e < 16; ++e) o[i][e] = 0.f;
    float mrow = -1e30f, lrow = 0.f;
    const unsigned char* Kg0 = (const unsigned char*)(Kk + ((size_t)((b * 4 + h) * 2 + 0) * SEQ) * 64);
    const unsigned char* Kg1 = (const unsigned char*)(Kk + ((size_t)((b * 4 + h) * 2 + 1) * SEQ) * 64);
    const unsigned char* Vg = (const unsigned char*)(V + ((size_t)(b * 4 + h) * SEQ) * 128);
    const int lk = (tid >> 3) * AT_KROW + (tid & 7) * 16;
    const int lv0 = AT_V + (tid >> 4) * AT_VROW + (tid & 15) * 16, lv1 = lv0 + 32 * AT_VROW;
    u32x4 r0, r1, r2, r3;
    r0 = *(const u32x4*)(Kg0 + tid * 16); r1 = *(const u32x4*)(Kg1 + tid * 16); r2 = *(const u32x4*)(Vg + tid * 16); r3 = *(const u32x4*)(Vg + 8192 + tid * 16);
    *(LAS u32x4*)(lds + lk) = r0; *(LAS u32x4*)(lds + AT_K1 + lk) = r1; *(LAS u32x4*)(lds + lv0) = r2; *(LAS u32x4*)(lds + lv1) = r3;
    r0 = *(const u32x4*)(Kg0 + 8192 + tid * 16); r1 = *(const u32x4*)(Kg1 + 8192 + tid * 16);
    *(LAS u32x4*)(lds + AT_STG + lk) = r0; *(LAS u32x4*)(lds + AT_STG + AT_K1 + lk) = r1;
    __syncthreads();
    const int ka = c * AT_K1 + r32 * AT_KROW + hh * 16;
    const int va = AT_V + (4 * hh + ((lane & 15) >> 2)) * AT_VROW + ((lane >> 4) & 1) * 32 + (lane & 3) * 8;

#define AT_QK(sv, st) do { f32x16 t0_, t1_; _Pragma("unroll") for (int e = 0; e < 16; ++e) { t0_[e] = 0.f; t1_[e] = 0.f; } \
        _Pragma("unroll") for (int ks = 0; ks < 4; ++ks) { \
            const bf16x8 a0 = *(const LAS bf16x8*)(lds + (st) + ka + ks * 32), a1 = *(const LAS bf16x8*)(lds + (st) + ka + 32 * AT_KROW + ks * 32); \
            t0_ = __builtin_amdgcn_mfma_f32_32x32x16_bf16(a0, qf[ks], t0_, 0, 0, 0); t1_ = __builtin_amdgcn_mfma_f32_32x32x16_bf16(a1, qf[ks], t1_, 0, 0, 0); } \
        sv##0 = t0_; sv##1 = t1_; } while (0)
    f32x16 sA0, sA1, sB0, sB1;
    AT_QK(sA, 0);
#define AT_VFRAG(dst, STC, g) do { const LAS unsigned char* vb_ = lds + (STC) + va + (16 * (g)) * AT_VROW; \
        _Pragma("unroll") for (int vt = 0; vt < 4; ++vt) { const s16x4 t0 = tr_read(vb_ + vt * 64), t1 = tr_read(vb_ + vt * 64 + 8 * AT_VROW); \
            dst[vt] = (bf16x8){t0[0], t0[1], t0[2], t0[3], t1[0], t1[1], t1[2], t1[3]}; } } while (0)
#define AT_PV(vf, p) do { __builtin_amdgcn_s_setprio(1); _Pragma("unroll") for (int vt = 0; vt < 4; ++vt) o[vt] = __builtin_amdgcn_mfma_f32_32x32x16_bf16(vf[vt], p, o[vt], 0, 0, 0); __builtin_amdgcn_s_setprio(0); } while (0)
#define AT_SB __builtin_amdgcn_sched_barrier(0)
#define AT_TILE(j, s0, s1, sn, STC  , STN  ) do { \
        if ((j) + 2 < 64) { const size_t go = (size_t)((j) + 2) * 8192; r0 = *(const u32x4*)(Kg0 + go + tid * 16); r1 = *(const u32x4*)(Kg1 + go + tid * 16); } \
        if ((j) + 1 < 64) { const size_t go = (size_t)((j) + 1) * 16384; r2 = *(const u32x4*)(Vg + go + tid * 16); r3 = *(const u32x4*)(Vg + go + 8192 + tid * 16); } \
        bf16x8 kf[4], kg[4], vA[4]; \
        if ((j) + 1 < 64) { _Pragma("unroll") for (int ks = 0; ks < 2; ++ks) { kf[2 * ks] = *(const LAS bf16x8*)(lds + (STN) + ka + ks * 32); kf[2 * ks + 1] = *(const LAS bf16x8*)(lds + (STN) + ka + 32 * AT_KROW + ks * 32); } } \
        AT_SB; \
        float mx = fmaxf(s0[0], s1[0]); \
        _Pragma("unroll") for (int e = 1; e < 16; ++e) mx = fmaxf(mx, fmaxf(s0[e], s1[e])); \
        mx = fmaxf(mx, __shfl_xor(mx, 32)); \
        if (__builtin_amdgcn_ballot_w64(mx > mrow + 8.0f) != 0ull) { \
            const float mnew = fmaxf(mrow, mx), alpha = __builtin_amdgcn_exp2f(mrow - mnew); mrow = mnew; lrow *= alpha; \
            _Pragma("unroll") for (int i = 0; i < 4; ++i) _Pragma("unroll") for (int e = 0; e < 16; ++e) o[i][e] *= alpha; } \
        AT_SB; \
        if ((j) + 1 < 64) { f32x16 t0_, t1_; _Pragma("unroll") for (int e = 0; e < 16; ++e) { t0_[e] = 0.f; t1_[e] = 0.f; } \
            __builtin_amdgcn_s_setprio(1); \
            _Pragma("unroll") for (int ks = 0; ks < 2; ++ks) { t0_ = __builtin_amdgcn_mfma_f32_32x32x16_bf16(kf[2 * ks], qf[ks], t0_, 0, 0, 0); t1_ = __builtin_amdgcn_mfma_f32_32x32x16_bf16(kf[2 * ks + 1], qf[ks], t1_, 0, 0, 0); } \
            AT_SB; \
            _Pragma("unroll") for (int ks = 0; ks < 2; ++ks) { kg[2 * ks] = *(const LAS bf16x8*)(lds + (STN) + ka + (ks + 2) * 32); kg[2 * ks + 1] = *(const LAS bf16x8*)(lds + (STN) + ka + 32 * AT_KROW + (ks + 2) * 32); } \
            AT_SB; \
            _Pragma("unroll") for (int ks = 0; ks < 2; ++ks) { t0_ = __builtin_amdgcn_mfma_f32_32x32x16_bf16(kg[2 * ks], qf[ks + 2], t0_, 0, 0, 0); t1_ = __builtin_amdgcn_mfma_f32_32x32x16_bf16(kg[2 * ks + 1], qf[ks + 2], t1_, 0, 0, 0); } \
            __builtin_amdgcn_s_setprio(0); sn##0 = t0_; sn##1 = t1_; } \
        AT_VFRAG(vA, STC, 0); \
        AT_SB; \
        float ls = 0.f; \
        _Pragma("unroll") for (int e = 0; e < 16; ++e) { s0[e] = __builtin_amdgcn_exp2f(s0[e] - mrow); s1[e] = __builtin_amdgcn_exp2f(s1[e] - mrow); ls += s0[e] + s1[e]; } \
        lrow += ls; \
        bf16x8 pf[2][2]; \
        _Pragma("unroll") for (int s = 0; s < 2; ++s) { u32x4 w0, w1; \
            w0.x = pk2(s0[8 * s + 0], s0[8 * s + 1]); w0.y = pk2(s0[8 * s + 2], s0[8 * s + 3]); w0.z = pk2(s0[8 * s + 4], s0[8 * s + 5]); w0.w = pk2(s0[8 * s + 6], s0[8 * s + 7]); \
            w1.x = pk2(s1[8 * s + 0], s1[8 * s + 1]); w1.y = pk2(s1[8 * s + 2], s1[8 * s + 3]); w1.z = pk2(s1[8 * s + 4], s1[8 * s + 5]); w1.w = pk2(s1[8 * s + 6], s1[8 * s + 7]); \
            pf[0][s] = __builtin_bit_cast(bf16x8, w0); pf[1][s] = __builtin_bit_cast(bf16x8, w1); } \
        AT_SB; \
        AT_PV(vA, pf[0][0]); \
        AT_SB; \
        AT_VFRAG(vA, STC, 1); \
        AT_SB; \
        AT_PV(vA, pf[0][1]); \
        AT_SB; \
          \
        if ((j) + 2 < 64) { *(LAS u32x4*)(lds + (STC) + lk) = r0; *(LAS u32x4*)(lds + (STC) + AT_K1 + lk) = r1; } \
        if ((j) + 1 < 64) { *(LAS u32x4*)(lds + (STN) + lv0) = r2; *(LAS u32x4*)(lds + (STN) + lv1) = r3; } \
        AT_SB; \
        AT_VFRAG(vA, STC, 2); \
        AT_SB; \
        AT_PV(vA, pf[1][0]); \
        AT_SB; \
        AT_VFRAG(vA, STC, 3); \
        AT_SB; \
        AT_PV(vA, pf[1][1]); \
        __syncthreads(); } while (0)
    for (int j = 0; j < 64; j += 2) {
        AT_TILE(j, sA0, sA1, sB, 0, AT_STG);
        AT_TILE(j + 1, sB0, sB1, sA, AT_STG, 0);
    }
#undef AT_TILE
#undef AT_QK
#undef AT_VFRAG
#undef AT_PV
#undef AT_SB
    const float inv = __builtin_amdgcn_rcpf(lrow + __shfl_xor(lrow, 32));
    LAS float* img = (LAS float*)lds;
    const int qrow = wq * 32 + r32;
    if (c == 1) {
        const float sc = -lam * inv;
#pragma unroll
        for (int vt = 0; vt < 4; ++vt)
#pragma unroll
            for (int g = 0; g < 4; ++g)
                *(LAS f32x4*)(img + qrow * AT_IMG_ROW + 32 * vt + 8 * g + 4 * hh) = (f32x4){o[vt][4 * g] * sc, o[vt][4 * g + 1] * sc, o[vt][4 * g + 2] * sc, o[vt][4 * g + 3] * sc};
    }
    __syncthreads();
    if (c == 0) {
#pragma unroll
        for (int vt = 0; vt < 4; ++vt)
#pragma unroll
            for (int g = 0; g < 4; ++g) {
                LAS f32x4* p = (LAS f32x4*)(img + qrow * AT_IMG_ROW + 32 * vt + 8 * g + 4 * hh);
                f32x4 t = *p;
                t.x += o[vt][4 * g] * inv; t.y += o[vt][4 * g + 1] * inv; t.z += o[vt][4 * g + 2] * inv; t.w += o[vt][4 * g + 3] * inv;
                *p = t;
            }
    }
    __syncthreads();
    {
        const int q = tid >> 2, part = tid & 3;
        float v[32]; float ss = 0.f;
#pragma unroll
        for (int i = 0; i < 8; ++i) { const f32x4 t = *(const LAS f32x4*)(img + q * AT_IMG_ROW + 32 * part + 4 * i); v[4 * i] = t.x; v[4 * i + 1] = t.y; v[4 * i + 2] = t.z; v[4 * i + 3] = t.w;
            ss += (t.x * t.x + t.y * t.y) + (t.z * t.z + t.w * t.w); }
        ss += __shfl_xor(ss, 1); ss += __shfl_xor(ss, 2);
        const float rs = rsqrtf(ss * (1.0f / 128.0f) + EPS) * one_minus_lam_init;
        const float* gp = gainA + h * 128 + 32 * part;
        bf16_t* dst = AO + ((size_t)(b * SEQ + qb * 128 + q)) * 1024 + h * 128 + 32 * part;
#pragma unroll
        for (int i = 0; i < 4; ++i) {
            const f32x4 g0 = *(const f32x4*)(gp + 8 * i), g1 = *(const f32x4*)(gp + 8 * i + 4);
            u32x4 w; w.x = pk2(v[8 * i] * rs * g0.x, v[8 * i + 1] * rs * g0.y); w.y = pk2(v[8 * i + 2] * rs * g0.z, v[8 * i + 3] * rs * g0.w);
            w.z = pk2(v[8 * i + 4] * rs * g1.x, v[8 * i + 5] * rs * g1.y); w.w = pk2(v[8 * i + 6] * rs * g1.z, v[8 * i + 7] * rs * g1.w);
            *(u32x4*)(dst + 8 * i) = w;
        }
    }
    __syncthreads();
}

constexpr int HG_SEG = 0;
constexpr int HG_F = 2048;
constexpr int HG_PART = 2560;
constexpr int HG_V = 4096;
constexpr int HG_VROW = 288;
constexpr int HG_A = HG_V + 64 * HG_VROW;
constexpr int HG_KTROW = 144, HG_QKROW = 272;
constexpr int HG_Bq = HG_A + 128 * HG_KTROW;

__device__ __forceinline__ void hg_cumsum(const float (&gv)[16], int dir, int k, int j, LAS unsigned char* lds, float (&d)[16], float& m_out, float& tot_out) {
    float run = 0.f;
    if (dir == 0) {
#pragma unroll
        for (int i = 0; i < 16; ++i) { run += gv[i]; d[i] = run; }
    } else {
#pragma unroll
        for (int i = 15; i >= 0; --i) { run += gv[i]; d[i] = run; }
    }
    LAS float* seg = (LAS float*)(lds + HG_SEG);
    seg[j * 128 + k] = run;
    __syncthreads();
    const float s0 = seg[k], s1 = seg[128 + k], s2 = seg[256 + k], s3 = seg[384 + k];
    float off, m;
    if (dir == 0) { off = (j > 0 ? s0 : 0.f) + (j > 1 ? s1 : 0.f) + (j > 2 ? s2 : 0.f); m = s0 + s1; }
    else { off = (j < 3 ? s3 : 0.f) + (j < 2 ? s2 : 0.f) + (j < 1 ? s1 : 0.f); m = s2 + s3; }
#pragma unroll
    for (int i = 0; i < 16; ++i) d[i] = d[i] + off - m;
    m_out = m; tot_out = (s0 + s1) + (s2 + s3);
}
__device__ __forceinline__ void hg_load_v(const bf16_t* HV, int tok0, int h, LAS unsigned char* lds, int tid) {
#pragma unroll
    for (int i = 0; i < 2; ++i) { const int ch = tid + 512 * i, p = ch >> 4, part = ch & 15;
        *(LAS u32x4*)(lds + HG_V + p * HG_VROW + part * 16) = *(const u32x4*)(HV + (size_t)(tok0 + p) * 512 + h * 128 + part * 8); }
}
__device__ __forceinline__ void hg_load_g(const bf16_t* G, int tok0, int h, int k, int j, float (&gv)[16]) {
    const bf16_t* gp = G + (size_t)(tok0 + 16 * j) * 512 + h * 128 + k;
    unsigned short raw[16];
#pragma unroll
    for (int i = 0; i < 16; ++i) raw[i] = gp[(size_t)i * 512];
#pragma unroll
    for (int i = 0; i < 16; ++i) gv[i] = bf2f(raw[i]);
}

__device__ __forceinline__ void hg1_phase(int bx, int G, const bf16_t* GF, const bf16_t* GB, const bf16_t* HV, bf16_t* UT, float* Dg, float* Eg, LAS unsigned char* lds) {
    int tid_ = threadIdx.x; asm volatile("" : "+v"(tid_));
    const int tid = tid_, wave = __builtin_amdgcn_readfirstlane(tid >> 6), lane = tid & 63;
    const int k = tid & 127, j = tid >> 7, i16 = lane & 15, g4 = lane >> 4;
    float gn[16]; u32x4 vn[2];
#define HG1_LOAD(uu) do { const int u_ = (uu), dir_ = u_ & 1, cch_ = (u_ >> 1) & 63, bh_ = u_ >> 7, tok_ = (bh_ >> 2) * SEQ + cch_ * 64; \
        hg_load_g(dir_ ? GB : GF, tok_, bh_ & 3, k, j, gn); \
        _Pragma("unroll") for (int i = 0; i < 2; ++i) { const int ch = tid + 512 * i; vn[i] = *(const u32x4*)(HV + (size_t)(tok_ + (ch >> 4)) * 512 + (bh_ & 3) * 128 + (ch & 15) * 8); } } while (0)
    if (bx < 2048) HG1_LOAD(bx);
    for (int u = bx; u < 2048; u += G) {
        const int dir = u & 1, cch = (u >> 1) & 63, bh = u >> 7, b = bh >> 2, h = bh & 3;
        const int tok0 = b * SEQ + cch * 64;
        float gv[16], d[16], m, tot;
#pragma unroll
        for (int i = 0; i < 16; ++i) gv[i] = gn[i];
        u32x4 vr[2];
#pragma unroll
        for (int i = 0; i < 2; ++i) vr[i] = vn[i];
        if (u + G < 2048) HG1_LOAD(u + G);
        hg_cumsum(gv, dir, k, j, lds, d, m, tot);
        float kt[16];
#pragma unroll
        for (int i = 0; i < 16; ++i) kt[i] = (1.0f - __expf(gv[i])) * __expf(fminf(-d[i], 40.f));
        { u32x4 w0, w1;
          w0.x = pk2(kt[0], kt[1]); w0.y = pk2(kt[2], kt[3]); w0.z = pk2(kt[4], kt[5]); w0.w = pk2(kt[6], kt[7]);
          w1.x = pk2(kt[8], kt[9]); w1.y = pk2(kt[10], kt[11]); w1.z = pk2(kt[12], kt[13]); w1.w = pk2(kt[14], kt[15]);
          *(LAS u32x4*)(lds + HG_A + k * HG_KTROW + j * 32) = w0; *(LAS u32x4*)(lds + HG_A + k * HG_KTROW + j * 32 + 16) = w1; }
#pragma unroll
        for (int i = 0; i < 2; ++i) { const int ch = tid + 512 * i; *(LAS u32x4*)(lds + HG_V + (ch >> 4) * HG_VROW + (ch & 15) * 16) = vr[i]; }
        if (j == 0) { ((LAS float*)(lds + HG_F))[k] = __expf(tot - m); Dg[(size_t)u * 128 + k] = __expf(tot); Eg[(size_t)u * 128 + k] = __expf(m); }
        __syncthreads();
        bf16x8 af[2];
#pragma unroll
        for (int s = 0; s < 2; ++s) {
            const LAS unsigned char* ap = lds + HG_A + (16 * wave + i16) * HG_KTROW + (32 * s + 4 * g4) * 2;
            const u32x2 lo = *(const LAS u32x2*)ap, hi = *(const LAS u32x2*)(ap + 32);
            af[s] = __builtin_bit_cast(bf16x8, (u32x4){lo.x, lo.y, hi.x, hi.y});
        }
        const f32x4 fsc = *(const LAS f32x4*)(lds + HG_F + (16 * wave + 4 * g4) * 4);
        const LAS unsigned char* vbase = lds + HG_V + (4 * g4 + (i16 >> 2)) * HG_VROW + (i16 & 3) * 8;
#pragma unroll
        for (int vt = 0; vt < 8; ++vt) {
            f32x4 acc = {0.f, 0.f, 0.f, 0.f};
#pragma unroll
            for (int s = 0; s < 2; ++s) {
                const s16x4 t0 = tr_read(vbase + (32 * s) * HG_VROW + vt * 32), t1 = tr_read(vbase + (32 * s + 16) * HG_VROW + vt * 32);
                const bf16x8 bv = {t0[0], t0[1], t0[2], t0[3], t1[0], t1[1], t1[2], t1[3]};
                acc = __builtin_amdgcn_mfma_f32_16x16x32_bf16(af[s], bv, acc, 0, 0, 0);
            }
            u32x2 w; w.x = pk2(acc[0] * fsc[0], acc[1] * fsc[1]); w.y = pk2(acc[2] * fsc[2], acc[3] * fsc[3]);
            *(u32x2*)(UT + ((size_t)u * 128 + 16 * vt + i16) * 128 + 16 * wave + 4 * g4) = w;
        }
        __syncthreads();
    }
}

__device__ __forceinline__ void hg2_scan(bf16_t* UT, const float* Dg, const float* Eg, int gthread, int nthreads) {
    for (int idx = gthread; idx < 32 * 4096; idx += nthreads) {
        const int chain = idx >> 12, e4 = idx & 4095, v = e4 >> 5, k0 = (e4 & 31) * 4;
        const int dir = chain & 1, bh = chain >> 1;
        float S0 = 0.f, S1 = 0.f, S2 = 0.f, S3 = 0.f;
        int u = (bh * 64 + (dir ? 63 : 0)) * 2 + dir;
        const int ustep = dir ? -2 : 2;
        u32x2 uu[4]; f32x4 dd[4], ee[4];
#pragma unroll
        for (int r = 0; r < 4; ++r) { const int ur = u + r * ustep; uu[r] = *(const u32x2*)(UT + ((size_t)ur * 128 + v) * 128 + k0); dd[r] = *(const f32x4*)(Dg + (size_t)ur * 128 + k0); ee[r] = *(const f32x4*)(Eg + (size_t)ur * 128 + k0); }
        for (int cc = 0; cc < 64; cc += 4) {
#pragma unroll
            for (int r = 0; r < 4; ++r) {
                const u32x2 uc = uu[r]; const f32x4 dc = dd[r], ec = ee[r];
                if (cc + 4 < 64) { const int un = u + 4 * ustep; uu[r] = *(const u32x2*)(UT + ((size_t)un * 128 + v) * 128 + k0); dd[r] = *(const f32x4*)(Dg + (size_t)un * 128 + k0); ee[r] = *(const f32x4*)(Eg + (size_t)un * 128 + k0); }
                u32x2 w; w.x = pk2(ec.x * S0, ec.y * S1); w.y = pk2(ec.z * S2, ec.w * S3);
                *(u32x2*)(UT + ((size_t)u * 128 + v) * 128 + k0) = w;
                S0 = dc.x * S0 + bflo(uc.x); S1 = dc.y * S1 + bfhi(uc.x); S2 = dc.z * S2 + bflo(uc.y); S3 = dc.w * S3 + bfhi(uc.y);
                u += ustep;
            }
        }
    }
}

constexpr int HG_OUT = HG_Bq + 64 * HG_QKROW;
__device__ __forceinline__ void hg3_phase(int bx, int G, const bf16_t* GF, const bf16_t* GB, const bf16_t* HQ, const bf16_t* HV, const bf16_t* ST, const bf16_t* BG, const float* gainH, bf16_t* AO, LAS unsigned char* lds) {
    int tid_ = threadIdx.x; asm volatile("" : "+v"(tid_));
    const int tid = tid_, wave = __builtin_amdgcn_readfirstlane(tid >> 6), lane = tid & 63;
    const int k = tid & 127, j = tid >> 7;
    const int tb = wave & 3, vh = wave >> 2, i16 = lane & 15, g4 = lane >> 4;
    float gf[16], gb[16]; unsigned short qr[16];
#define HG3_LOAD(uu) do { const int u_ = (uu), cch_ = u_ & 63, bh_ = u_ >> 6, tok_ = (bh_ >> 2) * SEQ + cch_ * 64, h_ = bh_ & 3; \
        hg_load_g(GF, tok_, h_, k, j, gf); hg_load_g(GB, tok_, h_, k, j, gb); \
        const bf16_t* qp = HQ + (size_t)(tok_ + 16 * j) * 512 + h_ * 128 + k; \
        _Pragma("unroll") for (int i = 0; i < 16; ++i) qr[i] = qp[(size_t)i * 512]; } while (0)
    if (bx < 1024) HG3_LOAD(bx);
  for (int u3 = bx; u3 < 1024; u3 += G) {
    const int cch = u3 & 63, bh = u3 >> 6, b = bh >> 2, h = bh & 3;
    const int tok0 = b * SEQ + cch * 64;
    hg_load_v(HV, tok0, h, lds, tid);
    u32x4 bgq[2];
    { const bf16_t* bgp0 = BG + (size_t)(tok0 + (tid >> 3)) * 512 + h * 128 + 16 * (tid & 7); bgq[0] = *(const u32x4*)bgp0; bgq[1] = *(const u32x4*)(bgp0 + 8); }
    bf16x8 sb[16];
    { const bf16_t* stp = ST + ((size_t)((bh * 64 + cch) * 2 + 0) * 128) * 128;
#pragma unroll
      for (int vv = 0; vv < 4; ++vv)
#pragma unroll
        for (int ks = 0; ks < 4; ++ks) sb[vv * 4 + ks] = *(const bf16x8*)(stp + (size_t)(16 * (4 * vh + vv) + i16) * 128 + 32 * ks + 8 * g4); }
    f32x4 oacc[4];
#pragma unroll
    for (int i = 0; i < 4; ++i) oacc[i] = (f32x4){0.f, 0.f, 0.f, 0.f};
#pragma unroll
    for (int dir = 0; dir < 2; ++dir) {
        float d[16], m, tot;
        hg_cumsum(dir ? gb : gf, dir, k, j, lds, d, m, tot);
#pragma unroll
        for (int i = 0; i < 16; ++i) {
            const float gvi = dir ? gb[i] : gf[i];
            const float kt = (1.0f - __expf(gvi)) * __expf(fminf(-d[i], 40.f));
            const float qt = bf2f(qr[i]) * __expf(fminf(d[i], 40.f));
            *(LAS unsigned short*)(lds + HG_A + (16 * j + i) * HG_QKROW + k * 2) = (unsigned short)f2bf(kt);
            *(LAS unsigned short*)(lds + HG_Bq + (16 * j + i) * HG_QKROW + k * 2) = (unsigned short)f2bf(qt);
        }
        if (dir == 1 && u3 + G < 1024) HG3_LOAD(u3 + G);
        __syncthreads();
        f32x4 pt[4];
#pragma unroll
        for (int sg = 0; sg < 4; ++sg) pt[sg] = (f32x4){0.f, 0.f, 0.f, 0.f};
        bf16x8 qa[4];
#pragma unroll
        for (int ks = 0; ks < 4; ++ks) qa[ks] = *(const LAS bf16x8*)(lds + HG_Bq + (16 * tb + i16) * HG_QKROW + (32 * ks + 8 * g4) * 2);
#pragma unroll
        for (int sg = 0; sg < 4; ++sg)
#pragma unroll
            for (int ks = 0; ks < 4; ++ks) {
                const bf16x8 ka = *(const LAS bf16x8*)(lds + HG_A + (16 * sg + i16) * HG_QKROW + (32 * ks + 8 * g4) * 2);
                pt[sg] = __builtin_amdgcn_mfma_f32_16x16x32_bf16(ka, qa[ks], pt[sg], 0, 0, 0);
            }
        const int tcol = 16 * tb + i16;
#pragma unroll
        for (int sg = 0; sg < 4; ++sg)
#pragma unroll
            for (int e = 0; e < 4; ++e) { const int srow = 16 * sg + 4 * g4 + e; const bool keep = dir ? (srow >= tcol) : (srow <= tcol); pt[sg][e] = keep ? pt[sg][e] : 0.f; }
        bf16x8 pa[2];
#pragma unroll
        for (int s2 = 0; s2 < 2; ++s2) {
            u32x4 w; w.x = pk2(pt[2 * s2][0], pt[2 * s2][1]); w.y = pk2(pt[2 * s2][2], pt[2 * s2][3]); w.z = pk2(pt[2 * s2 + 1][0], pt[2 * s2 + 1][1]); w.w = pk2(pt[2 * s2 + 1][2], pt[2 * s2 + 1][3]);
            pa[s2] = __builtin_bit_cast(bf16x8, w);
        }
        const LAS unsigned char* vbase = lds + HG_V + (4 * g4 + (i16 >> 2)) * HG_VROW + (i16 & 3) * 8;
#pragma unroll
        for (int vv = 0; vv < 4; ++vv) {
            const int vt = 4 * vh + vv;
#pragma unroll
            for (int s2 = 0; s2 < 2; ++s2) {
                const s16x4 t0 = tr_read(vbase + (32 * s2) * HG_VROW + vt * 32), t1 = tr_read(vbase + (32 * s2 + 16) * HG_VROW + vt * 32);
                const bf16x8 bv = {t0[0], t0[1], t0[2], t0[3], t1[0], t1[1], t1[2], t1[3]};
                oacc[vv] = __builtin_amdgcn_mfma_f32_16x16x32_bf16(pa[s2], bv, oacc[vv], 0, 0, 0);
            }
#pragma unroll
            for (int ks = 0; ks < 4; ++ks) oacc[vv] = __builtin_amdgcn_mfma_f32_16x16x32_bf16(qa[ks], sb[vv * 4 + ks], oacc[vv], 0, 0, 0);
        }
        if (dir == 0) {
            const bf16_t* stp = ST + ((size_t)((bh * 64 + cch) * 2 + 1) * 128) * 128;
#pragma unroll
            for (int vv = 0; vv < 4; ++vv)
#pragma unroll
                for (int ks = 0; ks < 4; ++ks) sb[vv * 4 + ks] = *(const bf16x8*)(stp + (size_t)(16 * (4 * vh + vv) + i16) * 128 + 32 * ks + 8 * g4);
        }
        __syncthreads();
    }
    LAS float* ot = (LAS float*)(lds + HG_OUT);
#pragma unroll
    for (int vv = 0; vv < 4; ++vv)
#pragma unroll
        for (int e = 0; e < 4; ++e) ot[(16 * tb + 4 * g4 + e) * 132 + 16 * (4 * vh + vv) + i16] = oacc[vv][e];
    __syncthreads();
    {
        const int t = tid >> 3, part = tid & 7;
        float v[16]; float ss = 0.f;
#pragma unroll
        for (int i = 0; i < 4; ++i) { const f32x4 x = *(const LAS f32x4*)(ot + t * 132 + 16 * part + 4 * i); v[4 * i] = x.x; v[4 * i + 1] = x.y; v[4 * i + 2] = x.z; v[4 * i + 3] = x.w; ss += (x.x * x.x + x.y * x.y) + (x.z * x.z + x.w * x.w); }
        ss += __shfl_xor(ss, 1); ss += __shfl_xor(ss, 2); ss += __shfl_xor(ss, 4);
        const float rs = rsqrtf(ss * (1.0f / 128.0f) + EPS);
        const float* gp = gainH + h * 128 + 16 * part;
        bf16_t* dst = AO + (size_t)(tok0 + t) * 1024 + 512 + h * 128 + 16 * part;
#pragma unroll
        for (int i = 0; i < 2; ++i) {
            const u32x4 gq = bgq[i];
            const f32x4 g0 = *(const f32x4*)(gp + 8 * i), g1 = *(const f32x4*)(gp + 8 * i + 4);
            u32x4 w;
            w.x = pk2(v[8 * i] * rs * g0.x * bflo(gq.x), v[8 * i + 1] * rs * g0.y * bfhi(gq.x)); w.y = pk2(v[8 * i + 2] * rs * g0.z * bflo(gq.y), v[8 * i + 3] * rs * g0.w * bfhi(gq.y));
            w.z = pk2(v[8 * i + 4] * rs * g1.x * bflo(gq.z), v[8 * i + 5] * rs * g1.y * bfhi(gq.z)); w.w = pk2(v[8 * i + 6] * rs * g1.z * bflo(gq.w), v[8 * i + 7] * rs * g1.w * bfhi(gq.w));
            *(u32x4*)(dst + 8 * i) = w;
        }
    }
    __syncthreads();
  }
#undef HG3_LOAD
}

#define XB_TMO      128
#define XB_XCNT(j)  (256  + 64 * (j))
#define XB_XSUB(j)  (1280 + 64 * (j))
#define XB_XGEN(j)  (2304 + 64 * (j))
#define XB_TOP      3328
#define XB_TOPGEN   3392
#define XCD_BAR_WORDS 3456
#define XB_SPIN_CAP (1u << 18)

__device__ __forceinline__ unsigned xb_ld(unsigned* p)              { return __hip_atomic_load(p, __ATOMIC_RELAXED, __HIP_MEMORY_SCOPE_AGENT); }
__device__ __forceinline__ unsigned xb_add(unsigned* p, unsigned v) { return __hip_atomic_fetch_add(p, v, __ATOMIC_RELAXED, __HIP_MEMORY_SCOPE_AGENT); }
__device__ __forceinline__ unsigned xb_xcc_id() { return (unsigned)__builtin_amdgcn_s_getreg((3 << 11) | 20) & 0xFu; }
#define XB_SPIN(cond, bar) do { unsigned _sp = 0; while (cond) { __builtin_amdgcn_s_sleep(1); \
    if ((++_sp & 255u) == 0u) { if (xb_ld(&(bar)[XB_TMO])) break; if (_sp > XB_SPIN_CAP) { atomicAdd(&(bar)[XB_TMO], 1u); break; } } } } while (0)

struct XcdBarrier {
    unsigned* bar; unsigned x;
    volatile LAS unsigned* st;
};

__device__ __forceinline__ XcdBarrier xcd_barrier_post(unsigned* bar, volatile LAS unsigned* st) {
    XcdBarrier b; b.bar = bar; b.x = xb_xcc_id(); b.st = st;
    if (threadIdx.x == 0) (void)xb_add(&bar[XB_XCNT(b.x)], 1u);
    return b;
}
__device__ __forceinline__ void xcd_barrier_complete(unsigned* bar, unsigned x, unsigned& nloc, unsigned& nx) {
    const unsigned G = gridDim.x * gridDim.y * gridDim.z;
    unsigned sum, cnt, mine, sp = 0u;
    for (;;) {
        sum = 0u; cnt = 0u; mine = 0u;
#pragma unroll
        for (unsigned j = 0; j < 16; ++j) { const unsigned c = xb_ld(&bar[XB_XCNT(j)]); sum += c; cnt += (c > 0u) ? 1u : 0u; mine = (j == x) ? c : mine; }
        if (sum == G) break;
        __builtin_amdgcn_s_sleep(1);
        if ((++sp & 255u) == 0u) { if (xb_ld(&bar[XB_TMO])) break; if (sp > XB_SPIN_CAP) { atomicAdd(&bar[XB_TMO], 1u); break; } }
    }
    nloc = mine > 0u ? mine : 1u; nx = cnt > 0u ? cnt : 1u;
}

__device__ __forceinline__ void xcd_barrier(const XcdBarrier& b) {
    asm volatile("s_waitcnt vmcnt(0)" ::: "memory");
    __syncthreads();
    if (threadIdx.x == 0) {
        unsigned* bar = b.bar;
        __builtin_amdgcn_s_waitcnt(0);
        unsigned nloc = b.st[0], nx = b.st[1];
        if (nloc == 0u) { xcd_barrier_complete(bar, b.x, nloc, nx); b.st[0] = nloc; b.st[1] = nx; }
        const unsigned old = xb_add(&bar[XB_XSUB(b.x)], 1u);
        const unsigned gen = old / nloc;
        if (old + 1u == (gen + 1u) * nloc) {
            __builtin_amdgcn_fence(__ATOMIC_RELEASE, "agent");
            asm volatile("s_waitcnt vmcnt(0)" ::: "memory");
            const unsigned og = xb_add(&bar[XB_TOP], 1u);
            const unsigned tg = og / nx;
            if (og + 1u == (tg + 1u) * nx) xb_add(&bar[XB_TOPGEN], 1u);
            else XB_SPIN(xb_ld(&bar[XB_TOPGEN]) == tg, bar);
            __builtin_amdgcn_fence(__ATOMIC_ACQUIRE, "agent");
            xb_add(&bar[XB_XGEN(b.x)], 1u);
            asm volatile("s_waitcnt vmcnt(0)" ::: "memory");
        } else {
            XB_SPIN(xb_ld(&bar[XB_XGEN(b.x)]) == gen, bar);
            __builtin_amdgcn_fence(__ATOMIC_ACQUIRE, "agent");
            asm volatile("s_waitcnt vmcnt(0)" ::: "memory");
        }
    }
    __syncthreads();
}

__global__ void __launch_bounds__(512, 2) fwd_kernel(Ptrs Pk) {
    extern __shared__ __attribute__((aligned(16))) unsigned char lds_raw[];
    LAS unsigned char* lds = (LAS unsigned char*)lds_raw;
    cg::grid_group grid = cg::this_grid();
    const int G = gridDim.x, bx = blockIdx.x;
    const int lo = Pk.ph_lo, hi = Pk.ph_hi;
    int ph = 0;
    if (threadIdx.x < 4) ((LAS unsigned*)(lds + 131072 + 1024))[threadIdx.x] = 0u;
    __syncthreads();
    XcdBarrier xbar = xcd_barrier_post((unsigned*)(Pk.ws + OFF_BAR), (volatile LAS unsigned*)(lds + 131072 + 1024));
#ifdef TS_A
    if (threadIdx.x == 0) { LAS unsigned long long* TS_ = (LAS unsigned long long*)(lds + 131072); for (int i = 0; i < 15; ++i) TS_[i] = 0ull; TS_[15] = __builtin_amdgcn_s_memrealtime(); }
#endif
#ifndef PH_MASK
#define PH_MASK 0xFFFFFFFFu
#endif
#define ON(id) constexpr (((PH_MASK) >> (id)) & 1u)
#if defined(__HIP_DEVICE_COMPILE__)
#define LOAD_ARGS(P) int zoff_ = 0; asm volatile("" : "+s"(zoff_)); const Ptrs P = *(const __attribute__((address_space(4))) Ptrs*)((const __attribute__((address_space(4))) char*)__builtin_amdgcn_kernarg_segment_ptr() + zoff_);
#else
#define LOAD_ARGS(P) const Ptrs P = Pk;
#endif
#define PHASE_BEGIN if (ph >= lo && ph < hi) { LOAD_ARGS(P) unsigned char* ws = P.ws; asm volatile("" : "+s"(ws)); int tid = threadIdx.x; asm volatile("" : "+v"(tid)); \
    const int lane = tid & 63, wave = __builtin_amdgcn_readfirstlane(tid >> 6), gw = bx * 8 + wave, ngw = G * 8; (void)lane; (void)gw; (void)ngw;
#define XB ((bf16_t*)(ws + OFF_XB))
#define RSA ((float*)(ws + OFF_RSA))
#define RSB ((float*)(ws + OFF_RSB))
#define CS ((const float*)(ws + OFF_CS))
#define LB ((const float*)(ws + OFF_LB))
#define LAM ((const float*)(ws + OFF_LAM))
#define Dg ((float*)(ws + OFF_DG))
#define Eg ((float*)(ws + OFF_EG))
#define GATE ((bf16_t*)(ws + OFF_GATE))
#define Qb ((bf16_t*)(ws + OFF_Q))
#define Kb ((bf16_t*)(ws + OFF_K))
#define Vb ((bf16_t*)(ws + OFF_V))
#define HQ ((bf16_t*)(ws + OFF_HQ))
#define HV ((bf16_t*)(ws + OFF_HV))
#define GF ((bf16_t*)(ws + OFF_GF))
#define GB ((bf16_t*)(ws + OFF_GB))
#define Yb ((bf16_t*)(ws + OFF_Y))
#define BG ((bf16_t*)(ws + OFF_BG))
#define AO ((bf16_t*)(ws + OFF_AO))
#define UT ((bf16_t*)(ws + OFF_UT))
#define Hb ((bf16_t*)(ws + OFF_H))
#ifdef TS_A
#define TICK(cat) do { if (bx == 0 && threadIdx.x == 0) { LAS unsigned long long* TS_ = (LAS unsigned long long*)(lds + 131072); const unsigned long long t_ = __builtin_amdgcn_s_memrealtime(); TS_[cat] += t_ - TS_[15]; TS_[15] = t_; } } while (0)
#else
#define TICK(cat) do { } while (0)
#endif
#define PHASE_END(cat)   TICK(cat); if (ph + 1 < hi) { if (ph == 0) grid.sync(); else xcd_barrier(xbar); TICK(13); } } ++ph;

    PHASE_BEGIN
        if ON(0) prologue(P, lds, gw, ngw, wave, lane);
        if ON(6) convert_layer(P, 0, ws, lds, gw, ngw, wave, lane);
    PHASE_END(0)

    for (int layer = 0; layer < DEPTH; ++layer) {
        PHASE_BEGIN
            pg8::Gemm g{XB, (const bf16_t*)(ws + (size_t)(layer & 1) * WSZ + W_IN), Dm, Dm, Dm, 1 << 30, 0, -1};
            pg8::StaticOrder S; S.init(M, 4096, G, bx);
            EpiMix E{RSB, CS, LB + (0 * 4 + layer) * 512, LB + (1 * 4 + layer) * 512, Qb, Kb, Vb, HQ, HV, BG, GF, GB};
            if ON(1) pg8::gemm_phase(lds, g, S, E);
        PHASE_END(1)
        PHASE_BEGIN
            const float lam_init = 0.8f - 0.6f * __expf(-0.3f * (float)layer);
            const float lam = LAM[layer];
            if ON(2) for (int i = 0; i * G + bx < 512; ++i) {
                const int uid = i * G + bx; const int round = uid >> 8, r = uid & 255;
                const int bhh = round * 8 + (r & 7), qb = r >> 3;
                attn_unit(bhh >> 2, bhh & 3, qb, Qb, Kb, Vb, AO, P.da_norm + layer * 512, 1.0f - lam_init, lam, lds);
            }
            TICK(2);
            if ON(3) hg1_phase(bx, G, GF, GB, HV, UT, Dg, Eg, lds);
        PHASE_END(3)
        PHASE_BEGIN
            if ON(5) hg2_scan(UT, Dg, Eg, bx * 512 + tid, G * 512);
            TICK(5);
            {
                pg8::Gemm g{XB, (const bf16_t*)(ws + (size_t)(layer & 1) * WSZ + W_IN) + (size_t)4096 * Dm, Dm, Dm, Dm, 1 << 30, 0, -1};
                pg8::StaticOrder S; S.init(M, 2048, G, bx);
                EpiGate E{RSB, GATE};
                if ON(4) pg8::gemm_phase(lds, g, S, E);
            }
            TICK(4);
        PHASE_END(4)
        PHASE_BEGIN
            if ON(7) hg3_phase(bx, G, GF, GB, HQ, HV, UT, BG, P.hg_norm + layer * 512, AO, lds);
        PHASE_END(7)
        PHASE_BEGIN
            pg8::Gemm g{AO, (const bf16_t*)(ws + (size_t)(layer & 1) * WSZ + W_AB), 1024, 1024, 1024, 1 << 30, 0, 8};
            pg8::StaticOrder S; S.init(M, 1024, G, bx);
            EpiY E{GATE, Yb};
            if ON(8) pg8::gemm_phase(lds, g, S, E);
        PHASE_END(8)
        PHASE_BEGIN
            pg8::Gemm g{Yb, (const bf16_t*)(ws + (size_t)(layer & 1) * WSZ + W_O2), 1024, 1024, 1024, 1 << 30, 0, -1};
            pg8::StaticOrder S; S.init(M, Dm, G, bx);
            EpiRes E{layer == 0 ? P.x : P.out, P.out, XB, RSA};
            if ON(9) pg8::gemm_phase(lds, g, S, E);
        PHASE_END(9)
        PHASE_BEGIN
            pg8::Gemm g{XB, (const bf16_t*)(ws + (size_t)(layer & 1) * WSZ + W_GU), Dm, Dm, Dm, 1 << 30, 0, -1};
            pg8::StaticOrder S; S.init(M, 2 * FF, G, bx);
            EpiGU E{RSA, Hb};
            if ON(10) pg8::gemm_phase(lds, g, S, E);
        PHASE_END(10)
        PHASE_BEGIN
            pg8::Gemm g{Hb, (const bf16_t*)(ws + (size_t)(layer & 1) * WSZ + W_D), FF, FF, FF, 1 << 30, 0, -1};
            pg8::StaticOrder S; S.init(M, Dm, G, bx);
            EpiRes E{P.out, P.out, XB, RSB};
            if ON(11) pg8::gemm_phase(lds, g, S, E);
            TICK(11);
            if ON(6) if (layer + 1 < DEPTH) convert_layer(P, layer + 1, ws + (size_t)((layer + 1) & 1) * WSZ, lds, gw, ngw, wave, lane);
        PHASE_END(6)
    }
    PHASE_BEGIN
        if ON(12) for (int r = gw; r < M; r += ngw) {
            f32x4* xr = (f32x4*)(P.out + (size_t)r * Dm) + lane;
            f32x4 v[4]; float ss = 0.f;
#pragma unroll
            for (int j = 0; j < 4; ++j) { v[j] = xr[64 * j]; ss += (v[j].x * v[j].x + v[j].y * v[j].y) + (v[j].z * v[j].z + v[j].w * v[j].w); }
            const float rs = rsqrtf(wave_sum(ss) * (1.0f / Dm) + EPS);
#pragma unroll
            for (int j = 0; j < 4; ++j) { const f32x4 gn = *((const f32x4*)P.final_norm + lane + 64 * j); xr[64 * j] = (f32x4){v[j].x * rs * gn.x, v[j].y * rs * gn.y, v[j].z * rs * gn.z, v[j].w * rs * gn.w}; }
        }
    PHASE_END(12)
#ifdef TS_A
    if (bx == 0 && threadIdx.x == 0) {
        LAS unsigned long long* TS_ = (LAS unsigned long long*)(lds + 131072);
        unsigned long long a = 0;
        for (int i = 0; i < 15; ++i) { if ((TS_A >> i) & 1) a += TS_[i]; }
        const unsigned long long t_end = __builtin_amdgcn_s_memrealtime() + a;
        while (__builtin_amdgcn_s_memrealtime() < t_end) __builtin_amdgcn_s_sleep(20);
    }
#endif
}
constexpr int NPHASES = 2 + 8 * DEPTH;

#ifndef MK_PER_PHASE
#define MK_PER_PHASE 0
#endif

extern "C" void kernel_launch(void* const* d_in, const int* in_sizes, int n_in, void* d_out, int out_size, void* d_ws, size_t ws_size, hipStream_t stream) {
    static int grid = 0;
    if (grid == 0) {
        if (n_in != 16 || out_size != M * Dm || ws_size < WS_END) { fprintf(stderr, "kernel_launch: unexpected sizes (n_in %d, out %d, ws %zu, need %zu)\n", n_in, out_size, ws_size, (size_t)WS_END); grid = -1; return; }
        int dev = 0, cus = 0, per_cu = 0;
        (void)hipGetDevice(&dev);
        (void)hipDeviceGetAttribute(&cus, hipDeviceAttributeMultiprocessorCount, dev);
        if (hipFuncSetAttribute((const void*)fwd_kernel, hipFuncAttributeMaxDynamicSharedMemorySize, LDS_BYTES) != hipSuccess) { fprintf(stderr, "kernel_launch: hipFuncSetAttribute failed\n"); grid = -1; return; }
        (void)hipOccupancyMaxActiveBlocksPerMultiprocessor(&per_cu, (const void*)fwd_kernel, 512, LDS_BYTES);
        (void)hipGetLastError();
        if (per_cu < 1) per_cu = 1;
        grid = cus * 1;
        fprintf(stderr, "kernel_launch: grid %d (per_cu %d), ws %zu need %zu\n", grid, per_cu, ws_size, (size_t)WS_END);
    }
    if (grid < 0) return;
    Ptrs p{};
    p.x = (const float*)d_in[0]; p.pos = (const int*)d_in[1]; p.w_in = (const float*)d_in[2]; p.da_lambda = (const float*)d_in[3]; p.da_norm = (const float*)d_in[4];
    p.hg_lb = (const float*)d_in[5]; p.hg_norm = (const float*)d_in[6]; p.w_a = (const float*)d_in[7]; p.w_b = (const float*)d_in[8]; p.w_o = (const float*)d_in[9];
    p.attn_norm = (const float*)d_in[10]; p.ffn_norm = (const float*)d_in[11]; p.w_gate = (const float*)d_in[12]; p.w_up = (const float*)d_in[13]; p.w_down = (const float*)d_in[14];
    p.final_norm = (const float*)d_in[15];
    p.out = (float*)d_out; p.ws = (unsigned char*)d_ws;
    (void)hipMemsetAsync((char*)d_ws + OFF_BAR, 0, BAR_BYTES, stream);
#if MK_PER_PHASE
    for (int ph = 0; ph < NPHASES; ++ph) {
        p.ph_lo = ph; p.ph_hi = ph + 1;
        hipLaunchKernelGGL(fwd_kernel, dim3(grid), dim3(512), LDS_BYTES, stream, p);
    }
#else
    p.ph_lo = 0; p.ph_hi = NPHASES;
    void* args[] = {&p};
    hipError_t e = hipLaunchCooperativeKernel((const void*)fwd_kernel, dim3(grid), dim3(512), args, LDS_BYTES, stream);
    if (e != hipSuccess) fprintf(stderr, "cooperative launch failed: %s (grid %d)\n", hipGetErrorString(e), grid);
#endif
}
```

```cpp
#include <hip/hip_runtime.h>
#include <hip/hip_cooperative_groups.h>
#include <cstdio>
#include <cstdint>
namespace cg = cooperative_groups;

#define LAS __attribute__((address_space(3)))
typedef unsigned short bf16_t;
typedef short bf16x8 __attribute__((ext_vector_type(8)));
typedef short s16x4 __attribute__((ext_vector_type(4)));
typedef float f32x4 __attribute__((ext_vector_type(4)));
typedef float f32x16 __attribute__((ext_vector_type(16)));
typedef unsigned u32x4 __attribute__((ext_vector_type(4)));
typedef unsigned u32x2 __attribute__((ext_vector_type(2)));

constexpr int Dm = 1024, NB = 4, SEQ = 4096, M = NB * SEQ, DEPTH = 4, FF = 2816, INW = 6144;
constexpr float EPS = 1e-6f;
constexpr float LOG2E = 1.4426950408889634f;

constexpr size_t W_IN = 0, W_AB = 12582912, W_O2 = 14680064, W_GU = 18874368, W_D = 30408704, WSZ = 36175872;
constexpr size_t MiB = 1048576;
constexpr size_t OFF_XB = 2 * WSZ;
constexpr size_t OFF_RSA = OFF_XB + 32 * MiB;
constexpr size_t OFF_RSB = OFF_RSA + MiB;
constexpr size_t OFF_CS = OFF_RSB + MiB;
constexpr size_t OFF_LB = OFF_CS + MiB;
constexpr size_t OFF_LAM = OFF_LB + 16384;
constexpr size_t OFF_DG = OFF_LAM + 256;
constexpr size_t OFF_EG = OFF_DG + MiB;
constexpr size_t OFF_B = OFF_EG + MiB;
constexpr size_t OFF_GATE = OFF_B;
constexpr size_t OFF_Q = OFF_B, OFF_K = OFF_B + 16 * MiB, OFF_V = OFF_B + 32 * MiB;
constexpr size_t OFF_HQ = OFF_B + 64 * MiB;
constexpr size_t OFF_HV = OFF_HQ + 16 * MiB;
constexpr size_t OFF_GF = OFF_HV + 16 * MiB;
constexpr size_t OFF_GB = OFF_GF + 16 * MiB;
constexpr size_t OFF_Y = OFF_GF;
constexpr size_t OFF_BG = OFF_GB + 16 * MiB;
constexpr size_t OFF_AO = OFF_BG + 16 * MiB;
constexpr size_t OFF_UT = OFF_AO + 32 * MiB;
constexpr size_t OFF_H = OFF_B;
constexpr size_t OFF_BAR = OFF_UT + 64 * MiB;
constexpr size_t BAR_BYTES = 16384;
constexpr size_t WS_END = OFF_BAR + BAR_BYTES;

constexpr int LDS_BYTES = 131072 + 2048;

__device__ __forceinline__ unsigned f2bf(float f) { unsigned u = __builtin_bit_cast(unsigned, f); return (u + 0x7fffu + ((u >> 16) & 1u)) >> 16; }
typedef float f32x2_t __attribute__((ext_vector_type(2)));
typedef __bf16 bf16x2_t __attribute__((ext_vector_type(2)));
__device__ __forceinline__ unsigned pk2(float lo, float hi) { f32x2_t v = {lo, hi}; bf16x2_t b = __builtin_convertvector(v, bf16x2_t); return __builtin_bit_cast(unsigned, b); }
__device__ __forceinline__ float bf2f(unsigned short b) { return __builtin_bit_cast(float, (unsigned)b << 16); }
__device__ __forceinline__ float bflo(unsigned u) { return __builtin_bit_cast(float, u << 16); }
__device__ __forceinline__ float bfhi(unsigned u) { return __builtin_bit_cast(float, u & 0xffff0000u); }
__device__ __forceinline__ float sigmoidf_(float x) { return __builtin_amdgcn_rcpf(1.0f + __expf(-x)); }

namespace pg8 {
constexpr int BM = 256, BK = 64, HALF = 128, HTB = HALF * BK * 2, STAGE_BYTES = 8 * HTB, NXCD = 8, WGM = 8;
__host__ __device__ __forceinline__ int lds_byte(int r, int c) { const int st = (r >> 4) * 2 + (c >> 5), rr = r & 15, cc = c & 31, ob = rr * 64 + cc * 2; return st * 1024 + (ob ^ (((ob >> 9) & 1) << 5)); }
__host__ __device__ __forceinline__ void stage_rc(int b, int& R, int& C) { const int st = b / 1024, sb = b % 1024, swz = sb ^ (((sb >> 9) & 1) << 5); R = (st >> 1) * 16 + swz / 64; C = (st & 1) * 32 + (swz % 64) / 2; }
__host__ __device__ __forceinline__ int perm32(int rho) { const int n = rho >> 4, i = rho & 15; return 8 * (i >> 2) + 4 * n + (i & 3); }

struct Unit { int pm, pn; };
struct Gemm { const bf16_t* A; const bf16_t* Bt; int lda, ldb, K; int split_pn; int split_aoff; int mid_t; };

struct StaticOrder {
    int nM, nN, nwg, G, c;
    __device__ __forceinline__ void init(int M_, int N_, int G_, int c_) { nM = M_ / BM; nN = N_ / BM; nwg = nM * nN; G = G_; c = c_; }
    __device__ bool next(int i, Unit& u) const {
        const long L = (long)i * G + c; if (L >= nwg) return false;
        int wgid = (int)L; { const int q = nwg / NXCD, r = nwg % NXCD, xcd = wgid % NXCD, off = wgid / NXCD; wgid = (xcd < r ? xcd * (q + 1) : r * (q + 1) + (xcd - r) * q) + off; }
        const int nig = WGM * nN, gid = wgid / nig, fm = gid * WGM, gsz = (nM - fm) < WGM ? (nM - fm) : WGM;
        u.pm = fm + ((wgid % nig) % gsz); u.pn = (wgid % nig) / gsz; return true;
    }
};

template <class Epi>
__device__ __forceinline__ void gemm_phase(LAS unsigned char* lds, const Gemm g, const StaticOrder& S, const Epi& E) {
    int tid_ = threadIdx.x; asm volatile("" : "+v"(tid_));
    const int tid = tid_, wid = __builtin_amdgcn_readfirstlane(tid >> 6), lane = tid & 63, wr = wid >> 2, wc = wid & 3, fr = lane & 15, fq = lane >> 4;
    const int K = g.K, nt = K / BK;
    unsigned voffA[2], voffB[2];
#pragma unroll
    for (int i = 0; i < 2; ++i) { int R, C; stage_rc(tid * 16 + i * 8192, R, C); const int Rb = (R & ~31) + perm32(R & 31);
        voffA[i] = (unsigned)(R * g.lda + C) * 2u; voffB[i] = (unsigned)(Rb * g.ldb + C) * 2u; }
    const size_t kstep = (size_t)(BK * 2);
    const size_t hstepA = (size_t)HALF * g.lda * 2, hstepB = (size_t)HALF * g.ldb * 2;
    const size_t tstepA = 2 * hstepA, tstepB = 2 * hstepB;
    const unsigned ldsw = (unsigned)wid * 1024u;
    const int aoff = lds_byte(wr * 64 + fr, fq * 8), boff = lds_byte(wc * 32 + fr, fq * 8);
#define PG8_SA(b, h) (((b) * 2 + (h)) * HTB)
#define PG8_SB(b, h) ((4 + (b) * 2 + (h)) * HTB)
#define PG8_STAGE(bufoff, gbase, voff) do { _Pragma("unroll") for (int _i = 0; _i < 2; ++_i) \
        __builtin_amdgcn_global_load_lds((const unsigned*)((const char*)(gbase) + (voff)[_i]), (LAS unsigned*)(lds + (bufoff) + ldsw + _i * 8192), 16, 0, 0); } while (0)
#define PG8_LDA(dst, b, h) do { _Pragma("unroll") for (int m = 0; m < 4; ++m) _Pragma("unroll") for (int k = 0; k < 2; ++k) dst[m][k] = *(const LAS bf16x8*)(lds + PG8_SA(b, h) + aoff + m * 2048 + k * 1024); } while (0)
#define PG8_LDB(dst, b, h) do { _Pragma("unroll") for (int n = 0; n < 2; ++n) _Pragma("unroll") for (int k = 0; k < 2; ++k) dst[n][k] = *(const LAS bf16x8*)(lds + PG8_SB(b, h) + boff + n * 2048 + k * 1024); } while (0)
#define PG8_MMA(ai, bj, At, Bt) do { __builtin_amdgcn_s_setprio(1); _Pragma("unroll") for (int m = 0; m < 4; ++m) _Pragma("unroll") for (int n = 0; n < 2; ++n) _Pragma("unroll") for (int k = 0; k < 2; ++k) \
        acc[ai][bj][m][n] = __builtin_amdgcn_mfma_f32_16x16x32_bf16(Bt[n][k], At[m][k], acc[ai][bj][m][n], 0, 0, 0); __builtin_amdgcn_s_setprio(0); } while (0)
#define PG8_WAIT_V(n) asm volatile("s_waitcnt vmcnt(" #n ")" ::: "memory")
#define PG8_WAIT_L(n) asm volatile("s_waitcnt lgkmcnt(" #n ")" ::: "memory")
#define PG8_BAR __builtin_amdgcn_s_barrier()
#define PG8_SCHED __builtin_amdgcn_sched_barrier(0)
#define PG8_UA(u) ((const char*)g.A + (size_t)(u).pm * tstepA + (((u).pn >= g.split_pn) ? (size_t)g.split_aoff * 2 : (size_t)0))
    Unit cur, nxt; int ui = 0;
    if (!S.next(0, cur)) return;
    f32x4 acc[2][2][4][2];
#pragma unroll
    for (int a = 0; a < 2; ++a)
#pragma unroll
        for (int b = 0; b < 2; ++b)
#pragma unroll
            for (int m = 0; m < 4; ++m)
#pragma unroll
                for (int n = 0; n < 2; ++n) acc[a][b][m][n] = (f32x4){0.f, 0.f, 0.f, 0.f};
    bf16x8 At[4][2], B0[2][2], B1[2][2];
    const char* cA = PG8_UA(cur); const char* cB = (const char*)g.Bt + (size_t)cur.pn * tstepB;
    PG8_STAGE(PG8_SB(0, 0), cB, voffB); PG8_STAGE(PG8_SB(0, 1), cB + hstepB, voffB); PG8_STAGE(PG8_SA(0, 0), cA, voffA); PG8_STAGE(PG8_SA(0, 1), cA + hstepA, voffA);
    if (wr == 1) PG8_BAR;
    PG8_WAIT_V(2); PG8_BAR;
    PG8_STAGE(PG8_SB(1, 0), cB + kstep, voffB); PG8_STAGE(PG8_SA(1, 0), cA + kstep, voffA); PG8_STAGE(PG8_SB(1, 1), cB + hstepB + kstep, voffB);
    PG8_WAIT_V(6); PG8_BAR;
    for (;;) {
        const bool has_next = S.next(ui + 1, nxt);
        const char* nA = has_next ? PG8_UA(nxt) : cA; const char* nB = has_next ? (const char*)g.Bt + (size_t)nxt.pn * tstepB : cB;
        for (int t = 0; t < nt; t += 2) {
            if constexpr (Epi::HAS_MID) { if (t == g.mid_t) E.mid(acc, cur, wr, wc, fr, fq); }
            const bool last = (t == nt - 2);
            const char* a1 = cA + (size_t)(t + 1) * kstep;
            const char* a2 = last ? nA : cA + (size_t)(t + 2) * kstep; const char* b2 = last ? nB : cB + (size_t)(t + 2) * kstep;
            const char* a3 = a2 + kstep; const char* b3 = b2 + kstep;
            PG8_LDB(B0, 0, 0); PG8_LDB(B1, 0, 1); PG8_SCHED; PG8_LDA(At, 0, 0); PG8_STAGE(PG8_SA(1, 1), a1 + hstepA, voffA);
            PG8_WAIT_V(8); PG8_WAIT_L(0); PG8_BAR; PG8_MMA(0, 0, At, B0); PG8_MMA(0, 1, At, B1); PG8_BAR; PG8_SCHED;
            PG8_LDA(At, 0, 1); PG8_STAGE(PG8_SB(0, 0), b2, voffB); PG8_STAGE(PG8_SB(0, 1), b2 + hstepB, voffB); PG8_STAGE(PG8_SA(0, 0), a2, voffA);
            PG8_WAIT_V(8); PG8_WAIT_L(0); PG8_BAR; PG8_MMA(1, 0, At, B0); PG8_MMA(1, 1, At, B1); PG8_BAR; PG8_SCHED;
            PG8_LDB(B0, 1, 0); PG8_LDB(B1, 1, 1); PG8_SCHED; PG8_LDA(At, 1, 0); PG8_STAGE(PG8_SA(0, 1), a2 + hstepA, voffA);
            PG8_WAIT_V(8); PG8_WAIT_L(0); PG8_BAR; PG8_MMA(0, 0, At, B0); PG8_MMA(0, 1, At, B1); PG8_BAR; PG8_SCHED;
            PG8_LDA(At, 1, 1); PG8_STAGE(PG8_SB(1, 0), b3, voffB); PG8_STAGE(PG8_SB(1, 1), b3 + hstepB, voffB); PG8_STAGE(PG8_SA(1, 0), a3, voffA);
            PG8_WAIT_V(8); PG8_WAIT_L(0); PG8_BAR; PG8_MMA(1, 0, At, B0); PG8_MMA(1, 1, At, B1); PG8_BAR; PG8_SCHED;
        }
        if (wr == 0) PG8_BAR;
        E(acc, cur, wr, wc, fr, fq);
        if (!has_next) break;
#pragma unroll
        for (int a = 0; a < 2; ++a)
#pragma unroll
            for (int b = 0; b < 2; ++b)
#pragma unroll
                for (int m = 0; m < 4; ++m)
#pragma unroll
                    for (int n = 0; n < 2; ++n) acc[a][b][m][n] = (f32x4){0.f, 0.f, 0.f, 0.f};
        cur = nxt; cA = nA; cB = nB; ++ui;
        if (wr == 1) PG8_BAR;
    }
    PG8_WAIT_V(0);
    PG8_BAR;
#undef PG8_SA
#undef PG8_SB
#undef PG8_STAGE
#undef PG8_LDA
#undef PG8_LDB
#undef PG8_MMA
#undef PG8_UA
}
}

__device__ __forceinline__ float row_rs(const float* rsp, int row) {
    const f32x4* p = (const f32x4*)(rsp + (size_t)row * 16);
    f32x4 a = p[0], b = p[1], c = p[2], d = p[3];
    float s = ((a.x + a.y) + (a.z + a.w)) + ((b.x + b.y) + (b.z + b.w)) + ((c.x + c.y) + (c.z + c.w)) + ((d.x + d.y) + (d.z + d.w));
    return __builtin_amdgcn_rsqf(s * (1.0f / Dm) + EPS);
}
__device__ __forceinline__ void rows_rs4(const float* rsp, int row0  , float (&rs)[4]) {
#pragma unroll
    for (int mp = 0; mp < 2; ++mp) {
        f32x4 p[2][4];
#pragma unroll
        for (int m = 0; m < 2; ++m) { const f32x4* q = (const f32x4*)(rsp + (size_t)(row0 + 16 * (2 * mp + m)) * 16);
#pragma unroll
            for (int i = 0; i < 4; ++i) p[m][i] = q[i]; }
#pragma unroll
        for (int m = 0; m < 2; ++m) { float t = 0.f;
#pragma unroll
            for (int i = 0; i < 4; ++i) t += (p[m][i].x + p[m][i].y) + (p[m][i].z + p[m][i].w);
            rs[2 * mp + m] = __builtin_amdgcn_rsqf(t * (1.0f / Dm) + EPS); }
        __builtin_amdgcn_sched_barrier(0);
    }
}
__device__ __forceinline__ void rows_rs2(const float* rsp, int row0, float (&rs)[2]) {
    f32x4 p[2][4];
#pragma unroll
    for (int m = 0; m < 2; ++m) { const f32x4* q = (const f32x4*)(rsp + (size_t)(row0 + 16 * m) * 16);
#pragma unroll
        for (int i = 0; i < 4; ++i) p[m][i] = q[i]; }
#pragma unroll
    for (int m = 0; m < 2; ++m) { float t = 0.f;
#pragma unroll
        for (int i = 0; i < 4; ++i) t += (p[m][i].x + p[m][i].y) + (p[m][i].z + p[m][i].w);
        rs[m] = __builtin_amdgcn_rsqf(t * (1.0f / Dm) + EPS); }
}
__device__ __forceinline__ u32x4 pack8(const float* v) { u32x4 w; w.x = pk2(v[0], v[1]); w.y = pk2(v[2], v[3]); w.z = pk2(v[4], v[5]); w.w = pk2(v[6], v[7]); return w; }

struct EpiMix {
    static constexpr bool HAS_MID = false;
    const float* rsp; const float* cs; const float* lbF; const float* lbB;
    bf16_t *Q, *Kk, *V, *HQ, *HV, *BG, *GF, *GB;
    template <int GRP>
    __device__ __forceinline__ void run(const f32x4 (&acc)[2][2][4][2], const pg8::Unit& u, int wr, int wc, int fr, int fq) const {
#pragma unroll
        for (int ai = 0; ai < 2; ++ai)
#pragma unroll
        for (int mp = 0; mp < 2; ++mp) {
            const int row0 = u.pm * 256 + ai * 128 + wr * 64 + mp * 32 + fr;
            float rs4[2]; rows_rs2(rsp, row0, rs4);
            const int d0r = (wc * 32 + fq * 8) & 63;
            f32x4 c4r[2], s4r[2];
            if constexpr (GRP <= 1) {
                if (d0r < 16) {
#pragma unroll
                    for (int mm = 0; mm < 2; ++mm) { const float* cp = cs + (size_t)(row0 + 16 * mm) * 16 + (d0r >> 3) * 4; c4r[mm] = *(const f32x4*)cp; s4r[mm] = *(const f32x4*)(cp + 8); }
                }
            }
            __builtin_amdgcn_sched_barrier(0);
#pragma unroll
            for (int mm = 0; mm < 2; ++mm) {
                const int m = 2 * mp + mm;
                const int row = row0 + mm * 16;
                const float rs = rs4[mm];
                const int b = row >> 12, s = row & 4095;
#pragma unroll
                for (int bj = 0; bj < 2; ++bj) {
                    const int col = u.pn * 256 + bj * 128 + wc * 32 + fq * 8;
                    const int jj = col & 511;
                    float v[8];
#pragma unroll
                    for (int e = 0; e < 4; ++e) { v[e] = acc[ai][bj][m][0][e] * rs; v[4 + e] = acc[ai][bj][m][1][e] * rs; }
                    if constexpr (GRP <= 1) {
                        const int d0 = jj & 63;
                        if (d0 < 16) {
                            const f32x4 c4 = c4r[mm], s4 = s4r[mm];
#pragma unroll
                            for (int e = 0; e < 4; ++e) { const float t1 = v[e], t2 = v[4 + e]; v[e] = t1 * c4[e] - t2 * s4[e]; v[4 + e] = t2 * c4[e] + t1 * s4[e]; }
                        }
                        if constexpr (GRP == 0) {
#pragma unroll
                            for (int e = 0; e < 8; ++e) v[e] *= 0.125f * LOG2E;
                        }
                        const int h = jj >> 7, c = (jj >> 6) & 1;
                        bf16_t* dst = (GRP == 0 ? Q : Kk) + ((size_t)(((b * 4 + h) * 2 + c) * SEQ + s)) * 64 + d0;
                        *(u32x4*)dst = pack8(v);
                    } else if constexpr (GRP == 2) {
                        const int h = jj >> 7, d0 = jj & 127;
                        *(u32x4*)(V + ((size_t)((b * 4 + h) * SEQ + s)) * 128 + d0) = pack8(v);
                    } else if constexpr (GRP == 3) {
                        *(u32x4*)(HQ + (size_t)row * 512 + jj) = pack8(v);
                    } else if constexpr (GRP == 4 || GRP == 5) {
                        const float* lbp = (GRP == 4 ? lbF : lbB) + jj;
                        const f32x4 l0 = *(const f32x4*)lbp, l1 = *(const f32x4*)(lbp + 4);
                        float gl[8];
#pragma unroll
                        for (int e = 0; e < 8; ++e) { const float lb = e < 4 ? l0[e] : l1[e - 4]; const float f = lb + (1.0f - lb) * sigmoidf_(v[e]); gl[e] = __builtin_amdgcn_logf(fmaxf(f, 1e-37f)) * 0.6931471805599453f; }
                        *(u32x4*)((GRP == 4 ? GF : GB) + (size_t)row * 512 + jj) = pack8(gl);
                    } else if constexpr (GRP == 6) {
                        *(u32x4*)(HV + (size_t)row * 512 + jj) = pack8(v);
                    } else {
#pragma unroll
                        for (int e = 0; e < 8; ++e) v[e] = sigmoidf_(v[e]);
                        *(u32x4*)(BG + (size_t)row * 512 + jj) = pack8(v);
                    }
                }
            }
            __builtin_amdgcn_sched_barrier(0);
        }
    }
    __device__ __forceinline__ void operator()(const f32x4 (&acc)[2][2][4][2], const pg8::Unit& u, int wr, int wc, int fr, int fq) const {
        switch (u.pn >> 1) {
            case 0: run<0>(acc, u, wr, wc, fr, fq); break;
            case 1: run<1>(acc, u, wr, wc, fr, fq); break;
            case 2: run<2>(acc, u, wr, wc, fr, fq); break;
            case 3: run<3>(acc, u, wr, wc, fr, fq); break;
            case 4: run<4>(acc, u, wr, wc, fr, fq); break;
            case 5: run<5>(acc, u, wr, wc, fr, fq); break;
            case 6: run<6>(acc, u, wr, wc, fr, fq); break;
            default: run<7>(acc, u, wr, wc, fr, fq); break;
        }
    }
};

struct EpiGate {
    static constexpr bool HAS_MID = false;
    const float* rsp; bf16_t* G;
    __device__ __forceinline__ void operator()(const f32x4 (&acc)[2][2][4][2], const pg8::Unit& u, int wr, int wc, int fr, int fq) const {
#pragma unroll
        for (int ai = 0; ai < 2; ++ai) {
            const int row0 = u.pm * 256 + ai * 128 + wr * 64 + fr;
            float rs4[4]; rows_rs4(rsp, row0, rs4);
            __builtin_amdgcn_sched_barrier(0);
#pragma unroll
            for (int m = 0; m < 4; ++m) {
                const int row = row0 + m * 16;
                const float rs = rs4[m];
                const int col = u.pn * 128 + wc * 32 + fq * 8;
                float r[8], sb[8];
                const float nrl = -rs * LOG2E;
#pragma unroll
                for (int n = 0; n < 2; ++n) {
                    f32x4 ta = acc[ai][0][m][n] * nrl, tb = acc[ai][1][m][n] * nrl;
                    ta = __builtin_elementwise_min(ta, (f32x4){86.f, 86.f, 86.f, 86.f}); tb = __builtin_elementwise_min(tb, (f32x4){86.f, 86.f, 86.f, 86.f});
                    ta.x = __builtin_amdgcn_exp2f(ta.x); ta.y = __builtin_amdgcn_exp2f(ta.y); ta.z = __builtin_amdgcn_exp2f(ta.z); ta.w = __builtin_amdgcn_exp2f(ta.w);
                    tb.x = __builtin_amdgcn_exp2f(tb.x); tb.y = __builtin_amdgcn_exp2f(tb.y); tb.z = __builtin_amdgcn_exp2f(tb.z); tb.w = __builtin_amdgcn_exp2f(tb.w);
                    ta = ta + 1.0f; tb = tb + 1.0f;
                    f32x4 ia, ib;
                    ia.x = __builtin_amdgcn_rcpf(ta.x); ia.y = __builtin_amdgcn_rcpf(ta.y); ia.z = __builtin_amdgcn_rcpf(ta.z); ia.w = __builtin_amdgcn_rcpf(ta.w);
                    ib.x = __builtin_amdgcn_rcpf(tb.x); ib.y = __builtin_amdgcn_rcpf(tb.y); ib.z = __builtin_amdgcn_rcpf(tb.z); ib.w = __builtin_amdgcn_rcpf(tb.w);
                    const f32x4 rr = tb * ia;
                    r[n * 4] = rr.x; r[n * 4 + 1] = rr.y; r[n * 4 + 2] = rr.z; r[n * 4 + 3] = rr.w;
                    sb[n * 4] = ib.x; sb[n * 4 + 1] = ib.y; sb[n * 4 + 2] = ib.z; sb[n * 4 + 3] = ib.w;
                }
                *(u32x4*)(G + (size_t)row * 2048 + col) = pack8(r);
                *(u32x4*)(G + (size_t)row * 2048 + 1024 + col) = pack8(sb);
            }
            __builtin_amdgcn_sched_barrier(0);
        }
    }
};

struct EpiY {
    static constexpr bool HAS_MID = true;
    const bf16_t* G; bf16_t* Y;
    __device__ __forceinline__ void mid(f32x4 (&acc)[2][2][4][2], const pg8::Unit& u, int wr, int wc, int fr, int fq) const {
        int fr_ = fr; asm volatile("" : "+v"(fr_));
#pragma unroll
        for (int ai = 0; ai < 2; ++ai) {
            __builtin_amdgcn_sched_barrier(0);
#pragma unroll
            for (int m = 0; m < 4; ++m) {
                const int row = u.pm * 256 + ai * 128 + wr * 64 + m * 16 + fr_;
#pragma unroll
                for (int bj = 0; bj < 2; ++bj) {
                    const int col = u.pn * 256 + bj * 128 + wc * 32 + fq * 8;
                    const u32x4 gq = *(const u32x4*)(G + (size_t)row * 2048 + col);
                    acc[ai][bj][m][0][0] *= bflo(gq.x); acc[ai][bj][m][0][1] *= bfhi(gq.x); acc[ai][bj][m][0][2] *= bflo(gq.y); acc[ai][bj][m][0][3] *= bfhi(gq.y);
                    acc[ai][bj][m][1][0] *= bflo(gq.z); acc[ai][bj][m][1][1] *= bfhi(gq.z); acc[ai][bj][m][1][2] *= bflo(gq.w); acc[ai][bj][m][1][3] *= bfhi(gq.w);
                }
            }
        }
        __builtin_amdgcn_sched_barrier(0);
    }
    __device__ __forceinline__ void operator()(const f32x4 (&acc)[2][2][4][2], const pg8::Unit& u, int wr, int wc, int fr, int fq) const {
#pragma unroll
        for (int ai = 0; ai < 2; ++ai) {
            u32x4 gqr[4][2];
#pragma unroll
            for (int m = 0; m < 4; ++m)
#pragma unroll
                for (int bj = 0; bj < 2; ++bj) gqr[m][bj] = *(const u32x4*)(G + (size_t)(u.pm * 256 + ai * 128 + wr * 64 + m * 16 + fr) * 2048 + 1024 + u.pn * 256 + bj * 128 + wc * 32 + fq * 8);
            __builtin_amdgcn_sched_barrier(0);
#pragma unroll
            for (int m = 0; m < 4; ++m) {
                const int row = u.pm * 256 + ai * 128 + wr * 64 + m * 16 + fr;
#pragma unroll
                for (int bj = 0; bj < 2; ++bj) {
                    const int col = u.pn * 256 + bj * 128 + wc * 32 + fq * 8;
                    const u32x4 gq = gqr[m][bj];
                    float v[8];
                    v[0] = acc[ai][bj][m][0][0] * bflo(gq.x); v[1] = acc[ai][bj][m][0][1] * bfhi(gq.x);
                    v[2] = acc[ai][bj][m][0][2] * bflo(gq.y); v[3] = acc[ai][bj][m][0][3] * bfhi(gq.y);
                    v[4] = acc[ai][bj][m][1][0] * bflo(gq.z); v[5] = acc[ai][bj][m][1][1] * bfhi(gq.z);
                    v[6] = acc[ai][bj][m][1][2] * bflo(gq.w); v[7] = acc[ai][bj][m][1][3] * bfhi(gq.w);
                    *(u32x4*)(Y + (size_t)row * 1024 + col) = pack8(v);
                }
            }
            __builtin_amdgcn_sched_barrier(0);
        }
    }
};

struct EpiRes {
    static constexpr bool HAS_MID = false;
    bf16_t* XB; float* rsp;
    __device__ __forceinline__ void operator()(const f32x4 (&acc)[2][2][4][2], const pg8::Unit& u, int wr, int wc, int fr, int fq) const {
#pragma unroll
        for (int ai = 0; ai < 2; ++ai) {
            u32x4 xr[4][2];
#pragma unroll
            for (int m = 0; m < 4; ++m)
#pragma unroll
                for (int bj = 0; bj < 2; ++bj) xr[m][bj] = *(const u32x4*)(XB + (size_t)(u.pm * 256 + ai * 128 + wr * 64 + m * 16 + fr) * Dm + u.pn * 256 + bj * 128 + wc * 32 + fq * 8);
            __builtin_amdgcn_sched_barrier(0);
#pragma unroll
            for (int m = 0; m < 4; ++m) {
                const int row = u.pm * 256 + ai * 128 + wr * 64 + m * 16 + fr;
                float ss = 0.f;
#pragma unroll
                for (int bj = 0; bj < 2; ++bj) {
                    const int col = u.pn * 256 + bj * 128 + wc * 32 + fq * 8;
                    const u32x4 x = xr[m][bj];
                    float v[8];
                    v[0] = bflo(x.x) + acc[ai][bj][m][0][0]; v[1] = bfhi(x.x) + acc[ai][bj][m][0][1]; v[2] = bflo(x.y) + acc[ai][bj][m][0][2]; v[3] = bfhi(x.y) + acc[ai][bj][m][0][3];
                    v[4] = bflo(x.z) + acc[ai][bj][m][1][0]; v[5] = bfhi(x.z) + acc[ai][bj][m][1][1]; v[6] = bflo(x.w) + acc[ai][bj][m][1][2]; v[7] = bfhi(x.w) + acc[ai][bj][m][1][3];
#pragma unroll
                    for (int e = 0; e < 8; ++e) ss += v[e] * v[e];
                    *(u32x4*)(XB + (size_t)row * Dm + col) = pack8(v);
                }
                ss += __shfl_xor(ss, 16); ss += __shfl_xor(ss, 32);
                if (fq == 0) rsp[(size_t)row * 16 + u.pn * 4 + wc] = ss;
            }
            __builtin_amdgcn_sched_barrier(0);
        }
    }
};

struct EpiGU {
    static constexpr bool HAS_MID = false;
    const float* rsp; bf16_t* H;
    __device__ __forceinline__ void operator()(const f32x4 (&acc)[2][2][4][2], const pg8::Unit& u, int wr, int wc, int fr, int fq) const {
#pragma unroll
        for (int ai = 0; ai < 2; ++ai) {
            const int row0 = u.pm * 256 + ai * 128 + wr * 64 + fr;
            float rs4[4]; rows_rs4(rsp, row0, rs4);
            __builtin_amdgcn_sched_barrier(0);
#pragma unroll
            for (int m = 0; m < 4; ++m) {
                const int row = row0 + m * 16;
                const float rs = rs4[m];
                const int col = u.pn * 128 + wc * 32 + fq * 8;
                float v[8];
                const float nrl = -rs * LOG2E, rs2 = rs * rs;
#pragma unroll
                for (int n = 0; n < 2; ++n) {
                    const f32x4 a = acc[ai][0][m][n], b = acc[ai][1][m][n];
                    f32x4 t = a * nrl;
                    t.x = __builtin_amdgcn_exp2f(t.x); t.y = __builtin_amdgcn_exp2f(t.y); t.z = __builtin_amdgcn_exp2f(t.z); t.w = __builtin_amdgcn_exp2f(t.w);
                    t = t + 1.0f;
                    t.x = __builtin_amdgcn_rcpf(t.x); t.y = __builtin_amdgcn_rcpf(t.y); t.z = __builtin_amdgcn_rcpf(t.z); t.w = __builtin_amdgcn_rcpf(t.w);
                    const f32x4 o = ((a * b) * rs2) * t;
                    v[n * 4] = o.x; v[n * 4 + 1] = o.y; v[n * 4 + 2] = o.z; v[n * 4 + 3] = o.w;
                }
                *(u32x4*)(H + (size_t)row * FF + col) = pack8(v);
            }
            __builtin_amdgcn_sched_barrier(0);
        }
    }
};

__device__ __forceinline__ int rope_perm(int n) {
    const int d = n & 63; if (d >= 16) return n;
    const int g = d >> 3, e = d & 7; return (n & ~63) + ((e < 4) ? 4 * g + e : 8 + 4 * g + (e - 4));
}
__device__ __forceinline__ void conv_item(const float* src, int ld_src, int ks0, int c0  , int mode  ,
                                          const float* gain, bf16_t* dst, int ld_dst, int n0, int kd0, LAS float* scr, int lane) {
    const int n4 = lane & 7, kr = lane >> 3;
    int sc = c0 + 4 * n4;
    if (mode) { const int q = (sc & 63) >> 2; if (q == 1) sc += 4; else if (q == 2) sc -= 4; }
#pragma unroll
    for (int i = 0; i < 8; ++i) { const int kk = kr + 8 * i; f32x4 w = *(const f32x4*)(src + (size_t)(ks0 + kk) * ld_src + sc);
        if (gain) { const float gg = gain[ks0 + kk]; w.x *= gg; w.y *= gg; w.z *= gg; w.w *= gg; }
        LAS float* d = scr + kk * 33 + 4 * n4; d[0] = w.x; d[1] = w.y; d[2] = w.z; d[3] = w.w; }
    asm volatile("s_waitcnt lgkmcnt(0)" ::: "memory");
    const int c = lane & 7;
#pragma unroll
    for (int j = 0; j < 4; ++j) { const int n = (lane >> 3) + 8 * j; const LAS float* s = scr + (8 * c) * 33 + n;
        u32x4 o; o.x = pk2(s[0 * 33], s[1 * 33]); o.y = pk2(s[2 * 33], s[3 * 33]); o.z = pk2(s[4 * 33], s[5 * 33]); o.w = pk2(s[6 * 33], s[7 * 33]);
        *(u32x4*)(dst + (size_t)(n0 + n) * ld_dst + kd0 + 8 * c) = o; }
    asm volatile("s_waitcnt lgkmcnt(0)" ::: "memory");
}

struct Ptrs {
    const float *x; const int* pos; const float *w_in, *da_lambda, *da_norm, *hg_lb, *hg_norm, *w_a, *w_b, *w_o, *attn_norm, *ffn_norm, *w_gate, *w_up, *w_down, *final_norm;
    float* out; unsigned char* ws; int ph_lo, ph_hi;
};

__device__ __forceinline__ void convert_layer(const Ptrs& P, int layer, unsigned char* wbuf, LAS unsigned char* lds, int gw, int ngw, int wave, int lane) {
    LAS float* scr = (LAS float*)(lds + wave * 8704);
    constexpr int I_IN = 16 * 192, I_A = 8 * 32, I_B = 8 * 32, I_O = 16 * 32, I_GU = 16 * 176, I_D = 44 * 32;
    constexpr int NIT = I_IN + I_A + I_B + I_O + I_GU + I_D;
    for (int it = gw; it < NIT; it += ngw) {
        int r = it;
        if (r < I_IN) { const int kb = r / 192, nb = r % 192, n0 = nb * 32;
            int c0 = n0; if (n0 >= 4096) { const int q = n0 - 4096, tile = q >> 8, rr = q & 255; c0 = (rr < 128 ? 4096 : 5120) + tile * 128 + (rr & 127); }
            conv_item(P.w_in + (size_t)layer * Dm * INW, INW, kb * 64, c0, n0 < 1024 ? 1 : 0, P.attn_norm + layer * Dm, (bf16_t*)(wbuf + W_IN), Dm, n0, kb * 64, scr, lane); continue; }
        r -= I_IN;
        if (r < I_A) { const int kb = r / 32, nb = r % 32;
            conv_item(P.w_a + (size_t)layer * 512 * Dm, Dm, kb * 64, nb * 32, 0, nullptr, (bf16_t*)(wbuf + W_AB), 1024, nb * 32, kb * 64, scr, lane); continue; }
        r -= I_A;
        if (r < I_B) { const int kb = r / 32, nb = r % 32;
            conv_item(P.w_b + (size_t)layer * 512 * Dm, Dm, kb * 64, nb * 32, 0, nullptr, (bf16_t*)(wbuf + W_AB), 1024, nb * 32, 512 + kb * 64, scr, lane); continue; }
        r -= I_B;
        if (r < I_O) { const int kb = r / 32, nb = r % 32;
            conv_item(P.w_o + (size_t)layer * Dm * Dm, Dm, kb * 64, nb * 32, 0, nullptr, (bf16_t*)(wbuf + W_O2), Dm, nb * 32, kb * 64, scr, lane); continue; }
        r -= I_O;
        if (r < I_GU) { const int kb = r / 176, nb = r % 176, n0 = nb * 32, tile = n0 >> 8, rr = n0 & 255;
            const float* srcm = (rr < 128 ? P.w_gate : P.w_up) + (size_t)layer * Dm * FF;
            conv_item(srcm, FF, kb * 64, tile * 128 + (rr & 127), 0, P.ffn_norm + layer * Dm, (bf16_t*)(wbuf + W_GU), Dm, n0, kb * 64, scr, lane); continue; }
        r -= I_GU;
        { const int kb = r / 32, nb = r % 32;
            conv_item(P.w_down + (size_t)layer * FF * Dm, Dm, kb * 64, nb * 32, 0, nullptr, (bf16_t*)(wbuf + W_D), FF, nb * 32, kb * 64, scr, lane); }
    }
}

__device__ __forceinline__ float wave_sum(float v) {
#pragma unroll
    for (int o = 1; o < 64; o <<= 1) v += __shfl_xor(v, o);
    return v;
}
__device__ __forceinline__ void prologue(const Ptrs& P, LAS unsigned char* lds, int gw, int ngw, int wave, int lane) {
    unsigned char* ws = P.ws;
    bf16_t* XB = (bf16_t*)(ws + OFF_XB); float* rsb = (float*)(ws + OFF_RSB);
    for (int r = gw; r < M; r += ngw) {
        const f32x4* xr = (const f32x4*)(P.x + (size_t)r * Dm) + lane;
        float ss = 0.f;
#pragma unroll
        for (int j = 0; j < 4; ++j) { const f32x4 v = xr[64 * j]; ss += (v.x * v.x + v.y * v.y) + (v.z * v.z + v.w * v.w);
            u32x2 o; o.x = pk2(v.x, v.y); o.y = pk2(v.z, v.w); *((u32x2*)(XB + (size_t)r * Dm) + lane + 64 * j) = o; }
        ss = wave_sum(ss);
        if (lane < 16) rsb[(size_t)r * 16 + lane] = (lane == 0) ? ss : 0.f;
    }
    const int gt = gw * 64 + lane, ngt = ngw * 64;
    float* cs = (float*)(ws + OFF_CS);
    for (int i = gt; i < M * 8; i += ngt) {
        const int tok = i >> 3, f = i & 7;
        const double invf[8] = {1.0, 0.19392274474868576, 0.03760603093086393, 0.007292664737217109, 0.001414213562373095, 0.0002742481756762073, 5.318295896944988e-05, 1.031338537721246e-05};
        double fr;
        switch (f) { case 0: fr = invf[0]; break; case 1: fr = invf[1]; break; case 2: fr = invf[2]; break; case 3: fr = invf[3]; break; case 4: fr = invf[4]; break; case 5: fr = invf[5]; break; case 6: fr = invf[6]; break; default: fr = invf[7]; }
        const float ang32 = (float)P.pos[tok] * (float)fr;
        const double ang = (double)ang32;
        const double rev = ang * 0.15915494309189535;
        const double fracrev = rev - __builtin_floor(rev + 0.5);
        const float a = (float)(fracrev * 6.283185307179586);
        cs[(size_t)tok * 16 + f] = __cosf(a); cs[(size_t)tok * 16 + 8 + f] = __sinf(a);
    }
    float* LB = (float*)(ws + OFF_LB);
    for (int i = gt; i < 2 * 512; i += ngt) {
        const int d = i >> 9, k = i & 511;
        float l[4], mx = -1e30f;
#pragma unroll
        for (int j = 0; j < 4; ++j) { l[j] = P.hg_lb[(size_t)(d * 4 + j) * 512 + k]; mx = fmaxf(mx, l[j]); }
        float e[4], sum = 0.f;
#pragma unroll
        for (int j = 0; j < 4; ++j) { e[j] = __expf(l[j] - mx); sum += e[j]; }
        float cum = 0.f;
#pragma unroll
        for (int j = 0; j < 4; ++j) { if (j > 0) cum += e[j] / sum; LB[(size_t)(d * 4 + j) * 512 + k] = cum; }
    }
    if (gw == 0) {
        float* LAM = (float*)(ws + OFF_LAM);
        for (int l = 0; l < 4; ++l) {
            const float* p = P.da_lambda + l * 256;
            float a = wave_sum(p[lane] * p[64 + lane]), b = wave_sum(p[128 + lane] * p[192 + lane]);
            const float lam_init = 0.8f - 0.6f * __expf(-0.3f * (float)l);
            if (lane == 0) LAM[l] = __expf(a) - __expf(b) + lam_init;
        }
    }
}

constexpr int AT_KROW = 144, AT_VROW = 320, AT_K1 = 64 * AT_KROW, AT_V = 2 * AT_K1, AT_STG = AT_V + 64 * AT_VROW;
constexpr int AT_IMG_ROW = 132;
__device__ __forceinline__ s16x4 tr_read(const LAS unsigned char* p) { return __builtin_bit_cast(s16x4, __builtin_amdgcn_ds_read_tr16_b64_v4i16((LAS s16x4*)p)); }

__device__ __forceinline__ void attn_unit(int b, int h, int qb, const bf16_t* Q, const bf16_t* Kk, const bf16_t* V, bf16_t* AO, const float* gainA  , float one_minus_lam_init, float lam, LAS unsigned char* lds) {
    int tid_ = threadIdx.x; asm volatile("" : "+v"(tid_));
    const int tid = tid_, wave = __builtin_amdgcn_readfirstlane(tid >> 6), lane = tid & 63, c = wave >> 2, wq = wave & 3, r32 = lane & 31, hh = lane >> 5;
    const int q0 = qb * 128 + wq * 32;
    bf16x8 qf[4];
    { const bf16_t* Qp = Q + ((size_t)(((b * 4 + h) * 2 + c) * SEQ + q0 + r32)) * 64 + 8 * hh;
#pragma unroll
      for (int s = 0; s < 4; ++s) qf[s] = *(const bf16x8*)(Qp + 16 * s); }
    f32x16 o[4];
#pragma unroll
    for (int i = 0; i < 4; ++i)
#pragma unroll
        for (int e = 0; e < 16; ++e) o[i][e] = 0.f;
    float mrow = -1e30f, lrow = 0.f;
    const unsigned char* Kg0 = (const unsigned char*)(Kk + ((size_t)((b * 4 + h) * 2 + 0) * SEQ) * 64);
    const unsigned char* Kg1 = (const unsigned char*)(Kk + ((size_t)((b * 4 + h) * 2 + 1) * SEQ) * 64);
    const unsigned char* Vg = (const unsigned char*)(V + ((size_t)(b * 4 + h) * SEQ) * 128);
    const int lk = (tid >> 3) * AT_KROW + (tid & 7) * 16;
    const int lv0 = AT_V + (tid >> 4) * AT_VROW + (tid & 15) * 16, lv1 = lv0 + 32 * AT_VROW;
    u32x4 r0, r1, r2, r3;
    r0 = *(const u32x4*)(Kg0 + tid * 16); r1 = *(const u32x4*)(Kg1 + tid * 16); r2 = *(const u32x4*)(Vg + tid * 16); r3 = *(const u32x4*)(Vg + 8192 + tid * 16);
    *(LAS u32x4*)(lds + lk) = r0; *(LAS u32x4*)(lds + AT_K1 + lk) = r1; *(LAS u32x4*)(lds + lv0) = r2; *(LAS u32x4*)(lds + lv1) = r3;
    r0 = *(const u32x4*)(Kg0 + 8192 + tid * 16); r1 = *(const u32x4*)(Kg1 + 8192 + tid * 16);
    *(LAS u32x4*)(lds + AT_STG + lk) = r0; *(LAS u32x4*)(lds + AT_STG + AT_K1 + lk) = r1;
    __syncthreads();
    const int ka = c * AT_K1 + r32 * AT_KROW + hh * 16;
    const int va = AT_V + (4 * hh + ((lane & 15) >> 2)) * AT_VROW + ((lane >> 4) & 1) * 32 + (lane & 3) * 8;

#define AT_QK(sv, st) do { f32x16 t0_, t1_; _Pragma("unroll") for (int e = 0; e < 16; ++e) { t0_[e] = 0.f; t1_[e] = 0.f; } \
        _Pragma("unroll") for (int ks = 0; ks < 4; ++ks) { \
            const bf16x8 a0 = *(const LAS bf16x8*)(lds + (st) + ka + ks * 32), a1 = *(const LAS bf16x8*)(lds + (st) + ka + 32 * AT_KROW + ks * 32); \
            t0_ = __builtin_amdgcn_mfma_f32_32x32x16_bf16(a0, qf[ks], t0_, 0, 0, 0); t1_ = __builtin_amdgcn_mfma_f32_32x32x16_bf16(a1, qf[ks], t1_, 0, 0, 0); } \
        sv##0 = t0_; sv##1 = t1_; } while (0)
    f32x16 sA0, sA1, sB0, sB1;
    AT_QK(sA, 0);
#define AT_VFRAG(dst, STC, g) do { const LAS unsigned char* vb_ = lds + (STC) + va + (16 * (g)) * AT_VROW; \
        _Pragma("unroll") for (int vt = 0; vt < 4; ++vt) { const s16x4 t0 = tr_read(vb_ + vt * 64), t1 = tr_read(vb_ + vt * 64 + 8 * AT_VROW); \
            dst[vt] = (bf16x8){t0[0], t0[1], t0[2], t0[3], t1[0], t1[1], t1[2], t1[3]}; } } while (0)
#define AT_PV(vf, p) do { __builtin_amdgcn_s_setprio(1); _Pragma("unroll") for (int vt = 0; vt < 4; ++vt) o[vt] = __builtin_amdgcn_mfma_f32_32x32x16_bf16(vf[vt], p, o[vt], 0, 0, 0); __builtin_amdgcn_s_setprio(0); } while (0)
#define AT_SB __builtin_amdgcn_sched_barrier(0)
#define AT_TILE(j, s0, s1, sn, STC  , STN  ) do { \
        if ((j) + 2 < 64) { const size_t go = (size_t)((j) + 2) * 8192; r0 = *(const u32x4*)(Kg0 + go + tid * 16); r1 = *(const u32x4*)(Kg1 + go + tid * 16); } \
        if ((j) + 1 < 64) { const size_t go = (size_t)((j) + 1) * 16384; r2 = *(const u32x4*)(Vg + go + tid * 16); r3 = *(const u32x4*)(Vg + go + 8192 + tid * 16); } \
        bf16x8 kf[4], kg[4], vA[4]; \
        if ((j) + 1 < 64) { _Pragma("unroll") for (int ks = 0; ks < 2; ++ks) { kf[2 * ks] = *(const LAS bf16x8*)(lds + (STN) + ka + ks * 32); kf[2 * ks + 1] = *(const LAS bf16x8*)(lds + (STN) + ka + 32 * AT_KROW + ks * 32); } } \
        AT_SB; \
        float mx = fmaxf(s0[0], s1[0]); \
        _Pragma("unroll") for (int e = 1; e < 16; ++e) mx = fmaxf(mx, fmaxf(s0[e], s1[e])); \
        mx = fmaxf(mx, __shfl_xor(mx, 32)); \
        if (__builtin_amdgcn_ballot_w64(mx > mrow + 8.0f) != 0ull) { \
            const float mnew = fmaxf(mrow, mx), alpha = __builtin_amdgcn_exp2f(mrow - mnew); mrow = mnew; lrow *= alpha; \
            _Pragma("unroll") for (int i = 0; i < 4; ++i) _Pragma("unroll") for (int e = 0; e < 16; ++e) o[i][e] *= alpha; } \
        AT_SB; \
        if ((j) + 1 < 64) { f32x16 t0_, t1_; _Pragma("unroll") for (int e = 0; e < 16; ++e) { t0_[e] = 0.f; t1_[e] = 0.f; } \
            __builtin_amdgcn_s_setprio(1); \
            _Pragma("unroll") for (int ks = 0; ks < 2; ++ks) { t0_ = __builtin_amdgcn_mfma_f32_32x32x16_bf16(kf[2 * ks], qf[ks], t0_, 0, 0, 0); t1_ = __builtin_amdgcn_mfma_f32_32x32x16_bf16(kf[2 * ks + 1], qf[ks], t1_, 0, 0, 0); } \
            AT_SB; \
            _Pragma("unroll") for (int ks = 0; ks < 2; ++ks) { kg[2 * ks] = *(const LAS bf16x8*)(lds + (STN) + ka + (ks + 2) * 32); kg[2 * ks + 1] = *(const LAS bf16x8*)(lds + (STN) + ka + 32 * AT_KROW + (ks + 2) * 32); } \
            AT_SB; \
            _Pragma("unroll") for (int ks = 0; ks < 2; ++ks) { t0_ = __builtin_amdgcn_mfma_f32_32x32x16_bf16(kg[2 * ks], qf[ks + 2], t0_, 0, 0, 0); t1_ = __builtin_amdgcn_mfma_f32_32x32x16_bf16(kg[2 * ks + 1], qf[ks + 2], t1_, 0, 0, 0); } \
            __builtin_amdgcn_s_setprio(0); sn##0 = t0_; sn##1 = t1_; } \
        AT_VFRAG(vA, STC, 0); \
        AT_SB; \
        float ls = 0.f; \
        _Pragma("unroll") for (int e = 0; e < 16; ++e) { s0[e] = __builtin_amdgcn_exp2f(s0[e] - mrow); s1[e] = __builtin_amdgcn_exp2f(s1[e] - mrow); ls += s0[e] + s1[e]; } \
        lrow += ls; \
        bf16x8 pf[2][2]; \
        _Pragma("unroll") for (int s = 0; s < 2; ++s) { u32x4 w0, w1; \
            w0.x = pk2(s0[8 * s + 0], s0[8 * s + 1]); w0.y = pk2(s0[8 * s + 2], s0[8 * s + 3]); w0.z = pk2(s0[8 * s + 4], s0[8 * s + 5]); w0.w = pk2(s0[8 * s + 6], s0[8 * s + 7]); \
            w1.x = pk2(s1[8 * s + 0], s1[8 * s + 1]); w1.y = pk2(s1[8 * s + 2], s1[8 * s + 3]); w1.z = pk2(s1[8 * s + 4], s1[8 * s + 5]); w1.w = pk2(s1[8 * s + 6], s1[8 * s + 7]); \
            pf[0][s] = __builtin_bit_cast(bf16x8, w0); pf[1][s] = __builtin_bit_cast(bf16x8, w1); } \
        AT_SB; \
        AT_PV(vA, pf[0][0]); \
        AT_SB; \
        AT_VFRAG(vA, STC, 1); \
        AT_SB; \
        AT_PV(vA, pf[0][1]); \
        AT_SB; \
          \
        if ((j) + 2 < 64) { *(LAS u32x4*)(lds + (STC) + lk) = r0; *(LAS u32x4*)(lds + (STC) + AT_K1 + lk) = r1; } \
        if ((j) + 1 < 64) { *(LAS u32x4*)(lds + (STN) + lv0) = r2; *(LAS u32x4*)(lds + (STN) + lv1) = r3; } \
        AT_SB; \
        AT_VFRAG(vA, STC, 2); \
        AT_SB; \
        AT_PV(vA, pf[1][0]); \
        AT_SB; \
        AT_VFRAG(vA, STC, 3); \
        AT_SB; \
        AT_PV(vA, pf[1][1]); \
        __syncthreads(); } while (0)
    for (int j = 0; j < 64; j += 2) {
        AT_TILE(j, sA0, sA1, sB, 0, AT_STG);
        AT_TILE(j + 1, sB0, sB1, sA, AT_STG, 0);
    }
#undef AT_TILE
#undef AT_QK
#undef AT_VFRAG
#undef AT_PV
#undef AT_SB
    const float inv = __builtin_amdgcn_rcpf(lrow + __shfl_xor(lrow, 32));
    LAS float* img = (LAS float*)lds;
    const int qrow = wq * 32 + r32;
    if (c == 1) {
        const float sc = -lam * inv;
#pragma unroll
        for (int vt = 0; vt < 4; ++vt)
#pragma unroll
            for (int g = 0; g < 4; ++g)
                *(LAS f32x4*)(img + qrow * AT_IMG_ROW + 32 * vt + 8 * g + 4 * hh) = (f32x4){o[vt][4 * g] * sc, o[vt][4 * g + 1] * sc, o[vt][4 * g + 2] * sc, o[vt][4 * g + 3] * sc};
    }
    __syncthreads();
    if (c == 0) {
#pragma unroll
        for (int vt = 0; vt < 4; ++vt)
#pragma unroll
            for (int g = 0; g < 4; ++g) {
                LAS f32x4* p = (LAS f32x4*)(img + qrow * AT_IMG_ROW + 32 * vt + 8 * g + 4 * hh);
                f32x4 t = *p;
                t.x += o[vt][4 * g] * inv; t.y += o[vt][4 * g + 1] * inv; t.z += o[vt][4 * g + 2] * inv; t.w += o[vt][4 * g + 3] * inv;
                *p = t;
            }
    }
    __syncthreads();
    {
        const int q = tid >> 2, part = tid & 3;
        float v[32]; float ss = 0.f;
#pragma unroll
        for (int i = 0; i < 8; ++i) { const f32x4 t = *(const LAS f32x4*)(img + q * AT_IMG_ROW + 32 * part + 4 * i); v[4 * i] = t.x; v[4 * i + 1] = t.y; v[4 * i + 2] = t.z; v[4 * i + 3] = t.w;
            ss += (t.x * t.x + t.y * t.y) + (t.z * t.z + t.w * t.w); }
        ss += __shfl_xor(ss, 1); ss += __shfl_xor(ss, 2);
        const float rs = rsqrtf(ss * (1.0f / 128.0f) + EPS) * one_minus_lam_init;
        const float* gp = gainA + h * 128 + 32 * part;
        bf16_t* dst = AO + ((size_t)(b * SEQ + qb * 128 + q)) * 1024 + h * 128 + 32 * part;
#pragma unroll
        for (int i = 0; i < 4; ++i) {
            const f32x4 g0 = *(const f32x4*)(gp + 8 * i), g1 = *(const f32x4*)(gp + 8 * i + 4);
            u32x4 w; w.x = pk2(v[8 * i] * rs * g0.x, v[8 * i + 1] * rs * g0.y); w.y = pk2(v[8 * i + 2] * rs * g0.z, v[8 * i + 3] * rs * g0.w);
            w.z = pk2(v[8 * i + 4] * rs * g1.x, v[8 * i + 5] * rs * g1.y); w.w = pk2(v[8 * i + 6] * rs * g1.z, v[8 * i + 7] * rs * g1.w);
            *(u32x4*)(dst + 8 * i) = w;
        }
    }
    __syncthreads();
}

constexpr int HG_SEG = 0;
constexpr int HG_F = 2048;
constexpr int HG_PART = 2560;
constexpr int HG_V = 4096;
constexpr int HG_VROW = 288;
constexpr int HG_A = HG_V + 64 * HG_VROW;
constexpr int HG_KTROW = 144, HG_QKROW = 272;
constexpr int HG_Bq = HG_A + 128 * HG_KTROW;

__device__ __forceinline__ void hg_cumsum(const float (&gv)[16], int dir, int k, int j, LAS unsigned char* lds, float (&d)[16], float& m_out, float& tot_out) {
    float run = 0.f;
    if (dir == 0) {
#pragma unroll
        for (int i = 0; i < 16; ++i) { run += gv[i]; d[i] = run; }
    } else {
#pragma unroll
        for (int i = 15; i >= 0; --i) { run += gv[i]; d[i] = run; }
    }
    LAS float* seg = (LAS float*)(lds + HG_SEG);
    seg[j * 128 + k] = run;
    __syncthreads();
    const float s0 = seg[k], s1 = seg[128 + k], s2 = seg[256 + k], s3 = seg[384 + k];
    float off, m;
    if (dir == 0) { off = (j > 0 ? s0 : 0.f) + (j > 1 ? s1 : 0.f) + (j > 2 ? s2 : 0.f); m = s0 + s1; }
    else { off = (j < 3 ? s3 : 0.f) + (j < 2 ? s2 : 0.f) + (j < 1 ? s1 : 0.f); m = s2 + s3; }
#pragma unroll
    for (int i = 0; i < 16; ++i) d[i] = d[i] + off - m;
    m_out = m; tot_out = (s0 + s1) + (s2 + s3);
}
__device__ __forceinline__ void hg_load_v(const bf16_t* HV, int tok0, int h, LAS unsigned char* lds, int tid) {
#pragma unroll
    for (int i = 0; i < 2; ++i) { const int ch = tid + 512 * i, p = ch >> 4, part = ch & 15;
        *(LAS u32x4*)(lds + HG_V + p * HG_VROW + part * 16) = *(const u32x4*)(HV + (size_t)(tok0 + p) * 512 + h * 128 + part * 8); }
}
__device__ __forceinline__ void hg_load_g(const bf16_t* G, int tok0, int h, int k, int j, float (&gv)[16]) {
    const bf16_t* gp = G + (size_t)(tok0 + 16 * j) * 512 + h * 128 + k;
    unsigned short raw[16];
#pragma unroll
    for (int i = 0; i < 16; ++i) raw[i] = gp[(size_t)i * 512];
#pragma unroll
    for (int i = 0; i < 16; ++i) gv[i] = bf2f(raw[i]);
}

__device__ __forceinline__ void hg1_phase(int bx, int G, const bf16_t* GF, const bf16_t* GB, const bf16_t* HV, bf16_t* UT, float* Dg, float* Eg, LAS unsigned char* lds) {
    int tid_ = threadIdx.x; asm volatile("" : "+v"(tid_));
    const int tid = tid_, wave = __builtin_amdgcn_readfirstlane(tid >> 6), lane = tid & 63;
    const int k = tid & 127, j = tid >> 7, i16 = lane & 15, g4 = lane >> 4;
    float gn[16]; u32x4 vn[2];
#define HG1_LOAD(uu) do { const int u_ = (uu), dir_ = u_ & 1, cch_ = (u_ >> 1) & 63, bh_ = u_ >> 7, tok_ = (bh_ >> 2) * SEQ + cch_ * 64; \
        hg_load_g(dir_ ? GB : GF, tok_, bh_ & 3, k, j, gn); \
        _Pragma("unroll") for (int i = 0; i < 2; ++i) { const int ch = tid + 512 * i; vn[i] = *(const u32x4*)(HV + (size_t)(tok_ + (ch >> 4)) * 512 + (bh_ & 3) * 128 + (ch & 15) * 8); } } while (0)
    if (bx < 2048) HG1_LOAD(bx);
    for (int u = bx; u < 2048; u += G) {
        const int dir = u & 1, cch = (u >> 1) & 63, bh = u >> 7, b = bh >> 2, h = bh & 3;
        const int tok0 = b * SEQ + cch * 64;
        float gv[16], d[16], m, tot;
#pragma unroll
        for (int i = 0; i < 16; ++i) gv[i] = gn[i];
        u32x4 vr[2];
#pragma unroll
        for (int i = 0; i < 2; ++i) vr[i] = vn[i];
        if (u + G < 2048) HG1_LOAD(u + G);
        hg_cumsum(gv, dir, k, j, lds, d, m, tot);
        float kt[16];
#pragma unroll
        for (int i = 0; i < 16; ++i) kt[i] = (1.0f - __expf(gv[i])) * __expf(fminf(-d[i], 40.f));
        { u32x4 w0, w1;
          w0.x = pk2(kt[0], kt[1]); w0.y = pk2(kt[2], kt[3]); w0.z = pk2(kt[4], kt[5]); w0.w = pk2(kt[6], kt[7]);
          w1.x = pk2(kt[8], kt[9]); w1.y = pk2(kt[10], kt[11]); w1.z = pk2(kt[12], kt[13]); w1.w = pk2(kt[14], kt[15]);
          *(LAS u32x4*)(lds + HG_A + k * HG_KTROW + j * 32) = w0; *(LAS u32x4*)(lds + HG_A + k * HG_KTROW + j * 32 + 16) = w1; }
#pragma unroll
        for (int i = 0; i < 2; ++i) { const int ch = tid + 512 * i; *(LAS u32x4*)(lds + HG_V + (ch >> 4) * HG_VROW + (ch & 15) * 16) = vr[i]; }
        if (j == 0) { ((LAS float*)(lds + HG_F))[k] = __expf(tot - m); Dg[(size_t)u * 128 + k] = __expf(tot); Eg[(size_t)u * 128 + k] = __expf(m); }
        __syncthreads();
        bf16x8 af[2];
#pragma unroll
        for (int s = 0; s < 2; ++s) {
            const LAS unsigned char* ap = lds + HG_A + (16 * wave + i16) * HG_KTROW + (32 * s + 4 * g4) * 2;
            const u32x2 lo = *(const LAS u32x2*)ap, hi = *(const LAS u32x2*)(ap + 32);
            af[s] = __builtin_bit_cast(bf16x8, (u32x4){lo.x, lo.y, hi.x, hi.y});
        }
        const f32x4 fsc = *(const LAS f32x4*)(lds + HG_F + (16 * wave + 4 * g4) * 4);
        const LAS unsigned char* vbase = lds + HG_V + (4 * g4 + (i16 >> 2)) * HG_VROW + (i16 & 3) * 8;
#pragma unroll
        for (int vt = 0; vt < 8; ++vt) {
            f32x4 acc = {0.f, 0.f, 0.f, 0.f};
#pragma unroll
            for (int s = 0; s < 2; ++s) {
                const s16x4 t0 = tr_read(vbase + (32 * s) * HG_VROW + vt * 32), t1 = tr_read(vbase + (32 * s + 16) * HG_VROW + vt * 32);
                const bf16x8 bv = {t0[0], t0[1], t0[2], t0[3], t1[0], t1[1], t1[2], t1[3]};
                acc = __builtin_amdgcn_mfma_f32_16x16x32_bf16(af[s], bv, acc, 0, 0, 0);
            }
            u32x2 w; w.x = pk2(acc[0] * fsc[0], acc[1] * fsc[1]); w.y = pk2(acc[2] * fsc[2], acc[3] * fsc[3]);
            *(u32x2*)(UT + ((size_t)u * 128 + 16 * vt + i16) * 128 + 16 * wave + 4 * g4) = w;
        }
        __syncthreads();
    }
}

__device__ __forceinline__ void hg2_scan(bf16_t* UT, const float* Dg, const float* Eg, int gthread, int nthreads) {
    for (int idx = gthread; idx < 32 * 4096; idx += nthreads) {
        const int chain = idx >> 12, e4 = idx & 4095, v = e4 >> 5, k0 = (e4 & 31) * 4;
        const int dir = chain & 1, bh = chain >> 1;
        float S0 = 0.f, S1 = 0.f, S2 = 0.f, S3 = 0.f;
        int u = (bh * 64 + (dir ? 63 : 0)) * 2 + dir;
        const int ustep = dir ? -2 : 2;
        u32x2 uu[4]; f32x4 dd[4], ee[4];
#pragma unroll
        for (int r = 0; r < 4; ++r) { const int ur = u + r * ustep; uu[r] = *(const u32x2*)(UT + ((size_t)ur * 128 + v) * 128 + k0); dd[r] = *(const f32x4*)(Dg + (size_t)ur * 128 + k0); ee[r] = *(const f32x4*)(Eg + (size_t)ur * 128 + k0); }
        for (int cc = 0; cc < 64; cc += 4) {
#pragma unroll
            for (int r = 0; r < 4; ++r) {
                const u32x2 uc = uu[r]; const f32x4 dc = dd[r], ec = ee[r];
                if (cc + 4 < 64) { const int un = u + 4 * ustep; uu[r] = *(const u32x2*)(UT + ((size_t)un * 128 + v) * 128 + k0); dd[r] = *(const f32x4*)(Dg + (size_t)un * 128 + k0); ee[r] = *(const f32x4*)(Eg + (size_t)un * 128 + k0); }
                u32x2 w; w.x = pk2(ec.x * S0, ec.y * S1); w.y = pk2(ec.z * S2, ec.w * S3);
                *(u32x2*)(UT + ((size_t)u * 128 + v) * 128 + k0) = w;
                S0 = dc.x * S0 + bflo(uc.x); S1 = dc.y * S1 + bfhi(uc.x); S2 = dc.z * S2 + bflo(uc.y); S3 = dc.w * S3 + bfhi(uc.y);
                u += ustep;
            }
        }
    }
}

constexpr int HG_OUT = HG_Bq + 64 * HG_QKROW;
__device__ __forceinline__ void hg3_phase(int bx, int G, const bf16_t* GF, const bf16_t* GB, const bf16_t* HQ, const bf16_t* HV, const bf16_t* ST, const bf16_t* BG, const float* gainH, bf16_t* AO, LAS unsigned char* lds) {
    int tid_ = threadIdx.x; asm volatile("" : "+v"(tid_));
    const int tid = tid_, wave = __builtin_amdgcn_readfirstlane(tid >> 6), lane = tid & 63;
    const int k = tid & 127, j = tid >> 7;
    const int tb = wave & 3, vh = wave >> 2, i16 = lane & 15, g4 = lane >> 4;
    float gf[16], gb[16]; unsigned short qr[16];
#define HG3_LOAD(uu) do { const int u_ = (uu), cch_ = u_ & 63, bh_ = u_ >> 6, tok_ = (bh_ >> 2) * SEQ + cch_ * 64, h_ = bh_ & 3; \
        hg_load_g(GF, tok_, h_, k, j, gf); hg_load_g(GB, tok_, h_, k, j, gb); \
        const bf16_t* qp = HQ + (size_t)(tok_ + 16 * j) * 512 + h_ * 128 + k; \
        _Pragma("unroll") for (int i = 0; i < 16; ++i) qr[i] = qp[(size_t)i * 512]; } while (0)
    if (bx < 1024) HG3_LOAD(bx);
  for (int u3 = bx; u3 < 1024; u3 += G) {
    const int cch = u3 & 63, bh = u3 >> 6, b = bh >> 2, h = bh & 3;
    const int tok0 = b * SEQ + cch * 64;
    hg_load_v(HV, tok0, h, lds, tid);
    u32x4 bgq[2];
    { const bf16_t* bgp0 = BG + (size_t)(tok0 + (tid >> 3)) * 512 + h * 128 + 16 * (tid & 7); bgq[0] = *(const u32x4*)bgp0; bgq[1] = *(const u32x4*)(bgp0 + 8); }
    bf16x8 sb[16];
    { const bf16_t* stp = ST + ((size_t)((bh * 64 + cch) * 2 + 0) * 128) * 128;
#pragma unroll
      for (int vv = 0; vv < 4; ++vv)
#pragma unroll
        for (int ks = 0; ks < 4; ++ks) sb[vv * 4 + ks] = *(const bf16x8*)(stp + (size_t)(16 * (4 * vh + vv) + i16) * 128 + 32 * ks + 8 * g4); }
    f32x4 oacc[4];
#pragma unroll
    for (int i = 0; i < 4; ++i) oacc[i] = (f32x4){0.f, 0.f, 0.f, 0.f};
#pragma unroll
    for (int dir = 0; dir < 2; ++dir) {
        float d[16], m, tot;
        hg_cumsum(dir ? gb : gf, dir, k, j, lds, d, m, tot);
#pragma unroll
        for (int i = 0; i < 16; ++i) {
            const float gvi = dir ? gb[i] : gf[i];
            const float kt = (1.0f - __expf(gvi)) * __expf(fminf(-d[i], 40.f));
            const float qt = bf2f(qr[i]) * __expf(fminf(d[i], 40.f));
            *(LAS unsigned short*)(lds + HG_A + (16 * j + i) * HG_QKROW + k * 2) = (unsigned short)f2bf(kt);
            *(LAS unsigned short*)(lds + HG_Bq + (16 * j + i) * HG_QKROW + k * 2) = (unsigned short)f2bf(qt);
        }
        if (dir == 1 && u3 + G < 1024) HG3_LOAD(u3 + G);
        __syncthreads();
        f32x4 pt[4];
#pragma unroll
        for (int sg = 0; sg < 4; ++sg) pt[sg] = (f32x4){0.f, 0.f, 0.f, 0.f};
        bf16x8 qa[4];
#pragma unroll
        for (int ks = 0; ks < 4; ++ks) qa[ks] = *(const LAS bf16x8*)(lds + HG_Bq + (16 * tb + i16) * HG_QKROW + (32 * ks + 8 * g4) * 2);
#pragma unroll
        for (int sg = 0; sg < 4; ++sg)
#pragma unroll
            for (int ks = 0; ks < 4; ++ks) {
                const bf16x8 ka = *(const LAS bf16x8*)(lds + HG_A + (16 * sg + i16) * HG_QKROW + (32 * ks + 8 * g4) * 2);
                pt[sg] = __builtin_amdgcn_mfma_f32_16x16x32_bf16(ka, qa[ks], pt[sg], 0, 0, 0);
            }
        const int tcol = 16 * tb + i16;
#pragma unroll
        for (int sg = 0; sg < 4; ++sg)
#pragma unroll
            for (int e = 0; e < 4; ++e) { const int srow = 16 * sg + 4 * g4 + e; const bool keep = dir ? (srow >= tcol) : (srow <= tcol); pt[sg][e] = keep ? pt[sg][e] : 0.f; }
        bf16x8 pa[2];
#pragma unroll
        for (int s2 = 0; s2 < 2; ++s2) {
            u32x4 w; w.x = pk2(pt[2 * s2][0], pt[2 * s2][1]); w.y = pk2(pt[2 * s2][2], pt[2 * s2][3]); w.z = pk2(pt[2 * s2 + 1][0], pt[2 * s2 + 1][1]); w.w = pk2(pt[2 * s2 + 1][2], pt[2 * s2 + 1][3]);
            pa[s2] = __builtin_bit_cast(bf16x8, w);
        }
        const LAS unsigned char* vbase = lds + HG_V + (4 * g4 + (i16 >> 2)) * HG_VROW + (i16 & 3) * 8;
#pragma unroll
        for (int vv = 0; vv < 4; ++vv) {
            const int vt = 4 * vh + vv;
#pragma unroll
            for (int s2 = 0; s2 < 2; ++s2) {
                const s16x4 t0 = tr_read(vbase + (32 * s2) * HG_VROW + vt * 32), t1 = tr_read(vbase + (32 * s2 + 16) * HG_VROW + vt * 32);
                const bf16x8 bv = {t0[0], t0[1], t0[2], t0[3], t1[0], t1[1], t1[2], t1[3]};
                oacc[vv] = __builtin_amdgcn_mfma_f32_16x16x32_bf16(pa[s2], bv, oacc[vv], 0, 0, 0);
            }
#pragma unroll
            for (int ks = 0; ks < 4; ++ks) oacc[vv] = __builtin_amdgcn_mfma_f32_16x16x32_bf16(qa[ks], sb[vv * 4 + ks], oacc[vv], 0, 0, 0);
        }
        if (dir == 0) {
            const bf16_t* stp = ST + ((size_t)((bh * 64 + cch) * 2 + 1) * 128) * 128;
#pragma unroll
            for (int vv = 0; vv < 4; ++vv)
#pragma unroll
                for (int ks = 0; ks < 4; ++ks) sb[vv * 4 + ks] = *(const bf16x8*)(stp + (size_t)(16 * (4 * vh + vv) + i16) * 128 + 32 * ks + 8 * g4);
        }
        __syncthreads();
    }
    LAS float* ot = (LAS float*)(lds + HG_OUT);
#pragma unroll
    for (int vv = 0; vv < 4; ++vv)
#pragma unroll
        for (int e = 0; e < 4; ++e) ot[(16 * tb + 4 * g4 + e) * 132 + 16 * (4 * vh + vv) + i16] = oacc[vv][e];
    __syncthreads();
    {
        const int t = tid >> 3, part = tid & 7;
        float v[16]; float ss = 0.f;
#pragma unroll
        for (int i = 0; i < 4; ++i) { const f32x4 x = *(const LAS f32x4*)(ot + t * 132 + 16 * part + 4 * i); v[4 * i] = x.x; v[4 * i + 1] = x.y; v[4 * i + 2] = x.z; v[4 * i + 3] = x.w; ss += (x.x * x.x + x.y * x.y) + (x.z * x.z + x.w * x.w); }
        ss += __shfl_xor(ss, 1); ss += __shfl_xor(ss, 2); ss += __shfl_xor(ss, 4);
        const float rs = rsqrtf(ss * (1.0f / 128.0f) + EPS);
        const float* gp = gainH + h * 128 + 16 * part;
        bf16_t* dst = AO + (size_t)(tok0 + t) * 1024 + 512 + h * 128 + 16 * part;
#pragma unroll
        for (int i = 0; i < 2; ++i) {
            const u32x4 gq = bgq[i];
            const f32x4 g0 = *(const f32x4*)(gp + 8 * i), g1 = *(const f32x4*)(gp + 8 * i + 4);
            u32x4 w;
            w.x = pk2(v[8 * i] * rs * g0.x * bflo(gq.x), v[8 * i + 1] * rs * g0.y * bfhi(gq.x)); w.y = pk2(v[8 * i + 2] * rs * g0.z * bflo(gq.y), v[8 * i + 3] * rs * g0.w * bfhi(gq.y));
            w.z = pk2(v[8 * i + 4] * rs * g1.x * bflo(gq.z), v[8 * i + 5] * rs * g1.y * bfhi(gq.z)); w.w = pk2(v[8 * i + 6] * rs * g1.z * bflo(gq.w), v[8 * i + 7] * rs * g1.w * bfhi(gq.w));
            *(u32x4*)(dst + 8 * i) = w;
        }
    }
    __syncthreads();
  }
#undef HG3_LOAD
}

#define XB_TMO      128
#define XB_XCNT(j)  (256  + 64 * (j))
#define XB_XSUB(j)  (1280 + 64 * (j))
#define XB_XGEN(j)  (2304 + 64 * (j))
#define XB_TOP      3328
#define XB_TOPGEN   3392
#define XCD_BAR_WORDS 3456
#define XB_SPIN_CAP (1u << 18)

__device__ __forceinline__ unsigned xb_ld(unsigned* p)              { return __hip_atomic_load(p, __ATOMIC_RELAXED, __HIP_MEMORY_SCOPE_AGENT); }
__device__ __forceinline__ unsigned xb_add(unsigned* p, unsigned v) { return __hip_atomic_fetch_add(p, v, __ATOMIC_RELAXED, __HIP_MEMORY_SCOPE_AGENT); }
__device__ __forceinline__ unsigned xb_xcc_id() { return (unsigned)__builtin_amdgcn_s_getreg((3 << 11) | 20) & 0xFu; }
#define XB_SPIN(cond, bar) do { unsigned _sp = 0; while (cond) { __builtin_amdgcn_s_sleep(1); \
    if ((++_sp & 255u) == 0u) { if (xb_ld(&(bar)[XB_TMO])) break; if (_sp > XB_SPIN_CAP) { atomicAdd(&(bar)[XB_TMO], 1u); break; } } } } while (0)

struct XcdBarrier {
    unsigned* bar; unsigned x;
    volatile LAS unsigned* st;
};

__device__ __forceinline__ XcdBarrier xcd_barrier_post(unsigned* bar, volatile LAS unsigned* st) {
    XcdBarrier b; b.bar = bar; b.x = xb_xcc_id(); b.st = st;
    if (threadIdx.x == 0) (void)xb_add(&bar[XB_XCNT(b.x)], 1u);
    return b;
}
__device__ __forceinline__ void xcd_barrier_complete(unsigned* bar, unsigned x, unsigned& nloc, unsigned& nx) {
    const unsigned G = gridDim.x * gridDim.y * gridDim.z;
    unsigned sum, cnt, mine, sp = 0u;
    for (;;) {
        sum = 0u; cnt = 0u; mine = 0u;
#pragma unroll
        for (unsigned j = 0; j < 16; ++j) { const unsigned c = xb_ld(&bar[XB_XCNT(j)]); sum += c; cnt += (c > 0u) ? 1u : 0u; mine = (j == x) ? c : mine; }
        if (sum == G) break;
        __builtin_amdgcn_s_sleep(1);
        if ((++sp & 255u) == 0u) { if (xb_ld(&bar[XB_TMO])) break; if (sp > XB_SPIN_CAP) { atomicAdd(&bar[XB_TMO], 1u); break; } }
    }
    nloc = mine > 0u ? mine : 1u; nx = cnt > 0u ? cnt : 1u;
}

__device__ __forceinline__ void xcd_barrier(const XcdBarrier& b) {
    asm volatile("s_waitcnt vmcnt(0)" ::: "memory");
    __syncthreads();
    if (threadIdx.x == 0) {
        unsigned* bar = b.bar;
        __builtin_amdgcn_s_waitcnt(0);
        unsigned nloc = b.st[0], nx = b.st[1];
        if (nloc == 0u) { xcd_barrier_complete(bar, b.x, nloc, nx); b.st[0] = nloc; b.st[1] = nx; }
        const unsigned old = xb_add(&bar[XB_XSUB(b.x)], 1u);
        const unsigned gen = old / nloc;
        if (old + 1u == (gen + 1u) * nloc) {
            __builtin_amdgcn_fence(__ATOMIC_RELEASE, "agent");
            asm volatile("s_waitcnt vmcnt(0)" ::: "memory");
            const unsigned og = xb_add(&bar[XB_TOP], 1u);
            const unsigned tg = og / nx;
            if (og + 1u == (tg + 1u) * nx) xb_add(&bar[XB_TOPGEN], 1u);
            else XB_SPIN(xb_ld(&bar[XB_TOPGEN]) == tg, bar);
            __builtin_amdgcn_fence(__ATOMIC_ACQUIRE, "agent");
            xb_add(&bar[XB_XGEN(b.x)], 1u);
            asm volatile("s_waitcnt vmcnt(0)" ::: "memory");
        } else {
            XB_SPIN(xb_ld(&bar[XB_XGEN(b.x)]) == gen, bar);
            __builtin_amdgcn_fence(__ATOMIC_ACQUIRE, "agent");
            asm volatile("s_waitcnt vmcnt(0)" ::: "memory");
        }
    }
    __syncthreads();
}

__global__ void __launch_bounds__(512, 2) fwd_kernel(Ptrs Pk) {
    extern __shared__ __attribute__((aligned(16))) unsigned char lds_raw[];
    LAS unsigned char* lds = (LAS unsigned char*)lds_raw;
    cg::grid_group grid = cg::this_grid();
    const int G = gridDim.x, bx = blockIdx.x;
    const int lo = Pk.ph_lo, hi = Pk.ph_hi;
    int ph = 0;
    if (threadIdx.x < 4) ((LAS unsigned*)(lds + 131072 + 1024))[threadIdx.x] = 0u;
    __syncthreads();
    XcdBarrier xbar = xcd_barrier_post((unsigned*)(Pk.ws + OFF_BAR), (volatile LAS unsigned*)(lds + 131072 + 1024));
#ifdef TS_A
    if (threadIdx.x == 0) { LAS unsigned long long* TS_ = (LAS unsigned long long*)(lds + 131072); for (int i = 0; i < 15; ++i) TS_[i] = 0ull; TS_[15] = __builtin_amdgcn_s_memrealtime(); }
#endif
#ifndef PH_MASK
#define PH_MASK 0xFFFFFFFFu
#endif
#define ON(id) constexpr (((PH_MASK) >> (id)) & 1u)
#if defined(__HIP_DEVICE_COMPILE__)
#define LOAD_ARGS(P) int zoff_ = 0; asm volatile("" : "+s"(zoff_)); const Ptrs P = *(const __attribute__((address_space(4))) Ptrs*)((const __attribute__((address_space(4))) char*)__builtin_amdgcn_kernarg_segment_ptr() + zoff_);
#else
#define LOAD_ARGS(P) const Ptrs P = Pk;
#endif
#define PHASE_BEGIN if (ph >= lo && ph < hi) { LOAD_ARGS(P) unsigned char* ws = P.ws; asm volatile("" : "+s"(ws)); int tid = threadIdx.x; asm volatile("" : "+v"(tid)); \
    const int lane = tid & 63, wave = __builtin_amdgcn_readfirstlane(tid >> 6), gw = bx * 8 + wave, ngw = G * 8; (void)lane; (void)gw; (void)ngw;
#define XB ((bf16_t*)(ws + OFF_XB))
#define RSA ((float*)(ws + OFF_RSA))
#define RSB ((float*)(ws + OFF_RSB))
#define CS ((const float*)(ws + OFF_CS))
#define LB ((const float*)(ws + OFF_LB))
#define LAM ((const float*)(ws + OFF_LAM))
#define Dg ((float*)(ws + OFF_DG))
#define Eg ((float*)(ws + OFF_EG))
#define GATE ((bf16_t*)(ws + OFF_GATE))
#define Qb ((bf16_t*)(ws + OFF_Q))
#define Kb ((bf16_t*)(ws + OFF_K))
#define Vb ((bf16_t*)(ws + OFF_V))
#define HQ ((bf16_t*)(ws + OFF_HQ))
#define HV ((bf16_t*)(ws + OFF_HV))
#define GF ((bf16_t*)(ws + OFF_GF))
#define GB ((bf16_t*)(ws + OFF_GB))
#define Yb ((bf16_t*)(ws + OFF_Y))
#define BG ((bf16_t*)(ws + OFF_BG))
#define AO ((bf16_t*)(ws + OFF_AO))
#define UT ((bf16_t*)(ws + OFF_UT))
#define Hb ((bf16_t*)(ws + OFF_H))
#ifdef TS_A
#define TICK(cat) do { if (bx == 0 && threadIdx.x == 0) { LAS unsigned long long* TS_ = (LAS unsigned long long*)(lds + 131072); const unsigned long long t_ = __builtin_amdgcn_s_memrealtime(); TS_[cat] += t_ - TS_[15]; TS_[15] = t_; } } while (0)
#else
#define TICK(cat) do { } while (0)
#endif
#define PHASE_END(cat)   TICK(cat); if (ph + 1 < hi) { if (ph == 0) grid.sync(); else xcd_barrier(xbar); TICK(13); } } ++ph;

    PHASE_BEGIN
        if ON(0) prologue(P, lds, gw, ngw, wave, lane);
        if ON(6) convert_layer(P, 0, ws, lds, gw, ngw, wave, lane);
    PHASE_END(0)

    for (int layer = 0; layer < DEPTH; ++layer) {
        PHASE_BEGIN
            pg8::Gemm g{XB, (const bf16_t*)(ws + (size_t)(layer & 1) * WSZ + W_IN), Dm, Dm, Dm, 1 << 30, 0, -1};
            pg8::StaticOrder S; S.init(M, 4096, G, bx);
            EpiMix E{RSB, CS, LB + (0 * 4 + layer) * 512, LB + (1 * 4 + layer) * 512, Qb, Kb, Vb, HQ, HV, BG, GF, GB};
            if ON(1) pg8::gemm_phase(lds, g, S, E);
        PHASE_END(1)
        PHASE_BEGIN
            const float lam_init = 0.8f - 0.6f * __expf(-0.3f * (float)layer);
            const float lam = LAM[layer];
            if ON(2) for (int i = 0; i * G + bx < 512; ++i) {
                const int uid = i * G + bx; const int round = uid >> 8, r = uid & 255;
                const int bhh = round * 8 + (r & 7), qb = r >> 3;
                attn_unit(bhh >> 2, bhh & 3, qb, Qb, Kb, Vb, AO, P.da_norm + layer * 512, 1.0f - lam_init, lam, lds);
            }
            TICK(2);
            if ON(3) hg1_phase(bx, G, GF, GB, HV, UT, Dg, Eg, lds);
        PHASE_END(3)
        PHASE_BEGIN
            if ON(5) hg2_scan(UT, Dg, Eg, bx * 512 + tid, G * 512);
            TICK(5);
            {
                pg8::Gemm g{XB, (const bf16_t*)(ws + (size_t)(layer & 1) * WSZ + W_IN) + (size_t)4096 * Dm, Dm, Dm, Dm, 1 << 30, 0, -1};
                pg8::StaticOrder S; S.init(M, 2048, G, bx);
                EpiGate E{RSB, GATE};
                if ON(4) pg8::gemm_phase(lds, g, S, E);
            }
            TICK(4);
        PHASE_END(4)
        PHASE_BEGIN
            if ON(7) hg3_phase(bx, G, GF, GB, HQ, HV, UT, BG, P.hg_norm + layer * 512, AO, lds);
        PHASE_END(7)
        PHASE_BEGIN
            pg8::Gemm g{AO, (const bf16_t*)(ws + (size_t)(layer & 1) * WSZ + W_AB), 1024, 1024, 1024, 1 << 30, 0, 8};
            pg8::StaticOrder S; S.init(M, 1024, G, bx);
            EpiY E{GATE, Yb};
            if ON(8) pg8::gemm_phase(lds, g, S, E);
        PHASE_END(8)
        PHASE_BEGIN
            pg8::Gemm g{Yb, (const bf16_t*)(ws + (size_t)(layer & 1) * WSZ + W_O2), 1024, 1024, 1024, 1 << 30, 0, -1};
            pg8::StaticOrder S; S.init(M, Dm, G, bx);
            EpiRes E{XB, RSA};
            if ON(9) pg8::gemm_phase(lds, g, S, E);
        PHASE_END(9)
        PHASE_BEGIN
            pg8::Gemm g{XB, (const bf16_t*)(ws + (size_t)(layer & 1) * WSZ + W_GU), Dm, Dm, Dm, 1 << 30, 0, -1};
            pg8::StaticOrder S; S.init(M, 2 * FF, G, bx);
            EpiGU E{RSA, Hb};
            if ON(10) pg8::gemm_phase(lds, g, S, E);
        PHASE_END(10)
        PHASE_BEGIN
            pg8::Gemm g{Hb, (const bf16_t*)(ws + (size_t)(layer & 1) * WSZ + W_D), FF, FF, FF, 1 << 30, 0, -1};
            pg8::StaticOrder S; S.init(M, Dm, G, bx);
            EpiRes E{XB, RSB};
            if ON(11) pg8::gemm_phase(lds, g, S, E);
            TICK(11);
            if ON(6) if (layer + 1 < DEPTH) convert_layer(P, layer + 1, ws + (size_t)((layer + 1) & 1) * WSZ, lds, gw, ngw, wave, lane);
        PHASE_END(6)
    }
    PHASE_BEGIN
        if ON(12) for (int r = gw; r < M; r += ngw) {
            float v[16]; float ss = 0.f;
#pragma unroll
            for (int j = 0; j < 2; ++j) { const u32x4 x = *(const u32x4*)(XB + (size_t)r * Dm + 8 * lane + 512 * j);
                v[8 * j] = bflo(x.x); v[8 * j + 1] = bfhi(x.x); v[8 * j + 2] = bflo(x.y); v[8 * j + 3] = bfhi(x.y); v[8 * j + 4] = bflo(x.z); v[8 * j + 5] = bfhi(x.z); v[8 * j + 6] = bflo(x.w); v[8 * j + 7] = bfhi(x.w); }
#pragma unroll
            for (int e = 0; e < 16; ++e) ss += v[e] * v[e];
            const float rs = rsqrtf(wave_sum(ss) * (1.0f / Dm) + EPS);
#pragma unroll
            for (int j = 0; j < 2; ++j) { const float* gp = P.final_norm + 8 * lane + 512 * j; const f32x4 g0 = *(const f32x4*)gp, g1 = *(const f32x4*)(gp + 4);
                float* op = P.out + (size_t)r * Dm + 8 * lane + 512 * j;
                *(f32x4*)op = (f32x4){v[8 * j] * rs * g0.x, v[8 * j + 1] * rs * g0.y, v[8 * j + 2] * rs * g0.z, v[8 * j + 3] * rs * g0.w};
                *(f32x4*)(op + 4) = (f32x4){v[8 * j + 4] * rs * g1.x, v[8 * j + 5] * rs * g1.y, v[8 * j + 6] * rs * g1.z, v[8 * j + 7] * rs * g1.w}; }
        }
    PHASE_END(12)
#ifdef TS_A
    if (bx == 0 && threadIdx.x == 0) {
        LAS unsigned long long* TS_ = (LAS unsigned long long*)(lds + 131072);
        unsigned long long a = 0;
        for (int i = 0; i < 15; ++i) { if ((TS_A >> i) & 1) a += TS_[i]; }
        const unsigned long long t_end = __builtin_amdgcn_s_memrealtime() + a;
        while (__builtin_amdgcn_s_memrealtime() < t_end) __builtin_amdgcn_s_sleep(20);
    }
#endif
}
constexpr int NPHASES = 2 + 8 * DEPTH;

#ifndef MK_PER_PHASE
#define MK_PER_PHASE 0
#endif

extern "C" void kernel_launch(void* const* d_in, const int* in_sizes, int n_in, void* d_out, int out_size, void* d_ws, size_t ws_size, hipStream_t stream) {
    static int grid = 0;
    if (grid == 0) {
        if (n_in != 16 || out_size != M * Dm || ws_size < WS_END) { fprintf(stderr, "kernel_launch: unexpected sizes (n_in %d, out %d, ws %zu, need %zu)\n", n_in, out_size, ws_size, (size_t)WS_END); grid = -1; return; }
        int dev = 0, cus = 0, per_cu = 0;
        (void)hipGetDevice(&dev);
        (void)hipDeviceGetAttribute(&cus, hipDeviceAttributeMultiprocessorCount, dev);
        if (hipFuncSetAttribute((const void*)fwd_kernel, hipFuncAttributeMaxDynamicSharedMemorySize, LDS_BYTES) != hipSuccess) { fprintf(stderr, "kernel_launch: hipFuncSetAttribute failed\n"); grid = -1; return; }
        (void)hipOccupancyMaxActiveBlocksPerMultiprocessor(&per_cu, (const void*)fwd_kernel, 512, LDS_BYTES);
        (void)hipGetLastError();
        if (per_cu < 1) per_cu = 1;
        grid = cus * 1;
        fprintf(stderr, "kernel_launch: grid %d (per_cu %d), ws %zu need %zu\n", grid, per_cu, ws_size, (size_t)WS_END);
    }
    if (grid < 0) return;
    Ptrs p{};
    p.x = (const float*)d_in[0]; p.pos = (const int*)d_in[1]; p.w_in = (const float*)d_in[2]; p.da_lambda = (const float*)d_in[3]; p.da_norm = (const float*)d_in[4];
    p.hg_lb = (const float*)d_in[5]; p.hg_norm = (const float*)d_in[6]; p.w_a = (const float*)d_in[7]; p.w_b = (const float*)d_in[8]; p.w_o = (const float*)d_in[9];
    p.attn_norm = (const float*)d_in[10]; p.ffn_norm = (const float*)d_in[11]; p.w_gate = (const float*)d_in[12]; p.w_up = (const float*)d_in[13]; p.w_down = (const float*)d_in[14];
    p.final_norm = (const float*)d_in[15];
    p.out = (float*)d_out; p.ws = (unsigned char*)d_ws;
    (void)hipMemsetAsync((char*)d_ws + OFF_BAR, 0, BAR_BYTES, stream);
#if MK_PER_PHASE
    for (int ph = 0; ph < NPHASES; ++ph) {
        p.ph_lo = ph; p.ph_hi = ph + 1;
        hipLaunchKernelGGL(fwd_kernel, dim3(grid), dim3(512), LDS_BYTES, stream, p);
    }
#else
    p.ph_lo = 0; p.ph_hi = NPHASES;
    void* args[] = {&p};
    hipError_t e = hipLaunchCooperativeKernel((const void*)fwd_kernel, dim3(grid), dim3(512), args, LDS_BYTES, stream);
    if (e != hipSuccess) fprintf(stderr, "cooperative launch failed: %s (grid %d)\n", hipGetErrorString(e), grid);
#endif
}
```

```cpp
#include <hip/hip_runtime.h>
#include <hip/hip_cooperative_groups.h>
#include <cstdio>
#include <cstdint>
namespace cg = cooperative_groups;

#define LAS __attribute__((address_space(3)))
typedef unsigned short bf16_t;
typedef short bf16x8 __attribute__((ext_vector_type(8)));
typedef short s16x4 __attribute__((ext_vector_type(4)));
typedef float f32x4 __attribute__((ext_vector_type(4)));
typedef float f32x16 __attribute__((ext_vector_type(16)));
typedef unsigned u32x4 __attribute__((ext_vector_type(4)));
typedef unsigned u32x2 __attribute__((ext_vector_type(2)));

constexpr int Dm = 1024, NB = 4, SEQ = 4096, M = NB * SEQ, DEPTH = 4, FF = 2816, INW = 6144;
constexpr float EPS = 1e-6f;
constexpr float LOG2E = 1.4426950408889634f;

constexpr size_t W_IN = 0, W_AB = 12582912, W_O2 = 14680064, W_GU = 18874368, W_D = 30408704, WSZ = 36175872;
constexpr size_t MiB = 1048576;
constexpr size_t OFF_XB = 2 * WSZ;
constexpr size_t OFF_RSA = OFF_XB + 32 * MiB;
constexpr size_t OFF_RSB = OFF_RSA + MiB;
constexpr size_t OFF_CS = OFF_RSB + MiB;
constexpr size_t OFF_LB = OFF_CS + MiB;
constexpr size_t OFF_LAM = OFF_LB + 16384;
constexpr size_t OFF_DG = OFF_LAM + 256;
constexpr size_t OFF_EG = OFF_DG + MiB;
constexpr size_t OFF_B = OFF_EG + MiB;
constexpr size_t OFF_GATE = OFF_B;
constexpr size_t OFF_Q = OFF_B, OFF_K = OFF_B + 16 * MiB, OFF_V = OFF_B + 32 * MiB;
constexpr size_t OFF_HQ = OFF_B + 64 * MiB;
constexpr size_t OFF_HV = OFF_HQ + 16 * MiB;
constexpr size_t OFF_GF = OFF_HV + 16 * MiB;
constexpr size_t OFF_GB = OFF_GF + 16 * MiB;
constexpr size_t OFF_Y = OFF_GF;
constexpr size_t OFF_BG = OFF_GB + 16 * MiB;
constexpr size_t OFF_AO = OFF_BG + 16 * MiB;
constexpr size_t OFF_UT = OFF_AO + 32 * MiB;
constexpr size_t OFF_H = OFF_B;
constexpr size_t OFF_BAR = OFF_UT + 64 * MiB;
constexpr size_t BAR_BYTES = 16384;
constexpr size_t WS_END = OFF_BAR + BAR_BYTES;

constexpr int LDS_BYTES = 131072 + 2048;

__device__ __forceinline__ unsigned f2bf(float f) { unsigned u = __builtin_bit_cast(unsigned, f); return (u + 0x7fffu + ((u >> 16) & 1u)) >> 16; }
typedef float f32x2_t __attribute__((ext_vector_type(2)));
typedef __bf16 bf16x2_t __attribute__((ext_vector_type(2)));
__device__ __forceinline__ unsigned pk2(float lo, float hi) { f32x2_t v = {lo, hi}; bf16x2_t b = __builtin_convertvector(v, bf16x2_t); return __builtin_bit_cast(unsigned, b); }
__device__ __forceinline__ float bf2f(unsigned short b) { return __builtin_bit_cast(float, (unsigned)b << 16); }
__device__ __forceinline__ float bflo(unsigned u) { return __builtin_bit_cast(float, u << 16); }
__device__ __forceinline__ float bfhi(unsigned u) { return __builtin_bit_cast(float, u & 0xffff0000u); }
__device__ __forceinline__ float sigmoidf_(float x) { return __builtin_amdgcn_rcpf(1.0f + __expf(-x)); }

namespace pg8 {
constexpr int BM = 256, BK = 64, HALF = 128, HTB = HALF * BK * 2, STAGE_BYTES = 8 * HTB, NXCD = 8, WGM = 8;
__host__ __device__ __forceinline__ int lds_byte(int r, int c) { const int st = (r >> 4) * 2 + (c >> 5), rr = r & 15, cc = c & 31, ob = rr * 64 + cc * 2; return st * 1024 + (ob ^ (((ob >> 9) & 1) << 5)); }
__host__ __device__ __forceinline__ void stage_rc(int b, int& R, int& C) { const int st = b / 1024, sb = b % 1024, swz = sb ^ (((sb >> 9) & 1) << 5); R = (st >> 1) * 16 + swz / 64; C = (st & 1) * 32 + (swz % 64) / 2; }
__host__ __device__ __forceinline__ int perm32(int rho) { const int n = rho >> 4, i = rho & 15; return 8 * (i >> 2) + 4 * n + (i & 3); }

struct Unit { int pm, pn; };
struct Gemm { const bf16_t* A; const bf16_t* Bt; int lda, ldb, K; int split_pn; int split_aoff; int mid_t; };

struct StaticOrder {
    int nM, nN, nwg, G, c;
    __device__ __forceinline__ void init(int M_, int N_, int G_, int c_) { nM = M_ / BM; nN = N_ / BM; nwg = nM * nN; G = G_; c = c_; }
    __device__ bool next(int i, Unit& u) const {
        const long L = (long)i * G + c; if (L >= nwg) return false;
        int wgid = (int)L; { const int q = nwg / NXCD, r = nwg % NXCD, xcd = wgid % NXCD, off = wgid / NXCD; wgid = (xcd < r ? xcd * (q + 1) : r * (q + 1) + (xcd - r) * q) + off; }
        const int nig = WGM * nN, gid = wgid / nig, fm = gid * WGM, gsz = (nM - fm) < WGM ? (nM - fm) : WGM;
        u.pm = fm + ((wgid % nig) % gsz); u.pn = (wgid % nig) / gsz; return true;
    }
};

template <class Epi>
__device__ __forceinline__ void gemm_phase(LAS unsigned char* lds, const Gemm g, const StaticOrder& S, const Epi& E) {
    int tid_ = threadIdx.x; asm volatile("" : "+v"(tid_));
    const int tid = tid_, wid = __builtin_amdgcn_readfirstlane(tid >> 6), lane = tid & 63, wr = wid >> 2, wc = wid & 3, fr = lane & 15, fq = lane >> 4;
    const int K = g.K, nt = K / BK;
    unsigned voffA[2], voffB[2];
#pragma unroll
    for (int i = 0; i < 2; ++i) { int R, C; stage_rc(tid * 16 + i * 8192, R, C); const int Rb = (R & ~31) + perm32(R & 31);
        voffA[i] = (unsigned)(R * g.lda + C) * 2u; voffB[i] = (unsigned)(Rb * g.ldb + C) * 2u; }
    const size_t kstep = (size_t)(BK * 2);
    const size_t hstepA = (size_t)HALF * g.lda * 2, hstepB = (size_t)HALF * g.ldb * 2;
    const size_t tstepA = 2 * hstepA, tstepB = 2 * hstepB;
    const unsigned ldsw = (unsigned)wid * 1024u;
    const int aoff = lds_byte(wr * 64 + fr, fq * 8), boff = lds_byte(wc * 32 + fr, fq * 8);
#define PG8_SA(b, h) (((b) * 2 + (h)) * HTB)
#define PG8_SB(b, h) ((4 + (b) * 2 + (h)) * HTB)
#define PG8_STAGE(bufoff, gbase, voff) do { _Pragma("unroll") for (int _i = 0; _i < 2; ++_i) \
        __builtin_amdgcn_global_load_lds((const unsigned*)((const char*)(gbase) + (voff)[_i]), (LAS unsigned*)(lds + (bufoff) + ldsw + _i * 8192), 16, 0, 0); } while (0)
#define PG8_LDA(dst, b, h) do { _Pragma("unroll") for (int m = 0; m < 4; ++m) _Pragma("unroll") for (int k = 0; k < 2; ++k) dst[m][k] = *(const LAS bf16x8*)(lds + PG8_SA(b, h) + aoff + m * 2048 + k * 1024); } while (0)
#define PG8_LDB(dst, b, h) do { _Pragma("unroll") for (int n = 0; n < 2; ++n) _Pragma("unroll") for (int k = 0; k < 2; ++k) dst[n][k] = *(const LAS bf16x8*)(lds + PG8_SB(b, h) + boff + n * 2048 + k * 1024); } while (0)
#define PG8_MMA(ai, bj, At, Bt) do { __builtin_amdgcn_s_setprio(1); _Pragma("unroll") for (int m = 0; m < 4; ++m) _Pragma("unroll") for (int n = 0; n < 2; ++n) _Pragma("unroll") for (int k = 0; k < 2; ++k) \
        acc[ai][bj][m][n] = __builtin_amdgcn_mfma_f32_16x16x32_bf16(Bt[n][k], At[m][k], acc[ai][bj][m][n], 0, 0, 0); __builtin_amdgcn_s_setprio(0); } while (0)
#define PG8_WAIT_V(n) asm volatile("s_waitcnt vmcnt(" #n ")" ::: "memory")
#define PG8_WAIT_L(n) asm volatile("s_waitcnt lgkmcnt(" #n ")" ::: "memory")
#define PG8_BAR __builtin_amdgcn_s_barrier()
#define PG8_SCHED __builtin_amdgcn_sched_barrier(0)
#define PG8_UA(u) ((const char*)g.A + (size_t)(u).pm * tstepA + (((u).pn >= g.split_pn) ? (size_t)g.split_aoff * 2 : (size_t)0))
    Unit cur, nxt; int ui = 0;
    if (!S.next(0, cur)) return;
    f32x4 acc[2][2][4][2];
#pragma unroll
    for (int a = 0; a < 2; ++a)
#pragma unroll
        for (int b = 0; b < 2; ++b)
#pragma unroll
            for (int m = 0; m < 4; ++m)
#pragma unroll
                for (int n = 0; n < 2; ++n) acc[a][b][m][n] = (f32x4){0.f, 0.f, 0.f, 0.f};
    bf16x8 At[4][2], B0[2][2], B1[2][2];
    const char* cA = PG8_UA(cur); const char* cB = (const char*)g.Bt + (size_t)cur.pn * tstepB;
    PG8_STAGE(PG8_SB(0, 0), cB, voffB); PG8_STAGE(PG8_SB(0, 1), cB + hstepB, voffB); PG8_STAGE(PG8_SA(0, 0), cA, voffA); PG8_STAGE(PG8_SA(0, 1), cA + hstepA, voffA);
    if (wr == 1) PG8_BAR;
    PG8_WAIT_V(2); PG8_BAR;
    PG8_STAGE(PG8_SB(1, 0), cB + kstep, voffB); PG8_STAGE(PG8_SA(1, 0), cA + kstep, voffA); PG8_STAGE(PG8_SB(1, 1), cB + hstepB + kstep, voffB);
    PG8_WAIT_V(6); PG8_BAR;
    for (;;) {
        const bool has_next = S.next(ui + 1, nxt);
        const char* nA = has_next ? PG8_UA(nxt) : cA; const char* nB = has_next ? (const char*)g.Bt + (size_t)nxt.pn * tstepB : cB;
        for (int t = 0; t < nt; t += 2) {
            if constexpr (Epi::HAS_MID) { if (t == g.mid_t) E.mid(acc, cur, wr, wc, fr, fq); }
            const bool last = (t == nt - 2);
            const char* a1 = cA + (size_t)(t + 1) * kstep;
            const char* a2 = last ? nA : cA + (size_t)(t + 2) * kstep; const char* b2 = last ? nB : cB + (size_t)(t + 2) * kstep;
            const char* a3 = a2 + kstep; const char* b3 = b2 + kstep;
            PG8_LDB(B0, 0, 0); PG8_LDB(B1, 0, 1); PG8_SCHED; PG8_LDA(At, 0, 0); PG8_STAGE(PG8_SA(1, 1), a1 + hstepA, voffA);
            PG8_WAIT_V(8); PG8_WAIT_L(0); PG8_BAR; PG8_MMA(0, 0, At, B0); PG8_MMA(0, 1, At, B1); PG8_BAR; PG8_SCHED;
            PG8_LDA(At, 0, 1); PG8_STAGE(PG8_SB(0, 0), b2, voffB); PG8_STAGE(PG8_SB(0, 1), b2 + hstepB, voffB); PG8_STAGE(PG8_SA(0, 0), a2, voffA);
            PG8_WAIT_V(8); PG8_WAIT_L(0); PG8_BAR; PG8_MMA(1, 0, At, B0); PG8_MMA(1, 1, At, B1); PG8_BAR; PG8_SCHED;
            PG8_LDB(B0, 1, 0); PG8_LDB(B1, 1, 1); PG8_SCHED; PG8_LDA(At, 1, 0); PG8_STAGE(PG8_SA(0, 1), a2 + hstepA, voffA);
            PG8_WAIT_V(8); PG8_WAIT_L(0); PG8_BAR; PG8_MMA(0, 0, At, B0); PG8_MMA(0, 1, At, B1); PG8_BAR; PG8_SCHED;
            PG8_LDA(At, 1, 1); PG8_STAGE(PG8_SB(1, 0), b3, voffB); PG8_STAGE(PG8_SB(1, 1), b3 + hstepB, voffB); PG8_STAGE(PG8_SA(1, 0), a3, voffA);
            PG8_WAIT_V(8); PG8_WAIT_L(0); PG8_BAR; PG8_MMA(1, 0, At, B0); PG8_MMA(1, 1, At, B1); PG8_BAR; PG8_SCHED;
        }
        if (wr == 0) PG8_BAR;
        E(acc, cur, wr, wc, fr, fq);
        if (!has_next) break;
#pragma unroll
        for (int a = 0; a < 2; ++a)
#pragma unroll
            for (int b = 0; b < 2; ++b)
#pragma unroll
                for (int m = 0; m < 4; ++m)
#pragma unroll
                    for (int n = 0; n < 2; ++n) acc[a][b][m][n] = (f32x4){0.f, 0.f, 0.f, 0.f};
        cur = nxt; cA = nA; cB = nB; ++ui;
        if (wr == 1) PG8_BAR;
    }
    PG8_WAIT_V(0);
    PG8_BAR;
#undef PG8_SA
#undef PG8_SB
#undef PG8_STAGE
#undef PG8_LDA
#undef PG8_LDB
#undef PG8_MMA
#undef PG8_UA
}
}

__device__ __forceinline__ float row_rs(const float* rsp, int row) {
    const f32x4* p = (const f32x4*)(rsp + (size_t)row * 16);
    f32x4 a = p[0], b = p[1], c = p[2], d = p[3];
    float s = ((a.x + a.y) + (a.z + a.w)) + ((b.x + b.y) + (b.z + b.w)) + ((c.x + c.y) + (c.z + c.w)) + ((d.x + d.y) + (d.z + d.w));
    return __builtin_amdgcn_rsqf(s * (1.0f / Dm) + EPS);
}
__device__ __forceinline__ void rows_rs4(const float* rsp, int row0  , float (&rs)[4]) {
#pragma unroll
    for (int mp = 0; mp < 2; ++mp) {
        f32x4 p[2][4];
#pragma unroll
        for (int m = 0; m < 2; ++m) { const f32x4* q = (const f32x4*)(rsp + (size_t)(row0 + 16 * (2 * mp + m)) * 16);
#pragma unroll
            for (int i = 0; i < 4; ++i) p[m][i] = q[i]; }
#pragma unroll
        for (int m = 0; m < 2; ++m) { float t = 0.f;
#pragma unroll
            for (int i = 0; i < 4; ++i) t += (p[m][i].x + p[m][i].y) + (p[m][i].z + p[m][i].w);
            rs[2 * mp + m] = __builtin_amdgcn_rsqf(t * (1.0f / Dm) + EPS); }
        __builtin_amdgcn_sched_barrier(0);
    }
}
__device__ __forceinline__ void rows_rs2(const float* rsp, int row0, float (&rs)[2]) {
    f32x4 p[2][4];
#pragma unroll
    for (int m = 0; m < 2; ++m) { const f32x4* q = (const f32x4*)(rsp + (size_t)(row0 + 16 * m) * 16);
#pragma unroll
        for (int i = 0; i < 4; ++i) p[m][i] = q[i]; }
#pragma unroll
    for (int m = 0; m < 2; ++m) { float t = 0.f;
#pragma unroll
        for (int i = 0; i < 4; ++i) t += (p[m][i].x + p[m][i].y) + (p[m][i].z + p[m][i].w);
        rs[m] = __builtin_amdgcn_rsqf(t * (1.0f / Dm) + EPS); }
}
__device__ __forceinline__ u32x4 pack8(const float* v) { u32x4 w; w.x = pk2(v[0], v[1]); w.y = pk2(v[2], v[3]); w.z = pk2(v[4], v[5]); w.w = pk2(v[6], v[7]); return w; }

struct EpiMix {
    static constexpr bool HAS_MID = false;
    const float* rsp; const float* cs; const float* lbF; const float* lbB;
    bf16_t *Q, *Kk, *V, *HQ, *HV, *BG, *GF, *GB;
    template <int GRP>
    __device__ __forceinline__ void run(const f32x4 (&acc)[2][2][4][2], const pg8::Unit& u, int wr, int wc, int fr, int fq) const {
#pragma unroll
        for (int ai = 0; ai < 2; ++ai)
#pragma unroll
        for (int mp = 0; mp < 2; ++mp) {
            const int row0 = u.pm * 256 + ai * 128 + wr * 64 + mp * 32 + fr;
            float rs4[2]; rows_rs2(rsp, row0, rs4);
            const int d0r = (wc * 32 + fq * 8) & 63;
            f32x4 c4r[2], s4r[2];
            if constexpr (GRP <= 1) {
                if (d0r < 16) {
#pragma unroll
                    for (int mm = 0; mm < 2; ++mm) { const float* cp = cs + (size_t)(row0 + 16 * mm) * 16 + (d0r >> 3) * 4; c4r[mm] = *(const f32x4*)cp; s4r[mm] = *(const f32x4*)(cp + 8); }
                }
            }
            __builtin_amdgcn_sched_barrier(0);
#pragma unroll
            for (int mm = 0; mm < 2; ++mm) {
                const int m = 2 * mp + mm;
                const int row = row0 + mm * 16;
                const float rs = rs4[mm];
                const int b = row >> 12, s = row & 4095;
#pragma unroll
                for (int bj = 0; bj < 2; ++bj) {
                    const int col = u.pn * 256 + bj * 128 + wc * 32 + fq * 8;
                    const int jj = col & 511;
                    float v[8];
#pragma unroll
                    for (int e = 0; e < 4; ++e) { v[e] = acc[ai][bj][m][0][e] * rs; v[4 + e] = acc[ai][bj][m][1][e] * rs; }
                    if constexpr (GRP <= 1) {
                        const int d0 = jj & 63;
                        if (d0 < 16) {
                            const f32x4 c4 = c4r[mm], s4 = s4r[mm];
#pragma unroll
                            for (int e = 0; e < 4; ++e) { const float t1 = v[e], t2 = v[4 + e]; v[e] = t1 * c4[e] - t2 * s4[e]; v[4 + e] = t2 * c4[e] + t1 * s4[e]; }
                        }
                        if constexpr (GRP == 0) {
#pragma unroll
                            for (int e = 0; e < 8; ++e) v[e] *= 0.125f * LOG2E;
                        }
                        const int h = jj >> 7, c = (jj >> 6) & 1;
                        bf16_t* dst = (GRP == 0 ? Q : Kk) + ((size_t)(((b * 4 + h) * 2 + c) * SEQ + s)) * 64 + d0;
                        *(u32x4*)dst = pack8(v);
                    } else if constexpr (GRP == 2) {
                        const int h = jj >> 7, d0 = jj & 127;
                        *(u32x4*)(V + ((size_t)((b * 4 + h) * SEQ + s)) * 128 + d0) = pack8(v);
                    } else if constexpr (GRP == 3) {
                        *(u32x4*)(HQ + (size_t)row * 512 + jj) = pack8(v);
                    } else if constexpr (GRP == 4 || GRP == 5) {
                        const float* lbp = (GRP == 4 ? lbF : lbB) + jj;
                        const f32x4 l0 = *(const f32x4*)lbp, l1 = *(const f32x4*)(lbp + 4);
                        float gl[8];
#pragma unroll
                        for (int e = 0; e < 8; ++e) { const float lb = e < 4 ? l0[e] : l1[e - 4]; const float f = lb + (1.0f - lb) * sigmoidf_(v[e]); gl[e] = __builtin_amdgcn_logf(fmaxf(f, 1e-37f)) * 0.6931471805599453f; }
                        *(u32x4*)((GRP == 4 ? GF : GB) + (size_t)row * 512 + jj) = pack8(gl);
                    } else if constexpr (GRP == 6) {
                        *(u32x4*)(HV + (size_t)row * 512 + jj) = pack8(v);
                    } else {
#pragma unroll
                        for (int e = 0; e < 8; ++e) v[e] = sigmoidf_(v[e]);
                        *(u32x4*)(BG + (size_t)row * 512 + jj) = pack8(v);
                    }
                }
            }
            __builtin_amdgcn_sched_barrier(0);
        }
    }
    __device__ __forceinline__ void operator()(const f32x4 (&acc)[2][2][4][2], const pg8::Unit& u, int wr, int wc, int fr, int fq) const {
        switch (u.pn >> 1) {
            case 0: run<0>(acc, u, wr, wc, fr, fq); break;
            case 1: run<1>(acc, u, wr, wc, fr, fq); break;
            case 2: run<2>(acc, u, wr, wc, fr, fq); break;
            case 3: run<3>(acc, u, wr, wc, fr, fq); break;
            case 4: run<4>(acc, u, wr, wc, fr, fq); break;
            case 5: run<5>(acc, u, wr, wc, fr, fq); break;
            case 6: run<6>(acc, u, wr, wc, fr, fq); break;
            default: run<7>(acc, u, wr, wc, fr, fq); break;
        }
    }
};

struct EpiGate {
    static constexpr bool HAS_MID = false;
    const float* rsp; bf16_t* G;
    __device__ __forceinline__ void operator()(const f32x4 (&acc)[2][2][4][2], const pg8::Unit& u, int wr, int wc, int fr, int fq) const {
#pragma unroll
        for (int ai = 0; ai < 2; ++ai) {
            const int row0 = u.pm * 256 + ai * 128 + wr * 64 + fr;
            float rs4[4]; rows_rs4(rsp, row0, rs4);
            __builtin_amdgcn_sched_barrier(0);
#pragma unroll
            for (int m = 0; m < 4; ++m) {
                const int row = row0 + m * 16;
                const float rs = rs4[m];
                const int col = u.pn * 128 + wc * 32 + fq * 8;
                float r[8], sb[8];
                const float nrl = -rs * LOG2E;
#pragma unroll
                for (int n = 0; n < 2; ++n) {
                    f32x4 ta = acc[ai][0][m][n] * nrl, tb = acc[ai][1][m][n] * nrl;
                    ta = __builtin_elementwise_min(ta, (f32x4){86.f, 86.f, 86.f, 86.f}); tb = __builtin_elementwise_min(tb, (f32x4){86.f, 86.f, 86.f, 86.f});
                    ta.x = __builtin_amdgcn_exp2f(ta.x); ta.y = __builtin_amdgcn_exp2f(ta.y); ta.z = __builtin_amdgcn_exp2f(ta.z); ta.w = __builtin_amdgcn_exp2f(ta.w);
                    tb.x = __builtin_amdgcn_exp2f(tb.x); tb.y = __builtin_amdgcn_exp2f(tb.y); tb.z = __builtin_amdgcn_exp2f(tb.z); tb.w = __builtin_amdgcn_exp2f(tb.w);
                    ta = ta + 1.0f; tb = tb + 1.0f;
                    f32x4 ia, ib;
                    ia.x = __builtin_amdgcn_rcpf(ta.x); ia.y = __builtin_amdgcn_rcpf(ta.y); ia.z = __builtin_amdgcn_rcpf(ta.z); ia.w = __builtin_amdgcn_rcpf(ta.w);
                    ib.x = __builtin_amdgcn_rcpf(tb.x); ib.y = __builtin_amdgcn_rcpf(tb.y); ib.z = __builtin_amdgcn_rcpf(tb.z); ib.w = __builtin_amdgcn_rcpf(tb.w);
                    const f32x4 qa = ia * 255.0f, qb = __builtin_elementwise_max(ib * 255.0f, (f32x4){1.f, 1.f, 1.f, 1.f});
                    r[n * 4] = qa.x; r[n * 4 + 1] = qa.y; r[n * 4 + 2] = qa.z; r[n * 4 + 3] = qa.w;
                    sb[n * 4] = qb.x; sb[n * 4 + 1] = qb.y; sb[n * 4 + 2] = qb.z; sb[n * 4 + 3] = qb.w;
                }
                { u32x2 wa = {0u, 0u}, wb = {0u, 0u};
#pragma unroll
                  for (int e = 0; e < 4; ++e) { wa.x = __builtin_amdgcn_cvt_pk_u8_f32(r[e], e, wa.x); wa.y = __builtin_amdgcn_cvt_pk_u8_f32(r[4 + e], e, wa.y);
                      wb.x = __builtin_amdgcn_cvt_pk_u8_f32(sb[e], e, wb.x); wb.y = __builtin_amdgcn_cvt_pk_u8_f32(sb[4 + e], e, wb.y); }
                  unsigned char* g8 = (unsigned char*)G;
                  *(u32x2*)(g8 + (size_t)row * 2048 + col) = wa; *(u32x2*)(g8 + (size_t)row * 2048 + 1024 + col) = wb; }
            }
            __builtin_amdgcn_sched_barrier(0);
        }
    }
};

struct EpiY {
    static constexpr bool HAS_MID = true;
    const bf16_t* G; bf16_t* Y;
    __device__ __forceinline__ void mid(f32x4 (&acc)[2][2][4][2], const pg8::Unit& u, int wr, int wc, int fr, int fq) const {
        int fr_ = fr; asm volatile("" : "+v"(fr_));
#pragma unroll
        for (int ai = 0; ai < 2; ++ai) {
            __builtin_amdgcn_sched_barrier(0);
#pragma unroll
            for (int m = 0; m < 4; ++m) {
                const int row = u.pm * 256 + ai * 128 + wr * 64 + m * 16 + fr_;
#pragma unroll
                for (int bj = 0; bj < 2; ++bj) {
                    const int col = u.pn * 256 + bj * 128 + wc * 32 + fq * 8;
                    const unsigned char* g8 = (const unsigned char*)G + (size_t)row * 2048 + col;
                    const u32x2 qa = *(const u32x2*)g8, qb = *(const u32x2*)(g8 + 1024);
#pragma unroll
                    for (int n = 0; n < 2; ++n)
#pragma unroll
                        for (int e = 0; e < 4; ++e) { const unsigned wa = n ? qa.y : qa.x, wb = n ? qb.y : qb.x;
                            acc[ai][bj][m][n][e] *= (float)((wa >> (8 * e)) & 255u) * __builtin_amdgcn_rcpf((float)((wb >> (8 * e)) & 255u)); }
                }
            }
        }
        __builtin_amdgcn_sched_barrier(0);
    }
    __device__ __forceinline__ void operator()(const f32x4 (&acc)[2][2][4][2], const pg8::Unit& u, int wr, int wc, int fr, int fq) const {
#pragma unroll
        for (int ai = 0; ai < 2; ++ai) {
            u32x2 gqr[4][2];
#pragma unroll
            for (int m = 0; m < 4; ++m)
#pragma unroll
                for (int bj = 0; bj < 2; ++bj) gqr[m][bj] = *(const u32x2*)((const unsigned char*)G + (size_t)(u.pm * 256 + ai * 128 + wr * 64 + m * 16 + fr) * 2048 + 1024 + u.pn * 256 + bj * 128 + wc * 32 + fq * 8);
            __builtin_amdgcn_sched_barrier(0);
#pragma unroll
            for (int m = 0; m < 4; ++m) {
                const int row = u.pm * 256 + ai * 128 + wr * 64 + m * 16 + fr;
#pragma unroll
                for (int bj = 0; bj < 2; ++bj) {
                    const int col = u.pn * 256 + bj * 128 + wc * 32 + fq * 8;
                    const u32x2 gq = gqr[m][bj];
                    float v[8];
#pragma unroll
                    for (int n = 0; n < 2; ++n)
#pragma unroll
                        for (int e = 0; e < 4; ++e) { const unsigned wb = n ? gq.y : gq.x; v[n * 4 + e] = acc[ai][bj][m][n][e] * ((float)((wb >> (8 * e)) & 255u) * (1.0f / 255.0f)); }
                    *(u32x4*)(Y + (size_t)row * 1024 + col) = pack8(v);
                }
            }
            __builtin_amdgcn_sched_barrier(0);
        }
    }
};

struct EpiRes {
    static constexpr bool HAS_MID = false;
    bf16_t* XB; float* rsp;
    __device__ __forceinline__ void operator()(const f32x4 (&acc)[2][2][4][2], const pg8::Unit& u, int wr, int wc, int fr, int fq) const {
#pragma unroll
        for (int ai = 0; ai < 2; ++ai) {
            u32x4 xr[4][2];
#pragma unroll
            for (int m = 0; m < 4; ++m)
#pragma unroll
                for (int bj = 0; bj < 2; ++bj) xr[m][bj] = *(const u32x4*)(XB + (size_t)(u.pm * 256 + ai * 128 + wr * 64 + m * 16 + fr) * Dm + u.pn * 256 + bj * 128 + wc * 32 + fq * 8);
            __builtin_amdgcn_sched_barrier(0);
#pragma unroll
            for (int m = 0; m < 4; ++m) {
                const int row = u.pm * 256 + ai * 128 + wr * 64 + m * 16 + fr;
                float ss = 0.f;
#pragma unroll
                for (int bj = 0; bj < 2; ++bj) {
                    const int col = u.pn * 256 + bj * 128 + wc * 32 + fq * 8;
                    const u32x4 x = xr[m][bj];
                    float v[8];
                    v[0] = bflo(x.x) + acc[ai][bj][m][0][0]; v[1] = bfhi(x.x) + acc[ai][bj][m][0][1]; v[2] = bflo(x.y) + acc[ai][bj][m][0][2]; v[3] = bfhi(x.y) + acc[ai][bj][m][0][3];
                    v[4] = bflo(x.z) + acc[ai][bj][m][1][0]; v[5] = bfhi(x.z) + acc[ai][bj][m][1][1]; v[6] = bflo(x.w) + acc[ai][bj][m][1][2]; v[7] = bfhi(x.w) + acc[ai][bj][m][1][3];
#pragma unroll
                    for (int e = 0; e < 8; ++e) ss += v[e] * v[e];
                    *(u32x4*)(XB + (size_t)row * Dm + col) = pack8(v);
                }
                ss += __shfl_xor(ss, 16); ss += __shfl_xor(ss, 32);
                if (fq == 0) rsp[(size_t)row * 16 + u.pn * 4 + wc] = ss;
            }
            __builtin_amdgcn_sched_barrier(0);
        }
    }
};

struct EpiGU {
    static constexpr bool HAS_MID = false;
    const float* rsp; bf16_t* H;
    __device__ __forceinline__ void operator()(const f32x4 (&acc)[2][2][4][2], const pg8::Unit& u, int wr, int wc, int fr, int fq) const {
#pragma unroll
        for (int ai = 0; ai < 2; ++ai) {
            const int row0 = u.pm * 256 + ai * 128 + wr * 64 + fr;
            float rs4[4]; rows_rs4(rsp, row0, rs4);
            __builtin_amdgcn_sched_barrier(0);
#pragma unroll
            for (int m = 0; m < 4; ++m) {
                const int row = row0 + m * 16;
                const float rs = rs4[m];
                const int col = u.pn * 128 + wc * 32 + fq * 8;
                float v[8];
                const float nrl = -rs * LOG2E, rs2 = rs * rs;
#pragma unroll
                for (int n = 0; n < 2; ++n) {
                    const f32x4 a = acc[ai][0][m][n], b = acc[ai][1][m][n];
                    f32x4 t = a * nrl;
                    t.x = __builtin_amdgcn_exp2f(t.x); t.y = __builtin_amdgcn_exp2f(t.y); t.z = __builtin_amdgcn_exp2f(t.z); t.w = __builtin_amdgcn_exp2f(t.w);
                    t = t + 1.0f;
                    t.x = __builtin_amdgcn_rcpf(t.x); t.y = __builtin_amdgcn_rcpf(t.y); t.z = __builtin_amdgcn_rcpf(t.z); t.w = __builtin_amdgcn_rcpf(t.w);
                    const f32x4 o = ((a * b) * rs2) * t;
                    v[n * 4] = o.x; v[n * 4 + 1] = o.y; v[n * 4 + 2] = o.z; v[n * 4 + 3] = o.w;
                }
                *(u32x4*)(H + (size_t)row * FF + col) = pack8(v);
            }
            __builtin_amdgcn_sched_barrier(0);
        }
    }
};

__device__ __forceinline__ int rope_perm(int n) {
    const int d = n & 63; if (d >= 16) return n;
    const int g = d >> 3, e = d & 7; return (n & ~63) + ((e < 4) ? 4 * g + e : 8 + 4 * g + (e - 4));
}
__device__ __forceinline__ void conv_item(const float* src, int ld_src, int ks0, int c0  , int mode  ,
                                          const float* gain, bf16_t* dst, int ld_dst, int n0, int kd0, LAS float* scr, int lane) {
    const int n4 = lane & 7, kr = lane >> 3;
    int sc = c0 + 4 * n4;
    if (mode) { const int q = (sc & 63) >> 2; if (q == 1) sc += 4; else if (q == 2) sc -= 4; }
#pragma unroll
    for (int i = 0; i < 8; ++i) { const int kk = kr + 8 * i; f32x4 w = *(const f32x4*)(src + (size_t)(ks0 + kk) * ld_src + sc);
        if (gain) { const float gg = gain[ks0 + kk]; w.x *= gg; w.y *= gg; w.z *= gg; w.w *= gg; }
        LAS float* d = scr + kk * 33 + 4 * n4; d[0] = w.x; d[1] = w.y; d[2] = w.z; d[3] = w.w; }
    asm volatile("s_waitcnt lgkmcnt(0)" ::: "memory");
    const int c = lane & 7;
#pragma unroll
    for (int j = 0; j < 4; ++j) { const int n = (lane >> 3) + 8 * j; const LAS float* s = scr + (8 * c) * 33 + n;
        u32x4 o; o.x = pk2(s[0 * 33], s[1 * 33]); o.y = pk2(s[2 * 33], s[3 * 33]); o.z = pk2(s[4 * 33], s[5 * 33]); o.w = pk2(s[6 * 33], s[7 * 33]);
        *(u32x4*)(dst + (size_t)(n0 + n) * ld_dst + kd0 + 8 * c) = o; }
    asm volatile("s_waitcnt lgkmcnt(0)" ::: "memory");
}

struct Ptrs {
    const float *x; const int* pos; const float *w_in, *da_lambda, *da_norm, *hg_lb, *hg_norm, *w_a, *w_b, *w_o, *attn_norm, *ffn_norm, *w_gate, *w_up, *w_down, *final_norm;
    float* out; unsigned char* ws; int ph_lo, ph_hi;
};

__device__ __forceinline__ void convert_layer(const Ptrs& P, int layer, unsigned char* wbuf, LAS unsigned char* lds, int gw, int ngw, int wave, int lane) {
    LAS float* scr = (LAS float*)(lds + wave * 8704);
    constexpr int I_IN = 16 * 192, I_A = 8 * 32, I_B = 8 * 32, I_O = 16 * 32, I_GU = 16 * 176, I_D = 44 * 32;
    constexpr int NIT = I_IN + I_A + I_B + I_O + I_GU + I_D;
    for (int it = gw; it < NIT; it += ngw) {
        int r = it;
        if (r < I_IN) { const int kb = r / 192, nb = r % 192, n0 = nb * 32;
            int c0 = n0; if (n0 >= 4096) { const int q = n0 - 4096, tile = q >> 8, rr = q & 255; c0 = (rr < 128 ? 4096 : 5120) + tile * 128 + (rr & 127); }
            conv_item(P.w_in + (size_t)layer * Dm * INW, INW, kb * 64, c0, n0 < 1024 ? 1 : 0, P.attn_norm + layer * Dm, (bf16_t*)(wbuf + W_IN), Dm, n0, kb * 64, scr, lane); continue; }
        r -= I_IN;
        if (r < I_A) { const int kb = r / 32, nb = r % 32;
            conv_item(P.w_a + (size_t)layer * 512 * Dm, Dm, kb * 64, nb * 32, 0, nullptr, (bf16_t*)(wbuf + W_AB), 1024, nb * 32, kb * 64, scr, lane); continue; }
        r -= I_A;
        if (r < I_B) { const int kb = r / 32, nb = r % 32;
            conv_item(P.w_b + (size_t)layer * 512 * Dm, Dm, kb * 64, nb * 32, 0, nullptr, (bf16_t*)(wbuf + W_AB), 1024, nb * 32, 512 + kb * 64, scr, lane); continue; }
        r -= I_B;
        if (r < I_O) { const int kb = r / 32, nb = r % 32;
            conv_item(P.w_o + (size_t)layer * Dm * Dm, Dm, kb * 64, nb * 32, 0, nullptr, (bf16_t*)(wbuf + W_O2), Dm, nb * 32, kb * 64, scr, lane); continue; }
        r -= I_O;
        if (r < I_GU) { const int kb = r / 176, nb = r % 176, n0 = nb * 32, tile = n0 >> 8, rr = n0 & 255;
            const float* srcm = (rr < 128 ? P.w_gate : P.w_up) + (size_t)layer * Dm * FF;
            conv_item(srcm, FF, kb * 64, tile * 128 + (rr & 127), 0, P.ffn_norm + layer * Dm, (bf16_t*)(wbuf + W_GU), Dm, n0, kb * 64, scr, lane); continue; }
        r -= I_GU;
        { const int kb = r / 32, nb = r % 32;
            conv_item(P.w_down + (size_t)layer * FF * Dm, Dm, kb * 64, nb * 32, 0, nullptr, (bf16_t*)(wbuf + W_D), FF, nb * 32, kb * 64, scr, lane); }
    }
}

__device__ __forceinline__ float wave_sum(float v) {
#pragma unroll
    for (int o = 1; o < 64; o <<= 1) v += __shfl_xor(v, o);
    return v;
}
__device__ __forceinline__ void prologue(const Ptrs& P, LAS unsigned char* lds, int gw, int ngw, int wave, int lane) {
    unsigned char* ws = P.ws;
    bf16_t* XB = (bf16_t*)(ws + OFF_XB); float* rsb = (float*)(ws + OFF_RSB);
    for (int r = gw; r < M; r += ngw) {
        const f32x4* xr = (const f32x4*)(P.x + (size_t)r * Dm) + lane;
        float ss = 0.f;
#pragma unroll
        for (int j = 0; j < 4; ++j) { const f32x4 v = xr[64 * j]; ss += (v.x * v.x + v.y * v.y) + (v.z * v.z + v.w * v.w);
            u32x2 o; o.x = pk2(v.x, v.y); o.y = pk2(v.z, v.w); *((u32x2*)(XB + (size_t)r * Dm) + lane + 64 * j) = o; }
        ss = wave_sum(ss);
        if (lane < 16) rsb[(size_t)r * 16 + lane] = (lane == 0) ? ss : 0.f;
    }
    const int gt = gw * 64 + lane, ngt = ngw * 64;
    float* cs = (float*)(ws + OFF_CS);
    for (int i = gt; i < M * 8; i += ngt) {
        const int tok = i >> 3, f = i & 7;
        const double invf[8] = {1.0, 0.19392274474868576, 0.03760603093086393, 0.007292664737217109, 0.001414213562373095, 0.0002742481756762073, 5.318295896944988e-05, 1.031338537721246e-05};
        double fr;
        switch (f) { case 0: fr = invf[0]; break; case 1: fr = invf[1]; break; case 2: fr = invf[2]; break; case 3: fr = invf[3]; break; case 4: fr = invf[4]; break; case 5: fr = invf[5]; break; case 6: fr = invf[6]; break; default: fr = invf[7]; }
        const float ang32 = (float)P.pos[tok] * (float)fr;
        const double ang = (double)ang32;
        const double rev = ang * 0.15915494309189535;
        const double fracrev = rev - __builtin_floor(rev + 0.5);
        const float a = (float)(fracrev * 6.283185307179586);
        cs[(size_t)tok * 16 + f] = __cosf(a); cs[(size_t)tok * 16 + 8 + f] = __sinf(a);
    }
    float* LB = (float*)(ws + OFF_LB);
    for (int i = gt; i < 2 * 512; i += ngt) {
        const int d = i >> 9, k = i & 511;
        float l[4], mx = -1e30f;
#pragma unroll
        for (int j = 0; j < 4; ++j) { l[j] = P.hg_lb[(size_t)(d * 4 + j) * 512 + k]; mx = fmaxf(mx, l[j]); }
        float e[4], sum = 0.f;
#pragma unroll
        for (int j = 0; j < 4; ++j) { e[j] = __expf(l[j] - mx); sum += e[j]; }
        float cum = 0.f;
#pragma unroll
        for (int j = 0; j < 4; ++j) { if (j > 0) cum += e[j] / sum; LB[(size_t)(d * 4 + j) * 512 + k] = cum; }
    }
    if (gw == 0) {
        float* LAM = (float*)(ws + OFF_LAM);
        for (int l = 0; l < 4; ++l) {
            const float* p = P.da_lambda + l * 256;
            float a = wave_sum(p[lane] * p[64 + lane]), b = wave_sum(p[128 + lane] * p[192 + lane]);
            const float lam_init = 0.8f - 0.6f * __expf(-0.3f * (float)l);
            if (lane == 0) LAM[l] = __expf(a) - __expf(b) + lam_init;
        }
    }
}

constexpr int AT_KROW = 144, AT_VROW = 320, AT_K1 = 64 * AT_KROW, AT_V = 2 * AT_K1, AT_STG = AT_V + 64 * AT_VROW;
constexpr int AT_IMG_ROW = 132;
__device__ __forceinline__ s16x4 tr_read(const LAS unsigned char* p) { return __builtin_bit_cast(s16x4, __builtin_amdgcn_ds_read_tr16_b64_v4i16((LAS s16x4*)p)); }

__device__ __forceinline__ void attn_unit(int b, int h, int qb, const bf16_t* Q, const bf16_t* Kk, const bf16_t* V, bf16_t* AO, const float* gainA  , float one_minus_lam_init, float lam, LAS unsigned char* lds) {
    int tid_ = threadIdx.x; asm volatile("" : "+v"(tid_));
    const int tid = tid_, wave = __builtin_amdgcn_readfirstlane(tid >> 6), lane = tid & 63, c = wave >> 2, wq = wave & 3, r32 = lane & 31, hh = lane >> 5;
    const int q0 = qb * 128 + wq * 32;
    bf16x8 qf[4];
    { const bf16_t* Qp = Q + ((size_t)(((b * 4 + h) * 2 + c) * SEQ + q0 + r32)) * 64 + 8 * hh;
#pragma unroll
      for (int s = 0; s < 4; ++s) qf[s] = *(const bf16x8*)(Qp + 16 * s); }
    f32x16 o[4];
#pragma unroll
    for (int i = 0; i < 4; ++i)
#pragma unroll
        for (int e = 0; e < 16; ++e) o[i][e] = 0.f;
    float mrow = -1e30f, lrow = 0.f;
    const unsigned char* Kg0 = (const unsigned char*)(Kk + ((size_t)((b * 4 + h) * 2 + 0) * SEQ) * 64);
    const unsigned char* Kg1 = (const unsigned char*)(Kk + ((size_t)((b * 4 + h) * 2 + 1) * SEQ) * 64);
    const unsigned char* Vg = (const unsigned char*)(V + ((size_t)(b * 4 + h) * SEQ) * 128);
    const int lk = (tid >> 3) * AT_KROW + (tid & 7) * 16;
    const int lv0 = AT_V + (tid >> 4) * AT_VROW + (tid & 15) * 16, lv1 = lv0 + 32 * AT_VROW;
    u32x4 r0, r1, r2, r3;
    r0 = *(const u32x4*)(Kg0 + tid * 16); r1 = *(const u32x4*)(Kg1 + tid * 16); r2 = *(const u32x4*)(Vg + tid * 16); r3 = *(const u32x4*)(Vg + 8192 + tid * 16);
    *(LAS u32x4*)(lds + lk) = r0; *(LAS u32x4*)(lds + AT_K1 + lk) = r1; *(LAS u32x4*)(lds + lv0) = r2; *(LAS u32x4*)(lds + lv1) = r3;
    r0 = *(const u32x4*)(Kg0 + 8192 + tid * 16); r1 = *(const u32x4*)(Kg1 + 8192 + tid * 16);
    *(LAS u32x4*)(lds + AT_STG + lk) = r0; *(LAS u32x4*)(lds + AT_STG + AT_K1 + lk) = r1;
    __syncthreads();
    const int ka = c * AT_K1 + r32 * AT_KROW + hh * 16;
    const int va = AT_V + (4 * hh + ((lane & 15) >> 2)) * AT_VROW + ((lane >> 4) & 1) * 32 + (lane & 3) * 8;

#define AT_QK(sv, st) do { f32x16 t0_, t1_; _Pragma("unroll") for (int e = 0; e < 16; ++e) { t0_[e] = 0.f; t1_[e] = 0.f; } \
        _Pragma("unroll") for (int ks = 0; ks < 4; ++ks) { \
            const bf16x8 a0 = *(const LAS bf16x8*)(lds + (st) + ka + ks * 32), a1 = *(const LAS bf16x8*)(lds + (st) + ka + 32 * AT_KROW + ks * 32); \
            t0_ = __builtin_amdgcn_mfma_f32_32x32x16_bf16(a0, qf[ks], t0_, 0, 0, 0); t1_ = __builtin_amdgcn_mfma_f32_32x32x16_bf16(a1, qf[ks], t1_, 0, 0, 0); } \
        sv##0 = t0_; sv##1 = t1_; } while (0)
    f32x16 sA0, sA1, sB0, sB1;
    AT_QK(sA, 0);
#define AT_VFRAG(dst, STC, g) do { const LAS unsigned char* vb_ = lds + (STC) + va + (16 * (g)) * AT_VROW; \
        _Pragma("unroll") for (int vt = 0; vt < 4; ++vt) { const s16x4 t0 = tr_read(vb_ + vt * 64), t1 = tr_read(vb_ + vt * 64 + 8 * AT_VROW); \
            dst[vt] = (bf16x8){t0[0], t0[1], t0[2], t0[3], t1[0], t1[1], t1[2], t1[3]}; } } while (0)
#define AT_PV(vf, p) do { __builtin_amdgcn_s_setprio(1); _Pragma("unroll") for (int vt = 0; vt < 4; ++vt) o[vt] = __builtin_amdgcn_mfma_f32_32x32x16_bf16(vf[vt], p, o[vt], 0, 0, 0); __builtin_amdgcn_s_setprio(0); } while (0)
#define AT_SB __builtin_amdgcn_sched_barrier(0)
#define AT_TILE(j, s0, s1, sn, STC  , STN  ) do { \
        if ((j) + 2 < 64) { const size_t go = (size_t)((j) + 2) * 8192; r0 = *(const u32x4*)(Kg0 + go + tid * 16); r1 = *(const u32x4*)(Kg1 + go + tid * 16); } \
        if ((j) + 1 < 64) { const size_t go = (size_t)((j) + 1) * 16384; r2 = *(const u32x4*)(Vg + go + tid * 16); r3 = *(const u32x4*)(Vg + go + 8192 + tid * 16); } \
        bf16x8 kf[4], kg[4], vA[4]; \
        if ((j) + 1 < 64) { _Pragma("unroll") for (int ks = 0; ks < 2; ++ks) { kf[2 * ks] = *(const LAS bf16x8*)(lds + (STN) + ka + ks * 32); kf[2 * ks + 1] = *(const LAS bf16x8*)(lds + (STN) + ka + 32 * AT_KROW + ks * 32); } } \
        AT_SB; \
        float mx = fmaxf(s0[0], s1[0]); \
        _Pragma("unroll") for (int e = 1; e < 16; ++e) mx = fmaxf(mx, fmaxf(s0[e], s1[e])); \
        mx = fmaxf(mx, __shfl_xor(mx, 32)); \
        if (__builtin_amdgcn_ballot_w64(mx > mrow + 8.0f) != 0ull) { \
            const float mnew = fmaxf(mrow, mx), alpha = __builtin_amdgcn_exp2f(mrow - mnew); mrow = mnew; lrow *= alpha; \
            _Pragma("unroll") for (int i = 0; i < 4; ++i) _Pragma("unroll") for (int e = 0; e < 16; ++e) o[i][e] *= alpha; } \
        AT_SB; \
        if ((j) + 1 < 64) { f32x16 t0_, t1_; _Pragma("unroll") for (int e = 0; e < 16; ++e) { t0_[e] = 0.f; t1_[e] = 0.f; } \
            __builtin_amdgcn_s_setprio(1); \
            _Pragma("unroll") for (int ks = 0; ks < 2; ++ks) { t0_ = __builtin_amdgcn_mfma_f32_32x32x16_bf16(kf[2 * ks], qf[ks], t0_, 0, 0, 0); t1_ = __builtin_amdgcn_mfma_f32_32x32x16_bf16(kf[2 * ks + 1], qf[ks], t1_, 0, 0, 0); } \
            AT_SB; \
            _Pragma("unroll") for (int ks = 0; ks < 2; ++ks) { kg[2 * ks] = *(const LAS bf16x8*)(lds + (STN) + ka + (ks + 2) * 32); kg[2 * ks + 1] = *(const LAS bf16x8*)(lds + (STN) + ka + 32 * AT_KROW + (ks + 2) * 32); } \
            AT_SB; \
            _Pragma("unroll") for (int ks = 0; ks < 2; ++ks) { t0_ = __builtin_amdgcn_mfma_f32_32x32x16_bf16(kg[2 * ks], qf[ks + 2], t0_, 0, 0, 0); t1_ = __builtin_amdgcn_mfma_f32_32x32x16_bf16(kg[2 * ks + 1], qf[ks + 2], t1_, 0, 0, 0); } \
            __builtin_amdgcn_s_setprio(0); sn##0 = t0_; sn##1 = t1_; } \
        AT_VFRAG(vA, STC, 0); \
        AT_SB; \
        float ls = 0.f; \
        _Pragma("unroll") for (int e = 0; e < 16; ++e) { s0[e] = __builtin_amdgcn_exp2f(s0[e] - mrow); s1[e] = __builtin_amdgcn_exp2f(s1[e] - mrow); ls += s0[e] + s1[e]; } \
        lrow += ls; \
        bf16x8 pf[2][2]; \
        _Pragma("unroll") for (int s = 0; s < 2; ++s) { u32x4 w0, w1; \
            w0.x = pk2(s0[8 * s + 0], s0[8 * s + 1]); w0.y = pk2(s0[8 * s + 2], s0[8 * s + 3]); w0.z = pk2(s0[8 * s + 4], s0[8 * s + 5]); w0.w = pk2(s0[8 * s + 6], s0[8 * s + 7]); \
            w1.x = pk2(s1[8 * s + 0], s1[8 * s + 1]); w1.y = pk2(s1[8 * s + 2], s1[8 * s + 3]); w1.z = pk2(s1[8 * s + 4], s1[8 * s + 5]); w1.w = pk2(s1[8 * s + 6], s1[8 * s + 7]); \
            pf[0][s] = __builtin_bit_cast(bf16x8, w0); pf[1][s] = __builtin_bit_cast(bf16x8, w1); } \
        AT_SB; \
        AT_PV(vA, pf[0][0]); \
        AT_SB; \
        AT_VFRAG(vA, STC, 1); \
        AT_SB; \
        AT_PV(vA, pf[0][1]); \
        AT_SB; \
          \
        if ((j) + 2 < 64) { *(LAS u32x4*)(lds + (STC) + lk) = r0; *(LAS u32x4*)(lds + (STC) + AT_K1 + lk) = r1; } \
        if ((j) + 1 < 64) { *(LAS u32x4*)(lds + (STN) + lv0) = r2; *(LAS u32x4*)(lds + (STN) + lv1) = r3; } \
        AT_SB; \
        AT_VFRAG(vA, STC, 2); \
        AT_SB; \
        AT_PV(vA, pf[1][0]); \
        AT_SB; \
        AT_VFRAG(vA, STC, 3); \
        AT_SB; \
        AT_PV(vA, pf[1][1]); \
        __syncthreads(); } while (0)
    for (int j = 0; j < 64; j += 2) {
        AT_TILE(j, sA0, sA1, sB, 0, AT_STG);
        AT_TILE(j + 1, sB0, sB1, sA, AT_STG, 0);
    }
#undef AT_TILE
#undef AT_QK
#undef AT_VFRAG
#undef AT_PV
#undef AT_SB
    const float inv = __builtin_amdgcn_rcpf(lrow + __shfl_xor(lrow, 32));
    LAS float* img = (LAS float*)lds;
    const int qrow = wq * 32 + r32;
    if (c == 1) {
        const float sc = -lam * inv;
#pragma unroll
        for (int vt = 0; vt < 4; ++vt)
#pragma unroll
            for (int g = 0; g < 4; ++g)
                *(LAS f32x4*)(img + qrow * AT_IMG_ROW + 32 * vt + 8 * g + 4 * hh) = (f32x4){o[vt][4 * g] * sc, o[vt][4 * g + 1] * sc, o[vt][4 * g + 2] * sc, o[vt][4 * g + 3] * sc};
    }
    __syncthreads();
    if (c == 0) {
#pragma unroll
        for (int vt = 0; vt < 4; ++vt)
#pragma unroll
            for (int g = 0; g < 4; ++g) {
                LAS f32x4* p = (LAS f32x4*)(img + qrow * AT_IMG_ROW + 32 * vt + 8 * g + 4 * hh);
                f32x4 t = *p;
                t.x += o[vt][4 * g] * inv; t.y += o[vt][4 * g + 1] * inv; t.z += o[vt][4 * g + 2] * inv; t.w += o[vt][4 * g + 3] * inv;
                *p = t;
            }
    }
    __syncthreads();
    {
        const int q = tid >> 2, part = tid & 3;
        float v[32]; float ss = 0.f;
#pragma unroll
        for (int i = 0; i < 8; ++i) { const f32x4 t = *(const LAS f32x4*)(img + q * AT_IMG_ROW + 32 * part + 4 * i); v[4 * i] = t.x; v[4 * i + 1] = t.y; v[4 * i + 2] = t.z; v[4 * i + 3] = t.w;
            ss += (t.x * t.x + t.y * t.y) + (t.z * t.z + t.w * t.w); }
        ss += __shfl_xor(ss, 1); ss += __shfl_xor(ss, 2);
        const float rs = rsqrtf(ss * (1.0f / 128.0f) + EPS) * one_minus_lam_init;
        const float* gp = gainA + h * 128 + 32 * part;
        bf16_t* dst = AO + ((size_t)(b * SEQ + qb * 128 + q)) * 1024 + h * 128 + 32 * part;
#pragma unroll
        for (int i = 0; i < 4; ++i) {
            const f32x4 g0 = *(const f32x4*)(gp + 8 * i), g1 = *(const f32x4*)(gp + 8 * i + 4);
            u32x4 w; w.x = pk2(v[8 * i] * rs * g0.x, v[8 * i + 1] * rs * g0.y); w.y = pk2(v[8 * i + 2] * rs * g0.z, v[8 * i + 3] * rs * g0.w);
            w.z = pk2(v[8 * i + 4] * rs * g1.x, v[8 * i + 5] * rs * g1.y); w.w = pk2(v[8 * i + 6] * rs * g1.z, v[8 * i + 7] * rs * g1.w);
            *(u32x4*)(dst + 8 * i) = w;
        }
    }
    __syncthreads();
}

constexpr int HG_SEG = 0;
constexpr int HG_F = 2048;
constexpr int HG_PART = 2560;
constexpr int HG_V = 4096;
constexpr int HG_VROW = 288;
constexpr int HG_A = HG_V + 64 * HG_VROW;
constexpr int HG_KTROW = 144, HG_QKROW = 272;
constexpr int HG_Bq = HG_A + 128 * HG_KTROW;

__device__ __forceinline__ void hg_cumsum(const float (&gv)[16], int dir, int k, int j, LAS unsigned char* lds, float (&d)[16], float& m_out, float& tot_out) {
    float run = 0.f;
    if (dir == 0) {
#pragma unroll
        for (int i = 0; i < 16; ++i) { run += gv[i]; d[i] = run; }
    } else {
#pragma unroll
        for (int i = 15; i >= 0; --i) { run += gv[i]; d[i] = run; }
    }
    LAS float* seg = (LAS float*)(lds + HG_SEG);
    seg[j * 128 + k] = run;
    __syncthreads();
    const float s0 = seg[k], s1 = seg[128 + k], s2 = seg[256 + k], s3 = seg[384 + k];
    float off, m;
    if (dir == 0) { off = (j > 0 ? s0 : 0.f) + (j > 1 ? s1 : 0.f) + (j > 2 ? s2 : 0.f); m = s0 + s1; }
    else { off = (j < 3 ? s3 : 0.f) + (j < 2 ? s2 : 0.f) + (j < 1 ? s1 : 0.f); m = s2 + s3; }
#pragma unroll
    for (int i = 0; i < 16; ++i) d[i] = d[i] + off - m;
    m_out = m; tot_out = (s0 + s1) + (s2 + s3);
}
__device__ __forceinline__ void hg_load_v(const bf16_t* HV, int tok0, int h, LAS unsigned char* lds, int tid) {
#pragma unroll
    for (int i = 0; i < 2; ++i) { const int ch = tid + 512 * i, p = ch >> 4, part = ch & 15;
        *(LAS u32x4*)(lds + HG_V + p * HG_VROW + part * 16) = *(const u32x4*)(HV + (size_t)(tok0 + p) * 512 + h * 128 + part * 8); }
}
__device__ __forceinline__ void hg_load_g(const bf16_t* G, int tok0, int h, int k, int j, float (&gv)[16]) {
    const bf16_t* gp = G + (size_t)(tok0 + 16 * j) * 512 + h * 128 + k;
    unsigned short raw[16];
#pragma unroll
    for (int i = 0; i < 16; ++i) raw[i] = gp[(size_t)i * 512];
#pragma unroll
    for (int i = 0; i < 16; ++i) gv[i] = bf2f(raw[i]);
}

__device__ __forceinline__ void hg1_phase(int bx, int G, const bf16_t* GF, const bf16_t* GB, const bf16_t* HV, bf16_t* UT, float* Dg, float* Eg, LAS unsigned char* lds) {
    int tid_ = threadIdx.x; asm volatile("" : "+v"(tid_));
    const int tid = tid_, wave = __builtin_amdgcn_readfirstlane(tid >> 6), lane = tid & 63;
    const int k = tid & 127, j = tid >> 7, i16 = lane & 15, g4 = lane >> 4;
    float gn[16]; u32x4 vn[2];
#define HG1_LOAD(uu) do { const int u_ = (uu), dir_ = u_ & 1, cch_ = (u_ >> 1) & 63, bh_ = u_ >> 7, tok_ = (bh_ >> 2) * SEQ + cch_ * 64; \
        hg_load_g(dir_ ? GB : GF, tok_, bh_ & 3, k, j, gn); \
        _Pragma("unroll") for (int i = 0; i < 2; ++i) { const int ch = tid + 512 * i; vn[i] = *(const u32x4*)(HV + (size_t)(tok_ + (ch >> 4)) * 512 + (bh_ & 3) * 128 + (ch & 15) * 8); } } while (0)
    if (bx < 2048) HG1_LOAD(bx);
    for (int u = bx; u < 2048; u += G) {
        const int dir = u & 1, cch = (u >> 1) & 63, bh = u >> 7, b = bh >> 2, h = bh & 3;
        const int tok0 = b * SEQ + cch * 64;
        float gv[16], d[16], m, tot;
#pragma unroll
        for (int i = 0; i < 16; ++i) gv[i] = gn[i];
        u32x4 vr[2];
#pragma unroll
        for (int i = 0; i < 2; ++i) vr[i] = vn[i];
        if (u + G < 2048) HG1_LOAD(u + G);
        hg_cumsum(gv, dir, k, j, lds, d, m, tot);
        float kt[16];
#pragma unroll
        for (int i = 0; i < 16; ++i) kt[i] = (1.0f - __expf(gv[i])) * __expf(fminf(-d[i], 40.f));
        { u32x4 w0, w1;
          w0.x = pk2(kt[0], kt[1]); w0.y = pk2(kt[2], kt[3]); w0.z = pk2(kt[4], kt[5]); w0.w = pk2(kt[6], kt[7]);
          w1.x = pk2(kt[8], kt[9]); w1.y = pk2(kt[10], kt[11]); w1.z = pk2(kt[12], kt[13]); w1.w = pk2(kt[14], kt[15]);
          *(LAS u32x4*)(lds + HG_A + k * HG_KTROW + j * 32) = w0; *(LAS u32x4*)(lds + HG_A + k * HG_KTROW + j * 32 + 16) = w1; }
#pragma unroll
        for (int i = 0; i < 2; ++i) { const int ch = tid + 512 * i; *(LAS u32x4*)(lds + HG_V + (ch >> 4) * HG_VROW + (ch & 15) * 16) = vr[i]; }
        if (j == 0) { ((LAS float*)(lds + HG_F))[k] = __expf(tot - m); Dg[(size_t)u * 128 + k] = __expf(tot); Eg[(size_t)u * 128 + k] = __expf(m); }
        __syncthreads();
        bf16x8 af[2];
#pragma unroll
        for (int s = 0; s < 2; ++s) {
            const LAS unsigned char* ap = lds + HG_A + (16 * wave + i16) * HG_KTROW + (32 * s + 4 * g4) * 2;
            const u32x2 lo = *(const LAS u32x2*)ap, hi = *(const LAS u32x2*)(ap + 32);
            af[s] = __builtin_bit_cast(bf16x8, (u32x4){lo.x, lo.y, hi.x, hi.y});
        }
        const f32x4 fsc = *(const LAS f32x4*)(lds + HG_F + (16 * wave + 4 * g4) * 4);
        const LAS unsigned char* vbase = lds + HG_V + (4 * g4 + (i16 >> 2)) * HG_VROW + (i16 & 3) * 8;
#pragma unroll
        for (int vt = 0; vt < 8; ++vt) {
            f32x4 acc = {0.f, 0.f, 0.f, 0.f};
#pragma unroll
            for (int s = 0; s < 2; ++s) {
                const s16x4 t0 = tr_read(vbase + (32 * s) * HG_VROW + vt * 32), t1 = tr_read(vbase + (32 * s + 16) * HG_VROW + vt * 32);
                const bf16x8 bv = {t0[0], t0[1], t0[2], t0[3], t1[0], t1[1], t1[2], t1[3]};
                acc = __builtin_amdgcn_mfma_f32_16x16x32_bf16(af[s], bv, acc, 0, 0, 0);
            }
            u32x2 w; w.x = pk2(acc[0] * fsc[0], acc[1] * fsc[1]); w.y = pk2(acc[2] * fsc[2], acc[3] * fsc[3]);
            *(u32x2*)(UT + ((size_t)u * 128 + 16 * vt + i16) * 128 + 16 * wave + 4 * g4) = w;
        }
        __syncthreads();
    }
}

__device__ __forceinline__ void hg2_scan(bf16_t* UT, const float* Dg, const float* Eg, int gthread, int nthreads) {
    for (int idx = gthread; idx < 32 * 4096; idx += nthreads) {
        const int chain = idx >> 12, e4 = idx & 4095, v = e4 >> 5, k0 = (e4 & 31) * 4;
        const int dir = chain & 1, bh = chain >> 1;
        float S0 = 0.f, S1 = 0.f, S2 = 0.f, S3 = 0.f;
        int u = (bh * 64 + (dir ? 63 : 0)) * 2 + dir;
        const int ustep = dir ? -2 : 2;
        u32x2 uu[4]; f32x4 dd[4], ee[4];
#pragma unroll
        for (int r = 0; r < 4; ++r) { const int ur = u + r * ustep; uu[r] = *(const u32x2*)(UT + ((size_t)ur * 128 + v) * 128 + k0); dd[r] = *(const f32x4*)(Dg + (size_t)ur * 128 + k0); ee[r] = *(const f32x4*)(Eg + (size_t)ur * 128 + k0); }
        for (int cc = 0; cc < 64; cc += 4) {
#pragma unroll
            for (int r = 0; r < 4; ++r) {
                const u32x2 uc = uu[r]; const f32x4 dc = dd[r], ec = ee[r];
                if (cc + 4 < 64) { const int un = u + 4 * ustep; uu[r] = *(const u32x2*)(UT + ((size_t)un * 128 + v) * 128 + k0); dd[r] = *(const f32x4*)(Dg + (size_t)un * 128 + k0); ee[r] = *(const f32x4*)(Eg + (size_t)un * 128 + k0); }
                u32x2 w; w.x = pk2(ec.x * S0, ec.y * S1); w.y = pk2(ec.z * S2, ec.w * S3);
                *(u32x2*)(UT + ((size_t)u * 128 + v) * 128 + k0) = w;
                S0 = dc.x * S0 + bflo(uc.x); S1 = dc.y * S1 + bfhi(uc.x); S2 = dc.z * S2 + bflo(uc.y); S3 = dc.w * S3 + bfhi(uc.y);
                u += ustep;
            }
        }
    }
}

constexpr int HG_OUT = HG_Bq + 64 * HG_QKROW;
__device__ __forceinline__ void hg3_phase(int bx, int G, const bf16_t* GF, const bf16_t* GB, const bf16_t* HQ, const bf16_t* HV, const bf16_t* ST, const bf16_t* BG, const float* gainH, bf16_t* AO, LAS unsigned char* lds) {
    int tid_ = threadIdx.x; asm volatile("" : "+v"(tid_));
    const int tid = tid_, wave = __builtin_amdgcn_readfirstlane(tid >> 6), lane = tid & 63;
    const int k = tid & 127, j = tid >> 7;
    const int tb = wave & 3, vh = wave >> 2, i16 = lane & 15, g4 = lane >> 4;
    float gf[16], gb[16]; unsigned short qr[16];
#define HG3_LOAD(uu) do { const int u_ = (uu), cch_ = u_ & 63, bh_ = u_ >> 6, tok_ = (bh_ >> 2) * SEQ + cch_ * 64, h_ = bh_ & 3; \
        hg_load_g(GF, tok_, h_, k, j, gf); hg_load_g(GB, tok_, h_, k, j, gb); \
        const bf16_t* qp = HQ + (size_t)(tok_ + 16 * j) * 512 + h_ * 128 + k; \
        _Pragma("unroll") for (int i = 0; i < 16; ++i) qr[i] = qp[(size_t)i * 512]; } while (0)
    if (bx < 1024) HG3_LOAD(bx);
  for (int u3 = bx; u3 < 1024; u3 += G) {
    const int cch = u3 & 63, bh = u3 >> 6, b = bh >> 2, h = bh & 3;
    const int tok0 = b * SEQ + cch * 64;
    hg_load_v(HV, tok0, h, lds, tid);
    u32x4 bgq[2];
    { const bf16_t* bgp0 = BG + (size_t)(tok0 + (tid >> 3)) * 512 + h * 128 + 16 * (tid & 7); bgq[0] = *(const u32x4*)bgp0; bgq[1] = *(const u32x4*)(bgp0 + 8); }
    bf16x8 sb[16];
    { const bf16_t* stp = ST + ((size_t)((bh * 64 + cch) * 2 + 0) * 128) * 128;
#pragma unroll
      for (int vv = 0; vv < 4; ++vv)
#pragma unroll
        for (int ks = 0; ks < 4; ++ks) sb[vv * 4 + ks] = *(const bf16x8*)(stp + (size_t)(16 * (4 * vh + vv) + i16) * 128 + 32 * ks + 8 * g4); }
    f32x4 oacc[4];
#pragma unroll
    for (int i = 0; i < 4; ++i) oacc[i] = (f32x4){0.f, 0.f, 0.f, 0.f};
#pragma unroll
    for (int dir = 0; dir < 2; ++dir) {
        float d[16], m, tot;
        hg_cumsum(dir ? gb : gf, dir, k, j, lds, d, m, tot);
#pragma unroll
        for (int i = 0; i < 16; ++i) {
            const float gvi = dir ? gb[i] : gf[i];
            const float kt = (1.0f - __expf(gvi)) * __expf(fminf(-d[i], 40.f));
            const float qt = bf2f(qr[i]) * __expf(fminf(d[i], 40.f));
            *(LAS unsigned short*)(lds + HG_A + (16 * j + i) * HG_QKROW + k * 2) = (unsigned short)f2bf(kt);
            *(LAS unsigned short*)(lds + HG_Bq + (16 * j + i) * HG_QKROW + k * 2) = (unsigned short)f2bf(qt);
        }
        if (dir == 1 && u3 + G < 1024) HG3_LOAD(u3 + G);
        __syncthreads();
        f32x4 pt[4];
#pragma unroll
        for (int sg = 0; sg < 4; ++sg) pt[sg] = (f32x4){0.f, 0.f, 0.f, 0.f};
        bf16x8 qa[4];
#pragma unroll
        for (int ks = 0; ks < 4; ++ks) qa[ks] = *(const LAS bf16x8*)(lds + HG_Bq + (16 * tb + i16) * HG_QKROW + (32 * ks + 8 * g4) * 2);
#pragma unroll
        for (int sg = 0; sg < 4; ++sg)
#pragma unroll
            for (int ks = 0; ks < 4; ++ks) {
                const bf16x8 ka = *(const LAS bf16x8*)(lds + HG_A + (16 * sg + i16) * HG_QKROW + (32 * ks + 8 * g4) * 2);
                pt[sg] = __builtin_amdgcn_mfma_f32_16x16x32_bf16(ka, qa[ks], pt[sg], 0, 0, 0);
            }
        const int tcol = 16 * tb + i16;
#pragma unroll
        for (int sg = 0; sg < 4; ++sg)
#pragma unroll
            for (int e = 0; e < 4; ++e) { const int srow = 16 * sg + 4 * g4 + e; const bool keep = dir ? (srow >= tcol) : (srow <= tcol); pt[sg][e] = keep ? pt[sg][e] : 0.f; }
        bf16x8 pa[2];
#pragma unroll
        for (int s2 = 0; s2 < 2; ++s2) {
            u32x4 w; w.x = pk2(pt[2 * s2][0], pt[2 * s2][1]); w.y = pk2(pt[2 * s2][2], pt[2 * s2][3]); w.z = pk2(pt[2 * s2 + 1][0], pt[2 * s2 + 1][1]); w.w = pk2(pt[2 * s2 + 1][2], pt[2 * s2 + 1][3]);
            pa[s2] = __builtin_bit_cast(bf16x8, w);
        }
        const LAS unsigned char* vbase = lds + HG_V + (4 * g4 + (i16 >> 2)) * HG_VROW + (i16 & 3) * 8;
#pragma unroll
        for (int vv = 0; vv < 4; ++vv) {
            const int vt = 4 * vh + vv;
#pragma unroll
            for (int s2 = 0; s2 < 2; ++s2) {
                const s16x4 t0 = tr_read(vbase + (32 * s2) * HG_VROW + vt * 32), t1 = tr_read(vbase + (32 * s2 + 16) * HG_VROW + vt * 32);
                const bf16x8 bv = {t0[0], t0[1], t0[2], t0[3], t1[0], t1[1], t1[2], t1[3]};
                oacc[vv] = __builtin_amdgcn_mfma_f32_16x16x32_bf16(pa[s2], bv, oacc[vv], 0, 0, 0);
            }
#pragma unroll
            for (int ks = 0; ks < 4; ++ks) oacc[vv] = __builtin_amdgcn_mfma_f32_16x16x32_bf16(qa[ks], sb[vv * 4 + ks], oacc[vv], 0, 0, 0);
        }
        if (dir == 0) {
            const bf16_t* stp = ST + ((size_t)((bh * 64 + cch) * 2 + 1) * 128) * 128;
#pragma unroll
            for (int vv = 0; vv < 4; ++vv)
#pragma unroll
                for (int ks = 0; ks < 4; ++ks) sb[vv * 4 + ks] = *(const bf16x8*)(stp + (size_t)(16 * (4 * vh + vv) + i16) * 128 + 32 * ks + 8 * g4);
        }
        __syncthreads();
    }
    LAS float* ot = (LAS float*)(lds + HG_OUT);
#pragma unroll
    for (int vv = 0; vv < 4; ++vv)
#pragma unroll
        for (int e = 0; e < 4; ++e) ot[(16 * tb + 4 * g4 + e) * 132 + 16 * (4 * vh + vv) + i16] = oacc[vv][e];
    __syncthreads();
    {
        const int t = tid >> 3, part = tid & 7;
        float v[16]; float ss = 0.f;
#pragma unroll
        for (int i = 0; i < 4; ++i) { const f32x4 x = *(const LAS f32x4*)(ot + t * 132 + 16 * part + 4 * i); v[4 * i] = x.x; v[4 * i + 1] = x.y; v[4 * i + 2] = x.z; v[4 * i + 3] = x.w; ss += (x.x * x.x + x.y * x.y) + (x.z * x.z + x.w * x.w); }
        ss += __shfl_xor(ss, 1); ss += __shfl_xor(ss, 2); ss += __shfl_xor(ss, 4);
        const float rs = rsqrtf(ss * (1.0f / 128.0f) + EPS);
        const float* gp = gainH + h * 128 + 16 * part;
        bf16_t* dst = AO + (size_t)(tok0 + t) * 1024 + 512 + h * 128 + 16 * part;
#pragma unroll
        for (int i = 0; i < 2; ++i) {
            const u32x4 gq = bgq[i];
            const f32x4 g0 = *(const f32x4*)(gp + 8 * i), g1 = *(const f32x4*)(gp + 8 * i + 4);
            u32x4 w;
            w.x = pk2(v[8 * i] * rs * g0.x * bflo(gq.x), v[8 * i + 1] * rs * g0.y * bfhi(gq.x)); w.y = pk2(v[8 * i + 2] * rs * g0.z * bflo(gq.y), v[8 * i + 3] * rs * g0.w * bfhi(gq.y));
            w.z = pk2(v[8 * i + 4] * rs * g1.x * bflo(gq.z), v[8 * i + 5] * rs * g1.y * bfhi(gq.z)); w.w = pk2(v[8 * i + 6] * rs * g1.z * bflo(gq.w), v[8 * i + 7] * rs * g1.w * bfhi(gq.w));
            *(u32x4*)(dst + 8 * i) = w;
        }
    }
    __syncthreads();
  }
#undef HG3_LOAD
}

#define XB_TMO      128
#define XB_XCNT(j)  (256  + 64 * (j))
#define XB_XSUB(j)  (1280 + 64 * (j))
#define XB_XGEN(j)  (2304 + 64 * (j))
#define XB_TOP      3328
#define XB_TOPGEN   3392
#define XCD_BAR_WORDS 3456
#define XB_SPIN_CAP (1u << 18)

__device__ __forceinline__ unsigned xb_ld(unsigned* p)              { return __hip_atomic_load(p, __ATOMIC_RELAXED, __HIP_MEMORY_SCOPE_AGENT); }
__device__ __forceinline__ unsigned xb_add(unsigned* p, unsigned v) { return __hip_atomic_fetch_add(p, v, __ATOMIC_RELAXED, __HIP_MEMORY_SCOPE_AGENT); }
__device__ __forceinline__ unsigned xb_xcc_id() { return (unsigned)__builtin_amdgcn_s_getreg((3 << 11) | 20) & 0xFu; }
#define XB_SPIN(cond, bar) do { unsigned _sp = 0; while (cond) { __builtin_amdgcn_s_sleep(1); \
    if ((++_sp & 255u) == 0u) { if (xb_ld(&(bar)[XB_TMO])) break; if (_sp > XB_SPIN_CAP) { atomicAdd(&(bar)[XB_TMO], 1u); break; } } } } while (0)

struct XcdBarrier {
    unsigned* bar; unsigned x;
    volatile LAS unsigned* st;
};

__device__ __forceinline__ XcdBarrier xcd_barrier_post(unsigned* bar, volatile LAS unsigned* st) {
    XcdBarrier b; b.bar = bar; b.x = xb_xcc_id(); b.st = st;
    if (threadIdx.x == 0) (void)xb_add(&bar[XB_XCNT(b.x)], 1u);
    return b;
}
__device__ __forceinline__ void xcd_barrier_complete(unsigned* bar, unsigned x, unsigned& nloc, unsigned& nx) {
    const unsigned G = gridDim.x * gridDim.y * gridDim.z;
    unsigned sum, cnt, mine, sp = 0u;
    for (;;) {
        sum = 0u; cnt = 0u; mine = 0u;
#pragma unroll
        for (unsigned j = 0; j < 16; ++j) { const unsigned c = xb_ld(&bar[XB_XCNT(j)]); sum += c; cnt += (c > 0u) ? 1u : 0u; mine = (j == x) ? c : mine; }
        if (sum == G) break;
        __builtin_amdgcn_s_sleep(1);
        if ((++sp & 255u) == 0u) { if (xb_ld(&bar[XB_TMO])) break; if (sp > XB_SPIN_CAP) { atomicAdd(&bar[XB_TMO], 1u); break; } }
    }
    nloc = mine > 0u ? mine : 1u; nx = cnt > 0u ? cnt : 1u;
}

__device__ __forceinline__ void xcd_barrier(const XcdBarrier& b) {
    asm volatile("s_waitcnt vmcnt(0)" ::: "memory");
    __syncthreads();
    if (threadIdx.x == 0) {
        unsigned* bar = b.bar;
        __builtin_amdgcn_s_waitcnt(0);
        unsigned nloc = b.st[0], nx = b.st[1];
        if (nloc == 0u) { xcd_barrier_complete(bar, b.x, nloc, nx); b.st[0] = nloc; b.st[1] = nx; }
        const unsigned old = xb_add(&bar[XB_XSUB(b.x)], 1u);
        const unsigned gen = old / nloc;
        if (old + 1u == (gen + 1u) * nloc) {
            __builtin_amdgcn_fence(__ATOMIC_RELEASE, "agent");
            asm volatile("s_waitcnt vmcnt(0)" ::: "memory");
            const unsigned og = xb_add(&bar[XB_TOP], 1u);
            const unsigned tg = og / nx;
            if (og + 1u == (tg + 1u) * nx) xb_add(&bar[XB_TOPGEN], 1u);
            else XB_SPIN(xb_ld(&bar[XB_TOPGEN]) == tg, bar);
            __builtin_amdgcn_fence(__ATOMIC_ACQUIRE, "agent");
            xb_add(&bar[XB_XGEN(b.x)], 1u);
            asm volatile("s_waitcnt vmcnt(0)" ::: "memory");
        } else {
            XB_SPIN(xb_ld(&bar[XB_XGEN(b.x)]) == gen, bar);
            __builtin_amdgcn_fence(__ATOMIC_ACQUIRE, "agent");
            asm volatile("s_waitcnt vmcnt(0)" ::: "memory");
        }
    }
    __syncthreads();
}

__global__ void __launch_bounds__(512, 2) fwd_kernel(Ptrs Pk) {
    extern __shared__ __attribute__((aligned(16))) unsigned char lds_raw[];
    LAS unsigned char* lds = (LAS unsigned char*)lds_raw;
    cg::grid_group grid = cg::this_grid();
    const int G = gridDim.x, bx = blockIdx.x;
    const int lo = Pk.ph_lo, hi = Pk.ph_hi;
    int ph = 0;
    if (threadIdx.x < 4) ((LAS unsigned*)(lds + 131072 + 1024))[threadIdx.x] = 0u;
    __syncthreads();
    XcdBarrier xbar = xcd_barrier_post((unsigned*)(Pk.ws + OFF_BAR), (volatile LAS unsigned*)(lds + 131072 + 1024));
#ifdef TS_A
    if (threadIdx.x == 0) { LAS unsigned long long* TS_ = (LAS unsigned long long*)(lds + 131072); for (int i = 0; i < 15; ++i) TS_[i] = 0ull; TS_[15] = __builtin_amdgcn_s_memrealtime(); }
#endif
#ifndef PH_MASK
#define PH_MASK 0xFFFFFFFFu
#endif
#define ON(id) constexpr (((PH_MASK) >> (id)) & 1u)
#if defined(__HIP_DEVICE_COMPILE__)
#define LOAD_ARGS(P) int zoff_ = 0; asm volatile("" : "+s"(zoff_)); const Ptrs P = *(const __attribute__((address_space(4))) Ptrs*)((const __attribute__((address_space(4))) char*)__builtin_amdgcn_kernarg_segment_ptr() + zoff_);
#else
#define LOAD_ARGS(P) const Ptrs P = Pk;
#endif
#define PHASE_BEGIN if (ph >= lo && ph < hi) { LOAD_ARGS(P) unsigned char* ws = P.ws; asm volatile("" : "+s"(ws)); int tid = threadIdx.x; asm volatile("" : "+v"(tid)); \
    const int lane = tid & 63, wave = __builtin_amdgcn_readfirstlane(tid >> 6), gw = bx * 8 + wave, ngw = G * 8; (void)lane; (void)gw; (void)ngw;
#define XB ((bf16_t*)(ws + OFF_XB))
#define RSA ((float*)(ws + OFF_RSA))
#define RSB ((float*)(ws + OFF_RSB))
#define CS ((const float*)(ws + OFF_CS))
#define LB ((const float*)(ws + OFF_LB))
#define LAM ((const float*)(ws + OFF_LAM))
#define Dg ((float*)(ws + OFF_DG))
#define Eg ((float*)(ws + OFF_EG))
#define GATE ((bf16_t*)(ws + OFF_GATE))
#define Qb ((bf16_t*)(ws + OFF_Q))
#define Kb ((bf16_t*)(ws + OFF_K))
#define Vb ((bf16_t*)(ws + OFF_V))
#define HQ ((bf16_t*)(ws + OFF_HQ))
#define HV ((bf16_t*)(ws + OFF_HV))
#define GF ((bf16_t*)(ws + OFF_GF))
#define GB ((bf16_t*)(ws + OFF_GB))
#define Yb ((bf16_t*)(ws + OFF_Y))
#define BG ((bf16_t*)(ws + OFF_BG))
#define AO ((bf16_t*)(ws + OFF_AO))
#define UT ((bf16_t*)(ws + OFF_UT))
#define Hb ((bf16_t*)(ws + OFF_H))
#ifdef TS_A
#define TICK(cat) do { if (bx == 0 && threadIdx.x == 0) { LAS unsigned long long* TS_ = (LAS unsigned long long*)(lds + 131072); const unsigned long long t_ = __builtin_amdgcn_s_memrealtime(); TS_[cat] += t_ - TS_[15]; TS_[15] = t_; } } while (0)
#else
#define TICK(cat) do { } while (0)
#endif
#define PHASE_END(cat)   TICK(cat); if (ph + 1 < hi) { if (ph == 0) grid.sync(); else xcd_barrier(xbar); TICK(13); } } ++ph;

    PHASE_BEGIN
        if ON(0) prologue(P, lds, gw, ngw, wave, lane);
        if ON(6) convert_layer(P, 0, ws, lds, gw, ngw, wave, lane);
    PHASE_END(0)

    for (int layer = 0; layer < DEPTH; ++layer) {
        PHASE_BEGIN
            pg8::Gemm g{XB, (const bf16_t*)(ws + (size_t)(layer & 1) * WSZ + W_IN), Dm, Dm, Dm, 1 << 30, 0, -1};
            pg8::StaticOrder S; S.init(M, 4096, G, bx);
            EpiMix E{RSB, CS, LB + (0 * 4 + layer) * 512, LB + (1 * 4 + layer) * 512, Qb, Kb, Vb, HQ, HV, BG, GF, GB};
            if ON(1) pg8::gemm_phase(lds, g, S, E);
        PHASE_END(1)
        PHASE_BEGIN
            const float lam_init = 0.8f - 0.6f * __expf(-0.3f * (float)layer);
            const float lam = LAM[layer];
            if ON(2) for (int i = 0; i * G + bx < 512; ++i) {
                const int uid = i * G + bx; const int round = uid >> 8, r = uid & 255;
                const int bhh = round * 8 + (r & 7), qb = r >> 3;
                attn_unit(bhh >> 2, bhh & 3, qb, Qb, Kb, Vb, AO, P.da_norm + layer * 512, 1.0f - lam_init, lam, lds);
            }
            TICK(2);
            if ON(3) hg1_phase(bx, G, GF, GB, HV, UT, Dg, Eg, lds);
        PHASE_END(3)
        PHASE_BEGIN
            if ON(5) hg2_scan(UT, Dg, Eg, bx * 512 + tid, G * 512);
            TICK(5);
            {
                pg8::Gemm g{XB, (const bf16_t*)(ws + (size_t)(layer & 1) * WSZ + W_IN) + (size_t)4096 * Dm, Dm, Dm, Dm, 1 << 30, 0, -1};
                pg8::StaticOrder S; S.init(M, 2048, G, bx);
                EpiGate E{RSB, GATE};
                if ON(4) pg8::gemm_phase(lds, g, S, E);
            }
            TICK(4);
        PHASE_END(4)
        PHASE_BEGIN
            if ON(7) hg3_phase(bx, G, GF, GB, HQ, HV, UT, BG, P.hg_norm + layer * 512, AO, lds);
        PHASE_END(7)
        PHASE_BEGIN
            pg8::Gemm g{AO, (const bf16_t*)(ws + (size_t)(layer & 1) * WSZ + W_AB), 1024, 1024, 1024, 1 << 30, 0, 8};
            pg8::StaticOrder S; S.init(M, 1024, G, bx);
            EpiY E{GATE, Yb};
            if ON(8) pg8::gemm_phase(lds, g, S, E);
        PHASE_END(8)
        PHASE_BEGIN
            pg8::Gemm g{Yb, (const bf16_t*)(ws + (size_t)(layer & 1) * WSZ + W_O2), 1024, 1024, 1024, 1 << 30, 0, -1};
            pg8::StaticOrder S; S.init(M, Dm, G, bx);
            EpiRes E{XB, RSA};
            if ON(9) pg8::gemm_phase(lds, g, S, E);
        PHASE_END(9)
        PHASE_BEGIN
            pg8::Gemm g{XB, (const bf16_t*)(ws + (size_t)(layer & 1) * WSZ + W_GU), Dm, Dm, Dm, 1 << 30, 0, -1};
            pg8::StaticOrder S; S.init(M, 2 * FF, G, bx);
            EpiGU E{RSA, Hb};
            if ON(10) pg8::gemm_phase(lds, g, S, E);
        PHASE_END(10)
        PHASE_BEGIN
            pg8::Gemm g{Hb, (const bf16_t*)(ws + (size_t)(layer & 1) * WSZ + W_D), FF, FF, FF, 1 << 30, 0, -1};
            pg8::StaticOrder S; S.init(M, Dm, G, bx);
            EpiRes E{XB, RSB};
            if ON(11) pg8::gemm_phase(lds, g, S, E);
            TICK(11);
            if ON(6) if (layer + 1 < DEPTH) convert_layer(P, layer + 1, ws + (size_t)((layer + 1) & 1) * WSZ, lds, gw, ngw, wave, lane);
        PHASE_END(6)
    }
    PHASE_BEGIN
        if ON(12) for (int r = gw; r < M; r += ngw) {
            float v[16]; float ss = 0.f;
#pragma unroll
            for (int j = 0; j < 2; ++j) { const u32x4 x = *(const u32x4*)(XB + (size_t)r * Dm + 8 * lane + 512 * j);
                v[8 * j] = bflo(x.x); v[8 * j + 1] = bfhi(x.x); v[8 * j + 2] = bflo(x.y); v[8 * j + 3] = bfhi(x.y); v[8 * j + 4] = bflo(x.z); v[8 * j + 5] = bfhi(x.z); v[8 * j + 6] = bflo(x.w); v[8 * j + 7] = bfhi(x.w); }
#pragma unroll
            for (int e = 0; e < 16; ++e) ss += v[e] * v[e];
            const float rs = rsqrtf(wave_sum(ss) * (1.0f / Dm) + EPS);
#pragma unroll
            for (int j = 0; j < 2; ++j) { const float* gp = P.final_norm + 8 * lane + 512 * j; const f32x4 g0 = *(const f32x4*)gp, g1 = *(const f32x4*)(gp + 4);
                float* op = P.out + (size_t)r * Dm + 8 * lane + 512 * j;
                *(f32x4*)op = (f32x4){v[8 * j] * rs * g0.x, v[8 * j + 1] * rs * g0.y, v[8 * j + 2] * rs * g0.z, v[8 * j + 3] * rs * g0.w};
                *(f32x4*)(op + 4) = (f32x4){v[8 * j + 4] * rs * g1.x, v[8 * j + 5] * rs * g1.y, v[8 * j + 6] * rs * g1.z, v[8 * j + 7] * rs * g1.w}; }
        }
    PHASE_END(12)
#ifdef TS_A
    if (bx == 0 && threadIdx.x == 0) {
        LAS unsigned long long* TS_ = (LAS unsigned long long*)(lds + 131072);
        unsigned long long a = 0;
        for (int i = 0; i < 15; ++i) { if ((TS_A >> i) & 1) a += TS_[i]; }
        const unsigned long long t_end = __builtin_amdgcn_s_memrealtime() + a;
        while (__builtin_amdgcn_s_memrealtime() < t_end) __builtin_amdgcn_s_sleep(20);
    }
#endif
}
constexpr int NPHASES = 2 + 8 * DEPTH;

#ifndef MK_PER_PHASE
#define MK_PER_PHASE 0
#endif

extern "C" void kernel_launch(void* const* d_in, const int* in_sizes, int n_in, void* d_out, int out_size, void* d_ws, size_t ws_size, hipStream_t stream) {
    static int grid = 0;
    if (grid == 0) {
        if (n_in != 16 || out_size != M * Dm || ws_size < WS_END) { fprintf(stderr, "kernel_launch: unexpected sizes (n_in %d, out %d, ws %zu, need %zu)\n", n_in, out_size, ws_size, (size_t)WS_END); grid = -1; return; }
        int dev = 0, cus = 0, per_cu = 0;
        (void)hipGetDevice(&dev);
        (void)hipDeviceGetAttribute(&cus, hipDeviceAttributeMultiprocessorCount, dev);
        if (hipFuncSetAttribute((const void*)fwd_kernel, hipFuncAttributeMaxDynamicSharedMemorySize, LDS_BYTES) != hipSuccess) { fprintf(stderr, "kernel_launch: hipFuncSetAttribute failed\n"); grid = -1; return; }
        (void)hipOccupancyMaxActiveBlocksPerMultiprocessor(&per_cu, (const void*)fwd_kernel, 512, LDS_BYTES);
        (void)hipGetLastError();
        if (per_cu < 1) per_cu = 1;
        grid = cus * 1;
        fprintf(stderr, "kernel_launch: grid %d (per_cu %d), ws %zu need %zu\n", grid, per_cu, ws_size, (size_t)WS_END);
    }
    if (grid < 0) return;
    Ptrs p{};
    p.x = (const float*)d_in[0]; p.pos = (const int*)d_in[1]; p.w_in = (const float*)d_in[2]; p.da_lambda = (const float*)d_in[3]; p.da_norm = (const float*)d_in[4];
    p.hg_lb = (const float*)d_in[5]; p.hg_norm = (const float*)d_in[6]; p.w_a = (const float*)d_in[7]; p.w_b = (const float*)d_in[8]; p.w_o = (const float*)d_in[9];
    p.attn_norm = (const float*)d_in[10]; p.ffn_norm = (const float*)d_in[11]; p.w_gate = (const float*)d_in[12]; p.w_up = (const float*)d_in[13]; p.w_down = (const float*)d_in[14];
    p.final_norm = (const float*)d_in[15];
    p.out = (float*)d_out; p.ws = (unsigned char*)d_ws;
    (void)hipMemsetAsync((char*)d_ws + OFF_BAR, 0, BAR_BYTES, stream);
#if MK_PER_PHASE
    for (int ph = 0; ph < NPHASES; ++ph) {
        p.ph_lo = ph; p.ph_hi = ph + 1;
        hipLaunchKernelGGL(fwd_kernel, dim3(grid), dim3(512), LDS_BYTES, stream, p);
    }
#else
    p.ph_lo = 0; p.ph_hi = NPHASES;
    void* args[] = {&p};
    hipError_t e = hipLaunchCooperativeKernel((const void*)fwd_kernel, dim3(grid), dim3(512), args, LDS_BYTES, stream);
    if (e != hipSuccess) fprintf(stderr, "cooperative launch failed: %s (grid %d)\n", hipGetErrorString(e), grid);
#endif
}
```
